# Optimizing an MI355X kernel written in HIP

```python
import math
import jax, jax.numpy as jnp
from jax import lax
import numpy as np

D_MODEL = 1024
BATCH = 2
SEQ = 8192
DEPTH = 4

CHUNK = 64
N_META = 16
D_MIX = D_MODEL
D_POOL = D_MIX // 2
D_RNN = D_MIX // 2
POOL_WINDOWS = (2, 4, 8, 16)
N_POOL_GROUPS = len(POOL_WINDOWS)
POOL_GROUP_DIM = D_POOL // N_POOL_GROUPS
N_RNN_HEADS = 8
RNN_HEAD_DIM = D_RNN // N_RNN_HEADS
CONV_WIDTH = 4
LRU_C = 8.0
D_IN_PROJ = D_POOL + D_RNN + D_RNN
D_FF = 4 * D_MODEL
EPS = 1e-6

kernel_name = "hybrid_pool_rglru_encoder"


def rms_norm(x, g):
    xf = x.astype(jnp.float32)
    y = xf * lax.rsqrt(jnp.mean(xf * xf, axis=-1, keepdims=True) + EPS)
    return (y * g.astype(jnp.float32)).astype(x.dtype)


def multiscale_pool_mixer(u, pool_w, pool_b, pool_scale):
    B, T, _ = u.shape
    uf = u.astype(jnp.float32)
    cs = jnp.concatenate([jnp.zeros((B, 1, D_POOL), jnp.float32), jnp.cumsum(uf, axis=1)], axis=1)
    upper = cs[:, 1:]
    t_idx = jnp.arange(T, dtype=jnp.float32)[None, :, None]
    pooled = []
    for g, k in enumerate(POOL_WINDOWS):
        sl = slice(g * POOL_GROUP_DIM, (g + 1) * POOL_GROUP_DIM)
        cs_g = cs[:, :, sl]
        lower = jnp.pad(cs_g[:, :T + 1 - k], ((0, 0), (k - 1, 0), (0, 0)))
        count = jnp.minimum(t_idx + 1.0, float(k))
        pooled.append((upper[:, :, sl] - lower) / count)
    pooled = jnp.concatenate(pooled, axis=-1) - uf
    pg = pooled.astype(u.dtype).reshape(B, T, N_POOL_GROUPS, POOL_GROUP_DIM)
    mapped = jnp.einsum('btgi,gij->btgj', pg, pool_w).reshape(B, T, D_POOL) + pool_b
    return mapped * pool_scale


def rglru_mixer(u, gate, conv_w, conv_b, gate_r_w, gate_r_b, gate_i_w, gate_i_b, lru_lambda):
    B, T, _ = u.shape
    upad = jnp.pad(u, ((0, 0), (CONV_WIDTH - 1, 0), (0, 0)))
    xc = conv_b + sum(upad[:, k:k + T] * conv_w[k] for k in range(CONV_WIDTH))
    xh = xc.reshape(B, T, N_RNN_HEADS, RNN_HEAD_DIM)
    r = jax.nn.sigmoid((jnp.einsum('bthi,hij->bthj', xh, gate_r_w).reshape(B, T, D_RNN) + gate_r_b).astype(jnp.float32))
    i = jax.nn.sigmoid((jnp.einsum('bthi,hij->bthj', xh, gate_i_w).reshape(B, T, D_RNN) + gate_i_b).astype(jnp.float32))
    log_a = -LRU_C * r * jax.nn.softplus(-lru_lambda.astype(jnp.float32))
    a = jnp.exp(log_a)
    mult = jnp.sqrt(-jnp.expm1(2.0 * log_a))
    b = mult * (i * xc.astype(jnp.float32))

    def combine(left, right):
        a_l, b_l = left
        a_r, b_r = right
        return a_l * a_r, a_r * b_l + b_r

    _, h = lax.associative_scan(combine, (a, b), axis=1)
    return h.astype(u.dtype) * jax.nn.gelu(gate)


def hybrid_mixer(xn, w_in, pool_w, pool_b, pool_scale, conv_w, conv_b, gate_r_w, gate_r_b,
                 gate_i_w, gate_i_b, lru_lambda, group_norm_g, w_out):
    proj = xn @ w_in
    u_pool = proj[..., :D_POOL]
    u_rnn = proj[..., D_POOL:D_POOL + D_RNN]
    u_gate = proj[..., D_POOL + D_RNN:]
    y_pool = multiscale_pool_mixer(u_pool, pool_w, pool_b, pool_scale)
    y_rnn = rglru_mixer(u_rnn, u_gate, conv_w, conv_b, gate_r_w, gate_r_b, gate_i_w, gate_i_b, lru_lambda)
    y = jnp.concatenate([rms_norm(y_pool, group_norm_g[:D_POOL]),
                         rms_norm(y_rnn, group_norm_g[D_POOL:])], axis=-1)
    return y @ w_out


def sq_relu_mlp(xn, w_up, w_down):
    h = jax.nn.relu(xn @ w_up)
    return (h * h) @ w_down


def setup_inputs(seed: int = 0) -> dict:
    key = jax.random.key(seed)
    ks = jax.random.split(key, 24)
    f32 = jnp.float32
    nrm = lambda k, shape, s: jax.random.normal(k, shape, f32) * s
    a0 = jax.random.uniform(ks[11], (DEPTH, D_RNN), f32, 0.9, 0.999)
    p = a0 ** (1.0 / LRU_C)
    lru_lambda = jnp.log(p) - jnp.log1p(-p)
    return {
        "x": nrm(ks[0], (BATCH, SEQ, D_MODEL), 1.0),
        "meta_tokens": nrm(ks[1], (N_META, D_MODEL), 1.0),
        "mix_norm_g": 1.0 + nrm(ks[2], (DEPTH, D_MODEL), 0.1),
        "w_in": nrm(ks[3], (DEPTH, D_MODEL, D_IN_PROJ), D_MODEL ** -0.5),
        "pool_w": nrm(ks[4], (DEPTH, N_POOL_GROUPS, POOL_GROUP_DIM, POOL_GROUP_DIM), POOL_GROUP_DIM ** -0.5),
        "pool_b": nrm(ks[5], (DEPTH, D_POOL), 0.02),
        "pool_scale": 0.5 + nrm(ks[6], (DEPTH, D_POOL), 0.1),
        "conv_w": nrm(ks[7], (DEPTH, CONV_WIDTH, D_RNN), CONV_WIDTH ** -0.5),
        "conv_b": nrm(ks[8], (DEPTH, D_RNN), 0.02),
        "gate_r_w": nrm(ks[9], (DEPTH, N_RNN_HEADS, RNN_HEAD_DIM, RNN_HEAD_DIM), RNN_HEAD_DIM ** -0.5),
        "gate_r_b": nrm(ks[10], (DEPTH, D_RNN), 0.02),
        "gate_i_w": nrm(ks[12], (DEPTH, N_RNN_HEADS, RNN_HEAD_DIM, RNN_HEAD_DIM), RNN_HEAD_DIM ** -0.5),
        "gate_i_b": nrm(ks[13], (DEPTH, D_RNN), 0.02),
        "lru_lambda": lru_lambda,
        "group_norm_g": 1.0 + nrm(ks[14], (DEPTH, D_MIX), 0.1),
        "w_out": nrm(ks[15], (DEPTH, D_MIX, D_MODEL), D_MIX ** -0.5),
        "mlp_norm_g": 1.0 + nrm(ks[16], (DEPTH, D_MODEL), 0.1),
        "w_up": nrm(ks[17], (DEPTH, D_MODEL, D_FF), D_MODEL ** -0.5),
        "w_down": nrm(ks[18], (DEPTH, D_FF, D_MODEL), D_FF ** -0.5),
        "final_norm_g": 1.0 + nrm(ks[19], (D_MODEL,), 0.1),
    }


def reference(x, meta_tokens, mix_norm_g, w_in, pool_w, pool_b, pool_scale, conv_w, conv_b,
              gate_r_w, gate_r_b, gate_i_w, gate_i_b, lru_lambda, group_norm_g, w_out,
              mlp_norm_g, w_up, w_down, final_norm_g):
    B = x.shape[0]
    meta = jnp.broadcast_to(meta_tokens.astype(x.dtype)[None], (B, N_META, D_MODEL))
    h = jnp.concatenate([meta, x], axis=1)
    for l in range(DEPTH):
        h = h + hybrid_mixer(rms_norm(h, mix_norm_g[l]), w_in[l], pool_w[l], pool_b[l], pool_scale[l],
                             conv_w[l], conv_b[l], gate_r_w[l], gate_r_b[l], gate_i_w[l], gate_i_b[l],
                             lru_lambda[l], group_norm_g[l], w_out[l])
        h = h + sq_relu_mlp(rms_norm(h, mlp_norm_g[l]), w_up[l], w_down[l])
    h = rms_norm(h, final_norm_g)
    return h[:, N_META:]
```

```cpp
#include <hip/hip_runtime.h>
#include <hip/hip_cooperative_groups.h>
#include <cstdio>
#include <cstdint>
namespace cg = cooperative_groups;
namespace pg8 {
#define PG8_LAS __attribute__((address_space(3)))
typedef unsigned short bf16_t;
typedef short bf16x8 __attribute__((ext_vector_type(8)));
typedef float f32x4 __attribute__((ext_vector_type(4)));
typedef unsigned u32x4 __attribute__((ext_vector_type(4)));
constexpr int BM = 256, BK = 64, HALF = 128, HTB = HALF * BK * 2  , STAGE_BYTES = 8 * HTB, NXCD = 8, WGM = 8;

__host__ __device__ __forceinline__ int lds_byte(int r, int c) { const int st = (r >> 4) * 2 + (c >> 5), rr = r & 15, cc = c & 31, ob = rr * 64 + cc * 2; return st * 1024 + (ob ^ (((ob >> 9) & 1) << 5)); }
__host__ __device__ __forceinline__ void stage_rc(int b, int& R, int& C) { const int st = b / 1024, sb = b % 1024, swz = sb ^ (((sb >> 9) & 1) << 5); R = (st >> 1) * 16 + swz / 64; C = (st & 1) * 32 + (swz % 64) / 2; }
__host__ __device__ __forceinline__ int perm32(int rho) { const int n = rho >> 4, i = rho & 15; return 8 * (i >> 2) + 4 * n + (i & 3); }

struct Unit { int pm, pn; };
struct Gemm { const bf16_t* A; const bf16_t* Bt; int M, N, K, gap; };

struct StaticOrder {
    int nM, nN, nwg, G, c;
    __host__ __device__ void init(int M, int N, int G_, int c_) { nM = M / BM; nN = N / BM; nwg = nM * nN; G = G_; c = c_; }
    __host__ __device__ bool next(int i, Unit& u) const {
        const long L = (long)i * G + c; if (L >= nwg) return false;
        int wgid = (int)L; { const int q = nwg / NXCD, r = nwg % NXCD, xcd = wgid % NXCD, off = wgid / NXCD; wgid = (xcd < r ? xcd * (q + 1) : r * (q + 1) + (xcd - r) * q) + off; }
        const int nig = WGM * nN, gid = wgid / nig, fm = gid * WGM, gsz = (nM - fm) < WGM ? (nM - fm) : WGM;
        u.pm = fm + ((wgid % nig) % gsz); u.pn = (wgid % nig) / gsz; return true;
    }
    __device__ __forceinline__ void a_ready(const Unit&) const {}
    __device__ __forceinline__ void done(const Unit&) const {}
};
__device__ __forceinline__ unsigned cvt_pk_bf16(float lo, float hi) { unsigned r; asm volatile("v_cvt_pk_bf16_f32 %0, %1, %2" : "=v"(r) : "v"(lo), "v"(hi)); return r; }
template <class Epi, class Sched, bool ALIGN_EPI = false, bool SP2 = false>
__device__ __forceinline__ void gemm_phase(PG8_LAS unsigned char* lds, const Gemm g, const Sched& S, const Epi& E) {
    int tid_ = threadIdx.x; asm volatile("" : "+v"(tid_));
    const int tid = tid_, wid = __builtin_amdgcn_readfirstlane(tid >> 6), lane = tid & 63, wr = wid >> 2, wc = wid & 3, fr = lane & 15, fq = lane >> 4;
    const int K = g.K, nt = K / BK;
    unsigned voffA[2], voffB[2];
#pragma unroll
    for (int i = 0; i < 2; ++i) { int R, C; stage_rc(tid * 16 + i * 8192, R, C); const int Rb = Epi::PERM ? ((R & ~31) + perm32(R & 31)) : R;
        voffA[i] = (unsigned)(R * K + C) * 2u; voffB[i] = (unsigned)(Rb * K + C) * 2u; }
    const size_t kstep = (size_t)(BK * 2);
    const size_t hstep = (size_t)HALF * K * 2;
    const size_t tstep = 2 * hstep;
    const int agap = g.gap;
#define a_off(pm_) ((size_t)((pm_) * BM + agap * (1 + ((pm_) >> 5))) * (size_t)K * 2)
    const unsigned ldsw = (unsigned)wid * 1024u;
    const int aoff = lds_byte(wr * 64 + fr, fq * 8), boff = lds_byte(wc * 32 + fr, fq * 8);
#define PG8_SA(b, h) (((b) * 2 + (h)) * HTB)
#define PG8_SB(b, h) ((4 + (b) * 2 + (h)) * HTB)
#define PG8_STAGE(bufoff, gbase, voff) do { _Pragma("unroll") for (int _i = 0; _i < 2; ++_i) \
        __builtin_amdgcn_global_load_lds((const unsigned*)((const char*)(gbase) + (voff)[_i]), (PG8_LAS unsigned*)(lds + (bufoff) + ldsw + _i * 8192), 16, 0, 0); } while (0)
#define PG8_LDA(dst, b, h) do { _Pragma("unroll") for (int m = 0; m < 4; ++m) _Pragma("unroll") for (int k = 0; k < 2; ++k) dst[m][k] = *(const PG8_LAS bf16x8*)(lds + PG8_SA(b, h) + aoff + m * 2048 + k * 1024); } while (0)
#define PG8_LDB(dst, b, h) do { _Pragma("unroll") for (int n = 0; n < 2; ++n) _Pragma("unroll") for (int k = 0; k < 2; ++k) dst[n][k] = *(const PG8_LAS bf16x8*)(lds + PG8_SB(b, h) + boff + n * 2048 + k * 1024); } while (0)
#define PG8_MMA(ai, bj, At, Bt) do { __builtin_amdgcn_s_setprio(1); _Pragma("unroll") for (int m = 0; m < 4; ++m) _Pragma("unroll") for (int n = 0; n < 2; ++n) _Pragma("unroll") for (int k = 0; k < 2; ++k) \
        acc[ai][bj][m][n] = __builtin_amdgcn_mfma_f32_16x16x32_bf16(Bt[n][k], At[m][k], acc[ai][bj][m][n], 0, 0, 0); __builtin_amdgcn_s_setprio(0); } while (0)
#define PG8_WAIT_V(n) asm volatile("s_waitcnt vmcnt(" #n ")" ::: "memory")
#define PG8_WAIT_L(n) asm volatile("s_waitcnt lgkmcnt(" #n ")" ::: "memory")
#define PG8_BAR __builtin_amdgcn_s_barrier()
#define PG8_SCHED __builtin_amdgcn_sched_barrier(0)
    Unit cur, nxt; int ui = 0;
    if (!S.next(0, cur)) return;
    f32x4 acc[2][2][4][2];
#pragma unroll
    for (int a = 0; a < 2; ++a)
#pragma unroll
        for (int b = 0; b < 2; ++b)
#pragma unroll
            for (int m = 0; m < 4; ++m)
#pragma unroll
                for (int n = 0; n < 2; ++n) acc[a][b][m][n] = (f32x4){0.f, 0.f, 0.f, 0.f};
    bf16x8 At[4][2], B0[2][2], B1[2][2];
    const char* cA = (const char*)g.A + a_off(cur.pm); const char* cB = (const char*)g.Bt + (size_t)cur.pn * tstep;
    S.a_ready(cur);
    if constexpr (SP2) {
        PG8_STAGE(PG8_SB(0, 0), cB, voffB); PG8_STAGE(PG8_SB(0, 1), cB + hstep, voffB); PG8_STAGE(PG8_SA(0, 0), cA, voffA); PG8_STAGE(PG8_SA(0, 1), cA + hstep, voffA);
        if (wr == 1) PG8_BAR;
        PG8_WAIT_V(2); PG8_BAR;
        PG8_STAGE(PG8_SB(1, 0), cB + kstep, voffB); PG8_STAGE(PG8_SA(1, 0), cA + kstep, voffA); PG8_STAGE(PG8_SB(1, 1), cB + hstep + kstep, voffB);
        PG8_WAIT_V(6); PG8_BAR;
    } else {
        PG8_STAGE(PG8_SB(0, 0), cB, voffB); PG8_STAGE(PG8_SA(0, 0), cA, voffA); PG8_STAGE(PG8_SB(0, 1), cB + hstep, voffB); PG8_STAGE(PG8_SA(0, 1), cA + hstep, voffA);
        if (wr == 1) PG8_BAR;
        PG8_WAIT_V(4); PG8_BAR;
        PG8_STAGE(PG8_SB(1, 0), cB + kstep, voffB); PG8_STAGE(PG8_SA(1, 0), cA + kstep, voffA); PG8_STAGE(PG8_SB(1, 1), cB + hstep + kstep, voffB);
        PG8_WAIT_V(6); PG8_BAR;
    }
    for (;;) {
        const bool has_next = S.next(ui + 1, nxt);
        const char* nA = has_next ? (const char*)g.A + a_off(nxt.pm) : cA; const char* nB = has_next ? (const char*)g.Bt + (size_t)nxt.pn * tstep : cB;
        for (int t = 0; t < nt; t += 2) {
            const bool last = (t == nt - 2);
            const char* a1 = cA + (size_t)(t + 1) * kstep;
            const char* a2 = last ? nA : cA + (size_t)(t + 2) * kstep; const char* b2 = last ? nB : cB + (size_t)(t + 2) * kstep;
            const char* a3 = a2 + kstep; const char* b3 = b2 + kstep;
            if (last && has_next) S.a_ready(nxt);
            if constexpr (SP2) {
            PG8_LDB(B0, 0, 0); PG8_LDB(B1, 0, 1); PG8_SCHED; PG8_LDA(At, 0, 0); PG8_STAGE(PG8_SA(1, 1), a1 + hstep, voffA);
            PG8_WAIT_V(8); PG8_WAIT_L(0); PG8_BAR; PG8_MMA(0, 0, At, B0); PG8_MMA(0, 1, At, B1); PG8_BAR; PG8_SCHED;
            PG8_LDA(At, 0, 1); PG8_STAGE(PG8_SB(0, 0), b2, voffB); PG8_STAGE(PG8_SB(0, 1), b2 + hstep, voffB); PG8_STAGE(PG8_SA(0, 0), a2, voffA);
            PG8_WAIT_V(8); PG8_WAIT_L(0); PG8_BAR; PG8_MMA(1, 0, At, B0); PG8_MMA(1, 1, At, B1); PG8_BAR; PG8_SCHED;
            PG8_LDB(B0, 1, 0); PG8_LDB(B1, 1, 1); PG8_SCHED; PG8_LDA(At, 1, 0); PG8_STAGE(PG8_SA(0, 1), a2 + hstep, voffA);
            PG8_WAIT_V(8); PG8_WAIT_L(0); PG8_BAR; PG8_MMA(0, 0, At, B0); PG8_MMA(0, 1, At, B1); PG8_BAR; PG8_SCHED;
            PG8_LDA(At, 1, 1); PG8_STAGE(PG8_SB(1, 0), b3, voffB); PG8_STAGE(PG8_SB(1, 1), b3 + hstep, voffB); PG8_STAGE(PG8_SA(1, 0), a3, voffA);
            PG8_WAIT_V(8); PG8_WAIT_L(0); PG8_BAR; PG8_MMA(1, 0, At, B0); PG8_MMA(1, 1, At, B1); PG8_BAR; PG8_SCHED;
            } else {
            PG8_LDB(B0, 0, 0); PG8_SCHED; PG8_LDA(At, 0, 0); PG8_STAGE(PG8_SA(1, 1), a1 + hstep, voffA);
            PG8_WAIT_L(8); PG8_BAR; PG8_WAIT_L(0); PG8_MMA(0, 0, At, B0); PG8_BAR; PG8_SCHED;
            PG8_LDB(B1, 0, 1); PG8_STAGE(PG8_SB(0, 0), b2, voffB);
            PG8_BAR; PG8_WAIT_L(0); PG8_MMA(0, 1, At, B1); PG8_BAR;
            PG8_LDA(At, 0, 1); PG8_STAGE(PG8_SA(0, 0), a2, voffA);
            PG8_BAR; PG8_WAIT_L(0); PG8_MMA(1, 0, At, B0); PG8_BAR; PG8_SCHED;
            PG8_STAGE(PG8_SB(0, 1), b2 + hstep, voffB);
            PG8_WAIT_V(6); PG8_BAR; PG8_MMA(1, 1, At, B1); PG8_BAR;
            PG8_LDB(B0, 1, 0); PG8_SCHED; PG8_LDA(At, 1, 0); PG8_STAGE(PG8_SA(0, 1), a2 + hstep, voffA);
            PG8_WAIT_L(8); PG8_BAR; PG8_WAIT_L(0); PG8_MMA(0, 0, At, B0); PG8_BAR; PG8_SCHED;
            PG8_LDB(B1, 1, 1); PG8_STAGE(PG8_SB(1, 0), b3, voffB);
            PG8_BAR; PG8_WAIT_L(0); PG8_MMA(0, 1, At, B1); PG8_BAR;
            PG8_LDA(At, 1, 1); PG8_STAGE(PG8_SA(1, 0), a3, voffA);
            PG8_BAR; PG8_WAIT_L(0); PG8_MMA(1, 0, At, B0); PG8_BAR; PG8_SCHED;
            PG8_STAGE(PG8_SB(1, 1), b3 + hstep, voffB);
            PG8_WAIT_V(6); PG8_BAR; PG8_MMA(1, 1, At, B1); PG8_BAR;
            }
        }
        if constexpr (ALIGN_EPI) { if (wr == 0) PG8_BAR; }
        if constexpr (!Epi::AFTER_DRAIN) { E(acc, cur, wr, wc, fr, fq); S.done(cur); }
        if (!has_next) break;
#pragma unroll
        for (int a = 0; a < 2; ++a)
#pragma unroll
            for (int b = 0; b < 2; ++b)
#pragma unroll
                for (int m = 0; m < 4; ++m)
#pragma unroll
                    for (int n = 0; n < 2; ++n) acc[a][b][m][n] = (f32x4){0.f, 0.f, 0.f, 0.f};
        cur = nxt; cA = nA; cB = nB; ++ui;
        if constexpr (ALIGN_EPI) { if (wr == 1) PG8_BAR; }
    }
    PG8_WAIT_V(0);
    if constexpr (!ALIGN_EPI) { if (wr == 0) PG8_BAR; }
    PG8_BAR;
    if constexpr (Epi::AFTER_DRAIN) { E.fused(acc, cur, wr, wc, fr, fq, lds, wid, lane); S.done(cur); }
#undef PG8_SA
#undef PG8_SB
#undef PG8_STAGE
#undef PG8_LDA
#undef PG8_LDB
#undef PG8_MMA
#undef PG8_WAIT_V
#undef PG8_WAIT_L
#undef PG8_BAR
#undef PG8_SCHED
}
}

#define LAS __attribute__((address_space(3)))
typedef unsigned short bf16;
typedef unsigned u32x4 __attribute__((ext_vector_type(4)));
typedef unsigned u32x2 __attribute__((ext_vector_type(2)));
typedef float f32x4 __attribute__((ext_vector_type(4)));
typedef short bf16x8 __attribute__((ext_vector_type(8)));
constexpr int D = 1024, SEQ = 8192, NB = 2, NMETA = 16, TT = SEQ + NMETA, M = NB * SEQ, DEPTH = 4, DIN = 1536, FF = 4096, DH = 512;
constexpr float EPS = 1e-6f;
constexpr size_t MiB = 1u << 20;
constexpr size_t WS_POOLW = 1 * MiB, WS_GR = WS_POOLW + 512 * 1024, WS_GI = WS_GR + 256 * 1024;
constexpr size_t WS_SP = 2 * MiB, WS_HMETA = WS_SP + 64 * 1024, WS_MIDMETA = WS_HMETA + 64 * 1024;
constexpr size_t WS_SS = 3 * MiB, WS_CARA = 4 * MiB, WS_CARH = WS_CARA + 512 * 1024;
constexpr size_t WS_W = 8 * MiB, W_LAYER = 21 * MiB, W_IN = 0, W_OUT = 3 * MiB, W_UP = 5 * MiB, W_DOWN = 13 * MiB;
constexpr size_t WS_HB = 92 * MiB, WS_MID = 124 * MiB;
constexpr size_t WS_PROJ = WS_MID, WS_Y = WS_MID + 48 * MiB + 256 * 1024, WS_HL = WS_Y + 32 * MiB + 256 * 1024, WS_P = WS_HL + 32 * MiB + 256 * 1024, WS_END = 256 * MiB;
static_assert(WS_PROJ + (size_t)NB * TT * DIN * 2 <= WS_Y && WS_Y + (size_t)NB * TT * D * 2 <= WS_HL && WS_HL + (size_t)NB * TT * DH * 4 <= WS_P && WS_P + (size_t)NB * TT * DH * 2 <= WS_END, "ws map");
static_assert(WS_W + DEPTH * W_LAYER <= WS_HB && WS_HB + (size_t)M * D * 2 <= WS_MID && WS_MID + (size_t)M * FF * 2 <= WS_END, "ws map 2");
constexpr int LDS_BYTES = 131072 + 16384;

struct Params {
    const float* in[20];
    float* out;
    unsigned char* ws;
};

__device__ __forceinline__ unsigned cvt_pk(float lo, float hi) { return pg8::cvt_pk_bf16(lo, hi); }
__device__ __forceinline__ float bf_lo(unsigned w) { return __builtin_bit_cast(float, w << 16); }
__device__ __forceinline__ float bf_hi(unsigned w) { return __builtin_bit_cast(float, w & 0xffff0000u); }
__device__ __forceinline__ void unpack8(const u32x4 w, float (&f)[8]) {
    f[0] = bf_lo(w.x); f[1] = bf_hi(w.x); f[2] = bf_lo(w.y); f[3] = bf_hi(w.y); f[4] = bf_lo(w.z); f[5] = bf_hi(w.z); f[6] = bf_lo(w.w); f[7] = bf_hi(w.w);
}
__device__ __forceinline__ u32x4 pack8(const float (&f)[8]) { u32x4 w; w.x = cvt_pk(f[0], f[1]); w.y = cvt_pk(f[2], f[3]); w.z = cvt_pk(f[4], f[5]); w.w = cvt_pk(f[6], f[7]); return w; }
__device__ __forceinline__ float wave_sum(float v) {
#pragma unroll
    for (int o = 1; o < 64; o <<= 1) v += __shfl_xor(v, o);
    return v;
}
template <int CTRL> __device__ __forceinline__ float dppf(float old, float src) {
    return __builtin_bit_cast(float, __builtin_amdgcn_update_dpp(__builtin_bit_cast(int, old), __builtin_bit_cast(int, src), CTRL, 0xf, 0xf, false));
}
template <int DD> __device__ __forceinline__ float shiftd(float cur, float prev) {
    const float t = dppf<0x100 + (16 - DD)>(0.f, prev);
    return dppf<0x110 + DD>(t, cur);
}
__device__ __forceinline__ float sigm(float v) { return __builtin_amdgcn_rcpf(1.0f + __expf(-v)); }
__device__ __forceinline__ int outchan(int n, int rho) { return 32 * (n >> 1) + 8 * (rho >> 2) + 4 * (n & 1) + (rho & 3); }

__device__ __forceinline__ float row_rstd(const float* ss, int r) {
    const f32x4* s4 = (const f32x4*)(ss + (size_t)r * 16);
    const f32x4 a = s4[0], b = s4[1], c = s4[2], d = s4[3];
    const float s = ((a.x + a.y) + (a.z + a.w)) + ((b.x + b.y) + (b.z + b.w)) + ((c.x + c.y) + (c.z + c.w)) + ((d.x + d.y) + (d.z + d.w));
    return 1.0f / sqrtf(s * (1.0f / D) + EPS);
}
__device__ __forceinline__ void rows_rstd(const float* ss, int rowbase  , int fr, float (&rs)[2][4]) {
    const int lane = threadIdx.x & 63;
    const float r0 = row_rstd(ss, rowbase + lane), r1 = row_rstd(ss, rowbase + 128 + lane);
#pragma unroll
    for (int m = 0; m < 4; ++m) { rs[0][m] = __shfl(r0, m * 16 + fr); rs[1][m] = __shfl(r1, m * 16 + fr); }
}
struct EpiIn {
    static constexpr bool PERM = true, AFTER_DRAIN = false;
    bf16* P; const float* ss;
    __device__ __forceinline__ void operator()(const f32x4 (&acc)[2][2][4][2], const pg8::Unit& u, int wr, int wc, int fr, int fq) const {
        const int row0 = u.pm * 256 + wr * 64 + fr, col0 = u.pn * 256 + wc * 32 + 8 * fq;
        float rsv[2][4]; rows_rstd(ss, u.pm * 256 + wr * 64, fr, rsv);
#pragma unroll
        for (int ai = 0; ai < 2; ++ai)
#pragma unroll
            for (int m = 0; m < 4; ++m) {
                const int r = row0 + ai * 128 + m * 16; const float rs = rsv[ai][m];
                bf16* rowp = P + (size_t)(r + NMETA * (1 + (r >> 13))) * DIN + col0;
#pragma unroll
                for (int bj = 0; bj < 2; ++bj) { const f32x4 v0 = acc[ai][bj][m][0] * rs, v1 = acc[ai][bj][m][1] * rs;
                    u32x4 w; w.x = cvt_pk(v0[0], v0[1]); w.y = cvt_pk(v0[2], v0[3]); w.z = cvt_pk(v1[0], v1[1]); w.w = cvt_pk(v1[2], v1[3]);
                    *(u32x4*)(rowp + bj * 128) = w; }
            }
    }
};
struct EpiUp {
    static constexpr bool PERM = true, AFTER_DRAIN = false;
    bf16* O; const float* ss;
    __device__ __forceinline__ void operator()(const f32x4 (&acc)[2][2][4][2], const pg8::Unit& u, int wr, int wc, int fr, int fq) const {
        const int row0 = u.pm * 256 + wr * 64 + fr, col0 = u.pn * 256 + wc * 32 + 8 * fq;
        float rsv[2][4]; rows_rstd(ss, u.pm * 256 + wr * 64, fr, rsv);
#pragma unroll
        for (int ai = 0; ai < 2; ++ai)
#pragma unroll
            for (int m = 0; m < 4; ++m) {
                const int r = row0 + ai * 128 + m * 16; const float rs = rsv[ai][m];
                bf16* rowp = O + (size_t)r * FF + col0;
#pragma unroll
                for (int bj = 0; bj < 2; ++bj) { f32x4 v0 = acc[ai][bj][m][0] * rs, v1 = acc[ai][bj][m][1] * rs;
#pragma unroll
                    for (int j = 0; j < 4; ++j) { v0[j] = fmaxf(v0[j], 0.f); v0[j] *= v0[j]; v1[j] = fmaxf(v1[j], 0.f); v1[j] *= v1[j]; }
                    u32x4 w; w.x = cvt_pk(v0[0], v0[1]); w.y = cvt_pk(v0[2], v0[3]); w.z = cvt_pk(v1[0], v1[1]); w.w = cvt_pk(v1[2], v1[3]);
                    *(u32x4*)(rowp + bj * 128) = w; }
            }
    }
};
struct EpiRes {
    static constexpr bool PERM = true, AFTER_DRAIN = false;
    const float* base; float* out; bf16* hb; float* ssn;
    __device__ __forceinline__ void operator()(const f32x4 (&acc)[2][2][4][2], const pg8::Unit& u, int wr, int wc, int fr, int fq) const {
        const int row0 = u.pm * 256 + wr * 64 + fr, col0 = u.pn * 256 + wc * 32 + 8 * fq;
#pragma unroll
        for (int ai = 0; ai < 2; ++ai)
#pragma unroll
            for (int m = 0; m < 4; ++m) {
                const int r = row0 + ai * 128 + m * 16; const size_t off = (size_t)r * D + col0; float s = 0.f;
#pragma unroll
                for (int bj = 0; bj < 2; ++bj) {
                    const f32x4 b0 = *(const f32x4*)(base + off + bj * 128), b1 = *(const f32x4*)(base + off + bj * 128 + 4);
                    const f32x4 o0 = b0 + acc[ai][bj][m][0], o1 = b1 + acc[ai][bj][m][1];
                    *(f32x4*)(out + off + bj * 128) = o0; *(f32x4*)(out + off + bj * 128 + 4) = o1;
                    s += (o0[0] * o0[0] + o0[1] * o0[1]) + (o0[2] * o0[2] + o0[3] * o0[3]) + (o1[0] * o1[0] + o1[1] * o1[1]) + (o1[2] * o1[2] + o1[3] * o1[3]);
                    u32x4 w; w.x = cvt_pk(o0[0], o0[1]); w.y = cvt_pk(o0[2], o0[3]); w.z = cvt_pk(o1[0], o1[1]); w.w = cvt_pk(o1[2], o1[3]);
                    *(u32x4*)(hb + off + bj * 128) = w; }
                s += __shfl_xor(s, 16); s += __shfl_xor(s, 32);
                if (fq == 0) ssn[(size_t)r * 16 + u.pn * 4 + wc] = s;
                if (m & 1) asm volatile("" ::: "memory");
            }
    }
};

__device__ __forceinline__ void transpose_item(const float* W, const float* gk, int K, int N, bf16* WT, LAS float* scr, int item, int lane) {
    const int nblk = N / 32, kb = item / nblk, nb = item % nblk, k0 = 64 * kb, n0 = 32 * nb;
#pragma unroll 8
    for (int i = 0; i < 32; ++i) { const int kk = 2 * i + (lane >> 5); float v = W[(size_t)(k0 + kk) * N + n0 + (lane & 31)]; if (gk) v *= gk[k0 + kk]; scr[kk * 33 + (lane & 31)] = v; }
    asm volatile("s_waitcnt lgkmcnt(0)" ::: "memory");
    const int c = lane & 7;
#pragma unroll
    for (int j = 0; j < 4; ++j) { const int n = (lane >> 3) + 8 * j; const LAS float* s = scr + (8 * c) * 33 + n;
        u32x4 o; o.x = cvt_pk(s[0 * 33], s[1 * 33]); o.y = cvt_pk(s[2 * 33], s[3 * 33]); o.z = cvt_pk(s[4 * 33], s[5 * 33]); o.w = cvt_pk(s[6 * 33], s[7 * 33]);
        *(u32x4*)(WT + (size_t)(n0 + n) * K + k0 + 8 * c) = o; }
    asm volatile("s_waitcnt lgkmcnt(0)" ::: "memory");
}
__device__ __forceinline__ void prologue(const Params& p, LAS unsigned char* lds, int G) {
    int tid_ = threadIdx.x; asm volatile("" : "+v"(tid_));
    const int tid = tid_, lane = tid & 63, wid = __builtin_amdgcn_readfirstlane(tid >> 6);
    LAS float* scr = (LAS float*)(lds + wid * 16384);
    const int gw = blockIdx.x * 8 + wid, NGW = G * 8;
    constexpr int I_IN = 16 * 48, I_OUT = 16 * 32, I_UP = 16 * 128, I_DN = 64 * 32, I_PW = 4 * 8, I_G = 8 * 2, I_L = I_IN + I_OUT + I_UP + I_DN + I_PW + 2 * I_G;
    unsigned char* ws = p.ws;
    for (int it = gw; it < DEPTH * I_L; it += NGW) {
        const int l = it / I_L; int r = it % I_L;
        unsigned char* wl = ws + WS_W + (size_t)l * W_LAYER;
        if (r < I_IN) { transpose_item(p.in[3] + (size_t)l * D * DIN, p.in[2] + l * D, D, DIN, (bf16*)(wl + W_IN), scr, r, lane); continue; } r -= I_IN;
        if (r < I_OUT) { transpose_item(p.in[15] + (size_t)l * D * D, p.in[14] + l * D, D, D, (bf16*)(wl + W_OUT), scr, r, lane); continue; } r -= I_OUT;
        if (r < I_UP) { transpose_item(p.in[17] + (size_t)l * D * FF, p.in[16] + l * D, D, FF, (bf16*)(wl + W_UP), scr, r, lane); continue; } r -= I_UP;
        if (r < I_DN) { transpose_item(p.in[18] + (size_t)l * FF * D, nullptr, FF, D, (bf16*)(wl + W_DOWN), scr, r, lane); continue; } r -= I_DN;
        if (r < I_PW) { const int g = r / 8; transpose_item(p.in[4] + (size_t)(l * 4 + g) * 16384, nullptr, 128, 128, (bf16*)(ws + WS_POOLW) + (size_t)(l * 4 + g) * 16384, scr, r % 8, lane); continue; } r -= I_PW;
        if (r < I_G) { const int h = r / 2; transpose_item(p.in[9] + (size_t)(l * 8 + h) * 4096, nullptr, 64, 64, (bf16*)(ws + WS_GR) + (size_t)(l * 8 + h) * 4096, scr, r % 2, lane); continue; } r -= I_G;
        { const int h = r / 2; transpose_item(p.in[11] + (size_t)(l * 8 + h) * 4096, nullptr, 64, 64, (bf16*)(ws + WS_GI) + (size_t)(l * 8 + h) * 4096, scr, r % 2, lane); }
    }
    const float* x = p.in[0]; bf16* hb = (bf16*)(ws + WS_HB); float* ss = (float*)(ws + WS_SS);
    for (int m = gw; m < M; m += NGW) {
        const f32x4* xr = (const f32x4*)(x + (size_t)m * D) + lane; f32x4 v[4]; float s = 0.f;
#pragma unroll
        for (int j = 0; j < 4; ++j) { v[j] = xr[64 * j]; s += (v[j].x * v[j].x + v[j].y * v[j].y) + (v[j].z * v[j].z + v[j].w * v[j].w); }
        s = wave_sum(s);
        u32x2* o8 = (u32x2*)(hb + (size_t)m * D) + lane;
#pragma unroll
        for (int j = 0; j < 4; ++j) { u32x2 w; w.x = cvt_pk(v[j].x, v[j].y); w.y = cvt_pk(v[j].z, v[j].w); o8[64 * j] = w; }
        if (lane < 16) ss[(size_t)m * 16 + lane] = lane == 0 ? s : 0.f;
    }
    float* hm = (float*)(ws + WS_HMETA); float* sp = (float*)(ws + WS_SP);
    for (int i = blockIdx.x * 512 + tid; i < NMETA * D; i += G * 512) hm[i] = p.in[1][i];
    for (int i = blockIdx.x * 512 + tid; i < DEPTH * DH; i += G * 512) sp[i] = log1pf(expf(-p.in[13][i]));
}

template <int MODE> __device__ __forceinline__ void meta_tasks(const Params& p, LAS unsigned char* lds, int G, const bf16* Ab, int lda, const bf16* Bt, int K, int ntasks) {
    int tid_ = threadIdx.x; asm volatile("" : "+v"(tid_));
    const int tid = tid_, lane = tid & 63, wid = __builtin_amdgcn_readfirstlane(tid >> 6), fr = lane & 15, fq = lane >> 4;
    float* hm = (float*)(p.ws + WS_HMETA);
    LAS float* red = (LAS float*)lds;
    for (int task = G - 1 - (int)blockIdx.x; task < ntasks; task += G) {
        const int n0 = task * 16, kw = K / 8, k0 = wid * kw;
        f32x4 acc = {0.f, 0.f, 0.f, 0.f}; float ssq = 0.f;
        for (int kk = k0; kk < k0 + kw; kk += 32) {
            bf16x8 af;
            if (MODE == 1) af = *(const bf16x8*)(Ab + (size_t)fr * lda + kk + 8 * fq);
            else { const f32x4 a0 = *(const f32x4*)(hm + fr * D + kk + 8 * fq), a1 = *(const f32x4*)(hm + fr * D + kk + 8 * fq + 4);
                ssq += (a0.x * a0.x + a0.y * a0.y) + (a0.z * a0.z + a0.w * a0.w) + (a1.x * a1.x + a1.y * a1.y) + (a1.z * a1.z + a1.w * a1.w);
                u32x4 w; w.x = cvt_pk(a0.x, a0.y); w.y = cvt_pk(a0.z, a0.w); w.z = cvt_pk(a1.x, a1.y); w.w = cvt_pk(a1.z, a1.w); af = __builtin_bit_cast(bf16x8, w); }
            const bf16x8 bfr = *(const bf16x8*)(Bt + (size_t)(n0 + fr) * K + kk + 8 * fq);
            acc = __builtin_amdgcn_mfma_f32_16x16x32_bf16(bfr, af, acc, 0, 0, 0);
        }
        ssq += __shfl_xor(ssq, 16); ssq += __shfl_xor(ssq, 32);
        LAS float* rp = red + (wid * 64 + lane) * 5;
        rp[0] = acc[0]; rp[1] = acc[1]; rp[2] = acc[2]; rp[3] = acc[3]; rp[4] = ssq;
        __syncthreads();
        if (wid == 0) {
            float a0 = 0.f, a1 = 0.f, a2 = 0.f, a3 = 0.f, sq = 0.f;
#pragma unroll
            for (int w = 0; w < 8; ++w) { const LAS float* q = red + (w * 64 + lane) * 5; a0 += q[0]; a1 += q[1]; a2 += q[2]; a3 += q[3]; sq += q[4]; }
            const int col = n0 + 4 * fq;
            if (MODE == 1) { f32x4* hp = (f32x4*)(hm + fr * D + col); f32x4 h = *hp; h.x += a0; h.y += a1; h.z += a2; h.w += a3; *hp = h; }
            else {
                const float rs = 1.0f / sqrtf(sq * (1.0f / D) + EPS); a0 *= rs; a1 *= rs; a2 *= rs; a3 *= rs;
                if (MODE == 0) { u32x2 w; w.x = cvt_pk(a0, a1); w.y = cvt_pk(a2, a3); bf16* pr = (bf16*)(p.ws + WS_PROJ);
                    *(u32x2*)(pr + (size_t)fr * DIN + col) = w; *(u32x2*)(pr + (size_t)(TT + fr) * DIN + col) = w; }
                else { a0 = fmaxf(a0, 0.f); a1 = fmaxf(a1, 0.f); a2 = fmaxf(a2, 0.f); a3 = fmaxf(a3, 0.f);
                    u32x2 w; w.x = cvt_pk(a0 * a0, a1 * a1); w.y = cvt_pk(a2 * a2, a3 * a3); *(u32x2*)((bf16*)(p.ws + WS_MIDMETA) + (size_t)fr * FF + col) = w; }
            }
        }
        __syncthreads();
    }
}

__device__ __forceinline__ void m1_phase(const Params& p, LAS unsigned char* lds, int G, int l) {
    int tid_ = threadIdx.x; asm volatile("" : "+v"(tid_));
    const int tid = tid_, lane = tid & 63, wid = __builtin_amdgcn_readfirstlane(tid >> 6), fr = lane & 15, fq = lane >> 4;
    LAS float* cst = (LAS float*)lds;
    for (int i = tid; i < 8 * DH; i += 512) { const int row = i >> 9, ch = i & 511; float v;
        if (row < 4) v = p.in[7][(l * 4 + row) * DH + ch]; else if (row == 4) v = p.in[8][l * DH + ch]; else if (row == 5) v = p.in[10][l * DH + ch];
        else if (row == 6) v = p.in[12][l * DH + ch]; else v = ((const float*)(p.ws + WS_SP))[l * DH + ch];
        cst[i] = v; }
    __syncthreads();
    const bf16* proj = (const bf16*)(p.ws + WS_PROJ);
    const bf16* Wr = (const bf16*)(p.ws + WS_GR) + (size_t)(l * 8 + wid) * 4096; const bf16* Wi = (const bf16*)(p.ws + WS_GI) + (size_t)(l * 8 + wid) * 4096;
    float* hl = (float*)(p.ws + WS_HL); bf16* Pp = (bf16*)(p.ws + WS_P);
    float* carA = (float*)(p.ws + WS_CARA); float* carH = (float*)(p.ws + WS_CARH);
    for (int unit = blockIdx.x; unit < 256; unit += G) {
        const int b = unit >> 7, c = unit & 127, t0 = c ? NMETA + 64 * c : 0, NM = c ? 4 : 5;
        float Hc[16], Pc[16];
#pragma unroll
        for (int k = 0; k < 16; ++k) { Hc[k] = 0.f; Pc[k] = 1.f; }
#pragma unroll 1
        for (int m = 0; m < NM; ++m) {
            const int t = t0 + 16 * m + fr; const size_t rowg = (size_t)b * TT + t;
            float xc[2][8]; bf16x8 frag[2];
#pragma unroll
            for (int ks = 0; ks < 2; ++ks) {
                const int chb = wid * 64 + 32 * ks + 8 * fq;
                { const f32x4 c0 = *(const LAS f32x4*)(cst + 4 * DH + chb), c1 = *(const LAS f32x4*)(cst + 4 * DH + chb + 4);
                  xc[ks][0] = c0.x; xc[ks][1] = c0.y; xc[ks][2] = c0.z; xc[ks][3] = c0.w; xc[ks][4] = c1.x; xc[ks][5] = c1.y; xc[ks][6] = c1.z; xc[ks][7] = c1.w; }
#pragma unroll
                for (int d = 0; d < 4; ++d) {
                    const int tt = t - 3 + d;
                    u32x4 raw = {0u, 0u, 0u, 0u};
                    if (tt >= 0) raw = *(const u32x4*)(proj + ((size_t)b * TT + tt) * DIN + DH + chb);
                    float u[8]; unpack8(raw, u);
                    const f32x4 w0 = *(const LAS f32x4*)(cst + d * DH + chb), w1 = *(const LAS f32x4*)(cst + d * DH + chb + 4);
                    xc[ks][0] += u[0] * w0.x; xc[ks][1] += u[1] * w0.y; xc[ks][2] += u[2] * w0.z; xc[ks][3] += u[3] * w0.w;
                    xc[ks][4] += u[4] * w1.x; xc[ks][5] += u[5] * w1.y; xc[ks][6] += u[6] * w1.z; xc[ks][7] += u[7] * w1.w;
                }
                frag[ks] = __builtin_bit_cast(bf16x8, pack8(xc[ks]));
            }
            f32x4 ar[4], ai[4];
#pragma unroll
            for (int n = 0; n < 4; ++n) { ar[n] = (f32x4){0.f, 0.f, 0.f, 0.f}; ai[n] = (f32x4){0.f, 0.f, 0.f, 0.f};
#pragma unroll
                for (int ks = 0; ks < 2; ++ks) {
                    const bf16x8 wr_ = *(const bf16x8*)(Wr + outchan(n, fr) * 64 + 32 * ks + 8 * fq), wi_ = *(const bf16x8*)(Wi + outchan(n, fr) * 64 + 32 * ks + 8 * fq);
                    ar[n] = __builtin_amdgcn_mfma_f32_16x16x32_bf16(wr_, frag[ks], ar[n], 0, 0, 0);
                    ai[n] = __builtin_amdgcn_mfma_f32_16x16x32_bf16(wi_, frag[ks], ai[n], 0, 0, 0);
                } }
            float Aa[16], Bb[16];
#pragma unroll
            for (int n = 0; n < 4; ++n) {
                const int cho = wid * 64 + 32 * (n >> 1) + 8 * fq + 4 * (n & 1);
                const f32x4 rb = *(const LAS f32x4*)(cst + 5 * DH + cho), ib = *(const LAS f32x4*)(cst + 6 * DH + cho), spv = *(const LAS f32x4*)(cst + 7 * DH + cho);
#pragma unroll
                for (int jj = 0; jj < 4; ++jj) {
                    const float r = sigm(ar[n][jj] + rb[jj]), ig = sigm(ai[n][jj] + ib[jj]);
                    const float la = -8.0f * r * spv[jj], a = __expf(la), x2 = 2.0f * la;
                    const float m2s = -x2 * (1.0f + x2 * (0.5f + x2 * (0.16666667f + x2 * 0.041666668f))), m2 = (x2 > -0.0625f) ? m2s : 1.0f - a * a;
                    Aa[n * 4 + jj] = a; Bb[n * 4 + jj] = sqrtf(m2) * ig * xc[n >> 1][4 * (n & 1) + jj];
                }
            }
#pragma unroll
            for (int k = 0; k < 16; ++k) {
                float A = Aa[k], B = Bb[k], Ap, Bq;
                Ap = dppf<0x111>(1.f, A); Bq = dppf<0x111>(0.f, B); B = fmaf(A, Bq, B); A *= Ap;
                Ap = dppf<0x112>(1.f, A); Bq = dppf<0x112>(0.f, B); B = fmaf(A, Bq, B); A *= Ap;
                Ap = dppf<0x114>(1.f, A); Bq = dppf<0x114>(0.f, B); B = fmaf(A, Bq, B); A *= Ap;
                Ap = dppf<0x118>(1.f, A); Bq = dppf<0x118>(0.f, B); B = fmaf(A, Bq, B); A *= Ap;
                Bb[k] = fmaf(A, Hc[k], B); Aa[k] = A * Pc[k];
            }
#pragma unroll
            for (int ks = 0; ks < 2; ++ks) {
                const size_t o = rowg * DH + wid * 64 + 32 * ks + 8 * fq;
                *(f32x4*)(hl + o) = (f32x4){Bb[8 * ks + 0], Bb[8 * ks + 1], Bb[8 * ks + 2], Bb[8 * ks + 3]};
                *(f32x4*)(hl + o + 4) = (f32x4){Bb[8 * ks + 4], Bb[8 * ks + 5], Bb[8 * ks + 6], Bb[8 * ks + 7]};
                u32x4 w; w.x = cvt_pk(Aa[8 * ks + 0], Aa[8 * ks + 1]); w.y = cvt_pk(Aa[8 * ks + 2], Aa[8 * ks + 3]); w.z = cvt_pk(Aa[8 * ks + 4], Aa[8 * ks + 5]); w.w = cvt_pk(Aa[8 * ks + 6], Aa[8 * ks + 7]);
                *(u32x4*)(Pp + o) = w;
            }
            const int src = (lane & 48) | 15;
#pragma unroll
            for (int k = 0; k < 16; ++k) { Hc[k] = __shfl(Bb[k], src); Pc[k] = __shfl(Aa[k], src); }
        }
        if (fr == 0) {
#pragma unroll
            for (int ks = 0; ks < 2; ++ks) {
                const size_t o = (size_t)(b * 128 + c) * DH + wid * 64 + 32 * ks + 8 * fq;
                *(f32x4*)(carA + o) = (f32x4){Pc[8 * ks + 0], Pc[8 * ks + 1], Pc[8 * ks + 2], Pc[8 * ks + 3]}; *(f32x4*)(carA + o + 4) = (f32x4){Pc[8 * ks + 4], Pc[8 * ks + 5], Pc[8 * ks + 6], Pc[8 * ks + 7]};
                *(f32x4*)(carH + o) = (f32x4){Hc[8 * ks + 0], Hc[8 * ks + 1], Hc[8 * ks + 2], Hc[8 * ks + 3]}; *(f32x4*)(carH + o + 4) = (f32x4){Hc[8 * ks + 4], Hc[8 * ks + 5], Hc[8 * ks + 6], Hc[8 * ks + 7]};
            }
        }
    }
    __syncthreads();
}

__device__ __forceinline__ void m2_phase(const Params& p, LAS unsigned char* lds, int G, int l) {
    int tid_ = threadIdx.x; asm volatile("" : "+v"(tid_));
    const int tid = tid_, lane = tid & 63, wid = __builtin_amdgcn_readfirstlane(tid >> 6), fr = lane & 15, fq = lane >> 4;
    LAS float* segA = (LAS float*)lds; LAS float* segH = (LAS float*)(lds + 8192); LAS float* carr = (LAS float*)(lds + 16384);
    LAS float* red1 = (LAS float*)(lds + 18432); LAS float* red2 = (LAS float*)(lds + 21504);
    const bf16* proj = (const bf16*)(p.ws + WS_PROJ); bf16* Y = (bf16*)(p.ws + WS_Y);
    const float* hl = (const float*)(p.ws + WS_HL); const bf16* Pp = (const bf16*)(p.ws + WS_P);
    const float* carA = (const float*)(p.ws + WS_CARA); const float* carH = (const float*)(p.ws + WS_CARH);
    const int g = wid >> 1, half = wid & 1, kwin = 2 << g;
    const bf16* Wp = (const bf16*)(p.ws + WS_POOLW) + (size_t)(l * 4 + g) * 16384;
    const float* pbias = p.in[5] + l * DH; const float* pscale = p.in[6] + l * DH;
    for (int unit = blockIdx.x; unit < 256; unit += G) {
        const int b = unit >> 7, c = unit & 127, t0 = c ? NMETA + 64 * c : 0, NM = c ? 4 : 5;
        {
            const int q = (c + 3) >> 2, seg = tid >> 7, cgi = tid & 127, jlo = seg * q, jhi = (jlo + q < c) ? jlo + q : c;
            f32x4 A = {1.f, 1.f, 1.f, 1.f}, H = {0.f, 0.f, 0.f, 0.f};
            for (int j = jlo; j < jhi; ++j) { const f32x4 a = *(const f32x4*)(carA + (size_t)(b * 128 + j) * DH + 4 * cgi), hh = *(const f32x4*)(carH + (size_t)(b * 128 + j) * DH + 4 * cgi); H = a * H + hh; A = A * a; }
            *(LAS f32x4*)(segA + seg * DH + 4 * cgi) = A; *(LAS f32x4*)(segH + seg * DH + 4 * cgi) = H;
        }
        __syncthreads();
        { float cy = 0.f;
#pragma unroll
          for (int s = 0; s < 4; ++s) cy = segA[s * DH + tid] * cy + segH[s * DH + tid];
          carr[tid] = cy; }
        __syncthreads();
        {
            float cr[16];
#pragma unroll
            for (int ks = 0; ks < 2; ++ks) { const f32x4 c0 = *(const LAS f32x4*)(carr + wid * 64 + 32 * ks + 8 * fq), c1 = *(const LAS f32x4*)(carr + wid * 64 + 32 * ks + 8 * fq + 4);
                cr[8 * ks + 0] = c0.x; cr[8 * ks + 1] = c0.y; cr[8 * ks + 2] = c0.z; cr[8 * ks + 3] = c0.w; cr[8 * ks + 4] = c1.x; cr[8 * ks + 5] = c1.y; cr[8 * ks + 6] = c1.z; cr[8 * ks + 7] = c1.w; }
#pragma unroll 1
            for (int pass = 0; pass < 2; ++pass) {
#pragma unroll 1
                for (int m = 0; m < NM; ++m) {
                    const int t = t0 + 16 * m + fr; const size_t rowg = (size_t)b * TT + t; float s = 0.f; float rs = 0.f;
                    if (pass) { const f32x4 r0 = *(const LAS f32x4*)(red1 + (16 * m + fr) * 8), r1 = *(const LAS f32x4*)(red1 + (16 * m + fr) * 8 + 4);
                        rs = 1.0f / sqrtf((((r0.x + r0.y) + (r0.z + r0.w)) + ((r1.x + r1.y) + (r1.z + r1.w))) * (1.0f / DH) + EPS); }
#pragma unroll
                    for (int ks = 0; ks < 2; ++ks) {
                        const int ch = wid * 64 + 32 * ks + 8 * fq; const size_t o = rowg * DH + ch;
                        const f32x4 h0 = *(const f32x4*)(hl + o), h1 = *(const f32x4*)(hl + o + 4);
                        const u32x4 pw = *(const u32x4*)(Pp + o), gw = *(const u32x4*)(proj + rowg * DIN + 2 * DH + ch);
                        float pf[8], gt[8], yy[8]; unpack8(pw, pf); unpack8(gw, gt);
                        const float hh[8] = {h0.x, h0.y, h0.z, h0.w, h1.x, h1.y, h1.z, h1.w};
#pragma unroll
                        for (int e = 0; e < 8; ++e) {
                            const float hv = fmaf(pf[e], cr[8 * ks + e], hh[e]), x = gt[e];
                            const float ge = x * __builtin_amdgcn_rcpf(1.0f + __expf(-1.5957691216f * (x + 0.044715f * x * x * x)));
                            const float y = hv * ge; yy[e] = y * rs; s = fmaf(y, y, s);
                        }
                        if (pass) *(u32x4*)(Y + rowg * D + DH + ch) = pack8(yy);
                    }
                    if (!pass) { s += __shfl_xor(s, 16); s += __shfl_xor(s, 32); if (fq == 0) red1[(16 * m + fr) * 8 + wid] = s; }
                }
                if (!pass) __syncthreads();
            }
        }
        {
            bf16x8 pfr[5][4];
#pragma unroll
            for (int ks = 0; ks < 4; ++ks) {
                const int chb = g * 128 + 32 * ks + 8 * fq;
                float pu[8], p2[8], p4[8], p8[8];
                if (c) { const u32x4 raw = *(const u32x4*)(proj + ((size_t)b * TT + t0 - 16 + fr) * DIN + chb); unpack8(raw, pu);
#pragma unroll
                    for (int e = 0; e < 8; ++e) { p2[e] = pu[e] + dppf<0x111>(0.f, pu[e]); p4[e] = p2[e] + dppf<0x112>(0.f, p2[e]); p8[e] = p4[e] + dppf<0x114>(0.f, p4[e]); } }
                else {
#pragma unroll
                    for (int e = 0; e < 8; ++e) { pu[e] = 0.f; p2[e] = 0.f; p4[e] = 0.f; p8[e] = 0.f; } }
#pragma unroll
                for (int m = 0; m < 5; ++m) if (m < NM) {
                    const int t = t0 + 16 * m + fr; const size_t rowg = (size_t)b * TT + t;
                    const u32x4 raw = *(const u32x4*)(proj + rowg * DIN + chb); float u[8], po[8]; unpack8(raw, u);
                    const int cnt = (t + 1 < kwin) ? t + 1 : kwin; const float rc = 1.0f / (float)cnt;
#pragma unroll
                    for (int e = 0; e < 8; ++e) {
                        const float s2 = u[e] + shiftd<1>(u[e], pu[e]), s4 = s2 + shiftd<2>(s2, p2[e]), s8 = s4 + shiftd<4>(s4, p4[e]), s16 = s8 + shiftd<8>(s8, p8[e]);
                        const float win = g == 0 ? s2 : (g == 1 ? s4 : (g == 2 ? s8 : s16));
                        po[e] = fmaf(win, rc, -u[e]); pu[e] = u[e]; p2[e] = s2; p4[e] = s4; p8[e] = s8;
                    }
                    pfr[m][ks] = __builtin_bit_cast(bf16x8, pack8(po));
                }
            }
#pragma unroll 1
            for (int pass = 0; pass < 2; ++pass) {
#pragma unroll
                for (int m = 0; m < 5; ++m) if (m < NM) {
                    const int t = t0 + 16 * m + fr; const size_t rowg = (size_t)b * TT + t; float s = 0.f, rs = 0.f;
                    if (pass) { const f32x4 r0 = *(const LAS f32x4*)(red2 + (16 * m + fr) * 8), r1 = *(const LAS f32x4*)(red2 + (16 * m + fr) * 8 + 4);
                        rs = 1.0f / sqrtf((((r0.x + r0.y) + (r0.z + r0.w)) + ((r1.x + r1.y) + (r1.z + r1.w))) * (1.0f / DH) + EPS); }
#pragma unroll
                    for (int np = 0; np < 2; ++np) {
                        f32x4 o2[2];
#pragma unroll
                        for (int nn = 0; nn < 2; ++nn) { const int n = 2 * np + nn;
                            f32x4 acc = {0.f, 0.f, 0.f, 0.f};
#pragma unroll
                            for (int ks = 0; ks < 4; ++ks) { const bf16x8 wf = *(const bf16x8*)(Wp + (size_t)(64 * half + outchan(n, fr)) * 128 + 32 * ks + 8 * fq);
                                acc = __builtin_amdgcn_mfma_f32_16x16x32_bf16(wf, pfr[m][ks], acc, 0, 0, 0); }
                            const int col = g * 128 + 64 * half + 32 * np + 8 * fq + 4 * nn;
                            const f32x4 pb = *(const f32x4*)(pbias + col), ps = *(const f32x4*)(pscale + col);
                            acc = (acc + pb) * ps; s += (acc.x * acc.x + acc.y * acc.y) + (acc.z * acc.z + acc.w * acc.w); o2[nn] = acc * rs; }
                        if (pass) { u32x4 w; w.x = cvt_pk(o2[0].x, o2[0].y); w.y = cvt_pk(o2[0].z, o2[0].w); w.z = cvt_pk(o2[1].x, o2[1].y); w.w = cvt_pk(o2[1].z, o2[1].w);
                            *(u32x4*)(Y + rowg * D + g * 128 + 64 * half + 32 * np + 8 * fq) = w; }
                    }
                    if (!pass) { s += __shfl_xor(s, 16); s += __shfl_xor(s, 32); if (fq == 0) red2[(16 * m + fr) * 8 + wid] = s; }
                }
                if (!pass) __syncthreads();
            }
        }
    }
    __syncthreads();
}

__device__ __forceinline__ void final_norm(const Params& p, int G) {
    int tid_ = threadIdx.x; asm volatile("" : "+v"(tid_));
    const int tid = tid_, lane = tid & 63, wid = tid >> 6; const int gw = blockIdx.x * 8 + wid, NGW = G * 8;
    const f32x4* gp = (const f32x4*)p.in[19] + lane; f32x4 gg[4];
#pragma unroll
    for (int j = 0; j < 4; ++j) gg[j] = gp[64 * j];
    for (int m = gw; m < M; m += NGW) {
        f32x4* xr = (f32x4*)(p.out + (size_t)m * D) + lane; f32x4 v[4]; float s = 0.f;
#pragma unroll
        for (int j = 0; j < 4; ++j) { v[j] = xr[64 * j]; s += (v[j].x * v[j].x + v[j].y * v[j].y) + (v[j].z * v[j].z + v[j].w * v[j].w); }
        const float rs = 1.0f / sqrtf(wave_sum(s) * (1.0f / D) + EPS);
#pragma unroll
        for (int j = 0; j < 4; ++j) xr[64 * j] = v[j] * rs * gg[j];
    }
}

__global__ void __launch_bounds__(512, 2) fwd_megakernel(Params p) {
    extern __shared__ __attribute__((aligned(16))) unsigned char lds_raw[];
    LAS unsigned char* lds = (LAS unsigned char*)lds_raw;
    cg::grid_group grid = cg::this_grid();
    const int G = gridDim.x;
    unsigned char* ws = p.ws;
    bf16* hb = (bf16*)(ws + WS_HB); bf16* proj = (bf16*)(ws + WS_PROJ); bf16* Y = (bf16*)(ws + WS_Y); bf16* mid = (bf16*)(ws + WS_MID); float* ss = (float*)(ws + WS_SS);
#ifndef NO_PRO
    prologue(p, lds, G);
#endif
    grid.sync();
#pragma unroll 1
    for (int l = 0; l < DEPTH; ++l) {
        const unsigned char* wl = ws + WS_W + (size_t)l * W_LAYER;
        const bf16* in_t = (const bf16*)(wl + W_IN); const bf16* out_t = (const bf16*)(wl + W_OUT); const bf16* up_t = (const bf16*)(wl + W_UP); const bf16* down_t = (const bf16*)(wl + W_DOWN);
#ifndef NO_GIN
        { pg8::Gemm g{hb, in_t, M, DIN, D, 0}; pg8::StaticOrder S; S.init(M, DIN, G, (int)blockIdx.x); EpiIn E{proj, ss};
          pg8::gemm_phase<EpiIn, pg8::StaticOrder, true, true>(lds, g, S, E); }
#endif
#ifndef NO_META
        meta_tasks<0>(p, lds, G, nullptr, 0, in_t, D, DIN / 16);
#endif
        grid.sync();
#ifndef NO_M1
        m1_phase(p, lds, G, l);
#endif
        grid.sync();
#ifndef NO_M2
        m2_phase(p, lds, G, l);
#endif
        grid.sync();
#ifndef NO_GOUT
        { pg8::Gemm g{Y, out_t, M, D, D, NMETA}; pg8::StaticOrder S; S.init(M, D, G, (int)blockIdx.x); EpiRes E{l == 0 ? p.in[0] : p.out, p.out, hb, ss};
          pg8::gemm_phase<EpiRes, pg8::StaticOrder, false, true>(lds, g, S, E); }
#endif
#ifndef NO_META
        if (l < DEPTH - 1) meta_tasks<1>(p, lds, G, Y, D, out_t, D, D / 16);
#endif
        grid.sync();
#ifndef NO_GUP
        { pg8::Gemm g{hb, up_t, M, FF, D, 0}; pg8::StaticOrder S; S.init(M, FF, G, (int)blockIdx.x); EpiUp E{mid, ss};
          pg8::gemm_phase<EpiUp, pg8::StaticOrder, true, true>(lds, g, S, E); }
#endif
#ifndef NO_META
        if (l < DEPTH - 1) meta_tasks<2>(p, lds, G, nullptr, 0, up_t, D, FF / 16);
#endif
        grid.sync();
#ifndef NO_GDN
        { pg8::Gemm g{mid, down_t, M, D, FF, 0}; pg8::StaticOrder S; S.init(M, D, G, (int)blockIdx.x); EpiRes E{p.out, p.out, hb, ss};
          pg8::gemm_phase<EpiRes, pg8::StaticOrder, false, true>(lds, g, S, E); }
#endif
#ifndef NO_META
        if (l < DEPTH - 1) meta_tasks<1>(p, lds, G, (const bf16*)(ws + WS_MIDMETA), FF, down_t, FF, D / 16);
#endif
        grid.sync();
    }
    final_norm(p, G);
}

extern "C" void kernel_launch(void* const* d_in, const int* in_sizes, int n_in, void* d_out, int out_size, void* d_ws, size_t ws_size, hipStream_t stream) {
    static int grid = 0;
    if (grid == 0) {
        if (n_in != 20 || in_sizes[0] != M * D || out_size != M * D || ws_size < WS_END) { fprintf(stderr, "kernel_launch: unexpected shapes (n_in %d, in0 %d, out %d, ws %zu)\n", n_in, n_in > 0 ? in_sizes[0] : -1, out_size, ws_size); grid = -1; return; }
        int dev = 0, cus = 0, per_cu = 0;
        if (hipGetDevice(&dev) != hipSuccess || hipDeviceGetAttribute(&cus, hipDeviceAttributeMultiprocessorCount, dev) != hipSuccess) { grid = -1; return; }
        if (hipFuncSetAttribute((const void*)fwd_megakernel, hipFuncAttributeMaxDynamicSharedMemorySize, LDS_BYTES) != hipSuccess) { fprintf(stderr, "kernel_launch: hipFuncSetAttribute failed\n"); grid = -1; return; }
        if (hipOccupancyMaxActiveBlocksPerMultiprocessor(&per_cu, (const void*)fwd_megakernel, 512, LDS_BYTES) != hipSuccess || per_cu < 1) { fprintf(stderr, "kernel_launch: occupancy query gave %d\n", per_cu); (void)hipGetLastError(); grid = -1; return; }
        grid = cus * 1;
    }
    if (grid < 0) return;
    Params p{};
    for (int i = 0; i < 20; ++i) p.in[i] = (const float*)d_in[i];
    p.out = (float*)d_out; p.ws = (unsigned char*)d_ws;
    void* args[] = {&p};
    hipError_t e = hipLaunchCooperativeKernel((const void*)fwd_megakernel, dim3(grid), dim3(512), args, LDS_BYTES, stream);
    if (e != hipSuccess) fprintf(stderr, "cooperative launch failed: %s (grid %d)\n", hipGetErrorString(e), grid);
}
```

```cpp
#include <hip/hip_runtime.h>
#include <hip/hip_cooperative_groups.h>
#include <cstdio>
#include <cstdint>
namespace cg = cooperative_groups;
namespace pg8 {
#define PG8_LAS __attribute__((address_space(3)))
typedef unsigned short bf16_t;
typedef short bf16x8 __attribute__((ext_vector_type(8)));
typedef float f32x4 __attribute__((ext_vector_type(4)));
typedef unsigned u32x4 __attribute__((ext_vector_type(4)));
constexpr int BM = 256, BK = 64, HALF = 128, HTB = HALF * BK * 2  , STAGE_BYTES = 8 * HTB, NXCD = 8, WGM = 8;

__host__ __device__ __forceinline__ int lds_byte(int r, int c) { const int st = (r >> 4) * 2 + (c >> 5), rr = r & 15, cc = c & 31, ob = rr * 64 + cc * 2; return st * 1024 + (ob ^ (((ob >> 9) & 1) << 5)); }
__host__ __device__ __forceinline__ void stage_rc(int b, int& R, int& C) { const int st = b / 1024, sb = b % 1024, swz = sb ^ (((sb >> 9) & 1) << 5); R = (st >> 1) * 16 + swz / 64; C = (st & 1) * 32 + (swz % 64) / 2; }
__host__ __device__ __forceinline__ int perm32(int rho) { const int n = rho >> 4, i = rho & 15; return 8 * (i >> 2) + 4 * n + (i & 3); }

struct Unit { int pm, pn; };
struct Gemm { const bf16_t* A; const bf16_t* Bt; int M, N, K, gap; };

struct StaticOrder {
    int nM, nN, nwg, G, c;
    __host__ __device__ void init(int M, int N, int G_, int c_) { nM = M / BM; nN = N / BM; nwg = nM * nN; G = G_; c = c_; }
    __host__ __device__ bool next(int i, Unit& u) const {
        const long L = (long)i * G + c; if (L >= nwg) return false;
        int wgid = (int)L; { const int q = nwg / NXCD, r = nwg % NXCD, xcd = wgid % NXCD, off = wgid / NXCD; wgid = (xcd < r ? xcd * (q + 1) : r * (q + 1) + (xcd - r) * q) + off; }
        const int nig = WGM * nN, gid = wgid / nig, fm = gid * WGM, gsz = (nM - fm) < WGM ? (nM - fm) : WGM;
        u.pm = fm + ((wgid % nig) % gsz); u.pn = (wgid % nig) / gsz; return true;
    }
    __device__ __forceinline__ void a_ready(const Unit&) const {}
    __device__ __forceinline__ void done(const Unit&) const {}
};
__device__ __forceinline__ unsigned cvt_pk_bf16(float lo, float hi) { unsigned r; asm volatile("v_cvt_pk_bf16_f32 %0, %1, %2" : "=v"(r) : "v"(lo), "v"(hi)); return r; }
template <class Epi, class Sched, bool ALIGN_EPI = false, bool SP2 = false>
__device__ __forceinline__ void gemm_phase(PG8_LAS unsigned char* lds, const Gemm g, const Sched& S, const Epi& E) {
    int tid_ = threadIdx.x; asm volatile("" : "+v"(tid_));
    const int tid = tid_, wid = __builtin_amdgcn_readfirstlane(tid >> 6), lane = tid & 63, wr = wid >> 2, wc = wid & 3, fr = lane & 15, fq = lane >> 4;
    const int K = g.K, nt = K / BK;
    unsigned voffA[2], voffB[2];
#pragma unroll
    for (int i = 0; i < 2; ++i) { int R, C; stage_rc(tid * 16 + i * 8192, R, C); const int Rb = Epi::PERM ? ((R & ~31) + perm32(R & 31)) : R;
        voffA[i] = (unsigned)(R * K + C) * 2u; voffB[i] = (unsigned)(Rb * K + C) * 2u; }
    const size_t kstep = (size_t)(BK * 2);
    const size_t hstep = (size_t)HALF * K * 2;
    const size_t tstep = 2 * hstep;
    const int agap = g.gap;
#define a_off(pm_) ((size_t)((pm_) * BM + agap * (1 + ((pm_) >> 5))) * (size_t)K * 2)
    const unsigned ldsw = (unsigned)wid * 1024u;
    const int aoff = lds_byte(wr * 64 + fr, fq * 8), boff = lds_byte(wc * 32 + fr, fq * 8);
#define PG8_SA(b, h) (((b) * 2 + (h)) * HTB)
#define PG8_SB(b, h) ((4 + (b) * 2 + (h)) * HTB)
#define PG8_STAGE(bufoff, gbase, voff) do { _Pragma("unroll") for (int _i = 0; _i < 2; ++_i) \
        __builtin_amdgcn_global_load_lds((const unsigned*)((const char*)(gbase) + (voff)[_i]), (PG8_LAS unsigned*)(lds + (bufoff) + ldsw + _i * 8192), 16, 0, 0); } while (0)
#define PG8_LDA(dst, b, h) do { _Pragma("unroll") for (int m = 0; m < 4; ++m) _Pragma("unroll") for (int k = 0; k < 2; ++k) dst[m][k] = *(const PG8_LAS bf16x8*)(lds + PG8_SA(b, h) + aoff + m * 2048 + k * 1024); } while (0)
#define PG8_LDB(dst, b, h) do { _Pragma("unroll") for (int n = 0; n < 2; ++n) _Pragma("unroll") for (int k = 0; k < 2; ++k) dst[n][k] = *(const PG8_LAS bf16x8*)(lds + PG8_SB(b, h) + boff + n * 2048 + k * 1024); } while (0)
#define PG8_MMA(ai, bj, At, Bt) do { __builtin_amdgcn_s_setprio(1); _Pragma("unroll") for (int m = 0; m < 4; ++m) _Pragma("unroll") for (int n = 0; n < 2; ++n) _Pragma("unroll") for (int k = 0; k < 2; ++k) \
        acc[ai][bj][m][n] = __builtin_amdgcn_mfma_f32_16x16x32_bf16(Bt[n][k], At[m][k], acc[ai][bj][m][n], 0, 0, 0); __builtin_amdgcn_s_setprio(0); } while (0)
#define PG8_WAIT_V(n) asm volatile("s_waitcnt vmcnt(" #n ")" ::: "memory")
#define PG8_WAIT_L(n) asm volatile("s_waitcnt lgkmcnt(" #n ")" ::: "memory")
#define PG8_BAR __builtin_amdgcn_s_barrier()
#define PG8_SCHED __builtin_amdgcn_sched_barrier(0)
    Unit cur, nxt; int ui = 0;
    if (!S.next(0, cur)) return;
    f32x4 acc[2][2][4][2];
#pragma unroll
    for (int a = 0; a < 2; ++a)
#pragma unroll
        for (int b = 0; b < 2; ++b)
#pragma unroll
            for (int m = 0; m < 4; ++m)
#pragma unroll
                for (int n = 0; n < 2; ++n) acc[a][b][m][n] = (f32x4){0.f, 0.f, 0.f, 0.f};
    bf16x8 At[4][2], B0[2][2], B1[2][2];
    const char* cA = (const char*)g.A + a_off(cur.pm); const char* cB = (const char*)g.Bt + (size_t)cur.pn * tstep;
    S.a_ready(cur);
    if constexpr (SP2) {
        PG8_STAGE(PG8_SB(0, 0), cB, voffB); PG8_STAGE(PG8_SB(0, 1), cB + hstep, voffB); PG8_STAGE(PG8_SA(0, 0), cA, voffA); PG8_STAGE(PG8_SA(0, 1), cA + hstep, voffA);
        if (wr == 1) PG8_BAR;
        PG8_WAIT_V(2); PG8_BAR;
        PG8_STAGE(PG8_SB(1, 0), cB + kstep, voffB); PG8_STAGE(PG8_SA(1, 0), cA + kstep, voffA); PG8_STAGE(PG8_SB(1, 1), cB + hstep + kstep, voffB);
        PG8_WAIT_V(6); PG8_BAR;
    } else {
        PG8_STAGE(PG8_SB(0, 0), cB, voffB); PG8_STAGE(PG8_SA(0, 0), cA, voffA); PG8_STAGE(PG8_SB(0, 1), cB + hstep, voffB); PG8_STAGE(PG8_SA(0, 1), cA + hstep, voffA);
        if (wr == 1) PG8_BAR;
        PG8_WAIT_V(4); PG8_BAR;
        PG8_STAGE(PG8_SB(1, 0), cB + kstep, voffB); PG8_STAGE(PG8_SA(1, 0), cA + kstep, voffA); PG8_STAGE(PG8_SB(1, 1), cB + hstep + kstep, voffB);
        PG8_WAIT_V(6); PG8_BAR;
    }
    for (;;) {
        const bool has_next = S.next(ui + 1, nxt);
        const char* nA = has_next ? (const char*)g.A + a_off(nxt.pm) : cA; const char* nB = has_next ? (const char*)g.Bt + (size_t)nxt.pn * tstep : cB;
        for (int t = 0; t < nt; t += 2) {
            const bool last = (t == nt - 2);
            const char* a1 = cA + (size_t)(t + 1) * kstep;
            const char* a2 = last ? nA : cA + (size_t)(t + 2) * kstep; const char* b2 = last ? nB : cB + (size_t)(t + 2) * kstep;
            const char* a3 = a2 + kstep; const char* b3 = b2 + kstep;
            if (last && has_next) S.a_ready(nxt);
            if constexpr (SP2) {
            PG8_LDB(B0, 0, 0); PG8_LDB(B1, 0, 1); PG8_SCHED; PG8_LDA(At, 0, 0); PG8_STAGE(PG8_SA(1, 1), a1 + hstep, voffA);
            PG8_WAIT_V(8); PG8_WAIT_L(0); PG8_BAR; PG8_MMA(0, 0, At, B0); PG8_MMA(0, 1, At, B1); PG8_BAR; PG8_SCHED;
            PG8_LDA(At, 0, 1); PG8_STAGE(PG8_SB(0, 0), b2, voffB); PG8_STAGE(PG8_SB(0, 1), b2 + hstep, voffB); PG8_STAGE(PG8_SA(0, 0), a2, voffA);
            PG8_WAIT_V(8); PG8_WAIT_L(0); PG8_BAR; PG8_MMA(1, 0, At, B0); PG8_MMA(1, 1, At, B1); PG8_BAR; PG8_SCHED;
            PG8_LDB(B0, 1, 0); PG8_LDB(B1, 1, 1); PG8_SCHED; PG8_LDA(At, 1, 0); PG8_STAGE(PG8_SA(0, 1), a2 + hstep, voffA);
            PG8_WAIT_V(8); PG8_WAIT_L(0); PG8_BAR; PG8_MMA(0, 0, At, B0); PG8_MMA(0, 1, At, B1); PG8_BAR; PG8_SCHED;
            PG8_LDA(At, 1, 1); PG8_STAGE(PG8_SB(1, 0), b3, voffB); PG8_STAGE(PG8_SB(1, 1), b3 + hstep, voffB); PG8_STAGE(PG8_SA(1, 0), a3, voffA);
            PG8_WAIT_V(8); PG8_WAIT_L(0); PG8_BAR; PG8_MMA(1, 0, At, B0); PG8_MMA(1, 1, At, B1); PG8_BAR; PG8_SCHED;
            } else {
            PG8_LDB(B0, 0, 0); PG8_SCHED; PG8_LDA(At, 0, 0); PG8_STAGE(PG8_SA(1, 1), a1 + hstep, voffA);
            PG8_WAIT_L(8); PG8_BAR; PG8_WAIT_L(0); PG8_MMA(0, 0, At, B0); PG8_BAR; PG8_SCHED;
            PG8_LDB(B1, 0, 1); PG8_STAGE(PG8_SB(0, 0), b2, voffB);
            PG8_BAR; PG8_WAIT_L(0); PG8_MMA(0, 1, At, B1); PG8_BAR;
            PG8_LDA(At, 0, 1); PG8_STAGE(PG8_SA(0, 0), a2, voffA);
            PG8_BAR; PG8_WAIT_L(0); PG8_MMA(1, 0, At, B0); PG8_BAR; PG8_SCHED;
            PG8_STAGE(PG8_SB(0, 1), b2 + hstep, voffB);
            PG8_WAIT_V(6); PG8_BAR; PG8_MMA(1, 1, At, B1); PG8_BAR;
            PG8_LDB(B0, 1, 0); PG8_SCHED; PG8_LDA(At, 1, 0); PG8_STAGE(PG8_SA(0, 1), a2 + hstep, voffA);
            PG8_WAIT_L(8); PG8_BAR; PG8_WAIT_L(0); PG8_MMA(0, 0, At, B0); PG8_BAR; PG8_SCHED;
            PG8_LDB(B1, 1, 1); PG8_STAGE(PG8_SB(1, 0), b3, voffB);
            PG8_BAR; PG8_WAIT_L(0); PG8_MMA(0, 1, At, B1); PG8_BAR;
            PG8_LDA(At, 1, 1); PG8_STAGE(PG8_SA(1, 0), a3, voffA);
            PG8_BAR; PG8_WAIT_L(0); PG8_MMA(1, 0, At, B0); PG8_BAR; PG8_SCHED;
            PG8_STAGE(PG8_SB(1, 1), b3 + hstep, voffB);
            PG8_WAIT_V(6); PG8_BAR; PG8_MMA(1, 1, At, B1); PG8_BAR;
            }
        }
        if constexpr (ALIGN_EPI) { if (wr == 0) PG8_BAR; }
        if constexpr (!Epi::AFTER_DRAIN) { E(acc, cur, wr, wc, fr, fq); S.done(cur); }
        if (!has_next) break;
#pragma unroll
        for (int a = 0; a < 2; ++a)
#pragma unroll
            for (int b = 0; b < 2; ++b)
#pragma unroll
                for (int m = 0; m < 4; ++m)
#pragma unroll
                    for (int n = 0; n < 2; ++n) acc[a][b][m][n] = (f32x4){0.f, 0.f, 0.f, 0.f};
        cur = nxt; cA = nA; cB = nB; ++ui;
        if constexpr (ALIGN_EPI) { if (wr == 1) PG8_BAR; }
    }
    PG8_WAIT_V(0);
    if constexpr (!ALIGN_EPI) { if (wr == 0) PG8_BAR; }
    PG8_BAR;
    if constexpr (Epi::AFTER_DRAIN) { E.fused(acc, cur, wr, wc, fr, fq, lds, wid, lane); S.done(cur); }
#undef PG8_SA
#undef PG8_SB
#undef PG8_STAGE
#undef PG8_LDA
#undef PG8_LDB
#undef PG8_MMA
#undef PG8_WAIT_V
#undef PG8_WAIT_L
#undef PG8_BAR
#undef PG8_SCHED
}
}

#define LAS __attribute__((address_space(3)))
typedef unsigned short bf16;
typedef unsigned u32x4 __attribute__((ext_vector_type(4)));
typedef unsigned u32x2 __attribute__((ext_vector_type(2)));
typedef float f32x4 __attribute__((ext_vector_type(4)));
typedef short bf16x8 __attribute__((ext_vector_type(8)));
constexpr int D = 1024, SEQ = 8192, NB = 2, NMETA = 16, TT = SEQ + NMETA, M = NB * SEQ, DEPTH = 4, DIN = 1536, FF = 4096, DH = 512;
constexpr float EPS = 1e-6f;
constexpr size_t MiB = 1u << 20;
constexpr size_t WS_CTL = 0;
constexpr size_t WS_POOLW = 1 * MiB, WS_GR = WS_POOLW + 512 * 1024, WS_GI = WS_GR + 256 * 1024;
constexpr size_t WS_SP = 2 * MiB, WS_HMETA = WS_SP + 64 * 1024, WS_MIDMETA = WS_HMETA + 64 * 1024;
constexpr size_t WS_SS = 3 * MiB, WS_CARA = 4 * MiB, WS_CARH = WS_CARA + 512 * 1024;
constexpr size_t WS_W = 8 * MiB, W_LAYER = 21 * MiB, W_IN = 0, W_OUT = 3 * MiB, W_UP = 5 * MiB, W_DOWN = 13 * MiB;
constexpr size_t WS_HB = 92 * MiB, WS_MID = 124 * MiB;
constexpr size_t WS_PROJ = WS_MID, WS_Y = WS_MID + 48 * MiB + 256 * 1024, WS_HL = WS_Y + 32 * MiB + 256 * 1024, WS_P = WS_HL + 32 * MiB + 256 * 1024, WS_END = 256 * MiB;
static_assert(WS_PROJ + (size_t)NB * TT * DIN * 2 <= WS_Y && WS_Y + (size_t)NB * TT * D * 2 <= WS_HL && WS_HL + (size_t)NB * TT * DH * 4 <= WS_P && WS_P + (size_t)NB * TT * DH * 2 <= WS_END, "ws map");
static_assert(WS_W + DEPTH * W_LAYER <= WS_HB && WS_HB + (size_t)M * D * 2 <= WS_MID && WS_MID + (size_t)M * FF * 2 <= WS_END, "ws map 2");
constexpr int LDS_BYTES = 131072 + 16384;

struct Params {
    const float* in[20];
    float* out;
    unsigned char* ws;
};

__device__ __forceinline__ unsigned cvt_pk(float lo, float hi) { return pg8::cvt_pk_bf16(lo, hi); }
__device__ __forceinline__ float bf_lo(unsigned w) { return __builtin_bit_cast(float, w << 16); }
__device__ __forceinline__ float bf_hi(unsigned w) { return __builtin_bit_cast(float, w & 0xffff0000u); }
__device__ __forceinline__ void unpack8(const u32x4 w, float (&f)[8]) {
    f[0] = bf_lo(w.x); f[1] = bf_hi(w.x); f[2] = bf_lo(w.y); f[3] = bf_hi(w.y); f[4] = bf_lo(w.z); f[5] = bf_hi(w.z); f[6] = bf_lo(w.w); f[7] = bf_hi(w.w);
}
__device__ __forceinline__ u32x4 pack8(const float (&f)[8]) { u32x4 w; w.x = cvt_pk(f[0], f[1]); w.y = cvt_pk(f[2], f[3]); w.z = cvt_pk(f[4], f[5]); w.w = cvt_pk(f[6], f[7]); return w; }
__device__ __forceinline__ float wave_sum(float v) {
#pragma unroll
    for (int o = 1; o < 64; o <<= 1) v += __shfl_xor(v, o);
    return v;
}
template <int CTRL> __device__ __forceinline__ float dppf(float old, float src) {
    return __builtin_bit_cast(float, __builtin_amdgcn_update_dpp(__builtin_bit_cast(int, old), __builtin_bit_cast(int, src), CTRL, 0xf, 0xf, false));
}
template <int DD> __device__ __forceinline__ float shiftd(float cur, float prev) {
    const float t = dppf<0x100 + (16 - DD)>(0.f, prev);
    return dppf<0x110 + DD>(t, cur);
}
__device__ __forceinline__ float sigm(float v) { return __builtin_amdgcn_rcpf(1.0f + __expf(-v)); }
__device__ __forceinline__ int outchan(int n, int rho) { return 32 * (n >> 1) + 8 * (rho >> 2) + 4 * (n & 1) + (rho & 3); }

__device__ __forceinline__ float row_rstd(const float* ss, int r) {
    const f32x4* s4 = (const f32x4*)(ss + (size_t)r * 16);
    const f32x4 a = s4[0], b = s4[1], c = s4[2], d = s4[3];
    const float s = ((a.x + a.y) + (a.z + a.w)) + ((b.x + b.y) + (b.z + b.w)) + ((c.x + c.y) + (c.z + c.w)) + ((d.x + d.y) + (d.z + d.w));
    return 1.0f / sqrtf(s * (1.0f / D) + EPS);
}
__device__ __forceinline__ void rows_rstd(const float* ss, int rowbase  , int fr, float (&rs)[2][4]) {
    const int lane = threadIdx.x & 63;
    const float r0 = row_rstd(ss, rowbase + lane), r1 = row_rstd(ss, rowbase + 128 + lane);
#pragma unroll
    for (int m = 0; m < 4; ++m) { rs[0][m] = __shfl(r0, m * 16 + fr); rs[1][m] = __shfl(r1, m * 16 + fr); }
}
struct EpiIn {
    static constexpr bool PERM = true, AFTER_DRAIN = false;
    bf16* P; const float* ss;
    __device__ __forceinline__ void operator()(const f32x4 (&acc)[2][2][4][2], const pg8::Unit& u, int wr, int wc, int fr, int fq) const {
        const int row0 = u.pm * 256 + wr * 64 + fr, col0 = u.pn * 256 + wc * 32 + 8 * fq;
        float rsv[2][4]; rows_rstd(ss, u.pm * 256 + wr * 64, fr, rsv);
#pragma unroll
        for (int ai = 0; ai < 2; ++ai)
#pragma unroll
            for (int m = 0; m < 4; ++m) {
                const int r = row0 + ai * 128 + m * 16; const float rs = rsv[ai][m];
                bf16* rowp = P + (size_t)(r + NMETA * (1 + (r >> 13))) * DIN + col0;
#pragma unroll
                for (int bj = 0; bj < 2; ++bj) { const f32x4 v0 = acc[ai][bj][m][0] * rs, v1 = acc[ai][bj][m][1] * rs;
                    u32x4 w; w.x = cvt_pk(v0[0], v0[1]); w.y = cvt_pk(v0[2], v0[3]); w.z = cvt_pk(v1[0], v1[1]); w.w = cvt_pk(v1[2], v1[3]);
                    *(u32x4*)(rowp + bj * 128) = w; }
            }
    }
};
struct EpiUp {
    static constexpr bool PERM = true, AFTER_DRAIN = false;
    bf16* O; const float* ss;
    __device__ __forceinline__ void operator()(const f32x4 (&acc)[2][2][4][2], const pg8::Unit& u, int wr, int wc, int fr, int fq) const {
        const int row0 = u.pm * 256 + wr * 64 + fr, col0 = u.pn * 256 + wc * 32 + 8 * fq;
        float rsv[2][4]; rows_rstd(ss, u.pm * 256 + wr * 64, fr, rsv);
#pragma unroll
        for (int ai = 0; ai < 2; ++ai)
#pragma unroll
            for (int m = 0; m < 4; ++m) {
                const int r = row0 + ai * 128 + m * 16; const float rs = rsv[ai][m];
                bf16* rowp = O + (size_t)r * FF + col0;
#pragma unroll
                for (int bj = 0; bj < 2; ++bj) { f32x4 v0 = acc[ai][bj][m][0] * rs, v1 = acc[ai][bj][m][1] * rs;
#pragma unroll
                    for (int j = 0; j < 4; ++j) { v0[j] = fmaxf(v0[j], 0.f); v0[j] *= v0[j]; v1[j] = fmaxf(v1[j], 0.f); v1[j] *= v1[j]; }
                    u32x4 w; w.x = cvt_pk(v0[0], v0[1]); w.y = cvt_pk(v0[2], v0[3]); w.z = cvt_pk(v1[0], v1[1]); w.w = cvt_pk(v1[2], v1[3]);
                    *(u32x4*)(rowp + bj * 128) = w; }
            }
    }
};
struct EpiRes {
    static constexpr bool PERM = true, AFTER_DRAIN = false;
    const float* base; float* out; bf16* hb; float* ssn;
    __device__ __forceinline__ void operator()(const f32x4 (&acc)[2][2][4][2], const pg8::Unit& u, int wr, int wc, int fr, int fq) const {
        const int row0 = u.pm * 256 + wr * 64 + fr, col0 = u.pn * 256 + wc * 32 + 8 * fq;
#pragma unroll
        for (int ai = 0; ai < 2; ++ai)
#pragma unroll
            for (int m = 0; m < 4; ++m) {
                const int r = row0 + ai * 128 + m * 16; const size_t off = (size_t)r * D + col0; float s = 0.f;
#pragma unroll
                for (int bj = 0; bj < 2; ++bj) {
                    const f32x4 b0 = *(const f32x4*)(base + off + bj * 128), b1 = *(const f32x4*)(base + off + bj * 128 + 4);
                    const f32x4 o0 = b0 + acc[ai][bj][m][0], o1 = b1 + acc[ai][bj][m][1];
                    *(f32x4*)(out + off + bj * 128) = o0; *(f32x4*)(out + off + bj * 128 + 4) = o1;
                    s += (o0[0] * o0[0] + o0[1] * o0[1]) + (o0[2] * o0[2] + o0[3] * o0[3]) + (o1[0] * o1[0] + o1[1] * o1[1]) + (o1[2] * o1[2] + o1[3] * o1[3]);
                    u32x4 w; w.x = cvt_pk(o0[0], o0[1]); w.y = cvt_pk(o0[2], o0[3]); w.z = cvt_pk(o1[0], o1[1]); w.w = cvt_pk(o1[2], o1[3]);
                    *(u32x4*)(hb + off + bj * 128) = w; }
                s += __shfl_xor(s, 16); s += __shfl_xor(s, 32);
                if (fq == 0) ssn[(size_t)r * 16 + u.pn * 4 + wc] = s;
                if (m & 1) asm volatile("" ::: "memory");
            }
    }
};

__device__ __forceinline__ void transpose_item(const float* W, const float* gk, int K, int N, bf16* WT, LAS float* scr, int item, int lane) {
    const int nblk = N / 32, kb = item / nblk, nb = item % nblk, k0 = 64 * kb, n0 = 32 * nb;
#pragma unroll 8
    for (int i = 0; i < 32; ++i) { const int kk = 2 * i + (lane >> 5); float v = W[(size_t)(k0 + kk) * N + n0 + (lane & 31)]; if (gk) v *= gk[k0 + kk]; scr[kk * 33 + (lane & 31)] = v; }
    asm volatile("s_waitcnt lgkmcnt(0)" ::: "memory");
    const int c = lane & 7;
#pragma unroll
    for (int j = 0; j < 4; ++j) { const int n = (lane >> 3) + 8 * j; const LAS float* s = scr + (8 * c) * 33 + n;
        u32x4 o; o.x = cvt_pk(s[0 * 33], s[1 * 33]); o.y = cvt_pk(s[2 * 33], s[3 * 33]); o.z = cvt_pk(s[4 * 33], s[5 * 33]); o.w = cvt_pk(s[6 * 33], s[7 * 33]);
        *(u32x4*)(WT + (size_t)(n0 + n) * K + k0 + 8 * c) = o; }
    asm volatile("s_waitcnt lgkmcnt(0)" ::: "memory");
}
__device__ __forceinline__ void prologue(const Params& p, LAS unsigned char* lds, int G) {
    int tid_ = threadIdx.x; asm volatile("" : "+v"(tid_));
    const int tid = tid_, lane = tid & 63, wid = __builtin_amdgcn_readfirstlane(tid >> 6);
    LAS float* scr = (LAS float*)(lds + wid * 16384);
    const int gw = blockIdx.x * 8 + wid, NGW = G * 8;
    constexpr int I_IN = 16 * 48, I_OUT = 16 * 32, I_UP = 16 * 128, I_DN = 64 * 32, I_PW = 4 * 8, I_G = 8 * 2, I_L = I_IN + I_OUT + I_UP + I_DN + I_PW + 2 * I_G;
    unsigned char* ws = p.ws;
    for (int it = gw; it < DEPTH * I_L; it += NGW) {
        const int l = it / I_L; int r = it % I_L;
        unsigned char* wl = ws + WS_W + (size_t)l * W_LAYER;
        if (r < I_IN) { transpose_item(p.in[3] + (size_t)l * D * DIN, p.in[2] + l * D, D, DIN, (bf16*)(wl + W_IN), scr, r, lane); continue; } r -= I_IN;
        if (r < I_OUT) { transpose_item(p.in[15] + (size_t)l * D * D, p.in[14] + l * D, D, D, (bf16*)(wl + W_OUT), scr, r, lane); continue; } r -= I_OUT;
        if (r < I_UP) { transpose_item(p.in[17] + (size_t)l * D * FF, p.in[16] + l * D, D, FF, (bf16*)(wl + W_UP), scr, r, lane); continue; } r -= I_UP;
        if (r < I_DN) { transpose_item(p.in[18] + (size_t)l * FF * D, nullptr, FF, D, (bf16*)(wl + W_DOWN), scr, r, lane); continue; } r -= I_DN;
        if (r < I_PW) { const int g = r / 8; transpose_item(p.in[4] + (size_t)(l * 4 + g) * 16384, nullptr, 128, 128, (bf16*)(ws + WS_POOLW) + (size_t)(l * 4 + g) * 16384, scr, r % 8, lane); continue; } r -= I_PW;
        if (r < I_G) { const int h = r / 2; transpose_item(p.in[9] + (size_t)(l * 8 + h) * 4096, nullptr, 64, 64, (bf16*)(ws + WS_GR) + (size_t)(l * 8 + h) * 4096, scr, r % 2, lane); continue; } r -= I_G;
        { const int h = r / 2; transpose_item(p.in[11] + (size_t)(l * 8 + h) * 4096, nullptr, 64, 64, (bf16*)(ws + WS_GI) + (size_t)(l * 8 + h) * 4096, scr, r % 2, lane); }
    }
    const float* x = p.in[0]; bf16* hb = (bf16*)(ws + WS_HB); float* ss = (float*)(ws + WS_SS);
    for (int m = gw; m < M; m += NGW) {
        const f32x4* xr = (const f32x4*)(x + (size_t)m * D) + lane; f32x4 v[4]; float s = 0.f;
#pragma unroll
        for (int j = 0; j < 4; ++j) { v[j] = xr[64 * j]; s += (v[j].x * v[j].x + v[j].y * v[j].y) + (v[j].z * v[j].z + v[j].w * v[j].w); }
        s = wave_sum(s);
        u32x2* o8 = (u32x2*)(hb + (size_t)m * D) + lane;
#pragma unroll
        for (int j = 0; j < 4; ++j) { u32x2 w; w.x = cvt_pk(v[j].x, v[j].y); w.y = cvt_pk(v[j].z, v[j].w); o8[64 * j] = w; }
        if (lane < 16) ss[(size_t)m * 16 + lane] = lane == 0 ? s : 0.f;
    }
    float* hm = (float*)(ws + WS_HMETA); float* sp = (float*)(ws + WS_SP);
    for (int i = blockIdx.x * 512 + tid; i < NMETA * D; i += G * 512) hm[i] = p.in[1][i];
    for (int i = blockIdx.x * 512 + tid; i < DEPTH * DH; i += G * 512) sp[i] = log1pf(expf(-p.in[13][i]));
}

template <int MODE> __device__ __forceinline__ void meta_tasks(const Params& p, LAS unsigned char* lds, int G, const bf16* Ab, int lda, const bf16* Bt, int K, int ntasks) {
    int tid_ = threadIdx.x; asm volatile("" : "+v"(tid_));
    const int tid = tid_, lane = tid & 63, wid = __builtin_amdgcn_readfirstlane(tid >> 6), fr = lane & 15, fq = lane >> 4;
    float* hm = (float*)(p.ws + WS_HMETA);
    LAS float* red = (LAS float*)lds;
    for (int task = G - 1 - (int)blockIdx.x; task < ntasks; task += G) {
        const int n0 = task * 16, kw = K / 8, k0 = wid * kw;
        f32x4 acc = {0.f, 0.f, 0.f, 0.f}; float ssq = 0.f;
        for (int kk = k0; kk < k0 + kw; kk += 32) {
            bf16x8 af;
            if (MODE == 1) af = *(const bf16x8*)(Ab + (size_t)fr * lda + kk + 8 * fq);
            else { const f32x4 a0 = *(const f32x4*)(hm + fr * D + kk + 8 * fq), a1 = *(const f32x4*)(hm + fr * D + kk + 8 * fq + 4);
                ssq += (a0.x * a0.x + a0.y * a0.y) + (a0.z * a0.z + a0.w * a0.w) + (a1.x * a1.x + a1.y * a1.y) + (a1.z * a1.z + a1.w * a1.w);
                u32x4 w; w.x = cvt_pk(a0.x, a0.y); w.y = cvt_pk(a0.z, a0.w); w.z = cvt_pk(a1.x, a1.y); w.w = cvt_pk(a1.z, a1.w); af = __builtin_bit_cast(bf16x8, w); }
            const bf16x8 bfr = *(const bf16x8*)(Bt + (size_t)(n0 + fr) * K + kk + 8 * fq);
            acc = __builtin_amdgcn_mfma_f32_16x16x32_bf16(bfr, af, acc, 0, 0, 0);
        }
        ssq += __shfl_xor(ssq, 16); ssq += __shfl_xor(ssq, 32);
        LAS float* rp = red + (wid * 64 + lane) * 5;
        rp[0] = acc[0]; rp[1] = acc[1]; rp[2] = acc[2]; rp[3] = acc[3]; rp[4] = ssq;
        __syncthreads();
        if (wid == 0) {
            float a0 = 0.f, a1 = 0.f, a2 = 0.f, a3 = 0.f, sq = 0.f;
#pragma unroll
            for (int w = 0; w < 8; ++w) { const LAS float* q = red + (w * 64 + lane) * 5; a0 += q[0]; a1 += q[1]; a2 += q[2]; a3 += q[3]; sq += q[4]; }
            const int col = n0 + 4 * fq;
            if (MODE == 1) { f32x4* hp = (f32x4*)(hm + fr * D + col); f32x4 h = *hp; h.x += a0; h.y += a1; h.z += a2; h.w += a3; *hp = h; }
            else {
                const float rs = 1.0f / sqrtf(sq * (1.0f / D) + EPS); a0 *= rs; a1 *= rs; a2 *= rs; a3 *= rs;
                if (MODE == 0) { u32x2 w; w.x = cvt_pk(a0, a1); w.y = cvt_pk(a2, a3); bf16* pr = (bf16*)(p.ws + WS_PROJ);
                    *(u32x2*)(pr + (size_t)fr * DIN + col) = w; *(u32x2*)(pr + (size_t)(TT + fr) * DIN + col) = w; }
                else { a0 = fmaxf(a0, 0.f); a1 = fmaxf(a1, 0.f); a2 = fmaxf(a2, 0.f); a3 = fmaxf(a3, 0.f);
                    u32x2 w; w.x = cvt_pk(a0 * a0, a1 * a1); w.y = cvt_pk(a2 * a2, a3 * a3); *(u32x2*)((bf16*)(p.ws + WS_MIDMETA) + (size_t)fr * FF + col) = w; }
            }
        }
        __syncthreads();
    }
}

__device__ __forceinline__ void m1_phase(const Params& p, LAS unsigned char* lds, int G, int l) {
    int tid_ = threadIdx.x; asm volatile("" : "+v"(tid_));
    const int tid = tid_, lane = tid & 63, wid = __builtin_amdgcn_readfirstlane(tid >> 6), fr = lane & 15, fq = lane >> 4;
    LAS float* cst = (LAS float*)lds;
    for (int i = tid; i < 8 * DH; i += 512) { const int row = i >> 9, ch = i & 511; float v;
        if (row < 4) v = p.in[7][(l * 4 + row) * DH + ch]; else if (row == 4) v = p.in[8][l * DH + ch]; else if (row == 5) v = p.in[10][l * DH + ch];
        else if (row == 6) v = p.in[12][l * DH + ch]; else v = ((const float*)(p.ws + WS_SP))[l * DH + ch];
        cst[i] = v; }
    __syncthreads();
    const bf16* proj = (const bf16*)(p.ws + WS_PROJ);
    const bf16* Wr = (const bf16*)(p.ws + WS_GR) + (size_t)(l * 8 + wid) * 4096; const bf16* Wi = (const bf16*)(p.ws + WS_GI) + (size_t)(l * 8 + wid) * 4096;
    float* hl = (float*)(p.ws + WS_HL); bf16* Pp = (bf16*)(p.ws + WS_P);
    float* carA = (float*)(p.ws + WS_CARA); float* carH = (float*)(p.ws + WS_CARH);
    for (int unit = blockIdx.x; unit < 256; unit += G) {
        const int b = unit >> 7, c = unit & 127, t0 = c ? NMETA + 64 * c : 0, NM = c ? 4 : 5;
        float Hc[16], Pc[16];
#pragma unroll
        for (int k = 0; k < 16; ++k) { Hc[k] = 0.f; Pc[k] = 1.f; }
#pragma unroll 1
        for (int m = 0; m < NM; ++m) {
            const int t = t0 + 16 * m + fr; const size_t rowg = (size_t)b * TT + t;
            float xc[2][8]; bf16x8 frag[2];
#pragma unroll
            for (int ks = 0; ks < 2; ++ks) {
                const int chb = wid * 64 + 32 * ks + 8 * fq;
                { const f32x4 c0 = *(const LAS f32x4*)(cst + 4 * DH + chb), c1 = *(const LAS f32x4*)(cst + 4 * DH + chb + 4);
                  xc[ks][0] = c0.x; xc[ks][1] = c0.y; xc[ks][2] = c0.z; xc[ks][3] = c0.w; xc[ks][4] = c1.x; xc[ks][5] = c1.y; xc[ks][6] = c1.z; xc[ks][7] = c1.w; }
#pragma unroll
                for (int d = 0; d < 4; ++d) {
                    const int tt = t - 3 + d;
                    u32x4 raw = {0u, 0u, 0u, 0u};
                    if (tt >= 0) raw = *(const u32x4*)(proj + ((size_t)b * TT + tt) * DIN + DH + chb);
                    float u[8]; unpack8(raw, u);
                    const f32x4 w0 = *(const LAS f32x4*)(cst + d * DH + chb), w1 = *(const LAS f32x4*)(cst + d * DH + chb + 4);
                    xc[ks][0] += u[0] * w0.x; xc[ks][1] += u[1] * w0.y; xc[ks][2] += u[2] * w0.z; xc[ks][3] += u[3] * w0.w;
                    xc[ks][4] += u[4] * w1.x; xc[ks][5] += u[5] * w1.y; xc[ks][6] += u[6] * w1.z; xc[ks][7] += u[7] * w1.w;
                }
                frag[ks] = __builtin_bit_cast(bf16x8, pack8(xc[ks]));
            }
            f32x4 ar[4], ai[4];
#pragma unroll
            for (int n = 0; n < 4; ++n) { ar[n] = (f32x4){0.f, 0.f, 0.f, 0.f}; ai[n] = (f32x4){0.f, 0.f, 0.f, 0.f};
#pragma unroll
                for (int ks = 0; ks < 2; ++ks) {
                    const bf16x8 wr_ = *(const bf16x8*)(Wr + outchan(n, fr) * 64 + 32 * ks + 8 * fq), wi_ = *(const bf16x8*)(Wi + outchan(n, fr) * 64 + 32 * ks + 8 * fq);
                    ar[n] = __builtin_amdgcn_mfma_f32_16x16x32_bf16(wr_, frag[ks], ar[n], 0, 0, 0);
                    ai[n] = __builtin_amdgcn_mfma_f32_16x16x32_bf16(wi_, frag[ks], ai[n], 0, 0, 0);
                } }
            float Aa[16], Bb[16];
#pragma unroll
            for (int n = 0; n < 4; ++n) {
                const int cho = wid * 64 + 32 * (n >> 1) + 8 * fq + 4 * (n & 1);
                const f32x4 rb = *(const LAS f32x4*)(cst + 5 * DH + cho), ib = *(const LAS f32x4*)(cst + 6 * DH + cho), spv = *(const LAS f32x4*)(cst + 7 * DH + cho);
#pragma unroll
                for (int jj = 0; jj < 4; ++jj) {
                    const float r = sigm(ar[n][jj] + rb[jj]), ig = sigm(ai[n][jj] + ib[jj]);
                    const float la = -8.0f * r * spv[jj], a = __expf(la), x2 = 2.0f * la;
                    const float m2s = -x2 * (1.0f + x2 * (0.5f + x2 * (0.16666667f + x2 * 0.041666668f))), m2 = (x2 > -0.0625f) ? m2s : 1.0f - a * a;
                    Aa[n * 4 + jj] = a; Bb[n * 4 + jj] = sqrtf(m2) * ig * xc[n >> 1][4 * (n & 1) + jj];
                }
            }
#pragma unroll
            for (int k = 0; k < 16; ++k) {
                float A = Aa[k], B = Bb[k], Ap, Bq;
                Ap = dppf<0x111>(1.f, A); Bq = dppf<0x111>(0.f, B); B = fmaf(A, Bq, B); A *= Ap;
                Ap = dppf<0x112>(1.f, A); Bq = dppf<0x112>(0.f, B); B = fmaf(A, Bq, B); A *= Ap;
                Ap = dppf<0x114>(1.f, A); Bq = dppf<0x114>(0.f, B); B = fmaf(A, Bq, B); A *= Ap;
                Ap = dppf<0x118>(1.f, A); Bq = dppf<0x118>(0.f, B); B = fmaf(A, Bq, B); A *= Ap;
                Bb[k] = fmaf(A, Hc[k], B); Aa[k] = A * Pc[k];
            }
#pragma unroll
            for (int ks = 0; ks < 2; ++ks) {
                const size_t o = rowg * DH + wid * 64 + 32 * ks + 8 * fq;
                *(f32x4*)(hl + o) = (f32x4){Bb[8 * ks + 0], Bb[8 * ks + 1], Bb[8 * ks + 2], Bb[8 * ks + 3]};
                *(f32x4*)(hl + o + 4) = (f32x4){Bb[8 * ks + 4], Bb[8 * ks + 5], Bb[8 * ks + 6], Bb[8 * ks + 7]};
                u32x4 w; w.x = cvt_pk(Aa[8 * ks + 0], Aa[8 * ks + 1]); w.y = cvt_pk(Aa[8 * ks + 2], Aa[8 * ks + 3]); w.z = cvt_pk(Aa[8 * ks + 4], Aa[8 * ks + 5]); w.w = cvt_pk(Aa[8 * ks + 6], Aa[8 * ks + 7]);
                *(u32x4*)(Pp + o) = w;
            }
            const int src = (lane & 48) | 15;
#pragma unroll
            for (int k = 0; k < 16; ++k) { Hc[k] = __shfl(Bb[k], src); Pc[k] = __shfl(Aa[k], src); }
        }
        if (fr == 0) {
#pragma unroll
            for (int ks = 0; ks < 2; ++ks) {
                const size_t o = (size_t)(b * 128 + c) * DH + wid * 64 + 32 * ks + 8 * fq;
                *(f32x4*)(carA + o) = (f32x4){Pc[8 * ks + 0], Pc[8 * ks + 1], Pc[8 * ks + 2], Pc[8 * ks + 3]}; *(f32x4*)(carA + o + 4) = (f32x4){Pc[8 * ks + 4], Pc[8 * ks + 5], Pc[8 * ks + 6], Pc[8 * ks + 7]};
                *(f32x4*)(carH + o) = (f32x4){Hc[8 * ks + 0], Hc[8 * ks + 1], Hc[8 * ks + 2], Hc[8 * ks + 3]}; *(f32x4*)(carH + o + 4) = (f32x4){Hc[8 * ks + 4], Hc[8 * ks + 5], Hc[8 * ks + 6], Hc[8 * ks + 7]};
            }
        }
    }
    __syncthreads();
}

__device__ __forceinline__ void m2_phase(const Params& p, LAS unsigned char* lds, int G, int l) {
    int tid_ = threadIdx.x; asm volatile("" : "+v"(tid_));
    const int tid = tid_, lane = tid & 63, wid = __builtin_amdgcn_readfirstlane(tid >> 6), fr = lane & 15, fq = lane >> 4;
    LAS float* segA = (LAS float*)lds; LAS float* segH = (LAS float*)(lds + 8192); LAS float* carr = (LAS float*)(lds + 16384);
    LAS float* red1 = (LAS float*)(lds + 18432); LAS float* red2 = (LAS float*)(lds + 21504);
    const bf16* proj = (const bf16*)(p.ws + WS_PROJ); bf16* Y = (bf16*)(p.ws + WS_Y);
    const float* hl = (const float*)(p.ws + WS_HL); const bf16* Pp = (const bf16*)(p.ws + WS_P);
    const float* carA = (const float*)(p.ws + WS_CARA); const float* carH = (const float*)(p.ws + WS_CARH);
    const int g = wid >> 1, half = wid & 1, kwin = 2 << g;
    const bf16* Wp = (const bf16*)(p.ws + WS_POOLW) + (size_t)(l * 4 + g) * 16384;
    const float* pbias = p.in[5] + l * DH; const float* pscale = p.in[6] + l * DH;
    for (int unit = blockIdx.x; unit < 256; unit += G) {
        const int b = unit >> 7, c = unit & 127, t0 = c ? NMETA + 64 * c : 0, NM = c ? 4 : 5;
        {
            const int q = (c + 3) >> 2, seg = tid >> 7, cgi = tid & 127, jlo = seg * q, jhi = (jlo + q < c) ? jlo + q : c;
            f32x4 A = {1.f, 1.f, 1.f, 1.f}, H = {0.f, 0.f, 0.f, 0.f};
            for (int j = jlo; j < jhi; ++j) { const f32x4 a = *(const f32x4*)(carA + (size_t)(b * 128 + j) * DH + 4 * cgi), hh = *(const f32x4*)(carH + (size_t)(b * 128 + j) * DH + 4 * cgi); H = a * H + hh; A = A * a; }
            *(LAS f32x4*)(segA + seg * DH + 4 * cgi) = A; *(LAS f32x4*)(segH + seg * DH + 4 * cgi) = H;
        }
        __syncthreads();
        { float cy = 0.f;
#pragma unroll
          for (int s = 0; s < 4; ++s) cy = segA[s * DH + tid] * cy + segH[s * DH + tid];
          carr[tid] = cy; }
        __syncthreads();
        {
            float cr[16];
#pragma unroll
            for (int ks = 0; ks < 2; ++ks) { const f32x4 c0 = *(const LAS f32x4*)(carr + wid * 64 + 32 * ks + 8 * fq), c1 = *(const LAS f32x4*)(carr + wid * 64 + 32 * ks + 8 * fq + 4);
                cr[8 * ks + 0] = c0.x; cr[8 * ks + 1] = c0.y; cr[8 * ks + 2] = c0.z; cr[8 * ks + 3] = c0.w; cr[8 * ks + 4] = c1.x; cr[8 * ks + 5] = c1.y; cr[8 * ks + 6] = c1.z; cr[8 * ks + 7] = c1.w; }
#pragma unroll 1
            for (int pass = 0; pass < 2; ++pass) {
#pragma unroll 1
                for (int m = 0; m < NM; ++m) {
                    const int t = t0 + 16 * m + fr; const size_t rowg = (size_t)b * TT + t; float s = 0.f; float rs = 0.f;
                    if (pass) { const f32x4 r0 = *(const LAS f32x4*)(red1 + (16 * m + fr) * 8), r1 = *(const LAS f32x4*)(red1 + (16 * m + fr) * 8 + 4);
                        rs = 1.0f / sqrtf((((r0.x + r0.y) + (r0.z + r0.w)) + ((r1.x + r1.y) + (r1.z + r1.w))) * (1.0f / DH) + EPS); }
#pragma unroll
                    for (int ks = 0; ks < 2; ++ks) {
                        const int ch = wid * 64 + 32 * ks + 8 * fq; const size_t o = rowg * DH + ch;
                        const f32x4 h0 = *(const f32x4*)(hl + o), h1 = *(const f32x4*)(hl + o + 4);
                        const u32x4 pw = *(const u32x4*)(Pp + o), gw = *(const u32x4*)(proj + rowg * DIN + 2 * DH + ch);
                        float pf[8], gt[8], yy[8]; unpack8(pw, pf); unpack8(gw, gt);
                        const float hh[8] = {h0.x, h0.y, h0.z, h0.w, h1.x, h1.y, h1.z, h1.w};
#pragma unroll
                        for (int e = 0; e < 8; ++e) {
                            const float hv = fmaf(pf[e], cr[8 * ks + e], hh[e]), x = gt[e];
                            const float ge = x * __builtin_amdgcn_rcpf(1.0f + __expf(-1.5957691216f * (x + 0.044715f * x * x * x)));
                            const float y = hv * ge; yy[e] = y * rs; s = fmaf(y, y, s);
                        }
                        if (pass) *(u32x4*)(Y + rowg * D + DH + ch) = pack8(yy);
                    }
                    if (!pass) { s += __shfl_xor(s, 16); s += __shfl_xor(s, 32); if (fq == 0) red1[(16 * m + fr) * 8 + wid] = s; }
                }
                if (!pass) __syncthreads();
            }
        }
        {
            bf16x8 pfr[5][4];
#pragma unroll
            for (int ks = 0; ks < 4; ++ks) {
                const int chb = g * 128 + 32 * ks + 8 * fq;
                float pu[8], p2[8], p4[8], p8[8];
                if (c) { const u32x4 raw = *(const u32x4*)(proj + ((size_t)b * TT + t0 - 16 + fr) * DIN + chb); unpack8(raw, pu);
#pragma unroll
                    for (int e = 0; e < 8; ++e) { p2[e] = pu[e] + dppf<0x111>(0.f, pu[e]); p4[e] = p2[e] + dppf<0x112>(0.f, p2[e]); p8[e] = p4[e] + dppf<0x114>(0.f, p4[e]); } }
                else {
#pragma unroll
                    for (int e = 0; e < 8; ++e) { pu[e] = 0.f; p2[e] = 0.f; p4[e] = 0.f; p8[e] = 0.f; } }
#pragma unroll
                for (int m = 0; m < 5; ++m) if (m < NM) {
                    const int t = t0 + 16 * m + fr; const size_t rowg = (size_t)b * TT + t;
                    const u32x4 raw = *(const u32x4*)(proj + rowg * DIN + chb); float u[8], po[8]; unpack8(raw, u);
                    const int cnt = (t + 1 < kwin) ? t + 1 : kwin; const float rc = 1.0f / (float)cnt;
#pragma unroll
                    for (int e = 0; e < 8; ++e) {
                        const float s2 = u[e] + shiftd<1>(u[e], pu[e]), s4 = s2 + shiftd<2>(s2, p2[e]), s8 = s4 + shiftd<4>(s4, p4[e]), s16 = s8 + shiftd<8>(s8, p8[e]);
                        const float win = g == 0 ? s2 : (g == 1 ? s4 : (g == 2 ? s8 : s16));
                        po[e] = fmaf(win, rc, -u[e]); pu[e] = u[e]; p2[e] = s2; p4[e] = s4; p8[e] = s8;
                    }
                    pfr[m][ks] = __builtin_bit_cast(bf16x8, pack8(po));
                }
            }
#pragma unroll 1
            for (int pass = 0; pass < 2; ++pass) {
#pragma unroll
                for (int m = 0; m < 5; ++m) if (m < NM) {
                    const int t = t0 + 16 * m + fr; const size_t rowg = (size_t)b * TT + t; float s = 0.f, rs = 0.f;
                    if (pass) { const f32x4 r0 = *(const LAS f32x4*)(red2 + (16 * m + fr) * 8), r1 = *(const LAS f32x4*)(red2 + (16 * m + fr) * 8 + 4);
                        rs = 1.0f / sqrtf((((r0.x + r0.y) + (r0.z + r0.w)) + ((r1.x + r1.y) + (r1.z + r1.w))) * (1.0f / DH) + EPS); }
#pragma unroll
                    for (int np = 0; np < 2; ++np) {
                        f32x4 o2[2];
#pragma unroll
                        for (int nn = 0; nn < 2; ++nn) { const int n = 2 * np + nn;
                            f32x4 acc = {0.f, 0.f, 0.f, 0.f};
#pragma unroll
                            for (int ks = 0; ks < 4; ++ks) { const bf16x8 wf = *(const bf16x8*)(Wp + (size_t)(64 * half + outchan(n, fr)) * 128 + 32 * ks + 8 * fq);
                                acc = __builtin_amdgcn_mfma_f32_16x16x32_bf16(wf, pfr[m][ks], acc, 0, 0, 0); }
                            const int col = g * 128 + 64 * half + 32 * np + 8 * fq + 4 * nn;
                            const f32x4 pb = *(const f32x4*)(pbias + col), ps = *(const f32x4*)(pscale + col);
                            acc = (acc + pb) * ps; s += (acc.x * acc.x + acc.y * acc.y) + (acc.z * acc.z + acc.w * acc.w); o2[nn] = acc * rs; }
                        if (pass) { u32x4 w; w.x = cvt_pk(o2[0].x, o2[0].y); w.y = cvt_pk(o2[0].z, o2[0].w); w.z = cvt_pk(o2[1].x, o2[1].y); w.w = cvt_pk(o2[1].z, o2[1].w);
                            *(u32x4*)(Y + rowg * D + g * 128 + 64 * half + 32 * np + 8 * fq) = w; }
                    }
                    if (!pass) { s += __shfl_xor(s, 16); s += __shfl_xor(s, 32); if (fq == 0) red2[(16 * m + fr) * 8 + wid] = s; }
                }
                if (!pass) __syncthreads();
            }
        }
    }
    __syncthreads();
}

__device__ __forceinline__ void final_norm(const Params& p, int G) {
    int tid_ = threadIdx.x; asm volatile("" : "+v"(tid_));
    const int tid = tid_, lane = tid & 63, wid = tid >> 6; const int gw = blockIdx.x * 8 + wid, NGW = G * 8;
    const f32x4* gp = (const f32x4*)p.in[19] + lane; f32x4 gg[4];
#pragma unroll
    for (int j = 0; j < 4; ++j) gg[j] = gp[64 * j];
    for (int m = gw; m < M; m += NGW) {
        f32x4* xr = (f32x4*)(p.out + (size_t)m * D) + lane; f32x4 v[4]; float s = 0.f;
#pragma unroll
        for (int j = 0; j < 4; ++j) { v[j] = xr[64 * j]; s += (v[j].x * v[j].x + v[j].y * v[j].y) + (v[j].z * v[j].z + v[j].w * v[j].w); }
        const float rs = 1.0f / sqrtf(wave_sum(s) * (1.0f / D) + EPS);
#pragma unroll
        for (int j = 0; j < 4; ++j) xr[64 * j] = v[j] * rs * gg[j];
    }
}

#define XB_TMO      128
#define XB_XCNT(j)  (256  + 64 * (j))
#define XB_XSUB(j)  (1280 + 64 * (j))
#define XB_XGEN(j)  (2304 + 64 * (j))
#define XB_TOP      3328
#define XB_TOPGEN   3392
#define XCD_BAR_WORDS 3456
#define XB_SPIN_CAP (1u << 18)

__device__ __forceinline__ unsigned xb_ld(unsigned* p)              { return __hip_atomic_load(p, __ATOMIC_RELAXED, __HIP_MEMORY_SCOPE_AGENT); }
__device__ __forceinline__ unsigned xb_add(unsigned* p, unsigned v) { return __hip_atomic_fetch_add(p, v, __ATOMIC_RELAXED, __HIP_MEMORY_SCOPE_AGENT); }
__device__ __forceinline__ unsigned xb_xcc_id() { return (unsigned)__builtin_amdgcn_s_getreg((3 << 11) | 20) & 0xFu; }
#define XB_SPIN(cond, bar) do { unsigned _sp = 0; while (cond) { __builtin_amdgcn_s_sleep(1); \
    if ((++_sp & 255u) == 0u) { if (xb_ld(&(bar)[XB_TMO])) break; if (_sp > XB_SPIN_CAP) { atomicAdd(&(bar)[XB_TMO], 1u); break; } } } } while (0)

struct XcdBarrier {
    unsigned* bar; unsigned x;
    volatile LAS unsigned* st;
};

__device__ __forceinline__ XcdBarrier xcd_barrier_post(unsigned* bar, volatile LAS unsigned* st) {
    XcdBarrier b; b.bar = bar; b.x = xb_xcc_id(); b.st = st;
    if (threadIdx.x == 0) (void)xb_add(&bar[XB_XCNT(b.x)], 1u);
    return b;
}
__device__ __forceinline__ void xcd_barrier_complete(unsigned* bar, unsigned x, unsigned& nloc, unsigned& nx) {
    const unsigned G = gridDim.x * gridDim.y * gridDim.z;
    unsigned sum, cnt, mine, sp = 0u;
    for (;;) {
        sum = 0u; cnt = 0u; mine = 0u;
#pragma unroll
        for (unsigned j = 0; j < 16; ++j) { const unsigned c = xb_ld(&bar[XB_XCNT(j)]); sum += c; cnt += (c > 0u) ? 1u : 0u; mine = (j == x) ? c : mine; }
        if (sum == G) break;
        __builtin_amdgcn_s_sleep(1);
        if ((++sp & 255u) == 0u) { if (xb_ld(&bar[XB_TMO])) break; if (sp > XB_SPIN_CAP) { atomicAdd(&bar[XB_TMO], 1u); break; } }
    }
    nloc = mine > 0u ? mine : 1u; nx = cnt > 0u ? cnt : 1u;
}

__device__ __forceinline__ void xcd_barrier(const XcdBarrier& b) {
    asm volatile("s_waitcnt vmcnt(0)" ::: "memory");
    __syncthreads();
    if (threadIdx.x == 0) {
        unsigned* bar = b.bar;
        __builtin_amdgcn_s_waitcnt(0);
        unsigned nloc = b.st[0], nx = b.st[1];
        if (nloc == 0u) { xcd_barrier_complete(bar, b.x, nloc, nx); b.st[0] = nloc; b.st[1] = nx; }
        const unsigned old = xb_add(&bar[XB_XSUB(b.x)], 1u);
        const unsigned gen = old / nloc;
        if (old + 1u == (gen + 1u) * nloc) {
            __builtin_amdgcn_fence(__ATOMIC_RELEASE, "agent");
            asm volatile("s_waitcnt vmcnt(0)" ::: "memory");
            const unsigned og = xb_add(&bar[XB_TOP], 1u);
            const unsigned tg = og / nx;
            if (og + 1u == (tg + 1u) * nx) xb_add(&bar[XB_TOPGEN], 1u);
            else XB_SPIN(xb_ld(&bar[XB_TOPGEN]) == tg, bar);
            __builtin_amdgcn_fence(__ATOMIC_ACQUIRE, "agent");
            xb_add(&bar[XB_XGEN(b.x)], 1u);
            asm volatile("s_waitcnt vmcnt(0)" ::: "memory");
        } else {
            XB_SPIN(xb_ld(&bar[XB_XGEN(b.x)]) == gen, bar);
            __builtin_amdgcn_fence(__ATOMIC_ACQUIRE, "agent");
            asm volatile("s_waitcnt vmcnt(0)" ::: "memory");
        }
    }
    __syncthreads();
}

#ifndef PROBE_SYNC2
#define PROBE_SYNC2 0
#endif
#ifndef PROBE_M1X2
#define PROBE_M1X2 0
#endif
#ifndef PROBE_M2X2
#define PROBE_M2X2 0
#endif
#define GSYNC() do { xcd_barrier(xbar); if (PROBE_SYNC2) xcd_barrier(xbar); } while (0)
__global__ void __launch_bounds__(512, 2) fwd_megakernel(Params p) {
    extern __shared__ __attribute__((aligned(16))) unsigned char lds_raw[];
    LAS unsigned char* lds = (LAS unsigned char*)lds_raw;
    cg::grid_group grid = cg::this_grid();
    const int G = gridDim.x;
    unsigned char* ws = p.ws;
    volatile LAS unsigned* xst = (volatile LAS unsigned*)(lds + 131072 + 1024);
    if (threadIdx.x < 2) xst[threadIdx.x] = 0u;
    __syncthreads();
    XcdBarrier xbar = xcd_barrier_post((unsigned*)(ws + WS_CTL), xst);
    bf16* hb = (bf16*)(ws + WS_HB); bf16* proj = (bf16*)(ws + WS_PROJ); bf16* Y = (bf16*)(ws + WS_Y); bf16* mid = (bf16*)(ws + WS_MID); float* ss = (float*)(ws + WS_SS);
#ifndef NO_PRO
    prologue(p, lds, G);
#endif
    grid.sync();
#pragma unroll 1
    for (int l = 0; l < DEPTH; ++l) {
        const unsigned char* wl = ws + WS_W + (size_t)l * W_LAYER;
        const bf16* in_t = (const bf16*)(wl + W_IN); const bf16* out_t = (const bf16*)(wl + W_OUT); const bf16* up_t = (const bf16*)(wl + W_UP); const bf16* down_t = (const bf16*)(wl + W_DOWN);
#ifndef NO_GIN
        { pg8::Gemm g{hb, in_t, M, DIN, D, 0}; pg8::StaticOrder S; S.init(M, DIN, G, (int)blockIdx.x); EpiIn E{proj, ss};
          pg8::gemm_phase<EpiIn, pg8::StaticOrder, true, true>(lds, g, S, E); }
#endif
#ifndef NO_META
        meta_tasks<0>(p, lds, G, nullptr, 0, in_t, D, DIN / 16);
#endif
        GSYNC();
#ifndef NO_M1
        m1_phase(p, lds, G, l);
        if (PROBE_M1X2) m1_phase(p, lds, G, l);
#endif
        GSYNC();
#ifndef NO_M2
        m2_phase(p, lds, G, l);
        if (PROBE_M2X2) m2_phase(p, lds, G, l);
#endif
        GSYNC();
#ifndef NO_GOUT
        { pg8::Gemm g{Y, out_t, M, D, D, NMETA}; pg8::StaticOrder S; S.init(M, D, G, (int)blockIdx.x); EpiRes E{l == 0 ? p.in[0] : p.out, p.out, hb, ss};
          pg8::gemm_phase<EpiRes, pg8::StaticOrder, false, true>(lds, g, S, E); }
#endif
#ifndef NO_META
        if (l < DEPTH - 1) meta_tasks<1>(p, lds, G, Y, D, out_t, D, D / 16);
#endif
        GSYNC();
#ifndef NO_GUP
        { pg8::Gemm g{hb, up_t, M, FF, D, 0}; pg8::StaticOrder S; S.init(M, FF, G, (int)blockIdx.x); EpiUp E{mid, ss};
          pg8::gemm_phase<EpiUp, pg8::StaticOrder, true, true>(lds, g, S, E); }
#endif
#ifndef NO_META
        if (l < DEPTH - 1) meta_tasks<2>(p, lds, G, nullptr, 0, up_t, D, FF / 16);
#endif
        GSYNC();
#ifndef NO_GDN
        { pg8::Gemm g{mid, down_t, M, D, FF, 0}; pg8::StaticOrder S; S.init(M, D, G, (int)blockIdx.x); EpiRes E{p.out, p.out, hb, ss};
          pg8::gemm_phase<EpiRes, pg8::StaticOrder, false, true>(lds, g, S, E); }
#endif
#ifndef NO_META
        if (l < DEPTH - 1) meta_tasks<1>(p, lds, G, (const bf16*)(ws + WS_MIDMETA), FF, down_t, FF, D / 16);
#endif
        GSYNC();
    }
    final_norm(p, G);
}

extern "C" void kernel_launch(void* const* d_in, const int* in_sizes, int n_in, void* d_out, int out_size, void* d_ws, size_t ws_size, hipStream_t stream) {
    static int grid = 0;
    if (grid == 0) {
        if (n_in != 20 || in_sizes[0] != M * D || out_size != M * D || ws_size < WS_END) { fprintf(stderr, "kernel_launch: unexpected shapes (n_in %d, in0 %d, out %d, ws %zu)\n", n_in, n_in > 0 ? in_sizes[0] : -1, out_size, ws_size); grid = -1; return; }
        int dev = 0, cus = 0, per_cu = 0;
        if (hipGetDevice(&dev) != hipSuccess || hipDeviceGetAttribute(&cus, hipDeviceAttributeMultiprocessorCount, dev) != hipSuccess) { grid = -1; return; }
        if (hipFuncSetAttribute((const void*)fwd_megakernel, hipFuncAttributeMaxDynamicSharedMemorySize, LDS_BYTES) != hipSuccess) { fprintf(stderr, "kernel_launch: hipFuncSetAttribute failed\n"); grid = -1; return; }
        if (hipOccupancyMaxActiveBlocksPerMultiprocessor(&per_cu, (const void*)fwd_megakernel, 512, LDS_BYTES) != hipSuccess || per_cu < 1) { fprintf(stderr, "kernel_launch: occupancy query gave %d\n", per_cu); (void)hipGetLastError(); grid = -1; return; }
        grid = cus * 1;
    }
    if (grid < 0) return;
    if (hipMemsetAsync((char*)d_ws + WS_CTL, 0, XCD_BAR_WORDS * 4, stream) != hipSuccess) { fprintf(stderr, "kernel_launch: memset failed\n"); return; }
    Params p{};
    for (int i = 0; i < 20; ++i) p.in[i] = (const float*)d_in[i];
    p.out = (float*)d_out; p.ws = (unsigned char*)d_ws;
    void* args[] = {&p};
    hipError_t e = hipLaunchCooperativeKernel((const void*)fwd_megakernel, dim3(grid), dim3(512), args, LDS_BYTES, stream);
    if (e != hipSuccess) fprintf(stderr, "cooperative launch failed: %s (grid %d)\n", hipGetErrorString(e), grid);
}
```

```cpp
#include <hip/hip_runtime.h>
#include <hip/hip_cooperative_groups.h>
#include <cstdio>
#include <cstdint>
namespace cg = cooperative_groups;
namespace pg8 {
#define PG8_LAS __attribute__((address_space(3)))
typedef unsigned short bf16_t;
typedef short bf16x8 __attribute__((ext_vector_type(8)));
typedef float f32x4 __attribute__((ext_vector_type(4)));
typedef unsigned u32x4 __attribute__((ext_vector_type(4)));
constexpr int BM = 256, BK = 64, HALF = 128, HTB = HALF * BK * 2  , STAGE_BYTES = 8 * HTB, NXCD = 8, WGM = 8;

__host__ __device__ __forceinline__ int lds_byte(int r, int c) { const int st = (r >> 4) * 2 + (c >> 5), rr = r & 15, cc = c & 31, ob = rr * 64 + cc * 2; return st * 1024 + (ob ^ (((ob >> 9) & 1) << 5)); }
__host__ __device__ __forceinline__ void stage_rc(int b, int& R, int& C) { const int st = b / 1024, sb = b % 1024, swz = sb ^ (((sb >> 9) & 1) << 5); R = (st >> 1) * 16 + swz / 64; C = (st & 1) * 32 + (swz % 64) / 2; }
__host__ __device__ __forceinline__ int perm32(int rho) { const int n = rho >> 4, i = rho & 15; return 8 * (i >> 2) + 4 * n + (i & 3); }

struct Unit { int pm, pn; };
struct Gemm { const bf16_t* A; const bf16_t* Bt; int M, N, K, gap; };

struct StaticOrder {
    int nM, nN, nwg, G, c;
    __host__ __device__ void init(int M, int N, int G_, int c_) { nM = M / BM; nN = N / BM; nwg = nM * nN; G = G_; c = c_; }
    __host__ __device__ bool next(int i, Unit& u) const {
        const long L = (long)i * G + c; if (L >= nwg) return false;
        int wgid = (int)L; { const int q = nwg / NXCD, r = nwg % NXCD, xcd = wgid % NXCD, off = wgid / NXCD; wgid = (xcd < r ? xcd * (q + 1) : r * (q + 1) + (xcd - r) * q) + off; }
        const int nig = WGM * nN, gid = wgid / nig, fm = gid * WGM, gsz = (nM - fm) < WGM ? (nM - fm) : WGM;
        u.pm = fm + ((wgid % nig) % gsz); u.pn = (wgid % nig) / gsz; return true;
    }
    __device__ __forceinline__ void a_ready(const Unit&) const {}
    __device__ __forceinline__ void done(const Unit&) const {}
};
__device__ __forceinline__ unsigned cvt_pk_bf16(float lo, float hi) { unsigned r; asm volatile("v_cvt_pk_bf16_f32 %0, %1, %2" : "=v"(r) : "v"(lo), "v"(hi)); return r; }
template <class Epi, class Sched, bool ALIGN_EPI = false, bool SP2 = false>
__device__ __forceinline__ void gemm_phase(PG8_LAS unsigned char* lds, const Gemm g, const Sched& S, const Epi& E) {
    int tid_ = threadIdx.x; asm volatile("" : "+v"(tid_));
    const int tid = tid_, wid = __builtin_amdgcn_readfirstlane(tid >> 6), lane = tid & 63, wr = wid >> 2, wc = wid & 3, fr = lane & 15, fq = lane >> 4;
    const int K = g.K, nt = K / BK;
    unsigned voffA[2], voffB[2];
#pragma unroll
    for (int i = 0; i < 2; ++i) { int R, C; stage_rc(tid * 16 + i * 8192, R, C); const int Rb = Epi::PERM ? ((R & ~31) + perm32(R & 31)) : R;
        voffA[i] = (unsigned)(R * K + C) * 2u; voffB[i] = (unsigned)(Rb * K + C) * 2u; }
    const size_t kstep = (size_t)(BK * 2);
    const size_t hstep = (size_t)HALF * K * 2;
    const size_t tstep = 2 * hstep;
    const int agap = g.gap;
#define a_off(pm_) ((size_t)((pm_) * BM + agap * (1 + ((pm_) >> 5))) * (size_t)K * 2)
    const unsigned ldsw = (unsigned)wid * 1024u;
    const int aoff = lds_byte(wr * 64 + fr, fq * 8), boff = lds_byte(wc * 32 + fr, fq * 8);
#define PG8_SA(b, h) (((b) * 2 + (h)) * HTB)
#define PG8_SB(b, h) ((4 + (b) * 2 + (h)) * HTB)
#define PG8_STAGE(bufoff, gbase, voff) do { _Pragma("unroll") for (int _i = 0; _i < 2; ++_i) \
        __builtin_amdgcn_global_load_lds((const unsigned*)((const char*)(gbase) + (voff)[_i]), (PG8_LAS unsigned*)(lds + (bufoff) + ldsw + _i * 8192), 16, 0, 0); } while (0)
#define PG8_LDA(dst, b, h) do { _Pragma("unroll") for (int m = 0; m < 4; ++m) _Pragma("unroll") for (int k = 0; k < 2; ++k) dst[m][k] = *(const PG8_LAS bf16x8*)(lds + PG8_SA(b, h) + aoff + m * 2048 + k * 1024); } while (0)
#define PG8_LDB(dst, b, h) do { _Pragma("unroll") for (int n = 0; n < 2; ++n) _Pragma("unroll") for (int k = 0; k < 2; ++k) dst[n][k] = *(const PG8_LAS bf16x8*)(lds + PG8_SB(b, h) + boff + n * 2048 + k * 1024); } while (0)
#define PG8_MMA(ai, bj, At, Bt) do { __builtin_amdgcn_s_setprio(1); _Pragma("unroll") for (int m = 0; m < 4; ++m) _Pragma("unroll") for (int n = 0; n < 2; ++n) _Pragma("unroll") for (int k = 0; k < 2; ++k) \
        acc[ai][bj][m][n] = __builtin_amdgcn_mfma_f32_16x16x32_bf16(Bt[n][k], At[m][k], acc[ai][bj][m][n], 0, 0, 0); __builtin_amdgcn_s_setprio(0); } while (0)
#define PG8_WAIT_V(n) asm volatile("s_waitcnt vmcnt(" #n ")" ::: "memory")
#define PG8_WAIT_L(n) asm volatile("s_waitcnt lgkmcnt(" #n ")" ::: "memory")
#define PG8_BAR __builtin_amdgcn_s_barrier()
#define PG8_SCHED __builtin_amdgcn_sched_barrier(0)
    Unit cur, nxt; int ui = 0;
    if (!S.next(0, cur)) return;
    f32x4 acc[2][2][4][2];
#pragma unroll
    for (int a = 0; a < 2; ++a)
#pragma unroll
        for (int b = 0; b < 2; ++b)
#pragma unroll
            for (int m = 0; m < 4; ++m)
#pragma unroll
                for (int n = 0; n < 2; ++n) acc[a][b][m][n] = (f32x4){0.f, 0.f, 0.f, 0.f};
    bf16x8 At[4][2], B0[2][2], B1[2][2];
    const char* cA = (const char*)g.A + a_off(cur.pm); const char* cB = (const char*)g.Bt + (size_t)cur.pn * tstep;
    S.a_ready(cur);
    if constexpr (SP2) {
        PG8_STAGE(PG8_SB(0, 0), cB, voffB); PG8_STAGE(PG8_SB(0, 1), cB + hstep, voffB); PG8_STAGE(PG8_SA(0, 0), cA, voffA); PG8_STAGE(PG8_SA(0, 1), cA + hstep, voffA);
        if (wr == 1) PG8_BAR;
        PG8_WAIT_V(2); PG8_BAR;
        PG8_STAGE(PG8_SB(1, 0), cB + kstep, voffB); PG8_STAGE(PG8_SA(1, 0), cA + kstep, voffA); PG8_STAGE(PG8_SB(1, 1), cB + hstep + kstep, voffB);
        PG8_WAIT_V(6); PG8_BAR;
    } else {
        PG8_STAGE(PG8_SB(0, 0), cB, voffB); PG8_STAGE(PG8_SA(0, 0), cA, voffA); PG8_STAGE(PG8_SB(0, 1), cB + hstep, voffB); PG8_STAGE(PG8_SA(0, 1), cA + hstep, voffA);
        if (wr == 1) PG8_BAR;
        PG8_WAIT_V(4); PG8_BAR;
        PG8_STAGE(PG8_SB(1, 0), cB + kstep, voffB); PG8_STAGE(PG8_SA(1, 0), cA + kstep, voffA); PG8_STAGE(PG8_SB(1, 1), cB + hstep + kstep, voffB);
        PG8_WAIT_V(6); PG8_BAR;
    }
    for (;;) {
        const bool has_next = S.next(ui + 1, nxt);
        const char* nA = has_next ? (const char*)g.A + a_off(nxt.pm) : cA; const char* nB = has_next ? (const char*)g.Bt + (size_t)nxt.pn * tstep : cB;
        for (int t = 0; t < nt; t += 2) {
            const bool last = (t == nt - 2);
            const char* a1 = cA + (size_t)(t + 1) * kstep;
            const char* a2 = last ? nA : cA + (size_t)(t + 2) * kstep; const char* b2 = last ? nB : cB + (size_t)(t + 2) * kstep;
            const char* a3 = a2 + kstep; const char* b3 = b2 + kstep;
            if (last && has_next) S.a_ready(nxt);
            if constexpr (SP2) {
            PG8_LDB(B0, 0, 0); PG8_LDB(B1, 0, 1); PG8_SCHED; PG8_LDA(At, 0, 0); PG8_STAGE(PG8_SA(1, 1), a1 + hstep, voffA);
            PG8_WAIT_V(8); PG8_WAIT_L(0); PG8_BAR; PG8_MMA(0, 0, At, B0); PG8_MMA(0, 1, At, B1); PG8_BAR; PG8_SCHED;
            PG8_LDA(At, 0, 1); PG8_STAGE(PG8_SB(0, 0), b2, voffB); PG8_STAGE(PG8_SB(0, 1), b2 + hstep, voffB); PG8_STAGE(PG8_SA(0, 0), a2, voffA);
            PG8_WAIT_V(8); PG8_WAIT_L(0); PG8_BAR; PG8_MMA(1, 0, At, B0); PG8_MMA(1, 1, At, B1); PG8_BAR; PG8_SCHED;
            PG8_LDB(B0, 1, 0); PG8_LDB(B1, 1, 1); PG8_SCHED; PG8_LDA(At, 1, 0); PG8_STAGE(PG8_SA(0, 1), a2 + hstep, voffA);
            PG8_WAIT_V(8); PG8_WAIT_L(0); PG8_BAR; PG8_MMA(0, 0, At, B0); PG8_MMA(0, 1, At, B1); PG8_BAR; PG8_SCHED;
            PG8_LDA(At, 1, 1); PG8_STAGE(PG8_SB(1, 0), b3, voffB); PG8_STAGE(PG8_SB(1, 1), b3 + hstep, voffB); PG8_STAGE(PG8_SA(1, 0), a3, voffA);
            PG8_WAIT_V(8); PG8_WAIT_L(0); PG8_BAR; PG8_MMA(1, 0, At, B0); PG8_MMA(1, 1, At, B1); PG8_BAR; PG8_SCHED;
            } else {
            PG8_LDB(B0, 0, 0); PG8_SCHED; PG8_LDA(At, 0, 0); PG8_STAGE(PG8_SA(1, 1), a1 + hstep, voffA);
            PG8_WAIT_L(8); PG8_BAR; PG8_WAIT_L(0); PG8_MMA(0, 0, At, B0); PG8_BAR; PG8_SCHED;
            PG8_LDB(B1, 0, 1); PG8_STAGE(PG8_SB(0, 0), b2, voffB);
            PG8_BAR; PG8_WAIT_L(0); PG8_MMA(0, 1, At, B1); PG8_BAR;
            PG8_LDA(At, 0, 1); PG8_STAGE(PG8_SA(0, 0), a2, voffA);
            PG8_BAR; PG8_WAIT_L(0); PG8_MMA(1, 0, At, B0); PG8_BAR; PG8_SCHED;
            PG8_STAGE(PG8_SB(0, 1), b2 + hstep, voffB);
            PG8_WAIT_V(6); PG8_BAR; PG8_MMA(1, 1, At, B1); PG8_BAR;
            PG8_LDB(B0, 1, 0); PG8_SCHED; PG8_LDA(At, 1, 0); PG8_STAGE(PG8_SA(0, 1), a2 + hstep, voffA);
            PG8_WAIT_L(8); PG8_BAR; PG8_WAIT_L(0); PG8_MMA(0, 0, At, B0); PG8_BAR; PG8_SCHED;
            PG8_LDB(B1, 1, 1); PG8_STAGE(PG8_SB(1, 0), b3, voffB);
            PG8_BAR; PG8_WAIT_L(0); PG8_MMA(0, 1, At, B1); PG8_BAR;
            PG8_LDA(At, 1, 1); PG8_STAGE(PG8_SA(1, 0), a3, voffA);
            PG8_BAR; PG8_WAIT_L(0); PG8_MMA(1, 0, At, B0); PG8_BAR; PG8_SCHED;
            PG8_STAGE(PG8_SB(1, 1), b3 + hstep, voffB);
            PG8_WAIT_V(6); PG8_BAR; PG8_MMA(1, 1, At, B1); PG8_BAR;
            }
        }
        if constexpr (ALIGN_EPI) { if (wr == 0) PG8_BAR; }
        if constexpr (!Epi::AFTER_DRAIN) { E(acc, cur, wr, wc, fr, fq); S.done(cur); }
        if (!has_next) break;
#pragma unroll
        for (int a = 0; a < 2; ++a)
#pragma unroll
            for (int b = 0; b < 2; ++b)
#pragma unroll
                for (int m = 0; m < 4; ++m)
#pragma unroll
                    for (int n = 0; n < 2; ++n) acc[a][b][m][n] = (f32x4){0.f, 0.f, 0.f, 0.f};
        cur = nxt; cA = nA; cB = nB; ++ui;
        if constexpr (ALIGN_EPI) { if (wr == 1) PG8_BAR; }
    }
    PG8_WAIT_V(0);
    if constexpr (!ALIGN_EPI) { if (wr == 0) PG8_BAR; }
    PG8_BAR;
    if constexpr (Epi::AFTER_DRAIN) { E.fused(acc, cur, wr, wc, fr, fq, lds, wid, lane); S.done(cur); }
#undef PG8_SA
#undef PG8_SB
#undef PG8_STAGE
#undef PG8_LDA
#undef PG8_LDB
#undef PG8_MMA
#undef PG8_WAIT_V
#undef PG8_WAIT_L
#undef PG8_BAR
#undef PG8_SCHED
}
}

#define LAS __attribute__((address_space(3)))
typedef unsigned short bf16;
typedef unsigned u32x4 __attribute__((ext_vector_type(4)));
typedef unsigned u32x2 __attribute__((ext_vector_type(2)));
typedef float f32x4 __attribute__((ext_vector_type(4)));
typedef short bf16x8 __attribute__((ext_vector_type(8)));
constexpr int D = 1024, SEQ = 8192, NB = 2, NMETA = 16, TT = SEQ + NMETA, M = NB * SEQ, DEPTH = 4, DIN = 1536, FF = 4096, DH = 512;
constexpr float EPS = 1e-6f;
constexpr size_t MiB = 1u << 20;
constexpr size_t WS_CTL = 0;
constexpr size_t WS_POOLW = 1 * MiB, WS_GR = WS_POOLW + 512 * 1024, WS_GI = WS_GR + 256 * 1024;
constexpr size_t WS_SP = 2 * MiB, WS_HMETA = WS_SP + 64 * 1024, WS_MIDMETA = WS_HMETA + 64 * 1024;
constexpr size_t WS_SS = 3 * MiB, WS_CARA = 4 * MiB, WS_CARH = WS_CARA + 512 * 1024;
constexpr size_t WS_W = 8 * MiB, W_LAYER = 21 * MiB, W_IN = 0, W_OUT = 3 * MiB, W_UP = 5 * MiB, W_DOWN = 13 * MiB;
constexpr size_t WS_HB = 92 * MiB, WS_MID = 124 * MiB;
constexpr size_t WS_PROJ = WS_MID, WS_Y = WS_MID + 48 * MiB + 256 * 1024, WS_HL = WS_Y + 32 * MiB + 256 * 1024, WS_P = WS_HL + 32 * MiB + 256 * 1024, WS_END = 256 * MiB;
static_assert(WS_PROJ + (size_t)NB * TT * DIN * 2 <= WS_Y && WS_Y + (size_t)NB * TT * D * 2 <= WS_HL && WS_HL + (size_t)NB * TT * DH * 4 <= WS_P && WS_P + (size_t)NB * TT * DH * 2 <= WS_END, "ws map");
static_assert(WS_W + DEPTH * W_LAYER <= WS_HB && WS_HB + (size_t)M * D * 2 <= WS_MID && WS_MID + (size_t)M * FF * 2 <= WS_END, "ws map 2");
constexpr int LDS_XST = 147456;
constexpr int LDS_BYTES = 147456 + 1024;

struct Params {
    const float* in[20];
    float* out;
    unsigned char* ws;
};

__device__ __forceinline__ unsigned cvt_pk(float lo, float hi) { return pg8::cvt_pk_bf16(lo, hi); }
__device__ __forceinline__ float bf_lo(unsigned w) { return __builtin_bit_cast(float, w << 16); }
__device__ __forceinline__ float bf_hi(unsigned w) { return __builtin_bit_cast(float, w & 0xffff0000u); }
__device__ __forceinline__ void unpack8(const u32x4 w, float (&f)[8]) {
    f[0] = bf_lo(w.x); f[1] = bf_hi(w.x); f[2] = bf_lo(w.y); f[3] = bf_hi(w.y); f[4] = bf_lo(w.z); f[5] = bf_hi(w.z); f[6] = bf_lo(w.w); f[7] = bf_hi(w.w);
}
__device__ __forceinline__ u32x4 pack8(const float (&f)[8]) { u32x4 w; w.x = cvt_pk(f[0], f[1]); w.y = cvt_pk(f[2], f[3]); w.z = cvt_pk(f[4], f[5]); w.w = cvt_pk(f[6], f[7]); return w; }
__device__ __forceinline__ float wave_sum(float v) {
#pragma unroll
    for (int o = 1; o < 64; o <<= 1) v += __shfl_xor(v, o);
    return v;
}
template <int CTRL> __device__ __forceinline__ float dppf(float old, float src) {
    return __builtin_bit_cast(float, __builtin_amdgcn_update_dpp(__builtin_bit_cast(int, old), __builtin_bit_cast(int, src), CTRL, 0xf, 0xf, false));
}
template <int DD> __device__ __forceinline__ float shiftd(float cur, float prev) {
    const float t = dppf<0x100 + (16 - DD)>(0.f, prev);
    return dppf<0x110 + DD>(t, cur);
}
__device__ __forceinline__ float sigm(float v) { return __builtin_amdgcn_rcpf(1.0f + __expf(-v)); }
__device__ __forceinline__ int outchan(int n, int rho) { return 32 * (n >> 1) + 8 * (rho >> 2) + 4 * (n & 1) + (rho & 3); }

__device__ __forceinline__ float row_rstd(const float* ss, int r) {
    const f32x4* s4 = (const f32x4*)(ss + (size_t)r * 16);
    const f32x4 a = s4[0], b = s4[1], c = s4[2], d = s4[3];
    const float s = ((a.x + a.y) + (a.z + a.w)) + ((b.x + b.y) + (b.z + b.w)) + ((c.x + c.y) + (c.z + c.w)) + ((d.x + d.y) + (d.z + d.w));
    return 1.0f / sqrtf(s * (1.0f / D) + EPS);
}
__device__ __forceinline__ void rows_rstd(const float* ss, int rowbase  , int fr, float (&rs)[2][4]) {
    const int lane = threadIdx.x & 63;
    const float r0 = row_rstd(ss, rowbase + lane), r1 = row_rstd(ss, rowbase + 128 + lane);
#pragma unroll
    for (int m = 0; m < 4; ++m) { rs[0][m] = __shfl(r0, m * 16 + fr); rs[1][m] = __shfl(r1, m * 16 + fr); }
}
struct EpiIn {
    static constexpr bool PERM = true, AFTER_DRAIN = false;
    bf16* P; const float* ss;
    __device__ __forceinline__ void operator()(const f32x4 (&acc)[2][2][4][2], const pg8::Unit& u, int wr, int wc, int fr, int fq) const {
        const int row0 = u.pm * 256 + wr * 64 + fr, col0 = u.pn * 256 + wc * 32 + 8 * fq;
        float rsv[2][4]; rows_rstd(ss, u.pm * 256 + wr * 64, fr, rsv);
#pragma unroll
        for (int ai = 0; ai < 2; ++ai)
#pragma unroll
            for (int m = 0; m < 4; ++m) {
                const int r = row0 + ai * 128 + m * 16; const float rs = rsv[ai][m];
                bf16* rowp = P + (size_t)(r + NMETA * (1 + (r >> 13))) * DIN + col0;
#pragma unroll
                for (int bj = 0; bj < 2; ++bj) { const f32x4 v0 = acc[ai][bj][m][0] * rs, v1 = acc[ai][bj][m][1] * rs;
                    u32x4 w; w.x = cvt_pk(v0[0], v0[1]); w.y = cvt_pk(v0[2], v0[3]); w.z = cvt_pk(v1[0], v1[1]); w.w = cvt_pk(v1[2], v1[3]);
                    *(u32x4*)(rowp + bj * 128) = w; }
            }
    }
};
struct EpiUp {
    static constexpr bool PERM = true, AFTER_DRAIN = false;
    bf16* O; const float* ss;
    __device__ __forceinline__ void operator()(const f32x4 (&acc)[2][2][4][2], const pg8::Unit& u, int wr, int wc, int fr, int fq) const {
        const int row0 = u.pm * 256 + wr * 64 + fr, col0 = u.pn * 256 + wc * 32 + 8 * fq;
        float rsv[2][4]; rows_rstd(ss, u.pm * 256 + wr * 64, fr, rsv);
#pragma unroll
        for (int ai = 0; ai < 2; ++ai)
#pragma unroll
            for (int m = 0; m < 4; ++m) {
                const int r = row0 + ai * 128 + m * 16; const float rs = rsv[ai][m];
                bf16* rowp = O + (size_t)r * FF + col0;
#pragma unroll
                for (int bj = 0; bj < 2; ++bj) { f32x4 v0 = acc[ai][bj][m][0] * rs, v1 = acc[ai][bj][m][1] * rs;
#pragma unroll
                    for (int j = 0; j < 4; ++j) { v0[j] = fmaxf(v0[j], 0.f); v0[j] *= v0[j]; v1[j] = fmaxf(v1[j], 0.f); v1[j] *= v1[j]; }
                    u32x4 w; w.x = cvt_pk(v0[0], v0[1]); w.y = cvt_pk(v0[2], v0[3]); w.z = cvt_pk(v1[0], v1[1]); w.w = cvt_pk(v1[2], v1[3]);
                    *(u32x4*)(rowp + bj * 128) = w; }
            }
    }
};
struct EpiRes {
    static constexpr bool PERM = true, AFTER_DRAIN = false;
    const float* base; float* out; bf16* hb; float* ssn;
    __device__ __forceinline__ void operator()(const f32x4 (&acc)[2][2][4][2], const pg8::Unit& u, int wr, int wc, int fr, int fq) const {
        const int row0 = u.pm * 256 + wr * 64 + fr, col0 = u.pn * 256 + wc * 32 + 8 * fq;
#pragma unroll
        for (int ai = 0; ai < 2; ++ai)
#pragma unroll
            for (int m = 0; m < 4; ++m) {
                const int r = row0 + ai * 128 + m * 16; const size_t off = (size_t)r * D + col0; float s = 0.f;
#pragma unroll
                for (int bj = 0; bj < 2; ++bj) {
                    const f32x4 b0 = *(const f32x4*)(base + off + bj * 128), b1 = *(const f32x4*)(base + off + bj * 128 + 4);
                    const f32x4 o0 = b0 + acc[ai][bj][m][0], o1 = b1 + acc[ai][bj][m][1];
                    *(f32x4*)(out + off + bj * 128) = o0; *(f32x4*)(out + off + bj * 128 + 4) = o1;
                    s += (o0[0] * o0[0] + o0[1] * o0[1]) + (o0[2] * o0[2] + o0[3] * o0[3]) + (o1[0] * o1[0] + o1[1] * o1[1]) + (o1[2] * o1[2] + o1[3] * o1[3]);
                    u32x4 w; w.x = cvt_pk(o0[0], o0[1]); w.y = cvt_pk(o0[2], o0[3]); w.z = cvt_pk(o1[0], o1[1]); w.w = cvt_pk(o1[2], o1[3]);
                    *(u32x4*)(hb + off + bj * 128) = w; }
                s += __shfl_xor(s, 16); s += __shfl_xor(s, 32);
                if (fq == 0) ssn[(size_t)r * 16 + u.pn * 4 + wc] = s;
                if (m & 1) asm volatile("" ::: "memory");
            }
    }
};

__device__ __forceinline__ void transpose_item(const float* W, const float* gk, int K, int N, bf16* WT, LAS float* scr, int item, int lane) {
    const int nblk = N / 32, kb = item / nblk, nb = item % nblk, k0 = 64 * kb, n0 = 32 * nb;
#pragma unroll 8
    for (int i = 0; i < 32; ++i) { const int kk = 2 * i + (lane >> 5); float v = W[(size_t)(k0 + kk) * N + n0 + (lane & 31)]; if (gk) v *= gk[k0 + kk]; scr[kk * 33 + (lane & 31)] = v; }
    asm volatile("s_waitcnt lgkmcnt(0)" ::: "memory");
    const int c = lane & 7;
#pragma unroll
    for (int j = 0; j < 4; ++j) { const int n = (lane >> 3) + 8 * j; const LAS float* s = scr + (8 * c) * 33 + n;
        u32x4 o; o.x = cvt_pk(s[0 * 33], s[1 * 33]); o.y = cvt_pk(s[2 * 33], s[3 * 33]); o.z = cvt_pk(s[4 * 33], s[5 * 33]); o.w = cvt_pk(s[6 * 33], s[7 * 33]);
        *(u32x4*)(WT + (size_t)(n0 + n) * K + k0 + 8 * c) = o; }
    asm volatile("s_waitcnt lgkmcnt(0)" ::: "memory");
}
__device__ __forceinline__ void prologue(const Params& p, LAS unsigned char* lds, int G) {
    int tid_ = threadIdx.x; asm volatile("" : "+v"(tid_));
    const int tid = tid_, lane = tid & 63, wid = __builtin_amdgcn_readfirstlane(tid >> 6);
    LAS float* scr = (LAS float*)(lds + wid * 16384);
    const int gw = blockIdx.x * 8 + wid, NGW = G * 8;
    constexpr int I_IN = 16 * 48, I_OUT = 16 * 32, I_UP = 16 * 128, I_DN = 64 * 32, I_PW = 4 * 8, I_G = 8 * 2, I_L = I_IN + I_OUT + I_UP + I_DN + I_PW + 2 * I_G;
    unsigned char* ws = p.ws;
    for (int it = gw; it < DEPTH * I_L; it += NGW) {
        const int l = it / I_L; int r = it % I_L;
        unsigned char* wl = ws + WS_W + (size_t)l * W_LAYER;
        if (r < I_IN) { transpose_item(p.in[3] + (size_t)l * D * DIN, p.in[2] + l * D, D, DIN, (bf16*)(wl + W_IN), scr, r, lane); continue; } r -= I_IN;
        if (r < I_OUT) { transpose_item(p.in[15] + (size_t)l * D * D, p.in[14] + l * D, D, D, (bf16*)(wl + W_OUT), scr, r, lane); continue; } r -= I_OUT;
        if (r < I_UP) { transpose_item(p.in[17] + (size_t)l * D * FF, p.in[16] + l * D, D, FF, (bf16*)(wl + W_UP), scr, r, lane); continue; } r -= I_UP;
        if (r < I_DN) { transpose_item(p.in[18] + (size_t)l * FF * D, nullptr, FF, D, (bf16*)(wl + W_DOWN), scr, r, lane); continue; } r -= I_DN;
        if (r < I_PW) { const int g = r / 8; transpose_item(p.in[4] + (size_t)(l * 4 + g) * 16384, nullptr, 128, 128, (bf16*)(ws + WS_POOLW) + (size_t)(l * 4 + g) * 16384, scr, r % 8, lane); continue; } r -= I_PW;
        if (r < I_G) { const int h = r / 2; transpose_item(p.in[9] + (size_t)(l * 8 + h) * 4096, nullptr, 64, 64, (bf16*)(ws + WS_GR) + (size_t)(l * 8 + h) * 4096, scr, r % 2, lane); continue; } r -= I_G;
        { const int h = r / 2; transpose_item(p.in[11] + (size_t)(l * 8 + h) * 4096, nullptr, 64, 64, (bf16*)(ws + WS_GI) + (size_t)(l * 8 + h) * 4096, scr, r % 2, lane); }
    }
    const float* x = p.in[0]; bf16* hb = (bf16*)(ws + WS_HB); float* ss = (float*)(ws + WS_SS);
    for (int m = gw; m < M; m += NGW) {
        const f32x4* xr = (const f32x4*)(x + (size_t)m * D) + lane; f32x4 v[4]; float s = 0.f;
#pragma unroll
        for (int j = 0; j < 4; ++j) { v[j] = xr[64 * j]; s += (v[j].x * v[j].x + v[j].y * v[j].y) + (v[j].z * v[j].z + v[j].w * v[j].w); }
        s = wave_sum(s);
        u32x2* o8 = (u32x2*)(hb + (size_t)m * D) + lane;
#pragma unroll
        for (int j = 0; j < 4; ++j) { u32x2 w; w.x = cvt_pk(v[j].x, v[j].y); w.y = cvt_pk(v[j].z, v[j].w); o8[64 * j] = w; }
        if (lane < 16) ss[(size_t)m * 16 + lane] = lane == 0 ? s : 0.f;
    }
    float* hm = (float*)(ws + WS_HMETA); float* sp = (float*)(ws + WS_SP);
    for (int i = blockIdx.x * 512 + tid; i < NMETA * D; i += G * 512) hm[i] = p.in[1][i];
    for (int i = blockIdx.x * 512 + tid; i < DEPTH * DH; i += G * 512) sp[i] = log1pf(expf(-p.in[13][i]));
}

template <int MODE> __device__ __forceinline__ void meta_tasks(const Params& p, LAS unsigned char* lds, int G, const bf16* Ab, int lda, const bf16* Bt, int K, int ntasks) {
    int tid_ = threadIdx.x; asm volatile("" : "+v"(tid_));
    const int tid = tid_, lane = tid & 63, wid = __builtin_amdgcn_readfirstlane(tid >> 6), fr = lane & 15, fq = lane >> 4;
    float* hm = (float*)(p.ws + WS_HMETA);
    LAS float* red = (LAS float*)lds;
    for (int task = G - 1 - (int)blockIdx.x; task < ntasks; task += G) {
        const int n0 = task * 16, kw = K / 8, k0 = wid * kw;
        f32x4 acc = {0.f, 0.f, 0.f, 0.f}; float ssq = 0.f;
        for (int kk = k0; kk < k0 + kw; kk += 32) {
            bf16x8 af;
            if (MODE == 1) af = *(const bf16x8*)(Ab + (size_t)fr * lda + kk + 8 * fq);
            else { const f32x4 a0 = *(const f32x4*)(hm + fr * D + kk + 8 * fq), a1 = *(const f32x4*)(hm + fr * D + kk + 8 * fq + 4);
                ssq += (a0.x * a0.x + a0.y * a0.y) + (a0.z * a0.z + a0.w * a0.w) + (a1.x * a1.x + a1.y * a1.y) + (a1.z * a1.z + a1.w * a1.w);
                u32x4 w; w.x = cvt_pk(a0.x, a0.y); w.y = cvt_pk(a0.z, a0.w); w.z = cvt_pk(a1.x, a1.y); w.w = cvt_pk(a1.z, a1.w); af = __builtin_bit_cast(bf16x8, w); }
            const bf16x8 bfr = *(const bf16x8*)(Bt + (size_t)(n0 + fr) * K + kk + 8 * fq);
            acc = __builtin_amdgcn_mfma_f32_16x16x32_bf16(bfr, af, acc, 0, 0, 0);
        }
        ssq += __shfl_xor(ssq, 16); ssq += __shfl_xor(ssq, 32);
        LAS float* rp = red + (wid * 64 + lane) * 5;
        rp[0] = acc[0]; rp[1] = acc[1]; rp[2] = acc[2]; rp[3] = acc[3]; rp[4] = ssq;
        __syncthreads();
        if (wid == 0) {
            float a0 = 0.f, a1 = 0.f, a2 = 0.f, a3 = 0.f, sq = 0.f;
#pragma unroll
            for (int w = 0; w < 8; ++w) { const LAS float* q = red + (w * 64 + lane) * 5; a0 += q[0]; a1 += q[1]; a2 += q[2]; a3 += q[3]; sq += q[4]; }
            const int col = n0 + 4 * fq;
            if (MODE == 1) { f32x4* hp = (f32x4*)(hm + fr * D + col); f32x4 h = *hp; h.x += a0; h.y += a1; h.z += a2; h.w += a3; *hp = h; }
            else {
                const float rs = 1.0f / sqrtf(sq * (1.0f / D) + EPS); a0 *= rs; a1 *= rs; a2 *= rs; a3 *= rs;
                if (MODE == 0) { u32x2 w; w.x = cvt_pk(a0, a1); w.y = cvt_pk(a2, a3); bf16* pr = (bf16*)(p.ws + WS_PROJ);
                    *(u32x2*)(pr + (size_t)fr * DIN + col) = w; *(u32x2*)(pr + (size_t)(TT + fr) * DIN + col) = w; }
                else { a0 = fmaxf(a0, 0.f); a1 = fmaxf(a1, 0.f); a2 = fmaxf(a2, 0.f); a3 = fmaxf(a3, 0.f);
                    u32x2 w; w.x = cvt_pk(a0 * a0, a1 * a1); w.y = cvt_pk(a2 * a2, a3 * a3); *(u32x2*)((bf16*)(p.ws + WS_MIDMETA) + (size_t)fr * FF + col) = w; }
            }
        }
        __syncthreads();
    }
}

__device__ __forceinline__ void m1_phase(const Params& p, LAS unsigned char* lds, int G, int l) {
    int tid_ = threadIdx.x; asm volatile("" : "+v"(tid_));
    const int tid = tid_, lane = tid & 63, wid = __builtin_amdgcn_readfirstlane(tid >> 6), fr = lane & 15, fq = lane >> 4;
    LAS float* cst = (LAS float*)lds;
    for (int i = tid; i < 8 * DH; i += 512) { const int row = i >> 9, ch = i & 511; float v;
        if (row < 4) v = p.in[7][(l * 4 + row) * DH + ch]; else if (row == 4) v = p.in[8][l * DH + ch]; else if (row == 5) v = p.in[10][l * DH + ch];
        else if (row == 6) v = p.in[12][l * DH + ch]; else v = ((const float*)(p.ws + WS_SP))[l * DH + ch];
        cst[i] = v; }
    const bf16* proj = (const bf16*)(p.ws + WS_PROJ);
    const bf16* Wr = (const bf16*)(p.ws + WS_GR) + (size_t)(l * 8 + wid) * 4096; const bf16* Wi = (const bf16*)(p.ws + WS_GI) + (size_t)(l * 8 + wid) * 4096;
    LAS bf16x8* wl = (LAS bf16x8*)(lds + 16384 + wid * 16384) + lane;
#pragma unroll
    for (int n = 0; n < 4; ++n)
#pragma unroll
        for (int ks = 0; ks < 2; ++ks) {
            wl[((n * 2 + ks) * 2 + 0) * 64] = *(const bf16x8*)(Wr + outchan(n, fr) * 64 + 32 * ks + 8 * fq);
            wl[((n * 2 + ks) * 2 + 1) * 64] = *(const bf16x8*)(Wi + outchan(n, fr) * 64 + 32 * ks + 8 * fq); }
    __syncthreads();
    float* hl = (float*)(p.ws + WS_HL); bf16* Pp = (bf16*)(p.ws + WS_P);
    float* carA = (float*)(p.ws + WS_CARA); float* carH = (float*)(p.ws + WS_CARH);
    for (int unit = blockIdx.x; unit < 256; unit += G) {
        const int b = unit >> 7, c = unit & 127, t0 = c ? NMETA + 64 * c : 0, NM = c ? 4 : 5;
        float Hc[16], Pc[16];
#pragma unroll
        for (int k = 0; k < 16; ++k) { Hc[k] = 0.f; Pc[k] = 1.f; }
        u32x4 raw[2][4];
#pragma unroll
        for (int ks = 0; ks < 2; ++ks)
#pragma unroll
            for (int d = 0; d < 4; ++d) { const int tt = t0 + fr - 3 + d; raw[ks][d] = (u32x4){0u, 0u, 0u, 0u};
                if (tt >= 0) raw[ks][d] = *(const u32x4*)(proj + ((size_t)b * TT + tt) * DIN + DH + wid * 64 + 32 * ks + 8 * fq); }
#pragma unroll 1
        for (int m = 0; m < NM; ++m) {
            const int t = t0 + 16 * m + fr; const size_t rowg = (size_t)b * TT + t;
            u32x4 nraw[2][4];
#pragma unroll
            for (int ks = 0; ks < 2; ++ks)
#pragma unroll
                for (int d = 0; d < 4; ++d) { nraw[ks][d] = (u32x4){0u, 0u, 0u, 0u};
                    if (m + 1 < NM) nraw[ks][d] = *(const u32x4*)(proj + ((size_t)b * TT + t + 13 + d) * DIN + DH + wid * 64 + 32 * ks + 8 * fq); }
            float xc[2][8]; bf16x8 frag[2];
#pragma unroll
            for (int ks = 0; ks < 2; ++ks) {
                const int chb = wid * 64 + 32 * ks + 8 * fq;
                { const f32x4 c0 = *(const LAS f32x4*)(cst + 4 * DH + chb), c1 = *(const LAS f32x4*)(cst + 4 * DH + chb + 4);
                  xc[ks][0] = c0.x; xc[ks][1] = c0.y; xc[ks][2] = c0.z; xc[ks][3] = c0.w; xc[ks][4] = c1.x; xc[ks][5] = c1.y; xc[ks][6] = c1.z; xc[ks][7] = c1.w; }
#pragma unroll
                for (int d = 0; d < 4; ++d) {
                    float u[8]; unpack8(raw[ks][d], u);
                    const f32x4 w0 = *(const LAS f32x4*)(cst + d * DH + chb), w1 = *(const LAS f32x4*)(cst + d * DH + chb + 4);
                    xc[ks][0] += u[0] * w0.x; xc[ks][1] += u[1] * w0.y; xc[ks][2] += u[2] * w0.z; xc[ks][3] += u[3] * w0.w;
                    xc[ks][4] += u[4] * w1.x; xc[ks][5] += u[5] * w1.y; xc[ks][6] += u[6] * w1.z; xc[ks][7] += u[7] * w1.w;
                    raw[ks][d] = nraw[ks][d];
                }
                frag[ks] = __builtin_bit_cast(bf16x8, pack8(xc[ks]));
            }
            f32x4 ar[4], ai[4];
#pragma unroll
            for (int n = 0; n < 4; ++n) { ar[n] = (f32x4){0.f, 0.f, 0.f, 0.f}; ai[n] = (f32x4){0.f, 0.f, 0.f, 0.f};
#pragma unroll
                for (int ks = 0; ks < 2; ++ks) {
                    const bf16x8 wr_ = wl[((n * 2 + ks) * 2 + 0) * 64], wi_ = wl[((n * 2 + ks) * 2 + 1) * 64];
                    ar[n] = __builtin_amdgcn_mfma_f32_16x16x32_bf16(wr_, frag[ks], ar[n], 0, 0, 0);
                    ai[n] = __builtin_amdgcn_mfma_f32_16x16x32_bf16(wi_, frag[ks], ai[n], 0, 0, 0);
                } }
            float Aa[16], Bb[16];
#pragma unroll
            for (int n = 0; n < 4; ++n) {
                const int cho = wid * 64 + 32 * (n >> 1) + 8 * fq + 4 * (n & 1);
                const f32x4 rb = *(const LAS f32x4*)(cst + 5 * DH + cho), ib = *(const LAS f32x4*)(cst + 6 * DH + cho), spv = *(const LAS f32x4*)(cst + 7 * DH + cho);
#pragma unroll
                for (int jj = 0; jj < 4; ++jj) {
                    const float r = sigm(ar[n][jj] + rb[jj]), ig = sigm(ai[n][jj] + ib[jj]);
                    const float la = -8.0f * r * spv[jj], a = __expf(la), x2 = 2.0f * la;
                    const float m2s = -x2 * (1.0f + x2 * (0.5f + x2 * (0.16666667f + x2 * 0.041666668f))), m2 = (x2 > -0.0625f) ? m2s : 1.0f - a * a;
                    Aa[n * 4 + jj] = a; Bb[n * 4 + jj] = __builtin_amdgcn_sqrtf(m2) * ig * xc[n >> 1][4 * (n & 1) + jj];
                }
            }
#pragma unroll
            for (int k = 0; k < 16; ++k) {
                float A = Aa[k], B = Bb[k], Ap, Bq;
                Ap = dppf<0x111>(1.f, A); Bq = dppf<0x111>(0.f, B); B = fmaf(A, Bq, B); A *= Ap;
                Ap = dppf<0x112>(1.f, A); Bq = dppf<0x112>(0.f, B); B = fmaf(A, Bq, B); A *= Ap;
                Ap = dppf<0x114>(1.f, A); Bq = dppf<0x114>(0.f, B); B = fmaf(A, Bq, B); A *= Ap;
                Ap = dppf<0x118>(1.f, A); Bq = dppf<0x118>(0.f, B); B = fmaf(A, Bq, B); A *= Ap;
                Bb[k] = fmaf(A, Hc[k], B); Aa[k] = A * Pc[k];
            }
#pragma unroll
            for (int ks = 0; ks < 2; ++ks) {
                const size_t o = rowg * DH + wid * 64 + 32 * ks + 8 * fq;
                *(f32x4*)(hl + o) = (f32x4){Bb[8 * ks + 0], Bb[8 * ks + 1], Bb[8 * ks + 2], Bb[8 * ks + 3]};
                *(f32x4*)(hl + o + 4) = (f32x4){Bb[8 * ks + 4], Bb[8 * ks + 5], Bb[8 * ks + 6], Bb[8 * ks + 7]};
                u32x4 w; w.x = cvt_pk(Aa[8 * ks + 0], Aa[8 * ks + 1]); w.y = cvt_pk(Aa[8 * ks + 2], Aa[8 * ks + 3]); w.z = cvt_pk(Aa[8 * ks + 4], Aa[8 * ks + 5]); w.w = cvt_pk(Aa[8 * ks + 6], Aa[8 * ks + 7]);
                *(u32x4*)(Pp + o) = w;
            }
            const int src = (lane & 48) | 15;
#pragma unroll
            for (int k = 0; k < 16; ++k) { Hc[k] = __shfl(Bb[k], src); Pc[k] = __shfl(Aa[k], src); }
        }
        if (fr == 0) {
#pragma unroll
            for (int ks = 0; ks < 2; ++ks) {
                const size_t o = (size_t)(b * 128 + c) * DH + wid * 64 + 32 * ks + 8 * fq;
                *(f32x4*)(carA + o) = (f32x4){Pc[8 * ks + 0], Pc[8 * ks + 1], Pc[8 * ks + 2], Pc[8 * ks + 3]}; *(f32x4*)(carA + o + 4) = (f32x4){Pc[8 * ks + 4], Pc[8 * ks + 5], Pc[8 * ks + 6], Pc[8 * ks + 7]};
                *(f32x4*)(carH + o) = (f32x4){Hc[8 * ks + 0], Hc[8 * ks + 1], Hc[8 * ks + 2], Hc[8 * ks + 3]}; *(f32x4*)(carH + o + 4) = (f32x4){Hc[8 * ks + 4], Hc[8 * ks + 5], Hc[8 * ks + 6], Hc[8 * ks + 7]};
            }
        }
    }
    __syncthreads();
}


template <int NMR> __device__ __forceinline__ void m2_rnn_round(const float* hl, const bf16* Pp, const bf16* proj, bf16* Y, LAS float* red1, const float (&cr)[16], int b, int t0, int mbase, int wid, int fr, int fq) {
    f32x4 hv4[NMR][2][2]; u32x4 pw[NMR][2], gw[NMR][2];
#pragma unroll
    for (int m = 0; m < NMR; ++m)
#pragma unroll
        for (int ks = 0; ks < 2; ++ks) { const size_t rowg = (size_t)b * TT + t0 + 16 * (mbase + m) + fr; const int ch = wid * 64 + 32 * ks + 8 * fq; const size_t o = rowg * DH + ch;
            hv4[m][ks][0] = *(const f32x4*)(hl + o); hv4[m][ks][1] = *(const f32x4*)(hl + o + 4); pw[m][ks] = *(const u32x4*)(Pp + o); gw[m][ks] = *(const u32x4*)(proj + rowg * DIN + 2 * DH + ch); }
    float y[NMR][16];
#pragma unroll
    for (int m = 0; m < NMR; ++m) { float s = 0.f;
#pragma unroll
        for (int ks = 0; ks < 2; ++ks) { float pf[8], gt[8]; unpack8(pw[m][ks], pf); unpack8(gw[m][ks], gt);
            const float hh[8] = {hv4[m][ks][0].x, hv4[m][ks][0].y, hv4[m][ks][0].z, hv4[m][ks][0].w, hv4[m][ks][1].x, hv4[m][ks][1].y, hv4[m][ks][1].z, hv4[m][ks][1].w};
#pragma unroll
            for (int e = 0; e < 8; ++e) { const float hv = fmaf(pf[e], cr[8 * ks + e], hh[e]), x = gt[e];
                const float ge = x * __builtin_amdgcn_rcpf(1.0f + __expf(-1.5957691216f * (x + 0.044715f * x * x * x)));
                const float yy = hv * ge; y[m][8 * ks + e] = yy; s = fmaf(yy, yy, s); } }
        s += __shfl_xor(s, 16); s += __shfl_xor(s, 32);
        if (fq == 0) red1[(16 * (mbase + m) + fr) * 8 + wid] = s; }
    __syncthreads();
#pragma unroll
    for (int m = 0; m < NMR; ++m) { const size_t rowg = (size_t)b * TT + t0 + 16 * (mbase + m) + fr;
        const f32x4 r0 = *(const LAS f32x4*)(red1 + (16 * (mbase + m) + fr) * 8), r1 = *(const LAS f32x4*)(red1 + (16 * (mbase + m) + fr) * 8 + 4);
        const float rs = __builtin_amdgcn_rsqf((((r0.x + r0.y) + (r0.z + r0.w)) + ((r1.x + r1.y) + (r1.z + r1.w))) * (1.0f / DH) + EPS);
#pragma unroll
        for (int ks = 0; ks < 2; ++ks) { float yy[8];
#pragma unroll
            for (int e = 0; e < 8; ++e) yy[e] = y[m][8 * ks + e] * rs;
            *(u32x4*)(Y + rowg * D + DH + wid * 64 + 32 * ks + 8 * fq) = pack8(yy); } }
}


template <int NMR> __device__ __forceinline__ void m2_pool_round(const bf16* proj, bf16* Y, const bf16* Wp, const float* pbias, const float* pscale, LAS float* red2,
                                                                  int b, int t0, int mbase, int g, int half, int kwin, int wid, int fr, int fq) {
    const int tb = t0 + 16 * mbase;
    bf16x8 pfr[NMR][4];
#pragma unroll
    for (int ks = 0; ks < 4; ++ks) {
        const int chb = g * 128 + 32 * ks + 8 * fq;
        float pu[8], p2[8], p4[8], p8[8];
        if (tb) { const u32x4 raw = *(const u32x4*)(proj + ((size_t)b * TT + tb - 16 + fr) * DIN + chb); unpack8(raw, pu);
#pragma unroll
            for (int e = 0; e < 8; ++e) { p2[e] = pu[e] + dppf<0x111>(0.f, pu[e]); p4[e] = p2[e] + dppf<0x112>(0.f, p2[e]); p8[e] = p4[e] + dppf<0x114>(0.f, p4[e]); } }
        else {
#pragma unroll
            for (int e = 0; e < 8; ++e) { pu[e] = 0.f; p2[e] = 0.f; p4[e] = 0.f; p8[e] = 0.f; } }
#pragma unroll
        for (int m = 0; m < NMR; ++m) {
            const int t = tb + 16 * m + fr; const size_t rowg = (size_t)b * TT + t;
            const u32x4 raw = *(const u32x4*)(proj + rowg * DIN + chb); float u[8], po[8]; unpack8(raw, u);
            const int cnt = (t + 1 < kwin) ? t + 1 : kwin; const float rc = __builtin_amdgcn_rcpf((float)cnt);
#pragma unroll
            for (int e = 0; e < 8; ++e) {
                const float s2 = u[e] + shiftd<1>(u[e], pu[e]), s4 = s2 + shiftd<2>(s2, p2[e]), s8 = s4 + shiftd<4>(s4, p4[e]), s16 = s8 + shiftd<8>(s8, p8[e]);
                const float win = g == 0 ? s2 : (g == 1 ? s4 : (g == 2 ? s8 : s16));
                po[e] = fmaf(win, rc, -u[e]); pu[e] = u[e]; p2[e] = s2; p4[e] = s4; p8[e] = s8;
            }
            pfr[m][ks] = __builtin_bit_cast(bf16x8, pack8(po));
        }
    }
    bf16x8 wfr[4][4];
#pragma unroll
    for (int n = 0; n < 4; ++n)
#pragma unroll
        for (int ks = 0; ks < 4; ++ks) wfr[n][ks] = *(const bf16x8*)(Wp + (size_t)(64 * half + outchan(n, fr)) * 128 + 32 * ks + 8 * fq);
#pragma unroll 1
    for (int pass = 0; pass < 2; ++pass) {
#pragma unroll
        for (int m = 0; m < NMR; ++m) {
            const int t = tb + 16 * m + fr; const size_t rowg = (size_t)b * TT + t; float s = 0.f, rs = 0.f;
            if (pass) { const f32x4 r0 = *(const LAS f32x4*)(red2 + (16 * (mbase + m) + fr) * 8), r1 = *(const LAS f32x4*)(red2 + (16 * (mbase + m) + fr) * 8 + 4);
                rs = __builtin_amdgcn_rsqf((((r0.x + r0.y) + (r0.z + r0.w)) + ((r1.x + r1.y) + (r1.z + r1.w))) * (1.0f / DH) + EPS); }
#pragma unroll
            for (int np = 0; np < 2; ++np) {
                f32x4 o2[2];
#pragma unroll
                for (int nn = 0; nn < 2; ++nn) { const int n = 2 * np + nn;
                    f32x4 acc = {0.f, 0.f, 0.f, 0.f};
#pragma unroll
                    for (int ks = 0; ks < 4; ++ks) acc = __builtin_amdgcn_mfma_f32_16x16x32_bf16(wfr[n][ks], pfr[m][ks], acc, 0, 0, 0);
                    const int col = g * 128 + 64 * half + 32 * np + 8 * fq + 4 * nn;
                    const f32x4 pb = *(const f32x4*)(pbias + col), ps = *(const f32x4*)(pscale + col);
                    acc = (acc + pb) * ps; s += (acc.x * acc.x + acc.y * acc.y) + (acc.z * acc.z + acc.w * acc.w); o2[nn] = acc * rs; }
                if (pass) { u32x4 w; w.x = cvt_pk(o2[0].x, o2[0].y); w.y = cvt_pk(o2[0].z, o2[0].w); w.z = cvt_pk(o2[1].x, o2[1].y); w.w = cvt_pk(o2[1].z, o2[1].w);
                    *(u32x4*)(Y + rowg * D + g * 128 + 64 * half + 32 * np + 8 * fq) = w; }
            }
            if (!pass) { s += __shfl_xor(s, 16); s += __shfl_xor(s, 32); if (fq == 0) red2[(16 * (mbase + m) + fr) * 8 + wid] = s; }
        }
        if (!pass) __syncthreads();
    }
}

__device__ __forceinline__ void m2_phase(const Params& p, LAS unsigned char* lds, int G, int l) {
    int tid_ = threadIdx.x; asm volatile("" : "+v"(tid_));
    const int tid = tid_, lane = tid & 63, wid = __builtin_amdgcn_readfirstlane(tid >> 6), fr = lane & 15, fq = lane >> 4;
    LAS float* segA = (LAS float*)lds; LAS float* segH = (LAS float*)(lds + 16384); LAS float* carr = (LAS float*)(lds + 32768);
    LAS float* red1 = (LAS float*)(lds + 34816); LAS float* red2 = (LAS float*)(lds + 37888);
    const bf16* proj = (const bf16*)(p.ws + WS_PROJ); bf16* Y = (bf16*)(p.ws + WS_Y);
    const float* hl = (const float*)(p.ws + WS_HL); const bf16* Pp = (const bf16*)(p.ws + WS_P);
    const float* carA = (const float*)(p.ws + WS_CARA); const float* carH = (const float*)(p.ws + WS_CARH);
    const int g = wid >> 1, half = wid & 1, kwin = 2 << g;
    const bf16* Wp = (const bf16*)(p.ws + WS_POOLW) + (size_t)(l * 4 + g) * 16384;
    const float* pbias = p.in[5] + l * DH; const float* pscale = p.in[6] + l * DH;
    for (int unit = blockIdx.x; unit < 256; unit += G) {
        const int b = unit >> 7, c = unit & 127, t0 = c ? NMETA + 64 * c : 0, NM = c ? 4 : 5;
        {
            const int q = (c + 7) >> 3, jlo = wid * q, jhi = (jlo + q < c) ? jlo + q : c;
            f32x4 A0 = {1.f, 1.f, 1.f, 1.f}, A1 = A0, H0 = {0.f, 0.f, 0.f, 0.f}, H1 = H0;
            for (int j = jlo; j < jhi; j += 8) {
                f32x4 a0[8], a1[8], h0[8], h1[8];
#pragma unroll
                for (int i = 0; i < 8; ++i) { const int jj = (j + i < jhi) ? j + i : jhi - 1; const size_t o = (size_t)(b * 128 + jj) * DH + 8 * lane;
                    a0[i] = *(const f32x4*)(carA + o); a1[i] = *(const f32x4*)(carA + o + 4); h0[i] = *(const f32x4*)(carH + o); h1[i] = *(const f32x4*)(carH + o + 4); }
#pragma unroll
                for (int i = 0; i < 8; ++i) if (j + i < jhi) { H0 = a0[i] * H0 + h0[i]; A0 = A0 * a0[i]; H1 = a1[i] * H1 + h1[i]; A1 = A1 * a1[i]; }
            }
            *(LAS f32x4*)(segA + wid * DH + 8 * lane) = A0; *(LAS f32x4*)(segA + wid * DH + 8 * lane + 4) = A1;
            *(LAS f32x4*)(segH + wid * DH + 8 * lane) = H0; *(LAS f32x4*)(segH + wid * DH + 8 * lane + 4) = H1;
        }
        __syncthreads();
        { float cy = 0.f;
#pragma unroll
          for (int s8 = 0; s8 < 8; ++s8) cy = segA[s8 * DH + tid] * cy + segH[s8 * DH + tid];
          carr[tid] = cy; }
        __syncthreads();
        {
            float cr[16];
#pragma unroll
            for (int ks = 0; ks < 2; ++ks) { const f32x4 c0 = *(const LAS f32x4*)(carr + wid * 64 + 32 * ks + 8 * fq), c1 = *(const LAS f32x4*)(carr + wid * 64 + 32 * ks + 8 * fq + 4);
                cr[8 * ks + 0] = c0.x; cr[8 * ks + 1] = c0.y; cr[8 * ks + 2] = c0.z; cr[8 * ks + 3] = c0.w; cr[8 * ks + 4] = c1.x; cr[8 * ks + 5] = c1.y; cr[8 * ks + 6] = c1.z; cr[8 * ks + 7] = c1.w; }
            m2_rnn_round<4>(hl, Pp, proj, Y, red1, cr, b, t0, 0, wid, fr, fq);
            if (NM == 5) m2_rnn_round<1>(hl, Pp, proj, Y, red1, cr, b, t0, 4, wid, fr, fq);
        }
        m2_pool_round<4>(proj, Y, Wp, pbias, pscale, red2, b, t0, 0, g, half, kwin, wid, fr, fq);
        if (NM == 5) m2_pool_round<1>(proj, Y, Wp, pbias, pscale, red2, b, t0, 4, g, half, kwin, wid, fr, fq);
    }
    __syncthreads();
}

__device__ __forceinline__ void final_norm(const Params& p, int G) {
    int tid_ = threadIdx.x; asm volatile("" : "+v"(tid_));
    const int tid = tid_, lane = tid & 63, wid = tid >> 6; const int gw = blockIdx.x * 8 + wid, NGW = G * 8;
    const f32x4* gp = (const f32x4*)p.in[19] + lane; f32x4 gg[4];
#pragma unroll
    for (int j = 0; j < 4; ++j) gg[j] = gp[64 * j];
    for (int m = gw; m < M; m += NGW) {
        f32x4* xr = (f32x4*)(p.out + (size_t)m * D) + lane; f32x4 v[4]; float s = 0.f;
#pragma unroll
        for (int j = 0; j < 4; ++j) { v[j] = xr[64 * j]; s += (v[j].x * v[j].x + v[j].y * v[j].y) + (v[j].z * v[j].z + v[j].w * v[j].w); }
        const float rs = 1.0f / sqrtf(wave_sum(s) * (1.0f / D) + EPS);
#pragma unroll
        for (int j = 0; j < 4; ++j) xr[64 * j] = v[j] * rs * gg[j];
    }
}

#define XB_TMO      128
#define XB_XCNT(j)  (256  + 64 * (j))
#define XB_XSUB(j)  (1280 + 64 * (j))
#define XB_XGEN(j)  (2304 + 64 * (j))
#define XB_TOP      3328
#define XB_TOPGEN   3392
#define XCD_BAR_WORDS 3456
#define XB_SPIN_CAP (1u << 18)

__device__ __forceinline__ unsigned xb_ld(unsigned* p)              { return __hip_atomic_load(p, __ATOMIC_RELAXED, __HIP_MEMORY_SCOPE_AGENT); }
__device__ __forceinline__ unsigned xb_add(unsigned* p, unsigned v) { return __hip_atomic_fetch_add(p, v, __ATOMIC_RELAXED, __HIP_MEMORY_SCOPE_AGENT); }
__device__ __forceinline__ unsigned xb_xcc_id() { return (unsigned)__builtin_amdgcn_s_getreg((3 << 11) | 20) & 0xFu; }
#define XB_SPIN(cond, bar) do { unsigned _sp = 0; while (cond) { __builtin_amdgcn_s_sleep(1); \
    if ((++_sp & 255u) == 0u) { if (xb_ld(&(bar)[XB_TMO])) break; if (_sp > XB_SPIN_CAP) { atomicAdd(&(bar)[XB_TMO], 1u); break; } } } } while (0)

struct XcdBarrier {
    unsigned* bar; unsigned x;
    volatile LAS unsigned* st;
};

__device__ __forceinline__ XcdBarrier xcd_barrier_post(unsigned* bar, volatile LAS unsigned* st) {
    XcdBarrier b; b.bar = bar; b.x = xb_xcc_id(); b.st = st;
    if (threadIdx.x == 0) (void)xb_add(&bar[XB_XCNT(b.x)], 1u);
    return b;
}
__device__ __forceinline__ void xcd_barrier_complete(unsigned* bar, unsigned x, unsigned& nloc, unsigned& nx) {
    const unsigned G = gridDim.x * gridDim.y * gridDim.z;
    unsigned sum, cnt, mine, sp = 0u;
    for (;;) {
        sum = 0u; cnt = 0u; mine = 0u;
#pragma unroll
        for (unsigned j = 0; j < 16; ++j) { const unsigned c = xb_ld(&bar[XB_XCNT(j)]); sum += c; cnt += (c > 0u) ? 1u : 0u; mine = (j == x) ? c : mine; }
        if (sum == G) break;
        __builtin_amdgcn_s_sleep(1);
        if ((++sp & 255u) == 0u) { if (xb_ld(&bar[XB_TMO])) break; if (sp > XB_SPIN_CAP) { atomicAdd(&bar[XB_TMO], 1u); break; } }
    }
    nloc = mine > 0u ? mine : 1u; nx = cnt > 0u ? cnt : 1u;
}

__device__ __forceinline__ void xcd_barrier(const XcdBarrier& b) {
    asm volatile("s_waitcnt vmcnt(0)" ::: "memory");
    __syncthreads();
    if (threadIdx.x == 0) {
        unsigned* bar = b.bar;
        __builtin_amdgcn_s_waitcnt(0);
        unsigned nloc = b.st[0], nx = b.st[1];
        if (nloc == 0u) { xcd_barrier_complete(bar, b.x, nloc, nx); b.st[0] = nloc; b.st[1] = nx; }
        const unsigned old = xb_add(&bar[XB_XSUB(b.x)], 1u);
        const unsigned gen = old / nloc;
        if (old + 1u == (gen + 1u) * nloc) {
            __builtin_amdgcn_fence(__ATOMIC_RELEASE, "agent");
            asm volatile("s_waitcnt vmcnt(0)" ::: "memory");
            const unsigned og = xb_add(&bar[XB_TOP], 1u);
            const unsigned tg = og / nx;
            if (og + 1u == (tg + 1u) * nx) xb_add(&bar[XB_TOPGEN], 1u);
            else XB_SPIN(xb_ld(&bar[XB_TOPGEN]) == tg, bar);
            __builtin_amdgcn_fence(__ATOMIC_ACQUIRE, "agent");
            xb_add(&bar[XB_XGEN(b.x)], 1u);
            asm volatile("s_waitcnt vmcnt(0)" ::: "memory");
        } else {
            XB_SPIN(xb_ld(&bar[XB_XGEN(b.x)]) == gen, bar);
            __builtin_amdgcn_fence(__ATOMIC_ACQUIRE, "agent");
            asm volatile("s_waitcnt vmcnt(0)" ::: "memory");
        }
    }
    __syncthreads();
}

#ifndef PROBE_SYNC2
#define PROBE_SYNC2 0
#endif
#ifndef PROBE_M1X2
#define PROBE_M1X2 0
#endif
#ifndef PROBE_M2X2
#define PROBE_M2X2 0
#endif
#define GSYNC() do { xcd_barrier(xbar); if (PROBE_SYNC2) xcd_barrier(xbar); } while (0)
__global__ void __launch_bounds__(512, 2) fwd_megakernel(Params p) {
    extern __shared__ __attribute__((aligned(16))) unsigned char lds_raw[];
    LAS unsigned char* lds = (LAS unsigned char*)lds_raw;
    cg::grid_group grid = cg::this_grid();
    const int G = gridDim.x;
    unsigned char* ws = p.ws;
    volatile LAS unsigned* xst = (volatile LAS unsigned*)(lds + LDS_XST);
    if (threadIdx.x < 2) xst[threadIdx.x] = 0u;
    __syncthreads();
    XcdBarrier xbar = xcd_barrier_post((unsigned*)(ws + WS_CTL), xst);
    bf16* hb = (bf16*)(ws + WS_HB); bf16* proj = (bf16*)(ws + WS_PROJ); bf16* Y = (bf16*)(ws + WS_Y); bf16* mid = (bf16*)(ws + WS_MID); float* ss = (float*)(ws + WS_SS);
#ifndef NO_PRO
    prologue(p, lds, G);
#endif
    grid.sync();
#pragma unroll 1
    for (int l = 0; l < DEPTH; ++l) {
        const unsigned char* wl = ws + WS_W + (size_t)l * W_LAYER;
        const bf16* in_t = (const bf16*)(wl + W_IN); const bf16* out_t = (const bf16*)(wl + W_OUT); const bf16* up_t = (const bf16*)(wl + W_UP); const bf16* down_t = (const bf16*)(wl + W_DOWN);
#ifndef NO_GIN
        { pg8::Gemm g{hb, in_t, M, DIN, D, 0}; pg8::StaticOrder S; S.init(M, DIN, G, (int)blockIdx.x); EpiIn E{proj, ss};
          pg8::gemm_phase<EpiIn, pg8::StaticOrder, true, true>(lds, g, S, E); }
#endif
#ifndef NO_META
        meta_tasks<0>(p, lds, G, nullptr, 0, in_t, D, DIN / 16);
#endif
        GSYNC();
#ifndef NO_M1
        m1_phase(p, lds, G, l);
        if (PROBE_M1X2) m1_phase(p, lds, G, l);
#endif
        GSYNC();
#ifndef NO_M2
        m2_phase(p, lds, G, l);
        if (PROBE_M2X2) m2_phase(p, lds, G, l);
#endif
        GSYNC();
#ifndef NO_GOUT
        { pg8::Gemm g{Y, out_t, M, D, D, NMETA}; pg8::StaticOrder S; S.init(M, D, G, (int)blockIdx.x); EpiRes E{l == 0 ? p.in[0] : p.out, p.out, hb, ss};
          pg8::gemm_phase<EpiRes, pg8::StaticOrder, false, true>(lds, g, S, E); }
#endif
#ifndef NO_META
        if (l < DEPTH - 1) meta_tasks<1>(p, lds, G, Y, D, out_t, D, D / 16);
#endif
        GSYNC();
#ifndef NO_GUP
        { pg8::Gemm g{hb, up_t, M, FF, D, 0}; pg8::StaticOrder S; S.init(M, FF, G, (int)blockIdx.x); EpiUp E{mid, ss};
          pg8::gemm_phase<EpiUp, pg8::StaticOrder, true, true>(lds, g, S, E); }
#endif
#ifndef NO_META
        if (l < DEPTH - 1) meta_tasks<2>(p, lds, G, nullptr, 0, up_t, D, FF / 16);
#endif
        GSYNC();
#ifndef NO_GDN
        { pg8::Gemm g{mid, down_t, M, D, FF, 0}; pg8::StaticOrder S; S.init(M, D, G, (int)blockIdx.x); EpiRes E{p.out, p.out, hb, ss};
          pg8::gemm_phase<EpiRes, pg8::StaticOrder, false, true>(lds, g, S, E); }
#endif
#ifndef NO_META
        if (l < DEPTH - 1) meta_tasks<1>(p, lds, G, (const bf16*)(ws + WS_MIDMETA), FF, down_t, FF, D / 16);
#endif
        GSYNC();
    }
    final_norm(p, G);
}

extern "C" void kernel_launch(void* const* d_in, const int* in_sizes, int n_in, void* d_out, int out_size, void* d_ws, size_t ws_size, hipStream_t stream) {
    static int grid = 0;
    if (grid == 0) {
        if (n_in != 20 || in_sizes[0] != M * D || out_size != M * D || ws_size < WS_END) { fprintf(stderr, "kernel_launch: unexpected shapes (n_in %d, in0 %d, out %d, ws %zu)\n", n_in, n_in > 0 ? in_sizes[0] : -1, out_size, ws_size); grid = -1; return; }
        int dev = 0, cus = 0, per_cu = 0;
        if (hipGetDevice(&dev) != hipSuccess || hipDeviceGetAttribute(&cus, hipDeviceAttributeMultiprocessorCount, dev) != hipSuccess) { grid = -1; return; }
        if (hipFuncSetAttribute((const void*)fwd_megakernel, hipFuncAttributeMaxDynamicSharedMemorySize, LDS_BYTES) != hipSuccess) { fprintf(stderr, "kernel_launch: hipFuncSetAttribute failed\n"); grid = -1; return; }
        if (hipOccupancyMaxActiveBlocksPerMultiprocessor(&per_cu, (const void*)fwd_megakernel, 512, LDS_BYTES) != hipSuccess || per_cu < 1) { fprintf(stderr, "kernel_launch: occupancy query gave %d\n", per_cu); (void)hipGetLastError(); grid = -1; return; }
        grid = cus * 1;
    }
    if (grid < 0) return;
    if (hipMemsetAsync((char*)d_ws + WS_CTL, 0, XCD_BAR_WORDS * 4, stream) != hipSuccess) { fprintf(stderr, "kernel_launch: memset failed\n"); return; }
    Params p{};
    for (int i = 0; i < 20; ++i) p.in[i] = (const float*)d_in[i];
    p.out = (float*)d_out; p.ws = (unsigned char*)d_ws;
    void* args[] = {&p};
    hipError_t e = hipLaunchCooperativeKernel((const void*)fwd_megakernel, dim3(grid), dim3(512), args, LDS_BYTES, stream);
    if (e != hipSuccess) fprintf(stderr, "cooperative launch failed: %s (grid %d)\n", hipGetErrorString(e), grid);
}
```

```cpp
#include <hip/hip_runtime.h>
#include <hip/hip_cooperative_groups.h>
#include <cstdio>
#include <cstdint>
namespace cg = cooperative_groups;
namespace pg8 {
#define PG8_LAS __attribute__((address_space(3)))
typedef unsigned short bf16_t;
typedef short bf16x8 __attribute__((ext_vector_type(8)));
typedef float f32x4 __attribute__((ext_vector_type(4)));
typedef unsigned u32x4 __attribute__((ext_vector_type(4)));
constexpr int BM = 256, BK = 64, HALF = 128, HTB = HALF * BK * 2  , STAGE_BYTES = 8 * HTB, NXCD = 8, WGM = 8;

__host__ __device__ __forceinline__ int lds_byte(int r, int c) { const int st = (r >> 4) * 2 + (c >> 5), rr = r & 15, cc = c & 31, ob = rr * 64 + cc * 2; return st * 1024 + (ob ^ (((ob >> 9) & 1) << 5)); }
__host__ __device__ __forceinline__ void stage_rc(int b, int& R, int& C) { const int st = b / 1024, sb = b % 1024, swz = sb ^ (((sb >> 9) & 1) << 5); R = (st >> 1) * 16 + swz / 64; C = (st & 1) * 32 + (swz % 64) / 2; }
__host__ __device__ __forceinline__ int perm32(int rho) { const int n = rho >> 4, i = rho & 15; return 8 * (i >> 2) + 4 * n + (i & 3); }

struct Unit { int pm, pn; };
struct Gemm { const bf16_t* A; const bf16_t* Bt; int M, N, K, gap; };

struct StaticOrder {
    int nM, nN, nwg, G, c;
    __host__ __device__ void init(int M, int N, int G_, int c_) { nM = M / BM; nN = N / BM; nwg = nM * nN; G = G_; c = c_; }
    __host__ __device__ bool next(int i, Unit& u) const {
        const long L = (long)i * G + c; if (L >= nwg) return false;
        int wgid = (int)L; { const int q = nwg / NXCD, r = nwg % NXCD, xcd = wgid % NXCD, off = wgid / NXCD; wgid = (xcd < r ? xcd * (q + 1) : r * (q + 1) + (xcd - r) * q) + off; }
        const int nig = WGM * nN, gid = wgid / nig, fm = gid * WGM, gsz = (nM - fm) < WGM ? (nM - fm) : WGM;
        u.pm = fm + ((wgid % nig) % gsz); u.pn = (wgid % nig) / gsz; return true;
    }
    __device__ __forceinline__ void a_ready(const Unit&) const {}
    __device__ __forceinline__ void done(const Unit&) const {}
};
__device__ __forceinline__ unsigned cvt_pk_bf16(float lo, float hi) { unsigned r; asm volatile("v_cvt_pk_bf16_f32 %0, %1, %2" : "=v"(r) : "v"(lo), "v"(hi)); return r; }
template <class Epi, class Sched, bool ALIGN_EPI = false, bool SP2 = false>
__device__ __forceinline__ void gemm_phase(PG8_LAS unsigned char* lds, const Gemm g, const Sched& S, const Epi& E) {
    int tid_ = threadIdx.x; asm volatile("" : "+v"(tid_));
    const int tid = tid_, wid = __builtin_amdgcn_readfirstlane(tid >> 6), lane = tid & 63, wr = wid >> 2, wc = wid & 3, fr = lane & 15, fq = lane >> 4;
    const int K = g.K, nt = K / BK;
    unsigned voffA[2], voffB[2];
#pragma unroll
    for (int i = 0; i < 2; ++i) { int R, C; stage_rc(tid * 16 + i * 8192, R, C); const int Rb = Epi::PERM ? ((R & ~31) + perm32(R & 31)) : R;
        voffA[i] = (unsigned)(R * K + C) * 2u; voffB[i] = (unsigned)(Rb * K + C) * 2u; }
    const size_t kstep = (size_t)(BK * 2);
    const size_t hstep = (size_t)HALF * K * 2;
    const size_t tstep = 2 * hstep;
    const int agap = g.gap;
#define a_off(pm_) ((size_t)((pm_) * BM + agap * (1 + ((pm_) >> 5))) * (size_t)K * 2)
    const unsigned ldsw = (unsigned)wid * 1024u;
    const int aoff = lds_byte(wr * 64 + fr, fq * 8), boff = lds_byte(wc * 32 + fr, fq * 8);
#define PG8_SA(b, h) (((b) * 2 + (h)) * HTB)
#define PG8_SB(b, h) ((4 + (b) * 2 + (h)) * HTB)
#define PG8_STAGE(bufoff, gbase, voff) do { _Pragma("unroll") for (int _i = 0; _i < 2; ++_i) \
        __builtin_amdgcn_global_load_lds((const unsigned*)((const char*)(gbase) + (voff)[_i]), (PG8_LAS unsigned*)(lds + (bufoff) + ldsw + _i * 8192), 16, 0, 0); } while (0)
#define PG8_LDA(dst, b, h) do { _Pragma("unroll") for (int m = 0; m < 4; ++m) _Pragma("unroll") for (int k = 0; k < 2; ++k) dst[m][k] = *(const PG8_LAS bf16x8*)(lds + PG8_SA(b, h) + aoff + m * 2048 + k * 1024); } while (0)
#define PG8_LDB(dst, b, h) do { _Pragma("unroll") for (int n = 0; n < 2; ++n) _Pragma("unroll") for (int k = 0; k < 2; ++k) dst[n][k] = *(const PG8_LAS bf16x8*)(lds + PG8_SB(b, h) + boff + n * 2048 + k * 1024); } while (0)
#define PG8_MMA(ai, bj, At, Bt) do { __builtin_amdgcn_s_setprio(1); _Pragma("unroll") for (int m = 0; m < 4; ++m) _Pragma("unroll") for (int n = 0; n < 2; ++n) _Pragma("unroll") for (int k = 0; k < 2; ++k) \
        acc[ai][bj][m][n] = __builtin_amdgcn_mfma_f32_16x16x32_bf16(Bt[n][k], At[m][k], acc[ai][bj][m][n], 0, 0, 0); __builtin_amdgcn_s_setprio(0); } while (0)
#define PG8_WAIT_V(n) asm volatile("s_waitcnt vmcnt(" #n ")" ::: "memory")
#define PG8_WAIT_L(n) asm volatile("s_waitcnt lgkmcnt(" #n ")" ::: "memory")
#define PG8_BAR __builtin_amdgcn_s_barrier()
#define PG8_SCHED __builtin_amdgcn_sched_barrier(0)
    Unit cur, nxt; int ui = 0;
    if (!S.next(0, cur)) return;
    f32x4 acc[2][2][4][2];
#pragma unroll
    for (int a = 0; a < 2; ++a)
#pragma unroll
        for (int b = 0; b < 2; ++b)
#pragma unroll
            for (int m = 0; m < 4; ++m)
#pragma unroll
                for (int n = 0; n < 2; ++n) acc[a][b][m][n] = (f32x4){0.f, 0.f, 0.f, 0.f};
    if constexpr (Epi::PRELOAD) E.preload(acc, cur, wr, wc, fr, fq);
    bf16x8 At[4][2], B0[2][2], B1[2][2];
    const char* cA = (const char*)g.A + a_off(cur.pm); const char* cB = (const char*)g.Bt + (size_t)cur.pn * tstep;
    S.a_ready(cur);
    if constexpr (SP2) {
        PG8_STAGE(PG8_SB(0, 0), cB, voffB); PG8_STAGE(PG8_SB(0, 1), cB + hstep, voffB); PG8_STAGE(PG8_SA(0, 0), cA, voffA); PG8_STAGE(PG8_SA(0, 1), cA + hstep, voffA);
        if (wr == 1) PG8_BAR;
        PG8_WAIT_V(2); PG8_BAR;
        PG8_STAGE(PG8_SB(1, 0), cB + kstep, voffB); PG8_STAGE(PG8_SA(1, 0), cA + kstep, voffA); PG8_STAGE(PG8_SB(1, 1), cB + hstep + kstep, voffB);
        PG8_WAIT_V(6); PG8_BAR;
    } else {
        PG8_STAGE(PG8_SB(0, 0), cB, voffB); PG8_STAGE(PG8_SA(0, 0), cA, voffA); PG8_STAGE(PG8_SB(0, 1), cB + hstep, voffB); PG8_STAGE(PG8_SA(0, 1), cA + hstep, voffA);
        if (wr == 1) PG8_BAR;
        PG8_WAIT_V(4); PG8_BAR;
        PG8_STAGE(PG8_SB(1, 0), cB + kstep, voffB); PG8_STAGE(PG8_SA(1, 0), cA + kstep, voffA); PG8_STAGE(PG8_SB(1, 1), cB + hstep + kstep, voffB);
        PG8_WAIT_V(6); PG8_BAR;
    }
    for (;;) {
        const bool has_next = S.next(ui + 1, nxt);
        const char* nA = has_next ? (const char*)g.A + a_off(nxt.pm) : cA; const char* nB = has_next ? (const char*)g.Bt + (size_t)nxt.pn * tstep : cB;
        for (int t = 0; t < nt; t += 2) {
            const bool last = (t == nt - 2);
            const char* a1 = cA + (size_t)(t + 1) * kstep;
            const char* a2 = last ? nA : cA + (size_t)(t + 2) * kstep; const char* b2 = last ? nB : cB + (size_t)(t + 2) * kstep;
            const char* a3 = a2 + kstep; const char* b3 = b2 + kstep;
            if (last && has_next) S.a_ready(nxt);
            if constexpr (SP2) {
            PG8_LDB(B0, 0, 0); PG8_LDB(B1, 0, 1); PG8_SCHED; PG8_LDA(At, 0, 0); PG8_STAGE(PG8_SA(1, 1), a1 + hstep, voffA);
            PG8_WAIT_V(8); PG8_WAIT_L(0); PG8_BAR; PG8_MMA(0, 0, At, B0); PG8_MMA(0, 1, At, B1); PG8_BAR; PG8_SCHED;
            PG8_LDA(At, 0, 1); PG8_STAGE(PG8_SB(0, 0), b2, voffB); PG8_STAGE(PG8_SB(0, 1), b2 + hstep, voffB); PG8_STAGE(PG8_SA(0, 0), a2, voffA);
            PG8_WAIT_V(8); PG8_WAIT_L(0); PG8_BAR; PG8_MMA(1, 0, At, B0); PG8_MMA(1, 1, At, B1); PG8_BAR; PG8_SCHED;
            PG8_LDB(B0, 1, 0); PG8_LDB(B1, 1, 1); PG8_SCHED; PG8_LDA(At, 1, 0); PG8_STAGE(PG8_SA(0, 1), a2 + hstep, voffA);
            PG8_WAIT_V(8); PG8_WAIT_L(0); PG8_BAR; PG8_MMA(0, 0, At, B0); PG8_MMA(0, 1, At, B1); PG8_BAR; PG8_SCHED;
            PG8_LDA(At, 1, 1); PG8_STAGE(PG8_SB(1, 0), b3, voffB); PG8_STAGE(PG8_SB(1, 1), b3 + hstep, voffB); PG8_STAGE(PG8_SA(1, 0), a3, voffA);
            PG8_WAIT_V(8); PG8_WAIT_L(0); PG8_BAR; PG8_MMA(1, 0, At, B0); PG8_MMA(1, 1, At, B1); PG8_BAR; PG8_SCHED;
            } else {
            PG8_LDB(B0, 0, 0); PG8_SCHED; PG8_LDA(At, 0, 0); PG8_STAGE(PG8_SA(1, 1), a1 + hstep, voffA);
            PG8_WAIT_L(8); PG8_BAR; PG8_WAIT_L(0); PG8_MMA(0, 0, At, B0); PG8_BAR; PG8_SCHED;
            PG8_LDB(B1, 0, 1); PG8_STAGE(PG8_SB(0, 0), b2, voffB);
            PG8_BAR; PG8_WAIT_L(0); PG8_MMA(0, 1, At, B1); PG8_BAR;
            PG8_LDA(At, 0, 1); PG8_STAGE(PG8_SA(0, 0), a2, voffA);
            PG8_BAR; PG8_WAIT_L(0); PG8_MMA(1, 0, At, B0); PG8_BAR; PG8_SCHED;
            PG8_STAGE(PG8_SB(0, 1), b2 + hstep, voffB);
            PG8_WAIT_V(6); PG8_BAR; PG8_MMA(1, 1, At, B1); PG8_BAR;
            PG8_LDB(B0, 1, 0); PG8_SCHED; PG8_LDA(At, 1, 0); PG8_STAGE(PG8_SA(0, 1), a2 + hstep, voffA);
            PG8_WAIT_L(8); PG8_BAR; PG8_WAIT_L(0); PG8_MMA(0, 0, At, B0); PG8_BAR; PG8_SCHED;
            PG8_LDB(B1, 1, 1); PG8_STAGE(PG8_SB(1, 0), b3, voffB);
            PG8_BAR; PG8_WAIT_L(0); PG8_MMA(0, 1, At, B1); PG8_BAR;
            PG8_LDA(At, 1, 1); PG8_STAGE(PG8_SA(1, 0), a3, voffA);
            PG8_BAR; PG8_WAIT_L(0); PG8_MMA(1, 0, At, B0); PG8_BAR; PG8_SCHED;
            PG8_STAGE(PG8_SB(1, 1), b3 + hstep, voffB);
            PG8_WAIT_V(6); PG8_BAR; PG8_MMA(1, 1, At, B1); PG8_BAR;
            }
        }
        if constexpr (ALIGN_EPI) { if (wr == 0) PG8_BAR; }
        if constexpr (!Epi::AFTER_DRAIN) { E(acc, cur, wr, wc, fr, fq); S.done(cur); }
        if (!has_next) break;
#pragma unroll
        for (int a = 0; a < 2; ++a)
#pragma unroll
            for (int b = 0; b < 2; ++b)
#pragma unroll
                for (int m = 0; m < 4; ++m)
#pragma unroll
                    for (int n = 0; n < 2; ++n) acc[a][b][m][n] = (f32x4){0.f, 0.f, 0.f, 0.f};
        if constexpr (Epi::PRELOAD) { E.preload(acc, nxt, wr, wc, fr, fq); PG8_WAIT_V(0); }
        cur = nxt; cA = nA; cB = nB; ++ui;
        if constexpr (ALIGN_EPI) { if (wr == 1) PG8_BAR; }
    }
    PG8_WAIT_V(0);
    if constexpr (!ALIGN_EPI) { if (wr == 0) PG8_BAR; }
    PG8_BAR;
    if constexpr (Epi::AFTER_DRAIN) { E.fused(acc, cur, wr, wc, fr, fq, lds, wid, lane); S.done(cur); }
#undef PG8_SA
#undef PG8_SB
#undef PG8_STAGE
#undef PG8_LDA
#undef PG8_LDB
#undef PG8_MMA
#undef PG8_WAIT_V
#undef PG8_WAIT_L
#undef PG8_BAR
#undef PG8_SCHED
}
}

#define LAS __attribute__((address_space(3)))
typedef unsigned short bf16;
typedef unsigned u32x4 __attribute__((ext_vector_type(4)));
typedef unsigned u32x2 __attribute__((ext_vector_type(2)));
typedef float f32x4 __attribute__((ext_vector_type(4)));
typedef short bf16x8 __attribute__((ext_vector_type(8)));
constexpr int D = 1024, SEQ = 8192, NB = 2, NMETA = 16, TT = SEQ + NMETA, M = NB * SEQ, DEPTH = 4, DIN = 1536, FF = 4096, DH = 512;
constexpr float EPS = 1e-6f;
constexpr size_t MiB = 1u << 20;
constexpr size_t WS_CTL = 0;
constexpr size_t WS_POOLW = 1 * MiB, WS_GR = WS_POOLW + 512 * 1024, WS_GI = WS_GR + 256 * 1024;
constexpr size_t WS_SP = 2 * MiB, WS_HMETA = WS_SP + 64 * 1024, WS_MIDMETA = WS_HMETA + 64 * 1024;
constexpr size_t WS_SS = 3 * MiB, WS_CARA = 4 * MiB, WS_CARH = WS_CARA + 512 * 1024;
constexpr size_t WS_W = 8 * MiB, W_LAYER = 21 * MiB, W_IN = 0, W_OUT = 3 * MiB, W_UP = 5 * MiB, W_DOWN = 13 * MiB;
constexpr size_t WS_HB = 92 * MiB, WS_MID = 124 * MiB;
constexpr size_t WS_PROJ = WS_MID, WS_Y = WS_MID + 48 * MiB + 256 * 1024, WS_HL = WS_Y + 32 * MiB + 256 * 1024, WS_P = WS_HL + 32 * MiB + 256 * 1024, WS_END = 256 * MiB;
static_assert(WS_PROJ + (size_t)NB * TT * DIN * 2 <= WS_Y && WS_Y + (size_t)NB * TT * D * 2 <= WS_HL && WS_HL + (size_t)NB * TT * DH * 4 <= WS_P && WS_P + (size_t)NB * TT * DH * 2 <= WS_END, "ws map");
static_assert(WS_W + DEPTH * W_LAYER <= WS_HB && WS_HB + (size_t)M * D * 2 <= WS_MID && WS_MID + (size_t)M * FF * 2 <= WS_END, "ws map 2");
constexpr int LDS_XST = 147456;
constexpr int LDS_BYTES = 147456 + 1024;

struct Params {
    const float* in[20];
    float* out;
    unsigned char* ws;
};

__device__ __forceinline__ unsigned cvt_pk(float lo, float hi) { return pg8::cvt_pk_bf16(lo, hi); }
__device__ __forceinline__ float bf_lo(unsigned w) { return __builtin_bit_cast(float, w << 16); }
__device__ __forceinline__ float bf_hi(unsigned w) { return __builtin_bit_cast(float, w & 0xffff0000u); }
__device__ __forceinline__ void unpack8(const u32x4 w, float (&f)[8]) {
    f[0] = bf_lo(w.x); f[1] = bf_hi(w.x); f[2] = bf_lo(w.y); f[3] = bf_hi(w.y); f[4] = bf_lo(w.z); f[5] = bf_hi(w.z); f[6] = bf_lo(w.w); f[7] = bf_hi(w.w);
}
__device__ __forceinline__ u32x4 pack8(const float (&f)[8]) { u32x4 w; w.x = cvt_pk(f[0], f[1]); w.y = cvt_pk(f[2], f[3]); w.z = cvt_pk(f[4], f[5]); w.w = cvt_pk(f[6], f[7]); return w; }
__device__ __forceinline__ float wave_sum(float v) {
#pragma unroll
    for (int o = 1; o < 64; o <<= 1) v += __shfl_xor(v, o);
    return v;
}
template <int CTRL> __device__ __forceinline__ float dppf(float old, float src) {
    return __builtin_bit_cast(float, __builtin_amdgcn_update_dpp(__builtin_bit_cast(int, old), __builtin_bit_cast(int, src), CTRL, 0xf, 0xf, false));
}
template <int DD> __device__ __forceinline__ float shiftd(float cur, float prev) {
    const float t = dppf<0x100 + (16 - DD)>(0.f, prev);
    return dppf<0x110 + DD>(t, cur);
}
__device__ __forceinline__ float sigm(float v) { return __builtin_amdgcn_rcpf(1.0f + __expf(-v)); }
__device__ __forceinline__ int outchan(int n, int rho) { return 32 * (n >> 1) + 8 * (rho >> 2) + 4 * (n & 1) + (rho & 3); }

__device__ __forceinline__ float row_rstd(const float* ss, int r) {
    const f32x4* s4 = (const f32x4*)(ss + (size_t)r * 16);
    const f32x4 a = s4[0], b = s4[1], c = s4[2], d = s4[3];
    const float s = ((a.x + a.y) + (a.z + a.w)) + ((b.x + b.y) + (b.z + b.w)) + ((c.x + c.y) + (c.z + c.w)) + ((d.x + d.y) + (d.z + d.w));
    return 1.0f / sqrtf(s * (1.0f / D) + EPS);
}
__device__ __forceinline__ void rows_rstd(const float* ss, int rowbase  , int fr, float (&rs)[2][4]) {
    const int lane = threadIdx.x & 63;
    const float r0 = row_rstd(ss, rowbase + lane), r1 = row_rstd(ss, rowbase + 128 + lane);
#pragma unroll
    for (int m = 0; m < 4; ++m) { rs[0][m] = __shfl(r0, m * 16 + fr); rs[1][m] = __shfl(r1, m * 16 + fr); }
}
struct EpiIn {
    static constexpr bool PERM = true, AFTER_DRAIN = false, PRELOAD = false;
    bf16* P; const float* ss;
    __device__ __forceinline__ void operator()(const f32x4 (&acc)[2][2][4][2], const pg8::Unit& u, int wr, int wc, int fr, int fq) const {
        const int row0 = u.pm * 256 + wr * 64 + fr, col0 = u.pn * 256 + wc * 32 + 8 * fq;
        float rsv[2][4]; rows_rstd(ss, u.pm * 256 + wr * 64, fr, rsv);
#pragma unroll
        for (int ai = 0; ai < 2; ++ai)
#pragma unroll
            for (int m = 0; m < 4; ++m) {
                const int r = row0 + ai * 128 + m * 16; const float rs = rsv[ai][m];
                bf16* rowp = P + (size_t)(r + NMETA * (1 + (r >> 13))) * DIN + col0;
#pragma unroll
                for (int bj = 0; bj < 2; ++bj) { const f32x4 v0 = acc[ai][bj][m][0] * rs, v1 = acc[ai][bj][m][1] * rs;
                    u32x4 w; w.x = cvt_pk(v0[0], v0[1]); w.y = cvt_pk(v0[2], v0[3]); w.z = cvt_pk(v1[0], v1[1]); w.w = cvt_pk(v1[2], v1[3]);
                    *(u32x4*)(rowp + bj * 128) = w; }
            }
    }
};
struct EpiUp {
    static constexpr bool PERM = true, AFTER_DRAIN = false, PRELOAD = false;
    bf16* O; const float* ss;
    __device__ __forceinline__ void operator()(const f32x4 (&acc)[2][2][4][2], const pg8::Unit& u, int wr, int wc, int fr, int fq) const {
        const int row0 = u.pm * 256 + wr * 64 + fr, col0 = u.pn * 256 + wc * 32 + 8 * fq;
        float rsv[2][4]; rows_rstd(ss, u.pm * 256 + wr * 64, fr, rsv);
#pragma unroll
        for (int ai = 0; ai < 2; ++ai)
#pragma unroll
            for (int m = 0; m < 4; ++m) {
                const int r = row0 + ai * 128 + m * 16; const float rs = rsv[ai][m];
                bf16* rowp = O + (size_t)r * FF + col0;
#pragma unroll
                for (int bj = 0; bj < 2; ++bj) { f32x4 v0 = acc[ai][bj][m][0] * rs, v1 = acc[ai][bj][m][1] * rs;
#pragma unroll
                    for (int j = 0; j < 4; ++j) { v0[j] = fmaxf(v0[j], 0.f); v0[j] *= v0[j]; v1[j] = fmaxf(v1[j], 0.f); v1[j] *= v1[j]; }
                    u32x4 w; w.x = cvt_pk(v0[0], v0[1]); w.y = cvt_pk(v0[2], v0[3]); w.z = cvt_pk(v1[0], v1[1]); w.w = cvt_pk(v1[2], v1[3]);
                    *(u32x4*)(rowp + bj * 128) = w; }
            }
    }
};
struct EpiRes {
    static constexpr bool PERM = true, AFTER_DRAIN = false, PRELOAD = true;
    const float* base; float* out; bf16* hb; float* ssn;
    __device__ __forceinline__ void preload(f32x4 (&acc)[2][2][4][2], const pg8::Unit& u, int wr, int wc, int fr, int fq) const {
        const int row0 = u.pm * 256 + wr * 64 + fr, col0 = u.pn * 256 + wc * 32 + 8 * fq;
#pragma unroll
        for (int ai = 0; ai < 2; ++ai)
#pragma unroll
            for (int m = 0; m < 4; ++m) { const size_t off = (size_t)(row0 + ai * 128 + m * 16) * D + col0;
#pragma unroll
                for (int bj = 0; bj < 2; ++bj) { acc[ai][bj][m][0] = *(const f32x4*)(base + off + bj * 128); acc[ai][bj][m][1] = *(const f32x4*)(base + off + bj * 128 + 4); } }
    }
    __device__ __forceinline__ void operator()(const f32x4 (&acc)[2][2][4][2], const pg8::Unit& u, int wr, int wc, int fr, int fq) const {
        const int row0 = u.pm * 256 + wr * 64 + fr, col0 = u.pn * 256 + wc * 32 + 8 * fq;
#pragma unroll
        for (int ai = 0; ai < 2; ++ai)
#pragma unroll
            for (int m = 0; m < 4; ++m) {
                const int r = row0 + ai * 128 + m * 16; const size_t off = (size_t)r * D + col0; float s = 0.f;
#pragma unroll
                for (int bj = 0; bj < 2; ++bj) {
                    const f32x4 o0 = acc[ai][bj][m][0], o1 = acc[ai][bj][m][1];
                    *(f32x4*)(out + off + bj * 128) = o0; *(f32x4*)(out + off + bj * 128 + 4) = o1;
                    s += (o0[0] * o0[0] + o0[1] * o0[1]) + (o0[2] * o0[2] + o0[3] * o0[3]) + (o1[0] * o1[0] + o1[1] * o1[1]) + (o1[2] * o1[2] + o1[3] * o1[3]);
                    u32x4 w; w.x = cvt_pk(o0[0], o0[1]); w.y = cvt_pk(o0[2], o0[3]); w.z = cvt_pk(o1[0], o1[1]); w.w = cvt_pk(o1[2], o1[3]);
                    *(u32x4*)(hb + off + bj * 128) = w; }
                s += __shfl_xor(s, 16); s += __shfl_xor(s, 32);
                if (fq == 0) ssn[(size_t)r * 16 + u.pn * 4 + wc] = s;
            }
    }
};

__device__ __forceinline__ void transpose_item(const float* W, const float* gk, int K, int N, bf16* WT, LAS float* scr, int item, int lane) {
    const int nblk = N / 32, kb = item / nblk, nb = item % nblk, k0 = 64 * kb, n0 = 32 * nb;
    const int lr = lane >> 3, lc = (lane & 7) * 4;
    f32x4 v[8]; float gs[8];
#pragma unroll
    for (int i = 0; i < 8; ++i) { v[i] = *(const f32x4*)(W + (size_t)(k0 + 8 * i + lr) * N + n0 + lc); gs[i] = gk ? gk[k0 + 8 * i + lr] : 1.0f; }
#pragma unroll
    for (int i = 0; i < 8; ++i) { LAS float* d = scr + (8 * i + lr) * 33 + lc; d[0] = v[i].x * gs[i]; d[1] = v[i].y * gs[i]; d[2] = v[i].z * gs[i]; d[3] = v[i].w * gs[i]; }
    asm volatile("s_waitcnt lgkmcnt(0)" ::: "memory");
    const int c = lane & 7;
#pragma unroll
    for (int j = 0; j < 4; ++j) { const int n = (lane >> 3) + 8 * j; const LAS float* s = scr + (8 * c) * 33 + n;
        u32x4 o; o.x = cvt_pk(s[0 * 33], s[1 * 33]); o.y = cvt_pk(s[2 * 33], s[3 * 33]); o.z = cvt_pk(s[4 * 33], s[5 * 33]); o.w = cvt_pk(s[6 * 33], s[7 * 33]);
        *(u32x4*)(WT + (size_t)(n0 + n) * K + k0 + 8 * c) = o; }
    asm volatile("s_waitcnt lgkmcnt(0)" ::: "memory");
}
__device__ __forceinline__ void prologue(const Params& p, LAS unsigned char* lds, int G) {
    int tid_ = threadIdx.x; asm volatile("" : "+v"(tid_));
    const int tid = tid_, lane = tid & 63, wid = __builtin_amdgcn_readfirstlane(tid >> 6);
    LAS float* scr = (LAS float*)(lds + wid * 16384);
    const int gw = blockIdx.x * 8 + wid, NGW = G * 8;
    constexpr int I_IN = 16 * 48, I_OUT = 16 * 32, I_UP = 16 * 128, I_DN = 64 * 32, I_PW = 4 * 8, I_G = 8 * 2, I_L = I_IN + I_OUT + I_UP + I_DN + I_PW + 2 * I_G;
    unsigned char* ws = p.ws;
    for (int it = gw; it < DEPTH * I_L; it += NGW) {
        const int l = it / I_L; int r = it % I_L;
        unsigned char* wl = ws + WS_W + (size_t)l * W_LAYER;
        if (r < I_IN) { transpose_item(p.in[3] + (size_t)l * D * DIN, p.in[2] + l * D, D, DIN, (bf16*)(wl + W_IN), scr, r, lane); continue; } r -= I_IN;
        if (r < I_OUT) { transpose_item(p.in[15] + (size_t)l * D * D, p.in[14] + l * D, D, D, (bf16*)(wl + W_OUT), scr, r, lane); continue; } r -= I_OUT;
        if (r < I_UP) { transpose_item(p.in[17] + (size_t)l * D * FF, p.in[16] + l * D, D, FF, (bf16*)(wl + W_UP), scr, r, lane); continue; } r -= I_UP;
        if (r < I_DN) { transpose_item(p.in[18] + (size_t)l * FF * D, nullptr, FF, D, (bf16*)(wl + W_DOWN), scr, r, lane); continue; } r -= I_DN;
        if (r < I_PW) { const int g = r / 8; transpose_item(p.in[4] + (size_t)(l * 4 + g) * 16384, nullptr, 128, 128, (bf16*)(ws + WS_POOLW) + (size_t)(l * 4 + g) * 16384, scr, r % 8, lane); continue; } r -= I_PW;
        if (r < I_G) { const int h = r / 2; transpose_item(p.in[9] + (size_t)(l * 8 + h) * 4096, nullptr, 64, 64, (bf16*)(ws + WS_GR) + (size_t)(l * 8 + h) * 4096, scr, r % 2, lane); continue; } r -= I_G;
        { const int h = r / 2; transpose_item(p.in[11] + (size_t)(l * 8 + h) * 4096, nullptr, 64, 64, (bf16*)(ws + WS_GI) + (size_t)(l * 8 + h) * 4096, scr, r % 2, lane); }
    }
    const float* x = p.in[0]; bf16* hb = (bf16*)(ws + WS_HB); float* ss = (float*)(ws + WS_SS);
    for (int m2 = gw; m2 < M / 2; m2 += NGW) {
        f32x4 v[2][4]; float s[2] = {0.f, 0.f};
#pragma unroll
        for (int r = 0; r < 2; ++r) { const f32x4* xr = (const f32x4*)(x + (size_t)(2 * m2 + r) * D) + lane;
#pragma unroll
            for (int j = 0; j < 4; ++j) v[r][j] = xr[64 * j]; }
#pragma unroll
        for (int r = 0; r < 2; ++r) {
#pragma unroll
            for (int j = 0; j < 4; ++j) s[r] += (v[r][j].x * v[r][j].x + v[r][j].y * v[r][j].y) + (v[r][j].z * v[r][j].z + v[r][j].w * v[r][j].w);
            s[r] = wave_sum(s[r]);
            u32x2* o8 = (u32x2*)(hb + (size_t)(2 * m2 + r) * D) + lane;
#pragma unroll
            for (int j = 0; j < 4; ++j) { u32x2 w; w.x = cvt_pk(v[r][j].x, v[r][j].y); w.y = cvt_pk(v[r][j].z, v[r][j].w); o8[64 * j] = w; }
            if (lane < 16) ss[(size_t)(2 * m2 + r) * 16 + lane] = lane == 0 ? s[r] : 0.f;
        }
    }
    float* hm = (float*)(ws + WS_HMETA); float* sp = (float*)(ws + WS_SP);
    for (int i = blockIdx.x * 512 + tid; i < NMETA * D; i += G * 512) hm[i] = p.in[1][i];
    for (int i = blockIdx.x * 512 + tid; i < DEPTH * DH; i += G * 512) sp[i] = log1pf(expf(-p.in[13][i]));
}

template <int MODE> __device__ __forceinline__ void meta_tasks(const Params& p, LAS unsigned char* lds, int G, const bf16* Ab, int lda, const bf16* Bt, int K, int ntasks) {
    int tid_ = threadIdx.x; asm volatile("" : "+v"(tid_));
    const int tid = tid_, lane = tid & 63, wid = __builtin_amdgcn_readfirstlane(tid >> 6), fr = lane & 15, fq = lane >> 4;
    float* hm = (float*)(p.ws + WS_HMETA);
    LAS float* red = (LAS float*)lds;
    for (int task = G - 1 - (int)blockIdx.x; task < ntasks; task += G) {
        const int n0 = task * 16, kw = K / 8, k0 = wid * kw;
        f32x4 acc = {0.f, 0.f, 0.f, 0.f}; float ssq = 0.f;
        for (int kk = k0; kk < k0 + kw; kk += 32) {
            bf16x8 af;
            if (MODE == 1) af = *(const bf16x8*)(Ab + (size_t)fr * lda + kk + 8 * fq);
            else { const f32x4 a0 = *(const f32x4*)(hm + fr * D + kk + 8 * fq), a1 = *(const f32x4*)(hm + fr * D + kk + 8 * fq + 4);
                ssq += (a0.x * a0.x + a0.y * a0.y) + (a0.z * a0.z + a0.w * a0.w) + (a1.x * a1.x + a1.y * a1.y) + (a1.z * a1.z + a1.w * a1.w);
                u32x4 w; w.x = cvt_pk(a0.x, a0.y); w.y = cvt_pk(a0.z, a0.w); w.z = cvt_pk(a1.x, a1.y); w.w = cvt_pk(a1.z, a1.w); af = __builtin_bit_cast(bf16x8, w); }
            const bf16x8 bfr = *(const bf16x8*)(Bt + (size_t)(n0 + fr) * K + kk + 8 * fq);
            acc = __builtin_amdgcn_mfma_f32_16x16x32_bf16(bfr, af, acc, 0, 0, 0);
        }
        ssq += __shfl_xor(ssq, 16); ssq += __shfl_xor(ssq, 32);
        LAS float* rp = red + (wid * 64 + lane) * 5;
        rp[0] = acc[0]; rp[1] = acc[1]; rp[2] = acc[2]; rp[3] = acc[3]; rp[4] = ssq;
        __syncthreads();
        if (wid == 0) {
            float a0 = 0.f, a1 = 0.f, a2 = 0.f, a3 = 0.f, sq = 0.f;
#pragma unroll
            for (int w = 0; w < 8; ++w) { const LAS float* q = red + (w * 64 + lane) * 5; a0 += q[0]; a1 += q[1]; a2 += q[2]; a3 += q[3]; sq += q[4]; }
            const int col = n0 + 4 * fq;
            if (MODE == 1) { f32x4* hp = (f32x4*)(hm + fr * D + col); f32x4 h = *hp; h.x += a0; h.y += a1; h.z += a2; h.w += a3; *hp = h; }
            else {
                const float rs = 1.0f / sqrtf(sq * (1.0f / D) + EPS); a0 *= rs; a1 *= rs; a2 *= rs; a3 *= rs;
                if (MODE == 0) { u32x2 w; w.x = cvt_pk(a0, a1); w.y = cvt_pk(a2, a3); bf16* pr = (bf16*)(p.ws + WS_PROJ);
                    *(u32x2*)(pr + (size_t)fr * DIN + col) = w; *(u32x2*)(pr + (size_t)(TT + fr) * DIN + col) = w; }
                else { a0 = fmaxf(a0, 0.f); a1 = fmaxf(a1, 0.f); a2 = fmaxf(a2, 0.f); a3 = fmaxf(a3, 0.f);
                    u32x2 w; w.x = cvt_pk(a0 * a0, a1 * a1); w.y = cvt_pk(a2 * a2, a3 * a3); *(u32x2*)((bf16*)(p.ws + WS_MIDMETA) + (size_t)fr * FF + col) = w; }
            }
        }
        __syncthreads();
    }
}

__device__ __forceinline__ void m1_phase(const Params& p, LAS unsigned char* lds, int G, int l) {
    int tid_ = threadIdx.x; asm volatile("" : "+v"(tid_));
    const int tid = tid_, lane = tid & 63, wid = __builtin_amdgcn_readfirstlane(tid >> 6), fr = lane & 15, fq = lane >> 4;
    LAS float* cst = (LAS float*)lds;
    for (int i = tid; i < 8 * DH; i += 512) { const int row = i >> 9, ch = i & 511; float v;
        if (row < 4) v = p.in[7][(l * 4 + row) * DH + ch]; else if (row == 4) v = p.in[8][l * DH + ch]; else if (row == 5) v = p.in[10][l * DH + ch];
        else if (row == 6) v = p.in[12][l * DH + ch]; else v = ((const float*)(p.ws + WS_SP))[l * DH + ch];
        cst[i] = v; }
    const bf16* proj = (const bf16*)(p.ws + WS_PROJ);
    const bf16* Wr = (const bf16*)(p.ws + WS_GR) + (size_t)(l * 8 + wid) * 4096; const bf16* Wi = (const bf16*)(p.ws + WS_GI) + (size_t)(l * 8 + wid) * 4096;
    LAS bf16x8* wl = (LAS bf16x8*)(lds + 16384 + wid * 16384) + lane;
#pragma unroll
    for (int n = 0; n < 4; ++n)
#pragma unroll
        for (int ks = 0; ks < 2; ++ks) {
            wl[((n * 2 + ks) * 2 + 0) * 64] = *(const bf16x8*)(Wr + outchan(n, fr) * 64 + 32 * ks + 8 * fq);
            wl[((n * 2 + ks) * 2 + 1) * 64] = *(const bf16x8*)(Wi + outchan(n, fr) * 64 + 32 * ks + 8 * fq); }
    __syncthreads();
    float* hl = (float*)(p.ws + WS_HL); bf16* Pp = (bf16*)(p.ws + WS_P);
    float* carA = (float*)(p.ws + WS_CARA); float* carH = (float*)(p.ws + WS_CARH);
    for (int unit = blockIdx.x; unit < 256; unit += G) {
        const int b = unit >> 7, c = unit & 127, t0 = c ? NMETA + 64 * c : 0, NM = c ? 4 : 5;
        float Hc[16], Pc[16];
#pragma unroll
        for (int k = 0; k < 16; ++k) { Hc[k] = 0.f; Pc[k] = 1.f; }
        u32x4 raw[2][4];
#pragma unroll
        for (int ks = 0; ks < 2; ++ks)
#pragma unroll
            for (int d = 0; d < 4; ++d) { const int tt = t0 + fr - 3 + d; raw[ks][d] = (u32x4){0u, 0u, 0u, 0u};
                if (tt >= 0) raw[ks][d] = *(const u32x4*)(proj + ((size_t)b * TT + tt) * DIN + DH + wid * 64 + 32 * ks + 8 * fq); }
#pragma unroll 1
        for (int m = 0; m < NM; ++m) {
            const int t = t0 + 16 * m + fr; const size_t rowg = (size_t)b * TT + t;
            u32x4 nraw[2][4];
#pragma unroll
            for (int ks = 0; ks < 2; ++ks)
#pragma unroll
                for (int d = 0; d < 4; ++d) { nraw[ks][d] = (u32x4){0u, 0u, 0u, 0u};
                    if (m + 1 < NM) nraw[ks][d] = *(const u32x4*)(proj + ((size_t)b * TT + t + 13 + d) * DIN + DH + wid * 64 + 32 * ks + 8 * fq); }
            float xc[2][8]; bf16x8 frag[2];
#pragma unroll
            for (int ks = 0; ks < 2; ++ks) {
                const int chb = wid * 64 + 32 * ks + 8 * fq;
                { const f32x4 c0 = *(const LAS f32x4*)(cst + 4 * DH + chb), c1 = *(const LAS f32x4*)(cst + 4 * DH + chb + 4);
                  xc[ks][0] = c0.x; xc[ks][1] = c0.y; xc[ks][2] = c0.z; xc[ks][3] = c0.w; xc[ks][4] = c1.x; xc[ks][5] = c1.y; xc[ks][6] = c1.z; xc[ks][7] = c1.w; }
#pragma unroll
                for (int d = 0; d < 4; ++d) {
                    float u[8]; unpack8(raw[ks][d], u);
                    const f32x4 w0 = *(const LAS f32x4*)(cst + d * DH + chb), w1 = *(const LAS f32x4*)(cst + d * DH + chb + 4);
                    xc[ks][0] += u[0] * w0.x; xc[ks][1] += u[1] * w0.y; xc[ks][2] += u[2] * w0.z; xc[ks][3] += u[3] * w0.w;
                    xc[ks][4] += u[4] * w1.x; xc[ks][5] += u[5] * w1.y; xc[ks][6] += u[6] * w1.z; xc[ks][7] += u[7] * w1.w;
                    raw[ks][d] = nraw[ks][d];
                }
                frag[ks] = __builtin_bit_cast(bf16x8, pack8(xc[ks]));
            }
            f32x4 ar[4], ai[4];
#pragma unroll
            for (int n = 0; n < 4; ++n) { ar[n] = (f32x4){0.f, 0.f, 0.f, 0.f}; ai[n] = (f32x4){0.f, 0.f, 0.f, 0.f};
#pragma unroll
                for (int ks = 0; ks < 2; ++ks) {
                    const bf16x8 wr_ = wl[((n * 2 + ks) * 2 + 0) * 64], wi_ = wl[((n * 2 + ks) * 2 + 1) * 64];
                    ar[n] = __builtin_amdgcn_mfma_f32_16x16x32_bf16(wr_, frag[ks], ar[n], 0, 0, 0);
                    ai[n] = __builtin_amdgcn_mfma_f32_16x16x32_bf16(wi_, frag[ks], ai[n], 0, 0, 0);
                } }
            float Aa[16], Bb[16];
#pragma unroll
            for (int n = 0; n < 4; ++n) {
                const int cho = wid * 64 + 32 * (n >> 1) + 8 * fq + 4 * (n & 1);
                const f32x4 rb = *(const LAS f32x4*)(cst + 5 * DH + cho), ib = *(const LAS f32x4*)(cst + 6 * DH + cho), spv = *(const LAS f32x4*)(cst + 7 * DH + cho);
#pragma unroll
                for (int jj = 0; jj < 4; ++jj) {
                    const float r = sigm(ar[n][jj] + rb[jj]), ig = sigm(ai[n][jj] + ib[jj]);
                    const float la = -8.0f * r * spv[jj], a = __expf(la), x2 = 2.0f * la;
                    const float m2s = -x2 * (1.0f + x2 * (0.5f + x2 * (0.16666667f + x2 * 0.041666668f))), m2 = (x2 > -0.0625f) ? m2s : 1.0f - a * a;
                    Aa[n * 4 + jj] = a; Bb[n * 4 + jj] = __builtin_amdgcn_sqrtf(m2) * ig * xc[n >> 1][4 * (n & 1) + jj];
                }
            }
#pragma unroll
            for (int k = 0; k < 16; ++k) {
                float A = Aa[k], B = Bb[k], Ap, Bq;
                Ap = dppf<0x111>(1.f, A); Bq = dppf<0x111>(0.f, B); B = fmaf(A, Bq, B); A *= Ap;
                Ap = dppf<0x112>(1.f, A); Bq = dppf<0x112>(0.f, B); B = fmaf(A, Bq, B); A *= Ap;
                Ap = dppf<0x114>(1.f, A); Bq = dppf<0x114>(0.f, B); B = fmaf(A, Bq, B); A *= Ap;
                Ap = dppf<0x118>(1.f, A); Bq = dppf<0x118>(0.f, B); B = fmaf(A, Bq, B); A *= Ap;
                Bb[k] = fmaf(A, Hc[k], B); Aa[k] = A * Pc[k];
            }
#pragma unroll
            for (int ks = 0; ks < 2; ++ks) {
                const size_t o = rowg * DH + wid * 64 + 32 * ks + 8 * fq;
                *(f32x4*)(hl + o) = (f32x4){Bb[8 * ks + 0], Bb[8 * ks + 1], Bb[8 * ks + 2], Bb[8 * ks + 3]};
                *(f32x4*)(hl + o + 4) = (f32x4){Bb[8 * ks + 4], Bb[8 * ks + 5], Bb[8 * ks + 6], Bb[8 * ks + 7]};
                u32x4 w; w.x = cvt_pk(Aa[8 * ks + 0], Aa[8 * ks + 1]); w.y = cvt_pk(Aa[8 * ks + 2], Aa[8 * ks + 3]); w.z = cvt_pk(Aa[8 * ks + 4], Aa[8 * ks + 5]); w.w = cvt_pk(Aa[8 * ks + 6], Aa[8 * ks + 7]);
                *(u32x4*)(Pp + o) = w;
            }
            const int src = (lane & 48) | 15;
#pragma unroll
            for (int k = 0; k < 16; ++k) { Hc[k] = __shfl(Bb[k], src); Pc[k] = __shfl(Aa[k], src); }
        }
        if (fr == 0) {
#pragma unroll
            for (int ks = 0; ks < 2; ++ks) {
                const size_t o = (size_t)(b * 128 + c) * DH + wid * 64 + 32 * ks + 8 * fq;
                *(f32x4*)(carA + o) = (f32x4){Pc[8 * ks + 0], Pc[8 * ks + 1], Pc[8 * ks + 2], Pc[8 * ks + 3]}; *(f32x4*)(carA + o + 4) = (f32x4){Pc[8 * ks + 4], Pc[8 * ks + 5], Pc[8 * ks + 6], Pc[8 * ks + 7]};
                *(f32x4*)(carH + o) = (f32x4){Hc[8 * ks + 0], Hc[8 * ks + 1], Hc[8 * ks + 2], Hc[8 * ks + 3]}; *(f32x4*)(carH + o + 4) = (f32x4){Hc[8 * ks + 4], Hc[8 * ks + 5], Hc[8 * ks + 6], Hc[8 * ks + 7]};
            }
        }
    }
    __syncthreads();
}


template <int NMR> __device__ __forceinline__ void m2_rnn_round(const float* hl, const bf16* Pp, const bf16* proj, bf16* Y, LAS float* red1, const float (&cr)[16], int b, int t0, int mbase, int wid, int fr, int fq) {
    f32x4 hv4[NMR][2][2]; u32x4 pw[NMR][2], gw[NMR][2];
#pragma unroll
    for (int m = 0; m < NMR; ++m)
#pragma unroll
        for (int ks = 0; ks < 2; ++ks) { const size_t rowg = (size_t)b * TT + t0 + 16 * (mbase + m) + fr; const int ch = wid * 64 + 32 * ks + 8 * fq; const size_t o = rowg * DH + ch;
            hv4[m][ks][0] = *(const f32x4*)(hl + o); hv4[m][ks][1] = *(const f32x4*)(hl + o + 4); pw[m][ks] = *(const u32x4*)(Pp + o); gw[m][ks] = *(const u32x4*)(proj + rowg * DIN + 2 * DH + ch); }
    float y[NMR][16];
#pragma unroll
    for (int m = 0; m < NMR; ++m) { float s = 0.f;
#pragma unroll
        for (int ks = 0; ks < 2; ++ks) { float pf[8], gt[8]; unpack8(pw[m][ks], pf); unpack8(gw[m][ks], gt);
            const float hh[8] = {hv4[m][ks][0].x, hv4[m][ks][0].y, hv4[m][ks][0].z, hv4[m][ks][0].w, hv4[m][ks][1].x, hv4[m][ks][1].y, hv4[m][ks][1].z, hv4[m][ks][1].w};
#pragma unroll
            for (int e = 0; e < 8; ++e) { const float hv = fmaf(pf[e], cr[8 * ks + e], hh[e]), x = gt[e];
                const float ge = x * __builtin_amdgcn_rcpf(1.0f + __expf(-1.5957691216f * (x + 0.044715f * x * x * x)));
                const float yy = hv * ge; y[m][8 * ks + e] = yy; s = fmaf(yy, yy, s); } }
        s += __shfl_xor(s, 16); s += __shfl_xor(s, 32);
        if (fq == 0) red1[(16 * (mbase + m) + fr) * 8 + wid] = s; }
    __syncthreads();
#pragma unroll
    for (int m = 0; m < NMR; ++m) { const size_t rowg = (size_t)b * TT + t0 + 16 * (mbase + m) + fr;
        const f32x4 r0 = *(const LAS f32x4*)(red1 + (16 * (mbase + m) + fr) * 8), r1 = *(const LAS f32x4*)(red1 + (16 * (mbase + m) + fr) * 8 + 4);
        const float rs = __builtin_amdgcn_rsqf((((r0.x + r0.y) + (r0.z + r0.w)) + ((r1.x + r1.y) + (r1.z + r1.w))) * (1.0f / DH) + EPS);
#pragma unroll
        for (int ks = 0; ks < 2; ++ks) { float yy[8];
#pragma unroll
            for (int e = 0; e < 8; ++e) yy[e] = y[m][8 * ks + e] * rs;
            *(u32x4*)(Y + rowg * D + DH + wid * 64 + 32 * ks + 8 * fq) = pack8(yy); } }
}


template <int NMR> __device__ __forceinline__ void m2_pool_round(const bf16* proj, bf16* Y, const bf16* Wp, const float* pbias, const float* pscale, LAS float* red2,
                                                                  int b, int t0, int mbase, int g, int half, int kwin, int wid, int fr, int fq) {
    const int tb = t0 + 16 * mbase;
    bf16x8 pfr[NMR][4];
#pragma unroll
    for (int ks = 0; ks < 4; ++ks) {
        const int chb = g * 128 + 32 * ks + 8 * fq;
        float pu[8], p2[8], p4[8], p8[8];
        if (tb) { const u32x4 raw = *(const u32x4*)(proj + ((size_t)b * TT + tb - 16 + fr) * DIN + chb); unpack8(raw, pu);
#pragma unroll
            for (int e = 0; e < 8; ++e) { p2[e] = pu[e] + dppf<0x111>(0.f, pu[e]); p4[e] = p2[e] + dppf<0x112>(0.f, p2[e]); p8[e] = p4[e] + dppf<0x114>(0.f, p4[e]); } }
        else {
#pragma unroll
            for (int e = 0; e < 8; ++e) { pu[e] = 0.f; p2[e] = 0.f; p4[e] = 0.f; p8[e] = 0.f; } }
#pragma unroll
        for (int m = 0; m < NMR; ++m) {
            const int t = tb + 16 * m + fr; const size_t rowg = (size_t)b * TT + t;
            const u32x4 raw = *(const u32x4*)(proj + rowg * DIN + chb); float u[8], po[8]; unpack8(raw, u);
            const int cnt = (t + 1 < kwin) ? t + 1 : kwin; const float rc = __builtin_amdgcn_rcpf((float)cnt);
#pragma unroll
            for (int e = 0; e < 8; ++e) {
                const float s2 = u[e] + shiftd<1>(u[e], pu[e]), s4 = s2 + shiftd<2>(s2, p2[e]), s8 = s4 + shiftd<4>(s4, p4[e]), s16 = s8 + shiftd<8>(s8, p8[e]);
                const float win = g == 0 ? s2 : (g == 1 ? s4 : (g == 2 ? s8 : s16));
                po[e] = fmaf(win, rc, -u[e]); pu[e] = u[e]; p2[e] = s2; p4[e] = s4; p8[e] = s8;
            }
            pfr[m][ks] = __builtin_bit_cast(bf16x8, pack8(po));
        }
    }
    bf16x8 wfr[4][4];
#pragma unroll
    for (int n = 0; n < 4; ++n)
#pragma unroll
        for (int ks = 0; ks < 4; ++ks) wfr[n][ks] = *(const bf16x8*)(Wp + (size_t)(64 * half + outchan(n, fr)) * 128 + 32 * ks + 8 * fq);
#pragma unroll 1
    for (int pass = 0; pass < 2; ++pass) {
#pragma unroll
        for (int m = 0; m < NMR; ++m) {
            const int t = tb + 16 * m + fr; const size_t rowg = (size_t)b * TT + t; float s = 0.f, rs = 0.f;
            if (pass) { const f32x4 r0 = *(const LAS f32x4*)(red2 + (16 * (mbase + m) + fr) * 8), r1 = *(const LAS f32x4*)(red2 + (16 * (mbase + m) + fr) * 8 + 4);
                rs = __builtin_amdgcn_rsqf((((r0.x + r0.y) + (r0.z + r0.w)) + ((r1.x + r1.y) + (r1.z + r1.w))) * (1.0f / DH) + EPS); }
#pragma unroll
            for (int np = 0; np < 2; ++np) {
                f32x4 o2[2];
#pragma unroll
                for (int nn = 0; nn < 2; ++nn) { const int n = 2 * np + nn;
                    f32x4 acc = {0.f, 0.f, 0.f, 0.f};
#pragma unroll
                    for (int ks = 0; ks < 4; ++ks) acc = __builtin_amdgcn_mfma_f32_16x16x32_bf16(wfr[n][ks], pfr[m][ks], acc, 0, 0, 0);
                    const int col = g * 128 + 64 * half + 32 * np + 8 * fq + 4 * nn;
                    const f32x4 pb = *(const f32x4*)(pbias + col), ps = *(const f32x4*)(pscale + col);
                    acc = (acc + pb) * ps; s += (acc.x * acc.x + acc.y * acc.y) + (acc.z * acc.z + acc.w * acc.w); o2[nn] = acc * rs; }
                if (pass) { u32x4 w; w.x = cvt_pk(o2[0].x, o2[0].y); w.y = cvt_pk(o2[0].z, o2[0].w); w.z = cvt_pk(o2[1].x, o2[1].y); w.w = cvt_pk(o2[1].z, o2[1].w);
                    *(u32x4*)(Y + rowg * D + g * 128 + 64 * half + 32 * np + 8 * fq) = w; }
            }
            if (!pass) { s += __shfl_xor(s, 16); s += __shfl_xor(s, 32); if (fq == 0) red2[(16 * (mbase + m) + fr) * 8 + wid] = s; }
        }
        if (!pass) __syncthreads();
    }
}

__device__ __forceinline__ void m2_phase(const Params& p, LAS unsigned char* lds, int G, int l) {
    int tid_ = threadIdx.x; asm volatile("" : "+v"(tid_));
    const int tid = tid_, lane = tid & 63, wid = __builtin_amdgcn_readfirstlane(tid >> 6), fr = lane & 15, fq = lane >> 4;
    LAS float* segA = (LAS float*)lds; LAS float* segH = (LAS float*)(lds + 16384); LAS float* carr = (LAS float*)(lds + 32768);
    LAS float* red1 = (LAS float*)(lds + 34816); LAS float* red2 = (LAS float*)(lds + 37888);
    const bf16* proj = (const bf16*)(p.ws + WS_PROJ); bf16* Y = (bf16*)(p.ws + WS_Y);
    const float* hl = (const float*)(p.ws + WS_HL); const bf16* Pp = (const bf16*)(p.ws + WS_P);
    const float* carA = (const float*)(p.ws + WS_CARA); const float* carH = (const float*)(p.ws + WS_CARH);
    const int g = wid >> 1, half = wid & 1, kwin = 2 << g;
    const bf16* Wp = (const bf16*)(p.ws + WS_POOLW) + (size_t)(l * 4 + g) * 16384;
    const float* pbias = p.in[5] + l * DH; const float* pscale = p.in[6] + l * DH;
    for (int unit = blockIdx.x; unit < 256; unit += G) {
        const int b = unit >> 7, c = unit & 127, t0 = c ? NMETA + 64 * c : 0, NM = c ? 4 : 5;
        {
            const int q = (c + 7) >> 3, jlo = wid * q, jhi = (jlo + q < c) ? jlo + q : c;
            f32x4 A0 = {1.f, 1.f, 1.f, 1.f}, A1 = A0, H0 = {0.f, 0.f, 0.f, 0.f}, H1 = H0;
            for (int j = jlo; j < jhi; j += 8) {
                f32x4 a0[8], a1[8], h0[8], h1[8];
#pragma unroll
                for (int i = 0; i < 8; ++i) { const int jj = (j + i < jhi) ? j + i : jhi - 1; const size_t o = (size_t)(b * 128 + jj) * DH + 8 * lane;
                    a0[i] = *(const f32x4*)(carA + o); a1[i] = *(const f32x4*)(carA + o + 4); h0[i] = *(const f32x4*)(carH + o); h1[i] = *(const f32x4*)(carH + o + 4); }
#pragma unroll
                for (int i = 0; i < 8; ++i) if (j + i < jhi) { H0 = a0[i] * H0 + h0[i]; A0 = A0 * a0[i]; H1 = a1[i] * H1 + h1[i]; A1 = A1 * a1[i]; }
            }
            *(LAS f32x4*)(segA + wid * DH + 8 * lane) = A0; *(LAS f32x4*)(segA + wid * DH + 8 * lane + 4) = A1;
            *(LAS f32x4*)(segH + wid * DH + 8 * lane) = H0; *(LAS f32x4*)(segH + wid * DH + 8 * lane + 4) = H1;
        }
        __syncthreads();
        { float cy = 0.f;
#pragma unroll
          for (int s8 = 0; s8 < 8; ++s8) cy = segA[s8 * DH + tid] * cy + segH[s8 * DH + tid];
          carr[tid] = cy; }
        __syncthreads();
        {
            float cr[16];
#pragma unroll
            for (int ks = 0; ks < 2; ++ks) { const f32x4 c0 = *(const LAS f32x4*)(carr + wid * 64 + 32 * ks + 8 * fq), c1 = *(const LAS f32x4*)(carr + wid * 64 + 32 * ks + 8 * fq + 4);
                cr[8 * ks + 0] = c0.x; cr[8 * ks + 1] = c0.y; cr[8 * ks + 2] = c0.z; cr[8 * ks + 3] = c0.w; cr[8 * ks + 4] = c1.x; cr[8 * ks + 5] = c1.y; cr[8 * ks + 6] = c1.z; cr[8 * ks + 7] = c1.w; }
            m2_rnn_round<4>(hl, Pp, proj, Y, red1, cr, b, t0, 0, wid, fr, fq);
            if (NM == 5) m2_rnn_round<1>(hl, Pp, proj, Y, red1, cr, b, t0, 4, wid, fr, fq);
        }
        m2_pool_round<4>(proj, Y, Wp, pbias, pscale, red2, b, t0, 0, g, half, kwin, wid, fr, fq);
        if (NM == 5) m2_pool_round<1>(proj, Y, Wp, pbias, pscale, red2, b, t0, 4, g, half, kwin, wid, fr, fq);
    }
    __syncthreads();
}

__device__ __forceinline__ void final_norm(const Params& p, int G) {
    int tid_ = threadIdx.x; asm volatile("" : "+v"(tid_));
    const int tid = tid_, lane = tid & 63, wid = tid >> 6; const int gw = blockIdx.x * 8 + wid, NGW = G * 8;
    const f32x4* gp = (const f32x4*)p.in[19] + lane; f32x4 gg[4];
#pragma unroll
    for (int j = 0; j < 4; ++j) gg[j] = gp[64 * j];
    for (int m = gw; m < M; m += NGW) {
        f32x4* xr = (f32x4*)(p.out + (size_t)m * D) + lane; f32x4 v[4]; float s = 0.f;
#pragma unroll
        for (int j = 0; j < 4; ++j) { v[j] = xr[64 * j]; s += (v[j].x * v[j].x + v[j].y * v[j].y) + (v[j].z * v[j].z + v[j].w * v[j].w); }
        const float rs = 1.0f / sqrtf(wave_sum(s) * (1.0f / D) + EPS);
#pragma unroll
        for (int j = 0; j < 4; ++j) xr[64 * j] = v[j] * rs * gg[j];
    }
}

#define XB_TMO      128
#define XB_XCNT(j)  (256  + 64 * (j))
#define XB_XSUB(j)  (1280 + 64 * (j))
#define XB_XGEN(j)  (2304 + 64 * (j))
#define XB_TOP      3328
#define XB_TOPGEN   3392
#define XCD_BAR_WORDS 3456
#define XB_SPIN_CAP (1u << 18)

__device__ __forceinline__ unsigned xb_ld(unsigned* p)              { return __hip_atomic_load(p, __ATOMIC_RELAXED, __HIP_MEMORY_SCOPE_AGENT); }
__device__ __forceinline__ unsigned xb_add(unsigned* p, unsigned v) { return __hip_atomic_fetch_add(p, v, __ATOMIC_RELAXED, __HIP_MEMORY_SCOPE_AGENT); }
__device__ __forceinline__ unsigned xb_xcc_id() { return (unsigned)__builtin_amdgcn_s_getreg((3 << 11) | 20) & 0xFu; }
#define XB_SPIN(cond, bar) do { unsigned _sp = 0; while (cond) { __builtin_amdgcn_s_sleep(1); \
    if ((++_sp & 255u) == 0u) { if (xb_ld(&(bar)[XB_TMO])) break; if (_sp > XB_SPIN_CAP) { atomicAdd(&(bar)[XB_TMO], 1u); break; } } } } while (0)

struct XcdBarrier {
    unsigned* bar; unsigned x;
    volatile LAS unsigned* st;
};

__device__ __forceinline__ XcdBarrier xcd_barrier_post(unsigned* bar, volatile LAS unsigned* st) {
    XcdBarrier b; b.bar = bar; b.x = xb_xcc_id(); b.st = st;
    if (threadIdx.x == 0) (void)xb_add(&bar[XB_XCNT(b.x)], 1u);
    return b;
}
__device__ __forceinline__ void xcd_barrier_complete(unsigned* bar, unsigned x, unsigned& nloc, unsigned& nx) {
    const unsigned G = gridDim.x * gridDim.y * gridDim.z;
    unsigned sum, cnt, mine, sp = 0u;
    for (;;) {
        sum = 0u; cnt = 0u; mine = 0u;
#pragma unroll
        for (unsigned j = 0; j < 16; ++j) { const unsigned c = xb_ld(&bar[XB_XCNT(j)]); sum += c; cnt += (c > 0u) ? 1u : 0u; mine = (j == x) ? c : mine; }
        if (sum == G) break;
        __builtin_amdgcn_s_sleep(1);
        if ((++sp & 255u) == 0u) { if (xb_ld(&bar[XB_TMO])) break; if (sp > XB_SPIN_CAP) { atomicAdd(&bar[XB_TMO], 1u); break; } }
    }
    nloc = mine > 0u ? mine : 1u; nx = cnt > 0u ? cnt : 1u;
}

__device__ __forceinline__ void xcd_barrier(const XcdBarrier& b) {
    asm volatile("s_waitcnt vmcnt(0)" ::: "memory");
    __syncthreads();
    if (threadIdx.x == 0) {
        unsigned* bar = b.bar;
        __builtin_amdgcn_s_waitcnt(0);
        unsigned nloc = b.st[0], nx = b.st[1];
        if (nloc == 0u) { xcd_barrier_complete(bar, b.x, nloc, nx); b.st[0] = nloc; b.st[1] = nx; }
        const unsigned old = xb_add(&bar[XB_XSUB(b.x)], 1u);
        const unsigned gen = old / nloc;
        if (old + 1u == (gen + 1u) * nloc) {
            __builtin_amdgcn_fence(__ATOMIC_RELEASE, "agent");
            asm volatile("s_waitcnt vmcnt(0)" ::: "memory");
            const unsigned og = xb_add(&bar[XB_TOP], 1u);
            const unsigned tg = og / nx;
            if (og + 1u == (tg + 1u) * nx) xb_add(&bar[XB_TOPGEN], 1u);
            else XB_SPIN(xb_ld(&bar[XB_TOPGEN]) == tg, bar);
            __builtin_amdgcn_fence(__ATOMIC_ACQUIRE, "agent");
            xb_add(&bar[XB_XGEN(b.x)], 1u);
            asm volatile("s_waitcnt vmcnt(0)" ::: "memory");
        } else {
            XB_SPIN(xb_ld(&bar[XB_XGEN(b.x)]) == gen, bar);
            __builtin_amdgcn_fence(__ATOMIC_ACQUIRE, "agent");
            asm volatile("s_waitcnt vmcnt(0)" ::: "memory");
        }
    }
    __syncthreads();
}

#ifndef PROBE_SYNC2
#define PROBE_SYNC2 0
#endif
#ifndef PROBE_M1X2
#define PROBE_M1X2 0
#endif
#ifndef PROBE_M2X2
#define PROBE_M2X2 0
#endif
#define GSYNC() do { xcd_barrier(xbar); if (PROBE_SYNC2) xcd_barrier(xbar); } while (0)
#ifndef PROBE_PHASE
#define PROBE_PHASE (-1)
#endif
#define TIC() do { if (PROBE_PHASE >= 0) tic = __builtin_amdgcn_s_memrealtime(); } while (0)
#define TOC(k) do { if (PROBE_PHASE == (k)) tacc += __builtin_amdgcn_s_memrealtime() - tic; } while (0)
__global__ void __launch_bounds__(512, 2) fwd_megakernel(Params p) {
    extern __shared__ __attribute__((aligned(16))) unsigned char lds_raw[];
    LAS unsigned char* lds = (LAS unsigned char*)lds_raw;
    cg::grid_group grid = cg::this_grid();
    const int G = gridDim.x;
    unsigned long long tic = 0, tacc = 0;
    unsigned char* ws = p.ws;
    volatile LAS unsigned* xst = (volatile LAS unsigned*)(lds + LDS_XST);
    if (threadIdx.x < 2) xst[threadIdx.x] = 0u;
    __syncthreads();
    XcdBarrier xbar = xcd_barrier_post((unsigned*)(ws + WS_CTL), xst);
    bf16* hb = (bf16*)(ws + WS_HB); bf16* proj = (bf16*)(ws + WS_PROJ); bf16* Y = (bf16*)(ws + WS_Y); bf16* mid = (bf16*)(ws + WS_MID); float* ss = (float*)(ws + WS_SS);
    TIC();
#ifndef NO_PRO
    prologue(p, lds, G);
#endif
    grid.sync();
    TOC(0);
#pragma unroll 1
    for (int l = 0; l < DEPTH; ++l) {
        const unsigned char* wl = ws + WS_W + (size_t)l * W_LAYER;
        const bf16* in_t = (const bf16*)(wl + W_IN); const bf16* out_t = (const bf16*)(wl + W_OUT); const bf16* up_t = (const bf16*)(wl + W_UP); const bf16* down_t = (const bf16*)(wl + W_DOWN);
        TIC();
#ifndef NO_GIN
        { pg8::Gemm g{hb, in_t, M, DIN, D, 0}; pg8::StaticOrder S; S.init(M, DIN, G, (int)blockIdx.x); EpiIn E{proj, ss};
          pg8::gemm_phase<EpiIn, pg8::StaticOrder, true, true>(lds, g, S, E); }
#endif
#ifndef NO_META
        meta_tasks<0>(p, lds, G, nullptr, 0, in_t, D, DIN / 16);
#endif
        GSYNC();
        TOC(1); TIC();
#ifndef NO_M1
        m1_phase(p, lds, G, l);
        if (PROBE_M1X2) m1_phase(p, lds, G, l);
#endif
        GSYNC();
        TOC(2); TIC();
#ifndef NO_M2
        m2_phase(p, lds, G, l);
        if (PROBE_M2X2) m2_phase(p, lds, G, l);
#endif
        GSYNC();
        TOC(3); TIC();
#ifndef NO_GOUT
        { pg8::Gemm g{Y, out_t, M, D, D, NMETA}; pg8::StaticOrder S; S.init(M, D, G, (int)blockIdx.x); EpiRes E{l == 0 ? p.in[0] : p.out, p.out, hb, ss};
          pg8::gemm_phase<EpiRes, pg8::StaticOrder, false, true>(lds, g, S, E); }
#endif
#ifndef NO_META
        if (l < DEPTH - 1) meta_tasks<1>(p, lds, G, Y, D, out_t, D, D / 16);
#endif
        GSYNC();
        TOC(4); TIC();
#ifndef NO_GUP
        { pg8::Gemm g{hb, up_t, M, FF, D, 0}; pg8::StaticOrder S; S.init(M, FF, G, (int)blockIdx.x); EpiUp E{mid, ss};
          pg8::gemm_phase<EpiUp, pg8::StaticOrder, true, true>(lds, g, S, E); }
#endif
#ifndef NO_META
        if (l < DEPTH - 1) meta_tasks<2>(p, lds, G, nullptr, 0, up_t, D, FF / 16);
#endif
        GSYNC();
        TOC(5); TIC();
#ifndef NO_GDN
        { pg8::Gemm g{mid, down_t, M, D, FF, 0}; pg8::StaticOrder S; S.init(M, D, G, (int)blockIdx.x); EpiRes E{p.out, p.out, hb, ss};
          pg8::gemm_phase<EpiRes, pg8::StaticOrder, false, true>(lds, g, S, E); }
#endif
#ifndef NO_META
        if (l < DEPTH - 1) meta_tasks<1>(p, lds, G, (const bf16*)(ws + WS_MIDMETA), FF, down_t, FF, D / 16);
#endif
        GSYNC();
        TOC(6);
    }
    TIC();
    final_norm(p, G);
    TOC(7);
    if (PROBE_PHASE >= 0 && blockIdx.x == 0 && threadIdx.x == 0) { const unsigned long long w0 = __builtin_amdgcn_s_memrealtime(); while (__builtin_amdgcn_s_memrealtime() - w0 < 4ull * tacc) __builtin_amdgcn_s_sleep(8); }
}

extern "C" void kernel_launch(void* const* d_in, const int* in_sizes, int n_in, void* d_out, int out_size, void* d_ws, size_t ws_size, hipStream_t stream) {
    static int grid = 0;
    if (grid == 0) {
        if (n_in != 20 || in_sizes[0] != M * D || out_size != M * D || ws_size < WS_END) { fprintf(stderr, "kernel_launch: unexpected shapes (n_in %d, in0 %d, out %d, ws %zu)\n", n_in, n_in > 0 ? in_sizes[0] : -1, out_size, ws_size); grid = -1; return; }
        int dev = 0, cus = 0, per_cu = 0;
        if (hipGetDevice(&dev) != hipSuccess || hipDeviceGetAttribute(&cus, hipDeviceAttributeMultiprocessorCount, dev) != hipSuccess) { grid = -1; return; }
        if (hipFuncSetAttribute((const void*)fwd_megakernel, hipFuncAttributeMaxDynamicSharedMemorySize, LDS_BYTES) != hipSuccess) { fprintf(stderr, "kernel_launch: hipFuncSetAttribute failed\n"); grid = -1; return; }
        if (hipOccupancyMaxActiveBlocksPerMultiprocessor(&per_cu, (const void*)fwd_megakernel, 512, LDS_BYTES) != hipSuccess || per_cu < 1) { fprintf(stderr, "kernel_launch: occupancy query gave %d\n", per_cu); (void)hipGetLastError(); grid = -1; return; }
        grid = cus * 1;
    }
    if (grid < 0) return;
    if (hipMemsetAsync((char*)d_ws + WS_CTL, 0, XCD_BAR_WORDS * 4, stream) != hipSuccess) { fprintf(stderr, "kernel_launch: memset failed\n"); return; }
    Params p{};
    for (int i = 0; i < 20; ++i) p.in[i] = (const float*)d_in[i];
    p.out = (float*)d_out; p.ws = (unsigned char*)d_ws;
    void* args[] = {&p};
    hipError_t e = hipLaunchCooperativeKernel((const void*)fwd_megakernel, dim3(grid), dim3(512), args, LDS_BYTES, stream);
    if (e != hipSuccess) fprintf(stderr, "cooperative launch failed: %s (grid %d)\n", hipGetErrorString(e), grid);
}
```

```cpp
#include <hip/hip_runtime.h>
#include <hip/hip_cooperative_groups.h>
#include <cstdio>
#include <cstdint>
namespace cg = cooperative_groups;
namespace pg8 {
#define PG8_LAS __attribute__((address_space(3)))
typedef unsigned short bf16_t;
typedef short bf16x8 __attribute__((ext_vector_type(8)));
typedef float f32x4 __attribute__((ext_vector_type(4)));
typedef unsigned u32x4 __attribute__((ext_vector_type(4)));
constexpr int BM = 256, BK = 64, HALF = 128, HTB = HALF * BK * 2  , STAGE_BYTES = 8 * HTB, NXCD = 8, WGM = 8;

__host__ __device__ __forceinline__ int lds_byte(int r, int c) { const int st = (r >> 4) * 2 + (c >> 5), rr = r & 15, cc = c & 31, ob = rr * 64 + cc * 2; return st * 1024 + (ob ^ (((ob >> 9) & 1) << 5)); }
__host__ __device__ __forceinline__ void stage_rc(int b, int& R, int& C) { const int st = b / 1024, sb = b % 1024, swz = sb ^ (((sb >> 9) & 1) << 5); R = (st >> 1) * 16 + swz / 64; C = (st & 1) * 32 + (swz % 64) / 2; }
__host__ __device__ __forceinline__ int perm32(int rho) { const int n = rho >> 4, i = rho & 15; return 8 * (i >> 2) + 4 * n + (i & 3); }

struct Unit { int pm, pn; };
struct Gemm { const bf16_t* A; const bf16_t* Bt; int M, N, K, gap; };

struct StaticOrder {
    int nM, nN, nwg, G, c;
    __host__ __device__ void init(int M, int N, int G_, int c_) { nM = M / BM; nN = N / BM; nwg = nM * nN; G = G_; c = c_; }
    __host__ __device__ bool next(int i, Unit& u) const {
        const long L = (long)i * G + c; if (L >= nwg) return false;
        int wgid = (int)L; { const int q = nwg / NXCD, r = nwg % NXCD, xcd = wgid % NXCD, off = wgid / NXCD; wgid = (xcd < r ? xcd * (q + 1) : r * (q + 1) + (xcd - r) * q) + off; }
        const int nig = WGM * nN, gid = wgid / nig, fm = gid * WGM, gsz = (nM - fm) < WGM ? (nM - fm) : WGM;
        u.pm = fm + ((wgid % nig) % gsz); u.pn = (wgid % nig) / gsz; return true;
    }
    __device__ __forceinline__ void a_ready(const Unit&) const {}
    __device__ __forceinline__ void done(const Unit&) const {}
};
__device__ __forceinline__ unsigned cvt_pk_bf16(float lo, float hi) { unsigned r; asm volatile("v_cvt_pk_bf16_f32 %0, %1, %2" : "=v"(r) : "v"(lo), "v"(hi)); return r; }
template <class Epi, class Sched, bool ALIGN_EPI = false, bool SP2 = false>
__device__ __forceinline__ void gemm_phase(PG8_LAS unsigned char* lds, const Gemm g, const Sched& S, const Epi& E) {
    int tid_ = threadIdx.x; asm volatile("" : "+v"(tid_));
    const int tid = tid_, wid = __builtin_amdgcn_readfirstlane(tid >> 6), lane = tid & 63, wr = wid >> 2, wc = wid & 3, fr = lane & 15, fq = lane >> 4;
    const int K = g.K, nt = K / BK;
    unsigned voffA[2], voffB[2];
#pragma unroll
    for (int i = 0; i < 2; ++i) { int R, C; stage_rc(tid * 16 + i * 8192, R, C); const int Rb = Epi::PERM ? ((R & ~31) + perm32(R & 31)) : R;
        voffA[i] = (unsigned)(R * K + C) * 2u; voffB[i] = (unsigned)(Rb * K + C) * 2u; }
    const size_t kstep = (size_t)(BK * 2);
    const size_t hstep = (size_t)HALF * K * 2;
    const size_t tstep = 2 * hstep;
    const int agap = g.gap;
#define a_off(pm_) ((size_t)((pm_) * BM + agap * (1 + ((pm_) >> 5))) * (size_t)K * 2)
    const unsigned ldsw = (unsigned)wid * 1024u;
    const int aoff = lds_byte(wr * 64 + fr, fq * 8), boff = lds_byte(wc * 32 + fr, fq * 8);
#define PG8_SA(b, h) (((b) * 2 + (h)) * HTB)
#define PG8_SB(b, h) ((4 + (b) * 2 + (h)) * HTB)
#define PG8_STAGE(bufoff, gbase, voff) do { _Pragma("unroll") for (int _i = 0; _i < 2; ++_i) \
        __builtin_amdgcn_global_load_lds((const unsigned*)((const char*)(gbase) + (voff)[_i]), (PG8_LAS unsigned*)(lds + (bufoff) + ldsw + _i * 8192), 16, 0, 0); } while (0)
#define PG8_LDA(dst, b, h) do { _Pragma("unroll") for (int m = 0; m < 4; ++m) _Pragma("unroll") for (int k = 0; k < 2; ++k) dst[m][k] = *(const PG8_LAS bf16x8*)(lds + PG8_SA(b, h) + aoff + m * 2048 + k * 1024); } while (0)
#define PG8_LDB(dst, b, h) do { _Pragma("unroll") for (int n = 0; n < 2; ++n) _Pragma("unroll") for (int k = 0; k < 2; ++k) dst[n][k] = *(const PG8_LAS bf16x8*)(lds + PG8_SB(b, h) + boff + n * 2048 + k * 1024); } while (0)
#define PG8_MMA(ai, bj, At, Bt) do { __builtin_amdgcn_s_setprio(1); _Pragma("unroll") for (int m = 0; m < 4; ++m) _Pragma("unroll") for (int n = 0; n < 2; ++n) _Pragma("unroll") for (int k = 0; k < 2; ++k) \
        acc[ai][bj][m][n] = __builtin_amdgcn_mfma_f32_16x16x32_bf16(Bt[n][k], At[m][k], acc[ai][bj][m][n], 0, 0, 0); __builtin_amdgcn_s_setprio(0); } while (0)
#define PG8_WAIT_V(n) asm volatile("s_waitcnt vmcnt(" #n ")" ::: "memory")
#define PG8_WAIT_L(n) asm volatile("s_waitcnt lgkmcnt(" #n ")" ::: "memory")
#define PG8_BAR __builtin_amdgcn_s_barrier()
#define PG8_SCHED __builtin_amdgcn_sched_barrier(0)
    Unit cur, nxt; int ui = 0;
    if (!S.next(0, cur)) return;
    f32x4 acc[2][2][4][2];
#pragma unroll
    for (int a = 0; a < 2; ++a)
#pragma unroll
        for (int b = 0; b < 2; ++b)
#pragma unroll
            for (int m = 0; m < 4; ++m)
#pragma unroll
                for (int n = 0; n < 2; ++n) acc[a][b][m][n] = (f32x4){0.f, 0.f, 0.f, 0.f};
    if constexpr (Epi::PRELOAD) E.preload(acc, cur, wr, wc, fr, fq);
    bf16x8 At[4][2], B0[2][2], B1[2][2];
    const char* cA = (const char*)g.A + a_off(cur.pm); const char* cB = (const char*)g.Bt + (size_t)cur.pn * tstep;
    S.a_ready(cur);
    if constexpr (SP2) {
        PG8_STAGE(PG8_SB(0, 0), cB, voffB); PG8_STAGE(PG8_SB(0, 1), cB + hstep, voffB); PG8_STAGE(PG8_SA(0, 0), cA, voffA); PG8_STAGE(PG8_SA(0, 1), cA + hstep, voffA);
        if (wr == 1) PG8_BAR;
        PG8_WAIT_V(2); PG8_BAR;
        PG8_STAGE(PG8_SB(1, 0), cB + kstep, voffB); PG8_STAGE(PG8_SA(1, 0), cA + kstep, voffA); PG8_STAGE(PG8_SB(1, 1), cB + hstep + kstep, voffB);
        PG8_WAIT_V(6); PG8_BAR;
    } else {
        PG8_STAGE(PG8_SB(0, 0), cB, voffB); PG8_STAGE(PG8_SA(0, 0), cA, voffA); PG8_STAGE(PG8_SB(0, 1), cB + hstep, voffB); PG8_STAGE(PG8_SA(0, 1), cA + hstep, voffA);
        if (wr == 1) PG8_BAR;
        PG8_WAIT_V(4); PG8_BAR;
        PG8_STAGE(PG8_SB(1, 0), cB + kstep, voffB); PG8_STAGE(PG8_SA(1, 0), cA + kstep, voffA); PG8_STAGE(PG8_SB(1, 1), cB + hstep + kstep, voffB);
        PG8_WAIT_V(6); PG8_BAR;
    }
    for (;;) {
        const bool has_next = S.next(ui + 1, nxt);
        const char* nA = has_next ? (const char*)g.A + a_off(nxt.pm) : cA; const char* nB = has_next ? (const char*)g.Bt + (size_t)nxt.pn * tstep : cB;
        for (int t = 0; t < nt; t += 2) {
            const bool last = (t == nt - 2);
            const char* a1 = cA + (size_t)(t + 1) * kstep;
            const char* a2 = last ? nA : cA + (size_t)(t + 2) * kstep; const char* b2 = last ? nB : cB + (size_t)(t + 2) * kstep;
            const char* a3 = a2 + kstep; const char* b3 = b2 + kstep;
            if (last && has_next) S.a_ready(nxt);
            if constexpr (SP2) {
            PG8_LDB(B0, 0, 0); PG8_LDB(B1, 0, 1); PG8_SCHED; PG8_LDA(At, 0, 0); PG8_STAGE(PG8_SA(1, 1), a1 + hstep, voffA);
            PG8_WAIT_V(8); PG8_WAIT_L(0); PG8_BAR; PG8_MMA(0, 0, At, B0); PG8_MMA(0, 1, At, B1); PG8_BAR; PG8_SCHED;
            PG8_LDA(At, 0, 1); PG8_STAGE(PG8_SB(0, 0), b2, voffB); PG8_STAGE(PG8_SB(0, 1), b2 + hstep, voffB); PG8_STAGE(PG8_SA(0, 0), a2, voffA);
            PG8_WAIT_V(8); PG8_WAIT_L(0); PG8_BAR; PG8_MMA(1, 0, At, B0); PG8_MMA(1, 1, At, B1); PG8_BAR; PG8_SCHED;
            PG8_LDB(B0, 1, 0); PG8_LDB(B1, 1, 1); PG8_SCHED; PG8_LDA(At, 1, 0); PG8_STAGE(PG8_SA(0, 1), a2 + hstep, voffA);
            PG8_WAIT_V(8); PG8_WAIT_L(0); PG8_BAR; PG8_MMA(0, 0, At, B0); PG8_MMA(0, 1, At, B1); PG8_BAR; PG8_SCHED;
            PG8_LDA(At, 1, 1); PG8_STAGE(PG8_SB(1, 0), b3, voffB); PG8_STAGE(PG8_SB(1, 1), b3 + hstep, voffB); PG8_STAGE(PG8_SA(1, 0), a3, voffA);
            PG8_WAIT_V(8); PG8_WAIT_L(0); PG8_BAR; PG8_MMA(1, 0, At, B0); PG8_MMA(1, 1, At, B1); PG8_BAR; PG8_SCHED;
            } else {
            PG8_LDB(B0, 0, 0); PG8_SCHED; PG8_LDA(At, 0, 0); PG8_STAGE(PG8_SA(1, 1), a1 + hstep, voffA);
            PG8_WAIT_L(8); PG8_BAR; PG8_WAIT_L(0); PG8_MMA(0, 0, At, B0); PG8_BAR; PG8_SCHED;
            PG8_LDB(B1, 0, 1); PG8_STAGE(PG8_SB(0, 0), b2, voffB);
            PG8_BAR; PG8_WAIT_L(0); PG8_MMA(0, 1, At, B1); PG8_BAR;
            PG8_LDA(At, 0, 1); PG8_STAGE(PG8_SA(0, 0), a2, voffA);
            PG8_BAR; PG8_WAIT_L(0); PG8_MMA(1, 0, At, B0); PG8_BAR; PG8_SCHED;
            PG8_STAGE(PG8_SB(0, 1), b2 + hstep, voffB);
            PG8_WAIT_V(6); PG8_BAR; PG8_MMA(1, 1, At, B1); PG8_BAR;
            PG8_LDB(B0, 1, 0); PG8_SCHED; PG8_LDA(At, 1, 0); PG8_STAGE(PG8_SA(0, 1), a2 + hstep, voffA);
            PG8_WAIT_L(8); PG8_BAR; PG8_WAIT_L(0); PG8_MMA(0, 0, At, B0); PG8_BAR; PG8_SCHED;
            PG8_LDB(B1, 1, 1); PG8_STAGE(PG8_SB(1, 0), b3, voffB);
            PG8_BAR; PG8_WAIT_L(0); PG8_MMA(0, 1, At, B1); PG8_BAR;
            PG8_LDA(At, 1, 1); PG8_STAGE(PG8_SA(1, 0), a3, voffA);
            PG8_BAR; PG8_WAIT_L(0); PG8_MMA(1, 0, At, B0); PG8_BAR; PG8_SCHED;
            PG8_STAGE(PG8_SB(1, 1), b3 + hstep, voffB);
            PG8_WAIT_V(6); PG8_BAR; PG8_MMA(1, 1, At, B1); PG8_BAR;
            }
        }
        if constexpr (ALIGN_EPI) { if (wr == 0) PG8_BAR; }
        if constexpr (!Epi::AFTER_DRAIN) { E(acc, cur, wr, wc, fr, fq); S.done(cur); }
        if (!has_next) break;
#pragma unroll
        for (int a = 0; a < 2; ++a)
#pragma unroll
            for (int b = 0; b < 2; ++b)
#pragma unroll
                for (int m = 0; m < 4; ++m)
#pragma unroll
                    for (int n = 0; n < 2; ++n) acc[a][b][m][n] = (f32x4){0.f, 0.f, 0.f, 0.f};
        if constexpr (Epi::PRELOAD) { E.preload(acc, nxt, wr, wc, fr, fq); PG8_WAIT_V(0); }
        cur = nxt; cA = nA; cB = nB; ++ui;
        if constexpr (ALIGN_EPI) { if (wr == 1) PG8_BAR; }
    }
    PG8_WAIT_V(0);
    if constexpr (!ALIGN_EPI) { if (wr == 0) PG8_BAR; }
    PG8_BAR;
    if constexpr (Epi::AFTER_DRAIN) { E.fused(acc, cur, wr, wc, fr, fq, lds, wid, lane); S.done(cur); }
#undef PG8_SA
#undef PG8_SB
#undef PG8_STAGE
#undef PG8_LDA
#undef PG8_LDB
#undef PG8_MMA
#undef PG8_WAIT_V
#undef PG8_WAIT_L
#undef PG8_BAR
#undef PG8_SCHED
}
}

#define LAS __attribute__((address_space(3)))
typedef unsigned short bf16;
typedef unsigned u32x4 __attribute__((ext_vector_type(4)));
typedef unsigned u32x2 __attribute__((ext_vector_type(2)));
typedef float f32x4 __attribute__((ext_vector_type(4)));
typedef short bf16x8 __attribute__((ext_vector_type(8)));
constexpr int D = 1024, SEQ = 8192, NB = 2, NMETA = 16, TT = SEQ + NMETA, M = NB * SEQ, DEPTH = 4, DIN = 1536, FF = 4096, DH = 512;
constexpr float EPS = 1e-6f;
constexpr size_t MiB = 1u << 20;
constexpr size_t WS_CTL = 0;
constexpr size_t WS_POOLW = 1 * MiB, WS_GR = WS_POOLW + 512 * 1024, WS_GI = WS_GR + 256 * 1024;
constexpr size_t WS_SP = 2 * MiB, WS_HMETA = WS_SP + 64 * 1024, WS_MIDMETA = WS_HMETA + 64 * 1024;
constexpr size_t WS_SS = 3 * MiB, WS_CARA = 4 * MiB, WS_CARH = WS_CARA + 512 * 1024;
constexpr size_t WS_W = 8 * MiB, W_LAYER = 21 * MiB, W_IN = 0, W_OUT = 3 * MiB, W_UP = 5 * MiB, W_DOWN = 13 * MiB;
constexpr size_t WS_HB = 92 * MiB, WS_MID = 124 * MiB;
constexpr size_t WS_PROJ = WS_MID, WS_Y = WS_MID + 48 * MiB + 256 * 1024, WS_HL = WS_Y + 32 * MiB + 256 * 1024, WS_P = WS_HL + 32 * MiB + 256 * 1024, WS_END = 256 * MiB;
static_assert(WS_PROJ + (size_t)NB * TT * DIN * 2 <= WS_Y && WS_Y + (size_t)NB * TT * D * 2 <= WS_HL && WS_HL + (size_t)NB * TT * DH * 4 <= WS_P && WS_P + (size_t)NB * TT * DH * 2 <= WS_END, "ws map");
static_assert(WS_W + DEPTH * W_LAYER <= WS_HB && WS_HB + (size_t)M * D * 2 <= WS_MID && WS_MID + (size_t)M * FF * 2 <= WS_END, "ws map 2");
constexpr int LDS_XST = 147456;
constexpr int LDS_BYTES = 147456 + 1024;

struct Params {
    const float* in[20];
    float* out;
    unsigned char* ws;
};

__device__ __forceinline__ Params launder(const Params& p) {
    Params q = p;
#pragma unroll
    for (int i = 0; i < 20; ++i) asm volatile("" : "+s"(q.in[i]));
    asm volatile("" : "+s"(q.out)); asm volatile("" : "+s"(q.ws));
    return q;
}
__device__ __forceinline__ unsigned cvt_pk(float lo, float hi) { return pg8::cvt_pk_bf16(lo, hi); }
__device__ __forceinline__ float bf_lo(unsigned w) { return __builtin_bit_cast(float, w << 16); }
__device__ __forceinline__ float bf_hi(unsigned w) { return __builtin_bit_cast(float, w & 0xffff0000u); }
__device__ __forceinline__ void unpack8(const u32x4 w, float (&f)[8]) {
    f[0] = bf_lo(w.x); f[1] = bf_hi(w.x); f[2] = bf_lo(w.y); f[3] = bf_hi(w.y); f[4] = bf_lo(w.z); f[5] = bf_hi(w.z); f[6] = bf_lo(w.w); f[7] = bf_hi(w.w);
}
__device__ __forceinline__ u32x4 pack8(const float (&f)[8]) { u32x4 w; w.x = cvt_pk(f[0], f[1]); w.y = cvt_pk(f[2], f[3]); w.z = cvt_pk(f[4], f[5]); w.w = cvt_pk(f[6], f[7]); return w; }
__device__ __forceinline__ float wave_sum(float v) {
#pragma unroll
    for (int o = 1; o < 64; o <<= 1) v += __shfl_xor(v, o);
    return v;
}
template <int CTRL> __device__ __forceinline__ float dppf(float old, float src) {
    return __builtin_bit_cast(float, __builtin_amdgcn_update_dpp(__builtin_bit_cast(int, old), __builtin_bit_cast(int, src), CTRL, 0xf, 0xf, false));
}
template <int DD> __device__ __forceinline__ float shiftd(float cur, float prev) {
    const float t = dppf<0x100 + (16 - DD)>(0.f, prev);
    return dppf<0x110 + DD>(t, cur);
}
__device__ __forceinline__ float sigm(float v) { return __builtin_amdgcn_rcpf(1.0f + __expf(-v)); }
__device__ __forceinline__ int outchan(int n, int rho) { return 32 * (n >> 1) + 8 * (rho >> 2) + 4 * (n & 1) + (rho & 3); }

__device__ __forceinline__ float row_rstd(const float* ss, int r) {
    const f32x4* s4 = (const f32x4*)(ss + (size_t)r * 16);
    const f32x4 a = s4[0], b = s4[1], c = s4[2], d = s4[3];
    const float s = ((a.x + a.y) + (a.z + a.w)) + ((b.x + b.y) + (b.z + b.w)) + ((c.x + c.y) + (c.z + c.w)) + ((d.x + d.y) + (d.z + d.w));
    return 1.0f / sqrtf(s * (1.0f / D) + EPS);
}
__device__ __forceinline__ void rows_rstd(const float* ss, int rowbase  , int fr, float (&rs)[2][4]) {
    const int lane = threadIdx.x & 63;
    const float r0 = row_rstd(ss, rowbase + lane), r1 = row_rstd(ss, rowbase + 128 + lane);
#pragma unroll
    for (int m = 0; m < 4; ++m) { rs[0][m] = __shfl(r0, m * 16 + fr); rs[1][m] = __shfl(r1, m * 16 + fr); }
}
struct EpiIn {
    static constexpr bool PERM = true, AFTER_DRAIN = false, PRELOAD = false;
    bf16* P; const float* ss; const LAS float* rl; int pmc;
    __device__ __forceinline__ void operator()(const f32x4 (&acc)[2][2][4][2], const pg8::Unit& u, int wr, int wc, int fr, int fq) const {
        const int row0 = u.pm * 256 + wr * 64 + fr, col0 = u.pn * 256 + wc * 32 + 8 * fq;
        float rsv[2][4];
        if (u.pm == pmc) {
#pragma unroll
            for (int ai = 0; ai < 2; ++ai)
#pragma unroll
                for (int m = 0; m < 4; ++m) rsv[ai][m] = rl[ai * 128 + wr * 64 + m * 16 + fr];
        } else {
#pragma unroll
            for (int ai = 0; ai < 2; ++ai)
#pragma unroll
                for (int m = 0; m < 4; ++m) { rsv[ai][m] = row_rstd(ss, row0 + ai * 128 + m * 16); asm volatile("" ::: "memory"); }
        }
#pragma unroll
        for (int ai = 0; ai < 2; ++ai)
#pragma unroll
            for (int m = 0; m < 4; ++m) {
                const int r = row0 + ai * 128 + m * 16; const float rs = rsv[ai][m];
                bf16* rowp = P + (size_t)(r + NMETA * (1 + (r >> 13))) * DIN + col0;
#pragma unroll
                for (int bj = 0; bj < 2; ++bj) { const f32x4 v0 = acc[ai][bj][m][0] * rs, v1 = acc[ai][bj][m][1] * rs;
                    u32x4 w; w.x = cvt_pk(v0[0], v0[1]); w.y = cvt_pk(v0[2], v0[3]); w.z = cvt_pk(v1[0], v1[1]); w.w = cvt_pk(v1[2], v1[3]);
                    *(u32x4*)(rowp + bj * 128) = w; }
            }
    }
};
struct EpiUp {
    static constexpr bool PERM = true, AFTER_DRAIN = false, PRELOAD = false;
    bf16* O; const float* ss; const LAS float* rl; int pmc;
    __device__ __forceinline__ void operator()(const f32x4 (&acc)[2][2][4][2], const pg8::Unit& u, int wr, int wc, int fr, int fq) const {
        const int row0 = u.pm * 256 + wr * 64 + fr, col0 = u.pn * 256 + wc * 32 + 8 * fq;
        float rsv[2][4];
        if (u.pm == pmc) {
#pragma unroll
            for (int ai = 0; ai < 2; ++ai)
#pragma unroll
                for (int m = 0; m < 4; ++m) rsv[ai][m] = rl[ai * 128 + wr * 64 + m * 16 + fr];
        } else {
#pragma unroll
            for (int ai = 0; ai < 2; ++ai)
#pragma unroll
                for (int m = 0; m < 4; ++m) { rsv[ai][m] = row_rstd(ss, row0 + ai * 128 + m * 16); asm volatile("" ::: "memory"); }
        }
#pragma unroll
        for (int ai = 0; ai < 2; ++ai)
#pragma unroll
            for (int m = 0; m < 4; ++m) {
                const int r = row0 + ai * 128 + m * 16; const float rs = rsv[ai][m];
                bf16* rowp = O + (size_t)r * FF + col0;
#pragma unroll
                for (int bj = 0; bj < 2; ++bj) { f32x4 v0 = acc[ai][bj][m][0] * rs, v1 = acc[ai][bj][m][1] * rs;
#pragma unroll
                    for (int j = 0; j < 4; ++j) { v0[j] = fmaxf(v0[j], 0.f); v0[j] *= v0[j]; v1[j] = fmaxf(v1[j], 0.f); v1[j] *= v1[j]; }
                    u32x4 w; w.x = cvt_pk(v0[0], v0[1]); w.y = cvt_pk(v0[2], v0[3]); w.z = cvt_pk(v1[0], v1[1]); w.w = cvt_pk(v1[2], v1[3]);
                    *(u32x4*)(rowp + bj * 128) = w; }
            }
    }
};
struct EpiRes {
    static constexpr bool PERM = true, AFTER_DRAIN = false, PRELOAD = true;
    bf16* hb; float* ssn;
    __device__ __forceinline__ void preload(f32x4 (&acc)[2][2][4][2], const pg8::Unit& u, int wr, int wc, int fr, int fq) const {
        const int row0 = u.pm * 256 + wr * 64 + fr, col0 = u.pn * 256 + wc * 32 + 8 * fq;
#pragma unroll
        for (int ai = 0; ai < 2; ++ai)
#pragma unroll
            for (int m = 0; m < 4; ++m) { const size_t off = (size_t)(row0 + ai * 128 + m * 16) * D + col0;
#pragma unroll
                for (int bj = 0; bj < 2; ++bj) { const u32x4 w = *(const u32x4*)(hb + off + bj * 128);
                    acc[ai][bj][m][0] = (f32x4){bf_lo(w.x), bf_hi(w.x), bf_lo(w.y), bf_hi(w.y)}; acc[ai][bj][m][1] = (f32x4){bf_lo(w.z), bf_hi(w.z), bf_lo(w.w), bf_hi(w.w)}; } }
    }
    __device__ __forceinline__ void operator()(const f32x4 (&acc)[2][2][4][2], const pg8::Unit& u, int wr, int wc, int fr, int fq) const {
        const int row0 = u.pm * 256 + wr * 64 + fr, col0 = u.pn * 256 + wc * 32 + 8 * fq;
#pragma unroll
        for (int ai = 0; ai < 2; ++ai)
#pragma unroll
            for (int m = 0; m < 4; ++m) {
                const int r = row0 + ai * 128 + m * 16; const size_t off = (size_t)r * D + col0; float s = 0.f;
#pragma unroll
                for (int bj = 0; bj < 2; ++bj) {
                    const f32x4 o0 = acc[ai][bj][m][0], o1 = acc[ai][bj][m][1];
                    s += (o0[0] * o0[0] + o0[1] * o0[1]) + (o0[2] * o0[2] + o0[3] * o0[3]) + (o1[0] * o1[0] + o1[1] * o1[1]) + (o1[2] * o1[2] + o1[3] * o1[3]);
                    u32x4 w; w.x = cvt_pk(o0[0], o0[1]); w.y = cvt_pk(o0[2], o0[3]); w.z = cvt_pk(o1[0], o1[1]); w.w = cvt_pk(o1[2], o1[3]);
                    *(u32x4*)(hb + off + bj * 128) = w; }
                s += __shfl_xor(s, 16); s += __shfl_xor(s, 32);
                if (fq == 0) ssn[(size_t)r * 16 + u.pn * 4 + wc] = s;
            }
    }
};

struct TItem { const float* W; const float* gk; bf16* WT; int K, N, item; };
__device__ __forceinline__ void titem_load(const TItem& t, int lane, f32x4 (&v)[8], float (&gs)[8]) {
    const int nblk = t.N / 32, kb = t.item / nblk, nb = t.item % nblk, k0 = 64 * kb, n0 = 32 * nb, lr = lane >> 3, lc = (lane & 7) * 4;
#pragma unroll
    for (int i = 0; i < 8; ++i) { v[i] = *(const f32x4*)(t.W + (size_t)(k0 + 8 * i + lr) * t.N + n0 + lc); gs[i] = t.gk ? t.gk[k0 + 8 * i + lr] : 1.0f; }
}
__device__ __forceinline__ void titem_store(const TItem& t, int lane, const f32x4 (&v)[8], const float (&gs)[8], LAS float* scr) {
    const int nblk = t.N / 32, kb = t.item / nblk, nb = t.item % nblk, k0 = 64 * kb, n0 = 32 * nb, lr = lane >> 3, lc = (lane & 7) * 4;
#pragma unroll
    for (int i = 0; i < 8; ++i) { LAS float* d = scr + (8 * i + lr) * 33 + lc; d[0] = v[i].x * gs[i]; d[1] = v[i].y * gs[i]; d[2] = v[i].z * gs[i]; d[3] = v[i].w * gs[i]; }
    asm volatile("s_waitcnt lgkmcnt(0)" ::: "memory");
    const int c = lane & 7;
#pragma unroll
    for (int j = 0; j < 4; ++j) { const int n = (lane >> 3) + 8 * j; const LAS float* s = scr + (8 * c) * 33 + n;
        u32x4 o; o.x = cvt_pk(s[0 * 33], s[1 * 33]); o.y = cvt_pk(s[2 * 33], s[3 * 33]); o.z = cvt_pk(s[4 * 33], s[5 * 33]); o.w = cvt_pk(s[6 * 33], s[7 * 33]);
        *(u32x4*)(t.WT + (size_t)(n0 + n) * t.K + k0 + 8 * c) = o; }
    asm volatile("s_waitcnt lgkmcnt(0)" ::: "memory");
}
__device__ __forceinline__ TItem titem_decode(const Params& p, int it) {
    constexpr int I_IN = 16 * 48, I_OUT = 16 * 32, I_UP = 16 * 128, I_DN = 64 * 32, I_PW = 4 * 8, I_G = 8 * 2, I_L = I_IN + I_OUT + I_UP + I_DN + I_PW + 2 * I_G;
    const int l = it / I_L; int r = it % I_L; unsigned char* ws = p.ws; unsigned char* wl = ws + WS_W + (size_t)l * W_LAYER; TItem t;
    if (r < I_IN) { t = TItem{p.in[3] + (size_t)l * D * DIN, p.in[2] + l * D, (bf16*)(wl + W_IN), D, DIN, r}; return t; } r -= I_IN;
    if (r < I_OUT) { t = TItem{p.in[15] + (size_t)l * D * D, p.in[14] + l * D, (bf16*)(wl + W_OUT), D, D, r}; return t; } r -= I_OUT;
    if (r < I_UP) { t = TItem{p.in[17] + (size_t)l * D * FF, p.in[16] + l * D, (bf16*)(wl + W_UP), D, FF, r}; return t; } r -= I_UP;
    if (r < I_DN) { t = TItem{p.in[18] + (size_t)l * FF * D, nullptr, (bf16*)(wl + W_DOWN), FF, D, r}; return t; } r -= I_DN;
    if (r < I_PW) { const int g = r / 8; t = TItem{p.in[4] + (size_t)(l * 4 + g) * 16384, nullptr, (bf16*)(ws + WS_POOLW) + (size_t)(l * 4 + g) * 16384, 128, 128, r % 8}; return t; } r -= I_PW;
    if (r < I_G) { const int h = r / 2; t = TItem{p.in[9] + (size_t)(l * 8 + h) * 4096, nullptr, (bf16*)(ws + WS_GR) + (size_t)(l * 8 + h) * 4096, 64, 64, r % 2}; return t; } r -= I_G;
    { const int h = r / 2; t = TItem{p.in[11] + (size_t)(l * 8 + h) * 4096, nullptr, (bf16*)(ws + WS_GI) + (size_t)(l * 8 + h) * 4096, 64, 64, r % 2}; }
    return t;
}
__device__ __forceinline__ void prologue(const Params& p_, LAS unsigned char* lds, int G) {
    const Params p = launder(p_);
    int tid_ = threadIdx.x; asm volatile("" : "+v"(tid_));
    const int tid = tid_, lane = tid & 63, wid = __builtin_amdgcn_readfirstlane(tid >> 6);
    LAS float* scr = (LAS float*)(lds + wid * 16384);
    const int gw = blockIdx.x * 8 + wid, NGW = G * 8;
    constexpr int NITEMS = DEPTH * (16 * 48 + 16 * 32 + 16 * 128 + 64 * 32 + 4 * 8 + 2 * 8 * 2);
    unsigned char* ws = p.ws;
    if (gw < NITEMS) {
        TItem cur = titem_decode(p, gw); f32x4 v[8]; float gs[8]; titem_load(cur, lane, v, gs);
        for (int it = gw; it < NITEMS; it += NGW) {
            const bool more = it + NGW < NITEMS; TItem nxt = cur; f32x4 nv[8]; float ngs[8];
            if (more) { nxt = titem_decode(p, it + NGW); titem_load(nxt, lane, nv, ngs); }
            titem_store(cur, lane, v, gs, scr);
            if (more) { cur = nxt;
#pragma unroll
                for (int i = 0; i < 8; ++i) { v[i] = nv[i]; gs[i] = ngs[i]; } }
        }
    }
    const float* x = p.in[0]; bf16* hb = (bf16*)(ws + WS_HB); float* ss = (float*)(ws + WS_SS);
    for (int m2 = gw; m2 < M / 2; m2 += NGW) {
        f32x4 v[2][4]; float s[2] = {0.f, 0.f};
#pragma unroll
        for (int r = 0; r < 2; ++r) { const f32x4* xr = (const f32x4*)(x + (size_t)(2 * m2 + r) * D) + lane;
#pragma unroll
            for (int j = 0; j < 4; ++j) v[r][j] = xr[64 * j]; }
#pragma unroll
        for (int r = 0; r < 2; ++r) {
#pragma unroll
            for (int j = 0; j < 4; ++j) s[r] += (v[r][j].x * v[r][j].x + v[r][j].y * v[r][j].y) + (v[r][j].z * v[r][j].z + v[r][j].w * v[r][j].w);
            s[r] = wave_sum(s[r]);
            u32x2* o8 = (u32x2*)(hb + (size_t)(2 * m2 + r) * D) + lane;
#pragma unroll
            for (int j = 0; j < 4; ++j) { u32x2 w; w.x = cvt_pk(v[r][j].x, v[r][j].y); w.y = cvt_pk(v[r][j].z, v[r][j].w); o8[64 * j] = w; }
            if (lane < 16) ss[(size_t)(2 * m2 + r) * 16 + lane] = lane == 0 ? s[r] : 0.f;
        }
    }
    float* hm = (float*)(ws + WS_HMETA); float* sp = (float*)(ws + WS_SP);
    for (int i = blockIdx.x * 512 + tid; i < NMETA * D; i += G * 512) hm[i] = p.in[1][i];
    for (int i = blockIdx.x * 512 + tid; i < DEPTH * DH; i += G * 512) sp[i] = log1pf(expf(-p.in[13][i]));
}

template <int MODE> __device__ __forceinline__ void meta_tasks(const Params& p_, LAS unsigned char* lds, int G, const bf16* Ab, int lda, const bf16* Bt, int K, int ntasks) {
    const Params p = launder(p_);
    int tid_ = threadIdx.x; asm volatile("" : "+v"(tid_));
    const int tid = tid_, lane = tid & 63, wid = __builtin_amdgcn_readfirstlane(tid >> 6), fr = lane & 15, fq = lane >> 4;
    float* hm = (float*)(p.ws + WS_HMETA);
    LAS float* red = (LAS float*)lds;
    for (int task = G - 1 - (int)blockIdx.x; task < ntasks; task += G) {
        const int n0 = task * 16, kw = K / 8, k0 = wid * kw;
        f32x4 acc = {0.f, 0.f, 0.f, 0.f}; float ssq = 0.f;
        for (int kb = k0; kb < k0 + kw; kb += 128) {
            bf16x8 af[4], bfr[4]; f32x4 a0[4], a1[4];
#pragma unroll
            for (int i = 0; i < 4; ++i) { const int kk = kb + 32 * i;
                if (MODE == 1) af[i] = *(const bf16x8*)(Ab + (size_t)fr * lda + kk + 8 * fq);
                else { a0[i] = *(const f32x4*)(hm + fr * D + kk + 8 * fq); a1[i] = *(const f32x4*)(hm + fr * D + kk + 8 * fq + 4); }
                bfr[i] = *(const bf16x8*)(Bt + (size_t)(n0 + fr) * K + kk + 8 * fq); }
#pragma unroll
            for (int i = 0; i < 4; ++i) {
                if (MODE != 1) { ssq += (a0[i].x * a0[i].x + a0[i].y * a0[i].y) + (a0[i].z * a0[i].z + a0[i].w * a0[i].w) + (a1[i].x * a1[i].x + a1[i].y * a1[i].y) + (a1[i].z * a1[i].z + a1[i].w * a1[i].w);
                    u32x4 w; w.x = cvt_pk(a0[i].x, a0[i].y); w.y = cvt_pk(a0[i].z, a0[i].w); w.z = cvt_pk(a1[i].x, a1[i].y); w.w = cvt_pk(a1[i].z, a1[i].w); af[i] = __builtin_bit_cast(bf16x8, w); }
                acc = __builtin_amdgcn_mfma_f32_16x16x32_bf16(bfr[i], af[i], acc, 0, 0, 0); }
        }
        ssq += __shfl_xor(ssq, 16); ssq += __shfl_xor(ssq, 32);
        LAS float* rp = red + (wid * 64 + lane) * 5;
        rp[0] = acc[0]; rp[1] = acc[1]; rp[2] = acc[2]; rp[3] = acc[3]; rp[4] = ssq;
        __syncthreads();
        if (wid == 0) {
            float a0 = 0.f, a1 = 0.f, a2 = 0.f, a3 = 0.f, sq = 0.f;
#pragma unroll
            for (int w = 0; w < 8; ++w) { const LAS float* q = red + (w * 64 + lane) * 5; a0 += q[0]; a1 += q[1]; a2 += q[2]; a3 += q[3]; sq += q[4]; }
            const int col = n0 + 4 * fq;
            if (MODE == 1) { f32x4* hp = (f32x4*)(hm + fr * D + col); f32x4 h = *hp; h.x += a0; h.y += a1; h.z += a2; h.w += a3; *hp = h; }
            else {
                const float rs = 1.0f / sqrtf(sq * (1.0f / D) + EPS); a0 *= rs; a1 *= rs; a2 *= rs; a3 *= rs;
                if (MODE == 0) { u32x2 w; w.x = cvt_pk(a0, a1); w.y = cvt_pk(a2, a3); bf16* pr = (bf16*)(p.ws + WS_PROJ);
                    *(u32x2*)(pr + (size_t)fr * DIN + col) = w; *(u32x2*)(pr + (size_t)(TT + fr) * DIN + col) = w; }
                else { a0 = fmaxf(a0, 0.f); a1 = fmaxf(a1, 0.f); a2 = fmaxf(a2, 0.f); a3 = fmaxf(a3, 0.f);
                    u32x2 w; w.x = cvt_pk(a0 * a0, a1 * a1); w.y = cvt_pk(a2 * a2, a3 * a3); *(u32x2*)((bf16*)(p.ws + WS_MIDMETA) + (size_t)fr * FF + col) = w; }
            }
        }
        __syncthreads();
    }
}

__device__ __forceinline__ void m1_phase(const Params& p_, LAS unsigned char* lds, int G, int l) {
    const Params p = launder(p_);
    int tid_ = threadIdx.x; asm volatile("" : "+v"(tid_));
    const int tid = tid_, lane = tid & 63, wid = __builtin_amdgcn_readfirstlane(tid >> 6), fr = lane & 15, fq = lane >> 4;
    LAS float* cst = (LAS float*)lds;
    for (int i = tid; i < 8 * DH; i += 512) { const int row = i >> 9, ch = i & 511; float v;
        if (row < 4) v = p.in[7][(l * 4 + row) * DH + ch]; else if (row == 4) v = p.in[8][l * DH + ch]; else if (row == 5) v = p.in[10][l * DH + ch];
        else if (row == 6) v = p.in[12][l * DH + ch]; else v = ((const float*)(p.ws + WS_SP))[l * DH + ch];
        cst[i] = v; }
    const bf16* proj = (const bf16*)(p.ws + WS_PROJ);
    const bf16* Wr = (const bf16*)(p.ws + WS_GR) + (size_t)(l * 8 + wid) * 4096; const bf16* Wi = (const bf16*)(p.ws + WS_GI) + (size_t)(l * 8 + wid) * 4096;
    LAS bf16x8* wl = (LAS bf16x8*)(lds + 16384 + wid * 16384) + lane;
#pragma unroll
    for (int n = 0; n < 4; ++n)
#pragma unroll
        for (int ks = 0; ks < 2; ++ks) {
            wl[((n * 2 + ks) * 2 + 0) * 64] = *(const bf16x8*)(Wr + outchan(n, fr) * 64 + 32 * ks + 8 * fq);
            wl[((n * 2 + ks) * 2 + 1) * 64] = *(const bf16x8*)(Wi + outchan(n, fr) * 64 + 32 * ks + 8 * fq); }
    __syncthreads();
    float* hl = (float*)(p.ws + WS_HL); bf16* Pp = (bf16*)(p.ws + WS_P);
    float* carA = (float*)(p.ws + WS_CARA); float* carH = (float*)(p.ws + WS_CARH);
    for (int unit = blockIdx.x; unit < 256; unit += G) {
        const int b = unit >> 7, c = unit & 127, t0 = c ? NMETA + 64 * c : 0, NM = c ? 4 : 5;
        float Hc[16], Pc[16];
#pragma unroll
        for (int k = 0; k < 16; ++k) { Hc[k] = 0.f; Pc[k] = 1.f; }
        u32x4 raw[2][4];
#pragma unroll
        for (int ks = 0; ks < 2; ++ks)
#pragma unroll
            for (int d = 0; d < 4; ++d) { const int tt = t0 + fr - 3 + d; raw[ks][d] = (u32x4){0u, 0u, 0u, 0u};
                if (tt >= 0) raw[ks][d] = *(const u32x4*)(proj + ((size_t)b * TT + tt) * DIN + DH + wid * 64 + 32 * ks + 8 * fq); }
#pragma unroll 1
        for (int m = 0; m < NM; ++m) {
            const int t = t0 + 16 * m + fr; const size_t rowg = (size_t)b * TT + t;
            u32x4 nraw[2][4];
#pragma unroll
            for (int ks = 0; ks < 2; ++ks)
#pragma unroll
                for (int d = 0; d < 4; ++d) { nraw[ks][d] = (u32x4){0u, 0u, 0u, 0u};
                    if (m + 1 < NM) nraw[ks][d] = *(const u32x4*)(proj + ((size_t)b * TT + t + 13 + d) * DIN + DH + wid * 64 + 32 * ks + 8 * fq); }
            float xc[2][8]; bf16x8 frag[2];
#pragma unroll
            for (int ks = 0; ks < 2; ++ks) {
                const int chb = wid * 64 + 32 * ks + 8 * fq;
                { const f32x4 c0 = *(const LAS f32x4*)(cst + 4 * DH + chb), c1 = *(const LAS f32x4*)(cst + 4 * DH + chb + 4);
                  xc[ks][0] = c0.x; xc[ks][1] = c0.y; xc[ks][2] = c0.z; xc[ks][3] = c0.w; xc[ks][4] = c1.x; xc[ks][5] = c1.y; xc[ks][6] = c1.z; xc[ks][7] = c1.w; }
#pragma unroll
                for (int d = 0; d < 4; ++d) {
                    float u[8]; unpack8(raw[ks][d], u);
                    const f32x4 w0 = *(const LAS f32x4*)(cst + d * DH + chb), w1 = *(const LAS f32x4*)(cst + d * DH + chb + 4);
                    xc[ks][0] += u[0] * w0.x; xc[ks][1] += u[1] * w0.y; xc[ks][2] += u[2] * w0.z; xc[ks][3] += u[3] * w0.w;
                    xc[ks][4] += u[4] * w1.x; xc[ks][5] += u[5] * w1.y; xc[ks][6] += u[6] * w1.z; xc[ks][7] += u[7] * w1.w;
                    raw[ks][d] = nraw[ks][d];
                }
                frag[ks] = __builtin_bit_cast(bf16x8, pack8(xc[ks]));
            }
            f32x4 ar[4], ai[4];
#pragma unroll
            for (int n = 0; n < 4; ++n) { ar[n] = (f32x4){0.f, 0.f, 0.f, 0.f}; ai[n] = (f32x4){0.f, 0.f, 0.f, 0.f};
#pragma unroll
                for (int ks = 0; ks < 2; ++ks) {
                    const bf16x8 wr_ = wl[((n * 2 + ks) * 2 + 0) * 64], wi_ = wl[((n * 2 + ks) * 2 + 1) * 64];
                    ar[n] = __builtin_amdgcn_mfma_f32_16x16x32_bf16(wr_, frag[ks], ar[n], 0, 0, 0);
                    ai[n] = __builtin_amdgcn_mfma_f32_16x16x32_bf16(wi_, frag[ks], ai[n], 0, 0, 0);
                } }
            float Aa[16], Bb[16];
#pragma unroll
            for (int n = 0; n < 4; ++n) {
                const int cho = wid * 64 + 32 * (n >> 1) + 8 * fq + 4 * (n & 1);
                const f32x4 rb = *(const LAS f32x4*)(cst + 5 * DH + cho), ib = *(const LAS f32x4*)(cst + 6 * DH + cho), spv = *(const LAS f32x4*)(cst + 7 * DH + cho);
#pragma unroll
                for (int jj = 0; jj < 4; ++jj) {
                    const float r = sigm(ar[n][jj] + rb[jj]), ig = sigm(ai[n][jj] + ib[jj]);
                    const float la = -8.0f * r * spv[jj], a = __expf(la), x2 = 2.0f * la;
                    const float m2s = -x2 * (1.0f + x2 * (0.5f + x2 * (0.16666667f + x2 * 0.041666668f))), m2 = (x2 > -0.0625f) ? m2s : 1.0f - a * a;
                    Aa[n * 4 + jj] = a; Bb[n * 4 + jj] = __builtin_amdgcn_sqrtf(m2) * ig * xc[n >> 1][4 * (n & 1) + jj];
                }
            }
#pragma unroll
            for (int k = 0; k < 16; ++k) {
                float A = Aa[k], B = Bb[k], Ap, Bq;
                Ap = dppf<0x111>(1.f, A); Bq = dppf<0x111>(0.f, B); B = fmaf(A, Bq, B); A *= Ap;
                Ap = dppf<0x112>(1.f, A); Bq = dppf<0x112>(0.f, B); B = fmaf(A, Bq, B); A *= Ap;
                Ap = dppf<0x114>(1.f, A); Bq = dppf<0x114>(0.f, B); B = fmaf(A, Bq, B); A *= Ap;
                Ap = dppf<0x118>(1.f, A); Bq = dppf<0x118>(0.f, B); B = fmaf(A, Bq, B); A *= Ap;
                Bb[k] = fmaf(A, Hc[k], B); Aa[k] = A * Pc[k];
            }
#pragma unroll
            for (int ks = 0; ks < 2; ++ks) {
                const size_t o = rowg * DH + wid * 64 + 32 * ks + 8 * fq;
                *(f32x4*)(hl + o) = (f32x4){Bb[8 * ks + 0], Bb[8 * ks + 1], Bb[8 * ks + 2], Bb[8 * ks + 3]};
                *(f32x4*)(hl + o + 4) = (f32x4){Bb[8 * ks + 4], Bb[8 * ks + 5], Bb[8 * ks + 6], Bb[8 * ks + 7]};
                u32x4 w; w.x = cvt_pk(Aa[8 * ks + 0], Aa[8 * ks + 1]); w.y = cvt_pk(Aa[8 * ks + 2], Aa[8 * ks + 3]); w.z = cvt_pk(Aa[8 * ks + 4], Aa[8 * ks + 5]); w.w = cvt_pk(Aa[8 * ks + 6], Aa[8 * ks + 7]);
                *(u32x4*)(Pp + o) = w;
            }
            const int src = (lane & 48) | 15;
#pragma unroll
            for (int k = 0; k < 16; ++k) { Hc[k] = __shfl(Bb[k], src); Pc[k] = __shfl(Aa[k], src); }
        }
        if (fr == 0) {
#pragma unroll
            for (int ks = 0; ks < 2; ++ks) {
                const size_t o = (size_t)(b * 128 + c) * DH + wid * 64 + 32 * ks + 8 * fq;
                *(f32x4*)(carA + o) = (f32x4){Pc[8 * ks + 0], Pc[8 * ks + 1], Pc[8 * ks + 2], Pc[8 * ks + 3]}; *(f32x4*)(carA + o + 4) = (f32x4){Pc[8 * ks + 4], Pc[8 * ks + 5], Pc[8 * ks + 6], Pc[8 * ks + 7]};
                *(f32x4*)(carH + o) = (f32x4){Hc[8 * ks + 0], Hc[8 * ks + 1], Hc[8 * ks + 2], Hc[8 * ks + 3]}; *(f32x4*)(carH + o + 4) = (f32x4){Hc[8 * ks + 4], Hc[8 * ks + 5], Hc[8 * ks + 6], Hc[8 * ks + 7]};
            }
        }
    }
    __syncthreads();
}


template <int NMR> __device__ __forceinline__ void m2_rnn_round(const float* hl, const bf16* Pp, const bf16* proj, bf16* Y, LAS float* red1, const float (&cr)[16], int b, int t0, int mbase, int wid, int fr, int fq) {
    f32x4 hv4[NMR][2][2]; u32x4 pw[NMR][2], gw[NMR][2];
#pragma unroll
    for (int m = 0; m < NMR; ++m)
#pragma unroll
        for (int ks = 0; ks < 2; ++ks) { const size_t rowg = (size_t)b * TT + t0 + 16 * (mbase + m) + fr; const int ch = wid * 64 + 32 * ks + 8 * fq; const size_t o = rowg * DH + ch;
            hv4[m][ks][0] = *(const f32x4*)(hl + o); hv4[m][ks][1] = *(const f32x4*)(hl + o + 4); pw[m][ks] = *(const u32x4*)(Pp + o); gw[m][ks] = *(const u32x4*)(proj + rowg * DIN + 2 * DH + ch); }
    float y[NMR][16];
#pragma unroll
    for (int m = 0; m < NMR; ++m) { float s = 0.f;
#pragma unroll
        for (int ks = 0; ks < 2; ++ks) { float pf[8], gt[8]; unpack8(pw[m][ks], pf); unpack8(gw[m][ks], gt);
            const float hh[8] = {hv4[m][ks][0].x, hv4[m][ks][0].y, hv4[m][ks][0].z, hv4[m][ks][0].w, hv4[m][ks][1].x, hv4[m][ks][1].y, hv4[m][ks][1].z, hv4[m][ks][1].w};
#pragma unroll
            for (int e = 0; e < 8; ++e) { const float hv = fmaf(pf[e], cr[8 * ks + e], hh[e]), x = gt[e];
                const float ge = x * __builtin_amdgcn_rcpf(1.0f + __expf(-1.5957691216f * (x + 0.044715f * x * x * x)));
                const float yy = hv * ge; y[m][8 * ks + e] = yy; s = fmaf(yy, yy, s); } }
        s += __shfl_xor(s, 16); s += __shfl_xor(s, 32);
        if (fq == 0) red1[(16 * (mbase + m) + fr) * 8 + wid] = s; }
    __syncthreads();
#pragma unroll
    for (int m = 0; m < NMR; ++m) { const size_t rowg = (size_t)b * TT + t0 + 16 * (mbase + m) + fr;
        const f32x4 r0 = *(const LAS f32x4*)(red1 + (16 * (mbase + m) + fr) * 8), r1 = *(const LAS f32x4*)(red1 + (16 * (mbase + m) + fr) * 8 + 4);
        const float rs = __builtin_amdgcn_rsqf((((r0.x + r0.y) + (r0.z + r0.w)) + ((r1.x + r1.y) + (r1.z + r1.w))) * (1.0f / DH) + EPS);
#pragma unroll
        for (int ks = 0; ks < 2; ++ks) { float yy[8];
#pragma unroll
            for (int e = 0; e < 8; ++e) yy[e] = y[m][8 * ks + e] * rs;
            *(u32x4*)(Y + rowg * D + DH + wid * 64 + 32 * ks + 8 * fq) = pack8(yy); } }
}


template <int NMR> __device__ __forceinline__ void m2_pool_round(const bf16* proj, bf16* Y, const bf16* Wp, const float* pbias, const float* pscale, LAS float* red2,
                                                                  int b, int t0, int mbase, int g, int half, int kwin, int wid, int fr, int fq) {
    const int tb = t0 + 16 * mbase;
    bf16x8 pfr[NMR][4];
#pragma unroll
    for (int ks = 0; ks < 4; ++ks) {
        const int chb = g * 128 + 32 * ks + 8 * fq;
        float pu[8], p2[8], p4[8], p8[8];
        if (tb) { const u32x4 raw = *(const u32x4*)(proj + ((size_t)b * TT + tb - 16 + fr) * DIN + chb); unpack8(raw, pu);
#pragma unroll
            for (int e = 0; e < 8; ++e) { p2[e] = pu[e] + dppf<0x111>(0.f, pu[e]); p4[e] = p2[e] + dppf<0x112>(0.f, p2[e]); p8[e] = p4[e] + dppf<0x114>(0.f, p4[e]); } }
        else {
#pragma unroll
            for (int e = 0; e < 8; ++e) { pu[e] = 0.f; p2[e] = 0.f; p4[e] = 0.f; p8[e] = 0.f; } }
#pragma unroll
        for (int m = 0; m < NMR; ++m) {
            const int t = tb + 16 * m + fr; const size_t rowg = (size_t)b * TT + t;
            const u32x4 raw = *(const u32x4*)(proj + rowg * DIN + chb); float u[8], po[8]; unpack8(raw, u);
            const int cnt = (t + 1 < kwin) ? t + 1 : kwin; const float rc = __builtin_amdgcn_rcpf((float)cnt);
#pragma unroll
            for (int e = 0; e < 8; ++e) {
                const float s2 = u[e] + shiftd<1>(u[e], pu[e]), s4 = s2 + shiftd<2>(s2, p2[e]), s8 = s4 + shiftd<4>(s4, p4[e]), s16 = s8 + shiftd<8>(s8, p8[e]);
                const float win = g == 0 ? s2 : (g == 1 ? s4 : (g == 2 ? s8 : s16));
                po[e] = fmaf(win, rc, -u[e]); pu[e] = u[e]; p2[e] = s2; p4[e] = s4; p8[e] = s8;
            }
            pfr[m][ks] = __builtin_bit_cast(bf16x8, pack8(po));
        }
    }
    bf16x8 wfr[4][4];
#pragma unroll
    for (int n = 0; n < 4; ++n)
#pragma unroll
        for (int ks = 0; ks < 4; ++ks) wfr[n][ks] = *(const bf16x8*)(Wp + (size_t)(64 * half + outchan(n, fr)) * 128 + 32 * ks + 8 * fq);
#pragma unroll 1
    for (int pass = 0; pass < 2; ++pass) {
#pragma unroll
        for (int m = 0; m < NMR; ++m) {
            const int t = tb + 16 * m + fr; const size_t rowg = (size_t)b * TT + t; float s = 0.f, rs = 0.f;
            if (pass) { const f32x4 r0 = *(const LAS f32x4*)(red2 + (16 * (mbase + m) + fr) * 8), r1 = *(const LAS f32x4*)(red2 + (16 * (mbase + m) + fr) * 8 + 4);
                rs = __builtin_amdgcn_rsqf((((r0.x + r0.y) + (r0.z + r0.w)) + ((r1.x + r1.y) + (r1.z + r1.w))) * (1.0f / DH) + EPS); }
#pragma unroll
            for (int np = 0; np < 2; ++np) {
                f32x4 o2[2];
#pragma unroll
                for (int nn = 0; nn < 2; ++nn) { const int n = 2 * np + nn;
                    f32x4 acc = {0.f, 0.f, 0.f, 0.f};
#pragma unroll
                    for (int ks = 0; ks < 4; ++ks) acc = __builtin_amdgcn_mfma_f32_16x16x32_bf16(wfr[n][ks], pfr[m][ks], acc, 0, 0, 0);
                    const int col = g * 128 + 64 * half + 32 * np + 8 * fq + 4 * nn;
                    const f32x4 pb = *(const f32x4*)(pbias + col), ps = *(const f32x4*)(pscale + col);
                    acc = (acc + pb) * ps; s += (acc.x * acc.x + acc.y * acc.y) + (acc.z * acc.z + acc.w * acc.w); o2[nn] = acc * rs; }
                if (pass) { u32x4 w; w.x = cvt_pk(o2[0].x, o2[0].y); w.y = cvt_pk(o2[0].z, o2[0].w); w.z = cvt_pk(o2[1].x, o2[1].y); w.w = cvt_pk(o2[1].z, o2[1].w);
                    *(u32x4*)(Y + rowg * D + g * 128 + 64 * half + 32 * np + 8 * fq) = w; }
            }
            if (!pass) { s += __shfl_xor(s, 16); s += __shfl_xor(s, 32); if (fq == 0) red2[(16 * (mbase + m) + fr) * 8 + wid] = s; }
        }
        if (!pass) __syncthreads();
    }
}

__device__ __forceinline__ void m2_phase(const Params& p_, LAS unsigned char* lds, int G, int l) {
    const Params p = launder(p_);
    int tid_ = threadIdx.x; asm volatile("" : "+v"(tid_));
    const int tid = tid_, lane = tid & 63, wid = __builtin_amdgcn_readfirstlane(tid >> 6), fr = lane & 15, fq = lane >> 4;
    LAS float* segA = (LAS float*)lds; LAS float* segH = (LAS float*)(lds + 16384); LAS float* carr = (LAS float*)(lds + 32768);
    LAS float* red1 = (LAS float*)(lds + 34816); LAS float* red2 = (LAS float*)(lds + 37888);
    const bf16* proj = (const bf16*)(p.ws + WS_PROJ); bf16* Y = (bf16*)(p.ws + WS_Y);
    const float* hl = (const float*)(p.ws + WS_HL); const bf16* Pp = (const bf16*)(p.ws + WS_P);
    const float* carA = (const float*)(p.ws + WS_CARA); const float* carH = (const float*)(p.ws + WS_CARH);
    const int g = wid >> 1, half = wid & 1, kwin = 2 << g;
    const bf16* Wp = (const bf16*)(p.ws + WS_POOLW) + (size_t)(l * 4 + g) * 16384;
    const float* pbias = p.in[5] + l * DH; const float* pscale = p.in[6] + l * DH;
    for (int unit = blockIdx.x; unit < 256; unit += G) {
        const int b = unit >> 7, c = unit & 127, t0 = c ? NMETA + 64 * c : 0, NM = c ? 4 : 5;
        {
            const int q = (c + 7) >> 3, jlo = wid * q, jhi = (jlo + q < c) ? jlo + q : c;
            f32x4 A0 = {1.f, 1.f, 1.f, 1.f}, A1 = A0, H0 = {0.f, 0.f, 0.f, 0.f}, H1 = H0;
            for (int j = jlo; j < jhi; j += 8) {
                f32x4 a0[8], a1[8], h0[8], h1[8];
#pragma unroll
                for (int i = 0; i < 8; ++i) { const int jj = (j + i < jhi) ? j + i : jhi - 1; const size_t o = (size_t)(b * 128 + jj) * DH + 8 * lane;
                    a0[i] = *(const f32x4*)(carA + o); a1[i] = *(const f32x4*)(carA + o + 4); h0[i] = *(const f32x4*)(carH + o); h1[i] = *(const f32x4*)(carH + o + 4); }
#pragma unroll
                for (int i = 0; i < 8; ++i) if (j + i < jhi) { H0 = a0[i] * H0 + h0[i]; A0 = A0 * a0[i]; H1 = a1[i] * H1 + h1[i]; A1 = A1 * a1[i]; }
            }
            *(LAS f32x4*)(segA + wid * DH + 8 * lane) = A0; *(LAS f32x4*)(segA + wid * DH + 8 * lane + 4) = A1;
            *(LAS f32x4*)(segH + wid * DH + 8 * lane) = H0; *(LAS f32x4*)(segH + wid * DH + 8 * lane + 4) = H1;
        }
        __syncthreads();
        { float cy = 0.f;
#pragma unroll
          for (int s8 = 0; s8 < 8; ++s8) cy = segA[s8 * DH + tid] * cy + segH[s8 * DH + tid];
          carr[tid] = cy; }
        __syncthreads();
        {
            float cr[16];
#pragma unroll
            for (int ks = 0; ks < 2; ++ks) { const f32x4 c0 = *(const LAS f32x4*)(carr + wid * 64 + 32 * ks + 8 * fq), c1 = *(const LAS f32x4*)(carr + wid * 64 + 32 * ks + 8 * fq + 4);
                cr[8 * ks + 0] = c0.x; cr[8 * ks + 1] = c0.y; cr[8 * ks + 2] = c0.z; cr[8 * ks + 3] = c0.w; cr[8 * ks + 4] = c1.x; cr[8 * ks + 5] = c1.y; cr[8 * ks + 6] = c1.z; cr[8 * ks + 7] = c1.w; }
            m2_rnn_round<4>(hl, Pp, proj, Y, red1, cr, b, t0, 0, wid, fr, fq);
            if (NM == 5) m2_rnn_round<1>(hl, Pp, proj, Y, red1, cr, b, t0, 4, wid, fr, fq);
        }
        m2_pool_round<4>(proj, Y, Wp, pbias, pscale, red2, b, t0, 0, g, half, kwin, wid, fr, fq);
        if (NM == 5) m2_pool_round<1>(proj, Y, Wp, pbias, pscale, red2, b, t0, 4, g, half, kwin, wid, fr, fq);
    }
    __syncthreads();
}

__device__ __forceinline__ void final_norm(const Params& p_, int G) {
    const Params p = launder(p_);
    int tid_ = threadIdx.x; asm volatile("" : "+v"(tid_));
    const int tid = tid_, lane = tid & 63, wid = tid >> 6; const int gw = blockIdx.x * 8 + wid, NGW = G * 8;
    const bf16* hb = (const bf16*)(p.ws + WS_HB);
    const f32x4* gp = (const f32x4*)p.in[19] + 2 * lane; f32x4 gg[2][2];
#pragma unroll
    for (int j = 0; j < 2; ++j) { gg[j][0] = gp[128 * j]; gg[j][1] = gp[128 * j + 1]; }
    for (int m = gw; m < M; m += NGW) {
        const u32x4* xr = (const u32x4*)(hb + (size_t)m * D) + lane; float v[2][8]; float s = 0.f;
#pragma unroll
        for (int j = 0; j < 2; ++j) { unpack8(xr[64 * j], v[j]);
#pragma unroll
            for (int e = 0; e < 8; ++e) s = fmaf(v[j][e], v[j][e], s); }
        const float rs = 1.0f / sqrtf(wave_sum(s) * (1.0f / D) + EPS);
        f32x4* orow = (f32x4*)(p.out + (size_t)m * D) + 2 * lane;
#pragma unroll
        for (int j = 0; j < 2; ++j) {
            orow[128 * j] = (f32x4){v[j][0] * rs * gg[j][0].x, v[j][1] * rs * gg[j][0].y, v[j][2] * rs * gg[j][0].z, v[j][3] * rs * gg[j][0].w};
            orow[128 * j + 1] = (f32x4){v[j][4] * rs * gg[j][1].x, v[j][5] * rs * gg[j][1].y, v[j][6] * rs * gg[j][1].z, v[j][7] * rs * gg[j][1].w}; }
    }
}

#define XB_TMO      128
#define XB_XCNT(j)  (256  + 64 * (j))
#define XB_XSUB(j)  (1280 + 64 * (j))
#define XB_XGEN(j)  (2304 + 64 * (j))
#define XB_TOP      3328
#define XB_TOPGEN   3392
#define XCD_BAR_WORDS 3456
#define XB_SPIN_CAP (1u << 18)

__device__ __forceinline__ unsigned xb_ld(unsigned* p)              { return __hip_atomic_load(p, __ATOMIC_RELAXED, __HIP_MEMORY_SCOPE_AGENT); }
__device__ __forceinline__ unsigned xb_add(unsigned* p, unsigned v) { return __hip_atomic_fetch_add(p, v, __ATOMIC_RELAXED, __HIP_MEMORY_SCOPE_AGENT); }
__device__ __forceinline__ unsigned xb_xcc_id() { return (unsigned)__builtin_amdgcn_s_getreg((3 << 11) | 20) & 0xFu; }
#define XB_SPIN(cond, bar) do { unsigned _sp = 0; while (cond) { __builtin_amdgcn_s_sleep(1); \
    if ((++_sp & 255u) == 0u) { if (xb_ld(&(bar)[XB_TMO])) break; if (_sp > XB_SPIN_CAP) { atomicAdd(&(bar)[XB_TMO], 1u); break; } } } } while (0)

struct XcdBarrier {
    unsigned* bar; unsigned x;
    volatile LAS unsigned* st;
};

__device__ __forceinline__ XcdBarrier xcd_barrier_post(unsigned* bar, volatile LAS unsigned* st) {
    XcdBarrier b; b.bar = bar; b.x = xb_xcc_id(); b.st = st;
    if (threadIdx.x == 0) (void)xb_add(&bar[XB_XCNT(b.x)], 1u);
    return b;
}
__device__ __forceinline__ void xcd_barrier_complete(unsigned* bar, unsigned x, unsigned& nloc, unsigned& nx) {
    const unsigned G = gridDim.x * gridDim.y * gridDim.z;
    unsigned sum, cnt, mine, sp = 0u;
    for (;;) {
        sum = 0u; cnt = 0u; mine = 0u;
#pragma unroll
        for (unsigned j = 0; j < 16; ++j) { const unsigned c = xb_ld(&bar[XB_XCNT(j)]); sum += c; cnt += (c > 0u) ? 1u : 0u; mine = (j == x) ? c : mine; }
        if (sum == G) break;
        __builtin_amdgcn_s_sleep(1);
        if ((++sp & 255u) == 0u) { if (xb_ld(&bar[XB_TMO])) break; if (sp > XB_SPIN_CAP) { atomicAdd(&bar[XB_TMO], 1u); break; } }
    }
    nloc = mine > 0u ? mine : 1u; nx = cnt > 0u ? cnt : 1u;
}

__device__ __forceinline__ void xcd_barrier(const XcdBarrier& b) {
    asm volatile("s_waitcnt vmcnt(0)" ::: "memory");
    __syncthreads();
    if (threadIdx.x == 0) {
        unsigned* bar = b.bar;
        __builtin_amdgcn_s_waitcnt(0);
        unsigned nloc = b.st[0], nx = b.st[1];
        if (nloc == 0u) { xcd_barrier_complete(bar, b.x, nloc, nx); b.st[0] = nloc; b.st[1] = nx; }
        const unsigned old = xb_add(&bar[XB_XSUB(b.x)], 1u);
        const unsigned gen = old / nloc;
        if (old + 1u == (gen + 1u) * nloc) {
            __builtin_amdgcn_fence(__ATOMIC_RELEASE, "agent");
            asm volatile("s_waitcnt vmcnt(0)" ::: "memory");
            const unsigned og = xb_add(&bar[XB_TOP], 1u);
            const unsigned tg = og / nx;
            if (og + 1u == (tg + 1u) * nx) xb_add(&bar[XB_TOPGEN], 1u);
            else XB_SPIN(xb_ld(&bar[XB_TOPGEN]) == tg, bar);
            __builtin_amdgcn_fence(__ATOMIC_ACQUIRE, "agent");
            xb_add(&bar[XB_XGEN(b.x)], 1u);
            asm volatile("s_waitcnt vmcnt(0)" ::: "memory");
        } else {
            XB_SPIN(xb_ld(&bar[XB_XGEN(b.x)]) == gen, bar);
            __builtin_amdgcn_fence(__ATOMIC_ACQUIRE, "agent");
            asm volatile("s_waitcnt vmcnt(0)" ::: "memory");
        }
    }
    __syncthreads();
}

#ifndef PROBE_SYNC2
#define PROBE_SYNC2 0
#endif
#ifndef PROBE_M1X2
#define PROBE_M1X2 0
#endif
#ifndef PROBE_M2X2
#define PROBE_M2X2 0
#endif
#define GSYNC() do { asm volatile("" : "+s"(xbar.bar)); xcd_barrier(xbar); if (PROBE_SYNC2) xcd_barrier(xbar); } while (0)
__device__ __forceinline__ int rstd_cache(LAS unsigned char* lds, const float* ss, const pg8::StaticOrder& S) {
    pg8::Unit u0; int pmc = -1;
    int tid = threadIdx.x; asm volatile("" : "+v"(tid));
    if (S.next(0, u0)) { pmc = u0.pm; if (tid < 256) ((LAS float*)(lds + 131072))[tid] = row_rstd(ss, u0.pm * 256 + tid); }
    __syncthreads();
    return pmc;
}
#ifndef PROBE_PHASE
#define PROBE_PHASE (-1)
#endif
#define TIC() do { if (PROBE_PHASE >= 0) tic = __builtin_amdgcn_s_memrealtime(); } while (0)
#define TOC(k) do { if (PROBE_PHASE == (k)) tacc += __builtin_amdgcn_s_memrealtime() - tic; } while (0)
__global__ void __launch_bounds__(512, 2) fwd_megakernel(Params p) {
    extern __shared__ __attribute__((aligned(16))) unsigned char lds_raw[];
    LAS unsigned char* lds = (LAS unsigned char*)lds_raw;
    cg::grid_group grid = cg::this_grid();
    const int G = gridDim.x;
    unsigned long long tic = 0, tacc = 0;
    unsigned char* ws = p.ws;
    volatile LAS unsigned* xst = (volatile LAS unsigned*)(lds + LDS_XST);
    if (threadIdx.x < 2) xst[threadIdx.x] = 0u;
    __syncthreads();
    XcdBarrier xbar = xcd_barrier_post((unsigned*)(ws + WS_CTL), xst);
    bf16* hb = (bf16*)(ws + WS_HB); bf16* proj = (bf16*)(ws + WS_PROJ); bf16* Y = (bf16*)(ws + WS_Y); bf16* mid = (bf16*)(ws + WS_MID); float* ss = (float*)(ws + WS_SS);
    grid.sync();
    TIC();
#ifndef NO_PRO
    prologue(p, lds, G);
#endif
    GSYNC();
    TOC(0);
#pragma unroll 1
    for (int l = 0; l < DEPTH; ++l) {
        asm volatile("" : "+s"(ws));
        const unsigned char* wl = ws + WS_W + (size_t)l * W_LAYER;
        const bf16* in_t = (const bf16*)(wl + W_IN); const bf16* out_t = (const bf16*)(wl + W_OUT); const bf16* up_t = (const bf16*)(wl + W_UP); const bf16* down_t = (const bf16*)(wl + W_DOWN);
        TIC();
#ifndef NO_GIN
        { pg8::Gemm g{hb, in_t, M, DIN, D, 0}; pg8::StaticOrder S; S.init(M, DIN, G, (int)blockIdx.x); const int pmc = rstd_cache(lds, ss, S); EpiIn E{proj, ss, (const LAS float*)(lds + 131072), pmc};
          pg8::gemm_phase<EpiIn, pg8::StaticOrder, true, true>(lds, g, S, E); }
#endif
#ifndef NO_META
        meta_tasks<0>(p, lds, G, nullptr, 0, in_t, D, DIN / 16);
#endif
        GSYNC();
        TOC(1); TIC();
#ifndef NO_M1
        m1_phase(p, lds, G, l);
        if (PROBE_M1X2) m1_phase(p, lds, G, l);
#endif
        GSYNC();
        TOC(2); TIC();
#ifndef NO_M2
        m2_phase(p, lds, G, l);
        if (PROBE_M2X2) m2_phase(p, lds, G, l);
#endif
        GSYNC();
        TOC(3); TIC();
#ifndef NO_GOUT
        { pg8::Gemm g{Y, out_t, M, D, D, NMETA}; pg8::StaticOrder S; S.init(M, D, G, (int)blockIdx.x); EpiRes E{hb, ss};
          pg8::gemm_phase<EpiRes, pg8::StaticOrder, false, true>(lds, g, S, E); }
#endif
#ifndef NO_META
        if (l < DEPTH - 1) meta_tasks<1>(p, lds, G, Y, D, out_t, D, D / 16);
#endif
        GSYNC();
        TOC(4); TIC();
#ifndef NO_GUP
        { pg8::Gemm g{hb, up_t, M, FF, D, 0}; pg8::StaticOrder S; S.init(M, FF, G, (int)blockIdx.x); const int pmc = rstd_cache(lds, ss, S); EpiUp E{mid, ss, (const LAS float*)(lds + 131072), pmc};
          pg8::gemm_phase<EpiUp, pg8::StaticOrder, true, true>(lds, g, S, E); }
#endif
#ifndef NO_META
        if (l < DEPTH - 1) meta_tasks<2>(p, lds, G, nullptr, 0, up_t, D, FF / 16);
#endif
        GSYNC();
        TOC(5); TIC();
#ifndef NO_GDN
        { pg8::Gemm g{mid, down_t, M, D, FF, 0}; pg8::StaticOrder S; S.init(M, D, G, (int)blockIdx.x); EpiRes E{hb, ss};
          pg8::gemm_phase<EpiRes, pg8::StaticOrder, false, true>(lds, g, S, E); }
#endif
#ifndef NO_META
        if (l < DEPTH - 1) meta_tasks<1>(p, lds, G, (const bf16*)(ws + WS_MIDMETA), FF, down_t, FF, D / 16);
#endif
        GSYNC();
        TOC(6);
    }
    TIC();
    final_norm(p, G);
    TOC(7);
    if (PROBE_PHASE >= 0 && blockIdx.x == 0 && threadIdx.x == 0) { const unsigned long long w0 = __builtin_amdgcn_s_memrealtime(); while (__builtin_amdgcn_s_memrealtime() - w0 < 4ull * tacc) __builtin_amdgcn_s_sleep(8); }
}

extern "C" void kernel_launch(void* const* d_in, const int* in_sizes, int n_in, void* d_out, int out_size, void* d_ws, size_t ws_size, hipStream_t stream) {
    static int grid = 0;
    if (grid == 0) {
        if (n_in != 20 || in_sizes[0] != M * D || out_size != M * D || ws_size < WS_END) { fprintf(stderr, "kernel_launch: unexpected shapes (n_in %d, in0 %d, out %d, ws %zu)\n", n_in, n_in > 0 ? in_sizes[0] : -1, out_size, ws_size); grid = -1; return; }
        int dev = 0, cus = 0, per_cu = 0;
        if (hipGetDevice(&dev) != hipSuccess || hipDeviceGetAttribute(&cus, hipDeviceAttributeMultiprocessorCount, dev) != hipSuccess) { grid = -1; return; }
        if (hipFuncSetAttribute((const void*)fwd_megakernel, hipFuncAttributeMaxDynamicSharedMemorySize, LDS_BYTES) != hipSuccess) { fprintf(stderr, "kernel_launch: hipFuncSetAttribute failed\n"); grid = -1; return; }
        if (hipOccupancyMaxActiveBlocksPerMultiprocessor(&per_cu, (const void*)fwd_megakernel, 512, LDS_BYTES) != hipSuccess || per_cu < 1) { fprintf(stderr, "kernel_launch: occupancy query gave %d\n", per_cu); (void)hipGetLastError(); grid = -1; return; }
        grid = cus * 1;
    }
    if (grid < 0) return;
    if (hipMemsetAsync((char*)d_ws + WS_CTL, 0, XCD_BAR_WORDS * 4, stream) != hipSuccess) { fprintf(stderr, "kernel_launch: memset failed\n"); return; }
    Params p{};
    for (int i = 0; i < 20; ++i) p.in[i] = (const float*)d_in[i];
    p.out = (float*)d_out; p.ws = (unsigned char*)d_ws;
    void* args[] = {&p};
    hipError_t e = hipLaunchCooperativeKernel((const void*)fwd_megakernel, dim3(grid), dim3(512), args, LDS_BYTES, stream);
    if (e != hipSuccess) fprintf(stderr, "cooperative launch failed: %s (grid %d)\n", hipGetErrorString(e), grid);
}
```

```cpp
#define FUSED_MIXER 0
#include <hip/hip_runtime.h>
#include <hip/hip_cooperative_groups.h>
#include <cstdio>
#include <cstdint>
namespace cg = cooperative_groups;
namespace pg8 {
#define PG8_LAS __attribute__((address_space(3)))
typedef unsigned short bf16_t;
typedef short bf16x8 __attribute__((ext_vector_type(8)));
typedef float f32x4 __attribute__((ext_vector_type(4)));
typedef unsigned u32x4 __attribute__((ext_vector_type(4)));
constexpr int BM = 256, BK = 64, HALF = 128, HTB = HALF * BK * 2  , STAGE_BYTES = 8 * HTB, NXCD = 8, WGM = 8;

__host__ __device__ __forceinline__ int lds_byte(int r, int c) { const int st = (r >> 4) * 2 + (c >> 5), rr = r & 15, cc = c & 31, ob = rr * 64 + cc * 2; return st * 1024 + (ob ^ (((ob >> 9) & 1) << 5)); }
__host__ __device__ __forceinline__ void stage_rc(int b, int& R, int& C) { const int st = b / 1024, sb = b % 1024, swz = sb ^ (((sb >> 9) & 1) << 5); R = (st >> 1) * 16 + swz / 64; C = (st & 1) * 32 + (swz % 64) / 2; }
__host__ __device__ __forceinline__ int perm32(int rho) { const int n = rho >> 4, i = rho & 15; return 8 * (i >> 2) + 4 * n + (i & 3); }

struct Unit { int pm, pn; };
struct Gemm { const bf16_t* A; const bf16_t* Bt; int M, N, K, gap; };

struct StaticOrder {
    int nM, nN, nwg, G, c;
    __host__ __device__ void init(int M, int N, int G_, int c_) { nM = M / BM; nN = N / BM; nwg = nM * nN; G = G_; c = c_; }
    __host__ __device__ bool next(int i, Unit& u) const {
        const long L = (long)i * G + c; if (L >= nwg) return false;
        int wgid = (int)L; { const int q = nwg / NXCD, r = nwg % NXCD, xcd = wgid % NXCD, off = wgid / NXCD; wgid = (xcd < r ? xcd * (q + 1) : r * (q + 1) + (xcd - r) * q) + off; }
        const int nig = WGM * nN, gid = wgid / nig, fm = gid * WGM, gsz = (nM - fm) < WGM ? (nM - fm) : WGM;
        u.pm = fm + ((wgid % nig) % gsz); u.pn = (wgid % nig) / gsz; return true;
    }
    __device__ __forceinline__ void a_ready(const Unit&) const {}
    __device__ __forceinline__ void done(const Unit&) const {}
};
__device__ __forceinline__ unsigned cvt_pk_bf16(float lo, float hi) { unsigned r; asm volatile("v_cvt_pk_bf16_f32 %0, %1, %2" : "=v"(r) : "v"(lo), "v"(hi)); return r; }
template <class Epi, class Sched, bool ALIGN_EPI = false, bool SP2 = false>
__device__ __forceinline__ void gemm_phase(PG8_LAS unsigned char* lds, const Gemm g, const Sched& S, const Epi& E) {
    int tid_ = threadIdx.x; asm volatile("" : "+v"(tid_));
    const int tid = tid_, wid = __builtin_amdgcn_readfirstlane(tid >> 6), lane = tid & 63, wr = wid >> 2, wc = wid & 3, fr = lane & 15, fq = lane >> 4;
    const int K = g.K, nt = K / BK;
    unsigned voffA[2], voffB[2];
#pragma unroll
    for (int i = 0; i < 2; ++i) { int R, C; stage_rc(tid * 16 + i * 8192, R, C); const int Rb = Epi::PERM ? ((R & ~31) + perm32(R & 31)) : R;
        voffA[i] = (unsigned)(R * K + C) * 2u; voffB[i] = (unsigned)(Rb * K + C) * 2u; }
    const size_t kstep = (size_t)(BK * 2);
    const size_t hstep = (size_t)HALF * K * 2;
    const size_t tstep = 2 * hstep;
    const int agap = g.gap;
#define a_off(pm_) ((size_t)((pm_) * BM + agap * (1 + ((pm_) >> 5))) * (size_t)K * 2)
    const unsigned ldsw = (unsigned)wid * 1024u;
    const int aoff = lds_byte(wr * 64 + fr, fq * 8), boff = lds_byte(wc * 32 + fr, fq * 8);
#define PG8_SA(b, h) (((b) * 2 + (h)) * HTB)
#define PG8_SB(b, h) ((4 + (b) * 2 + (h)) * HTB)
#define PG8_STAGE(bufoff, gbase, voff) do { _Pragma("unroll") for (int _i = 0; _i < 2; ++_i) \
        __builtin_amdgcn_global_load_lds((const unsigned*)((const char*)(gbase) + (voff)[_i]), (PG8_LAS unsigned*)(lds + (bufoff) + ldsw + _i * 8192), 16, 0, 0); } while (0)
#define PG8_LDA(dst, b, h) do { _Pragma("unroll") for (int m = 0; m < 4; ++m) _Pragma("unroll") for (int k = 0; k < 2; ++k) dst[m][k] = *(const PG8_LAS bf16x8*)(lds + PG8_SA(b, h) + aoff + m * 2048 + k * 1024); } while (0)
#define PG8_LDB(dst, b, h) do { _Pragma("unroll") for (int n = 0; n < 2; ++n) _Pragma("unroll") for (int k = 0; k < 2; ++k) dst[n][k] = *(const PG8_LAS bf16x8*)(lds + PG8_SB(b, h) + boff + n * 2048 + k * 1024); } while (0)
#define PG8_MMA(ai, bj, At, Bt) do { __builtin_amdgcn_s_setprio(1); _Pragma("unroll") for (int m = 0; m < 4; ++m) _Pragma("unroll") for (int n = 0; n < 2; ++n) _Pragma("unroll") for (int k = 0; k < 2; ++k) \
        acc[ai][bj][m][n] = __builtin_amdgcn_mfma_f32_16x16x32_bf16(Bt[n][k], At[m][k], acc[ai][bj][m][n], 0, 0, 0); __builtin_amdgcn_s_setprio(0); } while (0)
#define PG8_WAIT_V(n) asm volatile("s_waitcnt vmcnt(" #n ")" ::: "memory")
#define PG8_WAIT_L(n) asm volatile("s_waitcnt lgkmcnt(" #n ")" ::: "memory")
#define PG8_BAR __builtin_amdgcn_s_barrier()
#define PG8_SCHED __builtin_amdgcn_sched_barrier(0)
    Unit cur, nxt; int ui = 0;
    if (!S.next(0, cur)) return;
    f32x4 acc[2][2][4][2];
#pragma unroll
    for (int a = 0; a < 2; ++a)
#pragma unroll
        for (int b = 0; b < 2; ++b)
#pragma unroll
            for (int m = 0; m < 4; ++m)
#pragma unroll
                for (int n = 0; n < 2; ++n) acc[a][b][m][n] = (f32x4){0.f, 0.f, 0.f, 0.f};
    if constexpr (Epi::PRELOAD) E.preload(acc, cur, wr, wc, fr, fq);
    bf16x8 At[4][2], B0[2][2], B1[2][2];
    const char* cA = (const char*)g.A + a_off(cur.pm); const char* cB = (const char*)g.Bt + (size_t)cur.pn * tstep;
    S.a_ready(cur);
    if constexpr (SP2) {
        PG8_STAGE(PG8_SB(0, 0), cB, voffB); PG8_STAGE(PG8_SB(0, 1), cB + hstep, voffB); PG8_STAGE(PG8_SA(0, 0), cA, voffA); PG8_STAGE(PG8_SA(0, 1), cA + hstep, voffA);
        if (wr == 1) PG8_BAR;
        PG8_WAIT_V(2); PG8_BAR;
        PG8_STAGE(PG8_SB(1, 0), cB + kstep, voffB); PG8_STAGE(PG8_SA(1, 0), cA + kstep, voffA); PG8_STAGE(PG8_SB(1, 1), cB + hstep + kstep, voffB);
        PG8_WAIT_V(6); PG8_BAR;
    } else {
        PG8_STAGE(PG8_SB(0, 0), cB, voffB); PG8_STAGE(PG8_SA(0, 0), cA, voffA); PG8_STAGE(PG8_SB(0, 1), cB + hstep, voffB); PG8_STAGE(PG8_SA(0, 1), cA + hstep, voffA);
        if (wr == 1) PG8_BAR;
        PG8_WAIT_V(4); PG8_BAR;
        PG8_STAGE(PG8_SB(1, 0), cB + kstep, voffB); PG8_STAGE(PG8_SA(1, 0), cA + kstep, voffA); PG8_STAGE(PG8_SB(1, 1), cB + hstep + kstep, voffB);
        PG8_WAIT_V(6); PG8_BAR;
    }
    for (;;) {
        const bool has_next = S.next(ui + 1, nxt);
        const char* nA = has_next ? (const char*)g.A + a_off(nxt.pm) : cA; const char* nB = has_next ? (const char*)g.Bt + (size_t)nxt.pn * tstep : cB;
        for (int t = 0; t < nt; t += 2) {
            const bool last = (t == nt - 2);
            const char* a1 = cA + (size_t)(t + 1) * kstep;
            const char* a2 = last ? nA : cA + (size_t)(t + 2) * kstep; const char* b2 = last ? nB : cB + (size_t)(t + 2) * kstep;
            const char* a3 = a2 + kstep; const char* b3 = b2 + kstep;
            if (last && has_next) S.a_ready(nxt);
            if constexpr (SP2) {
            PG8_LDB(B0, 0, 0); PG8_LDB(B1, 0, 1); PG8_SCHED; PG8_LDA(At, 0, 0); PG8_STAGE(PG8_SA(1, 1), a1 + hstep, voffA);
            PG8_WAIT_V(8); PG8_WAIT_L(0); PG8_BAR; PG8_MMA(0, 0, At, B0); PG8_MMA(0, 1, At, B1); PG8_BAR; PG8_SCHED;
            PG8_LDA(At, 0, 1); PG8_STAGE(PG8_SB(0, 0), b2, voffB); PG8_STAGE(PG8_SB(0, 1), b2 + hstep, voffB); PG8_STAGE(PG8_SA(0, 0), a2, voffA);
            PG8_WAIT_V(8); PG8_WAIT_L(0); PG8_BAR; PG8_MMA(1, 0, At, B0); PG8_MMA(1, 1, At, B1); PG8_BAR; PG8_SCHED;
            PG8_LDB(B0, 1, 0); PG8_LDB(B1, 1, 1); PG8_SCHED; PG8_LDA(At, 1, 0); PG8_STAGE(PG8_SA(0, 1), a2 + hstep, voffA);
            PG8_WAIT_V(8); PG8_WAIT_L(0); PG8_BAR; PG8_MMA(0, 0, At, B0); PG8_MMA(0, 1, At, B1); PG8_BAR; PG8_SCHED;
            PG8_LDA(At, 1, 1); PG8_STAGE(PG8_SB(1, 0), b3, voffB); PG8_STAGE(PG8_SB(1, 1), b3 + hstep, voffB); PG8_STAGE(PG8_SA(1, 0), a3, voffA);
            PG8_WAIT_V(8); PG8_WAIT_L(0); PG8_BAR; PG8_MMA(1, 0, At, B0); PG8_MMA(1, 1, At, B1); PG8_BAR; PG8_SCHED;
            } else {
            PG8_LDB(B0, 0, 0); PG8_SCHED; PG8_LDA(At, 0, 0); PG8_STAGE(PG8_SA(1, 1), a1 + hstep, voffA);
            PG8_WAIT_L(8); PG8_BAR; PG8_WAIT_L(0); PG8_MMA(0, 0, At, B0); PG8_BAR; PG8_SCHED;
            PG8_LDB(B1, 0, 1); PG8_STAGE(PG8_SB(0, 0), b2, voffB);
            PG8_BAR; PG8_WAIT_L(0); PG8_MMA(0, 1, At, B1); PG8_BAR;
            PG8_LDA(At, 0, 1); PG8_STAGE(PG8_SA(0, 0), a2, voffA);
            PG8_BAR; PG8_WAIT_L(0); PG8_MMA(1, 0, At, B0); PG8_BAR; PG8_SCHED;
            PG8_STAGE(PG8_SB(0, 1), b2 + hstep, voffB);
            PG8_WAIT_V(6); PG8_BAR; PG8_MMA(1, 1, At, B1); PG8_BAR;
            PG8_LDB(B0, 1, 0); PG8_SCHED; PG8_LDA(At, 1, 0); PG8_STAGE(PG8_SA(0, 1), a2 + hstep, voffA);
            PG8_WAIT_L(8); PG8_BAR; PG8_WAIT_L(0); PG8_MMA(0, 0, At, B0); PG8_BAR; PG8_SCHED;
            PG8_LDB(B1, 1, 1); PG8_STAGE(PG8_SB(1, 0), b3, voffB);
            PG8_BAR; PG8_WAIT_L(0); PG8_MMA(0, 1, At, B1); PG8_BAR;
            PG8_LDA(At, 1, 1); PG8_STAGE(PG8_SA(1, 0), a3, voffA);
            PG8_BAR; PG8_WAIT_L(0); PG8_MMA(1, 0, At, B0); PG8_BAR; PG8_SCHED;
            PG8_STAGE(PG8_SB(1, 1), b3 + hstep, voffB);
            PG8_WAIT_V(6); PG8_BAR; PG8_MMA(1, 1, At, B1); PG8_BAR;
            }
        }
        if constexpr (ALIGN_EPI) { if (wr == 0) PG8_BAR; }
        if constexpr (!Epi::AFTER_DRAIN) { E(acc, cur, wr, wc, fr, fq); S.done(cur); }
        if (!has_next) break;
#pragma unroll
        for (int a = 0; a < 2; ++a)
#pragma unroll
            for (int b = 0; b < 2; ++b)
#pragma unroll
                for (int m = 0; m < 4; ++m)
#pragma unroll
                    for (int n = 0; n < 2; ++n) acc[a][b][m][n] = (f32x4){0.f, 0.f, 0.f, 0.f};
        if constexpr (Epi::PRELOAD) { E.preload(acc, nxt, wr, wc, fr, fq); PG8_WAIT_V(0); }
        cur = nxt; cA = nA; cB = nB; ++ui;
        if constexpr (ALIGN_EPI) { if (wr == 1) PG8_BAR; }
    }
    PG8_WAIT_V(0);
    if constexpr (!ALIGN_EPI) { if (wr == 0) PG8_BAR; }
    PG8_BAR;
    if constexpr (Epi::AFTER_DRAIN) { E.fused(acc, cur, wr, wc, fr, fq, lds, wid, lane); S.done(cur); }
#undef PG8_SA
#undef PG8_SB
#undef PG8_STAGE
#undef PG8_LDA
#undef PG8_LDB
#undef PG8_MMA
#undef PG8_WAIT_V
#undef PG8_WAIT_L
#undef PG8_BAR
#undef PG8_SCHED
}
}

#define LAS __attribute__((address_space(3)))
typedef unsigned short bf16;
typedef unsigned u32x4 __attribute__((ext_vector_type(4)));
typedef unsigned u32x2 __attribute__((ext_vector_type(2)));
typedef float f32x4 __attribute__((ext_vector_type(4)));
typedef short bf16x8 __attribute__((ext_vector_type(8)));
constexpr int D = 1024, SEQ = 8192, NB = 2, NMETA = 16, TT = SEQ + NMETA, M = NB * SEQ, DEPTH = 4, DIN = 1536, FF = 4096, DH = 512;
constexpr float EPS = 1e-6f;
constexpr size_t MiB = 1u << 20;
constexpr size_t WS_CTL = 0;
constexpr size_t WS_POOLW = 1 * MiB, WS_GR = WS_POOLW + 512 * 1024, WS_GI = WS_GR + 256 * 1024;
constexpr size_t WS_SP = 2 * MiB, WS_HMETA = WS_SP + 64 * 1024, WS_MIDMETA = WS_HMETA + 64 * 1024;
constexpr size_t WS_SS = 3 * MiB, WS_CARA = 4 * MiB, WS_CARH = WS_CARA + 512 * 1024;
constexpr size_t WS_W = 8 * MiB, W_LAYER = 21 * MiB, W_IN = 0, W_OUT = 3 * MiB, W_UP = 5 * MiB, W_DOWN = 13 * MiB;
constexpr size_t WS_HB = 92 * MiB, WS_MID = 124 * MiB;
constexpr size_t WS_PROJ = WS_MID, WS_Y = WS_MID + 48 * MiB + 256 * 1024, WS_HL = WS_Y + 32 * MiB + 256 * 1024, WS_P = WS_HL + 32 * MiB + 256 * 1024, WS_END = 256 * MiB;
static_assert(WS_PROJ + (size_t)NB * TT * DIN * 2 <= WS_Y && WS_Y + (size_t)NB * TT * D * 2 <= WS_HL && WS_HL + (size_t)NB * TT * DH * 2 <= WS_P && WS_P + (size_t)NB * TT * DH * 2 <= WS_END, "ws map");
static_assert(WS_W + DEPTH * W_LAYER <= WS_HB && WS_HB + (size_t)M * D * 2 <= WS_MID && WS_MID + (size_t)M * FF * 2 <= WS_END, "ws map 2");
constexpr int LDS_HL = 0, LDS_P = 65536, LDS_CST = 131072, LDS_CARR = 147456, LDS_RED1 = 149504, LDS_RED2 = 152064;
constexpr int LDS_XST = 163840 - 64;
constexpr int LDS_BYTES = 163840;
constexpr size_t WS_FLAG = 64 * 1024;

struct Params {
    const float* in[20];
    float* out;
    unsigned char* ws;
};

__device__ __forceinline__ Params launder(const Params& p) {
    Params q = p;
#pragma unroll
    for (int i = 0; i < 20; ++i) { const __attribute__((address_space(1))) float* g = (const __attribute__((address_space(1))) float*)q.in[i]; asm volatile("" : "+s"(g)); q.in[i] = (const float*)g; }
    { __attribute__((address_space(1))) float* g = (__attribute__((address_space(1))) float*)q.out; asm volatile("" : "+s"(g)); q.out = (float*)g; }
    { __attribute__((address_space(1))) unsigned char* g = (__attribute__((address_space(1))) unsigned char*)q.ws; asm volatile("" : "+s"(g)); q.ws = (unsigned char*)g; }
    return q;
}
__device__ __forceinline__ unsigned cvt_pk(float lo, float hi) { return pg8::cvt_pk_bf16(lo, hi); }
__device__ __forceinline__ float bf_lo(unsigned w) { return __builtin_bit_cast(float, w << 16); }
__device__ __forceinline__ float bf_hi(unsigned w) { return __builtin_bit_cast(float, w & 0xffff0000u); }
__device__ __forceinline__ void unpack8(const u32x4 w, float (&f)[8]) {
    f[0] = bf_lo(w.x); f[1] = bf_hi(w.x); f[2] = bf_lo(w.y); f[3] = bf_hi(w.y); f[4] = bf_lo(w.z); f[5] = bf_hi(w.z); f[6] = bf_lo(w.w); f[7] = bf_hi(w.w);
}
__device__ __forceinline__ u32x4 pack8(const float (&f)[8]) { u32x4 w; w.x = cvt_pk(f[0], f[1]); w.y = cvt_pk(f[2], f[3]); w.z = cvt_pk(f[4], f[5]); w.w = cvt_pk(f[6], f[7]); return w; }
__device__ __forceinline__ float wave_sum(float v) {
#pragma unroll
    for (int o = 1; o < 64; o <<= 1) v += __shfl_xor(v, o);
    return v;
}
template <int CTRL> __device__ __forceinline__ float dppf(float old, float src) {
    return __builtin_bit_cast(float, __builtin_amdgcn_update_dpp(__builtin_bit_cast(int, old), __builtin_bit_cast(int, src), CTRL, 0xf, 0xf, false));
}
template <int DD> __device__ __forceinline__ float shiftd(float cur, float prev) {
    const float t = dppf<0x100 + (16 - DD)>(0.f, prev);
    return dppf<0x110 + DD>(t, cur);
}
__device__ __forceinline__ float sigm(float v) { return __builtin_amdgcn_rcpf(1.0f + __expf(-v)); }
__device__ __forceinline__ int outchan(int n, int rho) { return 32 * (n >> 1) + 8 * (rho >> 2) + 4 * (n & 1) + (rho & 3); }

__device__ __forceinline__ float row_rstd(const float* ss, int r) {
    const f32x4* s4 = (const f32x4*)(ss + (size_t)r * 16);
    const f32x4 a = s4[0], b = s4[1], c = s4[2], d = s4[3];
    const float s = ((a.x + a.y) + (a.z + a.w)) + ((b.x + b.y) + (b.z + b.w)) + ((c.x + c.y) + (c.z + c.w)) + ((d.x + d.y) + (d.z + d.w));
    return 1.0f / sqrtf(s * (1.0f / D) + EPS);
}
__device__ __forceinline__ void rows_rstd(const float* ss, int rowbase  , int fr, float (&rs)[2][4]) {
    const int lane = threadIdx.x & 63;
    const float r0 = row_rstd(ss, rowbase + lane), r1 = row_rstd(ss, rowbase + 128 + lane);
#pragma unroll
    for (int m = 0; m < 4; ++m) { rs[0][m] = __shfl(r0, m * 16 + fr); rs[1][m] = __shfl(r1, m * 16 + fr); }
}
struct EpiIn {
    static constexpr bool PERM = true, AFTER_DRAIN = false, PRELOAD = false;
    bf16* P; const float* ss; const LAS float* rl; int pmc;
    __device__ __forceinline__ void operator()(const f32x4 (&acc)[2][2][4][2], const pg8::Unit& u, int wr, int wc, int fr, int fq) const {
        const int row0 = u.pm * 256 + wr * 64 + fr, col0 = u.pn * 256 + wc * 32 + 8 * fq;
        float rsv[2][4];
        if (u.pm == pmc) {
#pragma unroll
            for (int ai = 0; ai < 2; ++ai)
#pragma unroll
                for (int m = 0; m < 4; ++m) rsv[ai][m] = rl[ai * 128 + wr * 64 + m * 16 + fr];
        } else {
#pragma unroll
            for (int ai = 0; ai < 2; ++ai)
#pragma unroll
                for (int m = 0; m < 4; ++m) { rsv[ai][m] = row_rstd(ss, row0 + ai * 128 + m * 16); asm volatile("" ::: "memory"); }
        }
#pragma unroll
        for (int ai = 0; ai < 2; ++ai)
#pragma unroll
            for (int m = 0; m < 4; ++m) {
                const int r = row0 + ai * 128 + m * 16; const float rs = rsv[ai][m];
                bf16* rowp = P + (size_t)(r + NMETA * (1 + (r >> 13))) * DIN + col0;
#pragma unroll
                for (int bj = 0; bj < 2; ++bj) { const f32x4 v0 = acc[ai][bj][m][0] * rs, v1 = acc[ai][bj][m][1] * rs;
                    u32x4 w; w.x = cvt_pk(v0[0], v0[1]); w.y = cvt_pk(v0[2], v0[3]); w.z = cvt_pk(v1[0], v1[1]); w.w = cvt_pk(v1[2], v1[3]);
                    *(u32x4*)(rowp + bj * 128) = w; }
            }
    }
};
struct EpiUp {
    static constexpr bool PERM = true, AFTER_DRAIN = false, PRELOAD = false;
    bf16* O; const float* ss; const LAS float* rl; int pmc;
    __device__ __forceinline__ void operator()(const f32x4 (&acc)[2][2][4][2], const pg8::Unit& u, int wr, int wc, int fr, int fq) const {
        const int row0 = u.pm * 256 + wr * 64 + fr, col0 = u.pn * 256 + wc * 32 + 8 * fq;
        float rsv[2][4];
        if (u.pm == pmc) {
#pragma unroll
            for (int ai = 0; ai < 2; ++ai)
#pragma unroll
                for (int m = 0; m < 4; ++m) rsv[ai][m] = rl[ai * 128 + wr * 64 + m * 16 + fr];
        } else {
#pragma unroll
            for (int ai = 0; ai < 2; ++ai)
#pragma unroll
                for (int m = 0; m < 4; ++m) { rsv[ai][m] = row_rstd(ss, row0 + ai * 128 + m * 16); asm volatile("" ::: "memory"); }
        }
#pragma unroll
        for (int ai = 0; ai < 2; ++ai)
#pragma unroll
            for (int m = 0; m < 4; ++m) {
                const int r = row0 + ai * 128 + m * 16; const float rs = rsv[ai][m];
                bf16* rowp = O + (size_t)r * FF + col0;
#pragma unroll
                for (int bj = 0; bj < 2; ++bj) { f32x4 v0 = acc[ai][bj][m][0] * rs, v1 = acc[ai][bj][m][1] * rs;
#pragma unroll
                    for (int j = 0; j < 4; ++j) { v0[j] = fmaxf(v0[j], 0.f); v0[j] *= v0[j]; v1[j] = fmaxf(v1[j], 0.f); v1[j] *= v1[j]; }
                    u32x4 w; w.x = cvt_pk(v0[0], v0[1]); w.y = cvt_pk(v0[2], v0[3]); w.z = cvt_pk(v1[0], v1[1]); w.w = cvt_pk(v1[2], v1[3]);
                    *(u32x4*)(rowp + bj * 128) = w; }
            }
    }
};
struct EpiRes {
    static constexpr bool PERM = true, AFTER_DRAIN = false, PRELOAD = true;
    bf16* hb; float* ssn;
    __device__ __forceinline__ void preload(f32x4 (&acc)[2][2][4][2], const pg8::Unit& u, int wr, int wc, int fr, int fq) const {
        const int row0 = u.pm * 256 + wr * 64 + fr, col0 = u.pn * 256 + wc * 32 + 8 * fq;
#pragma unroll
        for (int ai = 0; ai < 2; ++ai)
#pragma unroll
            for (int m = 0; m < 4; ++m) { const size_t off = (size_t)(row0 + ai * 128 + m * 16) * D + col0;
#pragma unroll
                for (int bj = 0; bj < 2; ++bj) { const u32x4 w = *(const u32x4*)(hb + off + bj * 128);
                    acc[ai][bj][m][0] = (f32x4){bf_lo(w.x), bf_hi(w.x), bf_lo(w.y), bf_hi(w.y)}; acc[ai][bj][m][1] = (f32x4){bf_lo(w.z), bf_hi(w.z), bf_lo(w.w), bf_hi(w.w)}; } }
    }
    __device__ __forceinline__ void operator()(const f32x4 (&acc)[2][2][4][2], const pg8::Unit& u, int wr, int wc, int fr, int fq) const {
        const int row0 = u.pm * 256 + wr * 64 + fr, col0 = u.pn * 256 + wc * 32 + 8 * fq;
#pragma unroll
        for (int ai = 0; ai < 2; ++ai)
#pragma unroll
            for (int m = 0; m < 4; ++m) {
                const int r = row0 + ai * 128 + m * 16; const size_t off = (size_t)r * D + col0; float s = 0.f;
#pragma unroll
                for (int bj = 0; bj < 2; ++bj) {
                    const f32x4 o0 = acc[ai][bj][m][0], o1 = acc[ai][bj][m][1];
                    s += (o0[0] * o0[0] + o0[1] * o0[1]) + (o0[2] * o0[2] + o0[3] * o0[3]) + (o1[0] * o1[0] + o1[1] * o1[1]) + (o1[2] * o1[2] + o1[3] * o1[3]);
                    u32x4 w; w.x = cvt_pk(o0[0], o0[1]); w.y = cvt_pk(o0[2], o0[3]); w.z = cvt_pk(o1[0], o1[1]); w.w = cvt_pk(o1[2], o1[3]);
                    *(u32x4*)(hb + off + bj * 128) = w; }
                s += __shfl_xor(s, 16); s += __shfl_xor(s, 32);
                if (fq == 0) ssn[(size_t)r * 16 + u.pn * 4 + wc] = s;
            }
    }
};

struct TItem { const float* W; const float* gk; bf16* WT; int K, N, item; };
__device__ __forceinline__ void titem_load(const TItem& t, int lane, f32x4 (&v)[8], float (&gs)[8]) {
    const int nblk = t.N / 32, kb = t.item / nblk, nb = t.item % nblk, k0 = 64 * kb, n0 = 32 * nb, lr = lane >> 3, lc = (lane & 7) * 4;
#pragma unroll
    for (int i = 0; i < 8; ++i) { v[i] = *(const f32x4*)(t.W + (size_t)(k0 + 8 * i + lr) * t.N + n0 + lc); gs[i] = t.gk ? t.gk[k0 + 8 * i + lr] : 1.0f; }
}
__device__ __forceinline__ void titem_store(const TItem& t, int lane, const f32x4 (&v)[8], const float (&gs)[8], LAS float* scr) {
    const int nblk = t.N / 32, kb = t.item / nblk, nb = t.item % nblk, k0 = 64 * kb, n0 = 32 * nb, lr = lane >> 3, lc = (lane & 7) * 4;
#pragma unroll
    for (int i = 0; i < 8; ++i) { LAS float* d = scr + (8 * i + lr) * 33 + lc; d[0] = v[i].x * gs[i]; d[1] = v[i].y * gs[i]; d[2] = v[i].z * gs[i]; d[3] = v[i].w * gs[i]; }
    asm volatile("s_waitcnt lgkmcnt(0)" ::: "memory");
    const int c = lane & 7;
#pragma unroll
    for (int j = 0; j < 4; ++j) { const int n = (lane >> 3) + 8 * j; const LAS float* s = scr + (8 * c) * 33 + n;
        u32x4 o; o.x = cvt_pk(s[0 * 33], s[1 * 33]); o.y = cvt_pk(s[2 * 33], s[3 * 33]); o.z = cvt_pk(s[4 * 33], s[5 * 33]); o.w = cvt_pk(s[6 * 33], s[7 * 33]);
        *(u32x4*)(t.WT + (size_t)(n0 + n) * t.K + k0 + 8 * c) = o; }
    asm volatile("s_waitcnt lgkmcnt(0)" ::: "memory");
}
__device__ __forceinline__ TItem titem_decode(const Params& p, int it) {
    constexpr int I_IN = 16 * 48, I_OUT = 16 * 32, I_UP = 16 * 128, I_DN = 64 * 32, I_PW = 4 * 8, I_G = 8 * 2, I_L = I_IN + I_OUT + I_UP + I_DN + I_PW + 2 * I_G;
    const int l = it / I_L; int r = it % I_L; unsigned char* ws = p.ws; unsigned char* wl = ws + WS_W + (size_t)l * W_LAYER; TItem t;
    if (r < I_IN) { t = TItem{p.in[3] + (size_t)l * D * DIN, p.in[2] + l * D, (bf16*)(wl + W_IN), D, DIN, r}; return t; } r -= I_IN;
    if (r < I_OUT) { t = TItem{p.in[15] + (size_t)l * D * D, p.in[14] + l * D, (bf16*)(wl + W_OUT), D, D, r}; return t; } r -= I_OUT;
    if (r < I_UP) { t = TItem{p.in[17] + (size_t)l * D * FF, p.in[16] + l * D, (bf16*)(wl + W_UP), D, FF, r}; return t; } r -= I_UP;
    if (r < I_DN) { t = TItem{p.in[18] + (size_t)l * FF * D, nullptr, (bf16*)(wl + W_DOWN), FF, D, r}; return t; } r -= I_DN;
    if (r < I_PW) { const int g = r / 8; t = TItem{p.in[4] + (size_t)(l * 4 + g) * 16384, nullptr, (bf16*)(ws + WS_POOLW) + (size_t)(l * 4 + g) * 16384, 128, 128, r % 8}; return t; } r -= I_PW;
    if (r < I_G) { const int h = r / 2; t = TItem{p.in[9] + (size_t)(l * 8 + h) * 4096, nullptr, (bf16*)(ws + WS_GR) + (size_t)(l * 8 + h) * 4096, 64, 64, r % 2}; return t; } r -= I_G;
    { const int h = r / 2; t = TItem{p.in[11] + (size_t)(l * 8 + h) * 4096, nullptr, (bf16*)(ws + WS_GI) + (size_t)(l * 8 + h) * 4096, 64, 64, r % 2}; }
    return t;
}
__device__ __forceinline__ void prologue(const Params& p_, LAS unsigned char* lds, int G) {
    const Params p = launder(p_);
    int tid_ = threadIdx.x; asm volatile("" : "+v"(tid_));
    const int tid = tid_, lane = tid & 63, wid = __builtin_amdgcn_readfirstlane(tid >> 6);
    LAS float* scr = (LAS float*)(lds + wid * 16384);
    const int gw = blockIdx.x * 8 + wid, NGW = G * 8;
    constexpr int NITEMS = DEPTH * (16 * 48 + 16 * 32 + 16 * 128 + 64 * 32 + 4 * 8 + 2 * 8 * 2);
    unsigned char* ws = p.ws;
    if (gw < NITEMS) {
        TItem cur = titem_decode(p, gw); f32x4 v[8]; float gs[8]; titem_load(cur, lane, v, gs);
        for (int it = gw; it < NITEMS; it += NGW) {
            const bool more = it + NGW < NITEMS; TItem nxt = cur; f32x4 nv[8]; float ngs[8];
            if (more) { nxt = titem_decode(p, it + NGW); titem_load(nxt, lane, nv, ngs); }
            titem_store(cur, lane, v, gs, scr);
            if (more) { cur = nxt;
#pragma unroll
                for (int i = 0; i < 8; ++i) { v[i] = nv[i]; gs[i] = ngs[i]; } }
        }
    }
    const float* x = p.in[0]; bf16* hb = (bf16*)(ws + WS_HB); float* ss = (float*)(ws + WS_SS);
    for (int m2 = gw; m2 < M / 2; m2 += NGW) {
        f32x4 v[2][4]; float s[2] = {0.f, 0.f};
#pragma unroll
        for (int r = 0; r < 2; ++r) { const f32x4* xr = (const f32x4*)(x + (size_t)(2 * m2 + r) * D) + lane;
#pragma unroll
            for (int j = 0; j < 4; ++j) v[r][j] = xr[64 * j]; }
#pragma unroll
        for (int r = 0; r < 2; ++r) {
#pragma unroll
            for (int j = 0; j < 4; ++j) s[r] += (v[r][j].x * v[r][j].x + v[r][j].y * v[r][j].y) + (v[r][j].z * v[r][j].z + v[r][j].w * v[r][j].w);
            s[r] = wave_sum(s[r]);
            u32x2* o8 = (u32x2*)(hb + (size_t)(2 * m2 + r) * D) + lane;
#pragma unroll
            for (int j = 0; j < 4; ++j) { u32x2 w; w.x = cvt_pk(v[r][j].x, v[r][j].y); w.y = cvt_pk(v[r][j].z, v[r][j].w); o8[64 * j] = w; }
            if (lane < 16) ss[(size_t)(2 * m2 + r) * 16 + lane] = lane == 0 ? s[r] : 0.f;
        }
    }
    float* hm = (float*)(ws + WS_HMETA); float* sp = (float*)(ws + WS_SP);
    for (int i = blockIdx.x * 512 + tid; i < NMETA * D; i += G * 512) hm[i] = p.in[1][i];
    for (int i = blockIdx.x * 512 + tid; i < DEPTH * DH; i += G * 512) sp[i] = log1pf(expf(-p.in[13][i]));
}

template <int MODE> __device__ __forceinline__ void meta_tasks(const Params& p_, LAS unsigned char* lds, int G, const bf16* Ab, int lda, const bf16* Bt, int K, int ntasks) {
    const Params p = launder(p_);
    int tid_ = threadIdx.x; asm volatile("" : "+v"(tid_));
    const int tid = tid_, lane = tid & 63, wid = __builtin_amdgcn_readfirstlane(tid >> 6), fr = lane & 15, fq = lane >> 4;
    float* hm = (float*)(p.ws + WS_HMETA);
    LAS float* red = (LAS float*)lds;
    for (int task = G - 1 - (int)blockIdx.x; task < ntasks; task += G) {
        const int n0 = task * 16, kw = K / 8, k0 = wid * kw;
        f32x4 acc = {0.f, 0.f, 0.f, 0.f}; float ssq = 0.f;
        for (int kb = k0; kb < k0 + kw; kb += 128) {
            bf16x8 af[4], bfr[4]; f32x4 a0[4], a1[4];
#pragma unroll
            for (int i = 0; i < 4; ++i) { const int kk = kb + 32 * i;
                if (MODE == 1) af[i] = *(const bf16x8*)(Ab + (size_t)fr * lda + kk + 8 * fq);
                else { a0[i] = *(const f32x4*)(hm + fr * D + kk + 8 * fq); a1[i] = *(const f32x4*)(hm + fr * D + kk + 8 * fq + 4); }
                bfr[i] = *(const bf16x8*)(Bt + (size_t)(n0 + fr) * K + kk + 8 * fq); }
#pragma unroll
            for (int i = 0; i < 4; ++i) {
                if (MODE != 1) { ssq += (a0[i].x * a0[i].x + a0[i].y * a0[i].y) + (a0[i].z * a0[i].z + a0[i].w * a0[i].w) + (a1[i].x * a1[i].x + a1[i].y * a1[i].y) + (a1[i].z * a1[i].z + a1[i].w * a1[i].w);
                    u32x4 w; w.x = cvt_pk(a0[i].x, a0[i].y); w.y = cvt_pk(a0[i].z, a0[i].w); w.z = cvt_pk(a1[i].x, a1[i].y); w.w = cvt_pk(a1[i].z, a1[i].w); af[i] = __builtin_bit_cast(bf16x8, w); }
                acc = __builtin_amdgcn_mfma_f32_16x16x32_bf16(bfr[i], af[i], acc, 0, 0, 0); }
        }
        ssq += __shfl_xor(ssq, 16); ssq += __shfl_xor(ssq, 32);
        LAS float* rp = red + (wid * 64 + lane) * 5;
        rp[0] = acc[0]; rp[1] = acc[1]; rp[2] = acc[2]; rp[3] = acc[3]; rp[4] = ssq;
        __syncthreads();
        if (wid == 0) {
            float a0 = 0.f, a1 = 0.f, a2 = 0.f, a3 = 0.f, sq = 0.f;
#pragma unroll
            for (int w = 0; w < 8; ++w) { const LAS float* q = red + (w * 64 + lane) * 5; a0 += q[0]; a1 += q[1]; a2 += q[2]; a3 += q[3]; sq += q[4]; }
            const int col = n0 + 4 * fq;
            if (MODE == 1) { f32x4* hp = (f32x4*)(hm + fr * D + col); f32x4 h = *hp; h.x += a0; h.y += a1; h.z += a2; h.w += a3; *hp = h; }
            else {
                const float rs = 1.0f / sqrtf(sq * (1.0f / D) + EPS); a0 *= rs; a1 *= rs; a2 *= rs; a3 *= rs;
                if (MODE == 0) { u32x2 w; w.x = cvt_pk(a0, a1); w.y = cvt_pk(a2, a3); bf16* pr = (bf16*)(p.ws + WS_PROJ);
                    *(u32x2*)(pr + (size_t)fr * DIN + col) = w; *(u32x2*)(pr + (size_t)(TT + fr) * DIN + col) = w; }
                else { a0 = fmaxf(a0, 0.f); a1 = fmaxf(a1, 0.f); a2 = fmaxf(a2, 0.f); a3 = fmaxf(a3, 0.f);
                    u32x2 w; w.x = cvt_pk(a0 * a0, a1 * a1); w.y = cvt_pk(a2 * a2, a3 * a3); *(u32x2*)((bf16*)(p.ws + WS_MIDMETA) + (size_t)fr * FF + col) = w; }
            }
        }
        __syncthreads();
    }
}

__device__ __forceinline__ void m1_phase(const Params& p_, LAS unsigned char* lds, int G, int l) {
    const Params p = launder(p_);
    int tid_ = threadIdx.x; asm volatile("" : "+v"(tid_));
    const int tid = tid_, lane = tid & 63, wid = __builtin_amdgcn_readfirstlane(tid >> 6), fr = lane & 15, fq = lane >> 4;
    LAS float* cst = (LAS float*)lds;
    for (int i = tid; i < 8 * DH; i += 512) { const int row = i >> 9, ch = i & 511; float v;
        if (row < 4) v = p.in[7][(l * 4 + row) * DH + ch]; else if (row == 4) v = p.in[8][l * DH + ch]; else if (row == 5) v = p.in[10][l * DH + ch];
        else if (row == 6) v = p.in[12][l * DH + ch]; else v = ((const float*)(p.ws + WS_SP))[l * DH + ch];
        cst[i] = v; }
    const bf16* proj = (const bf16*)(p.ws + WS_PROJ);
    const bf16* Wr = (const bf16*)(p.ws + WS_GR) + (size_t)(l * 8 + wid) * 4096; const bf16* Wi = (const bf16*)(p.ws + WS_GI) + (size_t)(l * 8 + wid) * 4096;
    LAS bf16x8* wl = (LAS bf16x8*)(lds + 16384 + wid * 16384) + lane;
#pragma unroll
    for (int n = 0; n < 4; ++n)
#pragma unroll
        for (int ks = 0; ks < 2; ++ks) {
            wl[((n * 2 + ks) * 2 + 0) * 64] = *(const bf16x8*)(Wr + outchan(n, fr) * 64 + 32 * ks + 8 * fq);
            wl[((n * 2 + ks) * 2 + 1) * 64] = *(const bf16x8*)(Wi + outchan(n, fr) * 64 + 32 * ks + 8 * fq); }
    __syncthreads();
    bf16* hl = (bf16*)(p.ws + WS_HL); bf16* Pp = (bf16*)(p.ws + WS_P);
    float* carA = (float*)(p.ws + WS_CARA); float* carH = (float*)(p.ws + WS_CARH);
    for (int unit = blockIdx.x; unit < 256; unit += G) {
        const int b = unit >> 7, c = unit & 127, t0 = c ? NMETA + 64 * c : 0, NM = c ? 4 : 5;
        float Hc[16], Pc[16];
#pragma unroll
        for (int k = 0; k < 16; ++k) { Hc[k] = 0.f; Pc[k] = 1.f; }
        u32x4 raw[2][4];
#pragma unroll
        for (int ks = 0; ks < 2; ++ks)
#pragma unroll
            for (int d = 0; d < 4; ++d) { const int tt = t0 + fr - 3 + d; raw[ks][d] = (u32x4){0u, 0u, 0u, 0u};
                if (tt >= 0) raw[ks][d] = *(const u32x4*)(proj + ((size_t)b * TT + tt) * DIN + DH + wid * 64 + 32 * ks + 8 * fq); }
#pragma unroll 1
        for (int m = 0; m < NM; ++m) {
            const int t = t0 + 16 * m + fr; const size_t rowg = (size_t)b * TT + t;
            u32x4 nraw[2][4];
#pragma unroll
            for (int ks = 0; ks < 2; ++ks)
#pragma unroll
                for (int d = 0; d < 4; ++d) { nraw[ks][d] = (u32x4){0u, 0u, 0u, 0u};
                    if (m + 1 < NM) nraw[ks][d] = *(const u32x4*)(proj + ((size_t)b * TT + t + 13 + d) * DIN + DH + wid * 64 + 32 * ks + 8 * fq); }
            float xc[2][8]; bf16x8 frag[2];
#pragma unroll
            for (int ks = 0; ks < 2; ++ks) {
                const int chb = wid * 64 + 32 * ks + 8 * fq;
                { const f32x4 c0 = *(const LAS f32x4*)(cst + 4 * DH + chb), c1 = *(const LAS f32x4*)(cst + 4 * DH + chb + 4);
                  xc[ks][0] = c0.x; xc[ks][1] = c0.y; xc[ks][2] = c0.z; xc[ks][3] = c0.w; xc[ks][4] = c1.x; xc[ks][5] = c1.y; xc[ks][6] = c1.z; xc[ks][7] = c1.w; }
#pragma unroll
                for (int d = 0; d < 4; ++d) {
                    float u[8]; unpack8(raw[ks][d], u);
                    const f32x4 w0 = *(const LAS f32x4*)(cst + d * DH + chb), w1 = *(const LAS f32x4*)(cst + d * DH + chb + 4);
                    xc[ks][0] += u[0] * w0.x; xc[ks][1] += u[1] * w0.y; xc[ks][2] += u[2] * w0.z; xc[ks][3] += u[3] * w0.w;
                    xc[ks][4] += u[4] * w1.x; xc[ks][5] += u[5] * w1.y; xc[ks][6] += u[6] * w1.z; xc[ks][7] += u[7] * w1.w;
                    raw[ks][d] = nraw[ks][d];
                }
                frag[ks] = __builtin_bit_cast(bf16x8, pack8(xc[ks]));
            }
            f32x4 ar[4], ai[4];
#pragma unroll
            for (int n = 0; n < 4; ++n) { ar[n] = (f32x4){0.f, 0.f, 0.f, 0.f}; ai[n] = (f32x4){0.f, 0.f, 0.f, 0.f};
#pragma unroll
                for (int ks = 0; ks < 2; ++ks) {
                    const bf16x8 wr_ = wl[((n * 2 + ks) * 2 + 0) * 64], wi_ = wl[((n * 2 + ks) * 2 + 1) * 64];
                    ar[n] = __builtin_amdgcn_mfma_f32_16x16x32_bf16(wr_, frag[ks], ar[n], 0, 0, 0);
                    ai[n] = __builtin_amdgcn_mfma_f32_16x16x32_bf16(wi_, frag[ks], ai[n], 0, 0, 0);
                } }
            float Aa[16], Bb[16];
#pragma unroll
            for (int n = 0; n < 4; ++n) {
                const int cho = wid * 64 + 32 * (n >> 1) + 8 * fq + 4 * (n & 1);
                const f32x4 rb = *(const LAS f32x4*)(cst + 5 * DH + cho), ib = *(const LAS f32x4*)(cst + 6 * DH + cho), spv = *(const LAS f32x4*)(cst + 7 * DH + cho);
#pragma unroll
                for (int jj = 0; jj < 4; ++jj) {
                    const float r = sigm(ar[n][jj] + rb[jj]), ig = sigm(ai[n][jj] + ib[jj]);
                    const float la = -8.0f * r * spv[jj], a = __expf(la), x2 = 2.0f * la;
                    const float m2s = -x2 * (1.0f + x2 * (0.5f + x2 * (0.16666667f + x2 * 0.041666668f))), m2 = (x2 > -0.0625f) ? m2s : 1.0f - a * a;
                    Aa[n * 4 + jj] = a; Bb[n * 4 + jj] = __builtin_amdgcn_sqrtf(m2) * ig * xc[n >> 1][4 * (n & 1) + jj];
                }
            }
#pragma unroll
            for (int k = 0; k < 16; ++k) {
                float A = Aa[k], B = Bb[k], Ap, Bq;
                Ap = dppf<0x111>(1.f, A); Bq = dppf<0x111>(0.f, B); B = fmaf(A, Bq, B); A *= Ap;
                Ap = dppf<0x112>(1.f, A); Bq = dppf<0x112>(0.f, B); B = fmaf(A, Bq, B); A *= Ap;
                Ap = dppf<0x114>(1.f, A); Bq = dppf<0x114>(0.f, B); B = fmaf(A, Bq, B); A *= Ap;
                Ap = dppf<0x118>(1.f, A); Bq = dppf<0x118>(0.f, B); B = fmaf(A, Bq, B); A *= Ap;
                Bb[k] = fmaf(A, Hc[k], B); Aa[k] = A * Pc[k];
            }
#pragma unroll
            for (int ks = 0; ks < 2; ++ks) {
                const size_t o = rowg * DH + wid * 64 + 32 * ks + 8 * fq;
                { u32x4 wh; wh.x = cvt_pk(Bb[8 * ks + 0], Bb[8 * ks + 1]); wh.y = cvt_pk(Bb[8 * ks + 2], Bb[8 * ks + 3]); wh.z = cvt_pk(Bb[8 * ks + 4], Bb[8 * ks + 5]); wh.w = cvt_pk(Bb[8 * ks + 6], Bb[8 * ks + 7]);
                  *(u32x4*)(hl + o) = wh; }
                u32x4 w; w.x = cvt_pk(Aa[8 * ks + 0], Aa[8 * ks + 1]); w.y = cvt_pk(Aa[8 * ks + 2], Aa[8 * ks + 3]); w.z = cvt_pk(Aa[8 * ks + 4], Aa[8 * ks + 5]); w.w = cvt_pk(Aa[8 * ks + 6], Aa[8 * ks + 7]);
                *(u32x4*)(Pp + o) = w;
            }
            const int src = (lane & 48) | 15;
#pragma unroll
            for (int k = 0; k < 16; ++k) { Hc[k] = __shfl(Bb[k], src); Pc[k] = __shfl(Aa[k], src); }
        }
        if (fr == 0) {
#pragma unroll
            for (int ks = 0; ks < 2; ++ks) {
                const size_t o = (size_t)(b * 128 + c) * DH + wid * 64 + 32 * ks + 8 * fq;
                *(f32x4*)(carA + o) = (f32x4){Pc[8 * ks + 0], Pc[8 * ks + 1], Pc[8 * ks + 2], Pc[8 * ks + 3]}; *(f32x4*)(carA + o + 4) = (f32x4){Pc[8 * ks + 4], Pc[8 * ks + 5], Pc[8 * ks + 6], Pc[8 * ks + 7]};
                *(f32x4*)(carH + o) = (f32x4){Hc[8 * ks + 0], Hc[8 * ks + 1], Hc[8 * ks + 2], Hc[8 * ks + 3]}; *(f32x4*)(carH + o + 4) = (f32x4){Hc[8 * ks + 4], Hc[8 * ks + 5], Hc[8 * ks + 6], Hc[8 * ks + 7]};
            }
        }
    }
    __syncthreads();
}


template <int NMR, bool FROM_LDS> __device__ __forceinline__ void m2_rnn_round(LAS unsigned char* lds, const bf16* hl, const bf16* Pp, const bf16* proj, bf16* Y, LAS float* red1, const float (&cr)[16], int b, int t0, int mbase, int wid, int fr, int fq) {
    u32x4 hw[NMR][2], pw[NMR][2], gw[NMR][2];
#pragma unroll
    for (int m = 0; m < NMR; ++m)
#pragma unroll
        for (int ks = 0; ks < 2; ++ks) { const size_t rowg = (size_t)b * TT + t0 + 16 * (mbase + m) + fr; const int ch = wid * 64 + 32 * ks + 8 * fq; const size_t o = rowg * DH + ch;
            if (FROM_LDS) { const int lane = (int)(threadIdx.x & 63); hw[m][ks] = *(const LAS u32x4*)(lds + LDS_HL + wid * 8192 + (((mbase + m) * 2 + ks) * 64 + lane) * 16); pw[m][ks] = *(const LAS u32x4*)(lds + LDS_P + wid * 8192 + (((mbase + m) * 2 + ks) * 64 + lane) * 16); }
            else { hw[m][ks] = *(const u32x4*)(hl + o); pw[m][ks] = *(const u32x4*)(Pp + o); } gw[m][ks] = *(const u32x4*)(proj + rowg * DIN + 2 * DH + ch); }
    float y[NMR][16];
#pragma unroll
    for (int m = 0; m < NMR; ++m) { float s = 0.f;
#pragma unroll
        for (int ks = 0; ks < 2; ++ks) { float pf[8], gt[8]; unpack8(pw[m][ks], pf); unpack8(gw[m][ks], gt);
            float hh[8]; unpack8(hw[m][ks], hh);
#pragma unroll
            for (int e = 0; e < 8; ++e) { const float hv = fmaf(pf[e], cr[8 * ks + e], hh[e]), x = gt[e];
                const float ge = x * __builtin_amdgcn_rcpf(1.0f + __expf(-1.5957691216f * (x + 0.044715f * x * x * x)));
                const float yy = hv * ge; y[m][8 * ks + e] = yy; s = fmaf(yy, yy, s); } }
        s += __shfl_xor(s, 16); s += __shfl_xor(s, 32);
        if (fq == 0) red1[(16 * (mbase + m) + fr) * 8 + wid] = s; }
    __syncthreads();
#pragma unroll
    for (int m = 0; m < NMR; ++m) { const size_t rowg = (size_t)b * TT + t0 + 16 * (mbase + m) + fr;
        const f32x4 r0 = *(const LAS f32x4*)(red1 + (16 * (mbase + m) + fr) * 8), r1 = *(const LAS f32x4*)(red1 + (16 * (mbase + m) + fr) * 8 + 4);
        const float rs = __builtin_amdgcn_rsqf((((r0.x + r0.y) + (r0.z + r0.w)) + ((r1.x + r1.y) + (r1.z + r1.w))) * (1.0f / DH) + EPS);
#pragma unroll
        for (int ks = 0; ks < 2; ++ks) { float yy[8];
#pragma unroll
            for (int e = 0; e < 8; ++e) yy[e] = y[m][8 * ks + e] * rs;
            *(u32x4*)(Y + rowg * D + DH + wid * 64 + 32 * ks + 8 * fq) = pack8(yy); } }
}


template <int NMR> __device__ __forceinline__ void m2_pool_round(const bf16* proj, bf16* Y, const bf16* Wp, const float* pbias, const float* pscale, LAS float* red2,
                                                                  int b, int t0, int mbase, int g, int half, int kwin, int wid, int fr, int fq) {
    const int tb = t0 + 16 * mbase;
    bf16x8 pfr[NMR][4];
#pragma unroll
    for (int ks = 0; ks < 4; ++ks) {
        const int chb = g * 128 + 32 * ks + 8 * fq;
        float pu[8], p2[8], p4[8], p8[8];
        if (tb) { const u32x4 raw = *(const u32x4*)(proj + ((size_t)b * TT + tb - 16 + fr) * DIN + chb); unpack8(raw, pu);
#pragma unroll
            for (int e = 0; e < 8; ++e) { p2[e] = pu[e] + dppf<0x111>(0.f, pu[e]); p4[e] = p2[e] + dppf<0x112>(0.f, p2[e]); p8[e] = p4[e] + dppf<0x114>(0.f, p4[e]); } }
        else {
#pragma unroll
            for (int e = 0; e < 8; ++e) { pu[e] = 0.f; p2[e] = 0.f; p4[e] = 0.f; p8[e] = 0.f; } }
#pragma unroll
        for (int m = 0; m < NMR; ++m) {
            const int t = tb + 16 * m + fr; const size_t rowg = (size_t)b * TT + t;
            const u32x4 raw = *(const u32x4*)(proj + rowg * DIN + chb); float u[8], po[8]; unpack8(raw, u);
            const int cnt = (t + 1 < kwin) ? t + 1 : kwin; const float rc = __builtin_amdgcn_rcpf((float)cnt);
#pragma unroll
            for (int e = 0; e < 8; ++e) {
                const float s2 = u[e] + shiftd<1>(u[e], pu[e]), s4 = s2 + shiftd<2>(s2, p2[e]), s8 = s4 + shiftd<4>(s4, p4[e]), s16 = s8 + shiftd<8>(s8, p8[e]);
                const float win = g == 0 ? s2 : (g == 1 ? s4 : (g == 2 ? s8 : s16));
                po[e] = fmaf(win, rc, -u[e]); pu[e] = u[e]; p2[e] = s2; p4[e] = s4; p8[e] = s8;
            }
            pfr[m][ks] = __builtin_bit_cast(bf16x8, pack8(po));
        }
    }
    bf16x8 wfr[4][4];
#pragma unroll
    for (int n = 0; n < 4; ++n)
#pragma unroll
        for (int ks = 0; ks < 4; ++ks) wfr[n][ks] = *(const bf16x8*)(Wp + (size_t)(64 * half + outchan(n, fr)) * 128 + 32 * ks + 8 * fq);
#pragma unroll 1
    for (int pass = 0; pass < 2; ++pass) {
#pragma unroll
        for (int m = 0; m < NMR; ++m) {
            const int t = tb + 16 * m + fr; const size_t rowg = (size_t)b * TT + t; float s = 0.f, rs = 0.f;
            if (pass) { const f32x4 r0 = *(const LAS f32x4*)(red2 + (16 * (mbase + m) + fr) * 8), r1 = *(const LAS f32x4*)(red2 + (16 * (mbase + m) + fr) * 8 + 4);
                rs = __builtin_amdgcn_rsqf((((r0.x + r0.y) + (r0.z + r0.w)) + ((r1.x + r1.y) + (r1.z + r1.w))) * (1.0f / DH) + EPS); }
#pragma unroll
            for (int np = 0; np < 2; ++np) {
                f32x4 o2[2];
#pragma unroll
                for (int nn = 0; nn < 2; ++nn) { const int n = 2 * np + nn;
                    f32x4 acc = {0.f, 0.f, 0.f, 0.f};
#pragma unroll
                    for (int ks = 0; ks < 4; ++ks) acc = __builtin_amdgcn_mfma_f32_16x16x32_bf16(wfr[n][ks], pfr[m][ks], acc, 0, 0, 0);
                    const int col = g * 128 + 64 * half + 32 * np + 8 * fq + 4 * nn;
                    const f32x4 pb = *(const f32x4*)(pbias + col), ps = *(const f32x4*)(pscale + col);
                    acc = (acc + pb) * ps; s += (acc.x * acc.x + acc.y * acc.y) + (acc.z * acc.z + acc.w * acc.w); o2[nn] = acc * rs; }
                if (pass) { u32x4 w; w.x = cvt_pk(o2[0].x, o2[0].y); w.y = cvt_pk(o2[0].z, o2[0].w); w.z = cvt_pk(o2[1].x, o2[1].y); w.w = cvt_pk(o2[1].z, o2[1].w);
                    *(u32x4*)(Y + rowg * D + g * 128 + 64 * half + 32 * np + 8 * fq) = w; }
            }
            if (!pass) { s += __shfl_xor(s, 16); s += __shfl_xor(s, 32); if (fq == 0) red2[(16 * (mbase + m) + fr) * 8 + wid] = s; }
        }
        if (!pass) __syncthreads();
    }
}

__device__ __forceinline__ void m2_phase(const Params& p_, LAS unsigned char* lds, int G, int l) {
    const Params p = launder(p_);
    int tid_ = threadIdx.x; asm volatile("" : "+v"(tid_));
    const int tid = tid_, lane = tid & 63, wid = __builtin_amdgcn_readfirstlane(tid >> 6), fr = lane & 15, fq = lane >> 4;
    LAS float* segA = (LAS float*)lds; LAS float* segH = (LAS float*)(lds + 16384); LAS float* carr = (LAS float*)(lds + 32768);
    LAS float* red1 = (LAS float*)(lds + 34816); LAS float* red2 = (LAS float*)(lds + 37888);
    const bf16* proj = (const bf16*)(p.ws + WS_PROJ); bf16* Y = (bf16*)(p.ws + WS_Y);
    const bf16* hl = (const bf16*)(p.ws + WS_HL); const bf16* Pp = (const bf16*)(p.ws + WS_P);
    const float* carA = (const float*)(p.ws + WS_CARA); const float* carH = (const float*)(p.ws + WS_CARH);
    const int g = wid >> 1, half = wid & 1, kwin = 2 << g;
    const bf16* Wp = (const bf16*)(p.ws + WS_POOLW) + (size_t)(l * 4 + g) * 16384;
    const float* pbias = p.in[5] + l * DH; const float* pscale = p.in[6] + l * DH;
    for (int unit = blockIdx.x; unit < 256; unit += G) {
        const int b = unit >> 7, c = unit & 127, t0 = c ? NMETA + 64 * c : 0, NM = c ? 4 : 5;
        {
            const int q = (c + 7) >> 3, jlo = wid * q, jhi = (jlo + q < c) ? jlo + q : c;
            f32x4 A0 = {1.f, 1.f, 1.f, 1.f}, A1 = A0, H0 = {0.f, 0.f, 0.f, 0.f}, H1 = H0;
            for (int j = jlo; j < jhi; j += 8) {
                f32x4 a0[8], a1[8], h0[8], h1[8];
#pragma unroll
                for (int i = 0; i < 8; ++i) { const int jj = (j + i < jhi) ? j + i : jhi - 1; const size_t o = (size_t)(b * 128 + jj) * DH + 8 * lane;
                    a0[i] = *(const f32x4*)(carA + o); a1[i] = *(const f32x4*)(carA + o + 4); h0[i] = *(const f32x4*)(carH + o); h1[i] = *(const f32x4*)(carH + o + 4); }
#pragma unroll
                for (int i = 0; i < 8; ++i) if (j + i < jhi) { H0 = a0[i] * H0 + h0[i]; A0 = A0 * a0[i]; H1 = a1[i] * H1 + h1[i]; A1 = A1 * a1[i]; }
            }
            *(LAS f32x4*)(segA + wid * DH + 8 * lane) = A0; *(LAS f32x4*)(segA + wid * DH + 8 * lane + 4) = A1;
            *(LAS f32x4*)(segH + wid * DH + 8 * lane) = H0; *(LAS f32x4*)(segH + wid * DH + 8 * lane + 4) = H1;
        }
        __syncthreads();
        { float cy = 0.f;
#pragma unroll
          for (int s8 = 0; s8 < 8; ++s8) cy = segA[s8 * DH + tid] * cy + segH[s8 * DH + tid];
          carr[tid] = cy; }
        __syncthreads();
        {
            float cr[16];
#pragma unroll
            for (int ks = 0; ks < 2; ++ks) { const f32x4 c0 = *(const LAS f32x4*)(carr + wid * 64 + 32 * ks + 8 * fq), c1 = *(const LAS f32x4*)(carr + wid * 64 + 32 * ks + 8 * fq + 4);
                cr[8 * ks + 0] = c0.x; cr[8 * ks + 1] = c0.y; cr[8 * ks + 2] = c0.z; cr[8 * ks + 3] = c0.w; cr[8 * ks + 4] = c1.x; cr[8 * ks + 5] = c1.y; cr[8 * ks + 6] = c1.z; cr[8 * ks + 7] = c1.w; }
            m2_rnn_round<4, false>(lds, hl, Pp, proj, Y, red1, cr, b, t0, 0, wid, fr, fq);
            if (NM == 5) m2_rnn_round<1, false>(lds, hl, Pp, proj, Y, red1, cr, b, t0, 4, wid, fr, fq);
        }
        m2_pool_round<4>(proj, Y, Wp, pbias, pscale, red2, b, t0, 0, g, half, kwin, wid, fr, fq);
        if (NM == 5) m2_pool_round<1>(proj, Y, Wp, pbias, pscale, red2, b, t0, 4, g, half, kwin, wid, fr, fq);
    }
    __syncthreads();
}

__device__ __forceinline__ void final_norm(const Params& p_, int G) {
    const Params p = launder(p_);
    int tid_ = threadIdx.x; asm volatile("" : "+v"(tid_));
    const int tid = tid_, lane = tid & 63, wid = tid >> 6; const int gw = blockIdx.x * 8 + wid, NGW = G * 8;
    const bf16* hb = (const bf16*)(p.ws + WS_HB);
    const f32x4* gp = (const f32x4*)p.in[19] + 2 * lane; f32x4 gg[2][2];
#pragma unroll
    for (int j = 0; j < 2; ++j) { gg[j][0] = gp[128 * j]; gg[j][1] = gp[128 * j + 1]; }
    for (int m = gw; m < M; m += NGW) {
        const u32x4* xr = (const u32x4*)(hb + (size_t)m * D) + lane; float v[2][8]; float s = 0.f;
#pragma unroll
        for (int j = 0; j < 2; ++j) { unpack8(xr[64 * j], v[j]);
#pragma unroll
            for (int e = 0; e < 8; ++e) s = fmaf(v[j][e], v[j][e], s); }
        const float rs = 1.0f / sqrtf(wave_sum(s) * (1.0f / D) + EPS);
        f32x4* orow = (f32x4*)(p.out + (size_t)m * D) + 2 * lane;
#pragma unroll
        for (int j = 0; j < 2; ++j) {
            orow[128 * j] = (f32x4){v[j][0] * rs * gg[j][0].x, v[j][1] * rs * gg[j][0].y, v[j][2] * rs * gg[j][0].z, v[j][3] * rs * gg[j][0].w};
            orow[128 * j + 1] = (f32x4){v[j][4] * rs * gg[j][1].x, v[j][5] * rs * gg[j][1].y, v[j][6] * rs * gg[j][1].z, v[j][7] * rs * gg[j][1].w}; }
    }
}


__device__ __forceinline__ void mixer_phase(const Params& p_, LAS unsigned char* lds, int G, int l) {
    const Params p = launder(p_);
    int tid_ = threadIdx.x; asm volatile("" : "+v"(tid_));
    const int tid = tid_, lane = tid & 63, wid = __builtin_amdgcn_readfirstlane(tid >> 6), fr = lane & 15, fq = lane >> 4;
    LAS float* cst = (LAS float*)(lds + LDS_CST);
    const bf16* proj = (const bf16*)(p.ws + WS_PROJ);
    const bf16* Wr = (const bf16*)(p.ws + WS_GR) + (size_t)(l * 8 + wid) * 4096; const bf16* Wi = (const bf16*)(p.ws + WS_GI) + (size_t)(l * 8 + wid) * 4096;
    LAS float* segA = (LAS float*)(lds + LDS_CST); LAS float* segH = (LAS float*)(lds + LDS_CST + 8192); LAS float* carr = (LAS float*)(lds + LDS_CARR);
    LAS float* red1 = (LAS float*)(lds + LDS_RED1); LAS float* red2 = (LAS float*)(lds + LDS_RED2);
    bf16* Y = (bf16*)(p.ws + WS_Y);
    const int g = wid >> 1, half = wid & 1, kwin = 2 << g;
    const bf16* Wp = (const bf16*)(p.ws + WS_POOLW) + (size_t)(l * 4 + g) * 16384;
    const float* pbias = p.in[5] + l * DH; const float* pscale = p.in[6] + l * DH;
    unsigned* flags = (unsigned*)(p.ws + WS_FLAG);
    bf16* hl = (bf16*)(p.ws + WS_HL); bf16* Pp = (bf16*)(p.ws + WS_P);
    float* carA = (float*)(p.ws + WS_CARA); float* carH = (float*)(p.ws + WS_CARH);
    for (int unit = blockIdx.x; unit < 256; unit += G) {
        const int b = unit >> 7, c = unit & 127, t0 = c ? NMETA + 64 * c : 0, NM = c ? 4 : 5;
        __syncthreads();
        for (int i = tid; i < 8 * DH; i += 512) { const int row = i >> 9, ch = i & 511; float v;
            if (row < 4) v = p.in[7][(l * 4 + row) * DH + ch]; else if (row == 4) v = p.in[8][l * DH + ch]; else if (row == 5) v = p.in[10][l * DH + ch];
            else if (row == 6) v = p.in[12][l * DH + ch]; else v = ((const float*)(p.ws + WS_SP))[l * DH + ch];
            cst[i] = v; }
        __syncthreads();
        bf16x8 wfr[4][2][2];
#pragma unroll
        for (int n = 0; n < 4; ++n)
#pragma unroll
            for (int ks = 0; ks < 2; ++ks) { wfr[n][ks][0] = *(const bf16x8*)(Wr + outchan(n, fr) * 64 + 32 * ks + 8 * fq); wfr[n][ks][1] = *(const bf16x8*)(Wi + outchan(n, fr) * 64 + 32 * ks + 8 * fq); }
        float Hc[16], Pc[16];
#pragma unroll
        for (int k = 0; k < 16; ++k) { Hc[k] = 0.f; Pc[k] = 1.f; }
        u32x4 raw[2][4];
#pragma unroll
        for (int ks = 0; ks < 2; ++ks)
#pragma unroll
            for (int d = 0; d < 4; ++d) { const int tt = t0 + fr - 3 + d; raw[ks][d] = (u32x4){0u, 0u, 0u, 0u};
                if (tt >= 0) raw[ks][d] = *(const u32x4*)(proj + ((size_t)b * TT + tt) * DIN + DH + wid * 64 + 32 * ks + 8 * fq); }
#pragma unroll 1
        for (int m = 0; m < NM; ++m) {
            const int t = t0 + 16 * m + fr; const size_t rowg = (size_t)b * TT + t;
            u32x4 nraw[2][4];
#pragma unroll
            for (int ks = 0; ks < 2; ++ks)
#pragma unroll
                for (int d = 0; d < 4; ++d) { nraw[ks][d] = (u32x4){0u, 0u, 0u, 0u};
                    if (m + 1 < NM) nraw[ks][d] = *(const u32x4*)(proj + ((size_t)b * TT + t + 13 + d) * DIN + DH + wid * 64 + 32 * ks + 8 * fq); }
            float xc[2][8]; bf16x8 frag[2];
#pragma unroll
            for (int ks = 0; ks < 2; ++ks) {
                const int chb = wid * 64 + 32 * ks + 8 * fq;
                { const f32x4 c0 = *(const LAS f32x4*)(cst + 4 * DH + chb), c1 = *(const LAS f32x4*)(cst + 4 * DH + chb + 4);
                  xc[ks][0] = c0.x; xc[ks][1] = c0.y; xc[ks][2] = c0.z; xc[ks][3] = c0.w; xc[ks][4] = c1.x; xc[ks][5] = c1.y; xc[ks][6] = c1.z; xc[ks][7] = c1.w; }
#pragma unroll
                for (int d = 0; d < 4; ++d) {
                    float u[8]; unpack8(raw[ks][d], u);
                    const f32x4 w0 = *(const LAS f32x4*)(cst + d * DH + chb), w1 = *(const LAS f32x4*)(cst + d * DH + chb + 4);
                    xc[ks][0] += u[0] * w0.x; xc[ks][1] += u[1] * w0.y; xc[ks][2] += u[2] * w0.z; xc[ks][3] += u[3] * w0.w;
                    xc[ks][4] += u[4] * w1.x; xc[ks][5] += u[5] * w1.y; xc[ks][6] += u[6] * w1.z; xc[ks][7] += u[7] * w1.w;
                    raw[ks][d] = nraw[ks][d];
                }
                frag[ks] = __builtin_bit_cast(bf16x8, pack8(xc[ks]));
            }
            f32x4 ar[4], ai[4];
#pragma unroll
            for (int n = 0; n < 4; ++n) { ar[n] = (f32x4){0.f, 0.f, 0.f, 0.f}; ai[n] = (f32x4){0.f, 0.f, 0.f, 0.f};
#pragma unroll
                for (int ks = 0; ks < 2; ++ks) {
                    const bf16x8 wr_ = wfr[n][ks][0], wi_ = wfr[n][ks][1];
                    ar[n] = __builtin_amdgcn_mfma_f32_16x16x32_bf16(wr_, frag[ks], ar[n], 0, 0, 0);
                    ai[n] = __builtin_amdgcn_mfma_f32_16x16x32_bf16(wi_, frag[ks], ai[n], 0, 0, 0);
                } }
            float Aa[16], Bb[16];
#pragma unroll
            for (int n = 0; n < 4; ++n) {
                const int cho = wid * 64 + 32 * (n >> 1) + 8 * fq + 4 * (n & 1);
                const f32x4 rb = *(const LAS f32x4*)(cst + 5 * DH + cho), ib = *(const LAS f32x4*)(cst + 6 * DH + cho), spv = *(const LAS f32x4*)(cst + 7 * DH + cho);
#pragma unroll
                for (int jj = 0; jj < 4; ++jj) {
                    const float r = sigm(ar[n][jj] + rb[jj]), ig = sigm(ai[n][jj] + ib[jj]);
                    const float la = -8.0f * r * spv[jj], a = __expf(la), x2 = 2.0f * la;
                    const float m2s = -x2 * (1.0f + x2 * (0.5f + x2 * (0.16666667f + x2 * 0.041666668f))), m2 = (x2 > -0.0625f) ? m2s : 1.0f - a * a;
                    Aa[n * 4 + jj] = a; Bb[n * 4 + jj] = __builtin_amdgcn_sqrtf(m2) * ig * xc[n >> 1][4 * (n & 1) + jj];
                }
            }
#pragma unroll
            for (int k = 0; k < 16; ++k) {
                float A = Aa[k], B = Bb[k], Ap, Bq;
                Ap = dppf<0x111>(1.f, A); Bq = dppf<0x111>(0.f, B); B = fmaf(A, Bq, B); A *= Ap;
                Ap = dppf<0x112>(1.f, A); Bq = dppf<0x112>(0.f, B); B = fmaf(A, Bq, B); A *= Ap;
                Ap = dppf<0x114>(1.f, A); Bq = dppf<0x114>(0.f, B); B = fmaf(A, Bq, B); A *= Ap;
                Ap = dppf<0x118>(1.f, A); Bq = dppf<0x118>(0.f, B); B = fmaf(A, Bq, B); A *= Ap;
                Bb[k] = fmaf(A, Hc[k], B); Aa[k] = A * Pc[k];
            }
#pragma unroll
            for (int ks = 0; ks < 2; ++ks) {
                const size_t o = rowg * DH + wid * 64 + 32 * ks + 8 * fq;
                u32x4 wh; wh.x = cvt_pk(Bb[8 * ks + 0], Bb[8 * ks + 1]); wh.y = cvt_pk(Bb[8 * ks + 2], Bb[8 * ks + 3]); wh.z = cvt_pk(Bb[8 * ks + 4], Bb[8 * ks + 5]); wh.w = cvt_pk(Bb[8 * ks + 6], Bb[8 * ks + 7]);
                u32x4 w; w.x = cvt_pk(Aa[8 * ks + 0], Aa[8 * ks + 1]); w.y = cvt_pk(Aa[8 * ks + 2], Aa[8 * ks + 3]); w.z = cvt_pk(Aa[8 * ks + 4], Aa[8 * ks + 5]); w.w = cvt_pk(Aa[8 * ks + 6], Aa[8 * ks + 7]);
                if (m < 4) { *(LAS u32x4*)(lds + LDS_HL + wid * 8192 + ((m * 2 + ks) * 64 + lane) * 16) = wh; *(LAS u32x4*)(lds + LDS_P + wid * 8192 + ((m * 2 + ks) * 64 + lane) * 16) = w; }
                else { *(u32x4*)(hl + o) = wh; *(u32x4*)(Pp + o) = w; }
            }
            const int src = (lane & 48) | 15;
#pragma unroll
            for (int k = 0; k < 16; ++k) { Hc[k] = __shfl(Bb[k], src); Pc[k] = __shfl(Aa[k], src); }
        }
        if (fr == 0) {
#pragma unroll
            for (int ks = 0; ks < 2; ++ks) {
                const size_t o = (size_t)(b * 128 + c) * DH + wid * 64 + 32 * ks + 8 * fq;
                *(f32x4*)(carA + o) = (f32x4){Pc[8 * ks + 0], Pc[8 * ks + 1], Pc[8 * ks + 2], Pc[8 * ks + 3]}; *(f32x4*)(carA + o + 4) = (f32x4){Pc[8 * ks + 4], Pc[8 * ks + 5], Pc[8 * ks + 6], Pc[8 * ks + 7]};
                *(f32x4*)(carH + o) = (f32x4){Hc[8 * ks + 0], Hc[8 * ks + 1], Hc[8 * ks + 2], Hc[8 * ks + 3]}; *(f32x4*)(carH + o + 4) = (f32x4){Hc[8 * ks + 4], Hc[8 * ks + 5], Hc[8 * ks + 6], Hc[8 * ks + 7]};
            }
        }
        __threadfence();
        __syncthreads();
        if (tid == 0) __hip_atomic_store(flags + unit, (unsigned)(l + 1), __ATOMIC_RELAXED, __HIP_MEMORY_SCOPE_AGENT);
        m2_pool_round<4>(proj, Y, Wp, pbias, pscale, red2, b, t0, 0, g, half, kwin, wid, fr, fq);
        if (NM == 5) m2_pool_round<1>(proj, Y, Wp, pbias, pscale, red2, b, t0, 4, g, half, kwin, wid, fr, fq);
        if (tid < c) { unsigned sp = 0; while (__hip_atomic_load(flags + b * 128 + tid, __ATOMIC_RELAXED, __HIP_MEMORY_SCOPE_AGENT) < (unsigned)(l + 1)) { __builtin_amdgcn_s_sleep(2); if (++sp > (1u << 22)) break; } }
        __builtin_amdgcn_fence(__ATOMIC_ACQUIRE, "agent");
        __syncthreads();
        {
            const int q = (c + 3) >> 2, seg = tid >> 7, cgi = tid & 127, jlo = seg * q, jhi = (jlo + q < c) ? jlo + q : c;
            f32x4 A0 = {1.f, 1.f, 1.f, 1.f}, H0 = {0.f, 0.f, 0.f, 0.f};
            for (int j = jlo; j < jhi; j += 8) {
                f32x4 a0[8], h0[8];
#pragma unroll
                for (int i = 0; i < 8; ++i) { const int jj = (j + i < jhi) ? j + i : jhi - 1; const size_t o = (size_t)(b * 128 + jj) * DH + 4 * cgi; a0[i] = *(const f32x4*)(carA + o); h0[i] = *(const f32x4*)(carH + o); }
#pragma unroll
                for (int i = 0; i < 8; ++i) if (j + i < jhi) { H0 = a0[i] * H0 + h0[i]; A0 = A0 * a0[i]; }
            }
            *(LAS f32x4*)(segA + seg * DH + 4 * cgi) = A0; *(LAS f32x4*)(segH + seg * DH + 4 * cgi) = H0;
        }
        __syncthreads();
        { float cy = 0.f;
#pragma unroll
          for (int s4 = 0; s4 < 4; ++s4) cy = segA[s4 * DH + tid] * cy + segH[s4 * DH + tid];
          carr[tid] = cy; }
        __syncthreads();
        {
            float cr[16];
#pragma unroll
            for (int ks = 0; ks < 2; ++ks) { const f32x4 c0 = *(const LAS f32x4*)(carr + wid * 64 + 32 * ks + 8 * fq), c1 = *(const LAS f32x4*)(carr + wid * 64 + 32 * ks + 8 * fq + 4);
                cr[8 * ks + 0] = c0.x; cr[8 * ks + 1] = c0.y; cr[8 * ks + 2] = c0.z; cr[8 * ks + 3] = c0.w; cr[8 * ks + 4] = c1.x; cr[8 * ks + 5] = c1.y; cr[8 * ks + 6] = c1.z; cr[8 * ks + 7] = c1.w; }
            m2_rnn_round<4, true>(lds, hl, Pp, proj, Y, red1, cr, b, t0, 0, wid, fr, fq);
            if (NM == 5) m2_rnn_round<1, false>(lds, hl, Pp, proj, Y, red1, cr, b, t0, 4, wid, fr, fq);
        }
    }
    __syncthreads();
}

#define XB_TMO      128
#define XB_XCNT(j)  (256  + 64 * (j))
#define XB_XSUB(j)  (1280 + 64 * (j))
#define XB_XGEN(j)  (2304 + 64 * (j))
#define XB_TOP      3328
#define XB_TOPGEN   3392
#define XCD_BAR_WORDS 3456
#define XB_SPIN_CAP (1u << 18)

__device__ __forceinline__ unsigned xb_ld(unsigned* p)              { return __hip_atomic_load(p, __ATOMIC_RELAXED, __HIP_MEMORY_SCOPE_AGENT); }
__device__ __forceinline__ unsigned xb_add(unsigned* p, unsigned v) { return __hip_atomic_fetch_add(p, v, __ATOMIC_RELAXED, __HIP_MEMORY_SCOPE_AGENT); }
__device__ __forceinline__ unsigned xb_xcc_id() { return (unsigned)__builtin_amdgcn_s_getreg((3 << 11) | 20) & 0xFu; }
#define XB_SPIN(cond, bar) do { unsigned _sp = 0; while (cond) { __builtin_amdgcn_s_sleep(1); \
    if ((++_sp & 255u) == 0u) { if (xb_ld(&(bar)[XB_TMO])) break; if (_sp > XB_SPIN_CAP) { atomicAdd(&(bar)[XB_TMO], 1u); break; } } } } while (0)

struct XcdBarrier {
    unsigned* bar; unsigned x;
    volatile LAS unsigned* st;
};

__device__ __forceinline__ XcdBarrier xcd_barrier_post(unsigned* bar, volatile LAS unsigned* st) {
    XcdBarrier b; b.bar = bar; b.x = xb_xcc_id(); b.st = st;
    if (threadIdx.x == 0) (void)xb_add(&bar[XB_XCNT(b.x)], 1u);
    return b;
}
__device__ __forceinline__ void xcd_barrier_complete(unsigned* bar, unsigned x, unsigned& nloc, unsigned& nx) {
    const unsigned G = gridDim.x * gridDim.y * gridDim.z;
    unsigned sum, cnt, mine, sp = 0u;
    for (;;) {
        sum = 0u; cnt = 0u; mine = 0u;
#pragma unroll
        for (unsigned j = 0; j < 16; ++j) { const unsigned c = xb_ld(&bar[XB_XCNT(j)]); sum += c; cnt += (c > 0u) ? 1u : 0u; mine = (j == x) ? c : mine; }
        if (sum == G) break;
        __builtin_amdgcn_s_sleep(1);
        if ((++sp & 255u) == 0u) { if (xb_ld(&bar[XB_TMO])) break; if (sp > XB_SPIN_CAP) { atomicAdd(&bar[XB_TMO], 1u); break; } }
    }
    nloc = mine > 0u ? mine : 1u; nx = cnt > 0u ? cnt : 1u;
}

__device__ __forceinline__ void xcd_barrier(const XcdBarrier& b) {
    asm volatile("s_waitcnt vmcnt(0)" ::: "memory");
    __syncthreads();
    if (threadIdx.x == 0) {
        unsigned* bar = b.bar;
        __builtin_amdgcn_s_waitcnt(0);
        unsigned nloc = b.st[0], nx = b.st[1];
        if (nloc == 0u) { xcd_barrier_complete(bar, b.x, nloc, nx); b.st[0] = nloc; b.st[1] = nx; }
        const unsigned old = xb_add(&bar[XB_XSUB(b.x)], 1u);
        const unsigned gen = old / nloc;
        if (old + 1u == (gen + 1u) * nloc) {
            __builtin_amdgcn_fence(__ATOMIC_RELEASE, "agent");
            asm volatile("s_waitcnt vmcnt(0)" ::: "memory");
            const unsigned og = xb_add(&bar[XB_TOP], 1u);
            const unsigned tg = og / nx;
            if (og + 1u == (tg + 1u) * nx) xb_add(&bar[XB_TOPGEN], 1u);
            else XB_SPIN(xb_ld(&bar[XB_TOPGEN]) == tg, bar);
            __builtin_amdgcn_fence(__ATOMIC_ACQUIRE, "agent");
            xb_add(&bar[XB_XGEN(b.x)], 1u);
            asm volatile("s_waitcnt vmcnt(0)" ::: "memory");
        } else {
            XB_SPIN(xb_ld(&bar[XB_XGEN(b.x)]) == gen, bar);
            __builtin_amdgcn_fence(__ATOMIC_ACQUIRE, "agent");
            asm volatile("s_waitcnt vmcnt(0)" ::: "memory");
        }
    }
    __syncthreads();
}

#ifndef PROBE_SYNC2
#define PROBE_SYNC2 0
#endif
#ifndef PROBE_M1X2
#define PROBE_M1X2 0
#endif
#ifndef PROBE_M2X2
#define PROBE_M2X2 0
#endif
#define GSYNC() do { { __attribute__((address_space(1))) unsigned* gb_ = (__attribute__((address_space(1))) unsigned*)xbar.bar; asm volatile("" : "+s"(gb_)); xbar.bar = (unsigned*)gb_; asm volatile("" : "+s"(xbar.x)); } xcd_barrier(xbar); if (PROBE_SYNC2) xcd_barrier(xbar); } while (0)
__device__ __forceinline__ int rstd_cache(LAS unsigned char* lds, const float* ss, const pg8::StaticOrder& S) {
    pg8::Unit u0; int pmc = -1;
    int tid = threadIdx.x; asm volatile("" : "+v"(tid));
    if (S.next(0, u0)) { pmc = u0.pm; if (tid < 256) ((LAS float*)(lds + 131072))[tid] = row_rstd(ss, u0.pm * 256 + tid); }
    __syncthreads();
    return pmc;
}
#ifndef PROBE_PHASE
#define PROBE_PHASE (-1)
#endif
#define TIC() do { if (PROBE_PHASE >= 0) tic = __builtin_amdgcn_s_memrealtime(); } while (0)
#define TOC(k) do { if (PROBE_PHASE == (k)) tacc += __builtin_amdgcn_s_memrealtime() - tic; } while (0)
__global__ void __launch_bounds__(512, 2) fwd_megakernel(Params p) {
    extern __shared__ __attribute__((aligned(16))) unsigned char lds_raw[];
    LAS unsigned char* lds = (LAS unsigned char*)lds_raw;
    cg::grid_group grid = cg::this_grid();
    const int G = gridDim.x;
    unsigned long long tic = 0, tacc = 0;
    unsigned char* ws = p.ws;
    volatile LAS unsigned* xst = (volatile LAS unsigned*)(lds + LDS_XST);
    if (threadIdx.x < 2) xst[threadIdx.x] = 0u;
    __syncthreads();
    XcdBarrier xbar = xcd_barrier_post((unsigned*)(ws + WS_CTL), xst);
    bf16* hb = (bf16*)(ws + WS_HB); bf16* proj = (bf16*)(ws + WS_PROJ); bf16* Y = (bf16*)(ws + WS_Y); bf16* mid = (bf16*)(ws + WS_MID); float* ss = (float*)(ws + WS_SS);
    grid.sync();
    TIC();
#ifndef NO_PRO
    prologue(p, lds, G);
#endif
    GSYNC();
    TOC(0);
#pragma unroll 1
    for (int l = 0; l < DEPTH; ++l) {
        { __attribute__((address_space(1))) unsigned char* gws = (__attribute__((address_space(1))) unsigned char*)ws; asm volatile("" : "+s"(gws)); ws = (unsigned char*)gws; }
        const unsigned char* wl = ws + WS_W + (size_t)l * W_LAYER;
        const bf16* in_t = (const bf16*)(wl + W_IN); const bf16* out_t = (const bf16*)(wl + W_OUT); const bf16* up_t = (const bf16*)(wl + W_UP); const bf16* down_t = (const bf16*)(wl + W_DOWN);
        TIC();
#ifndef NO_GIN
        { pg8::Gemm g{hb, in_t, M, DIN, D, 0}; pg8::StaticOrder S; S.init(M, DIN, G, (int)blockIdx.x); const int pmc = rstd_cache(lds, ss, S); EpiIn E{proj, ss, (const LAS float*)(lds + 131072), pmc};
          pg8::gemm_phase<EpiIn, pg8::StaticOrder, true, true>(lds, g, S, E); }
#endif
#ifndef NO_META
        meta_tasks<0>(p, lds, G, nullptr, 0, in_t, D, DIN / 16);
#endif
        GSYNC();
        TOC(1); TIC();
#ifndef FUSED_MIXER
#define FUSED_MIXER 1
#endif
#if FUSED_MIXER
        mixer_phase(p, lds, G, l);
        GSYNC();
        TOC(2);
#else
        m1_phase(p, lds, G, l);
        GSYNC();
        TOC(2); TIC();
        m2_phase(p, lds, G, l);
        GSYNC();
#endif
        TOC(3); TIC();
#ifndef NO_GOUT
        { pg8::Gemm g{Y, out_t, M, D, D, NMETA}; pg8::StaticOrder S; S.init(M, D, G, (int)blockIdx.x); EpiRes E{hb, ss};
          pg8::gemm_phase<EpiRes, pg8::StaticOrder, false, true>(lds, g, S, E); }
#endif
#ifndef NO_META
        if (l < DEPTH - 1) meta_tasks<1>(p, lds, G, Y, D, out_t, D, D / 16);
#endif
        GSYNC();
        TOC(4); TIC();
#ifndef NO_GUP
        { pg8::Gemm g{hb, up_t, M, FF, D, 0}; pg8::StaticOrder S; S.init(M, FF, G, (int)blockIdx.x); const int pmc = rstd_cache(lds, ss, S); EpiUp E{mid, ss, (const LAS float*)(lds + 131072), pmc};
          pg8::gemm_phase<EpiUp, pg8::StaticOrder, true, true>(lds, g, S, E); }
#endif
#ifndef NO_META
        if (l < DEPTH - 1) meta_tasks<2>(p, lds, G, nullptr, 0, up_t, D, FF / 16);
#endif
        GSYNC();
        TOC(5); TIC();
#ifndef NO_GDN
        { pg8::Gemm g{mid, down_t, M, D, FF, 0}; pg8::StaticOrder S; S.init(M, D, G, (int)blockIdx.x); EpiRes E{hb, ss};
          pg8::gemm_phase<EpiRes, pg8::StaticOrder, false, true>(lds, g, S, E); }
#endif
#ifndef NO_META
        if (l < DEPTH - 1) meta_tasks<1>(p, lds, G, (const bf16*)(ws + WS_MIDMETA), FF, down_t, FF, D / 16);
#endif
        GSYNC();
        TOC(6);
    }
    TIC();
    final_norm(p, G);
    TOC(7);
    if (PROBE_PHASE >= 0 && blockIdx.x == 0 && threadIdx.x == 0) { const unsigned long long w0 = __builtin_amdgcn_s_memrealtime(); while (__builtin_amdgcn_s_memrealtime() - w0 < 4ull * tacc) __builtin_amdgcn_s_sleep(8); }
}

extern "C" void kernel_launch(void* const* d_in, const int* in_sizes, int n_in, void* d_out, int out_size, void* d_ws, size_t ws_size, hipStream_t stream) {
    static int grid = 0;
    if (grid == 0) {
        if (n_in != 20 || in_sizes[0] != M * D || out_size != M * D || ws_size < WS_END) { fprintf(stderr, "kernel_launch: unexpected shapes (n_in %d, in0 %d, out %d, ws %zu)\n", n_in, n_in > 0 ? in_sizes[0] : -1, out_size, ws_size); grid = -1; return; }
        int dev = 0, cus = 0, per_cu = 0;
        if (hipGetDevice(&dev) != hipSuccess || hipDeviceGetAttribute(&cus, hipDeviceAttributeMultiprocessorCount, dev) != hipSuccess) { grid = -1; return; }
        if (hipFuncSetAttribute((const void*)fwd_megakernel, hipFuncAttributeMaxDynamicSharedMemorySize, LDS_BYTES) != hipSuccess) { fprintf(stderr, "kernel_launch: hipFuncSetAttribute failed\n"); grid = -1; return; }
        if (hipOccupancyMaxActiveBlocksPerMultiprocessor(&per_cu, (const void*)fwd_megakernel, 512, LDS_BYTES) != hipSuccess || per_cu < 1) { fprintf(stderr, "kernel_launch: occupancy query gave %d\n", per_cu); (void)hipGetLastError(); grid = -1; return; }
        grid = cus * 1;
    }
    if (grid < 0) return;
    if (hipMemsetAsync((char*)d_ws + WS_CTL, 0, WS_FLAG + 256 * 4, stream) != hipSuccess) { fprintf(stderr, "kernel_launch: memset failed\n"); return; }
    Params p{};
    for (int i = 0; i < 20; ++i) p.in[i] = (const float*)d_in[i];
    p.out = (float*)d_out; p.ws = (unsigned char*)d_ws;
    void* args[] = {&p};
    hipError_t e = hipLaunchCooperativeKernel((const void*)fwd_megakernel, dim3(grid), dim3(512), args, LDS_BYTES, stream);
    if (e != hipSuccess) fprintf(stderr, "cooperative launch failed: %s (grid %d)\n", hipGetErrorString(e), grid);
}
```

```cpp
#include <hip/hip_runtime.h>
#include <hip/hip_cooperative_groups.h>
#include <cstdio>
#include <cstdint>
namespace cg = cooperative_groups;
namespace pg8 {
#define PG8_LAS __attribute__((address_space(3)))
typedef unsigned short bf16_t;
typedef short bf16x8 __attribute__((ext_vector_type(8)));
typedef float f32x4 __attribute__((ext_vector_type(4)));
typedef unsigned u32x4 __attribute__((ext_vector_type(4)));
constexpr int BM = 256, BK = 64, HALF = 128, HTB = HALF * BK * 2  , STAGE_BYTES = 8 * HTB, NXCD = 8, WGM = 8;

__host__ __device__ __forceinline__ int lds_byte(int r, int c) { const int st = (r >> 4) * 2 + (c >> 5), rr = r & 15, cc = c & 31, ob = rr * 64 + cc * 2; return st * 1024 + (ob ^ (((ob >> 9) & 1) << 5)); }
__host__ __device__ __forceinline__ void stage_rc(int b, int& R, int& C) { const int st = b / 1024, sb = b % 1024, swz = sb ^ (((sb >> 9) & 1) << 5); R = (st >> 1) * 16 + swz / 64; C = (st & 1) * 32 + (swz % 64) / 2; }
__host__ __device__ __forceinline__ int perm32(int rho) { const int n = rho >> 4, i = rho & 15; return 8 * (i >> 2) + 4 * n + (i & 3); }

struct Unit { int pm, pn; };
struct Gemm { const bf16_t* A; const bf16_t* Bt; int M, N, K, gap; };

struct StaticOrder {
    int nM, nN, nwg, G, c;
    __host__ __device__ void init(int M, int N, int G_, int c_) { nM = M / BM; nN = N / BM; nwg = nM * nN; G = G_; c = c_; }
    __host__ __device__ bool next(int i, Unit& u) const {
        const long L = (long)i * G + c; if (L >= nwg) return false;
        int wgid = (int)L; { const int q = nwg / NXCD, r = nwg % NXCD, xcd = wgid % NXCD, off = wgid / NXCD; wgid = (xcd < r ? xcd * (q + 1) : r * (q + 1) + (xcd - r) * q) + off; }
        const int nig = WGM * nN, gid = wgid / nig, fm = gid * WGM, gsz = (nM - fm) < WGM ? (nM - fm) : WGM;
        u.pm = fm + ((wgid % nig) % gsz); u.pn = (wgid % nig) / gsz; return true;
    }
    __device__ __forceinline__ void a_ready(const Unit&) const {}
    __device__ __forceinline__ void done(const Unit&) const {}
};
__device__ __forceinline__ unsigned cvt_pk_bf16(float lo, float hi) { unsigned r; asm volatile("v_cvt_pk_bf16_f32 %0, %1, %2" : "=v"(r) : "v"(lo), "v"(hi)); return r; }
template <class Epi, class Sched, bool ALIGN_EPI = false, bool SP2 = false>
__device__ __forceinline__ void gemm_phase(PG8_LAS unsigned char* lds, const Gemm g, const Sched& S, const Epi& E) {
    int tid_ = threadIdx.x; asm volatile("" : "+v"(tid_));
    const int tid = tid_, wid = __builtin_amdgcn_readfirstlane(tid >> 6), lane = tid & 63, wr = wid >> 2, wc = wid & 3, fr = lane & 15, fq = lane >> 4;
    const int K = g.K, nt = K / BK;
    unsigned voffA[2], voffB[2];
#pragma unroll
    for (int i = 0; i < 2; ++i) { int R, C; stage_rc(tid * 16 + i * 8192, R, C); const int Rb = Epi::PERM ? ((R & ~31) + perm32(R & 31)) : R;
        voffA[i] = (unsigned)(R * K + C) * 2u; voffB[i] = (unsigned)(Rb * K + C) * 2u; }
    const size_t kstep = (size_t)(BK * 2);
    const size_t hstep = (size_t)HALF * K * 2;
    const size_t tstep = 2 * hstep;
    const int agap = g.gap;
#define a_off(pm_) ((size_t)((pm_) * BM + agap * (1 + ((pm_) >> 5))) * (size_t)K * 2)
    const unsigned ldsw = (unsigned)wid * 1024u;
    const int aoff = lds_byte(wr * 64 + fr, fq * 8), boff = lds_byte(wc * 32 + fr, fq * 8);
#define PG8_SA(b, h) (((b) * 2 + (h)) * HTB)
#define PG8_SB(b, h) ((4 + (b) * 2 + (h)) * HTB)
#define PG8_STAGE(bufoff, gbase, voff) do { _Pragma("unroll") for (int _i = 0; _i < 2; ++_i) \
        __builtin_amdgcn_global_load_lds((const unsigned*)((const char*)(gbase) + (voff)[_i]), (PG8_LAS unsigned*)(lds + (bufoff) + ldsw + _i * 8192), 16, 0, 0); } while (0)
#define PG8_LDA(dst, b, h) do { _Pragma("unroll") for (int m = 0; m < 4; ++m) _Pragma("unroll") for (int k = 0; k < 2; ++k) dst[m][k] = *(const PG8_LAS bf16x8*)(lds + PG8_SA(b, h) + aoff + m * 2048 + k * 1024); } while (0)
#define PG8_LDB(dst, b, h) do { _Pragma("unroll") for (int n = 0; n < 2; ++n) _Pragma("unroll") for (int k = 0; k < 2; ++k) dst[n][k] = *(const PG8_LAS bf16x8*)(lds + PG8_SB(b, h) + boff + n * 2048 + k * 1024); } while (0)
#define PG8_MMA(ai, bj, At, Bt) do { __builtin_amdgcn_s_setprio(1); _Pragma("unroll") for (int m = 0; m < 4; ++m) _Pragma("unroll") for (int n = 0; n < 2; ++n) _Pragma("unroll") for (int k = 0; k < 2; ++k) \
        acc[ai][bj][m][n] = __builtin_amdgcn_mfma_f32_16x16x32_bf16(Bt[n][k], At[m][k], acc[ai][bj][m][n], 0, 0, 0); __builtin_amdgcn_s_setprio(0); } while (0)
#define PG8_WAIT_V(n) asm volatile("s_waitcnt vmcnt(" #n ")" ::: "memory")
#define PG8_WAIT_L(n) asm volatile("s_waitcnt lgkmcnt(" #n ")" ::: "memory")
#define PG8_BAR __builtin_amdgcn_s_barrier()
#define PG8_SCHED __builtin_amdgcn_sched_barrier(0)
    Unit cur, nxt; int ui = 0;
    if (!S.next(0, cur)) return;
    f32x4 acc[2][2][4][2];
#pragma unroll
    for (int a = 0; a < 2; ++a)
#pragma unroll
        for (int b = 0; b < 2; ++b)
#pragma unroll
            for (int m = 0; m < 4; ++m)
#pragma unroll
                for (int n = 0; n < 2; ++n) acc[a][b][m][n] = (f32x4){0.f, 0.f, 0.f, 0.f};
    if constexpr (Epi::PRELOAD) E.preload(acc, cur, wr, wc, fr, fq);
    bf16x8 At[4][2], B0[2][2], B1[2][2];
    const char* cA = (const char*)g.A + a_off(cur.pm); const char* cB = (const char*)g.Bt + (size_t)cur.pn * tstep;
    S.a_ready(cur);
    if constexpr (SP2) {
        PG8_STAGE(PG8_SB(0, 0), cB, voffB); PG8_STAGE(PG8_SB(0, 1), cB + hstep, voffB); PG8_STAGE(PG8_SA(0, 0), cA, voffA); PG8_STAGE(PG8_SA(0, 1), cA + hstep, voffA);
        if (wr == 1) PG8_BAR;
        PG8_WAIT_V(2); PG8_BAR;
        PG8_STAGE(PG8_SB(1, 0), cB + kstep, voffB); PG8_STAGE(PG8_SA(1, 0), cA + kstep, voffA); PG8_STAGE(PG8_SB(1, 1), cB + hstep + kstep, voffB);
        PG8_WAIT_V(6); PG8_BAR;
    } else {
        PG8_STAGE(PG8_SB(0, 0), cB, voffB); PG8_STAGE(PG8_SA(0, 0), cA, voffA); PG8_STAGE(PG8_SB(0, 1), cB + hstep, voffB); PG8_STAGE(PG8_SA(0, 1), cA + hstep, voffA);
        if (wr == 1) PG8_BAR;
        PG8_WAIT_V(4); PG8_BAR;
        PG8_STAGE(PG8_SB(1, 0), cB + kstep, voffB); PG8_STAGE(PG8_SA(1, 0), cA + kstep, voffA); PG8_STAGE(PG8_SB(1, 1), cB + hstep + kstep, voffB);
        PG8_WAIT_V(6); PG8_BAR;
    }
    for (;;) {
        const bool has_next = S.next(ui + 1, nxt);
        const char* nA = has_next ? (const char*)g.A + a_off(nxt.pm) : cA; const char* nB = has_next ? (const char*)g.Bt + (size_t)nxt.pn * tstep : cB;
        for (int t = 0; t < nt; t += 2) {
            const bool last = (t == nt - 2);
            const char* a1 = cA + (size_t)(t + 1) * kstep;
            const char* a2 = last ? nA : cA + (size_t)(t + 2) * kstep; const char* b2 = last ? nB : cB + (size_t)(t + 2) * kstep;
            const char* a3 = a2 + kstep; const char* b3 = b2 + kstep;
            if (last && has_next) S.a_ready(nxt);
            if constexpr (SP2) {
            PG8_LDB(B0, 0, 0); PG8_LDB(B1, 0, 1); PG8_SCHED; PG8_LDA(At, 0, 0); PG8_STAGE(PG8_SA(1, 1), a1 + hstep, voffA);
            PG8_WAIT_V(8); PG8_WAIT_L(0); PG8_BAR; PG8_MMA(0, 0, At, B0); PG8_MMA(0, 1, At, B1); PG8_BAR; PG8_SCHED;
            PG8_LDA(At, 0, 1); PG8_STAGE(PG8_SB(0, 0), b2, voffB); PG8_STAGE(PG8_SB(0, 1), b2 + hstep, voffB); PG8_STAGE(PG8_SA(0, 0), a2, voffA);
            PG8_WAIT_V(8); PG8_WAIT_L(0); PG8_BAR; PG8_MMA(1, 0, At, B0); PG8_MMA(1, 1, At, B1); PG8_BAR; PG8_SCHED;
            PG8_LDB(B0, 1, 0); PG8_LDB(B1, 1, 1); PG8_SCHED; PG8_LDA(At, 1, 0); PG8_STAGE(PG8_SA(0, 1), a2 + hstep, voffA);
            PG8_WAIT_V(8); PG8_WAIT_L(0); PG8_BAR; PG8_MMA(0, 0, At, B0); PG8_MMA(0, 1, At, B1); PG8_BAR; PG8_SCHED;
            PG8_LDA(At, 1, 1); PG8_STAGE(PG8_SB(1, 0), b3, voffB); PG8_STAGE(PG8_SB(1, 1), b3 + hstep, voffB); PG8_STAGE(PG8_SA(1, 0), a3, voffA);
            PG8_WAIT_V(8); PG8_WAIT_L(0); PG8_BAR; PG8_MMA(1, 0, At, B0); PG8_MMA(1, 1, At, B1); PG8_BAR; PG8_SCHED;
            } else {
            PG8_LDB(B0, 0, 0); PG8_SCHED; PG8_LDA(At, 0, 0); PG8_STAGE(PG8_SA(1, 1), a1 + hstep, voffA);
            PG8_WAIT_L(8); PG8_BAR; PG8_WAIT_L(0); PG8_MMA(0, 0, At, B0); PG8_BAR; PG8_SCHED;
            PG8_LDB(B1, 0, 1); PG8_STAGE(PG8_SB(0, 0), b2, voffB);
            PG8_BAR; PG8_WAIT_L(0); PG8_MMA(0, 1, At, B1); PG8_BAR;
            PG8_LDA(At, 0, 1); PG8_STAGE(PG8_SA(0, 0), a2, voffA);
            PG8_BAR; PG8_WAIT_L(0); PG8_MMA(1, 0, At, B0); PG8_BAR; PG8_SCHED;
            PG8_STAGE(PG8_SB(0, 1), b2 + hstep, voffB);
            PG8_WAIT_V(6); PG8_BAR; PG8_MMA(1, 1, At, B1); PG8_BAR;
            PG8_LDB(B0, 1, 0); PG8_SCHED; PG8_LDA(At, 1, 0); PG8_STAGE(PG8_SA(0, 1), a2 + hstep, voffA);
            PG8_WAIT_L(8); PG8_BAR; PG8_WAIT_L(0); PG8_MMA(0, 0, At, B0); PG8_BAR; PG8_SCHED;
            PG8_LDB(B1, 1, 1); PG8_STAGE(PG8_SB(1, 0), b3, voffB);
            PG8_BAR; PG8_WAIT_L(0); PG8_MMA(0, 1, At, B1); PG8_BAR;
            PG8_LDA(At, 1, 1); PG8_STAGE(PG8_SA(1, 0), a3, voffA);
            PG8_BAR; PG8_WAIT_L(0); PG8_MMA(1, 0, At, B0); PG8_BAR; PG8_SCHED;
            PG8_STAGE(PG8_SB(1, 1), b3 + hstep, voffB);
            PG8_WAIT_V(6); PG8_BAR; PG8_MMA(1, 1, At, B1); PG8_BAR;
            }
        }
        if constexpr (ALIGN_EPI) { if (wr == 0) PG8_BAR; }
        if constexpr (!Epi::AFTER_DRAIN) { E(acc, cur, wr, wc, fr, fq); S.done(cur); }
        if (!has_next) break;
#pragma unroll
        for (int a = 0; a < 2; ++a)
#pragma unroll
            for (int b = 0; b < 2; ++b)
#pragma unroll
                for (int m = 0; m < 4; ++m)
#pragma unroll
                    for (int n = 0; n < 2; ++n) acc[a][b][m][n] = (f32x4){0.f, 0.f, 0.f, 0.f};
        if constexpr (Epi::PRELOAD) { E.preload(acc, nxt, wr, wc, fr, fq); PG8_WAIT_V(0); }
        cur = nxt; cA = nA; cB = nB; ++ui;
        if constexpr (ALIGN_EPI) { if (wr == 1) PG8_BAR; }
    }
    PG8_WAIT_V(0);
    if constexpr (!ALIGN_EPI) { if (wr == 0) PG8_BAR; }
    PG8_BAR;
    if constexpr (Epi::AFTER_DRAIN) { E.fused(acc, cur, wr, wc, fr, fq, lds, wid, lane); S.done(cur); }
#undef PG8_SA
#undef PG8_SB
#undef PG8_STAGE
#undef PG8_LDA
#undef PG8_LDB
#undef PG8_MMA
#undef PG8_WAIT_V
#undef PG8_WAIT_L
#undef PG8_BAR
#undef PG8_SCHED
}
}

#define LAS __attribute__((address_space(3)))
typedef unsigned short bf16;
typedef unsigned u32x4 __attribute__((ext_vector_type(4)));
typedef unsigned u32x2 __attribute__((ext_vector_type(2)));
typedef float f32x4 __attribute__((ext_vector_type(4)));
typedef short bf16x8 __attribute__((ext_vector_type(8)));
constexpr int D = 1024, SEQ = 8192, NB = 2, NMETA = 16, TT = SEQ + NMETA, M = NB * SEQ, DEPTH = 4, DIN = 1536, FF = 4096, DH = 512;
constexpr float EPS = 1e-6f;
constexpr size_t MiB = 1u << 20;
constexpr size_t WS_CTL = 0;
constexpr size_t WS_POOLW = 1 * MiB, WS_GR = WS_POOLW + 512 * 1024, WS_GI = WS_GR + 256 * 1024;
constexpr size_t WS_SP = 2 * MiB, WS_HMETA = WS_SP + 64 * 1024, WS_MIDMETA = WS_HMETA + 64 * 1024;
constexpr size_t WS_SS = 3 * MiB, WS_CARA = 4 * MiB, WS_CARH = WS_CARA + 512 * 1024;
constexpr size_t WS_W = 8 * MiB, W_LAYER = 21 * MiB, W_IN = 0, W_OUT = 3 * MiB, W_UP = 5 * MiB, W_DOWN = 13 * MiB;
constexpr size_t WS_HB = 92 * MiB, WS_MID = 124 * MiB;
constexpr size_t WS_PROJ = WS_MID, WS_Y = WS_MID + 48 * MiB + 256 * 1024, WS_HL = WS_Y + 32 * MiB + 256 * 1024, WS_P = WS_HL + 32 * MiB + 256 * 1024, WS_END = 256 * MiB;
static_assert(WS_PROJ + (size_t)NB * TT * DIN * 2 <= WS_Y && WS_Y + (size_t)NB * TT * D * 2 <= WS_HL && WS_HL + (size_t)NB * TT * DH * 2 <= WS_P && WS_P + (size_t)NB * TT * DH * 2 <= WS_END, "ws map");
static_assert(WS_W + DEPTH * W_LAYER <= WS_HB && WS_HB + (size_t)M * D * 2 <= WS_MID && WS_MID + (size_t)M * FF * 2 <= WS_END, "ws map 2");
constexpr int LDS_HL = 0, LDS_P = 65536, LDS_CST = 131072, LDS_CARR = 147456, LDS_RED1 = 149504, LDS_RED2 = 152064, LDS_CARRY = 154624;
constexpr int LDS_XST = 163840 - 64;
constexpr int LDS_BYTES = 163840;
constexpr size_t WS_FLAG = 64 * 1024;

struct Params {
    const float* in[20];
    float* out;
    unsigned char* ws;
};

__device__ __forceinline__ Params launder(const Params& p) {
    Params q = p;
#pragma unroll
    for (int i = 0; i < 20; ++i) { const __attribute__((address_space(1))) float* g = (const __attribute__((address_space(1))) float*)q.in[i]; asm volatile("" : "+s"(g)); q.in[i] = (const float*)g; }
    { __attribute__((address_space(1))) float* g = (__attribute__((address_space(1))) float*)q.out; asm volatile("" : "+s"(g)); q.out = (float*)g; }
    { __attribute__((address_space(1))) unsigned char* g = (__attribute__((address_space(1))) unsigned char*)q.ws; asm volatile("" : "+s"(g)); q.ws = (unsigned char*)g; }
    return q;
}
__device__ __forceinline__ unsigned cvt_pk(float lo, float hi) { return pg8::cvt_pk_bf16(lo, hi); }
__device__ __forceinline__ float bf_lo(unsigned w) { return __builtin_bit_cast(float, w << 16); }
__device__ __forceinline__ float bf_hi(unsigned w) { return __builtin_bit_cast(float, w & 0xffff0000u); }
__device__ __forceinline__ void unpack8(const u32x4 w, float (&f)[8]) {
    f[0] = bf_lo(w.x); f[1] = bf_hi(w.x); f[2] = bf_lo(w.y); f[3] = bf_hi(w.y); f[4] = bf_lo(w.z); f[5] = bf_hi(w.z); f[6] = bf_lo(w.w); f[7] = bf_hi(w.w);
}
__device__ __forceinline__ u32x4 pack8(const float (&f)[8]) { u32x4 w; w.x = cvt_pk(f[0], f[1]); w.y = cvt_pk(f[2], f[3]); w.z = cvt_pk(f[4], f[5]); w.w = cvt_pk(f[6], f[7]); return w; }
__device__ __forceinline__ float wave_sum(float v) {
#pragma unroll
    for (int o = 1; o < 64; o <<= 1) v += __shfl_xor(v, o);
    return v;
}
template <int CTRL> __device__ __forceinline__ float dppf(float old, float src) {
    return __builtin_bit_cast(float, __builtin_amdgcn_update_dpp(__builtin_bit_cast(int, old), __builtin_bit_cast(int, src), CTRL, 0xf, 0xf, false));
}
template <int DD> __device__ __forceinline__ float shiftd(float cur, float prev) {
    const float t = dppf<0x100 + (16 - DD)>(0.f, prev);
    return dppf<0x110 + DD>(t, cur);
}
__device__ __forceinline__ float sigm(float v) { return __builtin_amdgcn_rcpf(1.0f + __expf(-v)); }
__device__ __forceinline__ int outchan(int n, int rho) { return 32 * (n >> 1) + 8 * (rho >> 2) + 4 * (n & 1) + (rho & 3); }

__device__ __forceinline__ float row_rstd(const float* ss, int r) {
    const f32x4* s4 = (const f32x4*)(ss + (size_t)r * 16);
    const f32x4 a = s4[0], b = s4[1], c = s4[2], d = s4[3];
    const float s = ((a.x + a.y) + (a.z + a.w)) + ((b.x + b.y) + (b.z + b.w)) + ((c.x + c.y) + (c.z + c.w)) + ((d.x + d.y) + (d.z + d.w));
    return 1.0f / sqrtf(s * (1.0f / D) + EPS);
}
__device__ __forceinline__ void rows_rstd(const float* ss, int rowbase  , int fr, float (&rs)[2][4]) {
    const int lane = threadIdx.x & 63;
    const float r0 = row_rstd(ss, rowbase + lane), r1 = row_rstd(ss, rowbase + 128 + lane);
#pragma unroll
    for (int m = 0; m < 4; ++m) { rs[0][m] = __shfl(r0, m * 16 + fr); rs[1][m] = __shfl(r1, m * 16 + fr); }
}
struct EpiIn {
    static constexpr bool PERM = true, AFTER_DRAIN = false, PRELOAD = false;
    bf16* P; const float* ss; const LAS float* rl; int pmc;
    __device__ __forceinline__ void operator()(const f32x4 (&acc)[2][2][4][2], const pg8::Unit& u, int wr, int wc, int fr, int fq) const {
        const int row0 = u.pm * 256 + wr * 64 + fr, col0 = u.pn * 256 + wc * 32 + 8 * fq;
        float rsv[2][4];
        if (u.pm == pmc) {
#pragma unroll
            for (int ai = 0; ai < 2; ++ai)
#pragma unroll
                for (int m = 0; m < 4; ++m) rsv[ai][m] = rl[ai * 128 + wr * 64 + m * 16 + fr];
        } else {
#pragma unroll
            for (int ai = 0; ai < 2; ++ai)
#pragma unroll
                for (int m = 0; m < 4; ++m) { rsv[ai][m] = row_rstd(ss, row0 + ai * 128 + m * 16); asm volatile("" ::: "memory"); }
        }
#pragma unroll
        for (int ai = 0; ai < 2; ++ai)
#pragma unroll
            for (int m = 0; m < 4; ++m) {
                const int r = row0 + ai * 128 + m * 16; const float rs = rsv[ai][m];
                bf16* rowp = P + (size_t)(r + NMETA * (1 + (r >> 13))) * DIN + col0;
#pragma unroll
                for (int bj = 0; bj < 2; ++bj) { const f32x4 v0 = acc[ai][bj][m][0] * rs, v1 = acc[ai][bj][m][1] * rs;
                    u32x4 w; w.x = cvt_pk(v0[0], v0[1]); w.y = cvt_pk(v0[2], v0[3]); w.z = cvt_pk(v1[0], v1[1]); w.w = cvt_pk(v1[2], v1[3]);
                    *(u32x4*)(rowp + bj * 128) = w; }
            }
    }
};
struct EpiUp {
    static constexpr bool PERM = true, AFTER_DRAIN = false, PRELOAD = false;
    bf16* O; const float* ss; const LAS float* rl; int pmc;
    __device__ __forceinline__ void operator()(const f32x4 (&acc)[2][2][4][2], const pg8::Unit& u, int wr, int wc, int fr, int fq) const {
        const int row0 = u.pm * 256 + wr * 64 + fr, col0 = u.pn * 256 + wc * 32 + 8 * fq;
        float rsv[2][4];
        if (u.pm == pmc) {
#pragma unroll
            for (int ai = 0; ai < 2; ++ai)
#pragma unroll
                for (int m = 0; m < 4; ++m) rsv[ai][m] = rl[ai * 128 + wr * 64 + m * 16 + fr];
        } else {
#pragma unroll
            for (int ai = 0; ai < 2; ++ai)
#pragma unroll
                for (int m = 0; m < 4; ++m) { rsv[ai][m] = row_rstd(ss, row0 + ai * 128 + m * 16); asm volatile("" ::: "memory"); }
        }
#pragma unroll
        for (int ai = 0; ai < 2; ++ai)
#pragma unroll
            for (int m = 0; m < 4; ++m) {
                const int r = row0 + ai * 128 + m * 16; const float rs = rsv[ai][m];
                bf16* rowp = O + (size_t)r * FF + col0;
#pragma unroll
                for (int bj = 0; bj < 2; ++bj) { f32x4 v0 = acc[ai][bj][m][0] * rs, v1 = acc[ai][bj][m][1] * rs;
#pragma unroll
                    for (int j = 0; j < 4; ++j) { v0[j] = fmaxf(v0[j], 0.f); v0[j] *= v0[j]; v1[j] = fmaxf(v1[j], 0.f); v1[j] *= v1[j]; }
                    u32x4 w; w.x = cvt_pk(v0[0], v0[1]); w.y = cvt_pk(v0[2], v0[3]); w.z = cvt_pk(v1[0], v1[1]); w.w = cvt_pk(v1[2], v1[3]);
                    *(u32x4*)(rowp + bj * 128) = w; }
            }
    }
};
struct EpiRes {
    static constexpr bool PERM = true, AFTER_DRAIN = false, PRELOAD = true;
    bf16* hb; float* ssn;
    __device__ __forceinline__ void preload(f32x4 (&acc)[2][2][4][2], const pg8::Unit& u, int wr, int wc, int fr, int fq) const {
        const int row0 = u.pm * 256 + wr * 64 + fr, col0 = u.pn * 256 + wc * 32 + 8 * fq;
#pragma unroll
        for (int ai = 0; ai < 2; ++ai)
#pragma unroll
            for (int m = 0; m < 4; ++m) { const size_t off = (size_t)(row0 + ai * 128 + m * 16) * D + col0;
#pragma unroll
                for (int bj = 0; bj < 2; ++bj) { const u32x4 w = *(const u32x4*)(hb + off + bj * 128);
                    acc[ai][bj][m][0] = (f32x4){bf_lo(w.x), bf_hi(w.x), bf_lo(w.y), bf_hi(w.y)}; acc[ai][bj][m][1] = (f32x4){bf_lo(w.z), bf_hi(w.z), bf_lo(w.w), bf_hi(w.w)}; } }
    }
    __device__ __forceinline__ void operator()(const f32x4 (&acc)[2][2][4][2], const pg8::Unit& u, int wr, int wc, int fr, int fq) const {
        const int row0 = u.pm * 256 + wr * 64 + fr, col0 = u.pn * 256 + wc * 32 + 8 * fq;
#pragma unroll
        for (int ai = 0; ai < 2; ++ai)
#pragma unroll
            for (int m = 0; m < 4; ++m) {
                const int r = row0 + ai * 128 + m * 16; const size_t off = (size_t)r * D + col0; float s = 0.f;
#pragma unroll
                for (int bj = 0; bj < 2; ++bj) {
                    const f32x4 o0 = acc[ai][bj][m][0], o1 = acc[ai][bj][m][1];
                    s += (o0[0] * o0[0] + o0[1] * o0[1]) + (o0[2] * o0[2] + o0[3] * o0[3]) + (o1[0] * o1[0] + o1[1] * o1[1]) + (o1[2] * o1[2] + o1[3] * o1[3]);
                    u32x4 w; w.x = cvt_pk(o0[0], o0[1]); w.y = cvt_pk(o0[2], o0[3]); w.z = cvt_pk(o1[0], o1[1]); w.w = cvt_pk(o1[2], o1[3]);
                    *(u32x4*)(hb + off + bj * 128) = w; }
                s += __shfl_xor(s, 16); s += __shfl_xor(s, 32);
                if (fq == 0) ssn[(size_t)r * 16 + u.pn * 4 + wc] = s;
            }
    }
};

struct TItem { const float* W; const float* gk; bf16* WT; int K, N, item; };
__device__ __forceinline__ void titem_load(const TItem& t, int lane, f32x4 (&v)[8], float (&gs)[8]) {
    const int nblk = t.N / 32, kb = t.item / nblk, nb = t.item % nblk, k0 = 64 * kb, n0 = 32 * nb, lr = lane >> 3, lc = (lane & 7) * 4;
#pragma unroll
    for (int i = 0; i < 8; ++i) { v[i] = *(const f32x4*)(t.W + (size_t)(k0 + 8 * i + lr) * t.N + n0 + lc); gs[i] = t.gk ? t.gk[k0 + 8 * i + lr] : 1.0f; }
}
__device__ __forceinline__ void titem_store(const TItem& t, int lane, const f32x4 (&v)[8], const float (&gs)[8], LAS float* scr) {
    const int nblk = t.N / 32, kb = t.item / nblk, nb = t.item % nblk, k0 = 64 * kb, n0 = 32 * nb, lr = lane >> 3, lc = (lane & 7) * 4;
#pragma unroll
    for (int i = 0; i < 8; ++i) { LAS float* d = scr + (8 * i + lr) * 33 + lc; d[0] = v[i].x * gs[i]; d[1] = v[i].y * gs[i]; d[2] = v[i].z * gs[i]; d[3] = v[i].w * gs[i]; }
    asm volatile("s_waitcnt lgkmcnt(0)" ::: "memory");
    const int c = lane & 7;
#pragma unroll
    for (int j = 0; j < 4; ++j) { const int n = (lane >> 3) + 8 * j; const LAS float* s = scr + (8 * c) * 33 + n;
        u32x4 o; o.x = cvt_pk(s[0 * 33], s[1 * 33]); o.y = cvt_pk(s[2 * 33], s[3 * 33]); o.z = cvt_pk(s[4 * 33], s[5 * 33]); o.w = cvt_pk(s[6 * 33], s[7 * 33]);
        *(u32x4*)(t.WT + (size_t)(n0 + n) * t.K + k0 + 8 * c) = o; }
    asm volatile("s_waitcnt lgkmcnt(0)" ::: "memory");
}
__device__ __forceinline__ TItem titem_decode(const Params& p, int it) {
    constexpr int I_IN = 16 * 48, I_OUT = 16 * 32, I_UP = 16 * 128, I_DN = 64 * 32, I_PW = 4 * 8, I_G = 8 * 2, I_L = I_IN + I_OUT + I_UP + I_DN + I_PW + 2 * I_G;
    const int l = it / I_L; int r = it % I_L; unsigned char* ws = p.ws; unsigned char* wl = ws + WS_W + (size_t)l * W_LAYER; TItem t;
    if (r < I_IN) { t = TItem{p.in[3] + (size_t)l * D * DIN, p.in[2] + l * D, (bf16*)(wl + W_IN), D, DIN, r}; return t; } r -= I_IN;
    if (r < I_OUT) { t = TItem{p.in[15] + (size_t)l * D * D, p.in[14] + l * D, (bf16*)(wl + W_OUT), D, D, r}; return t; } r -= I_OUT;
    if (r < I_UP) { t = TItem{p.in[17] + (size_t)l * D * FF, p.in[16] + l * D, (bf16*)(wl + W_UP), D, FF, r}; return t; } r -= I_UP;
    if (r < I_DN) { t = TItem{p.in[18] + (size_t)l * FF * D, nullptr, (bf16*)(wl + W_DOWN), FF, D, r}; return t; } r -= I_DN;
    if (r < I_PW) { const int g = r / 8; t = TItem{p.in[4] + (size_t)(l * 4 + g) * 16384, nullptr, (bf16*)(ws + WS_POOLW) + (size_t)(l * 4 + g) * 16384, 128, 128, r % 8}; return t; } r -= I_PW;
    if (r < I_G) { const int h = r / 2; t = TItem{p.in[9] + (size_t)(l * 8 + h) * 4096, nullptr, (bf16*)(ws + WS_GR) + (size_t)(l * 8 + h) * 4096, 64, 64, r % 2}; return t; } r -= I_G;
    { const int h = r / 2; t = TItem{p.in[11] + (size_t)(l * 8 + h) * 4096, nullptr, (bf16*)(ws + WS_GI) + (size_t)(l * 8 + h) * 4096, 64, 64, r % 2}; }
    return t;
}
__device__ __forceinline__ void prologue(const Params& p_, LAS unsigned char* lds, int G) {
    const Params p = launder(p_);
    int tid_ = threadIdx.x; asm volatile("" : "+v"(tid_));
    const int tid = tid_, lane = tid & 63, wid = __builtin_amdgcn_readfirstlane(tid >> 6);
    LAS float* scr = (LAS float*)(lds + wid * 16384);
    const int gw = blockIdx.x * 8 + wid, NGW = G * 8;
    constexpr int NITEMS = DEPTH * (16 * 48 + 16 * 32 + 16 * 128 + 64 * 32 + 4 * 8 + 2 * 8 * 2);
    unsigned char* ws = p.ws;
    if (gw < NITEMS) {
        TItem cur = titem_decode(p, gw); f32x4 v[8]; float gs[8]; titem_load(cur, lane, v, gs);
        for (int it = gw; it < NITEMS; it += NGW) {
            const bool more = it + NGW < NITEMS; TItem nxt = cur; f32x4 nv[8]; float ngs[8];
            if (more) { nxt = titem_decode(p, it + NGW); titem_load(nxt, lane, nv, ngs); }
            titem_store(cur, lane, v, gs, scr);
            if (more) { cur = nxt;
#pragma unroll
                for (int i = 0; i < 8; ++i) { v[i] = nv[i]; gs[i] = ngs[i]; } }
        }
    }
    const float* x = p.in[0]; bf16* hb = (bf16*)(ws + WS_HB); float* ss = (float*)(ws + WS_SS);
    for (int m2 = gw; m2 < M / 2; m2 += NGW) {
        f32x4 v[2][4]; float s[2] = {0.f, 0.f};
#pragma unroll
        for (int r = 0; r < 2; ++r) { const f32x4* xr = (const f32x4*)(x + (size_t)(2 * m2 + r) * D) + lane;
#pragma unroll
            for (int j = 0; j < 4; ++j) v[r][j] = xr[64 * j]; }
#pragma unroll
        for (int r = 0; r < 2; ++r) {
#pragma unroll
            for (int j = 0; j < 4; ++j) s[r] += (v[r][j].x * v[r][j].x + v[r][j].y * v[r][j].y) + (v[r][j].z * v[r][j].z + v[r][j].w * v[r][j].w);
            s[r] = wave_sum(s[r]);
            u32x2* o8 = (u32x2*)(hb + (size_t)(2 * m2 + r) * D) + lane;
#pragma unroll
            for (int j = 0; j < 4; ++j) { u32x2 w; w.x = cvt_pk(v[r][j].x, v[r][j].y); w.y = cvt_pk(v[r][j].z, v[r][j].w); o8[64 * j] = w; }
            if (lane < 16) ss[(size_t)(2 * m2 + r) * 16 + lane] = lane == 0 ? s[r] : 0.f;
        }
    }
    float* hm = (float*)(ws + WS_HMETA); float* sp = (float*)(ws + WS_SP);
    for (int i = blockIdx.x * 512 + tid; i < NMETA * D; i += G * 512) hm[i] = p.in[1][i];
    for (int i = blockIdx.x * 512 + tid; i < DEPTH * DH; i += G * 512) sp[i] = log1pf(expf(-p.in[13][i]));
}

template <int MODE> __device__ __forceinline__ void meta_tasks(const Params& p_, LAS unsigned char* lds, int G, const bf16* Ab, int lda, const bf16* Bt, int K, int ntasks) {
    const Params p = launder(p_);
    int tid_ = threadIdx.x; asm volatile("" : "+v"(tid_));
    const int tid = tid_, lane = tid & 63, wid = __builtin_amdgcn_readfirstlane(tid >> 6), fr = lane & 15, fq = lane >> 4;
    float* hm = (float*)(p.ws + WS_HMETA);
    LAS float* red = (LAS float*)lds;
    for (int task = G - 1 - (int)blockIdx.x; task < ntasks; task += G) {
        const int n0 = task * 16, kw = K / 8, k0 = wid * kw;
        f32x4 acc = {0.f, 0.f, 0.f, 0.f}; float ssq = 0.f;
        for (int kb = k0; kb < k0 + kw; kb += 128) {
            bf16x8 af[4], bfr[4]; f32x4 a0[4], a1[4];
#pragma unroll
            for (int i = 0; i < 4; ++i) { const int kk = kb + 32 * i;
                if (MODE == 1) af[i] = *(const bf16x8*)(Ab + (size_t)fr * lda + kk + 8 * fq);
                else { a0[i] = *(const f32x4*)(hm + fr * D + kk + 8 * fq); a1[i] = *(const f32x4*)(hm + fr * D + kk + 8 * fq + 4); }
                bfr[i] = *(const bf16x8*)(Bt + (size_t)(n0 + fr) * K + kk + 8 * fq); }
#pragma unroll
            for (int i = 0; i < 4; ++i) {
                if (MODE != 1) { ssq += (a0[i].x * a0[i].x + a0[i].y * a0[i].y) + (a0[i].z * a0[i].z + a0[i].w * a0[i].w) + (a1[i].x * a1[i].x + a1[i].y * a1[i].y) + (a1[i].z * a1[i].z + a1[i].w * a1[i].w);
                    u32x4 w; w.x = cvt_pk(a0[i].x, a0[i].y); w.y = cvt_pk(a0[i].z, a0[i].w); w.z = cvt_pk(a1[i].x, a1[i].y); w.w = cvt_pk(a1[i].z, a1[i].w); af[i] = __builtin_bit_cast(bf16x8, w); }
                acc = __builtin_amdgcn_mfma_f32_16x16x32_bf16(bfr[i], af[i], acc, 0, 0, 0); }
        }
        ssq += __shfl_xor(ssq, 16); ssq += __shfl_xor(ssq, 32);
        LAS float* rp = red + (wid * 64 + lane) * 5;
        rp[0] = acc[0]; rp[1] = acc[1]; rp[2] = acc[2]; rp[3] = acc[3]; rp[4] = ssq;
        __syncthreads();
        if (wid == 0) {
            float a0 = 0.f, a1 = 0.f, a2 = 0.f, a3 = 0.f, sq = 0.f;
#pragma unroll
            for (int w = 0; w < 8; ++w) { const LAS float* q = red + (w * 64 + lane) * 5; a0 += q[0]; a1 += q[1]; a2 += q[2]; a3 += q[3]; sq += q[4]; }
            const int col = n0 + 4 * fq;
            if (MODE == 1) { f32x4* hp = (f32x4*)(hm + fr * D + col); f32x4 h = *hp; h.x += a0; h.y += a1; h.z += a2; h.w += a3; *hp = h; }
            else {
                const float rs = 1.0f / sqrtf(sq * (1.0f / D) + EPS); a0 *= rs; a1 *= rs; a2 *= rs; a3 *= rs;
                if (MODE == 0) { u32x2 w; w.x = cvt_pk(a0, a1); w.y = cvt_pk(a2, a3); bf16* pr = (bf16*)(p.ws + WS_PROJ);
                    *(u32x2*)(pr + (size_t)fr * DIN + col) = w; *(u32x2*)(pr + (size_t)(TT + fr) * DIN + col) = w; }
                else { a0 = fmaxf(a0, 0.f); a1 = fmaxf(a1, 0.f); a2 = fmaxf(a2, 0.f); a3 = fmaxf(a3, 0.f);
                    u32x2 w; w.x = cvt_pk(a0 * a0, a1 * a1); w.y = cvt_pk(a2 * a2, a3 * a3); *(u32x2*)((bf16*)(p.ws + WS_MIDMETA) + (size_t)fr * FF + col) = w; }
            }
        }
        __syncthreads();
    }
}

__device__ __forceinline__ void m1_phase(const Params& p_, LAS unsigned char* lds, int G, int l) {
    const Params p = launder(p_);
    int tid_ = threadIdx.x; asm volatile("" : "+v"(tid_));
    const int tid = tid_, lane = tid & 63, wid = __builtin_amdgcn_readfirstlane(tid >> 6), fr = lane & 15, fq = lane >> 4;
    LAS float* cst = (LAS float*)lds;
    for (int i = tid; i < 8 * DH; i += 512) { const int row = i >> 9, ch = i & 511; float v;
        if (row < 4) v = p.in[7][(l * 4 + row) * DH + ch]; else if (row == 4) v = p.in[8][l * DH + ch]; else if (row == 5) v = p.in[10][l * DH + ch];
        else if (row == 6) v = p.in[12][l * DH + ch]; else v = ((const float*)(p.ws + WS_SP))[l * DH + ch];
        cst[i] = v; }
    const bf16* proj = (const bf16*)(p.ws + WS_PROJ);
    const bf16* Wr = (const bf16*)(p.ws + WS_GR) + (size_t)(l * 8 + wid) * 4096; const bf16* Wi = (const bf16*)(p.ws + WS_GI) + (size_t)(l * 8 + wid) * 4096;
    LAS bf16x8* wl = (LAS bf16x8*)(lds + 16384 + wid * 16384) + lane;
#pragma unroll
    for (int n = 0; n < 4; ++n)
#pragma unroll
        for (int ks = 0; ks < 2; ++ks) {
            wl[((n * 2 + ks) * 2 + 0) * 64] = *(const bf16x8*)(Wr + outchan(n, fr) * 64 + 32 * ks + 8 * fq);
            wl[((n * 2 + ks) * 2 + 1) * 64] = *(const bf16x8*)(Wi + outchan(n, fr) * 64 + 32 * ks + 8 * fq); }
    __syncthreads();
    bf16* hl = (bf16*)(p.ws + WS_HL); bf16* Pp = (bf16*)(p.ws + WS_P);
    float* carA = (float*)(p.ws + WS_CARA); float* carH = (float*)(p.ws + WS_CARH);
    for (int unit = blockIdx.x; unit < 256; unit += G) {
        const int b = unit >> 7, c = unit & 127, t0 = c ? NMETA + 64 * c : 0, NM = c ? 4 : 5;
        float Hc[16], Pc[16];
#pragma unroll
        for (int k = 0; k < 16; ++k) { Hc[k] = 0.f; Pc[k] = 1.f; }
        u32x4 raw[2][4];
#pragma unroll
        for (int ks = 0; ks < 2; ++ks)
#pragma unroll
            for (int d = 0; d < 4; ++d) { const int tt = t0 + fr - 3 + d; raw[ks][d] = (u32x4){0u, 0u, 0u, 0u};
                if (tt >= 0) raw[ks][d] = *(const u32x4*)(proj + ((size_t)b * TT + tt) * DIN + DH + wid * 64 + 32 * ks + 8 * fq); }
#pragma unroll 1
        for (int m = 0; m < NM; ++m) {
            const int t = t0 + 16 * m + fr; const size_t rowg = (size_t)b * TT + t;
            u32x4 nraw[2][4];
#pragma unroll
            for (int ks = 0; ks < 2; ++ks)
#pragma unroll
                for (int d = 0; d < 4; ++d) { nraw[ks][d] = (u32x4){0u, 0u, 0u, 0u};
                    if (m + 1 < NM) nraw[ks][d] = *(const u32x4*)(proj + ((size_t)b * TT + t + 13 + d) * DIN + DH + wid * 64 + 32 * ks + 8 * fq); }
            float xc[2][8]; bf16x8 frag[2];
#pragma unroll
            for (int ks = 0; ks < 2; ++ks) {
                const int chb = wid * 64 + 32 * ks + 8 * fq;
                { const f32x4 c0 = *(const LAS f32x4*)(cst + 4 * DH + chb), c1 = *(const LAS f32x4*)(cst + 4 * DH + chb + 4);
                  xc[ks][0] = c0.x; xc[ks][1] = c0.y; xc[ks][2] = c0.z; xc[ks][3] = c0.w; xc[ks][4] = c1.x; xc[ks][5] = c1.y; xc[ks][6] = c1.z; xc[ks][7] = c1.w; }
#pragma unroll
                for (int d = 0; d < 4; ++d) {
                    float u[8]; unpack8(raw[ks][d], u);
                    const f32x4 w0 = *(const LAS f32x4*)(cst + d * DH + chb), w1 = *(const LAS f32x4*)(cst + d * DH + chb + 4);
                    xc[ks][0] += u[0] * w0.x; xc[ks][1] += u[1] * w0.y; xc[ks][2] += u[2] * w0.z; xc[ks][3] += u[3] * w0.w;
                    xc[ks][4] += u[4] * w1.x; xc[ks][5] += u[5] * w1.y; xc[ks][6] += u[6] * w1.z; xc[ks][7] += u[7] * w1.w;
                    raw[ks][d] = nraw[ks][d];
                }
                frag[ks] = __builtin_bit_cast(bf16x8, pack8(xc[ks]));
            }
            f32x4 ar[4], ai[4];
#pragma unroll
            for (int n = 0; n < 4; ++n) { ar[n] = (f32x4){0.f, 0.f, 0.f, 0.f}; ai[n] = (f32x4){0.f, 0.f, 0.f, 0.f};
#pragma unroll
                for (int ks = 0; ks < 2; ++ks) {
                    const bf16x8 wr_ = wl[((n * 2 + ks) * 2 + 0) * 64], wi_ = wl[((n * 2 + ks) * 2 + 1) * 64];
                    ar[n] = __builtin_amdgcn_mfma_f32_16x16x32_bf16(wr_, frag[ks], ar[n], 0, 0, 0);
                    ai[n] = __builtin_amdgcn_mfma_f32_16x16x32_bf16(wi_, frag[ks], ai[n], 0, 0, 0);
                } }
            float Aa[16], Bb[16];
#pragma unroll
            for (int n = 0; n < 4; ++n) {
                const int cho = wid * 64 + 32 * (n >> 1) + 8 * fq + 4 * (n & 1);
                const f32x4 rb = *(const LAS f32x4*)(cst + 5 * DH + cho), ib = *(const LAS f32x4*)(cst + 6 * DH + cho), spv = *(const LAS f32x4*)(cst + 7 * DH + cho);
#pragma unroll
                for (int jj = 0; jj < 4; ++jj) {
                    const float r = sigm(ar[n][jj] + rb[jj]), ig = sigm(ai[n][jj] + ib[jj]);
                    const float la = -8.0f * r * spv[jj], a = __expf(la), x2 = 2.0f * la;
                    const float m2s = -x2 * (1.0f + x2 * (0.5f + x2 * (0.16666667f + x2 * 0.041666668f))), m2 = (x2 > -0.0625f) ? m2s : 1.0f - a * a;
                    Aa[n * 4 + jj] = a; Bb[n * 4 + jj] = __builtin_amdgcn_sqrtf(m2) * ig * xc[n >> 1][4 * (n & 1) + jj];
                }
            }
#pragma unroll
            for (int k = 0; k < 16; ++k) {
                float A = Aa[k], B = Bb[k], Ap, Bq;
                Ap = dppf<0x111>(1.f, A); Bq = dppf<0x111>(0.f, B); B = fmaf(A, Bq, B); A *= Ap;
                Ap = dppf<0x112>(1.f, A); Bq = dppf<0x112>(0.f, B); B = fmaf(A, Bq, B); A *= Ap;
                Ap = dppf<0x114>(1.f, A); Bq = dppf<0x114>(0.f, B); B = fmaf(A, Bq, B); A *= Ap;
                Ap = dppf<0x118>(1.f, A); Bq = dppf<0x118>(0.f, B); B = fmaf(A, Bq, B); A *= Ap;
                Bb[k] = fmaf(A, Hc[k], B); Aa[k] = A * Pc[k];
            }
#pragma unroll
            for (int ks = 0; ks < 2; ++ks) {
                const size_t o = rowg * DH + wid * 64 + 32 * ks + 8 * fq;
                { u32x4 wh; wh.x = cvt_pk(Bb[8 * ks + 0], Bb[8 * ks + 1]); wh.y = cvt_pk(Bb[8 * ks + 2], Bb[8 * ks + 3]); wh.z = cvt_pk(Bb[8 * ks + 4], Bb[8 * ks + 5]); wh.w = cvt_pk(Bb[8 * ks + 6], Bb[8 * ks + 7]);
                  *(u32x4*)(hl + o) = wh; }
                u32x4 w; w.x = cvt_pk(Aa[8 * ks + 0], Aa[8 * ks + 1]); w.y = cvt_pk(Aa[8 * ks + 2], Aa[8 * ks + 3]); w.z = cvt_pk(Aa[8 * ks + 4], Aa[8 * ks + 5]); w.w = cvt_pk(Aa[8 * ks + 6], Aa[8 * ks + 7]);
                *(u32x4*)(Pp + o) = w;
            }
            const int src = (lane & 48) | 15;
#pragma unroll
            for (int k = 0; k < 16; ++k) { Hc[k] = __shfl(Bb[k], src); Pc[k] = __shfl(Aa[k], src); }
        }
        if (fr == 0) {
#pragma unroll
            for (int ks = 0; ks < 2; ++ks) {
                const size_t o = (size_t)(b * 128 + c) * DH + wid * 64 + 32 * ks + 8 * fq;
                *(f32x4*)(carA + o) = (f32x4){Pc[8 * ks + 0], Pc[8 * ks + 1], Pc[8 * ks + 2], Pc[8 * ks + 3]}; *(f32x4*)(carA + o + 4) = (f32x4){Pc[8 * ks + 4], Pc[8 * ks + 5], Pc[8 * ks + 6], Pc[8 * ks + 7]};
                *(f32x4*)(carH + o) = (f32x4){Hc[8 * ks + 0], Hc[8 * ks + 1], Hc[8 * ks + 2], Hc[8 * ks + 3]}; *(f32x4*)(carH + o + 4) = (f32x4){Hc[8 * ks + 4], Hc[8 * ks + 5], Hc[8 * ks + 6], Hc[8 * ks + 7]};
            }
        }
    }
    __syncthreads();
}


template <int NMR, bool FROM_LDS> __device__ __forceinline__ void m2_rnn_round(LAS unsigned char* lds, const bf16* hl, const bf16* Pp, const bf16* proj, bf16* Y, LAS float* red1, const float (&cr)[16], int b, int t0, int mbase, int wid, int fr, int fq) {
    u32x4 hw[NMR][2], pw[NMR][2], gw[NMR][2];
#pragma unroll
    for (int m = 0; m < NMR; ++m)
#pragma unroll
        for (int ks = 0; ks < 2; ++ks) { const size_t rowg = (size_t)b * TT + t0 + 16 * (mbase + m) + fr; const int ch = wid * 64 + 32 * ks + 8 * fq; const size_t o = rowg * DH + ch;
            if (FROM_LDS) { const int lane = fq * 16 + fr; hw[m][ks] = *(const LAS u32x4*)(lds + LDS_HL + wid * 8192 + (((mbase + m) * 2 + ks) * 64 + lane) * 16); pw[m][ks] = *(const LAS u32x4*)(lds + LDS_P + wid * 8192 + (((mbase + m) * 2 + ks) * 64 + lane) * 16); }
            else { hw[m][ks] = *(const u32x4*)(hl + o); pw[m][ks] = *(const u32x4*)(Pp + o); } gw[m][ks] = *(const u32x4*)(proj + rowg * DIN + 2 * DH + ch); }
    float y[NMR][16];
#pragma unroll
    for (int m = 0; m < NMR; ++m) { float s = 0.f;
#pragma unroll
        for (int ks = 0; ks < 2; ++ks) { float pf[8], gt[8]; unpack8(pw[m][ks], pf); unpack8(gw[m][ks], gt);
            float hh[8]; unpack8(hw[m][ks], hh);
#pragma unroll
            for (int e = 0; e < 8; ++e) { const float hv = fmaf(pf[e], cr[8 * ks + e], hh[e]), x = gt[e];
                const float ge = x * __builtin_amdgcn_rcpf(1.0f + __expf(-1.5957691216f * (x + 0.044715f * x * x * x)));
                const float yy = hv * ge; y[m][8 * ks + e] = yy; s = fmaf(yy, yy, s); } }
        s += __shfl_xor(s, 16); s += __shfl_xor(s, 32);
        if (fq == 0) red1[(16 * (mbase + m) + fr) * 8 + wid] = s; }
    __syncthreads();
#pragma unroll
    for (int m = 0; m < NMR; ++m) { const size_t rowg = (size_t)b * TT + t0 + 16 * (mbase + m) + fr;
        const f32x4 r0 = *(const LAS f32x4*)(red1 + (16 * (mbase + m) + fr) * 8), r1 = *(const LAS f32x4*)(red1 + (16 * (mbase + m) + fr) * 8 + 4);
        const float rs = __builtin_amdgcn_rsqf((((r0.x + r0.y) + (r0.z + r0.w)) + ((r1.x + r1.y) + (r1.z + r1.w))) * (1.0f / DH) + EPS);
#pragma unroll
        for (int ks = 0; ks < 2; ++ks) { float yy[8];
#pragma unroll
            for (int e = 0; e < 8; ++e) yy[e] = y[m][8 * ks + e] * rs;
            *(u32x4*)(Y + rowg * D + DH + wid * 64 + 32 * ks + 8 * fq) = pack8(yy); } }
}


template <int NMR> __device__ __forceinline__ void m2_pool_round(const bf16* proj, bf16* Y, const bf16* Wp, const float* pbias, const float* pscale, LAS float* red2,
                                                                  int b, int t0, int mbase, int g, int half, int kwin, int wid, int fr, int fq) {
    const int tb = t0 + 16 * mbase;
    bf16x8 pfr[NMR][4];
#pragma unroll
    for (int ks = 0; ks < 4; ++ks) {
        const int chb = g * 128 + 32 * ks + 8 * fq;
        float pu[8], p2[8], p4[8], p8[8];
        if (tb) { const u32x4 raw = *(const u32x4*)(proj + ((size_t)b * TT + tb - 16 + fr) * DIN + chb); unpack8(raw, pu);
#pragma unroll
            for (int e = 0; e < 8; ++e) { p2[e] = pu[e] + dppf<0x111>(0.f, pu[e]); p4[e] = p2[e] + dppf<0x112>(0.f, p2[e]); p8[e] = p4[e] + dppf<0x114>(0.f, p4[e]); } }
        else {
#pragma unroll
            for (int e = 0; e < 8; ++e) { pu[e] = 0.f; p2[e] = 0.f; p4[e] = 0.f; p8[e] = 0.f; } }
#pragma unroll
        for (int m = 0; m < NMR; ++m) {
            const int t = tb + 16 * m + fr; const size_t rowg = (size_t)b * TT + t;
            const u32x4 raw = *(const u32x4*)(proj + rowg * DIN + chb); float u[8], po[8]; unpack8(raw, u);
            const int cnt = (t + 1 < kwin) ? t + 1 : kwin; const float rc = __builtin_amdgcn_rcpf((float)cnt);
#pragma unroll
            for (int e = 0; e < 8; ++e) {
                const float s2 = u[e] + shiftd<1>(u[e], pu[e]), s4 = s2 + shiftd<2>(s2, p2[e]), s8 = s4 + shiftd<4>(s4, p4[e]), s16 = s8 + shiftd<8>(s8, p8[e]);
                const float win = g == 0 ? s2 : (g == 1 ? s4 : (g == 2 ? s8 : s16));
                po[e] = fmaf(win, rc, -u[e]); pu[e] = u[e]; p2[e] = s2; p4[e] = s4; p8[e] = s8;
            }
            pfr[m][ks] = __builtin_bit_cast(bf16x8, pack8(po));
        }
    }
    bf16x8 wfr[4][4];
#pragma unroll
    for (int n = 0; n < 4; ++n)
#pragma unroll
        for (int ks = 0; ks < 4; ++ks) wfr[n][ks] = *(const bf16x8*)(Wp + (size_t)(64 * half + outchan(n, fr)) * 128 + 32 * ks + 8 * fq);
#pragma unroll 1
    for (int pass = 0; pass < 2; ++pass) {
#pragma unroll
        for (int m = 0; m < NMR; ++m) {
            const int t = tb + 16 * m + fr; const size_t rowg = (size_t)b * TT + t; float s = 0.f, rs = 0.f;
            if (pass) { const f32x4 r0 = *(const LAS f32x4*)(red2 + (16 * (mbase + m) + fr) * 8), r1 = *(const LAS f32x4*)(red2 + (16 * (mbase + m) + fr) * 8 + 4);
                rs = __builtin_amdgcn_rsqf((((r0.x + r0.y) + (r0.z + r0.w)) + ((r1.x + r1.y) + (r1.z + r1.w))) * (1.0f / DH) + EPS); }
#pragma unroll
            for (int np = 0; np < 2; ++np) {
                f32x4 o2[2];
#pragma unroll
                for (int nn = 0; nn < 2; ++nn) { const int n = 2 * np + nn;
                    f32x4 acc = {0.f, 0.f, 0.f, 0.f};
#pragma unroll
                    for (int ks = 0; ks < 4; ++ks) acc = __builtin_amdgcn_mfma_f32_16x16x32_bf16(wfr[n][ks], pfr[m][ks], acc, 0, 0, 0);
                    const int col = g * 128 + 64 * half + 32 * np + 8 * fq + 4 * nn;
                    const f32x4 pb = *(const f32x4*)(pbias + col), ps = *(const f32x4*)(pscale + col);
                    acc = (acc + pb) * ps; s += (acc.x * acc.x + acc.y * acc.y) + (acc.z * acc.z + acc.w * acc.w); o2[nn] = acc * rs; }
                if (pass) { u32x4 w; w.x = cvt_pk(o2[0].x, o2[0].y); w.y = cvt_pk(o2[0].z, o2[0].w); w.z = cvt_pk(o2[1].x, o2[1].y); w.w = cvt_pk(o2[1].z, o2[1].w);
                    *(u32x4*)(Y + rowg * D + g * 128 + 64 * half + 32 * np + 8 * fq) = w; }
            }
            if (!pass) { s += __shfl_xor(s, 16); s += __shfl_xor(s, 32); if (fq == 0) red2[(16 * (mbase + m) + fr) * 8 + wid] = s; }
        }
        if (!pass) __syncthreads();
    }
}

__device__ __forceinline__ void m2_phase(const Params& p_, LAS unsigned char* lds, int G, int l) {
    const Params p = launder(p_);
    int tid_ = threadIdx.x; asm volatile("" : "+v"(tid_));
    const int tid = tid_, lane = tid & 63, wid = __builtin_amdgcn_readfirstlane(tid >> 6), fr = lane & 15, fq = lane >> 4;
    LAS float* segA = (LAS float*)lds; LAS float* segH = (LAS float*)(lds + 16384); LAS float* carr = (LAS float*)(lds + 32768);
    LAS float* red1 = (LAS float*)(lds + 34816); LAS float* red2 = (LAS float*)(lds + 37888);
    const bf16* proj = (const bf16*)(p.ws + WS_PROJ); bf16* Y = (bf16*)(p.ws + WS_Y);
    const bf16* hl = (const bf16*)(p.ws + WS_HL); const bf16* Pp = (const bf16*)(p.ws + WS_P);
    const float* carA = (const float*)(p.ws + WS_CARA); const float* carH = (const float*)(p.ws + WS_CARH);
    const int g = wid >> 1, half = wid & 1, kwin = 2 << g;
    const bf16* Wp = (const bf16*)(p.ws + WS_POOLW) + (size_t)(l * 4 + g) * 16384;
    const float* pbias = p.in[5] + l * DH; const float* pscale = p.in[6] + l * DH;
    for (int unit = blockIdx.x; unit < 256; unit += G) {
        const int b = unit >> 7, c = unit & 127, t0 = c ? NMETA + 64 * c : 0, NM = c ? 4 : 5;
        {
            const int q = (c + 7) >> 3, jlo = wid * q, jhi = (jlo + q < c) ? jlo + q : c;
            f32x4 A0 = {1.f, 1.f, 1.f, 1.f}, A1 = A0, H0 = {0.f, 0.f, 0.f, 0.f}, H1 = H0;
            for (int j = jlo; j < jhi; j += 8) {
                f32x4 a0[8], a1[8], h0[8], h1[8];
#pragma unroll
                for (int i = 0; i < 8; ++i) { const int jj = (j + i < jhi) ? j + i : jhi - 1; const size_t o = (size_t)(b * 128 + jj) * DH + 8 * lane;
                    a0[i] = *(const f32x4*)(carA + o); a1[i] = *(const f32x4*)(carA + o + 4); h0[i] = *(const f32x4*)(carH + o); h1[i] = *(const f32x4*)(carH + o + 4); }
#pragma unroll
                for (int i = 0; i < 8; ++i) if (j + i < jhi) { H0 = a0[i] * H0 + h0[i]; A0 = A0 * a0[i]; H1 = a1[i] * H1 + h1[i]; A1 = A1 * a1[i]; }
            }
            *(LAS f32x4*)(segA + wid * DH + 8 * lane) = A0; *(LAS f32x4*)(segA + wid * DH + 8 * lane + 4) = A1;
            *(LAS f32x4*)(segH + wid * DH + 8 * lane) = H0; *(LAS f32x4*)(segH + wid * DH + 8 * lane + 4) = H1;
        }
        __syncthreads();
        { float cy = 0.f;
#pragma unroll
          for (int s8 = 0; s8 < 8; ++s8) cy = segA[s8 * DH + tid] * cy + segH[s8 * DH + tid];
          carr[tid] = cy; }
        __syncthreads();
        {
            float cr[16];
#pragma unroll
            for (int ks = 0; ks < 2; ++ks) { const f32x4 c0 = *(const LAS f32x4*)(carr + wid * 64 + 32 * ks + 8 * fq), c1 = *(const LAS f32x4*)(carr + wid * 64 + 32 * ks + 8 * fq + 4);
                cr[8 * ks + 0] = c0.x; cr[8 * ks + 1] = c0.y; cr[8 * ks + 2] = c0.z; cr[8 * ks + 3] = c0.w; cr[8 * ks + 4] = c1.x; cr[8 * ks + 5] = c1.y; cr[8 * ks + 6] = c1.z; cr[8 * ks + 7] = c1.w; }
            m2_rnn_round<4, false>(lds, hl, Pp, proj, Y, red1, cr, b, t0, 0, wid, fr, fq);
            if (NM == 5) m2_rnn_round<1, false>(lds, hl, Pp, proj, Y, red1, cr, b, t0, 4, wid, fr, fq);
        }
        m2_pool_round<4>(proj, Y, Wp, pbias, pscale, red2, b, t0, 0, g, half, kwin, wid, fr, fq);
        if (NM == 5) m2_pool_round<1>(proj, Y, Wp, pbias, pscale, red2, b, t0, 4, g, half, kwin, wid, fr, fq);
    }
    __syncthreads();
}

__device__ __forceinline__ void final_norm(const Params& p_, int G) {
    const Params p = launder(p_);
    int tid_ = threadIdx.x; asm volatile("" : "+v"(tid_));
    const int tid = tid_, lane = tid & 63, wid = tid >> 6; const int gw = blockIdx.x * 8 + wid, NGW = G * 8;
    const bf16* hb = (const bf16*)(p.ws + WS_HB);
    const f32x4* gp = (const f32x4*)p.in[19] + 2 * lane; f32x4 gg[2][2];
#pragma unroll
    for (int j = 0; j < 2; ++j) { gg[j][0] = gp[128 * j]; gg[j][1] = gp[128 * j + 1]; }
    for (int m = gw; m < M; m += NGW) {
        const u32x4* xr = (const u32x4*)(hb + (size_t)m * D) + lane; float v[2][8]; float s = 0.f;
#pragma unroll
        for (int j = 0; j < 2; ++j) { unpack8(xr[64 * j], v[j]);
#pragma unroll
            for (int e = 0; e < 8; ++e) s = fmaf(v[j][e], v[j][e], s); }
        const float rs = 1.0f / sqrtf(wave_sum(s) * (1.0f / D) + EPS);
        f32x4* orow = (f32x4*)(p.out + (size_t)m * D) + 2 * lane;
#pragma unroll
        for (int j = 0; j < 2; ++j) {
            orow[128 * j] = (f32x4){v[j][0] * rs * gg[j][0].x, v[j][1] * rs * gg[j][0].y, v[j][2] * rs * gg[j][0].z, v[j][3] * rs * gg[j][0].w};
            orow[128 * j + 1] = (f32x4){v[j][4] * rs * gg[j][1].x, v[j][5] * rs * gg[j][1].y, v[j][6] * rs * gg[j][1].z, v[j][7] * rs * gg[j][1].w}; }
    }
}


__device__ __forceinline__ void mixer_phase(const Params& p_, LAS unsigned char* lds, int G, int l) {
    const Params p = launder(p_);
    int tid_ = threadIdx.x; asm volatile("" : "+v"(tid_));
    const int tid = tid_, lane = tid & 63, wid = __builtin_amdgcn_readfirstlane(tid >> 6), fr = lane & 15, fq = lane >> 4;
    LAS float* cst = (LAS float*)(lds + LDS_CST);
    const bf16* proj = (const bf16*)(p.ws + WS_PROJ);
    const bf16* Wr = (const bf16*)(p.ws + WS_GR) + (size_t)(l * 8 + wid) * 4096; const bf16* Wi = (const bf16*)(p.ws + WS_GI) + (size_t)(l * 8 + wid) * 4096;
    LAS float* segA = (LAS float*)(lds + LDS_CST); LAS float* segH = (LAS float*)(lds + LDS_CST + 8192); LAS float* carr = (LAS float*)(lds + LDS_CARR);
    LAS float* red1 = (LAS float*)(lds + LDS_RED1); LAS float* red2 = (LAS float*)(lds + LDS_RED2);
    bf16* Y = (bf16*)(p.ws + WS_Y);
    const int g = wid >> 1, half = wid & 1, kwin = 2 << g;
    const bf16* Wp = (const bf16*)(p.ws + WS_POOLW) + (size_t)(l * 4 + g) * 16384;
    const float* pbias = p.in[5] + l * DH; const float* pscale = p.in[6] + l * DH;
    unsigned* flags = (unsigned*)(p.ws + WS_FLAG);
    bf16* hl = (bf16*)(p.ws + WS_HL); bf16* Pp = (bf16*)(p.ws + WS_P);
    float* carA = (float*)(p.ws + WS_CARA); float* carH = (float*)(p.ws + WS_CARH);
    const int unit = blockIdx.x;
    if (unit < 256) {
        const int b = unit >> 7, c = unit & 127, t0 = c ? NMETA + 64 * c : 0, NM = c ? 4 : 5;
        __syncthreads();
        for (int i = tid; i < 8 * DH; i += 512) { const int row = i >> 9, ch = i & 511; float v;
            if (row < 4) v = p.in[7][(l * 4 + row) * DH + ch]; else if (row == 4) v = p.in[8][l * DH + ch]; else if (row == 5) v = p.in[10][l * DH + ch];
            else if (row == 6) v = p.in[12][l * DH + ch]; else v = ((const float*)(p.ws + WS_SP))[l * DH + ch];
            cst[i] = v; }
        __syncthreads();
        bf16x8 wfr[4][2][2];
#pragma unroll
        for (int n = 0; n < 4; ++n)
#pragma unroll
            for (int ks = 0; ks < 2; ++ks) { wfr[n][ks][0] = *(const bf16x8*)(Wr + outchan(n, fr) * 64 + 32 * ks + 8 * fq); wfr[n][ks][1] = *(const bf16x8*)(Wi + outchan(n, fr) * 64 + 32 * ks + 8 * fq); }
        LAS float* cslot = (LAS float*)(lds + LDS_CARRY) + (wid * 4 + fq) * 32;
        if (fr == 15) {
#pragma unroll
            for (int k4 = 0; k4 < 4; ++k4) { *(LAS f32x4*)(cslot + 4 * k4) = (f32x4){0.f, 0.f, 0.f, 0.f}; *(LAS f32x4*)(cslot + 16 + 4 * k4) = (f32x4){1.f, 1.f, 1.f, 1.f}; } }
        u32x4 raw[2][4];
#pragma unroll
        for (int ks = 0; ks < 2; ++ks)
#pragma unroll
            for (int d = 0; d < 4; ++d) { const int tt = t0 + fr - 3 + d; raw[ks][d] = (u32x4){0u, 0u, 0u, 0u};
                if (tt >= 0) raw[ks][d] = *(const u32x4*)(proj + ((size_t)b * TT + tt) * DIN + DH + wid * 64 + 32 * ks + 8 * fq); }
#pragma unroll 1
        for (int m = 0; m < NM; ++m) {
            const int t = t0 + 16 * m + fr; const size_t rowg = (size_t)b * TT + t;
            u32x4 nraw[2][4];
#pragma unroll
            for (int ks = 0; ks < 2; ++ks)
#pragma unroll
                for (int d = 0; d < 4; ++d) { nraw[ks][d] = (u32x4){0u, 0u, 0u, 0u};
                    if (m + 1 < NM) nraw[ks][d] = *(const u32x4*)(proj + ((size_t)b * TT + t + 13 + d) * DIN + DH + wid * 64 + 32 * ks + 8 * fq); }
            float xc[2][8]; bf16x8 frag[2];
#pragma unroll
            for (int ks = 0; ks < 2; ++ks) {
                const int chb = wid * 64 + 32 * ks + 8 * fq;
                { const f32x4 c0 = *(const LAS f32x4*)(cst + 4 * DH + chb), c1 = *(const LAS f32x4*)(cst + 4 * DH + chb + 4);
                  xc[ks][0] = c0.x; xc[ks][1] = c0.y; xc[ks][2] = c0.z; xc[ks][3] = c0.w; xc[ks][4] = c1.x; xc[ks][5] = c1.y; xc[ks][6] = c1.z; xc[ks][7] = c1.w; }
#pragma unroll
                for (int d = 0; d < 4; ++d) {
                    float u[8]; unpack8(raw[ks][d], u);
                    const f32x4 w0 = *(const LAS f32x4*)(cst + d * DH + chb), w1 = *(const LAS f32x4*)(cst + d * DH + chb + 4);
                    xc[ks][0] += u[0] * w0.x; xc[ks][1] += u[1] * w0.y; xc[ks][2] += u[2] * w0.z; xc[ks][3] += u[3] * w0.w;
                    xc[ks][4] += u[4] * w1.x; xc[ks][5] += u[5] * w1.y; xc[ks][6] += u[6] * w1.z; xc[ks][7] += u[7] * w1.w;
                    raw[ks][d] = nraw[ks][d];
                }
                frag[ks] = __builtin_bit_cast(bf16x8, pack8(xc[ks]));
            }
            f32x4 ar[4], ai[4];
#pragma unroll
            for (int n = 0; n < 4; ++n) { ar[n] = (f32x4){0.f, 0.f, 0.f, 0.f}; ai[n] = (f32x4){0.f, 0.f, 0.f, 0.f};
#pragma unroll
                for (int ks = 0; ks < 2; ++ks) {
                    const bf16x8 wr_ = wfr[n][ks][0], wi_ = wfr[n][ks][1];
                    ar[n] = __builtin_amdgcn_mfma_f32_16x16x32_bf16(wr_, frag[ks], ar[n], 0, 0, 0);
                    ai[n] = __builtin_amdgcn_mfma_f32_16x16x32_bf16(wi_, frag[ks], ai[n], 0, 0, 0);
                } }
            float Aa[16], Bb[16];
#pragma unroll
            for (int n = 0; n < 4; ++n) {
                const int cho = wid * 64 + 32 * (n >> 1) + 8 * fq + 4 * (n & 1);
                const f32x4 rb = *(const LAS f32x4*)(cst + 5 * DH + cho), ib = *(const LAS f32x4*)(cst + 6 * DH + cho), spv = *(const LAS f32x4*)(cst + 7 * DH + cho);
#pragma unroll
                for (int jj = 0; jj < 4; ++jj) {
                    const float r = sigm(ar[n][jj] + rb[jj]), ig = sigm(ai[n][jj] + ib[jj]);
                    const float la = -8.0f * r * spv[jj], a = __expf(la), x2 = 2.0f * la;
                    const float m2s = -x2 * (1.0f + x2 * (0.5f + x2 * (0.16666667f + x2 * 0.041666668f))), m2 = (x2 > -0.0625f) ? m2s : 1.0f - a * a;
                    Aa[n * 4 + jj] = a; Bb[n * 4 + jj] = __builtin_amdgcn_sqrtf(m2) * ig * xc[n >> 1][4 * (n & 1) + jj];
                }
            }
#pragma unroll
            for (int k = 0; k < 16; ++k) {
                float A = Aa[k], B = Bb[k], Ap, Bq;
                Ap = dppf<0x111>(1.f, A); Bq = dppf<0x111>(0.f, B); B = fmaf(A, Bq, B); A *= Ap;
                Ap = dppf<0x112>(1.f, A); Bq = dppf<0x112>(0.f, B); B = fmaf(A, Bq, B); A *= Ap;
                Ap = dppf<0x114>(1.f, A); Bq = dppf<0x114>(0.f, B); B = fmaf(A, Bq, B); A *= Ap;
                Ap = dppf<0x118>(1.f, A); Bq = dppf<0x118>(0.f, B); B = fmaf(A, Bq, B); A *= Ap;
                Bb[k] = B; Aa[k] = A;
            }
            {
                float Hc[16], Pc[16];
#pragma unroll
                for (int k4 = 0; k4 < 4; ++k4) { const f32x4 hq = *(const LAS f32x4*)(cslot + 4 * k4), pq = *(const LAS f32x4*)(cslot + 16 + 4 * k4);
                    Hc[4 * k4] = hq.x; Hc[4 * k4 + 1] = hq.y; Hc[4 * k4 + 2] = hq.z; Hc[4 * k4 + 3] = hq.w; Pc[4 * k4] = pq.x; Pc[4 * k4 + 1] = pq.y; Pc[4 * k4 + 2] = pq.z; Pc[4 * k4 + 3] = pq.w; }
#pragma unroll
                for (int k = 0; k < 16; ++k) { Bb[k] = fmaf(Aa[k], Hc[k], Bb[k]); Aa[k] *= Pc[k]; }
                if (fr == 15) {
#pragma unroll
                    for (int k4 = 0; k4 < 4; ++k4) { *(LAS f32x4*)(cslot + 4 * k4) = (f32x4){Bb[4 * k4], Bb[4 * k4 + 1], Bb[4 * k4 + 2], Bb[4 * k4 + 3]}; *(LAS f32x4*)(cslot + 16 + 4 * k4) = (f32x4){Aa[4 * k4], Aa[4 * k4 + 1], Aa[4 * k4 + 2], Aa[4 * k4 + 3]}; } }
            }
#pragma unroll
            for (int ks = 0; ks < 2; ++ks) {
                const size_t o = rowg * DH + wid * 64 + 32 * ks + 8 * fq;
                u32x4 wh; wh.x = cvt_pk(Bb[8 * ks + 0], Bb[8 * ks + 1]); wh.y = cvt_pk(Bb[8 * ks + 2], Bb[8 * ks + 3]); wh.z = cvt_pk(Bb[8 * ks + 4], Bb[8 * ks + 5]); wh.w = cvt_pk(Bb[8 * ks + 6], Bb[8 * ks + 7]);
                u32x4 w; w.x = cvt_pk(Aa[8 * ks + 0], Aa[8 * ks + 1]); w.y = cvt_pk(Aa[8 * ks + 2], Aa[8 * ks + 3]); w.z = cvt_pk(Aa[8 * ks + 4], Aa[8 * ks + 5]); w.w = cvt_pk(Aa[8 * ks + 6], Aa[8 * ks + 7]);
                if (m < 4) { *(LAS u32x4*)(lds + LDS_HL + wid * 8192 + ((m * 2 + ks) * 64 + lane) * 16) = wh; *(LAS u32x4*)(lds + LDS_P + wid * 8192 + ((m * 2 + ks) * 64 + lane) * 16) = w; }
                else { *(u32x4*)(hl + o) = wh; *(u32x4*)(Pp + o) = w; }
            }
        }
        if (fr == 0) {
            float Hc[16], Pc[16];
#pragma unroll
            for (int k4 = 0; k4 < 4; ++k4) { const f32x4 hq = *(const LAS f32x4*)(cslot + 4 * k4), pq = *(const LAS f32x4*)(cslot + 16 + 4 * k4);
                Hc[4 * k4] = hq.x; Hc[4 * k4 + 1] = hq.y; Hc[4 * k4 + 2] = hq.z; Hc[4 * k4 + 3] = hq.w; Pc[4 * k4] = pq.x; Pc[4 * k4 + 1] = pq.y; Pc[4 * k4 + 2] = pq.z; Pc[4 * k4 + 3] = pq.w; }
#pragma unroll
            for (int ks = 0; ks < 2; ++ks) {
                const size_t o = (size_t)(b * 128 + c) * DH + wid * 64 + 32 * ks + 8 * fq;
#pragma unroll
                for (int e2 = 0; e2 < 4; ++e2) {
                    __hip_atomic_store((unsigned long long*)(carA + o) + e2, ((unsigned long long)__float_as_uint(Pc[8 * ks + 2 * e2 + 1]) << 32) | __float_as_uint(Pc[8 * ks + 2 * e2]), __ATOMIC_RELAXED, __HIP_MEMORY_SCOPE_AGENT);
                    __hip_atomic_store((unsigned long long*)(carH + o) + e2, ((unsigned long long)__float_as_uint(Hc[8 * ks + 2 * e2 + 1]) << 32) | __float_as_uint(Hc[8 * ks + 2 * e2]), __ATOMIC_RELAXED, __HIP_MEMORY_SCOPE_AGENT); }
            }
        }
        asm volatile("s_waitcnt vmcnt(0)" ::: "memory");
        __syncthreads();
        if (tid == 0) __hip_atomic_store(flags + unit, (unsigned)(l + 1), __ATOMIC_RELAXED, __HIP_MEMORY_SCOPE_AGENT);
        int fr2 = fr, fq2 = fq, tid2 = tid; asm volatile("" : "+v"(fr2), "+v"(fq2), "+v"(tid2));
#ifndef NO_MX_POOL
        m2_pool_round<4>(proj, Y, Wp, pbias, pscale, red2, b, t0, 0, g, half, kwin, wid, fr2, fq2);
        if (NM == 5) m2_pool_round<1>(proj, Y, Wp, pbias, pscale, red2, b, t0, 4, g, half, kwin, wid, fr2, fq2);
#endif
        if (tid2 < c) { unsigned sp = 0; while (__hip_atomic_load(flags + b * 128 + tid2, __ATOMIC_RELAXED, __HIP_MEMORY_SCOPE_AGENT) < (unsigned)(l + 1)) { __builtin_amdgcn_s_sleep(2); if (++sp > (1u << 22)) break; } }
        if (tid2 < c) __builtin_amdgcn_fence(__ATOMIC_ACQUIRE, "agent");
        __syncthreads();
        {
            const int q = (c + 3) >> 2, seg = tid2 >> 7, cgi = tid2 & 127, jlo = seg * q, jhi = (jlo + q < c) ? jlo + q : c;
            f32x4 A0 = {1.f, 1.f, 1.f, 1.f}, H0 = {0.f, 0.f, 0.f, 0.f};
            for (int j = jlo; j < jhi; j += 8) {
                f32x4 a0[8], h0[8];
#pragma unroll
                for (int i = 0; i < 8; ++i) { const int jj = (j + i < jhi) ? j + i : jhi - 1; const size_t o = (size_t)(b * 128 + jj) * DH + 4 * cgi; const unsigned long long al = __hip_atomic_load((const unsigned long long*)(carA + o), __ATOMIC_RELAXED, __HIP_MEMORY_SCOPE_AGENT), ah = __hip_atomic_load((const unsigned long long*)(carA + o) + 1, __ATOMIC_RELAXED, __HIP_MEMORY_SCOPE_AGENT);
                    const unsigned long long hl_ = __hip_atomic_load((const unsigned long long*)(carH + o), __ATOMIC_RELAXED, __HIP_MEMORY_SCOPE_AGENT), hh_ = __hip_atomic_load((const unsigned long long*)(carH + o) + 1, __ATOMIC_RELAXED, __HIP_MEMORY_SCOPE_AGENT);
                    a0[i] = (f32x4){__uint_as_float((unsigned)al), __uint_as_float((unsigned)(al >> 32)), __uint_as_float((unsigned)ah), __uint_as_float((unsigned)(ah >> 32))};
                    h0[i] = (f32x4){__uint_as_float((unsigned)hl_), __uint_as_float((unsigned)(hl_ >> 32)), __uint_as_float((unsigned)hh_), __uint_as_float((unsigned)(hh_ >> 32))}; }
#pragma unroll
                for (int i = 0; i < 8; ++i) if (j + i < jhi) { H0 = a0[i] * H0 + h0[i]; A0 = A0 * a0[i]; }
            }
            *(LAS f32x4*)(segA + seg * DH + 4 * cgi) = A0; *(LAS f32x4*)(segH + seg * DH + 4 * cgi) = H0;
        }
        __syncthreads();
        { float cy = 0.f;
#pragma unroll
          for (int s4 = 0; s4 < 4; ++s4) cy = segA[s4 * DH + tid2] * cy + segH[s4 * DH + tid2];
          carr[tid2] = cy; }
        __syncthreads();
        {
            float cr[16];
#pragma unroll
            for (int ks = 0; ks < 2; ++ks) { const f32x4 c0 = *(const LAS f32x4*)(carr + wid * 64 + 32 * ks + 8 * fq2), c1 = *(const LAS f32x4*)(carr + wid * 64 + 32 * ks + 8 * fq2 + 4);
                cr[8 * ks + 0] = c0.x; cr[8 * ks + 1] = c0.y; cr[8 * ks + 2] = c0.z; cr[8 * ks + 3] = c0.w; cr[8 * ks + 4] = c1.x; cr[8 * ks + 5] = c1.y; cr[8 * ks + 6] = c1.z; cr[8 * ks + 7] = c1.w; }
#ifndef NO_MX_RNN
            m2_rnn_round<4, true>(lds, hl, Pp, proj, Y, red1, cr, b, t0, 0, wid, fr2, fq2);
            if (NM == 5) m2_rnn_round<1, false>(lds, hl, Pp, proj, Y, red1, cr, b, t0, 4, wid, fr2, fq2);
#endif
        }
    }
    __syncthreads();
}

#define XB_TMO      128
#define XB_XCNT(j)  (256  + 64 * (j))
#define XB_XSUB(j)  (1280 + 64 * (j))
#define XB_XGEN(j)  (2304 + 64 * (j))
#define XB_TOP      3328
#define XB_TOPGEN   3392
#define XCD_BAR_WORDS 3456
#define XB_SPIN_CAP (1u << 18)

__device__ __forceinline__ unsigned xb_ld(unsigned* p)              { return __hip_atomic_load(p, __ATOMIC_RELAXED, __HIP_MEMORY_SCOPE_AGENT); }
__device__ __forceinline__ unsigned xb_add(unsigned* p, unsigned v) { return __hip_atomic_fetch_add(p, v, __ATOMIC_RELAXED, __HIP_MEMORY_SCOPE_AGENT); }
__device__ __forceinline__ unsigned xb_xcc_id() { return (unsigned)__builtin_amdgcn_s_getreg((3 << 11) | 20) & 0xFu; }
#define XB_SPIN(cond, bar) do { unsigned _sp = 0; while (cond) { __builtin_amdgcn_s_sleep(1); \
    if ((++_sp & 255u) == 0u) { if (xb_ld(&(bar)[XB_TMO])) break; if (_sp > XB_SPIN_CAP) { atomicAdd(&(bar)[XB_TMO], 1u); break; } } } } while (0)

struct XcdBarrier {
    unsigned* bar; unsigned x;
    volatile LAS unsigned* st;
};

__device__ __forceinline__ XcdBarrier xcd_barrier_post(unsigned* bar, volatile LAS unsigned* st) {
    XcdBarrier b; b.bar = bar; b.x = xb_xcc_id(); b.st = st;
    if (threadIdx.x == 0) (void)xb_add(&bar[XB_XCNT(b.x)], 1u);
    return b;
}
__device__ __forceinline__ void xcd_barrier_complete(unsigned* bar, unsigned x, unsigned& nloc, unsigned& nx) {
    const unsigned G = gridDim.x * gridDim.y * gridDim.z;
    unsigned sum, cnt, mine, sp = 0u;
    for (;;) {
        sum = 0u; cnt = 0u; mine = 0u;
#pragma unroll
        for (unsigned j = 0; j < 16; ++j) { const unsigned c = xb_ld(&bar[XB_XCNT(j)]); sum += c; cnt += (c > 0u) ? 1u : 0u; mine = (j == x) ? c : mine; }
        if (sum == G) break;
        __builtin_amdgcn_s_sleep(1);
        if ((++sp & 255u) == 0u) { if (xb_ld(&bar[XB_TMO])) break; if (sp > XB_SPIN_CAP) { atomicAdd(&bar[XB_TMO], 1u); break; } }
    }
    nloc = mine > 0u ? mine : 1u; nx = cnt > 0u ? cnt : 1u;
}

__device__ __forceinline__ void xcd_barrier(const XcdBarrier& b) {
    asm volatile("s_waitcnt vmcnt(0)" ::: "memory");
    __syncthreads();
    if (threadIdx.x == 0) {
        unsigned* bar = b.bar;
        __builtin_amdgcn_s_waitcnt(0);
        unsigned nloc = b.st[0], nx = b.st[1];
        if (nloc == 0u) { xcd_barrier_complete(bar, b.x, nloc, nx); b.st[0] = nloc; b.st[1] = nx; }
        const unsigned old = xb_add(&bar[XB_XSUB(b.x)], 1u);
        const unsigned gen = old / nloc;
        if (old + 1u == (gen + 1u) * nloc) {
            __builtin_amdgcn_fence(__ATOMIC_RELEASE, "agent");
            asm volatile("s_waitcnt vmcnt(0)" ::: "memory");
            const unsigned og = xb_add(&bar[XB_TOP], 1u);
            const unsigned tg = og / nx;
            if (og + 1u == (tg + 1u) * nx) xb_add(&bar[XB_TOPGEN], 1u);
            else XB_SPIN(xb_ld(&bar[XB_TOPGEN]) == tg, bar);
            __builtin_amdgcn_fence(__ATOMIC_ACQUIRE, "agent");
            xb_add(&bar[XB_XGEN(b.x)], 1u);
            asm volatile("s_waitcnt vmcnt(0)" ::: "memory");
        } else {
            XB_SPIN(xb_ld(&bar[XB_XGEN(b.x)]) == gen, bar);
            __builtin_amdgcn_fence(__ATOMIC_ACQUIRE, "agent");
            asm volatile("s_waitcnt vmcnt(0)" ::: "memory");
        }
    }
    __syncthreads();
}

#ifndef PROBE_SYNC2
#define PROBE_SYNC2 0
#endif
#ifndef PROBE_M1X2
#define PROBE_M1X2 0
#endif
#ifndef PROBE_M2X2
#define PROBE_M2X2 0
#endif
#define GSYNC() do { { __attribute__((address_space(1))) unsigned* gb_ = (__attribute__((address_space(1))) unsigned*)xbar.bar; asm volatile("" : "+s"(gb_)); xbar.bar = (unsigned*)gb_; asm volatile("" : "+s"(xbar.x)); } xcd_barrier(xbar); if (PROBE_SYNC2) xcd_barrier(xbar); } while (0)
__device__ __forceinline__ int rstd_cache(LAS unsigned char* lds, const float* ss, const pg8::StaticOrder& S) {
    pg8::Unit u0; int pmc = -1;
    int tid = threadIdx.x; asm volatile("" : "+v"(tid));
    if (S.next(0, u0)) { pmc = u0.pm; if (tid < 256) ((LAS float*)(lds + 131072))[tid] = row_rstd(ss, u0.pm * 256 + tid); }
    __syncthreads();
    return pmc;
}
#ifndef PROBE_PHASE
#define PROBE_PHASE (-1)
#endif
#define TIC() do { if (PROBE_PHASE >= 0) tic = __builtin_amdgcn_s_memrealtime(); } while (0)
#define TOC(k) do { if (PROBE_PHASE == (k)) tacc += __builtin_amdgcn_s_memrealtime() - tic; } while (0)
__global__ void __launch_bounds__(512, 2) fwd_megakernel(Params p) {
    extern __shared__ __attribute__((aligned(16))) unsigned char lds_raw[];
    LAS unsigned char* lds = (LAS unsigned char*)lds_raw;
    cg::grid_group grid = cg::this_grid();
    const int G = gridDim.x;
    unsigned long long tic = 0, tacc = 0;
    unsigned char* ws = p.ws;
    volatile LAS unsigned* xst = (volatile LAS unsigned*)(lds + LDS_XST);
    if (threadIdx.x < 2) xst[threadIdx.x] = 0u;
    __syncthreads();
    XcdBarrier xbar = xcd_barrier_post((unsigned*)(ws + WS_CTL), xst);
    bf16* hb = (bf16*)(ws + WS_HB); bf16* proj = (bf16*)(ws + WS_PROJ); bf16* Y = (bf16*)(ws + WS_Y); bf16* mid = (bf16*)(ws + WS_MID); float* ss = (float*)(ws + WS_SS);
    grid.sync();
    TIC();
#ifndef NO_PRO
    prologue(p, lds, G);
#endif
    GSYNC();
    TOC(0);
#pragma unroll 1
    for (int l = 0; l < DEPTH; ++l) {
        { __attribute__((address_space(1))) unsigned char* gws = (__attribute__((address_space(1))) unsigned char*)ws; asm volatile("" : "+s"(gws)); ws = (unsigned char*)gws; }
        const unsigned char* wl = ws + WS_W + (size_t)l * W_LAYER;
        const bf16* in_t = (const bf16*)(wl + W_IN); const bf16* out_t = (const bf16*)(wl + W_OUT); const bf16* up_t = (const bf16*)(wl + W_UP); const bf16* down_t = (const bf16*)(wl + W_DOWN);
        TIC();
#ifndef NO_GIN
        { pg8::Gemm g{hb, in_t, M, DIN, D, 0}; pg8::StaticOrder S; S.init(M, DIN, G, (int)blockIdx.x); const int pmc = rstd_cache(lds, ss, S); EpiIn E{proj, ss, (const LAS float*)(lds + 131072), pmc};
          pg8::gemm_phase<EpiIn, pg8::StaticOrder, true, true>(lds, g, S, E); }
#endif
#ifndef NO_META
        meta_tasks<0>(p, lds, G, nullptr, 0, in_t, D, DIN / 16);
#endif
        GSYNC();
        TOC(1); TIC();
#ifndef FUSED_MIXER
#define FUSED_MIXER 1
#endif
#if FUSED_MIXER
        mixer_phase(p, lds, G, l);
        GSYNC();
        TOC(2);
#else
        m1_phase(p, lds, G, l);
        GSYNC();
        TOC(2); TIC();
        m2_phase(p, lds, G, l);
        GSYNC();
#endif
        TOC(3); TIC();
#ifndef NO_GOUT
        { pg8::Gemm g{Y, out_t, M, D, D, NMETA}; pg8::StaticOrder S; S.init(M, D, G, (int)blockIdx.x); EpiRes E{hb, ss};
          pg8::gemm_phase<EpiRes, pg8::StaticOrder, false, true>(lds, g, S, E); }
#endif
#ifndef NO_META
        if (l < DEPTH - 1) meta_tasks<1>(p, lds, G, Y, D, out_t, D, D / 16);
#endif
        GSYNC();
        TOC(4); TIC();
#ifndef NO_GUP
        { pg8::Gemm g{hb, up_t, M, FF, D, 0}; pg8::StaticOrder S; S.init(M, FF, G, (int)blockIdx.x); const int pmc = rstd_cache(lds, ss, S); EpiUp E{mid, ss, (const LAS float*)(lds + 131072), pmc};
          pg8::gemm_phase<EpiUp, pg8::StaticOrder, true, true>(lds, g, S, E); }
#endif
#ifndef NO_META
        if (l < DEPTH - 1) meta_tasks<2>(p, lds, G, nullptr, 0, up_t, D, FF / 16);
#endif
        GSYNC();
        TOC(5); TIC();
#ifndef NO_GDN
        { pg8::Gemm g{mid, down_t, M, D, FF, 0}; pg8::StaticOrder S; S.init(M, D, G, (int)blockIdx.x); EpiRes E{hb, ss};
          pg8::gemm_phase<EpiRes, pg8::StaticOrder, false, true>(lds, g, S, E); }
#endif
#ifndef NO_META
        if (l < DEPTH - 1) meta_tasks<1>(p, lds, G, (const bf16*)(ws + WS_MIDMETA), FF, down_t, FF, D / 16);
#endif
        GSYNC();
        TOC(6);
    }
    TIC();
    final_norm(p, G);
    TOC(7);
    if (PROBE_PHASE >= 0 && blockIdx.x == 0 && threadIdx.x == 0) { const unsigned long long w0 = __builtin_amdgcn_s_memrealtime(); while (__builtin_amdgcn_s_memrealtime() - w0 < 4ull * tacc) __builtin_amdgcn_s_sleep(8); }
}

extern "C" void kernel_launch(void* const* d_in, const int* in_sizes, int n_in, void* d_out, int out_size, void* d_ws, size_t ws_size, hipStream_t stream) {
    static int grid = 0;
    if (grid == 0) {
        if (n_in != 20 || in_sizes[0] != M * D || out_size != M * D || ws_size < WS_END) { fprintf(stderr, "kernel_launch: unexpected shapes (n_in %d, in0 %d, out %d, ws %zu)\n", n_in, n_in > 0 ? in_sizes[0] : -1, out_size, ws_size); grid = -1; return; }
        int dev = 0, cus = 0, per_cu = 0;
        if (hipGetDevice(&dev) != hipSuccess || hipDeviceGetAttribute(&cus, hipDeviceAttributeMultiprocessorCount, dev) != hipSuccess) { grid = -1; return; }
        if (hipFuncSetAttribute((const void*)fwd_megakernel, hipFuncAttributeMaxDynamicSharedMemorySize, LDS_BYTES) != hipSuccess) { fprintf(stderr, "kernel_launch: hipFuncSetAttribute failed\n"); grid = -1; return; }
        if (hipOccupancyMaxActiveBlocksPerMultiprocessor(&per_cu, (const void*)fwd_megakernel, 512, LDS_BYTES) != hipSuccess || per_cu < 1) { fprintf(stderr, "kernel_launch: occupancy query gave %d\n", per_cu); (void)hipGetLastError(); grid = -1; return; }
        grid = cus * 1;
        if (grid < 256) { fprintf(stderr, "kernel_launch: %d CUs; the fused mixer phase needs 256 resident workgroups\n", cus); grid = -1; return; }
    }
    if (grid < 0) return;
    if (hipMemsetAsync((char*)d_ws + WS_CTL, 0, WS_FLAG + 256 * 4, stream) != hipSuccess) { fprintf(stderr, "kernel_launch: memset failed\n"); return; }
    Params p{};
    for (int i = 0; i < 20; ++i) p.in[i] = (const float*)d_in[i];
    p.out = (float*)d_out; p.ws = (unsigned char*)d_ws;
    void* args[] = {&p};
    hipError_t e = hipLaunchCooperativeKernel((const void*)fwd_megakernel, dim3(grid), dim3(512), args, LDS_BYTES, stream);
    if (e != hipSuccess) fprintf(stderr, "cooperative launch failed: %s (grid %d)\n", hipGetErrorString(e), grid);
}
```

```cpp
#include <hip/hip_runtime.h>
#include <hip/hip_cooperative_groups.h>
#include <cstdio>
#include <cstdint>
namespace cg = cooperative_groups;
namespace pg8 {
#define PG8_LAS __attribute__((address_space(3)))
typedef unsigned short bf16_t;
typedef short bf16x8 __attribute__((ext_vector_type(8)));
typedef float f32x4 __attribute__((ext_vector_type(4)));
typedef unsigned u32x4 __attribute__((ext_vector_type(4)));
constexpr int BM = 256, BK = 64, HALF = 128, HTB = HALF * BK * 2  , STAGE_BYTES = 8 * HTB, NXCD = 8, WGM = 8;

__host__ __device__ __forceinline__ int lds_byte(int r, int c) { const int st = (r >> 4) * 2 + (c >> 5), rr = r & 15, cc = c & 31, ob = rr * 64 + cc * 2; return st * 1024 + (ob ^ (((ob >> 9) & 1) << 5)); }
__host__ __device__ __forceinline__ void stage_rc(int b, int& R, int& C) { const int st = b / 1024, sb = b % 1024, swz = sb ^ (((sb >> 9) & 1) << 5); R = (st >> 1) * 16 + swz / 64; C = (st & 1) * 32 + (swz % 64) / 2; }
__host__ __device__ __forceinline__ int perm32(int rho) { const int n = rho >> 4, i = rho & 15; return 8 * (i >> 2) + 4 * n + (i & 3); }

struct Unit { int pm, pn; };
struct Gemm { const bf16_t* A; const bf16_t* Bt; int M, N, K, gap; };

struct StaticOrder {
    int nM, nN, nwg, G, c;
    __host__ __device__ void init(int M, int N, int G_, int c_) { nM = M / BM; nN = N / BM; nwg = nM * nN; G = G_; c = c_; }
    __host__ __device__ bool next(int i, Unit& u) const {
        const long L = (long)i * G + c; if (L >= nwg) return false;
        int wgid = (int)L; { const int q = nwg / NXCD, r = nwg % NXCD, xcd = wgid % NXCD, off = wgid / NXCD; wgid = (xcd < r ? xcd * (q + 1) : r * (q + 1) + (xcd - r) * q) + off; }
        const int nig = WGM * nN, gid = wgid / nig, fm = gid * WGM, gsz = (nM - fm) < WGM ? (nM - fm) : WGM;
        u.pm = fm + ((wgid % nig) % gsz); u.pn = (wgid % nig) / gsz; return true;
    }
    __device__ __forceinline__ void a_ready(const Unit&) const {}
    __device__ __forceinline__ void done(const Unit&) const {}
};
__device__ __forceinline__ unsigned cvt_pk_bf16(float lo, float hi) { unsigned r; asm volatile("v_cvt_pk_bf16_f32 %0, %1, %2" : "=v"(r) : "v"(lo), "v"(hi)); return r; }
template <class Epi, class Sched, bool ALIGN_EPI = false, bool SP2 = false>
__device__ __forceinline__ void gemm_phase(PG8_LAS unsigned char* lds, const Gemm g, const Sched& S, const Epi& E) {
    int tid_ = threadIdx.x; asm volatile("" : "+v"(tid_));
    const int tid = tid_, wid = __builtin_amdgcn_readfirstlane(tid >> 6), lane = tid & 63, wr = wid >> 2, wc = wid & 3, fr = lane & 15, fq = lane >> 4;
    const int K = g.K, nt = K / BK;
    unsigned voffA[2], voffB[2];
#pragma unroll
    for (int i = 0; i < 2; ++i) { int R, C; stage_rc(tid * 16 + i * 8192, R, C); const int Rb = Epi::PERM ? ((R & ~31) + perm32(R & 31)) : R;
        voffA[i] = (unsigned)(R * K + C) * 2u; voffB[i] = (unsigned)(Rb * K + C) * 2u; }
    const size_t kstep = (size_t)(BK * 2);
    const size_t hstep = (size_t)HALF * K * 2;
    const size_t tstep = 2 * hstep;
    const int agap = g.gap;
#define a_off(pm_) ((size_t)((pm_) * BM + agap * (1 + ((pm_) >> 5))) * (size_t)K * 2)
    const unsigned ldsw = (unsigned)wid * 1024u;
    const int aoff = lds_byte(wr * 64 + fr, fq * 8), boff = lds_byte(wc * 32 + fr, fq * 8);
#define PG8_SA(b, h) (((b) * 2 + (h)) * HTB)
#define PG8_SB(b, h) ((4 + (b) * 2 + (h)) * HTB)
#define PG8_STAGE(bufoff, gbase, voff) do { _Pragma("unroll") for (int _i = 0; _i < 2; ++_i) \
        __builtin_amdgcn_global_load_lds((const unsigned*)((const char*)(gbase) + (voff)[_i]), (PG8_LAS unsigned*)(lds + (bufoff) + ldsw + _i * 8192), 16, 0, 0); } while (0)
#define PG8_LDA(dst, b, h) do { _Pragma("unroll") for (int m = 0; m < 4; ++m) _Pragma("unroll") for (int k = 0; k < 2; ++k) dst[m][k] = *(const PG8_LAS bf16x8*)(lds + PG8_SA(b, h) + aoff + m * 2048 + k * 1024); } while (0)
#define PG8_LDB(dst, b, h) do { _Pragma("unroll") for (int n = 0; n < 2; ++n) _Pragma("unroll") for (int k = 0; k < 2; ++k) dst[n][k] = *(const PG8_LAS bf16x8*)(lds + PG8_SB(b, h) + boff + n * 2048 + k * 1024); } while (0)
#define PG8_MMA(ai, bj, At, Bt) do { __builtin_amdgcn_s_setprio(1); _Pragma("unroll") for (int m = 0; m < 4; ++m) _Pragma("unroll") for (int n = 0; n < 2; ++n) _Pragma("unroll") for (int k = 0; k < 2; ++k) \
        acc[ai][bj][m][n] = __builtin_amdgcn_mfma_f32_16x16x32_bf16(Bt[n][k], At[m][k], acc[ai][bj][m][n], 0, 0, 0); __builtin_amdgcn_s_setprio(0); } while (0)
#define PG8_WAIT_V(n) asm volatile("s_waitcnt vmcnt(" #n ")" ::: "memory")
#define PG8_WAIT_L(n) asm volatile("s_waitcnt lgkmcnt(" #n ")" ::: "memory")
#define PG8_BAR __builtin_amdgcn_s_barrier()
#define PG8_SCHED __builtin_amdgcn_sched_barrier(0)
    Unit cur, nxt; int ui = 0;
    if (!S.next(0, cur)) return;
    f32x4 acc[2][2][4][2];
#pragma unroll
    for (int a = 0; a < 2; ++a)
#pragma unroll
        for (int b = 0; b < 2; ++b)
#pragma unroll
            for (int m = 0; m < 4; ++m)
#pragma unroll
                for (int n = 0; n < 2; ++n) acc[a][b][m][n] = (f32x4){0.f, 0.f, 0.f, 0.f};
    if constexpr (Epi::PRELOAD) E.preload(acc, cur, wr, wc, fr, fq);
    bf16x8 At[4][2], B0[2][2], B1[2][2];
    const char* cA = (const char*)g.A + a_off(cur.pm); const char* cB = (const char*)g.Bt + (size_t)cur.pn * tstep;
    S.a_ready(cur);
    if constexpr (SP2) {
        PG8_STAGE(PG8_SB(0, 0), cB, voffB); PG8_STAGE(PG8_SB(0, 1), cB + hstep, voffB); PG8_STAGE(PG8_SA(0, 0), cA, voffA); PG8_STAGE(PG8_SA(0, 1), cA + hstep, voffA);
        if (wr == 1) PG8_BAR;
        PG8_WAIT_V(2); PG8_BAR;
        PG8_STAGE(PG8_SB(1, 0), cB + kstep, voffB); PG8_STAGE(PG8_SA(1, 0), cA + kstep, voffA); PG8_STAGE(PG8_SB(1, 1), cB + hstep + kstep, voffB);
        PG8_WAIT_V(6); PG8_BAR;
    } else {
        PG8_STAGE(PG8_SB(0, 0), cB, voffB); PG8_STAGE(PG8_SA(0, 0), cA, voffA); PG8_STAGE(PG8_SB(0, 1), cB + hstep, voffB); PG8_STAGE(PG8_SA(0, 1), cA + hstep, voffA);
        if (wr == 1) PG8_BAR;
        PG8_WAIT_V(4); PG8_BAR;
        PG8_STAGE(PG8_SB(1, 0), cB + kstep, voffB); PG8_STAGE(PG8_SA(1, 0), cA + kstep, voffA); PG8_STAGE(PG8_SB(1, 1), cB + hstep + kstep, voffB);
        PG8_WAIT_V(6); PG8_BAR;
    }
    for (;;) {
        const bool has_next = S.next(ui + 1, nxt);
        const char* nA = has_next ? (const char*)g.A + a_off(nxt.pm) : cA; const char* nB = has_next ? (const char*)g.Bt + (size_t)nxt.pn * tstep : cB;
        for (int t = 0; t < nt; t += 2) {
            const bool last = (t == nt - 2);
            const char* a1 = cA + (size_t)(t + 1) * kstep;
            const char* a2 = last ? nA : cA + (size_t)(t + 2) * kstep; const char* b2 = last ? nB : cB + (size_t)(t + 2) * kstep;
            const char* a3 = a2 + kstep; const char* b3 = b2 + kstep;
            if (last && has_next) S.a_ready(nxt);
            if constexpr (SP2) {
            PG8_LDB(B0, 0, 0); PG8_LDB(B1, 0, 1); PG8_SCHED; PG8_LDA(At, 0, 0); PG8_STAGE(PG8_SA(1, 1), a1 + hstep, voffA);
            PG8_WAIT_V(8); PG8_WAIT_L(0); PG8_BAR; PG8_MMA(0, 0, At, B0); PG8_MMA(0, 1, At, B1); PG8_BAR; PG8_SCHED;
            PG8_LDA(At, 0, 1); PG8_STAGE(PG8_SB(0, 0), b2, voffB); PG8_STAGE(PG8_SB(0, 1), b2 + hstep, voffB); PG8_STAGE(PG8_SA(0, 0), a2, voffA);
            PG8_WAIT_V(8); PG8_WAIT_L(0); PG8_BAR; PG8_MMA(1, 0, At, B0); PG8_MMA(1, 1, At, B1); PG8_BAR; PG8_SCHED;
            PG8_LDB(B0, 1, 0); PG8_LDB(B1, 1, 1); PG8_SCHED; PG8_LDA(At, 1, 0); PG8_STAGE(PG8_SA(0, 1), a2 + hstep, voffA);
            PG8_WAIT_V(8); PG8_WAIT_L(0); PG8_BAR; PG8_MMA(0, 0, At, B0); PG8_MMA(0, 1, At, B1); PG8_BAR; PG8_SCHED;
            PG8_LDA(At, 1, 1); PG8_STAGE(PG8_SB(1, 0), b3, voffB); PG8_STAGE(PG8_SB(1, 1), b3 + hstep, voffB); PG8_STAGE(PG8_SA(1, 0), a3, voffA);
            PG8_WAIT_V(8); PG8_WAIT_L(0); PG8_BAR; PG8_MMA(1, 0, At, B0); PG8_MMA(1, 1, At, B1); PG8_BAR; PG8_SCHED;
            } else {
            PG8_LDB(B0, 0, 0); PG8_SCHED; PG8_LDA(At, 0, 0); PG8_STAGE(PG8_SA(1, 1), a1 + hstep, voffA);
            PG8_WAIT_L(8); PG8_BAR; PG8_WAIT_L(0); PG8_MMA(0, 0, At, B0); PG8_BAR; PG8_SCHED;
            PG8_LDB(B1, 0, 1); PG8_STAGE(PG8_SB(0, 0), b2, voffB);
            PG8_BAR; PG8_WAIT_L(0); PG8_MMA(0, 1, At, B1); PG8_BAR;
            PG8_LDA(At, 0, 1); PG8_STAGE(PG8_SA(0, 0), a2, voffA);
            PG8_BAR; PG8_WAIT_L(0); PG8_MMA(1, 0, At, B0); PG8_BAR; PG8_SCHED;
            PG8_STAGE(PG8_SB(0, 1), b2 + hstep, voffB);
            PG8_WAIT_V(6); PG8_BAR; PG8_MMA(1, 1, At, B1); PG8_BAR;
            PG8_LDB(B0, 1, 0); PG8_SCHED; PG8_LDA(At, 1, 0); PG8_STAGE(PG8_SA(0, 1), a2 + hstep, voffA);
            PG8_WAIT_L(8); PG8_BAR; PG8_WAIT_L(0); PG8_MMA(0, 0, At, B0); PG8_BAR; PG8_SCHED;
            PG8_LDB(B1, 1, 1); PG8_STAGE(PG8_SB(1, 0), b3, voffB);
            PG8_BAR; PG8_WAIT_L(0); PG8_MMA(0, 1, At, B1); PG8_BAR;
            PG8_LDA(At, 1, 1); PG8_STAGE(PG8_SA(1, 0), a3, voffA);
            PG8_BAR; PG8_WAIT_L(0); PG8_MMA(1, 0, At, B0); PG8_BAR; PG8_SCHED;
            PG8_STAGE(PG8_SB(1, 1), b3 + hstep, voffB);
            PG8_WAIT_V(6); PG8_BAR; PG8_MMA(1, 1, At, B1); PG8_BAR;
            }
        }
        if constexpr (ALIGN_EPI) { if (wr == 0) PG8_BAR; }
        if constexpr (!Epi::AFTER_DRAIN) { E(acc, cur, wr, wc, fr, fq); S.done(cur); }
        if (!has_next) break;
#pragma unroll
        for (int a = 0; a < 2; ++a)
#pragma unroll
            for (int b = 0; b < 2; ++b)
#pragma unroll
                for (int m = 0; m < 4; ++m)
#pragma unroll
                    for (int n = 0; n < 2; ++n) acc[a][b][m][n] = (f32x4){0.f, 0.f, 0.f, 0.f};
        if constexpr (Epi::PRELOAD) { E.preload(acc, nxt, wr, wc, fr, fq); PG8_WAIT_V(0); }
        cur = nxt; cA = nA; cB = nB; ++ui;
        if constexpr (ALIGN_EPI) { if (wr == 1) PG8_BAR; }
    }
    PG8_WAIT_V(0);
    if constexpr (!ALIGN_EPI) { if (wr == 0) PG8_BAR; }
    PG8_BAR;
    if constexpr (Epi::AFTER_DRAIN) { E.fused(acc, cur, wr, wc, fr, fq, lds, wid, lane); S.done(cur); }
#undef PG8_SA
#undef PG8_SB
#undef PG8_STAGE
#undef PG8_LDA
#undef PG8_LDB
#undef PG8_MMA
#undef PG8_WAIT_V
#undef PG8_WAIT_L
#undef PG8_BAR
#undef PG8_SCHED
}
}

#define LAS __attribute__((address_space(3)))
typedef unsigned short bf16;
typedef unsigned u32x4 __attribute__((ext_vector_type(4)));
typedef unsigned u32x2 __attribute__((ext_vector_type(2)));
typedef float f32x4 __attribute__((ext_vector_type(4)));
typedef short bf16x8 __attribute__((ext_vector_type(8)));
constexpr int D = 1024, SEQ = 8192, NB = 2, NMETA = 16, TT = SEQ + NMETA, M = NB * SEQ, DEPTH = 4, DIN = 1536, FF = 4096, DH = 512;
constexpr float EPS = 1e-6f;
constexpr size_t MiB = 1u << 20;
constexpr size_t WS_CTL = 0;
constexpr size_t WS_POOLW = 1 * MiB, WS_GR = WS_POOLW + 512 * 1024, WS_GI = WS_GR + 256 * 1024;
constexpr size_t WS_SP = 2 * MiB, WS_HMETA = WS_SP + 64 * 1024, WS_MIDMETA = WS_HMETA + 64 * 1024;
constexpr size_t WS_SS = 3 * MiB, WS_CARA = 4 * MiB, WS_CARH = WS_CARA + 512 * 1024;
constexpr size_t WS_W = 8 * MiB, W_LAYER = 21 * MiB, W_IN = 0, W_OUT = 3 * MiB, W_UP = 5 * MiB, W_DOWN = 13 * MiB;
constexpr size_t WS_HB = 92 * MiB, WS_MID = 124 * MiB;
constexpr size_t WS_PROJ = WS_MID, WS_Y = WS_MID + 48 * MiB + 256 * 1024, WS_HL = WS_Y + 32 * MiB + 256 * 1024, WS_P = WS_HL + 32 * MiB + 256 * 1024, WS_END = 256 * MiB;
static_assert(WS_PROJ + (size_t)NB * TT * DIN * 2 <= WS_Y && WS_Y + (size_t)NB * TT * D * 2 <= WS_HL && WS_HL + (size_t)NB * TT * DH * 2 <= WS_P && WS_P + (size_t)NB * TT * DH * 2 <= WS_END, "ws map");
static_assert(WS_W + DEPTH * W_LAYER <= WS_HB && WS_HB + (size_t)M * D * 2 <= WS_MID && WS_MID + (size_t)M * FF * 2 <= WS_END, "ws map 2");
constexpr int LDS_HL = 0, LDS_P = 65536, LDS_CST = 131072, LDS_CARR = 147456, LDS_RED1 = 149504, LDS_RED2 = 152064, LDS_CARRY = 154624;
constexpr int LDS_XST = 163840 - 64;
constexpr int LDS_BYTES = 163840;
constexpr size_t WS_FLAG = 64 * 1024;

struct Params {
    const float* in[20];
    float* out;
    unsigned char* ws;
};

__device__ __forceinline__ Params launder(const Params& p) {
    Params q = p;
#pragma unroll
    for (int i = 0; i < 20; ++i) { const __attribute__((address_space(1))) float* g = (const __attribute__((address_space(1))) float*)q.in[i]; asm volatile("" : "+s"(g)); q.in[i] = (const float*)g; }
    { __attribute__((address_space(1))) float* g = (__attribute__((address_space(1))) float*)q.out; asm volatile("" : "+s"(g)); q.out = (float*)g; }
    { __attribute__((address_space(1))) unsigned char* g = (__attribute__((address_space(1))) unsigned char*)q.ws; asm volatile("" : "+s"(g)); q.ws = (unsigned char*)g; }
    return q;
}
__device__ __forceinline__ unsigned cvt_pk(float lo, float hi) { return pg8::cvt_pk_bf16(lo, hi); }
__device__ __forceinline__ float bf_lo(unsigned w) { return __builtin_bit_cast(float, w << 16); }
__device__ __forceinline__ float bf_hi(unsigned w) { return __builtin_bit_cast(float, w & 0xffff0000u); }
__device__ __forceinline__ void unpack8(const u32x4 w, float (&f)[8]) {
    f[0] = bf_lo(w.x); f[1] = bf_hi(w.x); f[2] = bf_lo(w.y); f[3] = bf_hi(w.y); f[4] = bf_lo(w.z); f[5] = bf_hi(w.z); f[6] = bf_lo(w.w); f[7] = bf_hi(w.w);
}
__device__ __forceinline__ u32x4 pack8(const float (&f)[8]) { u32x4 w; w.x = cvt_pk(f[0], f[1]); w.y = cvt_pk(f[2], f[3]); w.z = cvt_pk(f[4], f[5]); w.w = cvt_pk(f[6], f[7]); return w; }
__device__ __forceinline__ float wave_sum(float v) {
#pragma unroll
    for (int o = 1; o < 64; o <<= 1) v += __shfl_xor(v, o);
    return v;
}
template <int CTRL> __device__ __forceinline__ float dppf(float old, float src) {
    return __builtin_bit_cast(float, __builtin_amdgcn_update_dpp(__builtin_bit_cast(int, old), __builtin_bit_cast(int, src), CTRL, 0xf, 0xf, false));
}
template <int DD> __device__ __forceinline__ float shiftd(float cur, float prev) {
    const float t = dppf<0x100 + (16 - DD)>(0.f, prev);
    return dppf<0x110 + DD>(t, cur);
}
__device__ __forceinline__ float sigm(float v) { return __builtin_amdgcn_rcpf(1.0f + __expf(-v)); }
__device__ __forceinline__ int outchan(int n, int rho) { return 32 * (n >> 1) + 8 * (rho >> 2) + 4 * (n & 1) + (rho & 3); }

__device__ __forceinline__ float row_rstd(const float* ss, int r) {
    const f32x4* s4 = (const f32x4*)(ss + (size_t)r * 16);
    const f32x4 a = s4[0], b = s4[1], c = s4[2], d = s4[3];
    const float s = ((a.x + a.y) + (a.z + a.w)) + ((b.x + b.y) + (b.z + b.w)) + ((c.x + c.y) + (c.z + c.w)) + ((d.x + d.y) + (d.z + d.w));
    return 1.0f / sqrtf(s * (1.0f / D) + EPS);
}
__device__ __forceinline__ void rows_rstd(const float* ss, int rowbase  , int fr, float (&rs)[2][4]) {
    const int lane = threadIdx.x & 63;
    const float r0 = row_rstd(ss, rowbase + lane), r1 = row_rstd(ss, rowbase + 128 + lane);
#pragma unroll
    for (int m = 0; m < 4; ++m) { rs[0][m] = __shfl(r0, m * 16 + fr); rs[1][m] = __shfl(r1, m * 16 + fr); }
}
struct EpiIn {
    static constexpr bool PERM = true, AFTER_DRAIN = false, PRELOAD = false;
    bf16* P; const float* ss; const LAS float* rl; int pmc;
    __device__ __forceinline__ void operator()(const f32x4 (&acc)[2][2][4][2], const pg8::Unit& u, int wr, int wc, int fr, int fq) const {
        const int row0 = u.pm * 256 + wr * 64 + fr, col0 = u.pn * 256 + wc * 32 + 8 * fq;
        float rsv[2][4];
        if (u.pm == pmc) {
#pragma unroll
            for (int ai = 0; ai < 2; ++ai)
#pragma unroll
                for (int m = 0; m < 4; ++m) rsv[ai][m] = rl[ai * 128 + wr * 64 + m * 16 + fr];
        } else {
#pragma unroll
            for (int ai = 0; ai < 2; ++ai)
#pragma unroll
                for (int m = 0; m < 4; ++m) { rsv[ai][m] = row_rstd(ss, row0 + ai * 128 + m * 16); asm volatile("" ::: "memory"); }
        }
#pragma unroll
        for (int ai = 0; ai < 2; ++ai)
#pragma unroll
            for (int m = 0; m < 4; ++m) {
                const int r = row0 + ai * 128 + m * 16; const float rs = rsv[ai][m];
                bf16* rowp = P + (size_t)(r + NMETA * (1 + (r >> 13))) * DIN + col0;
#pragma unroll
                for (int bj = 0; bj < 2; ++bj) { const f32x4 v0 = acc[ai][bj][m][0] * rs, v1 = acc[ai][bj][m][1] * rs;
                    u32x4 w; w.x = cvt_pk(v0[0], v0[1]); w.y = cvt_pk(v0[2], v0[3]); w.z = cvt_pk(v1[0], v1[1]); w.w = cvt_pk(v1[2], v1[3]);
                    *(u32x4*)(rowp + bj * 128) = w; }
            }
    }
};
struct EpiUp {
    static constexpr bool PERM = true, AFTER_DRAIN = false, PRELOAD = false;
    bf16* O; const float* ss; const LAS float* rl; int pmc;
    __device__ __forceinline__ void operator()(const f32x4 (&acc)[2][2][4][2], const pg8::Unit& u, int wr, int wc, int fr, int fq) const {
        const int row0 = u.pm * 256 + wr * 64 + fr, col0 = u.pn * 256 + wc * 32 + 8 * fq;
        float rsv[2][4];
        if (u.pm == pmc) {
#pragma unroll
            for (int ai = 0; ai < 2; ++ai)
#pragma unroll
                for (int m = 0; m < 4; ++m) rsv[ai][m] = rl[ai * 128 + wr * 64 + m * 16 + fr];
        } else {
#pragma unroll
            for (int ai = 0; ai < 2; ++ai)
#pragma unroll
                for (int m = 0; m < 4; ++m) { rsv[ai][m] = row_rstd(ss, row0 + ai * 128 + m * 16); asm volatile("" ::: "memory"); }
        }
#pragma unroll
        for (int ai = 0; ai < 2; ++ai)
#pragma unroll
            for (int m = 0; m < 4; ++m) {
                const int r = row0 + ai * 128 + m * 16; const float rs = rsv[ai][m];
                bf16* rowp = O + (size_t)r * FF + col0;
#pragma unroll
                for (int bj = 0; bj < 2; ++bj) { f32x4 v0 = acc[ai][bj][m][0] * rs, v1 = acc[ai][bj][m][1] * rs;
#pragma unroll
                    for (int j = 0; j < 4; ++j) { v0[j] = fmaxf(v0[j], 0.f); v0[j] *= v0[j]; v1[j] = fmaxf(v1[j], 0.f); v1[j] *= v1[j]; }
                    u32x4 w; w.x = cvt_pk(v0[0], v0[1]); w.y = cvt_pk(v0[2], v0[3]); w.z = cvt_pk(v1[0], v1[1]); w.w = cvt_pk(v1[2], v1[3]);
                    *(u32x4*)(rowp + bj * 128) = w; }
            }
    }
};
struct EpiRes {
    static constexpr bool PERM = true, AFTER_DRAIN = false, PRELOAD = true;
    bf16* hb; float* ssn;
    __device__ __forceinline__ void preload(f32x4 (&acc)[2][2][4][2], const pg8::Unit& u, int wr, int wc, int fr, int fq) const {
        const int row0 = u.pm * 256 + wr * 64 + fr, col0 = u.pn * 256 + wc * 32 + 8 * fq;
#pragma unroll
        for (int ai = 0; ai < 2; ++ai)
#pragma unroll
            for (int m = 0; m < 4; ++m) { const size_t off = (size_t)(row0 + ai * 128 + m * 16) * D + col0;
#pragma unroll
                for (int bj = 0; bj < 2; ++bj) { const u32x4 w = *(const u32x4*)(hb + off + bj * 128);
                    acc[ai][bj][m][0] = (f32x4){bf_lo(w.x), bf_hi(w.x), bf_lo(w.y), bf_hi(w.y)}; acc[ai][bj][m][1] = (f32x4){bf_lo(w.z), bf_hi(w.z), bf_lo(w.w), bf_hi(w.w)}; } }
    }
    __device__ __forceinline__ void operator()(const f32x4 (&acc)[2][2][4][2], const pg8::Unit& u, int wr, int wc, int fr, int fq) const {
        const int row0 = u.pm * 256 + wr * 64 + fr, col0 = u.pn * 256 + wc * 32 + 8 * fq;
#pragma unroll
        for (int ai = 0; ai < 2; ++ai)
#pragma unroll
            for (int m = 0; m < 4; ++m) {
                const int r = row0 + ai * 128 + m * 16; const size_t off = (size_t)r * D + col0; float s = 0.f;
#pragma unroll
                for (int bj = 0; bj < 2; ++bj) {
                    const f32x4 o0 = acc[ai][bj][m][0], o1 = acc[ai][bj][m][1];
                    s += (o0[0] * o0[0] + o0[1] * o0[1]) + (o0[2] * o0[2] + o0[3] * o0[3]) + (o1[0] * o1[0] + o1[1] * o1[1]) + (o1[2] * o1[2] + o1[3] * o1[3]);
                    u32x4 w; w.x = cvt_pk(o0[0], o0[1]); w.y = cvt_pk(o0[2], o0[3]); w.z = cvt_pk(o1[0], o1[1]); w.w = cvt_pk(o1[2], o1[3]);
                    *(u32x4*)(hb + off + bj * 128) = w; }
                s += __shfl_xor(s, 16); s += __shfl_xor(s, 32);
                if (fq == 0) ssn[(size_t)r * 16 + u.pn * 4 + wc] = s;
            }
    }
};

struct TItem { const float* W; const float* gk; bf16* WT; int K, N, item; };
__device__ __forceinline__ void titem_load(const TItem& t, int lane, f32x4 (&v)[8], float (&gs)[8]) {
    const int nblk = t.N / 32, kb = t.item / nblk, nb = t.item % nblk, k0 = 64 * kb, n0 = 32 * nb, lr = lane >> 3, lc = (lane & 7) * 4;
#pragma unroll
    for (int i = 0; i < 8; ++i) { v[i] = *(const f32x4*)(t.W + (size_t)(k0 + 8 * i + lr) * t.N + n0 + lc); gs[i] = t.gk ? t.gk[k0 + 8 * i + lr] : 1.0f; }
}
__device__ __forceinline__ void titem_store(const TItem& t, int lane, const f32x4 (&v)[8], const float (&gs)[8], LAS float* scr) {
    const int nblk = t.N / 32, kb = t.item / nblk, nb = t.item % nblk, k0 = 64 * kb, n0 = 32 * nb, lr = lane >> 3, lc = (lane & 7) * 4;
#pragma unroll
    for (int i = 0; i < 8; ++i) { LAS float* d = scr + (8 * i + lr) * 33 + lc; d[0] = v[i].x * gs[i]; d[1] = v[i].y * gs[i]; d[2] = v[i].z * gs[i]; d[3] = v[i].w * gs[i]; }
    asm volatile("s_waitcnt lgkmcnt(0)" ::: "memory");
    const int c = lane & 7;
#pragma unroll
    for (int j = 0; j < 4; ++j) { const int n = (lane >> 3) + 8 * j; const LAS float* s = scr + (8 * c) * 33 + n;
        u32x4 o; o.x = cvt_pk(s[0 * 33], s[1 * 33]); o.y = cvt_pk(s[2 * 33], s[3 * 33]); o.z = cvt_pk(s[4 * 33], s[5 * 33]); o.w = cvt_pk(s[6 * 33], s[7 * 33]);
        *(u32x4*)(t.WT + (size_t)(n0 + n) * t.K + k0 + 8 * c) = o; }
    asm volatile("s_waitcnt lgkmcnt(0)" ::: "memory");
}
__device__ __forceinline__ TItem titem_decode(const Params& p, int it) {
    constexpr int I_IN = 16 * 48, I_OUT = 16 * 32, I_UP = 16 * 128, I_DN = 64 * 32, I_PW = 4 * 8, I_G = 8 * 2, I_L = I_IN + I_OUT + I_UP + I_DN + I_PW + 2 * I_G;
    const int l = it / I_L; int r = it % I_L; unsigned char* ws = p.ws; unsigned char* wl = ws + WS_W + (size_t)l * W_LAYER; TItem t;
    if (r < I_IN) { t = TItem{p.in[3] + (size_t)l * D * DIN, p.in[2] + l * D, (bf16*)(wl + W_IN), D, DIN, r}; return t; } r -= I_IN;
    if (r < I_OUT) { t = TItem{p.in[15] + (size_t)l * D * D, p.in[14] + l * D, (bf16*)(wl + W_OUT), D, D, r}; return t; } r -= I_OUT;
    if (r < I_UP) { t = TItem{p.in[17] + (size_t)l * D * FF, p.in[16] + l * D, (bf16*)(wl + W_UP), D, FF, r}; return t; } r -= I_UP;
    if (r < I_DN) { t = TItem{p.in[18] + (size_t)l * FF * D, nullptr, (bf16*)(wl + W_DOWN), FF, D, r}; return t; } r -= I_DN;
    if (r < I_PW) { const int g = r / 8; t = TItem{p.in[4] + (size_t)(l * 4 + g) * 16384, nullptr, (bf16*)(ws + WS_POOLW) + (size_t)(l * 4 + g) * 16384, 128, 128, r % 8}; return t; } r -= I_PW;
    if (r < I_G) { const int h = r / 2; t = TItem{p.in[9] + (size_t)(l * 8 + h) * 4096, nullptr, (bf16*)(ws + WS_GR) + (size_t)(l * 8 + h) * 4096, 64, 64, r % 2}; return t; } r -= I_G;
    { const int h = r / 2; t = TItem{p.in[11] + (size_t)(l * 8 + h) * 4096, nullptr, (bf16*)(ws + WS_GI) + (size_t)(l * 8 + h) * 4096, 64, 64, r % 2}; }
    return t;
}
constexpr int TITEMS_PER_LAYER = 16 * 48 + 16 * 32 + 16 * 128 + 64 * 32 + 4 * 8 + 2 * 8 * 2;
__device__ __forceinline__ void convert_items(const Params& p_, LAS unsigned char* lds, int it_lo, int it_hi, int wblock, int nworkers) {
    const Params p = launder(p_);
    int tid_ = threadIdx.x; asm volatile("" : "+v"(tid_));
    const int lane = tid_ & 63, wid = __builtin_amdgcn_readfirstlane(tid_ >> 6);
    LAS float* scr = (LAS float*)(lds + wid * 16384);
    const int worker = wblock * 8 + wid;
    if (it_lo + worker < it_hi) {
        TItem cur = titem_decode(p, it_lo + worker); f32x4 v[8]; float gs[8]; titem_load(cur, lane, v, gs);
        for (int it = it_lo + worker; it < it_hi; it += nworkers) {
            const bool more = it + nworkers < it_hi; TItem nxt = cur; f32x4 nv[8]; float ngs[8];
            if (more) { nxt = titem_decode(p, it + nworkers); titem_load(nxt, lane, nv, ngs); }
            titem_store(cur, lane, v, gs, scr);
            if (more) { cur = nxt;
#pragma unroll
                for (int i = 0; i < 8; ++i) { v[i] = nv[i]; gs[i] = ngs[i]; } }
        }
    }
}
__device__ __forceinline__ void prologue(const Params& p_, LAS unsigned char* lds, int G) {
    const Params p = launder(p_);
    int tid_ = threadIdx.x; asm volatile("" : "+v"(tid_));
    const int tid = tid_, lane = tid & 63, wid = __builtin_amdgcn_readfirstlane(tid >> 6);
    const int gw = blockIdx.x * 8 + wid, NGW = G * 8;
    unsigned char* ws = p.ws;
    convert_items(p_, lds, 0, (G == 256 ? 1 : DEPTH) * TITEMS_PER_LAYER, (int)blockIdx.x, NGW);
    const float* x = p.in[0]; bf16* hb = (bf16*)(ws + WS_HB); float* ss = (float*)(ws + WS_SS);
    for (int m2 = gw; m2 < M / 2; m2 += NGW) {
        f32x4 v[2][4]; float s[2] = {0.f, 0.f};
#pragma unroll
        for (int r = 0; r < 2; ++r) { const f32x4* xr = (const f32x4*)(x + (size_t)(2 * m2 + r) * D) + lane;
#pragma unroll
            for (int j = 0; j < 4; ++j) v[r][j] = xr[64 * j]; }
#pragma unroll
        for (int r = 0; r < 2; ++r) {
#pragma unroll
            for (int j = 0; j < 4; ++j) s[r] += (v[r][j].x * v[r][j].x + v[r][j].y * v[r][j].y) + (v[r][j].z * v[r][j].z + v[r][j].w * v[r][j].w);
            s[r] = wave_sum(s[r]);
            u32x2* o8 = (u32x2*)(hb + (size_t)(2 * m2 + r) * D) + lane;
#pragma unroll
            for (int j = 0; j < 4; ++j) { u32x2 w; w.x = cvt_pk(v[r][j].x, v[r][j].y); w.y = cvt_pk(v[r][j].z, v[r][j].w); o8[64 * j] = w; }
            if (lane < 16) ss[(size_t)(2 * m2 + r) * 16 + lane] = lane == 0 ? s[r] : 0.f;
        }
    }
    float* hm = (float*)(ws + WS_HMETA); float* sp = (float*)(ws + WS_SP);
    for (int i = blockIdx.x * 512 + tid; i < NMETA * D; i += G * 512) hm[i] = p.in[1][i];
    for (int i = blockIdx.x * 512 + tid; i < DEPTH * DH; i += G * 512) sp[i] = log1pf(expf(-p.in[13][i]));
}

template <int MODE> __device__ __forceinline__ void meta_tasks(const Params& p_, LAS unsigned char* lds, int G, const bf16* Ab, int lda, const bf16* Bt, int K, int ntasks) {
    const Params p = launder(p_);
    int tid_ = threadIdx.x; asm volatile("" : "+v"(tid_));
    const int tid = tid_, lane = tid & 63, wid = __builtin_amdgcn_readfirstlane(tid >> 6), fr = lane & 15, fq = lane >> 4;
    float* hm = (float*)(p.ws + WS_HMETA);
    LAS float* red = (LAS float*)lds;
    for (int task = G - 1 - (int)blockIdx.x; task < ntasks; task += G) {
        const int n0 = task * 16, kw = K / 8, k0 = wid * kw;
        f32x4 acc = {0.f, 0.f, 0.f, 0.f}; float ssq = 0.f;
        for (int kb = k0; kb < k0 + kw; kb += 128) {
            bf16x8 af[4], bfr[4]; f32x4 a0[4], a1[4];
#pragma unroll
            for (int i = 0; i < 4; ++i) { const int kk = kb + 32 * i;
                if (MODE == 1) af[i] = *(const bf16x8*)(Ab + (size_t)fr * lda + kk + 8 * fq);
                else { a0[i] = *(const f32x4*)(hm + fr * D + kk + 8 * fq); a1[i] = *(const f32x4*)(hm + fr * D + kk + 8 * fq + 4); }
                bfr[i] = *(const bf16x8*)(Bt + (size_t)(n0 + fr) * K + kk + 8 * fq); }
#pragma unroll
            for (int i = 0; i < 4; ++i) {
                if (MODE != 1) { ssq += (a0[i].x * a0[i].x + a0[i].y * a0[i].y) + (a0[i].z * a0[i].z + a0[i].w * a0[i].w) + (a1[i].x * a1[i].x + a1[i].y * a1[i].y) + (a1[i].z * a1[i].z + a1[i].w * a1[i].w);
                    u32x4 w; w.x = cvt_pk(a0[i].x, a0[i].y); w.y = cvt_pk(a0[i].z, a0[i].w); w.z = cvt_pk(a1[i].x, a1[i].y); w.w = cvt_pk(a1[i].z, a1[i].w); af[i] = __builtin_bit_cast(bf16x8, w); }
                acc = __builtin_amdgcn_mfma_f32_16x16x32_bf16(bfr[i], af[i], acc, 0, 0, 0); }
        }
        ssq += __shfl_xor(ssq, 16); ssq += __shfl_xor(ssq, 32);
        LAS float* rp = red + (wid * 64 + lane) * 5;
        rp[0] = acc[0]; rp[1] = acc[1]; rp[2] = acc[2]; rp[3] = acc[3]; rp[4] = ssq;
        __syncthreads();
        if (wid == 0) {
            float a0 = 0.f, a1 = 0.f, a2 = 0.f, a3 = 0.f, sq = 0.f;
#pragma unroll
            for (int w = 0; w < 8; ++w) { const LAS float* q = red + (w * 64 + lane) * 5; a0 += q[0]; a1 += q[1]; a2 += q[2]; a3 += q[3]; sq += q[4]; }
            const int col = n0 + 4 * fq;
            if (MODE == 1) { f32x4* hp = (f32x4*)(hm + fr * D + col); f32x4 h = *hp; h.x += a0; h.y += a1; h.z += a2; h.w += a3; *hp = h; }
            else {
                const float rs = 1.0f / sqrtf(sq * (1.0f / D) + EPS); a0 *= rs; a1 *= rs; a2 *= rs; a3 *= rs;
                if (MODE == 0) { u32x2 w; w.x = cvt_pk(a0, a1); w.y = cvt_pk(a2, a3); bf16* pr = (bf16*)(p.ws + WS_PROJ);
                    *(u32x2*)(pr + (size_t)fr * DIN + col) = w; *(u32x2*)(pr + (size_t)(TT + fr) * DIN + col) = w; }
                else { a0 = fmaxf(a0, 0.f); a1 = fmaxf(a1, 0.f); a2 = fmaxf(a2, 0.f); a3 = fmaxf(a3, 0.f);
                    u32x2 w; w.x = cvt_pk(a0 * a0, a1 * a1); w.y = cvt_pk(a2 * a2, a3 * a3); *(u32x2*)((bf16*)(p.ws + WS_MIDMETA) + (size_t)fr * FF + col) = w; }
            }
        }
        __syncthreads();
    }
}

__device__ __forceinline__ void m1_phase(const Params& p_, LAS unsigned char* lds, int G, int l) {
    const Params p = launder(p_);
    int tid_ = threadIdx.x; asm volatile("" : "+v"(tid_));
    const int tid = tid_, lane = tid & 63, wid = __builtin_amdgcn_readfirstlane(tid >> 6), fr = lane & 15, fq = lane >> 4;
    LAS float* cst = (LAS float*)lds;
    for (int i = tid; i < 8 * DH; i += 512) { const int row = i >> 9, ch = i & 511; float v;
        if (row < 4) v = p.in[7][(l * 4 + row) * DH + ch]; else if (row == 4) v = p.in[8][l * DH + ch]; else if (row == 5) v = p.in[10][l * DH + ch];
        else if (row == 6) v = p.in[12][l * DH + ch]; else v = ((const float*)(p.ws + WS_SP))[l * DH + ch];
        cst[i] = v; }
    const bf16* proj = (const bf16*)(p.ws + WS_PROJ);
    const bf16* Wr = (const bf16*)(p.ws + WS_GR) + (size_t)(l * 8 + wid) * 4096; const bf16* Wi = (const bf16*)(p.ws + WS_GI) + (size_t)(l * 8 + wid) * 4096;
    LAS bf16x8* wl = (LAS bf16x8*)(lds + 16384 + wid * 16384) + lane;
#pragma unroll
    for (int n = 0; n < 4; ++n)
#pragma unroll
        for (int ks = 0; ks < 2; ++ks) {
            wl[((n * 2 + ks) * 2 + 0) * 64] = *(const bf16x8*)(Wr + outchan(n, fr) * 64 + 32 * ks + 8 * fq);
            wl[((n * 2 + ks) * 2 + 1) * 64] = *(const bf16x8*)(Wi + outchan(n, fr) * 64 + 32 * ks + 8 * fq); }
    __syncthreads();
    bf16* hl = (bf16*)(p.ws + WS_HL); bf16* Pp = (bf16*)(p.ws + WS_P);
    float* carA = (float*)(p.ws + WS_CARA); float* carH = (float*)(p.ws + WS_CARH);
    for (int unit = blockIdx.x; unit < 256; unit += G) {
        const int b = unit >> 7, c = unit & 127, t0 = c ? NMETA + 64 * c : 0, NM = c ? 4 : 5;
        float Hc[16], Pc[16];
#pragma unroll
        for (int k = 0; k < 16; ++k) { Hc[k] = 0.f; Pc[k] = 1.f; }
        u32x4 raw[2][4];
#pragma unroll
        for (int ks = 0; ks < 2; ++ks)
#pragma unroll
            for (int d = 0; d < 4; ++d) { const int tt = t0 + fr - 3 + d; raw[ks][d] = (u32x4){0u, 0u, 0u, 0u};
                if (tt >= 0) raw[ks][d] = *(const u32x4*)(proj + ((size_t)b * TT + tt) * DIN + DH + wid * 64 + 32 * ks + 8 * fq); }
#pragma unroll 1
        for (int m = 0; m < NM; ++m) {
            const int t = t0 + 16 * m + fr; const size_t rowg = (size_t)b * TT + t;
            u32x4 nraw[2][4];
#pragma unroll
            for (int ks = 0; ks < 2; ++ks)
#pragma unroll
                for (int d = 0; d < 4; ++d) { nraw[ks][d] = (u32x4){0u, 0u, 0u, 0u};
                    if (m + 1 < NM) nraw[ks][d] = *(const u32x4*)(proj + ((size_t)b * TT + t + 13 + d) * DIN + DH + wid * 64 + 32 * ks + 8 * fq); }
            float xc[2][8]; bf16x8 frag[2];
#pragma unroll
            for (int ks = 0; ks < 2; ++ks) {
                const int chb = wid * 64 + 32 * ks + 8 * fq;
                { const f32x4 c0 = *(const LAS f32x4*)(cst + 4 * DH + chb), c1 = *(const LAS f32x4*)(cst + 4 * DH + chb + 4);
                  xc[ks][0] = c0.x; xc[ks][1] = c0.y; xc[ks][2] = c0.z; xc[ks][3] = c0.w; xc[ks][4] = c1.x; xc[ks][5] = c1.y; xc[ks][6] = c1.z; xc[ks][7] = c1.w; }
#pragma unroll
                for (int d = 0; d < 4; ++d) {
                    float u[8]; unpack8(raw[ks][d], u);
                    const f32x4 w0 = *(const LAS f32x4*)(cst + d * DH + chb), w1 = *(const LAS f32x4*)(cst + d * DH + chb + 4);
                    xc[ks][0] += u[0] * w0.x; xc[ks][1] += u[1] * w0.y; xc[ks][2] += u[2] * w0.z; xc[ks][3] += u[3] * w0.w;
                    xc[ks][4] += u[4] * w1.x; xc[ks][5] += u[5] * w1.y; xc[ks][6] += u[6] * w1.z; xc[ks][7] += u[7] * w1.w;
                    raw[ks][d] = nraw[ks][d];
                }
                frag[ks] = __builtin_bit_cast(bf16x8, pack8(xc[ks]));
            }
            f32x4 ar[4], ai[4];
#pragma unroll
            for (int n = 0; n < 4; ++n) { ar[n] = (f32x4){0.f, 0.f, 0.f, 0.f}; ai[n] = (f32x4){0.f, 0.f, 0.f, 0.f};
#pragma unroll
                for (int ks = 0; ks < 2; ++ks) {
                    const bf16x8 wr_ = wl[((n * 2 + ks) * 2 + 0) * 64], wi_ = wl[((n * 2 + ks) * 2 + 1) * 64];
                    ar[n] = __builtin_amdgcn_mfma_f32_16x16x32_bf16(wr_, frag[ks], ar[n], 0, 0, 0);
                    ai[n] = __builtin_amdgcn_mfma_f32_16x16x32_bf16(wi_, frag[ks], ai[n], 0, 0, 0);
                } }
            float Aa[16], Bb[16];
#pragma unroll
            for (int n = 0; n < 4; ++n) {
                const int cho = wid * 64 + 32 * (n >> 1) + 8 * fq + 4 * (n & 1);
                const f32x4 rb = *(const LAS f32x4*)(cst + 5 * DH + cho), ib = *(const LAS f32x4*)(cst + 6 * DH + cho), spv = *(const LAS f32x4*)(cst + 7 * DH + cho);
#pragma unroll
                for (int jj = 0; jj < 4; ++jj) {
                    const float r = sigm(ar[n][jj] + rb[jj]), ig = sigm(ai[n][jj] + ib[jj]);
                    const float la = -8.0f * r * spv[jj], a = __expf(la), x2 = 2.0f * la;
                    const float m2s = -x2 * (1.0f + x2 * (0.5f + x2 * (0.16666667f + x2 * 0.041666668f))), m2 = (x2 > -0.0625f) ? m2s : 1.0f - a * a;
                    Aa[n * 4 + jj] = a; Bb[n * 4 + jj] = __builtin_amdgcn_sqrtf(m2) * ig * xc[n >> 1][4 * (n & 1) + jj];
                }
            }
#pragma unroll
            for (int k = 0; k < 16; ++k) {
                float A = Aa[k], B = Bb[k], Ap, Bq;
                Ap = dppf<0x111>(1.f, A); Bq = dppf<0x111>(0.f, B); B = fmaf(A, Bq, B); A *= Ap;
                Ap = dppf<0x112>(1.f, A); Bq = dppf<0x112>(0.f, B); B = fmaf(A, Bq, B); A *= Ap;
                Ap = dppf<0x114>(1.f, A); Bq = dppf<0x114>(0.f, B); B = fmaf(A, Bq, B); A *= Ap;
                Ap = dppf<0x118>(1.f, A); Bq = dppf<0x118>(0.f, B); B = fmaf(A, Bq, B); A *= Ap;
                Bb[k] = fmaf(A, Hc[k], B); Aa[k] = A * Pc[k];
            }
#pragma unroll
            for (int ks = 0; ks < 2; ++ks) {
                const size_t o = rowg * DH + wid * 64 + 32 * ks + 8 * fq;
                { u32x4 wh; wh.x = cvt_pk(Bb[8 * ks + 0], Bb[8 * ks + 1]); wh.y = cvt_pk(Bb[8 * ks + 2], Bb[8 * ks + 3]); wh.z = cvt_pk(Bb[8 * ks + 4], Bb[8 * ks + 5]); wh.w = cvt_pk(Bb[8 * ks + 6], Bb[8 * ks + 7]);
                  *(u32x4*)(hl + o) = wh; }
                u32x4 w; w.x = cvt_pk(Aa[8 * ks + 0], Aa[8 * ks + 1]); w.y = cvt_pk(Aa[8 * ks + 2], Aa[8 * ks + 3]); w.z = cvt_pk(Aa[8 * ks + 4], Aa[8 * ks + 5]); w.w = cvt_pk(Aa[8 * ks + 6], Aa[8 * ks + 7]);
                *(u32x4*)(Pp + o) = w;
            }
            const int src = (lane & 48) | 15;
#pragma unroll
            for (int k = 0; k < 16; ++k) { Hc[k] = __shfl(Bb[k], src); Pc[k] = __shfl(Aa[k], src); }
        }
        if (fr == 0) {
#pragma unroll
            for (int ks = 0; ks < 2; ++ks) {
                const size_t o = (size_t)(b * 128 + c) * DH + wid * 64 + 32 * ks + 8 * fq;
                *(f32x4*)(carA + o) = (f32x4){Pc[8 * ks + 0], Pc[8 * ks + 1], Pc[8 * ks + 2], Pc[8 * ks + 3]}; *(f32x4*)(carA + o + 4) = (f32x4){Pc[8 * ks + 4], Pc[8 * ks + 5], Pc[8 * ks + 6], Pc[8 * ks + 7]};
                *(f32x4*)(carH + o) = (f32x4){Hc[8 * ks + 0], Hc[8 * ks + 1], Hc[8 * ks + 2], Hc[8 * ks + 3]}; *(f32x4*)(carH + o + 4) = (f32x4){Hc[8 * ks + 4], Hc[8 * ks + 5], Hc[8 * ks + 6], Hc[8 * ks + 7]};
            }
        }
    }
    __syncthreads();
}


template <int NMR, bool FROM_LDS> __device__ __forceinline__ void m2_rnn_round(LAS unsigned char* lds, const bf16* hl, const bf16* Pp, const bf16* proj, bf16* Y, LAS float* red1, const float (&cr)[16], int b, int t0, int mbase, int wid, int fr, int fq) {
    u32x4 hw[NMR][2], pw[NMR][2], gw[NMR][2];
#pragma unroll
    for (int m = 0; m < NMR; ++m)
#pragma unroll
        for (int ks = 0; ks < 2; ++ks) { const size_t rowg = (size_t)b * TT + t0 + 16 * (mbase + m) + fr; const int ch = wid * 64 + 32 * ks + 8 * fq; const size_t o = rowg * DH + ch;
            if (FROM_LDS) { const int lane = fq * 16 + fr; hw[m][ks] = *(const LAS u32x4*)(lds + LDS_HL + wid * 8192 + (((mbase + m) * 2 + ks) * 64 + lane) * 16); pw[m][ks] = *(const LAS u32x4*)(lds + LDS_P + wid * 8192 + (((mbase + m) * 2 + ks) * 64 + lane) * 16); }
            else { hw[m][ks] = *(const u32x4*)(hl + o); pw[m][ks] = *(const u32x4*)(Pp + o); } gw[m][ks] = *(const u32x4*)(proj + rowg * DIN + 2 * DH + ch); }
    float y[NMR][16];
#pragma unroll
    for (int m = 0; m < NMR; ++m) { float s = 0.f;
#pragma unroll
        for (int ks = 0; ks < 2; ++ks) { float pf[8], gt[8]; unpack8(pw[m][ks], pf); unpack8(gw[m][ks], gt);
            float hh[8]; unpack8(hw[m][ks], hh);
#pragma unroll
            for (int e = 0; e < 8; ++e) { const float hv = fmaf(pf[e], cr[8 * ks + e], hh[e]), x = gt[e];
                const float ge = x * __builtin_amdgcn_rcpf(1.0f + __expf(-1.5957691216f * (x + 0.044715f * x * x * x)));
                const float yy = hv * ge; y[m][8 * ks + e] = yy; s = fmaf(yy, yy, s); } }
        s += __shfl_xor(s, 16); s += __shfl_xor(s, 32);
        if (fq == 0) red1[(16 * (mbase + m) + fr) * 8 + wid] = s; }
    __syncthreads();
#pragma unroll
    for (int m = 0; m < NMR; ++m) { const size_t rowg = (size_t)b * TT + t0 + 16 * (mbase + m) + fr;
        const f32x4 r0 = *(const LAS f32x4*)(red1 + (16 * (mbase + m) + fr) * 8), r1 = *(const LAS f32x4*)(red1 + (16 * (mbase + m) + fr) * 8 + 4);
        const float rs = __builtin_amdgcn_rsqf((((r0.x + r0.y) + (r0.z + r0.w)) + ((r1.x + r1.y) + (r1.z + r1.w))) * (1.0f / DH) + EPS);
#pragma unroll
        for (int ks = 0; ks < 2; ++ks) { float yy[8];
#pragma unroll
            for (int e = 0; e < 8; ++e) yy[e] = y[m][8 * ks + e] * rs;
            *(u32x4*)(Y + rowg * D + DH + wid * 64 + 32 * ks + 8 * fq) = pack8(yy); } }
}


template <int NMR> __device__ __forceinline__ void m2_pool_round(const bf16* proj, bf16* Y, const bf16* Wp, const float* pbias, const float* pscale, LAS float* red2,
                                                                  int b, int t0, int mbase, int g, int half, int kwin, int wid, int fr, int fq) {
    const int tb = t0 + 16 * mbase;
    bf16x8 pfr[NMR][4];
#pragma unroll
    for (int ks = 0; ks < 4; ++ks) {
        const int chb = g * 128 + 32 * ks + 8 * fq;
        float pu[8], p2[8], p4[8], p8[8];
        if (tb) { const u32x4 raw = *(const u32x4*)(proj + ((size_t)b * TT + tb - 16 + fr) * DIN + chb); unpack8(raw, pu);
#pragma unroll
            for (int e = 0; e < 8; ++e) { p2[e] = pu[e] + dppf<0x111>(0.f, pu[e]); p4[e] = p2[e] + dppf<0x112>(0.f, p2[e]); p8[e] = p4[e] + dppf<0x114>(0.f, p4[e]); } }
        else {
#pragma unroll
            for (int e = 0; e < 8; ++e) { pu[e] = 0.f; p2[e] = 0.f; p4[e] = 0.f; p8[e] = 0.f; } }
#pragma unroll
        for (int m = 0; m < NMR; ++m) {
            const int t = tb + 16 * m + fr; const size_t rowg = (size_t)b * TT + t;
            const u32x4 raw = *(const u32x4*)(proj + rowg * DIN + chb); float u[8], po[8]; unpack8(raw, u);
            const int cnt = (t + 1 < kwin) ? t + 1 : kwin; const float rc = __builtin_amdgcn_rcpf((float)cnt);
#pragma unroll
            for (int e = 0; e < 8; ++e) {
                const float s2 = u[e] + shiftd<1>(u[e], pu[e]), s4 = s2 + shiftd<2>(s2, p2[e]), s8 = s4 + shiftd<4>(s4, p4[e]), s16 = s8 + shiftd<8>(s8, p8[e]);
                const float win = g == 0 ? s2 : (g == 1 ? s4 : (g == 2 ? s8 : s16));
                po[e] = fmaf(win, rc, -u[e]); pu[e] = u[e]; p2[e] = s2; p4[e] = s4; p8[e] = s8;
            }
            pfr[m][ks] = __builtin_bit_cast(bf16x8, pack8(po));
        }
    }
    bf16x8 wfr[4][4];
#pragma unroll
    for (int n = 0; n < 4; ++n)
#pragma unroll
        for (int ks = 0; ks < 4; ++ks) wfr[n][ks] = *(const bf16x8*)(Wp + (size_t)(64 * half + outchan(n, fr)) * 128 + 32 * ks + 8 * fq);
#pragma unroll 1
    for (int pass = 0; pass < 2; ++pass) {
#pragma unroll
        for (int m = 0; m < NMR; ++m) {
            const int t = tb + 16 * m + fr; const size_t rowg = (size_t)b * TT + t; float s = 0.f, rs = 0.f;
            if (pass) { const f32x4 r0 = *(const LAS f32x4*)(red2 + (16 * (mbase + m) + fr) * 8), r1 = *(const LAS f32x4*)(red2 + (16 * (mbase + m) + fr) * 8 + 4);
                rs = __builtin_amdgcn_rsqf((((r0.x + r0.y) + (r0.z + r0.w)) + ((r1.x + r1.y) + (r1.z + r1.w))) * (1.0f / DH) + EPS); }
#pragma unroll
            for (int np = 0; np < 2; ++np) {
                f32x4 o2[2];
#pragma unroll
                for (int nn = 0; nn < 2; ++nn) { const int n = 2 * np + nn;
                    f32x4 acc = {0.f, 0.f, 0.f, 0.f};
#pragma unroll
                    for (int ks = 0; ks < 4; ++ks) acc = __builtin_amdgcn_mfma_f32_16x16x32_bf16(wfr[n][ks], pfr[m][ks], acc, 0, 0, 0);
                    const int col = g * 128 + 64 * half + 32 * np + 8 * fq + 4 * nn;
                    const f32x4 pb = *(const f32x4*)(pbias + col), ps = *(const f32x4*)(pscale + col);
                    acc = (acc + pb) * ps; s += (acc.x * acc.x + acc.y * acc.y) + (acc.z * acc.z + acc.w * acc.w); o2[nn] = acc * rs; }
                if (pass) { u32x4 w; w.x = cvt_pk(o2[0].x, o2[0].y); w.y = cvt_pk(o2[0].z, o2[0].w); w.z = cvt_pk(o2[1].x, o2[1].y); w.w = cvt_pk(o2[1].z, o2[1].w);
                    *(u32x4*)(Y + rowg * D + g * 128 + 64 * half + 32 * np + 8 * fq) = w; }
            }
            if (!pass) { s += __shfl_xor(s, 16); s += __shfl_xor(s, 32); if (fq == 0) red2[(16 * (mbase + m) + fr) * 8 + wid] = s; }
        }
        if (!pass) __syncthreads();
    }
}

__device__ __forceinline__ void m2_phase(const Params& p_, LAS unsigned char* lds, int G, int l) {
    const Params p = launder(p_);
    int tid_ = threadIdx.x; asm volatile("" : "+v"(tid_));
    const int tid = tid_, lane = tid & 63, wid = __builtin_amdgcn_readfirstlane(tid >> 6), fr = lane & 15, fq = lane >> 4;
    LAS float* segA = (LAS float*)lds; LAS float* segH = (LAS float*)(lds + 16384); LAS float* carr = (LAS float*)(lds + 32768);
    LAS float* red1 = (LAS float*)(lds + 34816); LAS float* red2 = (LAS float*)(lds + 37888);
    const bf16* proj = (const bf16*)(p.ws + WS_PROJ); bf16* Y = (bf16*)(p.ws + WS_Y);
    const bf16* hl = (const bf16*)(p.ws + WS_HL); const bf16* Pp = (const bf16*)(p.ws + WS_P);
    const float* carA = (const float*)(p.ws + WS_CARA); const float* carH = (const float*)(p.ws + WS_CARH);
    const int g = wid >> 1, half = wid & 1, kwin = 2 << g;
    const bf16* Wp = (const bf16*)(p.ws + WS_POOLW) + (size_t)(l * 4 + g) * 16384;
    const float* pbias = p.in[5] + l * DH; const float* pscale = p.in[6] + l * DH;
    for (int unit = blockIdx.x; unit < 256; unit += G) {
        const int b = unit >> 7, c = unit & 127, t0 = c ? NMETA + 64 * c : 0, NM = c ? 4 : 5;
        {
            const int q = (c + 7) >> 3, jlo = wid * q, jhi = (jlo + q < c) ? jlo + q : c;
            f32x4 A0 = {1.f, 1.f, 1.f, 1.f}, A1 = A0, H0 = {0.f, 0.f, 0.f, 0.f}, H1 = H0;
            for (int j = jlo; j < jhi; j += 8) {
                f32x4 a0[8], a1[8], h0[8], h1[8];
#pragma unroll
                for (int i = 0; i < 8; ++i) { const int jj = (j + i < jhi) ? j + i : jhi - 1; const size_t o = (size_t)(b * 128 + jj) * DH + 8 * lane;
                    a0[i] = *(const f32x4*)(carA + o); a1[i] = *(const f32x4*)(carA + o + 4); h0[i] = *(const f32x4*)(carH + o); h1[i] = *(const f32x4*)(carH + o + 4); }
#pragma unroll
                for (int i = 0; i < 8; ++i) if (j + i < jhi) { H0 = a0[i] * H0 + h0[i]; A0 = A0 * a0[i]; H1 = a1[i] * H1 + h1[i]; A1 = A1 * a1[i]; }
            }
            *(LAS f32x4*)(segA + wid * DH + 8 * lane) = A0; *(LAS f32x4*)(segA + wid * DH + 8 * lane + 4) = A1;
            *(LAS f32x4*)(segH + wid * DH + 8 * lane) = H0; *(LAS f32x4*)(segH + wid * DH + 8 * lane + 4) = H1;
        }
        __syncthreads();
        { float cy = 0.f;
#pragma unroll
          for (int s8 = 0; s8 < 8; ++s8) cy = segA[s8 * DH + tid] * cy + segH[s8 * DH + tid];
          carr[tid] = cy; }
        __syncthreads();
        {
            float cr[16];
#pragma unroll
            for (int ks = 0; ks < 2; ++ks) { const f32x4 c0 = *(const LAS f32x4*)(carr + wid * 64 + 32 * ks + 8 * fq), c1 = *(const LAS f32x4*)(carr + wid * 64 + 32 * ks + 8 * fq + 4);
                cr[8 * ks + 0] = c0.x; cr[8 * ks + 1] = c0.y; cr[8 * ks + 2] = c0.z; cr[8 * ks + 3] = c0.w; cr[8 * ks + 4] = c1.x; cr[8 * ks + 5] = c1.y; cr[8 * ks + 6] = c1.z; cr[8 * ks + 7] = c1.w; }
            m2_rnn_round<4, false>(lds, hl, Pp, proj, Y, red1, cr, b, t0, 0, wid, fr, fq);
            if (NM == 5) m2_rnn_round<1, false>(lds, hl, Pp, proj, Y, red1, cr, b, t0, 4, wid, fr, fq);
        }
        m2_pool_round<4>(proj, Y, Wp, pbias, pscale, red2, b, t0, 0, g, half, kwin, wid, fr, fq);
        if (NM == 5) m2_pool_round<1>(proj, Y, Wp, pbias, pscale, red2, b, t0, 4, g, half, kwin, wid, fr, fq);
    }
    __syncthreads();
}

__device__ __forceinline__ void final_norm(const Params& p_, int G) {
    const Params p = launder(p_);
    int tid_ = threadIdx.x; asm volatile("" : "+v"(tid_));
    const int tid = tid_, lane = tid & 63, wid = tid >> 6; const int gw = blockIdx.x * 8 + wid, NGW = G * 8;
    const bf16* hb = (const bf16*)(p.ws + WS_HB);
    const f32x4* gp = (const f32x4*)p.in[19] + 2 * lane; f32x4 gg[2][2];
#pragma unroll
    for (int j = 0; j < 2; ++j) { gg[j][0] = gp[128 * j]; gg[j][1] = gp[128 * j + 1]; }
    for (int m = gw; m < M; m += NGW) {
        const u32x4* xr = (const u32x4*)(hb + (size_t)m * D) + lane; float v[2][8]; float s = 0.f;
#pragma unroll
        for (int j = 0; j < 2; ++j) { unpack8(xr[64 * j], v[j]);
#pragma unroll
            for (int e = 0; e < 8; ++e) s = fmaf(v[j][e], v[j][e], s); }
        const float rs = 1.0f / sqrtf(wave_sum(s) * (1.0f / D) + EPS);
        f32x4* orow = (f32x4*)(p.out + (size_t)m * D) + 2 * lane;
#pragma unroll
        for (int j = 0; j < 2; ++j) {
            orow[128 * j] = (f32x4){v[j][0] * rs * gg[j][0].x, v[j][1] * rs * gg[j][0].y, v[j][2] * rs * gg[j][0].z, v[j][3] * rs * gg[j][0].w};
            orow[128 * j + 1] = (f32x4){v[j][4] * rs * gg[j][1].x, v[j][5] * rs * gg[j][1].y, v[j][6] * rs * gg[j][1].z, v[j][7] * rs * gg[j][1].w}; }
    }
}


__device__ __forceinline__ void mixer_phase(const Params& p_, LAS unsigned char* lds, int G, int l) {
    const Params p = launder(p_);
    int tid_ = threadIdx.x; asm volatile("" : "+v"(tid_));
    const int tid = tid_, lane = tid & 63, wid = __builtin_amdgcn_readfirstlane(tid >> 6), fr = lane & 15, fq = lane >> 4;
    LAS float* cst = (LAS float*)(lds + LDS_CST);
    const bf16* proj = (const bf16*)(p.ws + WS_PROJ);
    const bf16* Wr = (const bf16*)(p.ws + WS_GR) + (size_t)(l * 8 + wid) * 4096; const bf16* Wi = (const bf16*)(p.ws + WS_GI) + (size_t)(l * 8 + wid) * 4096;
    LAS float* segA = (LAS float*)(lds + LDS_CST); LAS float* segH = (LAS float*)(lds + LDS_CST + 8192); LAS float* carr = (LAS float*)(lds + LDS_CARR);
    LAS float* red1 = (LAS float*)(lds + LDS_RED1); LAS float* red2 = (LAS float*)(lds + LDS_RED2);
    bf16* Y = (bf16*)(p.ws + WS_Y);
    const int g = wid >> 1, half = wid & 1, kwin = 2 << g;
    const bf16* Wp = (const bf16*)(p.ws + WS_POOLW) + (size_t)(l * 4 + g) * 16384;
    const float* pbias = p.in[5] + l * DH; const float* pscale = p.in[6] + l * DH;
    unsigned* flags = (unsigned*)(p.ws + WS_FLAG);
    bf16* hl = (bf16*)(p.ws + WS_HL); bf16* Pp = (bf16*)(p.ws + WS_P);
    float* carA = (float*)(p.ws + WS_CARA); float* carH = (float*)(p.ws + WS_CARH);
    const int unit = blockIdx.x;
    if (unit < 256) {
        const int b = unit >> 7, c = unit & 127, t0 = c ? NMETA + 64 * c : 0, NM = c ? 4 : 5;
        __syncthreads();
        for (int i = tid; i < 8 * DH; i += 512) { const int row = i >> 9, ch = i & 511; float v;
            if (row < 4) v = p.in[7][(l * 4 + row) * DH + ch]; else if (row == 4) v = p.in[8][l * DH + ch]; else if (row == 5) v = p.in[10][l * DH + ch];
            else if (row == 6) v = p.in[12][l * DH + ch]; else v = ((const float*)(p.ws + WS_SP))[l * DH + ch];
            cst[i] = v; }
        __syncthreads();
        bf16x8 wfr[4][2][2];
#pragma unroll
        for (int n = 0; n < 4; ++n)
#pragma unroll
            for (int ks = 0; ks < 2; ++ks) { wfr[n][ks][0] = *(const bf16x8*)(Wr + outchan(n, fr) * 64 + 32 * ks + 8 * fq); wfr[n][ks][1] = *(const bf16x8*)(Wi + outchan(n, fr) * 64 + 32 * ks + 8 * fq); }
        LAS float* cslot = (LAS float*)(lds + LDS_CARRY) + (wid * 4 + fq) * 32;
        if (fr == 15) {
#pragma unroll
            for (int k4 = 0; k4 < 4; ++k4) { *(LAS f32x4*)(cslot + 4 * k4) = (f32x4){0.f, 0.f, 0.f, 0.f}; *(LAS f32x4*)(cslot + 16 + 4 * k4) = (f32x4){1.f, 1.f, 1.f, 1.f}; } }
        u32x4 raw[2][4];
#pragma unroll
        for (int ks = 0; ks < 2; ++ks)
#pragma unroll
            for (int d = 0; d < 4; ++d) { const int tt = t0 + fr - 3 + d; raw[ks][d] = (u32x4){0u, 0u, 0u, 0u};
                if (tt >= 0) raw[ks][d] = *(const u32x4*)(proj + ((size_t)b * TT + tt) * DIN + DH + wid * 64 + 32 * ks + 8 * fq); }
#pragma unroll 1
        for (int m = 0; m < NM; ++m) {
            const int t = t0 + 16 * m + fr; const size_t rowg = (size_t)b * TT + t;
            u32x4 nraw[2][4];
#pragma unroll
            for (int ks = 0; ks < 2; ++ks)
#pragma unroll
                for (int d = 0; d < 4; ++d) { nraw[ks][d] = (u32x4){0u, 0u, 0u, 0u};
                    if (m + 1 < NM) nraw[ks][d] = *(const u32x4*)(proj + ((size_t)b * TT + t + 13 + d) * DIN + DH + wid * 64 + 32 * ks + 8 * fq); }
            float xc[2][8]; bf16x8 frag[2];
#pragma unroll
            for (int ks = 0; ks < 2; ++ks) {
                const int chb = wid * 64 + 32 * ks + 8 * fq;
                { const f32x4 c0 = *(const LAS f32x4*)(cst + 4 * DH + chb), c1 = *(const LAS f32x4*)(cst + 4 * DH + chb + 4);
                  xc[ks][0] = c0.x; xc[ks][1] = c0.y; xc[ks][2] = c0.z; xc[ks][3] = c0.w; xc[ks][4] = c1.x; xc[ks][5] = c1.y; xc[ks][6] = c1.z; xc[ks][7] = c1.w; }
#pragma unroll
                for (int d = 0; d < 4; ++d) {
                    float u[8]; unpack8(raw[ks][d], u);
                    const f32x4 w0 = *(const LAS f32x4*)(cst + d * DH + chb), w1 = *(const LAS f32x4*)(cst + d * DH + chb + 4);
                    xc[ks][0] += u[0] * w0.x; xc[ks][1] += u[1] * w0.y; xc[ks][2] += u[2] * w0.z; xc[ks][3] += u[3] * w0.w;
                    xc[ks][4] += u[4] * w1.x; xc[ks][5] += u[5] * w1.y; xc[ks][6] += u[6] * w1.z; xc[ks][7] += u[7] * w1.w;
                    raw[ks][d] = nraw[ks][d];
                }
                frag[ks] = __builtin_bit_cast(bf16x8, pack8(xc[ks]));
            }
            f32x4 ar[4], ai[4];
#pragma unroll
            for (int n = 0; n < 4; ++n) { ar[n] = (f32x4){0.f, 0.f, 0.f, 0.f}; ai[n] = (f32x4){0.f, 0.f, 0.f, 0.f};
#pragma unroll
                for (int ks = 0; ks < 2; ++ks) {
                    const bf16x8 wr_ = wfr[n][ks][0], wi_ = wfr[n][ks][1];
                    ar[n] = __builtin_amdgcn_mfma_f32_16x16x32_bf16(wr_, frag[ks], ar[n], 0, 0, 0);
                    ai[n] = __builtin_amdgcn_mfma_f32_16x16x32_bf16(wi_, frag[ks], ai[n], 0, 0, 0);
                } }
            float Aa[16], Bb[16];
#pragma unroll
            for (int n = 0; n < 4; ++n) {
                const int cho = wid * 64 + 32 * (n >> 1) + 8 * fq + 4 * (n & 1);
                const f32x4 rb = *(const LAS f32x4*)(cst + 5 * DH + cho), ib = *(const LAS f32x4*)(cst + 6 * DH + cho), spv = *(const LAS f32x4*)(cst + 7 * DH + cho);
#pragma unroll
                for (int jj = 0; jj < 4; ++jj) {
                    const float r = sigm(ar[n][jj] + rb[jj]), ig = sigm(ai[n][jj] + ib[jj]);
                    const float la = -8.0f * r * spv[jj], a = __expf(la), x2 = 2.0f * la;
                    const float m2s = -x2 * (1.0f + x2 * (0.5f + x2 * (0.16666667f + x2 * 0.041666668f))), m2 = (x2 > -0.0625f) ? m2s : 1.0f - a * a;
                    Aa[n * 4 + jj] = a; Bb[n * 4 + jj] = __builtin_amdgcn_sqrtf(m2) * ig * xc[n >> 1][4 * (n & 1) + jj];
                }
            }
#pragma unroll
            for (int k = 0; k < 16; ++k) {
                float A = Aa[k], B = Bb[k], Ap, Bq;
                Ap = dppf<0x111>(1.f, A); Bq = dppf<0x111>(0.f, B); B = fmaf(A, Bq, B); A *= Ap;
                Ap = dppf<0x112>(1.f, A); Bq = dppf<0x112>(0.f, B); B = fmaf(A, Bq, B); A *= Ap;
                Ap = dppf<0x114>(1.f, A); Bq = dppf<0x114>(0.f, B); B = fmaf(A, Bq, B); A *= Ap;
                Ap = dppf<0x118>(1.f, A); Bq = dppf<0x118>(0.f, B); B = fmaf(A, Bq, B); A *= Ap;
                Bb[k] = B; Aa[k] = A;
            }
            {
                float Hc[16], Pc[16];
#pragma unroll
                for (int k4 = 0; k4 < 4; ++k4) { const f32x4 hq = *(const LAS f32x4*)(cslot + 4 * k4), pq = *(const LAS f32x4*)(cslot + 16 + 4 * k4);
                    Hc[4 * k4] = hq.x; Hc[4 * k4 + 1] = hq.y; Hc[4 * k4 + 2] = hq.z; Hc[4 * k4 + 3] = hq.w; Pc[4 * k4] = pq.x; Pc[4 * k4 + 1] = pq.y; Pc[4 * k4 + 2] = pq.z; Pc[4 * k4 + 3] = pq.w; }
#pragma unroll
                for (int k = 0; k < 16; ++k) { Bb[k] = fmaf(Aa[k], Hc[k], Bb[k]); Aa[k] *= Pc[k]; }
                if (fr == 15) {
#pragma unroll
                    for (int k4 = 0; k4 < 4; ++k4) { *(LAS f32x4*)(cslot + 4 * k4) = (f32x4){Bb[4 * k4], Bb[4 * k4 + 1], Bb[4 * k4 + 2], Bb[4 * k4 + 3]}; *(LAS f32x4*)(cslot + 16 + 4 * k4) = (f32x4){Aa[4 * k4], Aa[4 * k4 + 1], Aa[4 * k4 + 2], Aa[4 * k4 + 3]}; } }
            }
#pragma unroll
            for (int ks = 0; ks < 2; ++ks) {
                const size_t o = rowg * DH + wid * 64 + 32 * ks + 8 * fq;
                u32x4 wh; wh.x = cvt_pk(Bb[8 * ks + 0], Bb[8 * ks + 1]); wh.y = cvt_pk(Bb[8 * ks + 2], Bb[8 * ks + 3]); wh.z = cvt_pk(Bb[8 * ks + 4], Bb[8 * ks + 5]); wh.w = cvt_pk(Bb[8 * ks + 6], Bb[8 * ks + 7]);
                u32x4 w; w.x = cvt_pk(Aa[8 * ks + 0], Aa[8 * ks + 1]); w.y = cvt_pk(Aa[8 * ks + 2], Aa[8 * ks + 3]); w.z = cvt_pk(Aa[8 * ks + 4], Aa[8 * ks + 5]); w.w = cvt_pk(Aa[8 * ks + 6], Aa[8 * ks + 7]);
                if (m < 4) { *(LAS u32x4*)(lds + LDS_HL + wid * 8192 + ((m * 2 + ks) * 64 + lane) * 16) = wh; *(LAS u32x4*)(lds + LDS_P + wid * 8192 + ((m * 2 + ks) * 64 + lane) * 16) = w; }
                else { *(u32x4*)(hl + o) = wh; *(u32x4*)(Pp + o) = w; }
            }
        }
        if (fr == 0) {
            float Hc[16], Pc[16];
#pragma unroll
            for (int k4 = 0; k4 < 4; ++k4) { const f32x4 hq = *(const LAS f32x4*)(cslot + 4 * k4), pq = *(const LAS f32x4*)(cslot + 16 + 4 * k4);
                Hc[4 * k4] = hq.x; Hc[4 * k4 + 1] = hq.y; Hc[4 * k4 + 2] = hq.z; Hc[4 * k4 + 3] = hq.w; Pc[4 * k4] = pq.x; Pc[4 * k4 + 1] = pq.y; Pc[4 * k4 + 2] = pq.z; Pc[4 * k4 + 3] = pq.w; }
#pragma unroll
            for (int ks = 0; ks < 2; ++ks) {
                const size_t o = (size_t)(b * 128 + c) * DH + wid * 64 + 32 * ks + 8 * fq;
#pragma unroll
                for (int e2 = 0; e2 < 4; ++e2) {
                    __hip_atomic_store((unsigned long long*)(carA + o) + e2, ((unsigned long long)__float_as_uint(Pc[8 * ks + 2 * e2 + 1]) << 32) | __float_as_uint(Pc[8 * ks + 2 * e2]), __ATOMIC_RELAXED, __HIP_MEMORY_SCOPE_AGENT);
                    __hip_atomic_store((unsigned long long*)(carH + o) + e2, ((unsigned long long)__float_as_uint(Hc[8 * ks + 2 * e2 + 1]) << 32) | __float_as_uint(Hc[8 * ks + 2 * e2]), __ATOMIC_RELAXED, __HIP_MEMORY_SCOPE_AGENT); }
            }
        }
        asm volatile("s_waitcnt vmcnt(0)" ::: "memory");
        __syncthreads();
        if (tid == 0) __hip_atomic_store(flags + unit, (unsigned)(l + 1), __ATOMIC_RELAXED, __HIP_MEMORY_SCOPE_AGENT);
        int fr2 = fr, fq2 = fq, tid2 = tid; asm volatile("" : "+v"(fr2), "+v"(fq2), "+v"(tid2));
#ifndef NO_MX_POOL
        m2_pool_round<4>(proj, Y, Wp, pbias, pscale, red2, b, t0, 0, g, half, kwin, wid, fr2, fq2);
        if (NM == 5) m2_pool_round<1>(proj, Y, Wp, pbias, pscale, red2, b, t0, 4, g, half, kwin, wid, fr2, fq2);
#endif
        if (tid2 < c) { unsigned sp = 0; while (__hip_atomic_load(flags + b * 128 + tid2, __ATOMIC_RELAXED, __HIP_MEMORY_SCOPE_AGENT) < (unsigned)(l + 1)) { __builtin_amdgcn_s_sleep(2); if (++sp > (1u << 22)) break; } }
#if defined(MIXER_ACQ_FENCE)
        if (tid2 < c) __builtin_amdgcn_fence(__ATOMIC_ACQUIRE, "agent");
#endif
        __syncthreads();
        {
            const int q = (c + 3) >> 2, seg = tid2 >> 7, cgi = tid2 & 127, jlo = seg * q, jhi = (jlo + q < c) ? jlo + q : c;
            f32x4 A0 = {1.f, 1.f, 1.f, 1.f}, H0 = {0.f, 0.f, 0.f, 0.f};
            for (int j = jlo; j < jhi; j += 8) {
                f32x4 a0[8], h0[8];
#pragma unroll
                for (int i = 0; i < 8; ++i) { const int jj = (j + i < jhi) ? j + i : jhi - 1; const size_t o = (size_t)(b * 128 + jj) * DH + 4 * cgi; const unsigned long long al = __hip_atomic_load((const unsigned long long*)(carA + o), __ATOMIC_RELAXED, __HIP_MEMORY_SCOPE_AGENT), ah = __hip_atomic_load((const unsigned long long*)(carA + o) + 1, __ATOMIC_RELAXED, __HIP_MEMORY_SCOPE_AGENT);
                    const unsigned long long hl_ = __hip_atomic_load((const unsigned long long*)(carH + o), __ATOMIC_RELAXED, __HIP_MEMORY_SCOPE_AGENT), hh_ = __hip_atomic_load((const unsigned long long*)(carH + o) + 1, __ATOMIC_RELAXED, __HIP_MEMORY_SCOPE_AGENT);
                    a0[i] = (f32x4){__uint_as_float((unsigned)al), __uint_as_float((unsigned)(al >> 32)), __uint_as_float((unsigned)ah), __uint_as_float((unsigned)(ah >> 32))};
                    h0[i] = (f32x4){__uint_as_float((unsigned)hl_), __uint_as_float((unsigned)(hl_ >> 32)), __uint_as_float((unsigned)hh_), __uint_as_float((unsigned)(hh_ >> 32))}; }
#pragma unroll
                for (int i = 0; i < 8; ++i) if (j + i < jhi) { H0 = a0[i] * H0 + h0[i]; A0 = A0 * a0[i]; }
            }
            *(LAS f32x4*)(segA + seg * DH + 4 * cgi) = A0; *(LAS f32x4*)(segH + seg * DH + 4 * cgi) = H0;
        }
        __syncthreads();
        { float cy = 0.f;
#pragma unroll
          for (int s4 = 0; s4 < 4; ++s4) cy = segA[s4 * DH + tid2] * cy + segH[s4 * DH + tid2];
          carr[tid2] = cy; }
        __syncthreads();
        {
            float cr[16];
#pragma unroll
            for (int ks = 0; ks < 2; ++ks) { const f32x4 c0 = *(const LAS f32x4*)(carr + wid * 64 + 32 * ks + 8 * fq2), c1 = *(const LAS f32x4*)(carr + wid * 64 + 32 * ks + 8 * fq2 + 4);
                cr[8 * ks + 0] = c0.x; cr[8 * ks + 1] = c0.y; cr[8 * ks + 2] = c0.z; cr[8 * ks + 3] = c0.w; cr[8 * ks + 4] = c1.x; cr[8 * ks + 5] = c1.y; cr[8 * ks + 6] = c1.z; cr[8 * ks + 7] = c1.w; }
#ifndef NO_MX_RNN
            m2_rnn_round<4, true>(lds, hl, Pp, proj, Y, red1, cr, b, t0, 0, wid, fr2, fq2);
            if (NM == 5) m2_rnn_round<1, false>(lds, hl, Pp, proj, Y, red1, cr, b, t0, 4, wid, fr2, fq2);
#endif
        }
    }
    __syncthreads();
}

#define XB_TMO      128
#define XB_XCNT(j)  (256  + 64 * (j))
#define XB_XSUB(j)  (1280 + 64 * (j))
#define XB_XGEN(j)  (2304 + 64 * (j))
#define XB_TOP      3328
#define XB_TOPGEN   3392
#define XCD_BAR_WORDS 3456
#define XB_SPIN_CAP (1u << 18)

__device__ __forceinline__ unsigned xb_ld(unsigned* p)              { return __hip_atomic_load(p, __ATOMIC_RELAXED, __HIP_MEMORY_SCOPE_AGENT); }
__device__ __forceinline__ unsigned xb_add(unsigned* p, unsigned v) { return __hip_atomic_fetch_add(p, v, __ATOMIC_RELAXED, __HIP_MEMORY_SCOPE_AGENT); }
__device__ __forceinline__ unsigned xb_xcc_id() { return (unsigned)__builtin_amdgcn_s_getreg((3 << 11) | 20) & 0xFu; }
#define XB_SPIN(cond, bar) do { unsigned _sp = 0; while (cond) { __builtin_amdgcn_s_sleep(1); \
    if ((++_sp & 255u) == 0u) { if (xb_ld(&(bar)[XB_TMO])) break; if (_sp > XB_SPIN_CAP) { atomicAdd(&(bar)[XB_TMO], 1u); break; } } } } while (0)

struct XcdBarrier {
    unsigned* bar; unsigned x;
    volatile LAS unsigned* st;
};

__device__ __forceinline__ XcdBarrier xcd_barrier_post(unsigned* bar, volatile LAS unsigned* st) {
    XcdBarrier b; b.bar = bar; b.x = xb_xcc_id(); b.st = st;
    if (threadIdx.x == 0) (void)xb_add(&bar[XB_XCNT(b.x)], 1u);
    return b;
}
__device__ __forceinline__ void xcd_barrier_complete(unsigned* bar, unsigned x, unsigned& nloc, unsigned& nx) {
    const unsigned G = gridDim.x * gridDim.y * gridDim.z;
    unsigned sum, cnt, mine, sp = 0u;
    for (;;) {
        sum = 0u; cnt = 0u; mine = 0u;
#pragma unroll
        for (unsigned j = 0; j < 16; ++j) { const unsigned c = xb_ld(&bar[XB_XCNT(j)]); sum += c; cnt += (c > 0u) ? 1u : 0u; mine = (j == x) ? c : mine; }
        if (sum == G) break;
        __builtin_amdgcn_s_sleep(1);
        if ((++sp & 255u) == 0u) { if (xb_ld(&bar[XB_TMO])) break; if (sp > XB_SPIN_CAP) { atomicAdd(&bar[XB_TMO], 1u); break; } }
    }
    nloc = mine > 0u ? mine : 1u; nx = cnt > 0u ? cnt : 1u;
}

__device__ __forceinline__ void xcd_barrier(const XcdBarrier& b) {
    asm volatile("s_waitcnt vmcnt(0)" ::: "memory");
    __syncthreads();
    if (threadIdx.x == 0) {
        unsigned* bar = b.bar;
        __builtin_amdgcn_s_waitcnt(0);
        unsigned nloc = b.st[0], nx = b.st[1];
        if (nloc == 0u) { xcd_barrier_complete(bar, b.x, nloc, nx); b.st[0] = nloc; b.st[1] = nx; }
        const unsigned old = xb_add(&bar[XB_XSUB(b.x)], 1u);
        const unsigned gen = old / nloc;
        if (old + 1u == (gen + 1u) * nloc) {
            __builtin_amdgcn_fence(__ATOMIC_RELEASE, "agent");
            asm volatile("s_waitcnt vmcnt(0)" ::: "memory");
            const unsigned og = xb_add(&bar[XB_TOP], 1u);
            const unsigned tg = og / nx;
            if (og + 1u == (tg + 1u) * nx) xb_add(&bar[XB_TOPGEN], 1u);
            else XB_SPIN(xb_ld(&bar[XB_TOPGEN]) == tg, bar);
            __builtin_amdgcn_fence(__ATOMIC_ACQUIRE, "agent");
            xb_add(&bar[XB_XGEN(b.x)], 1u);
            asm volatile("s_waitcnt vmcnt(0)" ::: "memory");
        } else {
            XB_SPIN(xb_ld(&bar[XB_XGEN(b.x)]) == gen, bar);
            __builtin_amdgcn_fence(__ATOMIC_ACQUIRE, "agent");
            asm volatile("s_waitcnt vmcnt(0)" ::: "memory");
        }
    }
    __syncthreads();
}

#ifndef PROBE_SYNC2
#define PROBE_SYNC2 0
#endif
#ifndef PROBE_M1X2
#define PROBE_M1X2 0
#endif
#ifndef PROBE_M2X2
#define PROBE_M2X2 0
#endif
#define GSYNC() do { { __attribute__((address_space(1))) unsigned* gb_ = (__attribute__((address_space(1))) unsigned*)xbar.bar; asm volatile("" : "+s"(gb_)); xbar.bar = (unsigned*)gb_; asm volatile("" : "+s"(xbar.x)); } xcd_barrier(xbar); if (PROBE_SYNC2) xcd_barrier(xbar); } while (0)
__device__ __forceinline__ int rstd_cache(LAS unsigned char* lds, const float* ss, const pg8::StaticOrder& S) {
    pg8::Unit u0; int pmc = -1;
    int tid = threadIdx.x; asm volatile("" : "+v"(tid));
    if (S.next(0, u0)) { pmc = u0.pm; if (tid < 256) ((LAS float*)(lds + 131072))[tid] = row_rstd(ss, u0.pm * 256 + tid); }
    __syncthreads();
    return pmc;
}
#ifndef PROBE_PHASE
#define PROBE_PHASE (-1)
#endif
#define TIC() do { if (PROBE_PHASE >= 0) tic = __builtin_amdgcn_s_memrealtime(); } while (0)
#define TOC(k) do { if (PROBE_PHASE == (k)) tacc += __builtin_amdgcn_s_memrealtime() - tic; } while (0)
__global__ void __launch_bounds__(512, 2) fwd_megakernel(Params p) {
    extern __shared__ __attribute__((aligned(16))) unsigned char lds_raw[];
    LAS unsigned char* lds = (LAS unsigned char*)lds_raw;
    cg::grid_group grid = cg::this_grid();
    const int G = gridDim.x;
    unsigned long long tic = 0, tacc = 0;
    unsigned char* ws = p.ws;
    volatile LAS unsigned* xst = (volatile LAS unsigned*)(lds + LDS_XST);
    if (threadIdx.x < 2) xst[threadIdx.x] = 0u;
    __syncthreads();
    XcdBarrier xbar = xcd_barrier_post((unsigned*)(ws + WS_CTL), xst);
    bf16* hb = (bf16*)(ws + WS_HB); bf16* proj = (bf16*)(ws + WS_PROJ); bf16* Y = (bf16*)(ws + WS_Y); bf16* mid = (bf16*)(ws + WS_MID); float* ss = (float*)(ws + WS_SS);
    grid.sync();
    TIC();
#ifndef NO_PRO
    prologue(p, lds, G);
#endif
    GSYNC();
    TOC(0);
#pragma unroll 1
    for (int l = 0; l < DEPTH; ++l) {
        { __attribute__((address_space(1))) unsigned char* gws = (__attribute__((address_space(1))) unsigned char*)ws; asm volatile("" : "+s"(gws)); ws = (unsigned char*)gws; }
        const unsigned char* wl = ws + WS_W + (size_t)l * W_LAYER;
        const bf16* in_t = (const bf16*)(wl + W_IN); const bf16* out_t = (const bf16*)(wl + W_OUT); const bf16* up_t = (const bf16*)(wl + W_UP); const bf16* down_t = (const bf16*)(wl + W_DOWN);
        TIC();
#ifndef NO_GIN
        { pg8::Gemm g{hb, in_t, M, DIN, D, 0}; pg8::StaticOrder S; S.init(M, DIN, G, (int)blockIdx.x); const int pmc = rstd_cache(lds, ss, S); EpiIn E{proj, ss, (const LAS float*)(lds + 131072), pmc};
          pg8::gemm_phase<EpiIn, pg8::StaticOrder, true, true>(lds, g, S, E); }
#endif
#ifndef NO_META
        meta_tasks<0>(p, lds, G, nullptr, 0, in_t, D, DIN / 16);
#endif
        if (G == 256 && l + 1 < DEPTH && blockIdx.x >= 128)
            convert_items(p, lds, (l + 1) * TITEMS_PER_LAYER, (l + 2) * TITEMS_PER_LAYER, (int)blockIdx.x - 128, 128 * 8);
        GSYNC();
        TOC(1); TIC();
#ifndef FUSED_MIXER
#define FUSED_MIXER 1
#endif
#if FUSED_MIXER
        mixer_phase(p, lds, G, l);
        GSYNC();
        TOC(2);
#else
        m1_phase(p, lds, G, l);
        GSYNC();
        TOC(2); TIC();
        m2_phase(p, lds, G, l);
        GSYNC();
#endif
        TOC(3); TIC();
#ifndef NO_GOUT
        { pg8::Gemm g{Y, out_t, M, D, D, NMETA}; pg8::StaticOrder S; S.init(M, D, G, (int)blockIdx.x); EpiRes E{hb, ss};
          pg8::gemm_phase<EpiRes, pg8::StaticOrder, false, true>(lds, g, S, E); }
#endif
#ifndef NO_META
        if (l < DEPTH - 1) meta_tasks<1>(p, lds, G, Y, D, out_t, D, D / 16);
#endif
        GSYNC();
        TOC(4); TIC();
#ifndef NO_GUP
#ifndef STAGGER_UP
#define STAGGER_UP 0
#endif
        if (STAGGER_UP > 0) {
            const unsigned long long w0 = __builtin_amdgcn_s_memrealtime(), dl = (unsigned long long)(((blockIdx.x >> 3) & 3) * STAGGER_UP);
            while (__builtin_amdgcn_s_memrealtime() - w0 < dl) __builtin_amdgcn_s_sleep(4);
        }
        { pg8::Gemm g{hb, up_t, M, FF, D, 0}; pg8::StaticOrder S; S.init(M, FF, G, (int)blockIdx.x); const int pmc = rstd_cache(lds, ss, S); EpiUp E{mid, ss, (const LAS float*)(lds + 131072), pmc};
          pg8::gemm_phase<EpiUp, pg8::StaticOrder, true, true>(lds, g, S, E); }
#endif
#ifndef NO_META
        if (l < DEPTH - 1) meta_tasks<2>(p, lds, G, nullptr, 0, up_t, D, FF / 16);
#endif
        GSYNC();
        TOC(5); TIC();
#ifndef NO_GDN
        { pg8::Gemm g{mid, down_t, M, D, FF, 0}; pg8::StaticOrder S; S.init(M, D, G, (int)blockIdx.x); EpiRes E{hb, ss};
          pg8::gemm_phase<EpiRes, pg8::StaticOrder, false, true>(lds, g, S, E); }
#endif
#ifndef NO_META
        if (l < DEPTH - 1) meta_tasks<1>(p, lds, G, (const bf16*)(ws + WS_MIDMETA), FF, down_t, FF, D / 16);
#endif
        GSYNC();
        TOC(6);
    }
    TIC();
    final_norm(p, G);
    TOC(7);
    if (PROBE_PHASE >= 0 && blockIdx.x == 0 && threadIdx.x == 0) { const unsigned long long w0 = __builtin_amdgcn_s_memrealtime(); while (__builtin_amdgcn_s_memrealtime() - w0 < 4ull * tacc) __builtin_amdgcn_s_sleep(8); }
}

extern "C" void kernel_launch(void* const* d_in, const int* in_sizes, int n_in, void* d_out, int out_size, void* d_ws, size_t ws_size, hipStream_t stream) {
    static int grid = 0;
    if (grid == 0) {
        if (n_in != 20 || in_sizes[0] != M * D || out_size != M * D || ws_size < WS_END) { fprintf(stderr, "kernel_launch: unexpected shapes (n_in %d, in0 %d, out %d, ws %zu)\n", n_in, n_in > 0 ? in_sizes[0] : -1, out_size, ws_size); grid = -1; return; }
        int dev = 0, cus = 0, per_cu = 0;
        if (hipGetDevice(&dev) != hipSuccess || hipDeviceGetAttribute(&cus, hipDeviceAttributeMultiprocessorCount, dev) != hipSuccess) { grid = -1; return; }
        if (hipFuncSetAttribute((const void*)fwd_megakernel, hipFuncAttributeMaxDynamicSharedMemorySize, LDS_BYTES) != hipSuccess) { fprintf(stderr, "kernel_launch: hipFuncSetAttribute failed\n"); grid = -1; return; }
        if (hipOccupancyMaxActiveBlocksPerMultiprocessor(&per_cu, (const void*)fwd_megakernel, 512, LDS_BYTES) != hipSuccess || per_cu < 1) { fprintf(stderr, "kernel_launch: occupancy query gave %d\n", per_cu); (void)hipGetLastError(); grid = -1; return; }
        grid = cus * 1;
        if (grid < 256) { fprintf(stderr, "kernel_launch: %d CUs; the fused mixer phase needs 256 resident workgroups\n", cus); grid = -1; return; }
    }
    if (grid < 0) return;
    if (hipMemsetAsync((char*)d_ws + WS_CTL, 0, WS_FLAG + 256 * 4, stream) != hipSuccess) { fprintf(stderr, "kernel_launch: memset failed\n"); return; }
    Params p{};
    for (int i = 0; i < 20; ++i) p.in[i] = (const float*)d_in[i];
    p.out = (float*)d_out; p.ws = (unsigned char*)d_ws;
    void* args[] = {&p};
    hipError_t e = hipLaunchCooperativeKernel((const void*)fwd_megakernel, dim3(grid), dim3(512), args, LDS_BYTES, stream);
    if (e != hipSuccess) fprintf(stderr, "cooperative launch failed: %s (grid %d)\n", hipGetErrorString(e), grid);
}
```

```cpp
#include <hip/hip_runtime.h>
#include <hip/hip_cooperative_groups.h>
#include <cstdio>
#include <cstdint>
namespace cg = cooperative_groups;
namespace pg8 {
#define PG8_LAS __attribute__((address_space(3)))
typedef unsigned short bf16_t;
typedef short bf16x8 __attribute__((ext_vector_type(8)));
typedef float f32x4 __attribute__((ext_vector_type(4)));
typedef unsigned u32x4 __attribute__((ext_vector_type(4)));
constexpr int BM = 256, BK = 64, HALF = 128, HTB = HALF * BK * 2  , STAGE_BYTES = 8 * HTB, NXCD = 8, WGM = 8;

__host__ __device__ __forceinline__ int lds_byte(int r, int c) { const int st = (r >> 4) * 2 + (c >> 5), rr = r & 15, cc = c & 31, ob = rr * 64 + cc * 2; return st * 1024 + (ob ^ (((ob >> 9) & 1) << 5)); }
__host__ __device__ __forceinline__ void stage_rc(int b, int& R, int& C) { const int st = b / 1024, sb = b % 1024, swz = sb ^ (((sb >> 9) & 1) << 5); R = (st >> 1) * 16 + swz / 64; C = (st & 1) * 32 + (swz % 64) / 2; }
__host__ __device__ __forceinline__ int perm32(int rho) { const int n = rho >> 4, i = rho & 15; return 8 * (i >> 2) + 4 * n + (i & 3); }

struct Unit { int pm, pn; };
struct Gemm { const bf16_t* A; const bf16_t* Bt; int M, N, K, gap; };

struct StaticOrder {
    int nM, nN, nwg, G, c;
    __host__ __device__ void init(int M, int N, int G_, int c_) { nM = M / BM; nN = N / BM; nwg = nM * nN; G = G_; c = c_; }
    __host__ __device__ bool next(int i, Unit& u) const {
        const long L = (long)i * G + c; if (L >= nwg) return false;
        int wgid = (int)L; { const int q = nwg / NXCD, r = nwg % NXCD, xcd = wgid % NXCD, off = wgid / NXCD; wgid = (xcd < r ? xcd * (q + 1) : r * (q + 1) + (xcd - r) * q) + off; }
        const int nig = WGM * nN, gid = wgid / nig, fm = gid * WGM, gsz = (nM - fm) < WGM ? (nM - fm) : WGM;
        u.pm = fm + ((wgid % nig) % gsz); u.pn = (wgid % nig) / gsz; return true;
    }
    __device__ __forceinline__ void a_ready(const Unit&) const {}
    __device__ __forceinline__ void done(const Unit&) const {}
};
__device__ __forceinline__ unsigned cvt_pk_bf16(float lo, float hi) { unsigned r; asm volatile("v_cvt_pk_bf16_f32 %0, %1, %2" : "=v"(r) : "v"(lo), "v"(hi)); return r; }
template <class Epi, class Sched, bool ALIGN_EPI = false, bool SP2 = false>
__device__ __forceinline__ void gemm_phase(PG8_LAS unsigned char* lds, const Gemm g, const Sched& S, const Epi& E) {
    int tid_ = threadIdx.x; asm volatile("" : "+v"(tid_));
    const int tid = tid_, wid = __builtin_amdgcn_readfirstlane(tid >> 6), lane = tid & 63, wr = wid >> 2, wc = wid & 3, fr = lane & 15, fq = lane >> 4;
    const int K = g.K, nt = K / BK;
    unsigned voffA[2], voffB[2];
#pragma unroll
    for (int i = 0; i < 2; ++i) { int R, C; stage_rc(tid * 16 + i * 8192, R, C); const int Rb = Epi::PERM ? ((R & ~31) + perm32(R & 31)) : R;
        voffA[i] = (unsigned)(R * K + C) * 2u; voffB[i] = (unsigned)(Rb * K + C) * 2u; }
    const size_t kstep = (size_t)(BK * 2);
    const size_t hstep = (size_t)HALF * K * 2;
    const size_t tstep = 2 * hstep;
    const int agap = g.gap;
#define a_off(pm_) ((size_t)((pm_) * BM + agap * (1 + ((pm_) >> 5))) * (size_t)K * 2)
    const unsigned ldsw = (unsigned)wid * 1024u;
    const int aoff = lds_byte(wr * 64 + fr, fq * 8), boff = lds_byte(wc * 32 + fr, fq * 8);
#define PG8_SA(b, h) (((b) * 2 + (h)) * HTB)
#define PG8_SB(b, h) ((4 + (b) * 2 + (h)) * HTB)
#define PG8_STAGE(bufoff, gbase, voff) do { _Pragma("unroll") for (int _i = 0; _i < 2; ++_i) \
        __builtin_amdgcn_global_load_lds((const unsigned*)((const char*)(gbase) + (voff)[_i]), (PG8_LAS unsigned*)(lds + (bufoff) + ldsw + _i * 8192), 16, 0, 0); } while (0)
#define PG8_LDA(dst, b, h) do { _Pragma("unroll") for (int m = 0; m < 4; ++m) _Pragma("unroll") for (int k = 0; k < 2; ++k) dst[m][k] = *(const PG8_LAS bf16x8*)(lds + PG8_SA(b, h) + aoff + m * 2048 + k * 1024); } while (0)
#define PG8_LDB(dst, b, h) do { _Pragma("unroll") for (int n = 0; n < 2; ++n) _Pragma("unroll") for (int k = 0; k < 2; ++k) dst[n][k] = *(const PG8_LAS bf16x8*)(lds + PG8_SB(b, h) + boff + n * 2048 + k * 1024); } while (0)
#define PG8_MMA(ai, bj, At, Bt) do { __builtin_amdgcn_s_setprio(1); _Pragma("unroll") for (int m = 0; m < 4; ++m) _Pragma("unroll") for (int n = 0; n < 2; ++n) _Pragma("unroll") for (int k = 0; k < 2; ++k) \
        acc[ai][bj][m][n] = __builtin_amdgcn_mfma_f32_16x16x32_bf16(Bt[n][k], At[m][k], acc[ai][bj][m][n], 0, 0, 0); __builtin_amdgcn_s_setprio(0); } while (0)
#define PG8_WAIT_V(n) asm volatile("s_waitcnt vmcnt(" #n ")" ::: "memory")
#define PG8_WAIT_L(n) asm volatile("s_waitcnt lgkmcnt(" #n ")" ::: "memory")
#define PG8_BAR __builtin_amdgcn_s_barrier()
#define PG8_SCHED __builtin_amdgcn_sched_barrier(0)
    Unit cur, nxt; int ui = 0;
    if (!S.next(0, cur)) return;
    f32x4 acc[2][2][4][2];
#pragma unroll
    for (int a = 0; a < 2; ++a)
#pragma unroll
        for (int b = 0; b < 2; ++b)
#pragma unroll
            for (int m = 0; m < 4; ++m)
#pragma unroll
                for (int n = 0; n < 2; ++n) acc[a][b][m][n] = (f32x4){0.f, 0.f, 0.f, 0.f};
    if constexpr (Epi::PRELOAD) E.preload(acc, cur, wr, wc, fr, fq);
    bf16x8 At[4][2], B0[2][2], B1[2][2];
    const char* cA = (const char*)g.A + a_off(cur.pm); const char* cB = (const char*)g.Bt + (size_t)cur.pn * tstep;
    S.a_ready(cur);
    if constexpr (SP2) {
        PG8_STAGE(PG8_SB(0, 0), cB, voffB); PG8_STAGE(PG8_SB(0, 1), cB + hstep, voffB); PG8_STAGE(PG8_SA(0, 0), cA, voffA); PG8_STAGE(PG8_SA(0, 1), cA + hstep, voffA);
        if (wr == 1) PG8_BAR;
        PG8_WAIT_V(2); PG8_BAR;
        PG8_STAGE(PG8_SB(1, 0), cB + kstep, voffB); PG8_STAGE(PG8_SA(1, 0), cA + kstep, voffA); PG8_STAGE(PG8_SB(1, 1), cB + hstep + kstep, voffB);
        PG8_WAIT_V(6); PG8_BAR;
    } else {
        PG8_STAGE(PG8_SB(0, 0), cB, voffB); PG8_STAGE(PG8_SA(0, 0), cA, voffA); PG8_STAGE(PG8_SB(0, 1), cB + hstep, voffB); PG8_STAGE(PG8_SA(0, 1), cA + hstep, voffA);
        if (wr == 1) PG8_BAR;
        PG8_WAIT_V(4); PG8_BAR;
        PG8_STAGE(PG8_SB(1, 0), cB + kstep, voffB); PG8_STAGE(PG8_SA(1, 0), cA + kstep, voffA); PG8_STAGE(PG8_SB(1, 1), cB + hstep + kstep, voffB);
        PG8_WAIT_V(6); PG8_BAR;
    }
    for (;;) {
        const bool has_next = S.next(ui + 1, nxt);
        const char* nA = has_next ? (const char*)g.A + a_off(nxt.pm) : cA; const char* nB = has_next ? (const char*)g.Bt + (size_t)nxt.pn * tstep : cB;
        for (int t = 0; t < nt; t += 2) {
            const bool last = (t == nt - 2);
            const char* a1 = cA + (size_t)(t + 1) * kstep;
            const char* a2 = last ? nA : cA + (size_t)(t + 2) * kstep; const char* b2 = last ? nB : cB + (size_t)(t + 2) * kstep;
            const char* a3 = a2 + kstep; const char* b3 = b2 + kstep;
            if (last && has_next) S.a_ready(nxt);
            if constexpr (SP2) {
            PG8_LDB(B0, 0, 0); PG8_LDB(B1, 0, 1); PG8_SCHED; PG8_LDA(At, 0, 0); PG8_STAGE(PG8_SA(1, 1), a1 + hstep, voffA);
            PG8_WAIT_V(8); PG8_WAIT_L(0); PG8_BAR; PG8_MMA(0, 0, At, B0); PG8_MMA(0, 1, At, B1); PG8_BAR; PG8_SCHED;
            PG8_LDA(At, 0, 1); PG8_STAGE(PG8_SB(0, 0), b2, voffB); PG8_STAGE(PG8_SB(0, 1), b2 + hstep, voffB); PG8_STAGE(PG8_SA(0, 0), a2, voffA);
            PG8_WAIT_V(8); PG8_WAIT_L(0); PG8_BAR; PG8_MMA(1, 0, At, B0); PG8_MMA(1, 1, At, B1); PG8_BAR; PG8_SCHED;
            PG8_LDB(B0, 1, 0); PG8_LDB(B1, 1, 1); PG8_SCHED; PG8_LDA(At, 1, 0); PG8_STAGE(PG8_SA(0, 1), a2 + hstep, voffA);
            PG8_WAIT_V(8); PG8_WAIT_L(0); PG8_BAR; PG8_MMA(0, 0, At, B0); PG8_MMA(0, 1, At, B1); PG8_BAR; PG8_SCHED;
            PG8_LDA(At, 1, 1); PG8_STAGE(PG8_SB(1, 0), b3, voffB); PG8_STAGE(PG8_SB(1, 1), b3 + hstep, voffB); PG8_STAGE(PG8_SA(1, 0), a3, voffA);
            PG8_WAIT_V(8); PG8_WAIT_L(0); PG8_BAR; PG8_MMA(1, 0, At, B0); PG8_MMA(1, 1, At, B1); PG8_BAR; PG8_SCHED;
            } else {
            PG8_LDB(B0, 0, 0); PG8_SCHED; PG8_LDA(At, 0, 0); PG8_STAGE(PG8_SA(1, 1), a1 + hstep, voffA);
            PG8_WAIT_L(8); PG8_BAR; PG8_WAIT_L(0); PG8_MMA(0, 0, At, B0); PG8_BAR; PG8_SCHED;
            PG8_LDB(B1, 0, 1); PG8_STAGE(PG8_SB(0, 0), b2, voffB);
            PG8_BAR; PG8_WAIT_L(0); PG8_MMA(0, 1, At, B1); PG8_BAR;
            PG8_LDA(At, 0, 1); PG8_STAGE(PG8_SA(0, 0), a2, voffA);
            PG8_BAR; PG8_WAIT_L(0); PG8_MMA(1, 0, At, B0); PG8_BAR; PG8_SCHED;
            PG8_STAGE(PG8_SB(0, 1), b2 + hstep, voffB);
            PG8_WAIT_V(6); PG8_BAR; PG8_MMA(1, 1, At, B1); PG8_BAR;
            PG8_LDB(B0, 1, 0); PG8_SCHED; PG8_LDA(At, 1, 0); PG8_STAGE(PG8_SA(0, 1), a2 + hstep, voffA);
            PG8_WAIT_L(8); PG8_BAR; PG8_WAIT_L(0); PG8_MMA(0, 0, At, B0); PG8_BAR; PG8_SCHED;
            PG8_LDB(B1, 1, 1); PG8_STAGE(PG8_SB(1, 0), b3, voffB);
            PG8_BAR; PG8_WAIT_L(0); PG8_MMA(0, 1, At, B1); PG8_BAR;
            PG8_LDA(At, 1, 1); PG8_STAGE(PG8_SA(1, 0), a3, voffA);
            PG8_BAR; PG8_WAIT_L(0); PG8_MMA(1, 0, At, B0); PG8_BAR; PG8_SCHED;
            PG8_STAGE(PG8_SB(1, 1), b3 + hstep, voffB);
            PG8_WAIT_V(6); PG8_BAR; PG8_MMA(1, 1, At, B1); PG8_BAR;
            }
        }
        if constexpr (ALIGN_EPI) { if (wr == 0) PG8_BAR; }
        if constexpr (!Epi::AFTER_DRAIN) { E(acc, cur, wr, wc, fr, fq); S.done(cur); }
        if (!has_next) break;
#pragma unroll
        for (int a = 0; a < 2; ++a)
#pragma unroll
            for (int b = 0; b < 2; ++b)
#pragma unroll
                for (int m = 0; m < 4; ++m)
#pragma unroll
                    for (int n = 0; n < 2; ++n) acc[a][b][m][n] = (f32x4){0.f, 0.f, 0.f, 0.f};
        if constexpr (Epi::PRELOAD) { E.preload(acc, nxt, wr, wc, fr, fq); PG8_WAIT_V(0); }
        cur = nxt; cA = nA; cB = nB; ++ui;
        if constexpr (ALIGN_EPI) { if (wr == 1) PG8_BAR; }
    }
    PG8_WAIT_V(0);
    if constexpr (!ALIGN_EPI) { if (wr == 0) PG8_BAR; }
    PG8_BAR;
    if constexpr (Epi::AFTER_DRAIN) { E.fused(acc, cur, wr, wc, fr, fq, lds, wid, lane); S.done(cur); }
#undef PG8_SA
#undef PG8_SB
#undef PG8_STAGE
#undef PG8_LDA
#undef PG8_LDB
#undef PG8_MMA
#undef PG8_WAIT_V
#undef PG8_WAIT_L
#undef PG8_BAR
#undef PG8_SCHED
}
}

#define LAS __attribute__((address_space(3)))
typedef unsigned short bf16;
typedef unsigned u32x4 __attribute__((ext_vector_type(4)));
typedef unsigned u32x2 __attribute__((ext_vector_type(2)));
typedef float f32x4 __attribute__((ext_vector_type(4)));
typedef short bf16x8 __attribute__((ext_vector_type(8)));
constexpr int D = 1024, SEQ = 8192, NB = 2, NMETA = 16, TT = SEQ + NMETA, M = NB * SEQ, DEPTH = 4, DIN = 1536, FF = 4096, DH = 512;
constexpr float EPS = 1e-6f;
constexpr size_t MiB = 1u << 20;
constexpr size_t WS_CTL = 0;
constexpr size_t WS_POOLW = 1 * MiB, WS_GR = WS_POOLW + 512 * 1024, WS_GI = WS_GR + 256 * 1024;
constexpr size_t WS_SP = 2 * MiB, WS_HMETA = WS_SP + 64 * 1024, WS_MIDMETA = WS_HMETA + 64 * 1024;
constexpr size_t WS_SS = 3 * MiB, WS_CARA = 4 * MiB, WS_CARH = WS_CARA + 512 * 1024;
constexpr size_t WS_W = 8 * MiB, W_LAYER = 21 * MiB, W_IN = 0, W_OUT = 3 * MiB, W_UP = 5 * MiB, W_DOWN = 13 * MiB;
constexpr size_t WS_HB = 92 * MiB, WS_MID = 124 * MiB;
constexpr size_t WS_PROJ = WS_MID, WS_Y = WS_MID + 48 * MiB + 256 * 1024, WS_HL = WS_Y + 32 * MiB + 256 * 1024, WS_P = WS_HL + 32 * MiB + 256 * 1024, WS_END = 256 * MiB;
static_assert(WS_PROJ + (size_t)NB * TT * DIN * 2 <= WS_Y && WS_Y + (size_t)NB * TT * D * 2 <= WS_HL && WS_HL + (size_t)NB * TT * DH * 2 <= WS_P && WS_P + (size_t)NB * TT * DH * 2 <= WS_END, "ws map");
static_assert(WS_W + DEPTH * W_LAYER <= WS_HB && WS_HB + (size_t)M * D * 2 <= WS_MID && WS_MID + (size_t)M * FF * 2 <= WS_END, "ws map 2");
constexpr int LDS_HL = 0, LDS_P = 65536, LDS_CST = 131072, LDS_CARR = 147456, LDS_RED1 = 149504, LDS_RED2 = 152064, LDS_CARRY = 154624;
constexpr int LDS_XST = 163840 - 64;
constexpr int LDS_BYTES = 163840;
constexpr size_t WS_FLAG = 64 * 1024;

struct Params {
    const float* in[20];
    float* out;
    unsigned char* ws;
};

__device__ __forceinline__ Params launder(const Params& p) {
    Params q = p;
#pragma unroll
    for (int i = 0; i < 20; ++i) { const __attribute__((address_space(1))) float* g = (const __attribute__((address_space(1))) float*)q.in[i]; asm volatile("" : "+s"(g)); q.in[i] = (const float*)g; }
    { __attribute__((address_space(1))) float* g = (__attribute__((address_space(1))) float*)q.out; asm volatile("" : "+s"(g)); q.out = (float*)g; }
    { __attribute__((address_space(1))) unsigned char* g = (__attribute__((address_space(1))) unsigned char*)q.ws; asm volatile("" : "+s"(g)); q.ws = (unsigned char*)g; }
    return q;
}
__device__ __forceinline__ unsigned cvt_pk(float lo, float hi) { return pg8::cvt_pk_bf16(lo, hi); }
__device__ __forceinline__ float bf_lo(unsigned w) { return __builtin_bit_cast(float, w << 16); }
__device__ __forceinline__ float bf_hi(unsigned w) { return __builtin_bit_cast(float, w & 0xffff0000u); }
__device__ __forceinline__ void unpack8(const u32x4 w, float (&f)[8]) {
    f[0] = bf_lo(w.x); f[1] = bf_hi(w.x); f[2] = bf_lo(w.y); f[3] = bf_hi(w.y); f[4] = bf_lo(w.z); f[5] = bf_hi(w.z); f[6] = bf_lo(w.w); f[7] = bf_hi(w.w);
}
__device__ __forceinline__ u32x4 pack8(const float (&f)[8]) { u32x4 w; w.x = cvt_pk(f[0], f[1]); w.y = cvt_pk(f[2], f[3]); w.z = cvt_pk(f[4], f[5]); w.w = cvt_pk(f[6], f[7]); return w; }
__device__ __forceinline__ float wave_sum(float v) {
#pragma unroll
    for (int o = 1; o < 64; o <<= 1) v += __shfl_xor(v, o);
    return v;
}
template <int CTRL> __device__ __forceinline__ float dppf(float old, float src) {
    return __builtin_bit_cast(float, __builtin_amdgcn_update_dpp(__builtin_bit_cast(int, old), __builtin_bit_cast(int, src), CTRL, 0xf, 0xf, false));
}
template <int DD> __device__ __forceinline__ float shiftd(float cur, float prev) {
    const float t = dppf<0x100 + (16 - DD)>(0.f, prev);
    return dppf<0x110 + DD>(t, cur);
}
__device__ __forceinline__ float sigm(float v) { return __builtin_amdgcn_rcpf(1.0f + __expf(-v)); }
__device__ __forceinline__ int outchan(int n, int rho) { return 32 * (n >> 1) + 8 * (rho >> 2) + 4 * (n & 1) + (rho & 3); }

__device__ __forceinline__ float row_rstd(const float* ss, int r) {
    const f32x4* s4 = (const f32x4*)(ss + (size_t)r * 16);
    const f32x4 a = s4[0], b = s4[1], c = s4[2], d = s4[3];
    const float s = ((a.x + a.y) + (a.z + a.w)) + ((b.x + b.y) + (b.z + b.w)) + ((c.x + c.y) + (c.z + c.w)) + ((d.x + d.y) + (d.z + d.w));
    return 1.0f / sqrtf(s * (1.0f / D) + EPS);
}
__device__ __forceinline__ void rows_rstd(const float* ss, int rowbase  , int fr, float (&rs)[2][4]) {
    const int lane = threadIdx.x & 63;
    const float r0 = row_rstd(ss, rowbase + lane), r1 = row_rstd(ss, rowbase + 128 + lane);
#pragma unroll
    for (int m = 0; m < 4; ++m) { rs[0][m] = __shfl(r0, m * 16 + fr); rs[1][m] = __shfl(r1, m * 16 + fr); }
}
struct EpiIn {
    static constexpr bool PERM = true, AFTER_DRAIN = false, PRELOAD = false;
    bf16* P; const float* ss; const LAS float* rl; int pmc;
    __device__ __forceinline__ void operator()(const f32x4 (&acc)[2][2][4][2], const pg8::Unit& u, int wr, int wc, int fr, int fq) const {
        const int row0 = u.pm * 256 + wr * 64 + fr, col0 = u.pn * 256 + wc * 32 + 8 * fq;
        float rsv[2][4];
        if (u.pm == pmc) {
#pragma unroll
            for (int ai = 0; ai < 2; ++ai)
#pragma unroll
                for (int m = 0; m < 4; ++m) rsv[ai][m] = rl[ai * 128 + wr * 64 + m * 16 + fr];
        } else {
#pragma unroll
            for (int ai = 0; ai < 2; ++ai)
#pragma unroll
                for (int m = 0; m < 4; ++m) { rsv[ai][m] = row_rstd(ss, row0 + ai * 128 + m * 16); asm volatile("" ::: "memory"); }
        }
#pragma unroll
        for (int ai = 0; ai < 2; ++ai)
#pragma unroll
            for (int m = 0; m < 4; ++m) {
                const int r = row0 + ai * 128 + m * 16; const float rs = rsv[ai][m];
                bf16* rowp = P + (size_t)(r + NMETA * (1 + (r >> 13))) * DIN + col0;
#pragma unroll
                for (int bj = 0; bj < 2; ++bj) { const f32x4 v0 = acc[ai][bj][m][0] * rs, v1 = acc[ai][bj][m][1] * rs;
                    u32x4 w; w.x = cvt_pk(v0[0], v0[1]); w.y = cvt_pk(v0[2], v0[3]); w.z = cvt_pk(v1[0], v1[1]); w.w = cvt_pk(v1[2], v1[3]);
                    *(u32x4*)(rowp + bj * 128) = w; }
            }
    }
};
struct EpiUp {
    static constexpr bool PERM = true, AFTER_DRAIN = false, PRELOAD = false;
    bf16* O; const float* ss; const LAS float* rl; int pmc;
    __device__ __forceinline__ void operator()(const f32x4 (&acc)[2][2][4][2], const pg8::Unit& u, int wr, int wc, int fr, int fq) const {
        const int row0 = u.pm * 256 + wr * 64 + fr, col0 = u.pn * 256 + wc * 32 + 8 * fq;
        float rsv[2][4];
        if (u.pm == pmc) {
#pragma unroll
            for (int ai = 0; ai < 2; ++ai)
#pragma unroll
                for (int m = 0; m < 4; ++m) rsv[ai][m] = rl[ai * 128 + wr * 64 + m * 16 + fr];
        } else {
#pragma unroll
            for (int ai = 0; ai < 2; ++ai)
#pragma unroll
                for (int m = 0; m < 4; ++m) { rsv[ai][m] = row_rstd(ss, row0 + ai * 128 + m * 16); asm volatile("" ::: "memory"); }
        }
#pragma unroll
        for (int ai = 0; ai < 2; ++ai)
#pragma unroll
            for (int m = 0; m < 4; ++m) {
                const int r = row0 + ai * 128 + m * 16; const float rs = rsv[ai][m];
                bf16* rowp = O + (size_t)r * FF + col0;
#pragma unroll
                for (int bj = 0; bj < 2; ++bj) { f32x4 v0 = acc[ai][bj][m][0] * rs, v1 = acc[ai][bj][m][1] * rs;
#pragma unroll
                    for (int j = 0; j < 4; ++j) { v0[j] = fmaxf(v0[j], 0.f); v0[j] *= v0[j]; v1[j] = fmaxf(v1[j], 0.f); v1[j] *= v1[j]; }
                    u32x4 w; w.x = cvt_pk(v0[0], v0[1]); w.y = cvt_pk(v0[2], v0[3]); w.z = cvt_pk(v1[0], v1[1]); w.w = cvt_pk(v1[2], v1[3]);
                    *(u32x4*)(rowp + bj * 128) = w; }
            }
    }
};
struct EpiRes {
    static constexpr bool PERM = true, AFTER_DRAIN = false, PRELOAD = true;
    bf16* hb; float* ssn;
    __device__ __forceinline__ void preload(f32x4 (&acc)[2][2][4][2], const pg8::Unit& u, int wr, int wc, int fr, int fq) const {
        const int row0 = u.pm * 256 + wr * 64 + fr, col0 = u.pn * 256 + wc * 32 + 8 * fq;
#pragma unroll
        for (int ai = 0; ai < 2; ++ai)
#pragma unroll
            for (int m = 0; m < 4; ++m) { const size_t off = (size_t)(row0 + ai * 128 + m * 16) * D + col0;
#pragma unroll
                for (int bj = 0; bj < 2; ++bj) { const u32x4 w = *(const u32x4*)(hb + off + bj * 128);
                    acc[ai][bj][m][0] = (f32x4){bf_lo(w.x), bf_hi(w.x), bf_lo(w.y), bf_hi(w.y)}; acc[ai][bj][m][1] = (f32x4){bf_lo(w.z), bf_hi(w.z), bf_lo(w.w), bf_hi(w.w)}; } }
    }
    __device__ __forceinline__ void operator()(const f32x4 (&acc)[2][2][4][2], const pg8::Unit& u, int wr, int wc, int fr, int fq) const {
        const int row0 = u.pm * 256 + wr * 64 + fr, col0 = u.pn * 256 + wc * 32 + 8 * fq;
#pragma unroll
        for (int ai = 0; ai < 2; ++ai)
#pragma unroll
            for (int m = 0; m < 4; ++m) {
                const int r = row0 + ai * 128 + m * 16; const size_t off = (size_t)r * D + col0; float s = 0.f;
#pragma unroll
                for (int bj = 0; bj < 2; ++bj) {
                    const f32x4 o0 = acc[ai][bj][m][0], o1 = acc[ai][bj][m][1];
                    s += (o0[0] * o0[0] + o0[1] * o0[1]) + (o0[2] * o0[2] + o0[3] * o0[3]) + (o1[0] * o1[0] + o1[1] * o1[1]) + (o1[2] * o1[2] + o1[3] * o1[3]);
                    u32x4 w; w.x = cvt_pk(o0[0], o0[1]); w.y = cvt_pk(o0[2], o0[3]); w.z = cvt_pk(o1[0], o1[1]); w.w = cvt_pk(o1[2], o1[3]);
                    *(u32x4*)(hb + off + bj * 128) = w; }
                s += __shfl_xor(s, 16); s += __shfl_xor(s, 32);
                if (fq == 0) ssn[(size_t)r * 16 + u.pn * 4 + wc] = s;
            }
    }
};

struct TItem { const float* W; const float* gk; bf16* WT; int K, N, item; };
__device__ __forceinline__ void titem_load(const TItem& t, int lane, f32x4 (&v)[8], float (&gs)[8]) {
    const int nblk = t.N / 32, kb = t.item / nblk, nb = t.item % nblk, k0 = 64 * kb, n0 = 32 * nb, lr = lane >> 3, lc = (lane & 7) * 4;
#pragma unroll
    for (int i = 0; i < 8; ++i) { v[i] = *(const f32x4*)(t.W + (size_t)(k0 + 8 * i + lr) * t.N + n0 + lc); gs[i] = t.gk ? t.gk[k0 + 8 * i + lr] : 1.0f; }
}
__device__ __forceinline__ void titem_store(const TItem& t, int lane, const f32x4 (&v)[8], const float (&gs)[8], LAS float* scr) {
    const int nblk = t.N / 32, kb = t.item / nblk, nb = t.item % nblk, k0 = 64 * kb, n0 = 32 * nb, lr = lane >> 3, lc = (lane & 7) * 4;
#pragma unroll
    for (int i = 0; i < 8; ++i) { LAS float* d = scr + (8 * i + lr) * 33 + lc; d[0] = v[i].x * gs[i]; d[1] = v[i].y * gs[i]; d[2] = v[i].z * gs[i]; d[3] = v[i].w * gs[i]; }
    asm volatile("s_waitcnt lgkmcnt(0)" ::: "memory");
    const int c = lane & 7;
#pragma unroll
    for (int j = 0; j < 4; ++j) { const int n = (lane >> 3) + 8 * j; const LAS float* s = scr + (8 * c) * 33 + n;
        u32x4 o; o.x = cvt_pk(s[0 * 33], s[1 * 33]); o.y = cvt_pk(s[2 * 33], s[3 * 33]); o.z = cvt_pk(s[4 * 33], s[5 * 33]); o.w = cvt_pk(s[6 * 33], s[7 * 33]);
        *(u32x4*)(t.WT + (size_t)(n0 + n) * t.K + k0 + 8 * c) = o; }
    asm volatile("s_waitcnt lgkmcnt(0)" ::: "memory");
}
__device__ __forceinline__ TItem titem_decode(const Params& p, int it) {
    constexpr int I_IN = 16 * 48, I_OUT = 16 * 32, I_UP = 16 * 128, I_DN = 64 * 32, I_PW = 4 * 8, I_G = 8 * 2, I_L = I_IN + I_OUT + I_UP + I_DN + I_PW + 2 * I_G;
    const int l = it / I_L; int r = it % I_L; unsigned char* ws = p.ws; unsigned char* wl = ws + WS_W + (size_t)l * W_LAYER; TItem t;
    if (r < I_IN) { t = TItem{p.in[3] + (size_t)l * D * DIN, p.in[2] + l * D, (bf16*)(wl + W_IN), D, DIN, r}; return t; } r -= I_IN;
    if (r < I_OUT) { t = TItem{p.in[15] + (size_t)l * D * D, p.in[14] + l * D, (bf16*)(wl + W_OUT), D, D, r}; return t; } r -= I_OUT;
    if (r < I_UP) { t = TItem{p.in[17] + (size_t)l * D * FF, p.in[16] + l * D, (bf16*)(wl + W_UP), D, FF, r}; return t; } r -= I_UP;
    if (r < I_DN) { t = TItem{p.in[18] + (size_t)l * FF * D, nullptr, (bf16*)(wl + W_DOWN), FF, D, r}; return t; } r -= I_DN;
    if (r < I_PW) { const int g = r / 8; t = TItem{p.in[4] + (size_t)(l * 4 + g) * 16384, nullptr, (bf16*)(ws + WS_POOLW) + (size_t)(l * 4 + g) * 16384, 128, 128, r % 8}; return t; } r -= I_PW;
    if (r < I_G) { const int h = r / 2; t = TItem{p.in[9] + (size_t)(l * 8 + h) * 4096, nullptr, (bf16*)(ws + WS_GR) + (size_t)(l * 8 + h) * 4096, 64, 64, r % 2}; return t; } r -= I_G;
    { const int h = r / 2; t = TItem{p.in[11] + (size_t)(l * 8 + h) * 4096, nullptr, (bf16*)(ws + WS_GI) + (size_t)(l * 8 + h) * 4096, 64, 64, r % 2}; }
    return t;
}
constexpr int TITEMS_PER_LAYER = 16 * 48 + 16 * 32 + 16 * 128 + 64 * 32 + 4 * 8 + 2 * 8 * 2;
__device__ __forceinline__ void convert_items(const Params& p_, LAS unsigned char* lds, int it_lo, int it_hi, int wblock, int nworkers) {
    const Params p = launder(p_);
    int tid_ = threadIdx.x; asm volatile("" : "+v"(tid_));
    const int lane = tid_ & 63, wid = __builtin_amdgcn_readfirstlane(tid_ >> 6);
    LAS float* scr = (LAS float*)(lds + wid * 16384);
    const int worker = wblock * 8 + wid;
    if (it_lo + worker < it_hi) {
        TItem cur = titem_decode(p, it_lo + worker); f32x4 v[8]; float gs[8]; titem_load(cur, lane, v, gs);
        for (int it = it_lo + worker; it < it_hi; it += nworkers) {
            const bool more = it + nworkers < it_hi; TItem nxt = cur; f32x4 nv[8]; float ngs[8];
            if (more) { nxt = titem_decode(p, it + nworkers); titem_load(nxt, lane, nv, ngs); }
            titem_store(cur, lane, v, gs, scr);
            if (more) { cur = nxt;
#pragma unroll
                for (int i = 0; i < 8; ++i) { v[i] = nv[i]; gs[i] = ngs[i]; } }
        }
    }
}
__device__ __forceinline__ void prologue(const Params& p_, LAS unsigned char* lds, int G) {
    const Params p = launder(p_);
    int tid_ = threadIdx.x; asm volatile("" : "+v"(tid_));
    const int tid = tid_, lane = tid & 63, wid = __builtin_amdgcn_readfirstlane(tid >> 6);
    const int gw = blockIdx.x * 8 + wid, NGW = G * 8;
    unsigned char* ws = p.ws;
    convert_items(p_, lds, 0, (G == 256 ? 1 : DEPTH) * TITEMS_PER_LAYER, (int)blockIdx.x, NGW);
    const float* x = p.in[0]; bf16* hb = (bf16*)(ws + WS_HB); float* ss = (float*)(ws + WS_SS);
    for (int m2 = gw; m2 < M / 2; m2 += NGW) {
        f32x4 v[2][4]; float s[2] = {0.f, 0.f};
#pragma unroll
        for (int r = 0; r < 2; ++r) { const f32x4* xr = (const f32x4*)(x + (size_t)(2 * m2 + r) * D) + lane;
#pragma unroll
            for (int j = 0; j < 4; ++j) v[r][j] = xr[64 * j]; }
#pragma unroll
        for (int r = 0; r < 2; ++r) {
#pragma unroll
            for (int j = 0; j < 4; ++j) s[r] += (v[r][j].x * v[r][j].x + v[r][j].y * v[r][j].y) + (v[r][j].z * v[r][j].z + v[r][j].w * v[r][j].w);
            s[r] = wave_sum(s[r]);
            u32x2* o8 = (u32x2*)(hb + (size_t)(2 * m2 + r) * D) + lane;
#pragma unroll
            for (int j = 0; j < 4; ++j) { u32x2 w; w.x = cvt_pk(v[r][j].x, v[r][j].y); w.y = cvt_pk(v[r][j].z, v[r][j].w); o8[64 * j] = w; }
            if (lane < 16) ss[(size_t)(2 * m2 + r) * 16 + lane] = lane == 0 ? s[r] : 0.f;
        }
    }
    float* hm = (float*)(ws + WS_HMETA); float* sp = (float*)(ws + WS_SP);
    for (int i = blockIdx.x * 512 + tid; i < NMETA * D; i += G * 512) hm[i] = p.in[1][i];
    for (int i = blockIdx.x * 512 + tid; i < DEPTH * DH; i += G * 512) sp[i] = log1pf(expf(-p.in[13][i]));
}

template <int MODE> __device__ __forceinline__ void meta_tasks(const Params& p_, LAS unsigned char* lds, int G, const bf16* Ab, int lda, const bf16* Bt, int K, int ntasks) {
    const Params p = launder(p_);
    int tid_ = threadIdx.x; asm volatile("" : "+v"(tid_));
    const int tid = tid_, lane = tid & 63, wid = __builtin_amdgcn_readfirstlane(tid >> 6), fr = lane & 15, fq = lane >> 4;
    float* hm = (float*)(p.ws + WS_HMETA);
    LAS float* red = (LAS float*)lds;
    for (int task = G - 1 - (int)blockIdx.x; task < ntasks; task += G) {
        const int n0 = task * 16, kw = K / 8, k0 = wid * kw;
        f32x4 acc = {0.f, 0.f, 0.f, 0.f}; float ssq = 0.f;
        for (int kb = k0; kb < k0 + kw; kb += 128) {
            bf16x8 af[4], bfr[4]; f32x4 a0[4], a1[4];
#pragma unroll
            for (int i = 0; i < 4; ++i) { const int kk = kb + 32 * i;
                if (MODE == 1) af[i] = *(const bf16x8*)(Ab + (size_t)fr * lda + kk + 8 * fq);
                else { a0[i] = *(const f32x4*)(hm + fr * D + kk + 8 * fq); a1[i] = *(const f32x4*)(hm + fr * D + kk + 8 * fq + 4); }
                bfr[i] = *(const bf16x8*)(Bt + (size_t)(n0 + fr) * K + kk + 8 * fq); }
#pragma unroll
            for (int i = 0; i < 4; ++i) {
                if (MODE != 1) { ssq += (a0[i].x * a0[i].x + a0[i].y * a0[i].y) + (a0[i].z * a0[i].z + a0[i].w * a0[i].w) + (a1[i].x * a1[i].x + a1[i].y * a1[i].y) + (a1[i].z * a1[i].z + a1[i].w * a1[i].w);
                    u32x4 w; w.x = cvt_pk(a0[i].x, a0[i].y); w.y = cvt_pk(a0[i].z, a0[i].w); w.z = cvt_pk(a1[i].x, a1[i].y); w.w = cvt_pk(a1[i].z, a1[i].w); af[i] = __builtin_bit_cast(bf16x8, w); }
                acc = __builtin_amdgcn_mfma_f32_16x16x32_bf16(bfr[i], af[i], acc, 0, 0, 0); }
        }
        ssq += __shfl_xor(ssq, 16); ssq += __shfl_xor(ssq, 32);
        LAS float* rp = red + (wid * 64 + lane) * 5;
        rp[0] = acc[0]; rp[1] = acc[1]; rp[2] = acc[2]; rp[3] = acc[3]; rp[4] = ssq;
        __syncthreads();
        if (wid == 0) {
            float a0 = 0.f, a1 = 0.f, a2 = 0.f, a3 = 0.f, sq = 0.f;
#pragma unroll
            for (int w = 0; w < 8; ++w) { const LAS float* q = red + (w * 64 + lane) * 5; a0 += q[0]; a1 += q[1]; a2 += q[2]; a3 += q[3]; sq += q[4]; }
            const int col = n0 + 4 * fq;
            if (MODE == 1) { f32x4* hp = (f32x4*)(hm + fr * D + col); f32x4 h = *hp; h.x += a0; h.y += a1; h.z += a2; h.w += a3; *hp = h; }
            else {
                const float rs = 1.0f / sqrtf(sq * (1.0f / D) + EPS); a0 *= rs; a1 *= rs; a2 *= rs; a3 *= rs;
                if (MODE == 0) { u32x2 w; w.x = cvt_pk(a0, a1); w.y = cvt_pk(a2, a3); bf16* pr = (bf16*)(p.ws + WS_PROJ);
                    *(u32x2*)(pr + (size_t)fr * DIN + col) = w; *(u32x2*)(pr + (size_t)(TT + fr) * DIN + col) = w; }
                else { a0 = fmaxf(a0, 0.f); a1 = fmaxf(a1, 0.f); a2 = fmaxf(a2, 0.f); a3 = fmaxf(a3, 0.f);
                    u32x2 w; w.x = cvt_pk(a0 * a0, a1 * a1); w.y = cvt_pk(a2 * a2, a3 * a3); *(u32x2*)((bf16*)(p.ws + WS_MIDMETA) + (size_t)fr * FF + col) = w; }
            }
        }
        __syncthreads();
    }
}

__device__ __forceinline__ void m1_phase(const Params& p_, LAS unsigned char* lds, int G, int l) {
    const Params p = launder(p_);
    int tid_ = threadIdx.x; asm volatile("" : "+v"(tid_));
    const int tid = tid_, lane = tid & 63, wid = __builtin_amdgcn_readfirstlane(tid >> 6), fr = lane & 15, fq = lane >> 4;
    LAS float* cst = (LAS float*)lds;
    for (int i = tid; i < 8 * DH; i += 512) { const int row = i >> 9, ch = i & 511; float v;
        if (row < 4) v = p.in[7][(l * 4 + row) * DH + ch]; else if (row == 4) v = p.in[8][l * DH + ch]; else if (row == 5) v = p.in[10][l * DH + ch];
        else if (row == 6) v = p.in[12][l * DH + ch]; else v = ((const float*)(p.ws + WS_SP))[l * DH + ch];
        cst[i] = v; }
    const bf16* proj = (const bf16*)(p.ws + WS_PROJ);
    const bf16* Wr = (const bf16*)(p.ws + WS_GR) + (size_t)(l * 8 + wid) * 4096; const bf16* Wi = (const bf16*)(p.ws + WS_GI) + (size_t)(l * 8 + wid) * 4096;
    LAS bf16x8* wl = (LAS bf16x8*)(lds + 16384 + wid * 16384) + lane;
#pragma unroll
    for (int n = 0; n < 4; ++n)
#pragma unroll
        for (int ks = 0; ks < 2; ++ks) {
            wl[((n * 2 + ks) * 2 + 0) * 64] = *(const bf16x8*)(Wr + outchan(n, fr) * 64 + 32 * ks + 8 * fq);
            wl[((n * 2 + ks) * 2 + 1) * 64] = *(const bf16x8*)(Wi + outchan(n, fr) * 64 + 32 * ks + 8 * fq); }
    __syncthreads();
    bf16* hl = (bf16*)(p.ws + WS_HL); bf16* Pp = (bf16*)(p.ws + WS_P);
    float* carA = (float*)(p.ws + WS_CARA); float* carH = (float*)(p.ws + WS_CARH);
    for (int unit = blockIdx.x; unit < 256; unit += G) {
        const int b = unit >> 7, c = unit & 127, t0 = c ? NMETA + 64 * c : 0, NM = c ? 4 : 5;
        float Hc[16], Pc[16];
#pragma unroll
        for (int k = 0; k < 16; ++k) { Hc[k] = 0.f; Pc[k] = 1.f; }
        u32x4 raw[2][4];
#pragma unroll
        for (int ks = 0; ks < 2; ++ks)
#pragma unroll
            for (int d = 0; d < 4; ++d) { const int tt = t0 + fr - 3 + d; raw[ks][d] = (u32x4){0u, 0u, 0u, 0u};
                if (tt >= 0) raw[ks][d] = *(const u32x4*)(proj + ((size_t)b * TT + tt) * DIN + DH + wid * 64 + 32 * ks + 8 * fq); }
#pragma unroll 1
        for (int m = 0; m < NM; ++m) {
            const int t = t0 + 16 * m + fr; const size_t rowg = (size_t)b * TT + t;
            u32x4 nraw[2][4];
#pragma unroll
            for (int ks = 0; ks < 2; ++ks)
#pragma unroll
                for (int d = 0; d < 4; ++d) { nraw[ks][d] = (u32x4){0u, 0u, 0u, 0u};
                    if (m + 1 < NM) nraw[ks][d] = *(const u32x4*)(proj + ((size_t)b * TT + t + 13 + d) * DIN + DH + wid * 64 + 32 * ks + 8 * fq); }
            float xc[2][8]; bf16x8 frag[2];
#pragma unroll
            for (int ks = 0; ks < 2; ++ks) {
                const int chb = wid * 64 + 32 * ks + 8 * fq;
                { const f32x4 c0 = *(const LAS f32x4*)(cst + 4 * DH + chb), c1 = *(const LAS f32x4*)(cst + 4 * DH + chb + 4);
                  xc[ks][0] = c0.x; xc[ks][1] = c0.y; xc[ks][2] = c0.z; xc[ks][3] = c0.w; xc[ks][4] = c1.x; xc[ks][5] = c1.y; xc[ks][6] = c1.z; xc[ks][7] = c1.w; }
#pragma unroll
                for (int d = 0; d < 4; ++d) {
                    float u[8]; unpack8(raw[ks][d], u);
                    const f32x4 w0 = *(const LAS f32x4*)(cst + d * DH + chb), w1 = *(const LAS f32x4*)(cst + d * DH + chb + 4);
                    xc[ks][0] += u[0] * w0.x; xc[ks][1] += u[1] * w0.y; xc[ks][2] += u[2] * w0.z; xc[ks][3] += u[3] * w0.w;
                    xc[ks][4] += u[4] * w1.x; xc[ks][5] += u[5] * w1.y; xc[ks][6] += u[6] * w1.z; xc[ks][7] += u[7] * w1.w;
                    raw[ks][d] = nraw[ks][d];
                }
                frag[ks] = __builtin_bit_cast(bf16x8, pack8(xc[ks]));
            }
            f32x4 ar[4], ai[4];
#pragma unroll
            for (int n = 0; n < 4; ++n) { ar[n] = (f32x4){0.f, 0.f, 0.f, 0.f}; ai[n] = (f32x4){0.f, 0.f, 0.f, 0.f};
#pragma unroll
                for (int ks = 0; ks < 2; ++ks) {
                    const bf16x8 wr_ = wl[((n * 2 + ks) * 2 + 0) * 64], wi_ = wl[((n * 2 + ks) * 2 + 1) * 64];
                    ar[n] = __builtin_amdgcn_mfma_f32_16x16x32_bf16(wr_, frag[ks], ar[n], 0, 0, 0);
                    ai[n] = __builtin_amdgcn_mfma_f32_16x16x32_bf16(wi_, frag[ks], ai[n], 0, 0, 0);
                } }
            float Aa[16], Bb[16];
#pragma unroll
            for (int n = 0; n < 4; ++n) {
                const int cho = wid * 64 + 32 * (n >> 1) + 8 * fq + 4 * (n & 1);
                const f32x4 rb = *(const LAS f32x4*)(cst + 5 * DH + cho), ib = *(const LAS f32x4*)(cst + 6 * DH + cho), spv = *(const LAS f32x4*)(cst + 7 * DH + cho);
#pragma unroll
                for (int jj = 0; jj < 4; ++jj) {
                    const float r = sigm(ar[n][jj] + rb[jj]), ig = sigm(ai[n][jj] + ib[jj]);
                    const float la = -8.0f * r * spv[jj], a = __expf(la), x2 = 2.0f * la;
                    const float m2s = -x2 * (1.0f + x2 * (0.5f + x2 * (0.16666667f + x2 * 0.041666668f))), m2 = (x2 > -0.0625f) ? m2s : 1.0f - a * a;
                    Aa[n * 4 + jj] = a; Bb[n * 4 + jj] = __builtin_amdgcn_sqrtf(m2) * ig * xc[n >> 1][4 * (n & 1) + jj];
                }
            }
#pragma unroll
            for (int k = 0; k < 16; ++k) {
                float A = Aa[k], B = Bb[k], Ap, Bq;
                Ap = dppf<0x111>(1.f, A); Bq = dppf<0x111>(0.f, B); B = fmaf(A, Bq, B); A *= Ap;
                Ap = dppf<0x112>(1.f, A); Bq = dppf<0x112>(0.f, B); B = fmaf(A, Bq, B); A *= Ap;
                Ap = dppf<0x114>(1.f, A); Bq = dppf<0x114>(0.f, B); B = fmaf(A, Bq, B); A *= Ap;
                Ap = dppf<0x118>(1.f, A); Bq = dppf<0x118>(0.f, B); B = fmaf(A, Bq, B); A *= Ap;
                Bb[k] = fmaf(A, Hc[k], B); Aa[k] = A * Pc[k];
            }
#pragma unroll
            for (int ks = 0; ks < 2; ++ks) {
                const size_t o = rowg * DH + wid * 64 + 32 * ks + 8 * fq;
                { u32x4 wh; wh.x = cvt_pk(Bb[8 * ks + 0], Bb[8 * ks + 1]); wh.y = cvt_pk(Bb[8 * ks + 2], Bb[8 * ks + 3]); wh.z = cvt_pk(Bb[8 * ks + 4], Bb[8 * ks + 5]); wh.w = cvt_pk(Bb[8 * ks + 6], Bb[8 * ks + 7]);
                  *(u32x4*)(hl + o) = wh; }
                u32x4 w; w.x = cvt_pk(Aa[8 * ks + 0], Aa[8 * ks + 1]); w.y = cvt_pk(Aa[8 * ks + 2], Aa[8 * ks + 3]); w.z = cvt_pk(Aa[8 * ks + 4], Aa[8 * ks + 5]); w.w = cvt_pk(Aa[8 * ks + 6], Aa[8 * ks + 7]);
                *(u32x4*)(Pp + o) = w;
            }
            const int src = (lane & 48) | 15;
#pragma unroll
            for (int k = 0; k < 16; ++k) { Hc[k] = __shfl(Bb[k], src); Pc[k] = __shfl(Aa[k], src); }
        }
        if (fr == 0) {
#pragma unroll
            for (int ks = 0; ks < 2; ++ks) {
                const size_t o = (size_t)(b * 128 + c) * DH + wid * 64 + 32 * ks + 8 * fq;
                *(f32x4*)(carA + o) = (f32x4){Pc[8 * ks + 0], Pc[8 * ks + 1], Pc[8 * ks + 2], Pc[8 * ks + 3]}; *(f32x4*)(carA + o + 4) = (f32x4){Pc[8 * ks + 4], Pc[8 * ks + 5], Pc[8 * ks + 6], Pc[8 * ks + 7]};
                *(f32x4*)(carH + o) = (f32x4){Hc[8 * ks + 0], Hc[8 * ks + 1], Hc[8 * ks + 2], Hc[8 * ks + 3]}; *(f32x4*)(carH + o + 4) = (f32x4){Hc[8 * ks + 4], Hc[8 * ks + 5], Hc[8 * ks + 6], Hc[8 * ks + 7]};
            }
        }
    }
    __syncthreads();
}


template <int NMR, bool FROM_LDS> __device__ __forceinline__ void m2_rnn_round(LAS unsigned char* lds, const bf16* hl, const bf16* Pp, const bf16* proj, bf16* Y, LAS float* red1, const float (&cr)[16], int b, int t0, int mbase, int wid, int fr, int fq) {
    u32x4 hw[NMR][2], pw[NMR][2], gw[NMR][2];
#pragma unroll
    for (int m = 0; m < NMR; ++m)
#pragma unroll
        for (int ks = 0; ks < 2; ++ks) { const size_t rowg = (size_t)b * TT + t0 + 16 * (mbase + m) + fr; const int ch = wid * 64 + 32 * ks + 8 * fq; const size_t o = rowg * DH + ch;
            if (FROM_LDS) { const int lane = fq * 16 + fr; hw[m][ks] = *(const LAS u32x4*)(lds + LDS_HL + wid * 8192 + (((mbase + m) * 2 + ks) * 64 + lane) * 16); pw[m][ks] = *(const LAS u32x4*)(lds + LDS_P + wid * 8192 + (((mbase + m) * 2 + ks) * 64 + lane) * 16); }
            else { hw[m][ks] = *(const u32x4*)(hl + o); pw[m][ks] = *(const u32x4*)(Pp + o); } gw[m][ks] = *(const u32x4*)(proj + rowg * DIN + 2 * DH + ch); }
    float y[NMR][16];
#pragma unroll
    for (int m = 0; m < NMR; ++m) { float s = 0.f;
#pragma unroll
        for (int ks = 0; ks < 2; ++ks) { float pf[8], gt[8]; unpack8(pw[m][ks], pf); unpack8(gw[m][ks], gt);
            float hh[8]; unpack8(hw[m][ks], hh);
#pragma unroll
            for (int e = 0; e < 8; ++e) { const float hv = fmaf(pf[e], cr[8 * ks + e], hh[e]), x = gt[e];
                const float ge = x * __builtin_amdgcn_rcpf(1.0f + __expf(-1.5957691216f * (x + 0.044715f * x * x * x)));
                const float yy = hv * ge; y[m][8 * ks + e] = yy; s = fmaf(yy, yy, s); } }
        s += __shfl_xor(s, 16); s += __shfl_xor(s, 32);
        if (fq == 0) red1[(16 * (mbase + m) + fr) * 8 + wid] = s; }
    __syncthreads();
#pragma unroll
    for (int m = 0; m < NMR; ++m) { const size_t rowg = (size_t)b * TT + t0 + 16 * (mbase + m) + fr;
        const f32x4 r0 = *(const LAS f32x4*)(red1 + (16 * (mbase + m) + fr) * 8), r1 = *(const LAS f32x4*)(red1 + (16 * (mbase + m) + fr) * 8 + 4);
        const float rs = __builtin_amdgcn_rsqf((((r0.x + r0.y) + (r0.z + r0.w)) + ((r1.x + r1.y) + (r1.z + r1.w))) * (1.0f / DH) + EPS);
#pragma unroll
        for (int ks = 0; ks < 2; ++ks) { float yy[8];
#pragma unroll
            for (int e = 0; e < 8; ++e) yy[e] = y[m][8 * ks + e] * rs;
            *(u32x4*)(Y + rowg * D + DH + wid * 64 + 32 * ks + 8 * fq) = pack8(yy); } }
}


template <int NMR> __device__ __forceinline__ void m2_pool_round(const bf16* proj, bf16* Y, const bf16* Wp, const float* pbias, const float* pscale, LAS float* red2,
                                                                  int b, int t0, int mbase, int g, int half, int kwin, int wid, int fr, int fq) {
    const int tb = t0 + 16 * mbase;
    bf16x8 pfr[NMR][4];
#pragma unroll
    for (int ks = 0; ks < 4; ++ks) {
        const int chb = g * 128 + 32 * ks + 8 * fq;
        float pu[8], p2[8], p4[8], p8[8];
        if (tb) { const u32x4 raw = *(const u32x4*)(proj + ((size_t)b * TT + tb - 16 + fr) * DIN + chb); unpack8(raw, pu);
#pragma unroll
            for (int e = 0; e < 8; ++e) { p2[e] = pu[e] + dppf<0x111>(0.f, pu[e]); p4[e] = p2[e] + dppf<0x112>(0.f, p2[e]); p8[e] = p4[e] + dppf<0x114>(0.f, p4[e]); } }
        else {
#pragma unroll
            for (int e = 0; e < 8; ++e) { pu[e] = 0.f; p2[e] = 0.f; p4[e] = 0.f; p8[e] = 0.f; } }
#pragma unroll
        for (int m = 0; m < NMR; ++m) {
            const int t = tb + 16 * m + fr; const size_t rowg = (size_t)b * TT + t;
            const u32x4 raw = *(const u32x4*)(proj + rowg * DIN + chb); float u[8], po[8]; unpack8(raw, u);
            const int cnt = (t + 1 < kwin) ? t + 1 : kwin; const float rc = __builtin_amdgcn_rcpf((float)cnt);
#pragma unroll
            for (int e = 0; e < 8; ++e) {
                const float s2 = u[e] + shiftd<1>(u[e], pu[e]), s4 = s2 + shiftd<2>(s2, p2[e]), s8 = s4 + shiftd<4>(s4, p4[e]), s16 = s8 + shiftd<8>(s8, p8[e]);
                const float win = g == 0 ? s2 : (g == 1 ? s4 : (g == 2 ? s8 : s16));
                po[e] = fmaf(win, rc, -u[e]); pu[e] = u[e]; p2[e] = s2; p4[e] = s4; p8[e] = s8;
            }
            pfr[m][ks] = __builtin_bit_cast(bf16x8, pack8(po));
        }
    }
    bf16x8 wfr[4][4];
#pragma unroll
    for (int n = 0; n < 4; ++n)
#pragma unroll
        for (int ks = 0; ks < 4; ++ks) wfr[n][ks] = *(const bf16x8*)(Wp + (size_t)(64 * half + outchan(n, fr)) * 128 + 32 * ks + 8 * fq);
#pragma unroll 1
    for (int pass = 0; pass < 2; ++pass) {
#pragma unroll
        for (int m = 0; m < NMR; ++m) {
            const int t = tb + 16 * m + fr; const size_t rowg = (size_t)b * TT + t; float s = 0.f, rs = 0.f;
            if (pass) { const f32x4 r0 = *(const LAS f32x4*)(red2 + (16 * (mbase + m) + fr) * 8), r1 = *(const LAS f32x4*)(red2 + (16 * (mbase + m) + fr) * 8 + 4);
                rs = __builtin_amdgcn_rsqf((((r0.x + r0.y) + (r0.z + r0.w)) + ((r1.x + r1.y) + (r1.z + r1.w))) * (1.0f / DH) + EPS); }
#pragma unroll
            for (int np = 0; np < 2; ++np) {
                f32x4 o2[2];
#pragma unroll
                for (int nn = 0; nn < 2; ++nn) { const int n = 2 * np + nn;
                    f32x4 acc = {0.f, 0.f, 0.f, 0.f};
#pragma unroll
                    for (int ks = 0; ks < 4; ++ks) acc = __builtin_amdgcn_mfma_f32_16x16x32_bf16(wfr[n][ks], pfr[m][ks], acc, 0, 0, 0);
                    const int col = g * 128 + 64 * half + 32 * np + 8 * fq + 4 * nn;
                    const f32x4 pb = *(const f32x4*)(pbias + col), ps = *(const f32x4*)(pscale + col);
                    acc = (acc + pb) * ps; s += (acc.x * acc.x + acc.y * acc.y) + (acc.z * acc.z + acc.w * acc.w); o2[nn] = acc * rs; }
                if (pass) { u32x4 w; w.x = cvt_pk(o2[0].x, o2[0].y); w.y = cvt_pk(o2[0].z, o2[0].w); w.z = cvt_pk(o2[1].x, o2[1].y); w.w = cvt_pk(o2[1].z, o2[1].w);
                    *(u32x4*)(Y + rowg * D + g * 128 + 64 * half + 32 * np + 8 * fq) = w; }
            }
            if (!pass) { s += __shfl_xor(s, 16); s += __shfl_xor(s, 32); if (fq == 0) red2[(16 * (mbase + m) + fr) * 8 + wid] = s; }
        }
        if (!pass) __syncthreads();
    }
}

__device__ __forceinline__ void m2_phase(const Params& p_, LAS unsigned char* lds, int G, int l) {
    const Params p = launder(p_);
    int tid_ = threadIdx.x; asm volatile("" : "+v"(tid_));
    const int tid = tid_, lane = tid & 63, wid = __builtin_amdgcn_readfirstlane(tid >> 6), fr = lane & 15, fq = lane >> 4;
    LAS float* segA = (LAS float*)lds; LAS float* segH = (LAS float*)(lds + 16384); LAS float* carr = (LAS float*)(lds + 32768);
    LAS float* red1 = (LAS float*)(lds + 34816); LAS float* red2 = (LAS float*)(lds + 37888);
    const bf16* proj = (const bf16*)(p.ws + WS_PROJ); bf16* Y = (bf16*)(p.ws + WS_Y);
    const bf16* hl = (const bf16*)(p.ws + WS_HL); const bf16* Pp = (const bf16*)(p.ws + WS_P);
    const float* carA = (const float*)(p.ws + WS_CARA); const float* carH = (const float*)(p.ws + WS_CARH);
    const int g = wid >> 1, half = wid & 1, kwin = 2 << g;
    const bf16* Wp = (const bf16*)(p.ws + WS_POOLW) + (size_t)(l * 4 + g) * 16384;
    const float* pbias = p.in[5] + l * DH; const float* pscale = p.in[6] + l * DH;
    for (int unit = blockIdx.x; unit < 256; unit += G) {
        const int b = unit >> 7, c = unit & 127, t0 = c ? NMETA + 64 * c : 0, NM = c ? 4 : 5;
        {
            const int q = (c + 7) >> 3, jlo = wid * q, jhi = (jlo + q < c) ? jlo + q : c;
            f32x4 A0 = {1.f, 1.f, 1.f, 1.f}, A1 = A0, H0 = {0.f, 0.f, 0.f, 0.f}, H1 = H0;
            for (int j = jlo; j < jhi; j += 8) {
                f32x4 a0[8], a1[8], h0[8], h1[8];
#pragma unroll
                for (int i = 0; i < 8; ++i) { const int jj = (j + i < jhi) ? j + i : jhi - 1; const size_t o = (size_t)(b * 128 + jj) * DH + 8 * lane;
                    a0[i] = *(const f32x4*)(carA + o); a1[i] = *(const f32x4*)(carA + o + 4); h0[i] = *(const f32x4*)(carH + o); h1[i] = *(const f32x4*)(carH + o + 4); }
#pragma unroll
                for (int i = 0; i < 8; ++i) if (j + i < jhi) { H0 = a0[i] * H0 + h0[i]; A0 = A0 * a0[i]; H1 = a1[i] * H1 + h1[i]; A1 = A1 * a1[i]; }
            }
            *(LAS f32x4*)(segA + wid * DH + 8 * lane) = A0; *(LAS f32x4*)(segA + wid * DH + 8 * lane + 4) = A1;
            *(LAS f32x4*)(segH + wid * DH + 8 * lane) = H0; *(LAS f32x4*)(segH + wid * DH + 8 * lane + 4) = H1;
        }
        __syncthreads();
        { float cy = 0.f;
#pragma unroll
          for (int s8 = 0; s8 < 8; ++s8) cy = segA[s8 * DH + tid] * cy + segH[s8 * DH + tid];
          carr[tid] = cy; }
        __syncthreads();
        {
            float cr[16];
#pragma unroll
            for (int ks = 0; ks < 2; ++ks) { const f32x4 c0 = *(const LAS f32x4*)(carr + wid * 64 + 32 * ks + 8 * fq), c1 = *(const LAS f32x4*)(carr + wid * 64 + 32 * ks + 8 * fq + 4);
                cr[8 * ks + 0] = c0.x; cr[8 * ks + 1] = c0.y; cr[8 * ks + 2] = c0.z; cr[8 * ks + 3] = c0.w; cr[8 * ks + 4] = c1.x; cr[8 * ks + 5] = c1.y; cr[8 * ks + 6] = c1.z; cr[8 * ks + 7] = c1.w; }
            m2_rnn_round<4, false>(lds, hl, Pp, proj, Y, red1, cr, b, t0, 0, wid, fr, fq);
            if (NM == 5) m2_rnn_round<1, false>(lds, hl, Pp, proj, Y, red1, cr, b, t0, 4, wid, fr, fq);
        }
        m2_pool_round<4>(proj, Y, Wp, pbias, pscale, red2, b, t0, 0, g, half, kwin, wid, fr, fq);
        if (NM == 5) m2_pool_round<1>(proj, Y, Wp, pbias, pscale, red2, b, t0, 4, g, half, kwin, wid, fr, fq);
    }
    __syncthreads();
}

__device__ __forceinline__ void final_norm(const Params& p_, int G) {
    const Params p = launder(p_);
    int tid_ = threadIdx.x; asm volatile("" : "+v"(tid_));
    const int tid = tid_, lane = tid & 63, wid = tid >> 6; const int gw = blockIdx.x * 8 + wid, NGW = G * 8;
    const bf16* hb = (const bf16*)(p.ws + WS_HB);
    const f32x4* gp = (const f32x4*)p.in[19] + 2 * lane; f32x4 gg[2][2];
#pragma unroll
    for (int j = 0; j < 2; ++j) { gg[j][0] = gp[128 * j]; gg[j][1] = gp[128 * j + 1]; }
    for (int m = gw; m < M; m += NGW) {
        const u32x4* xr = (const u32x4*)(hb + (size_t)m * D) + lane; float v[2][8]; float s = 0.f;
#pragma unroll
        for (int j = 0; j < 2; ++j) { unpack8(xr[64 * j], v[j]);
#pragma unroll
            for (int e = 0; e < 8; ++e) s = fmaf(v[j][e], v[j][e], s); }
        const float rs = 1.0f / sqrtf(wave_sum(s) * (1.0f / D) + EPS);
        f32x4* orow = (f32x4*)(p.out + (size_t)m * D) + 2 * lane;
#pragma unroll
        for (int j = 0; j < 2; ++j) {
            orow[128 * j] = (f32x4){v[j][0] * rs * gg[j][0].x, v[j][1] * rs * gg[j][0].y, v[j][2] * rs * gg[j][0].z, v[j][3] * rs * gg[j][0].w};
            orow[128 * j + 1] = (f32x4){v[j][4] * rs * gg[j][1].x, v[j][5] * rs * gg[j][1].y, v[j][6] * rs * gg[j][1].z, v[j][7] * rs * gg[j][1].w}; }
    }
}


template <int KW> __device__ __forceinline__ float pool_win(float P, float Sp) {
    float w = P;
    if (KW < 16) w -= dppf<0x110 + (KW & 15)>(0.f, P);
    return w + dppf<0x100 + (17 - KW)>(0.f, Sp);
}
template <int KW, int MAXG> __device__ __forceinline__ void pool_frags(const bf16* proj, bf16x8 (&pfr)[MAXG][4], int b, int tb, int cnt, int g, int fr, int fq) {
#pragma unroll
    for (int ks = 0; ks < 4; ++ks) {
        const int chb = g * 128 + 32 * ks + 8 * fq;
        float Sp[8];
        if (tb) { const u32x4 raw = *(const u32x4*)(proj + ((size_t)b * TT + tb - 16 + fr) * DIN + chb); unpack8(raw, Sp);
#pragma unroll
            for (int e = 0; e < 8; ++e) { Sp[e] += dppf<0x101>(0.f, Sp[e]); Sp[e] += dppf<0x102>(0.f, Sp[e]); Sp[e] += dppf<0x104>(0.f, Sp[e]); Sp[e] += dppf<0x108>(0.f, Sp[e]); } }
        else {
#pragma unroll
            for (int e = 0; e < 8; ++e) Sp[e] = 0.f; }
#pragma unroll
        for (int mi = 0; mi < MAXG; ++mi) if (mi < cnt) {
            const int t = tb + 16 * mi + fr;
            const u32x4 raw = *(const u32x4*)(proj + ((size_t)b * TT + t) * DIN + chb); float u[8], po[8]; unpack8(raw, u);
            const int cn = (t + 1 < KW) ? t + 1 : KW; const float rc = __builtin_amdgcn_rcpf((float)cn);
#pragma unroll
            for (int e = 0; e < 8; ++e) {
                float P = u[e]; P += dppf<0x111>(0.f, P); P += dppf<0x112>(0.f, P); P += dppf<0x114>(0.f, P); P += dppf<0x118>(0.f, P);
                float S = u[e]; S += dppf<0x101>(0.f, S); S += dppf<0x102>(0.f, S); S += dppf<0x104>(0.f, S); S += dppf<0x108>(0.f, S);
                po[e] = fmaf(pool_win<KW>(P, Sp[e]), rc, -u[e]); Sp[e] = S;
            }
            pfr[mi][ks] = __builtin_bit_cast(bf16x8, pack8(po));
        }
    }
}
__device__ __forceinline__ void m2_pool2(const bf16* proj, bf16* Y, const bf16* Wp, const float* pbias, const float* pscale, LAS float* red2, int b, int t0, int NM, int g, int th, int fr, int fq) {
    const int m0 = th ? (NM == 5 ? 3 : 2) : 0, cnt = th ? 2 : (NM == 5 ? 3 : 2), tb = t0 + 16 * m0;
    bf16x8 pfr[3][4];
    switch (g) {
        case 0: pool_frags<2, 3>(proj, pfr, b, tb, cnt, g, fr, fq); break;
        case 1: pool_frags<4, 3>(proj, pfr, b, tb, cnt, g, fr, fq); break;
        case 2: pool_frags<8, 3>(proj, pfr, b, tb, cnt, g, fr, fq); break;
        default: pool_frags<16, 3>(proj, pfr, b, tb, cnt, g, fr, fq); break;
    }
    f32x4 ov[3][8]; float sq[3] = {0.f, 0.f, 0.f};
#pragma unroll
    for (int n = 0; n < 8; ++n) {
        bf16x8 wf[4];
#pragma unroll
        for (int ks = 0; ks < 4; ++ks) wf[ks] = *(const bf16x8*)(Wp + (size_t)outchan(n, fr) * 128 + 32 * ks + 8 * fq);
        const int col = g * 128 + 32 * (n >> 1) + 8 * fq + 4 * (n & 1);
        const f32x4 pb = *(const f32x4*)(pbias + col), ps = *(const f32x4*)(pscale + col);
#pragma unroll
        for (int mi = 0; mi < 3; ++mi) if (mi < cnt) {
            f32x4 acc = {0.f, 0.f, 0.f, 0.f};
#pragma unroll
            for (int ks = 0; ks < 4; ++ks) acc = __builtin_amdgcn_mfma_f32_16x16x32_bf16(wf[ks], pfr[mi][ks], acc, 0, 0, 0);
            acc = (acc + pb) * ps; ov[mi][n] = acc; sq[mi] += (acc.x * acc.x + acc.y * acc.y) + (acc.z * acc.z + acc.w * acc.w);
        }
    }
#pragma unroll
    for (int mi = 0; mi < 3; ++mi) if (mi < cnt) { float s = sq[mi]; s += __shfl_xor(s, 16); s += __shfl_xor(s, 32); if (fq == 0) red2[(16 * (m0 + mi) + fr) * 4 + g] = s; }
    __syncthreads();
#pragma unroll
    for (int mi = 0; mi < 3; ++mi) if (mi < cnt) {
        const size_t rowg = (size_t)b * TT + tb + 16 * mi + fr;
        const f32x4 r0 = *(const LAS f32x4*)(red2 + (16 * (m0 + mi) + fr) * 4);
        const float rs = __builtin_amdgcn_rsqf(((r0.x + r0.y) + (r0.z + r0.w)) * (1.0f / DH) + EPS);
#pragma unroll
        for (int np = 0; np < 4; ++np) {
            const f32x4 a = ov[mi][2 * np] * rs, bq = ov[mi][2 * np + 1] * rs;
            u32x4 w; w.x = cvt_pk(a.x, a.y); w.y = cvt_pk(a.z, a.w); w.z = cvt_pk(bq.x, bq.y); w.w = cvt_pk(bq.z, bq.w);
            *(u32x4*)(Y + rowg * D + g * 128 + 32 * np + 8 * fq) = w;
        }
    }
}

#ifndef PROBE_PHASE
#define PROBE_PHASE (-1)
#endif
#ifndef PROBE_BLOCK
#define PROBE_BLOCK 0
#endif
#define TIC() do { if (PROBE_PHASE >= 0) tic = __builtin_amdgcn_s_memrealtime(); } while (0)
#define TOC(k) do { if (PROBE_PHASE == (k)) tacc += __builtin_amdgcn_s_memrealtime() - tic; } while (0)

__device__ __forceinline__ void mixer_phase(const Params& p_, LAS unsigned char* lds, int G, int l, unsigned long long& tic, unsigned long long& tacc) {
    const Params p = launder(p_);
    int tid_ = threadIdx.x; asm volatile("" : "+v"(tid_));
    const int tid = tid_, lane = tid & 63, wid = __builtin_amdgcn_readfirstlane(tid >> 6), fr = lane & 15, fq = lane >> 4;
    LAS float* cst = (LAS float*)(lds + LDS_CST);
    const bf16* proj = (const bf16*)(p.ws + WS_PROJ);
    const bf16* Wr = (const bf16*)(p.ws + WS_GR) + (size_t)(l * 8 + wid) * 4096; const bf16* Wi = (const bf16*)(p.ws + WS_GI) + (size_t)(l * 8 + wid) * 4096;
    LAS float* segA = (LAS float*)(lds + LDS_CST); LAS float* segH = (LAS float*)(lds + LDS_CST + 8192); LAS float* carr = (LAS float*)(lds + LDS_CARR);
    LAS float* red1 = (LAS float*)(lds + LDS_RED1); LAS float* red2 = (LAS float*)(lds + LDS_RED2);
    bf16* Y = (bf16*)(p.ws + WS_Y);
    const int g = wid >> 1, half = wid & 1, kwin = 2 << g;
    const bf16* Wp = (const bf16*)(p.ws + WS_POOLW) + (size_t)(l * 4 + g) * 16384;
    const float* pbias = p.in[5] + l * DH; const float* pscale = p.in[6] + l * DH;
    unsigned* flags = (unsigned*)(p.ws + WS_FLAG);
    bf16* hl = (bf16*)(p.ws + WS_HL); bf16* Pp = (bf16*)(p.ws + WS_P);
    float* carA = (float*)(p.ws + WS_CARA); float* carH = (float*)(p.ws + WS_CARH);
    const int unit = blockIdx.x;
    if (unit < 256) {
        const int b = unit >> 7, c = unit & 127, t0 = c ? NMETA + 64 * c : 0, NM = c ? 4 : 5;
        TIC();
        bf16x8 wfr[4][2][2];
#pragma unroll
        for (int n = 0; n < 4; ++n)
#pragma unroll
            for (int ks = 0; ks < 2; ++ks) { wfr[n][ks][0] = *(const bf16x8*)(Wr + outchan(n, fr) * 64 + 32 * ks + 8 * fq); wfr[n][ks][1] = *(const bf16x8*)(Wi + outchan(n, fr) * 64 + 32 * ks + 8 * fq); }
        LAS float* cslot = (LAS float*)(lds + LDS_CARRY) + (wid * 4 + fq) * 32;
        if (fr == 15) {
#pragma unroll
            for (int k4 = 0; k4 < 4; ++k4) { *(LAS f32x4*)(cslot + 4 * k4) = (f32x4){0.f, 0.f, 0.f, 0.f}; *(LAS f32x4*)(cslot + 16 + 4 * k4) = (f32x4){1.f, 1.f, 1.f, 1.f}; } }
        u32x4 raw[2][4];
#pragma unroll
        for (int ks = 0; ks < 2; ++ks)
#pragma unroll
            for (int d = 0; d < 4; ++d) { const int tt = t0 + fr - 3 + d; raw[ks][d] = (u32x4){0u, 0u, 0u, 0u};
                if (tt >= 0) raw[ks][d] = *(const u32x4*)(proj + ((size_t)b * TT + tt) * DIN + DH + wid * 64 + 32 * ks + 8 * fq); }
        __syncthreads();
        for (int i = tid; i < 8 * DH; i += 512) { const int row = i >> 9, ch = i & 511; float v;
            if (row < 4) v = p.in[7][(l * 4 + row) * DH + ch]; else if (row == 4) v = p.in[8][l * DH + ch]; else if (row == 5) v = p.in[10][l * DH + ch];
            else if (row == 6) v = p.in[12][l * DH + ch]; else v = ((const float*)(p.ws + WS_SP))[l * DH + ch];
            cst[i] = v; }
        __syncthreads();
        TOC(10); TIC();
#pragma unroll 1
        for (int m = 0; m < NM; ++m) {
            const int t = t0 + 16 * m + fr; const size_t rowg = (size_t)b * TT + t;
            u32x4 nraw[2][4];
#pragma unroll
            for (int ks = 0; ks < 2; ++ks)
#pragma unroll
                for (int d = 0; d < 4; ++d) { nraw[ks][d] = (u32x4){0u, 0u, 0u, 0u};
                    if (m + 1 < NM) nraw[ks][d] = *(const u32x4*)(proj + ((size_t)b * TT + t + 13 + d) * DIN + DH + wid * 64 + 32 * ks + 8 * fq); }
            float xc[2][8]; bf16x8 frag[2];
#pragma unroll
            for (int ks = 0; ks < 2; ++ks) {
                const int chb = wid * 64 + 32 * ks + 8 * fq;
                { const f32x4 c0 = *(const LAS f32x4*)(cst + 4 * DH + chb), c1 = *(const LAS f32x4*)(cst + 4 * DH + chb + 4);
                  xc[ks][0] = c0.x; xc[ks][1] = c0.y; xc[ks][2] = c0.z; xc[ks][3] = c0.w; xc[ks][4] = c1.x; xc[ks][5] = c1.y; xc[ks][6] = c1.z; xc[ks][7] = c1.w; }
#pragma unroll
                for (int d = 0; d < 4; ++d) {
                    float u[8]; unpack8(raw[ks][d], u);
                    const f32x4 w0 = *(const LAS f32x4*)(cst + d * DH + chb), w1 = *(const LAS f32x4*)(cst + d * DH + chb + 4);
                    xc[ks][0] += u[0] * w0.x; xc[ks][1] += u[1] * w0.y; xc[ks][2] += u[2] * w0.z; xc[ks][3] += u[3] * w0.w;
                    xc[ks][4] += u[4] * w1.x; xc[ks][5] += u[5] * w1.y; xc[ks][6] += u[6] * w1.z; xc[ks][7] += u[7] * w1.w;
                    raw[ks][d] = nraw[ks][d];
                }
                frag[ks] = __builtin_bit_cast(bf16x8, pack8(xc[ks]));
            }
            f32x4 ar[4], ai[4];
#pragma unroll
            for (int n = 0; n < 4; ++n) { ar[n] = (f32x4){0.f, 0.f, 0.f, 0.f}; ai[n] = (f32x4){0.f, 0.f, 0.f, 0.f};
#pragma unroll
                for (int ks = 0; ks < 2; ++ks) {
                    const bf16x8 wr_ = wfr[n][ks][0], wi_ = wfr[n][ks][1];
                    ar[n] = __builtin_amdgcn_mfma_f32_16x16x32_bf16(wr_, frag[ks], ar[n], 0, 0, 0);
                    ai[n] = __builtin_amdgcn_mfma_f32_16x16x32_bf16(wi_, frag[ks], ai[n], 0, 0, 0);
                } }
            float Aa[16], Bb[16];
#pragma unroll
            for (int n = 0; n < 4; ++n) {
                const int cho = wid * 64 + 32 * (n >> 1) + 8 * fq + 4 * (n & 1);
                const f32x4 rb = *(const LAS f32x4*)(cst + 5 * DH + cho), ib = *(const LAS f32x4*)(cst + 6 * DH + cho), spv = *(const LAS f32x4*)(cst + 7 * DH + cho);
#pragma unroll
                for (int jj = 0; jj < 4; ++jj) {
                    const float r = sigm(ar[n][jj] + rb[jj]), ig = sigm(ai[n][jj] + ib[jj]);
                    const float la = -8.0f * r * spv[jj], a = __expf(la), x2 = 2.0f * la;
                    const float m2s = -x2 * (1.0f + x2 * (0.5f + x2 * (0.16666667f + x2 * 0.041666668f))), m2 = (x2 > -0.0625f) ? m2s : 1.0f - a * a;
                    Aa[n * 4 + jj] = a; Bb[n * 4 + jj] = __builtin_amdgcn_sqrtf(m2) * ig * xc[n >> 1][4 * (n & 1) + jj];
                }
            }
#pragma unroll
            for (int k = 0; k < 16; ++k) {
                float A = Aa[k], B = Bb[k], Ap, Bq;
                Ap = dppf<0x111>(1.f, A); Bq = dppf<0x111>(0.f, B); B = fmaf(A, Bq, B); A *= Ap;
                Ap = dppf<0x112>(1.f, A); Bq = dppf<0x112>(0.f, B); B = fmaf(A, Bq, B); A *= Ap;
                Ap = dppf<0x114>(1.f, A); Bq = dppf<0x114>(0.f, B); B = fmaf(A, Bq, B); A *= Ap;
                Ap = dppf<0x118>(1.f, A); Bq = dppf<0x118>(0.f, B); B = fmaf(A, Bq, B); A *= Ap;
                Bb[k] = B; Aa[k] = A;
            }
            {
                float Hc[16], Pc[16];
#pragma unroll
                for (int k4 = 0; k4 < 4; ++k4) { const f32x4 hq = *(const LAS f32x4*)(cslot + 4 * k4), pq = *(const LAS f32x4*)(cslot + 16 + 4 * k4);
                    Hc[4 * k4] = hq.x; Hc[4 * k4 + 1] = hq.y; Hc[4 * k4 + 2] = hq.z; Hc[4 * k4 + 3] = hq.w; Pc[4 * k4] = pq.x; Pc[4 * k4 + 1] = pq.y; Pc[4 * k4 + 2] = pq.z; Pc[4 * k4 + 3] = pq.w; }
#pragma unroll
                for (int k = 0; k < 16; ++k) { Bb[k] = fmaf(Aa[k], Hc[k], Bb[k]); Aa[k] *= Pc[k]; }
                if (fr == 15) {
#pragma unroll
                    for (int k4 = 0; k4 < 4; ++k4) { *(LAS f32x4*)(cslot + 4 * k4) = (f32x4){Bb[4 * k4], Bb[4 * k4 + 1], Bb[4 * k4 + 2], Bb[4 * k4 + 3]}; *(LAS f32x4*)(cslot + 16 + 4 * k4) = (f32x4){Aa[4 * k4], Aa[4 * k4 + 1], Aa[4 * k4 + 2], Aa[4 * k4 + 3]}; } }
            }
#pragma unroll
            for (int ks = 0; ks < 2; ++ks) {
                const size_t o = rowg * DH + wid * 64 + 32 * ks + 8 * fq;
                u32x4 wh; wh.x = cvt_pk(Bb[8 * ks + 0], Bb[8 * ks + 1]); wh.y = cvt_pk(Bb[8 * ks + 2], Bb[8 * ks + 3]); wh.z = cvt_pk(Bb[8 * ks + 4], Bb[8 * ks + 5]); wh.w = cvt_pk(Bb[8 * ks + 6], Bb[8 * ks + 7]);
                u32x4 w; w.x = cvt_pk(Aa[8 * ks + 0], Aa[8 * ks + 1]); w.y = cvt_pk(Aa[8 * ks + 2], Aa[8 * ks + 3]); w.z = cvt_pk(Aa[8 * ks + 4], Aa[8 * ks + 5]); w.w = cvt_pk(Aa[8 * ks + 6], Aa[8 * ks + 7]);
                if (m < 4) { *(LAS u32x4*)(lds + LDS_HL + wid * 8192 + ((m * 2 + ks) * 64 + lane) * 16) = wh; *(LAS u32x4*)(lds + LDS_P + wid * 8192 + ((m * 2 + ks) * 64 + lane) * 16) = w; }
                else { *(u32x4*)(hl + o) = wh; *(u32x4*)(Pp + o) = w; }
            }
        }
        TOC(11); TIC();
        if (fr == 0) {
            float Hc[16], Pc[16];
#pragma unroll
            for (int k4 = 0; k4 < 4; ++k4) { const f32x4 hq = *(const LAS f32x4*)(cslot + 4 * k4), pq = *(const LAS f32x4*)(cslot + 16 + 4 * k4);
                Hc[4 * k4] = hq.x; Hc[4 * k4 + 1] = hq.y; Hc[4 * k4 + 2] = hq.z; Hc[4 * k4 + 3] = hq.w; Pc[4 * k4] = pq.x; Pc[4 * k4 + 1] = pq.y; Pc[4 * k4 + 2] = pq.z; Pc[4 * k4 + 3] = pq.w; }
#pragma unroll
            for (int ks = 0; ks < 2; ++ks) {
                const size_t o = (size_t)(b * 128 + c) * DH + wid * 64 + 32 * ks + 8 * fq;
#pragma unroll
                for (int e2 = 0; e2 < 4; ++e2) {
                    __hip_atomic_store((unsigned long long*)(carA + o) + e2, ((unsigned long long)__float_as_uint(Pc[8 * ks + 2 * e2 + 1]) << 32) | __float_as_uint(Pc[8 * ks + 2 * e2]), __ATOMIC_RELAXED, __HIP_MEMORY_SCOPE_AGENT);
                    __hip_atomic_store((unsigned long long*)(carH + o) + e2, ((unsigned long long)__float_as_uint(Hc[8 * ks + 2 * e2 + 1]) << 32) | __float_as_uint(Hc[8 * ks + 2 * e2]), __ATOMIC_RELAXED, __HIP_MEMORY_SCOPE_AGENT); }
            }
        }
        int fr2 = fr, fq2 = fq, tid2 = tid; asm volatile("" : "+v"(fr2), "+v"(fq2), "+v"(tid2));
        TOC(12); TIC();
#ifndef NO_MX_POOL
        m2_pool2(proj, Y, Wp, pbias, pscale, red2, b, t0, NM, g, half, fr2, fq2);
#endif
        asm volatile("s_waitcnt vmcnt(0)" ::: "memory");
        __syncthreads();
        if (tid2 == 0) __hip_atomic_store(flags + unit, (unsigned)(l + 1), __ATOMIC_RELAXED, __HIP_MEMORY_SCOPE_AGENT);
        TOC(13); TIC();
        if (tid2 < c) { unsigned sp = 0; while (__hip_atomic_load(flags + b * 128 + tid2, __ATOMIC_RELAXED, __HIP_MEMORY_SCOPE_AGENT) < (unsigned)(l + 1)) { __builtin_amdgcn_s_sleep(2); if (++sp > (1u << 22)) break; } }
#if defined(MIXER_ACQ_FENCE)
        if (tid2 < c) __builtin_amdgcn_fence(__ATOMIC_ACQUIRE, "agent");
#endif
        __syncthreads();
        TOC(14); TIC();
        {
            const int q = (c + 3) >> 2, seg = tid2 >> 7, cgi = tid2 & 127, jlo = seg * q, jhi = (jlo + q < c) ? jlo + q : c;
            f32x4 A0 = {1.f, 1.f, 1.f, 1.f}, H0 = {0.f, 0.f, 0.f, 0.f};
            for (int j = jlo; j < jhi; j += 16) {
                f32x4 a0[16], h0[16];
#pragma unroll
                for (int i = 0; i < 16; ++i) { const int jj = (j + i < jhi) ? j + i : jhi - 1; const size_t o = (size_t)(b * 128 + jj) * DH + 4 * cgi; const unsigned long long al = __hip_atomic_load((const unsigned long long*)(carA + o), __ATOMIC_RELAXED, __HIP_MEMORY_SCOPE_AGENT), ah = __hip_atomic_load((const unsigned long long*)(carA + o) + 1, __ATOMIC_RELAXED, __HIP_MEMORY_SCOPE_AGENT);
                    const unsigned long long hl_ = __hip_atomic_load((const unsigned long long*)(carH + o), __ATOMIC_RELAXED, __HIP_MEMORY_SCOPE_AGENT), hh_ = __hip_atomic_load((const unsigned long long*)(carH + o) + 1, __ATOMIC_RELAXED, __HIP_MEMORY_SCOPE_AGENT);
                    a0[i] = (f32x4){__uint_as_float((unsigned)al), __uint_as_float((unsigned)(al >> 32)), __uint_as_float((unsigned)ah), __uint_as_float((unsigned)(ah >> 32))};
                    h0[i] = (f32x4){__uint_as_float((unsigned)hl_), __uint_as_float((unsigned)(hl_ >> 32)), __uint_as_float((unsigned)hh_), __uint_as_float((unsigned)(hh_ >> 32))}; }
#pragma unroll
                for (int i = 0; i < 16; ++i) if (j + i < jhi) { H0 = a0[i] * H0 + h0[i]; A0 = A0 * a0[i]; }
            }
            *(LAS f32x4*)(segA + seg * DH + 4 * cgi) = A0; *(LAS f32x4*)(segH + seg * DH + 4 * cgi) = H0;
        }
        __syncthreads();
        { float cy = 0.f;
#pragma unroll
          for (int s4 = 0; s4 < 4; ++s4) cy = segA[s4 * DH + tid2] * cy + segH[s4 * DH + tid2];
          carr[tid2] = cy; }
        __syncthreads();
        TOC(15); TIC();
        {
            float cr[16];
#pragma unroll
            for (int ks = 0; ks < 2; ++ks) { const f32x4 c0 = *(const LAS f32x4*)(carr + wid * 64 + 32 * ks + 8 * fq2), c1 = *(const LAS f32x4*)(carr + wid * 64 + 32 * ks + 8 * fq2 + 4);
                cr[8 * ks + 0] = c0.x; cr[8 * ks + 1] = c0.y; cr[8 * ks + 2] = c0.z; cr[8 * ks + 3] = c0.w; cr[8 * ks + 4] = c1.x; cr[8 * ks + 5] = c1.y; cr[8 * ks + 6] = c1.z; cr[8 * ks + 7] = c1.w; }
#ifndef NO_MX_RNN
            m2_rnn_round<4, true>(lds, hl, Pp, proj, Y, red1, cr, b, t0, 0, wid, fr2, fq2);
            if (NM == 5) m2_rnn_round<1, false>(lds, hl, Pp, proj, Y, red1, cr, b, t0, 4, wid, fr2, fq2);
#endif
        }
        TOC(16);
    }
    __syncthreads();
}

#define XB_TMO      128
#define XB_XCNT(j)  (256  + 64 * (j))
#define XB_XSUB(j)  (1280 + 64 * (j))
#define XB_XGEN(j)  (2304 + 64 * (j))
#define XB_TOP      3328
#define XB_TOPGEN   3392
#define XCD_BAR_WORDS 3456
#define XB_SPIN_CAP (1u << 18)

__device__ __forceinline__ unsigned xb_ld(unsigned* p)              { return __hip_atomic_load(p, __ATOMIC_RELAXED, __HIP_MEMORY_SCOPE_AGENT); }
__device__ __forceinline__ unsigned xb_add(unsigned* p, unsigned v) { return __hip_atomic_fetch_add(p, v, __ATOMIC_RELAXED, __HIP_MEMORY_SCOPE_AGENT); }
__device__ __forceinline__ unsigned xb_xcc_id() { return (unsigned)__builtin_amdgcn_s_getreg((3 << 11) | 20) & 0xFu; }
#define XB_SPIN(cond, bar) do { unsigned _sp = 0; while (cond) { __builtin_amdgcn_s_sleep(1); \
    if ((++_sp & 255u) == 0u) { if (xb_ld(&(bar)[XB_TMO])) break; if (_sp > XB_SPIN_CAP) { atomicAdd(&(bar)[XB_TMO], 1u); break; } } } } while (0)

struct XcdBarrier {
    unsigned* bar; unsigned x;
    volatile LAS unsigned* st;
};

__device__ __forceinline__ XcdBarrier xcd_barrier_post(unsigned* bar, volatile LAS unsigned* st) {
    XcdBarrier b; b.bar = bar; b.x = xb_xcc_id(); b.st = st;
    if (threadIdx.x == 0) (void)xb_add(&bar[XB_XCNT(b.x)], 1u);
    return b;
}
__device__ __forceinline__ void xcd_barrier_complete(unsigned* bar, unsigned x, unsigned& nloc, unsigned& nx) {
    const unsigned G = gridDim.x * gridDim.y * gridDim.z;
    unsigned sum, cnt, mine, sp = 0u;
    for (;;) {
        sum = 0u; cnt = 0u; mine = 0u;
#pragma unroll
        for (unsigned j = 0; j < 16; ++j) { const unsigned c = xb_ld(&bar[XB_XCNT(j)]); sum += c; cnt += (c > 0u) ? 1u : 0u; mine = (j == x) ? c : mine; }
        if (sum == G) break;
        __builtin_amdgcn_s_sleep(1);
        if ((++sp & 255u) == 0u) { if (xb_ld(&bar[XB_TMO])) break; if (sp > XB_SPIN_CAP) { atomicAdd(&bar[XB_TMO], 1u); break; } }
    }
    nloc = mine > 0u ? mine : 1u; nx = cnt > 0u ? cnt : 1u;
}

__device__ __forceinline__ void xcd_barrier(const XcdBarrier& b) {
    asm volatile("s_waitcnt vmcnt(0)" ::: "memory");
    __syncthreads();
    if (threadIdx.x == 0) {
        unsigned* bar = b.bar;
        __builtin_amdgcn_s_waitcnt(0);
        unsigned nloc = b.st[0], nx = b.st[1];
        if (nloc == 0u) { xcd_barrier_complete(bar, b.x, nloc, nx); b.st[0] = nloc; b.st[1] = nx; }
        const unsigned old = xb_add(&bar[XB_XSUB(b.x)], 1u);
        const unsigned gen = old / nloc;
        if (old + 1u == (gen + 1u) * nloc) {
            __builtin_amdgcn_fence(__ATOMIC_RELEASE, "agent");
            asm volatile("s_waitcnt vmcnt(0)" ::: "memory");
            const unsigned og = xb_add(&bar[XB_TOP], 1u);
            const unsigned tg = og / nx;
            if (og + 1u == (tg + 1u) * nx) xb_add(&bar[XB_TOPGEN], 1u);
            else XB_SPIN(xb_ld(&bar[XB_TOPGEN]) == tg, bar);
            __builtin_amdgcn_fence(__ATOMIC_ACQUIRE, "agent");
            xb_add(&bar[XB_XGEN(b.x)], 1u);
            asm volatile("s_waitcnt vmcnt(0)" ::: "memory");
        } else {
            XB_SPIN(xb_ld(&bar[XB_XGEN(b.x)]) == gen, bar);
            __builtin_amdgcn_fence(__ATOMIC_ACQUIRE, "agent");
            asm volatile("s_waitcnt vmcnt(0)" ::: "memory");
        }
    }
    __syncthreads();
}

#ifndef PROBE_SYNC2
#define PROBE_SYNC2 0
#endif
#ifndef PROBE_M1X2
#define PROBE_M1X2 0
#endif
#ifndef PROBE_M2X2
#define PROBE_M2X2 0
#endif
#define GSYNC() do { { __attribute__((address_space(1))) unsigned* gb_ = (__attribute__((address_space(1))) unsigned*)xbar.bar; asm volatile("" : "+s"(gb_)); xbar.bar = (unsigned*)gb_; asm volatile("" : "+s"(xbar.x)); } xcd_barrier(xbar); if (PROBE_SYNC2) xcd_barrier(xbar); } while (0)
__device__ __forceinline__ int rstd_cache(LAS unsigned char* lds, const float* ss, const pg8::StaticOrder& S) {
    pg8::Unit u0; int pmc = -1;
    int tid = threadIdx.x; asm volatile("" : "+v"(tid));
    if (S.next(0, u0)) { pmc = u0.pm; if (tid < 256) ((LAS float*)(lds + 131072))[tid] = row_rstd(ss, u0.pm * 256 + tid); }
    __syncthreads();
    return pmc;
}
__global__ void __launch_bounds__(512, 2) fwd_megakernel(Params p) {
    extern __shared__ __attribute__((aligned(16))) unsigned char lds_raw[];
    LAS unsigned char* lds = (LAS unsigned char*)lds_raw;
    cg::grid_group grid = cg::this_grid();
    const int G = gridDim.x;
    unsigned long long tic = 0, tacc = 0;
    unsigned char* ws = p.ws;
    volatile LAS unsigned* xst = (volatile LAS unsigned*)(lds + LDS_XST);
    if (threadIdx.x < 2) xst[threadIdx.x] = 0u;
    __syncthreads();
    XcdBarrier xbar = xcd_barrier_post((unsigned*)(ws + WS_CTL), xst);
    bf16* hb = (bf16*)(ws + WS_HB); bf16* proj = (bf16*)(ws + WS_PROJ); bf16* Y = (bf16*)(ws + WS_Y); bf16* mid = (bf16*)(ws + WS_MID); float* ss = (float*)(ws + WS_SS);
    grid.sync();
    TIC();
#ifndef NO_PRO
    prologue(p, lds, G);
#endif
    GSYNC();
    TOC(0);
#pragma unroll 1
    for (int l = 0; l < DEPTH; ++l) {
        { __attribute__((address_space(1))) unsigned char* gws = (__attribute__((address_space(1))) unsigned char*)ws; asm volatile("" : "+s"(gws)); ws = (unsigned char*)gws; }
        const unsigned char* wl = ws + WS_W + (size_t)l * W_LAYER;
        const bf16* in_t = (const bf16*)(wl + W_IN); const bf16* out_t = (const bf16*)(wl + W_OUT); const bf16* up_t = (const bf16*)(wl + W_UP); const bf16* down_t = (const bf16*)(wl + W_DOWN);
        TIC();
#ifndef NO_GIN
        { pg8::Gemm g{hb, in_t, M, DIN, D, 0}; pg8::StaticOrder S; S.init(M, DIN, G, (int)blockIdx.x); const int pmc = rstd_cache(lds, ss, S); EpiIn E{proj, ss, (const LAS float*)(lds + 131072), pmc};
          pg8::gemm_phase<EpiIn, pg8::StaticOrder, true, true>(lds, g, S, E); }
#endif
#ifndef NO_META
        meta_tasks<0>(p, lds, G, nullptr, 0, in_t, D, DIN / 16);
#endif
        if (G == 256 && l + 1 < DEPTH && blockIdx.x >= 128)
            convert_items(p, lds, (l + 1) * TITEMS_PER_LAYER, (l + 2) * TITEMS_PER_LAYER, (int)blockIdx.x - 128, 128 * 8);
        GSYNC();
        TOC(1); TIC();
#ifndef FUSED_MIXER
#define FUSED_MIXER 1
#endif
#if FUSED_MIXER
        mixer_phase(p, lds, G, l, tic, tacc);
        GSYNC();
        TOC(2);
#else
        m1_phase(p, lds, G, l);
        GSYNC();
        TOC(2); TIC();
        m2_phase(p, lds, G, l);
        GSYNC();
#endif
        TOC(3); TIC();
#ifndef NO_GOUT
        { pg8::Gemm g{Y, out_t, M, D, D, NMETA}; pg8::StaticOrder S; S.init(M, D, G, (int)blockIdx.x); EpiRes E{hb, ss};
          pg8::gemm_phase<EpiRes, pg8::StaticOrder, false, true>(lds, g, S, E); }
#endif
#ifndef NO_META
        if (l < DEPTH - 1) meta_tasks<1>(p, lds, G, Y, D, out_t, D, D / 16);
#endif
        GSYNC();
        TOC(4); TIC();
#ifndef NO_GUP
#ifndef STAGGER_UP
#define STAGGER_UP 0
#endif
        if (STAGGER_UP > 0) {
            const unsigned long long w0 = __builtin_amdgcn_s_memrealtime(), dl = (unsigned long long)(((blockIdx.x >> 3) & 3) * STAGGER_UP);
            while (__builtin_amdgcn_s_memrealtime() - w0 < dl) __builtin_amdgcn_s_sleep(4);
        }
        { pg8::Gemm g{hb, up_t, M, FF, D, 0}; pg8::StaticOrder S; S.init(M, FF, G, (int)blockIdx.x); const int pmc = rstd_cache(lds, ss, S); EpiUp E{mid, ss, (const LAS float*)(lds + 131072), pmc};
          pg8::gemm_phase<EpiUp, pg8::StaticOrder, true, true>(lds, g, S, E); }
#endif
#ifndef NO_META
        if (l < DEPTH - 1) meta_tasks<2>(p, lds, G, nullptr, 0, up_t, D, FF / 16);
#endif
        GSYNC();
        TOC(5); TIC();
#ifndef NO_GDN
        { pg8::Gemm g{mid, down_t, M, D, FF, 0}; pg8::StaticOrder S; S.init(M, D, G, (int)blockIdx.x); EpiRes E{hb, ss};
          pg8::gemm_phase<EpiRes, pg8::StaticOrder, false, true>(lds, g, S, E); }
#endif
#ifndef NO_META
        if (l < DEPTH - 1) meta_tasks<1>(p, lds, G, (const bf16*)(ws + WS_MIDMETA), FF, down_t, FF, D / 16);
#endif
        GSYNC();
        TOC(6);
    }
    TIC();
    final_norm(p, G);
    TOC(7);
    if (PROBE_PHASE >= 0 && blockIdx.x == PROBE_BLOCK && threadIdx.x == 0) { const unsigned long long w0 = __builtin_amdgcn_s_memrealtime(); while (__builtin_amdgcn_s_memrealtime() - w0 < 4ull * tacc) __builtin_amdgcn_s_sleep(8); }
}

extern "C" void kernel_launch(void* const* d_in, const int* in_sizes, int n_in, void* d_out, int out_size, void* d_ws, size_t ws_size, hipStream_t stream) {
    static int grid = 0;
    if (grid == 0) {
        if (n_in != 20 || in_sizes[0] != M * D || out_size != M * D || ws_size < WS_END) { fprintf(stderr, "kernel_launch: unexpected shapes (n_in %d, in0 %d, out %d, ws %zu)\n", n_in, n_in > 0 ? in_sizes[0] : -1, out_size, ws_size); grid = -1; return; }
        int dev = 0, cus = 0, per_cu = 0;
        if (hipGetDevice(&dev) != hipSuccess || hipDeviceGetAttribute(&cus, hipDeviceAttributeMultiprocessorCount, dev) != hipSuccess) { grid = -1; return; }
        if (hipFuncSetAttribute((const void*)fwd_megakernel, hipFuncAttributeMaxDynamicSharedMemorySize, LDS_BYTES) != hipSuccess) { fprintf(stderr, "kernel_launch: hipFuncSetAttribute failed\n"); grid = -1; return; }
        if (hipOccupancyMaxActiveBlocksPerMultiprocessor(&per_cu, (const void*)fwd_megakernel, 512, LDS_BYTES) != hipSuccess || per_cu < 1) { fprintf(stderr, "kernel_launch: occupancy query gave %d\n", per_cu); (void)hipGetLastError(); grid = -1; return; }
        grid = cus * 1;
        if (grid < 256) { fprintf(stderr, "kernel_launch: %d CUs; the fused mixer phase needs 256 resident workgroups\n", cus); grid = -1; return; }
    }
    if (grid < 0) return;
    if (hipMemsetAsync((char*)d_ws + WS_CTL, 0, WS_FLAG + 256 * 4, stream) != hipSuccess) { fprintf(stderr, "kernel_launch: memset failed\n"); return; }
    Params p{};
    for (int i = 0; i < 20; ++i) p.in[i] = (const float*)d_in[i];
    p.out = (float*)d_out; p.ws = (unsigned char*)d_ws;
    void* args[] = {&p};
    hipError_t e = hipLaunchCooperativeKernel((const void*)fwd_megakernel, dim3(grid), dim3(512), args, LDS_BYTES, stream);
    if (e != hipSuccess) fprintf(stderr, "cooperative launch failed: %s (grid %d)\n", hipGetErrorString(e), grid);
}
```

```cpp
#include <hip/hip_runtime.h>
#include <hip/hip_cooperative_groups.h>
#include <cstdio>
#include <cstdint>
namespace cg = cooperative_groups;
namespace pg8 {
#define PG8_LAS __attribute__((address_space(3)))
typedef unsigned short bf16_t;
typedef short bf16x8 __attribute__((ext_vector_type(8)));
typedef float f32x4 __attribute__((ext_vector_type(4)));
typedef unsigned u32x4 __attribute__((ext_vector_type(4)));
constexpr int BM = 256, BK = 64, HALF = 128, HTB = HALF * BK * 2  , STAGE_BYTES = 8 * HTB, NXCD = 8, WGM = 8;

__host__ __device__ __forceinline__ int lds_byte(int r, int c) { const int st = (r >> 4) * 2 + (c >> 5), rr = r & 15, cc = c & 31, ob = rr * 64 + cc * 2; return st * 1024 + (ob ^ (((ob >> 9) & 1) << 5)); }
__host__ __device__ __forceinline__ void stage_rc(int b, int& R, int& C) { const int st = b / 1024, sb = b % 1024, swz = sb ^ (((sb >> 9) & 1) << 5); R = (st >> 1) * 16 + swz / 64; C = (st & 1) * 32 + (swz % 64) / 2; }
__host__ __device__ __forceinline__ int perm32(int rho) { const int n = rho >> 4, i = rho & 15; return 8 * (i >> 2) + 4 * n + (i & 3); }

struct Unit { int pm, pn; };
struct Gemm { const bf16_t* A; const bf16_t* Bt; int M, N, K, gap; };

struct StaticOrder {
    int nM, nN, nwg, G, c;
    __host__ __device__ void init(int M, int N, int G_, int c_) { nM = M / BM; nN = N / BM; nwg = nM * nN; G = G_; c = c_; }
    __host__ __device__ bool next(int i, Unit& u) const {
        const long L = (long)i * G + c; if (L >= nwg) return false;
        int wgid = (int)L; { const int q = nwg / NXCD, r = nwg % NXCD, xcd = wgid % NXCD, off = wgid / NXCD; wgid = (xcd < r ? xcd * (q + 1) : r * (q + 1) + (xcd - r) * q) + off; }
        const int nig = WGM * nN, gid = wgid / nig, fm = gid * WGM, gsz = (nM - fm) < WGM ? (nM - fm) : WGM;
        u.pm = fm + ((wgid % nig) % gsz); u.pn = (wgid % nig) / gsz; return true;
    }
    __device__ __forceinline__ void a_ready(const Unit&) const {}
    __device__ __forceinline__ void done(const Unit&) const {}
};
__device__ __forceinline__ unsigned cvt_pk_bf16(float lo, float hi) { unsigned r; asm volatile("v_cvt_pk_bf16_f32 %0, %1, %2" : "=v"(r) : "v"(lo), "v"(hi)); return r; }
template <class Epi, class Sched, bool ALIGN_EPI = false, bool SP2 = false>
__device__ __forceinline__ void gemm_phase(PG8_LAS unsigned char* lds, const Gemm g, const Sched& S, const Epi& E) {
    int tid_ = threadIdx.x; asm volatile("" : "+v"(tid_));
    const int tid = tid_, wid = __builtin_amdgcn_readfirstlane(tid >> 6), lane = tid & 63, wr = wid >> 2, wc = wid & 3, fr = lane & 15, fq = lane >> 4;
    const int K = g.K, nt = K / BK;
    unsigned voffA[2], voffB[2];
#pragma unroll
    for (int i = 0; i < 2; ++i) { int R, C; stage_rc(tid * 16 + i * 8192, R, C); const int Rb = Epi::PERM ? ((R & ~31) + perm32(R & 31)) : R;
        voffA[i] = (unsigned)(R * K + C) * 2u; voffB[i] = (unsigned)(Rb * K + C) * 2u; }
    const size_t kstep = (size_t)(BK * 2);
    const size_t hstep = (size_t)HALF * K * 2;
    const size_t tstep = 2 * hstep;
    const int agap = g.gap;
#define a_off(pm_) ((size_t)((pm_) * BM + agap * (1 + ((pm_) >> 5))) * (size_t)K * 2)
    const unsigned ldsw = (unsigned)wid * 1024u;
    const int aoff = lds_byte(wr * 64 + fr, fq * 8), boff = lds_byte(wc * 32 + fr, fq * 8);
#define PG8_SA(b, h) (((b) * 2 + (h)) * HTB)
#define PG8_SB(b, h) ((4 + (b) * 2 + (h)) * HTB)
#define PG8_STAGE(bufoff, gbase, voff) do { _Pragma("unroll") for (int _i = 0; _i < 2; ++_i) \
        __builtin_amdgcn_global_load_lds((const unsigned*)((const char*)(gbase) + (voff)[_i]), (PG8_LAS unsigned*)(lds + (bufoff) + ldsw + _i * 8192), 16, 0, 0); } while (0)
#define PG8_LDA(dst, b, h) do { _Pragma("unroll") for (int m = 0; m < 4; ++m) _Pragma("unroll") for (int k = 0; k < 2; ++k) dst[m][k] = *(const PG8_LAS bf16x8*)(lds + PG8_SA(b, h) + aoff + m * 2048 + k * 1024); } while (0)
#define PG8_LDB(dst, b, h) do { _Pragma("unroll") for (int n = 0; n < 2; ++n) _Pragma("unroll") for (int k = 0; k < 2; ++k) dst[n][k] = *(const PG8_LAS bf16x8*)(lds + PG8_SB(b, h) + boff + n * 2048 + k * 1024); } while (0)
#define PG8_MMA(ai, bj, At, Bt) do { __builtin_amdgcn_s_setprio(1); _Pragma("unroll") for (int m = 0; m < 4; ++m) _Pragma("unroll") for (int n = 0; n < 2; ++n) _Pragma("unroll") for (int k = 0; k < 2; ++k) \
        acc[ai][bj][m][n] = __builtin_amdgcn_mfma_f32_16x16x32_bf16(Bt[n][k], At[m][k], acc[ai][bj][m][n], 0, 0, 0); __builtin_amdgcn_s_setprio(0); } while (0)
#define PG8_WAIT_V(n) asm volatile("s_waitcnt vmcnt(" #n ")" ::: "memory")
#define PG8_WAIT_L(n) asm volatile("s_waitcnt lgkmcnt(" #n ")" ::: "memory")
#define PG8_BAR __builtin_amdgcn_s_barrier()
#define PG8_SCHED __builtin_amdgcn_sched_barrier(0)
    Unit cur, nxt; int ui = 0;
    if (!S.next(0, cur)) return;
    f32x4 acc[2][2][4][2];
#pragma unroll
    for (int a = 0; a < 2; ++a)
#pragma unroll
        for (int b = 0; b < 2; ++b)
#pragma unroll
            for (int m = 0; m < 4; ++m)
#pragma unroll
                for (int n = 0; n < 2; ++n) acc[a][b][m][n] = (f32x4){0.f, 0.f, 0.f, 0.f};
    if constexpr (Epi::PRELOAD) E.preload(acc, cur, wr, wc, fr, fq);
    bf16x8 At[4][2], B0[2][2], B1[2][2];
    const char* cA = (const char*)g.A + a_off(cur.pm); const char* cB = (const char*)g.Bt + (size_t)cur.pn * tstep;
    S.a_ready(cur);
    if constexpr (SP2) {
        PG8_STAGE(PG8_SB(0, 0), cB, voffB); PG8_STAGE(PG8_SB(0, 1), cB + hstep, voffB); PG8_STAGE(PG8_SA(0, 0), cA, voffA); PG8_STAGE(PG8_SA(0, 1), cA + hstep, voffA);
        if (wr == 1) PG8_BAR;
        PG8_WAIT_V(2); PG8_BAR;
        PG8_STAGE(PG8_SB(1, 0), cB + kstep, voffB); PG8_STAGE(PG8_SA(1, 0), cA + kstep, voffA); PG8_STAGE(PG8_SB(1, 1), cB + hstep + kstep, voffB);
        PG8_WAIT_V(6); PG8_BAR;
    } else {
        PG8_STAGE(PG8_SB(0, 0), cB, voffB); PG8_STAGE(PG8_SA(0, 0), cA, voffA); PG8_STAGE(PG8_SB(0, 1), cB + hstep, voffB); PG8_STAGE(PG8_SA(0, 1), cA + hstep, voffA);
        if (wr == 1) PG8_BAR;
        PG8_WAIT_V(4); PG8_BAR;
        PG8_STAGE(PG8_SB(1, 0), cB + kstep, voffB); PG8_STAGE(PG8_SA(1, 0), cA + kstep, voffA); PG8_STAGE(PG8_SB(1, 1), cB + hstep + kstep, voffB);
        PG8_WAIT_V(6); PG8_BAR;
    }
    for (;;) {
        const bool has_next = S.next(ui + 1, nxt);
        const char* nA = has_next ? (const char*)g.A + a_off(nxt.pm) : cA; const char* nB = has_next ? (const char*)g.Bt + (size_t)nxt.pn * tstep : cB;
        for (int t = 0; t < nt; t += 2) {
            const bool last = (t == nt - 2);
            const char* a1 = cA + (size_t)(t + 1) * kstep;
            const char* a2 = last ? nA : cA + (size_t)(t + 2) * kstep; const char* b2 = last ? nB : cB + (size_t)(t + 2) * kstep;
            const char* a3 = a2 + kstep; const char* b3 = b2 + kstep;
            if (last && has_next) S.a_ready(nxt);
            if constexpr (SP2) {
            PG8_LDB(B0, 0, 0); PG8_LDB(B1, 0, 1); PG8_SCHED; PG8_LDA(At, 0, 0); PG8_STAGE(PG8_SA(1, 1), a1 + hstep, voffA);
            PG8_WAIT_V(8); PG8_WAIT_L(0); PG8_BAR; PG8_MMA(0, 0, At, B0); PG8_MMA(0, 1, At, B1); PG8_BAR; PG8_SCHED;
            PG8_LDA(At, 0, 1); PG8_STAGE(PG8_SB(0, 0), b2, voffB); PG8_STAGE(PG8_SB(0, 1), b2 + hstep, voffB); PG8_STAGE(PG8_SA(0, 0), a2, voffA);
            PG8_WAIT_V(8); PG8_WAIT_L(0); PG8_BAR; PG8_MMA(1, 0, At, B0); PG8_MMA(1, 1, At, B1); PG8_BAR; PG8_SCHED;
            PG8_LDB(B0, 1, 0); PG8_LDB(B1, 1, 1); PG8_SCHED; PG8_LDA(At, 1, 0); PG8_STAGE(PG8_SA(0, 1), a2 + hstep, voffA);
            PG8_WAIT_V(8); PG8_WAIT_L(0); PG8_BAR; PG8_MMA(0, 0, At, B0); PG8_MMA(0, 1, At, B1); PG8_BAR; PG8_SCHED;
            PG8_LDA(At, 1, 1); PG8_STAGE(PG8_SB(1, 0), b3, voffB); PG8_STAGE(PG8_SB(1, 1), b3 + hstep, voffB); PG8_STAGE(PG8_SA(1, 0), a3, voffA);
            PG8_WAIT_V(8); PG8_WAIT_L(0); PG8_BAR; PG8_MMA(1, 0, At, B0); PG8_MMA(1, 1, At, B1); PG8_BAR; PG8_SCHED;
            } else {
            PG8_LDB(B0, 0, 0); PG8_SCHED; PG8_LDA(At, 0, 0); PG8_STAGE(PG8_SA(1, 1), a1 + hstep, voffA);
            PG8_WAIT_L(8); PG8_BAR; PG8_WAIT_L(0); PG8_MMA(0, 0, At, B0); PG8_BAR; PG8_SCHED;
            PG8_LDB(B1, 0, 1); PG8_STAGE(PG8_SB(0, 0), b2, voffB);
            PG8_BAR; PG8_WAIT_L(0); PG8_MMA(0, 1, At, B1); PG8_BAR;
            PG8_LDA(At, 0, 1); PG8_STAGE(PG8_SA(0, 0), a2, voffA);
            PG8_BAR; PG8_WAIT_L(0); PG8_MMA(1, 0, At, B0); PG8_BAR; PG8_SCHED;
            PG8_STAGE(PG8_SB(0, 1), b2 + hstep, voffB);
            PG8_WAIT_V(6); PG8_BAR; PG8_MMA(1, 1, At, B1); PG8_BAR;
            PG8_LDB(B0, 1, 0); PG8_SCHED; PG8_LDA(At, 1, 0); PG8_STAGE(PG8_SA(0, 1), a2 + hstep, voffA);
            PG8_WAIT_L(8); PG8_BAR; PG8_WAIT_L(0); PG8_MMA(0, 0, At, B0); PG8_BAR; PG8_SCHED;
            PG8_LDB(B1, 1, 1); PG8_STAGE(PG8_SB(1, 0), b3, voffB);
            PG8_BAR; PG8_WAIT_L(0); PG8_MMA(0, 1, At, B1); PG8_BAR;
            PG8_LDA(At, 1, 1); PG8_STAGE(PG8_SA(1, 0), a3, voffA);
            PG8_BAR; PG8_WAIT_L(0); PG8_MMA(1, 0, At, B0); PG8_BAR; PG8_SCHED;
            PG8_STAGE(PG8_SB(1, 1), b3 + hstep, voffB);
            PG8_WAIT_V(6); PG8_BAR; PG8_MMA(1, 1, At, B1); PG8_BAR;
            }
        }
        if constexpr (ALIGN_EPI) { if (wr == 0) PG8_BAR; }
        if constexpr (!Epi::AFTER_DRAIN) { E(acc, cur, wr, wc, fr, fq); S.done(cur); }
        if (!has_next) break;
#pragma unroll
        for (int a = 0; a < 2; ++a)
#pragma unroll
            for (int b = 0; b < 2; ++b)
#pragma unroll
                for (int m = 0; m < 4; ++m)
#pragma unroll
                    for (int n = 0; n < 2; ++n) acc[a][b][m][n] = (f32x4){0.f, 0.f, 0.f, 0.f};
        if constexpr (Epi::PRELOAD) { E.preload(acc, nxt, wr, wc, fr, fq); PG8_WAIT_V(0); }
        cur = nxt; cA = nA; cB = nB; ++ui;
        if constexpr (ALIGN_EPI) { if (wr == 1) PG8_BAR; }
    }
    PG8_WAIT_V(0);
    if constexpr (!ALIGN_EPI) { if (wr == 0) PG8_BAR; }
    PG8_BAR;
    if constexpr (Epi::AFTER_DRAIN) { E.fused(acc, cur, wr, wc, fr, fq, lds, wid, lane); S.done(cur); }
#undef PG8_SA
#undef PG8_SB
#undef PG8_STAGE
#undef PG8_LDA
#undef PG8_LDB
#undef PG8_MMA
#undef PG8_WAIT_V
#undef PG8_WAIT_L
#undef PG8_BAR
#undef PG8_SCHED
}
}

#define LAS __attribute__((address_space(3)))
typedef unsigned short bf16;
typedef unsigned u32x4 __attribute__((ext_vector_type(4)));
typedef unsigned u32x2 __attribute__((ext_vector_type(2)));
typedef float f32x4 __attribute__((ext_vector_type(4)));
typedef short bf16x8 __attribute__((ext_vector_type(8)));
constexpr int D = 1024, SEQ = 8192, NB = 2, NMETA = 16, TT = SEQ + NMETA, M = NB * SEQ, DEPTH = 4, DIN = 1536, FF = 4096, DH = 512;
constexpr float EPS = 1e-6f;
constexpr size_t MiB = 1u << 20;
constexpr size_t WS_CTL = 0;
constexpr size_t WS_POOLW = 1 * MiB, WS_GR = WS_POOLW + 512 * 1024, WS_GI = WS_GR + 256 * 1024;
constexpr size_t WS_SP = 2 * MiB, WS_HMETA = WS_SP + 64 * 1024, WS_MIDMETA = WS_HMETA + 64 * 1024;
constexpr size_t WS_SS = 3 * MiB, WS_CARA = 4 * MiB, WS_CARH = WS_CARA + 512 * 1024;
constexpr size_t WS_W = 8 * MiB, W_LAYER = 21 * MiB, W_IN = 0, W_OUT = 3 * MiB, W_UP = 5 * MiB, W_DOWN = 13 * MiB;
constexpr size_t WS_HB = 92 * MiB, WS_MID = 124 * MiB;
constexpr size_t WS_PROJ = WS_MID, WS_Y = WS_MID + 48 * MiB + 256 * 1024, WS_HL = WS_Y + 32 * MiB + 256 * 1024, WS_P = WS_HL + 32 * MiB + 256 * 1024, WS_END = 256 * MiB;
static_assert(WS_PROJ + (size_t)NB * TT * DIN * 2 <= WS_Y && WS_Y + (size_t)NB * TT * D * 2 <= WS_HL && WS_HL + (size_t)NB * TT * DH * 2 <= WS_P && WS_P + (size_t)NB * TT * DH * 2 <= WS_END, "ws map");
static_assert(WS_W + DEPTH * W_LAYER <= WS_HB && WS_HB + (size_t)M * D * 2 <= WS_MID && WS_MID + (size_t)M * FF * 2 <= WS_END, "ws map 2");
constexpr int LDS_HL = 0, LDS_P = 65536, LDS_CST = 131072, LDS_CARR = 147456, LDS_RED1 = 149504, LDS_RED2 = 152064, LDS_CARRY = 154624;
constexpr int LDS_XST = 163840 - 64;
constexpr int LDS_BYTES = 163840;
constexpr size_t WS_FLAG = 64 * 1024;

struct Params {
    const float* in[20];
    float* out;
    unsigned char* ws;
};

__device__ __forceinline__ Params launder(const Params& p) {
    Params q = p;
#pragma unroll
    for (int i = 0; i < 20; ++i) { const __attribute__((address_space(1))) float* g = (const __attribute__((address_space(1))) float*)q.in[i]; asm volatile("" : "+s"(g)); q.in[i] = (const float*)g; }
    { __attribute__((address_space(1))) float* g = (__attribute__((address_space(1))) float*)q.out; asm volatile("" : "+s"(g)); q.out = (float*)g; }
    { __attribute__((address_space(1))) unsigned char* g = (__attribute__((address_space(1))) unsigned char*)q.ws; asm volatile("" : "+s"(g)); q.ws = (unsigned char*)g; }
    return q;
}
__device__ __forceinline__ unsigned cvt_pk(float lo, float hi) { return pg8::cvt_pk_bf16(lo, hi); }
__device__ __forceinline__ float bf_lo(unsigned w) { return __builtin_bit_cast(float, w << 16); }
__device__ __forceinline__ float bf_hi(unsigned w) { return __builtin_bit_cast(float, w & 0xffff0000u); }
__device__ __forceinline__ void unpack8(const u32x4 w, float (&f)[8]) {
    f[0] = bf_lo(w.x); f[1] = bf_hi(w.x); f[2] = bf_lo(w.y); f[3] = bf_hi(w.y); f[4] = bf_lo(w.z); f[5] = bf_hi(w.z); f[6] = bf_lo(w.w); f[7] = bf_hi(w.w);
}
__device__ __forceinline__ u32x4 pack8(const float (&f)[8]) { u32x4 w; w.x = cvt_pk(f[0], f[1]); w.y = cvt_pk(f[2], f[3]); w.z = cvt_pk(f[4], f[5]); w.w = cvt_pk(f[6], f[7]); return w; }
__device__ __forceinline__ float wave_sum(float v) {
#pragma unroll
    for (int o = 1; o < 64; o <<= 1) v += __shfl_xor(v, o);
    return v;
}
template <int CTRL> __device__ __forceinline__ float dppf(float old, float src) {
    return __builtin_bit_cast(float, __builtin_amdgcn_update_dpp(__builtin_bit_cast(int, old), __builtin_bit_cast(int, src), CTRL, 0xf, 0xf, false));
}
template <int DD> __device__ __forceinline__ float shiftd(float cur, float prev) {
    const float t = dppf<0x100 + (16 - DD)>(0.f, prev);
    return dppf<0x110 + DD>(t, cur);
}
__device__ __forceinline__ float sigm(float v) { return __builtin_amdgcn_rcpf(1.0f + __expf(-v)); }
__device__ __forceinline__ int outchan(int n, int rho) { return 32 * (n >> 1) + 8 * (rho >> 2) + 4 * (n & 1) + (rho & 3); }

__device__ __forceinline__ float row_rstd(const float* ss, int r) {
    const f32x4* s4 = (const f32x4*)(ss + (size_t)r * 16);
    const f32x4 a = s4[0], b = s4[1], c = s4[2], d = s4[3];
    const float s = ((a.x + a.y) + (a.z + a.w)) + ((b.x + b.y) + (b.z + b.w)) + ((c.x + c.y) + (c.z + c.w)) + ((d.x + d.y) + (d.z + d.w));
    return 1.0f / sqrtf(s * (1.0f / D) + EPS);
}
__device__ __forceinline__ void rows_rstd(const float* ss, int rowbase  , int fr, float (&rs)[2][4]) {
    const int lane = threadIdx.x & 63;
    const float r0 = row_rstd(ss, rowbase + lane), r1 = row_rstd(ss, rowbase + 128 + lane);
#pragma unroll
    for (int m = 0; m < 4; ++m) { rs[0][m] = __shfl(r0, m * 16 + fr); rs[1][m] = __shfl(r1, m * 16 + fr); }
}
struct EpiIn {
    static constexpr bool PERM = true, AFTER_DRAIN = false, PRELOAD = false;
    bf16* P; const float* ss; const LAS float* rl; int pmc;
    __device__ __forceinline__ void operator()(const f32x4 (&acc)[2][2][4][2], const pg8::Unit& u, int wr, int wc, int fr, int fq) const {
        const int row0 = u.pm * 256 + wr * 64 + fr, col0 = u.pn * 256 + wc * 32 + 8 * fq;
        float rsv[2][4];
        if (u.pm == pmc) {
#pragma unroll
            for (int ai = 0; ai < 2; ++ai)
#pragma unroll
                for (int m = 0; m < 4; ++m) rsv[ai][m] = rl[ai * 128 + wr * 64 + m * 16 + fr];
        } else {
#pragma unroll
            for (int ai = 0; ai < 2; ++ai)
#pragma unroll
                for (int m = 0; m < 4; ++m) { rsv[ai][m] = row_rstd(ss, row0 + ai * 128 + m * 16); asm volatile("" ::: "memory"); }
        }
#pragma unroll
        for (int ai = 0; ai < 2; ++ai)
#pragma unroll
            for (int m = 0; m < 4; ++m) {
                const int r = row0 + ai * 128 + m * 16; const float rs = rsv[ai][m];
                bf16* rowp = P + (size_t)(r + NMETA * (1 + (r >> 13))) * DIN + col0;
#pragma unroll
                for (int bj = 0; bj < 2; ++bj) { const f32x4 v0 = acc[ai][bj][m][0] * rs, v1 = acc[ai][bj][m][1] * rs;
                    u32x4 w; w.x = cvt_pk(v0[0], v0[1]); w.y = cvt_pk(v0[2], v0[3]); w.z = cvt_pk(v1[0], v1[1]); w.w = cvt_pk(v1[2], v1[3]);
                    *(u32x4*)(rowp + bj * 128) = w; }
            }
    }
};
struct EpiUp {
    static constexpr bool PERM = true, AFTER_DRAIN = false, PRELOAD = false;
    bf16* O; const float* ss; const LAS float* rl; int pmc;
    __device__ __forceinline__ void operator()(const f32x4 (&acc)[2][2][4][2], const pg8::Unit& u, int wr, int wc, int fr, int fq) const {
        const int row0 = u.pm * 256 + wr * 64 + fr, col0 = u.pn * 256 + wc * 32 + 8 * fq;
        float rsv[2][4];
        if (u.pm == pmc) {
#pragma unroll
            for (int ai = 0; ai < 2; ++ai)
#pragma unroll
                for (int m = 0; m < 4; ++m) rsv[ai][m] = rl[ai * 128 + wr * 64 + m * 16 + fr];
        } else {
#pragma unroll
            for (int ai = 0; ai < 2; ++ai)
#pragma unroll
                for (int m = 0; m < 4; ++m) { rsv[ai][m] = row_rstd(ss, row0 + ai * 128 + m * 16); asm volatile("" ::: "memory"); }
        }
#pragma unroll
        for (int ai = 0; ai < 2; ++ai)
#pragma unroll
            for (int m = 0; m < 4; ++m) {
                const int r = row0 + ai * 128 + m * 16; const float rs = rsv[ai][m];
                bf16* rowp = O + (size_t)r * FF + col0;
#pragma unroll
                for (int bj = 0; bj < 2; ++bj) { f32x4 v0 = acc[ai][bj][m][0] * rs, v1 = acc[ai][bj][m][1] * rs;
#pragma unroll
                    for (int j = 0; j < 4; ++j) { v0[j] = fmaxf(v0[j], 0.f); v0[j] *= v0[j]; v1[j] = fmaxf(v1[j], 0.f); v1[j] *= v1[j]; }
                    u32x4 w; w.x = cvt_pk(v0[0], v0[1]); w.y = cvt_pk(v0[2], v0[3]); w.z = cvt_pk(v1[0], v1[1]); w.w = cvt_pk(v1[2], v1[3]);
                    *(u32x4*)(rowp + bj * 128) = w; }
            }
    }
};
struct EpiRes {
    static constexpr bool PERM = true, AFTER_DRAIN = false, PRELOAD = true;
    bf16* hb; float* ssn;
    __device__ __forceinline__ void preload(f32x4 (&acc)[2][2][4][2], const pg8::Unit& u, int wr, int wc, int fr, int fq) const {
        const int row0 = u.pm * 256 + wr * 64 + fr, col0 = u.pn * 256 + wc * 32 + 8 * fq;
#pragma unroll
        for (int ai = 0; ai < 2; ++ai)
#pragma unroll
            for (int m = 0; m < 4; ++m) { const size_t off = (size_t)(row0 + ai * 128 + m * 16) * D + col0;
#pragma unroll
                for (int bj = 0; bj < 2; ++bj) { const u32x4 w = *(const u32x4*)(hb + off + bj * 128);
                    acc[ai][bj][m][0] = (f32x4){bf_lo(w.x), bf_hi(w.x), bf_lo(w.y), bf_hi(w.y)}; acc[ai][bj][m][1] = (f32x4){bf_lo(w.z), bf_hi(w.z), bf_lo(w.w), bf_hi(w.w)}; } }
    }
    __device__ __forceinline__ void operator()(const f32x4 (&acc)[2][2][4][2], const pg8::Unit& u, int wr, int wc, int fr, int fq) const {
        const int row0 = u.pm * 256 + wr * 64 + fr, col0 = u.pn * 256 + wc * 32 + 8 * fq;
#pragma unroll
        for (int ai = 0; ai < 2; ++ai)
#pragma unroll
            for (int m = 0; m < 4; ++m) {
                const int r = row0 + ai * 128 + m * 16; const size_t off = (size_t)r * D + col0; float s = 0.f;
#pragma unroll
                for (int bj = 0; bj < 2; ++bj) {
                    const f32x4 o0 = acc[ai][bj][m][0], o1 = acc[ai][bj][m][1];
                    s += (o0[0] * o0[0] + o0[1] * o0[1]) + (o0[2] * o0[2] + o0[3] * o0[3]) + (o1[0] * o1[0] + o1[1] * o1[1]) + (o1[2] * o1[2] + o1[3] * o1[3]);
                    u32x4 w; w.x = cvt_pk(o0[0], o0[1]); w.y = cvt_pk(o0[2], o0[3]); w.z = cvt_pk(o1[0], o1[1]); w.w = cvt_pk(o1[2], o1[3]);
                    *(u32x4*)(hb + off + bj * 128) = w; }
                s += __shfl_xor(s, 16); s += __shfl_xor(s, 32);
                if (fq == 0) ssn[(size_t)r * 16 + u.pn * 4 + wc] = s;
            }
    }
};

struct TItem { const float* W; const float* gk; bf16* WT; int K, N, item; };
__device__ __forceinline__ void titem_load(const TItem& t, int lane, f32x4 (&v)[8], float (&gs)[8]) {
    const int nblk = t.N / 32, kb = t.item / nblk, nb = t.item % nblk, k0 = 64 * kb, n0 = 32 * nb, lr = lane >> 3, lc = (lane & 7) * 4;
#pragma unroll
    for (int i = 0; i < 8; ++i) { v[i] = *(const f32x4*)(t.W + (size_t)(k0 + 8 * i + lr) * t.N + n0 + lc); gs[i] = t.gk ? t.gk[k0 + 8 * i + lr] : 1.0f; }
}
__device__ __forceinline__ void titem_store(const TItem& t, int lane, const f32x4 (&v)[8], const float (&gs)[8], LAS float* scr) {
    const int nblk = t.N / 32, kb = t.item / nblk, nb = t.item % nblk, k0 = 64 * kb, n0 = 32 * nb, lr = lane >> 3, lc = (lane & 7) * 4;
#pragma unroll
    for (int i = 0; i < 8; ++i) { LAS float* d = scr + (8 * i + lr) * 33 + lc; d[0] = v[i].x * gs[i]; d[1] = v[i].y * gs[i]; d[2] = v[i].z * gs[i]; d[3] = v[i].w * gs[i]; }
    asm volatile("s_waitcnt lgkmcnt(0)" ::: "memory");
    const int c = lane & 7;
#pragma unroll
    for (int j = 0; j < 4; ++j) { const int n = (lane >> 3) + 8 * j; const LAS float* s = scr + (8 * c) * 33 + n;
        u32x4 o; o.x = cvt_pk(s[0 * 33], s[1 * 33]); o.y = cvt_pk(s[2 * 33], s[3 * 33]); o.z = cvt_pk(s[4 * 33], s[5 * 33]); o.w = cvt_pk(s[6 * 33], s[7 * 33]);
        *(u32x4*)(t.WT + (size_t)(n0 + n) * t.K + k0 + 8 * c) = o; }
    asm volatile("s_waitcnt lgkmcnt(0)" ::: "memory");
}
__device__ __forceinline__ TItem titem_decode(const Params& p, int it) {
    constexpr int I_IN = 16 * 48, I_OUT = 16 * 32, I_UP = 16 * 128, I_DN = 64 * 32, I_PW = 4 * 8, I_G = 8 * 2, I_L = I_IN + I_OUT + I_UP + I_DN + I_PW + 2 * I_G;
    const int l = it / I_L; int r = it % I_L; unsigned char* ws = p.ws; unsigned char* wl = ws + WS_W + (size_t)l * W_LAYER; TItem t;
    if (r < I_IN) { t = TItem{p.in[3] + (size_t)l * D * DIN, p.in[2] + l * D, (bf16*)(wl + W_IN), D, DIN, r}; return t; } r -= I_IN;
    if (r < I_OUT) { t = TItem{p.in[15] + (size_t)l * D * D, p.in[14] + l * D, (bf16*)(wl + W_OUT), D, D, r}; return t; } r -= I_OUT;
    if (r < I_UP) { t = TItem{p.in[17] + (size_t)l * D * FF, p.in[16] + l * D, (bf16*)(wl + W_UP), D, FF, r}; return t; } r -= I_UP;
    if (r < I_DN) { t = TItem{p.in[18] + (size_t)l * FF * D, nullptr, (bf16*)(wl + W_DOWN), FF, D, r}; return t; } r -= I_DN;
    if (r < I_PW) { const int g = r / 8; t = TItem{p.in[4] + (size_t)(l * 4 + g) * 16384, nullptr, (bf16*)(ws + WS_POOLW) + (size_t)(l * 4 + g) * 16384, 128, 128, r % 8}; return t; } r -= I_PW;
    if (r < I_G) { const int h = r / 2; t = TItem{p.in[9] + (size_t)(l * 8 + h) * 4096, nullptr, (bf16*)(ws + WS_GR) + (size_t)(l * 8 + h) * 4096, 64, 64, r % 2}; return t; } r -= I_G;
    { const int h = r / 2; t = TItem{p.in[11] + (size_t)(l * 8 + h) * 4096, nullptr, (bf16*)(ws + WS_GI) + (size_t)(l * 8 + h) * 4096, 64, 64, r % 2}; }
    return t;
}
constexpr int TITEMS_PER_LAYER = 16 * 48 + 16 * 32 + 16 * 128 + 64 * 32 + 4 * 8 + 2 * 8 * 2;
__device__ __forceinline__ void convert_items(const Params& p_, LAS unsigned char* lds, int it_lo, int it_hi, int wblock, int nworkers) {
    const Params p = launder(p_);
    int tid_ = threadIdx.x; asm volatile("" : "+v"(tid_));
    const int lane = tid_ & 63, wid = __builtin_amdgcn_readfirstlane(tid_ >> 6);
    LAS float* scr = (LAS float*)(lds + wid * 16384);
    const int worker = wblock * 8 + wid;
    if (it_lo + worker < it_hi) {
        TItem cur = titem_decode(p, it_lo + worker); f32x4 v[8]; float gs[8]; titem_load(cur, lane, v, gs);
        for (int it = it_lo + worker; it < it_hi; it += nworkers) {
            const bool more = it + nworkers < it_hi; TItem nxt = cur; f32x4 nv[8]; float ngs[8];
            if (more) { nxt = titem_decode(p, it + nworkers); titem_load(nxt, lane, nv, ngs); }
            titem_store(cur, lane, v, gs, scr);
            if (more) { cur = nxt;
#pragma unroll
                for (int i = 0; i < 8; ++i) { v[i] = nv[i]; gs[i] = ngs[i]; } }
        }
    }
}
__device__ __forceinline__ void prologue(const Params& p_, LAS unsigned char* lds, int G) {
    const Params p = launder(p_);
    int tid_ = threadIdx.x; asm volatile("" : "+v"(tid_));
    const int tid = tid_, lane = tid & 63, wid = __builtin_amdgcn_readfirstlane(tid >> 6);
    const int gw = blockIdx.x * 8 + wid, NGW = G * 8;
    unsigned char* ws = p.ws;
    convert_items(p_, lds, 0, (G == 256 ? 1 : DEPTH) * TITEMS_PER_LAYER, (int)blockIdx.x, NGW);
    const float* x = p.in[0]; bf16* hb = (bf16*)(ws + WS_HB); float* ss = (float*)(ws + WS_SS);
    for (int m2 = gw; m2 < M / 2; m2 += NGW) {
        f32x4 v[2][4]; float s[2] = {0.f, 0.f};
#pragma unroll
        for (int r = 0; r < 2; ++r) { const f32x4* xr = (const f32x4*)(x + (size_t)(2 * m2 + r) * D) + lane;
#pragma unroll
            for (int j = 0; j < 4; ++j) v[r][j] = xr[64 * j]; }
#pragma unroll
        for (int r = 0; r < 2; ++r) {
#pragma unroll
            for (int j = 0; j < 4; ++j) s[r] += (v[r][j].x * v[r][j].x + v[r][j].y * v[r][j].y) + (v[r][j].z * v[r][j].z + v[r][j].w * v[r][j].w);
            s[r] = wave_sum(s[r]);
            u32x2* o8 = (u32x2*)(hb + (size_t)(2 * m2 + r) * D) + lane;
#pragma unroll
            for (int j = 0; j < 4; ++j) { u32x2 w; w.x = cvt_pk(v[r][j].x, v[r][j].y); w.y = cvt_pk(v[r][j].z, v[r][j].w); o8[64 * j] = w; }
            if (lane < 16) ss[(size_t)(2 * m2 + r) * 16 + lane] = lane == 0 ? s[r] : 0.f;
        }
    }
    float* hm = (float*)(ws + WS_HMETA); float* sp = (float*)(ws + WS_SP);
    for (int i = blockIdx.x * 512 + tid; i < NMETA * D; i += G * 512) hm[i] = p.in[1][i];
    for (int i = blockIdx.x * 512 + tid; i < DEPTH * DH; i += G * 512) sp[i] = log1pf(expf(-p.in[13][i]));
}

template <int MODE> __device__ __forceinline__ void meta_tasks(const Params& p_, LAS unsigned char* lds, int G, const bf16* Ab, int lda, const bf16* Bt, int K, int ntasks) {
    const Params p = launder(p_);
    int tid_ = threadIdx.x; asm volatile("" : "+v"(tid_));
    const int tid = tid_, lane = tid & 63, wid = __builtin_amdgcn_readfirstlane(tid >> 6), fr = lane & 15, fq = lane >> 4;
    float* hm = (float*)(p.ws + WS_HMETA);
    LAS float* red = (LAS float*)lds;
    for (int task = G - 1 - (int)blockIdx.x; task < ntasks; task += G) {
        const int n0 = task * 16, kw = K / 8, k0 = wid * kw;
        f32x4 acc = {0.f, 0.f, 0.f, 0.f}; float ssq = 0.f;
        for (int kb = k0; kb < k0 + kw; kb += 128) {
            bf16x8 af[4], bfr[4]; f32x4 a0[4], a1[4];
#pragma unroll
            for (int i = 0; i < 4; ++i) { const int kk = kb + 32 * i;
                if (MODE == 1) af[i] = *(const bf16x8*)(Ab + (size_t)fr * lda + kk + 8 * fq);
                else { a0[i] = *(const f32x4*)(hm + fr * D + kk + 8 * fq); a1[i] = *(const f32x4*)(hm + fr * D + kk + 8 * fq + 4); }
                bfr[i] = *(const bf16x8*)(Bt + (size_t)(n0 + fr) * K + kk + 8 * fq); }
#pragma unroll
            for (int i = 0; i < 4; ++i) {
                if (MODE != 1) { ssq += (a0[i].x * a0[i].x + a0[i].y * a0[i].y) + (a0[i].z * a0[i].z + a0[i].w * a0[i].w) + (a1[i].x * a1[i].x + a1[i].y * a1[i].y) + (a1[i].z * a1[i].z + a1[i].w * a1[i].w);
                    u32x4 w; w.x = cvt_pk(a0[i].x, a0[i].y); w.y = cvt_pk(a0[i].z, a0[i].w); w.z = cvt_pk(a1[i].x, a1[i].y); w.w = cvt_pk(a1[i].z, a1[i].w); af[i] = __builtin_bit_cast(bf16x8, w); }
                acc = __builtin_amdgcn_mfma_f32_16x16x32_bf16(bfr[i], af[i], acc, 0, 0, 0); }
        }
        ssq += __shfl_xor(ssq, 16); ssq += __shfl_xor(ssq, 32);
        LAS float* rp = red + (wid * 64 + lane) * 5;
        rp[0] = acc[0]; rp[1] = acc[1]; rp[2] = acc[2]; rp[3] = acc[3]; rp[4] = ssq;
        __syncthreads();
        if (wid == 0) {
            float a0 = 0.f, a1 = 0.f, a2 = 0.f, a3 = 0.f, sq = 0.f;
#pragma unroll
            for (int w = 0; w < 8; ++w) { const LAS float* q = red + (w * 64 + lane) * 5; a0 += q[0]; a1 += q[1]; a2 += q[2]; a3 += q[3]; sq += q[4]; }
            const int col = n0 + 4 * fq;
            if (MODE == 1) { f32x4* hp = (f32x4*)(hm + fr * D + col); f32x4 h = *hp; h.x += a0; h.y += a1; h.z += a2; h.w += a3; *hp = h; }
            else {
                const float rs = 1.0f / sqrtf(sq * (1.0f / D) + EPS); a0 *= rs; a1 *= rs; a2 *= rs; a3 *= rs;
                if (MODE == 0) { u32x2 w; w.x = cvt_pk(a0, a1); w.y = cvt_pk(a2, a3); bf16* pr = (bf16*)(p.ws + WS_PROJ);
                    *(u32x2*)(pr + (size_t)fr * DIN + col) = w; *(u32x2*)(pr + (size_t)(TT + fr) * DIN + col) = w; }
                else { a0 = fmaxf(a0, 0.f); a1 = fmaxf(a1, 0.f); a2 = fmaxf(a2, 0.f); a3 = fmaxf(a3, 0.f);
                    u32x2 w; w.x = cvt_pk(a0 * a0, a1 * a1); w.y = cvt_pk(a2 * a2, a3 * a3); *(u32x2*)((bf16*)(p.ws + WS_MIDMETA) + (size_t)fr * FF + col) = w; }
            }
        }
        __syncthreads();
    }
}

__device__ __forceinline__ void m1_phase(const Params& p_, LAS unsigned char* lds, int G, int l) {
    const Params p = launder(p_);
    int tid_ = threadIdx.x; asm volatile("" : "+v"(tid_));
    const int tid = tid_, lane = tid & 63, wid = __builtin_amdgcn_readfirstlane(tid >> 6), fr = lane & 15, fq = lane >> 4;
    LAS float* cst = (LAS float*)lds;
    for (int i = tid; i < 8 * DH; i += 512) { const int row = i >> 9, ch = i & 511; float v;
        if (row < 4) v = p.in[7][(l * 4 + row) * DH + ch]; else if (row == 4) v = p.in[8][l * DH + ch]; else if (row == 5) v = p.in[10][l * DH + ch];
        else if (row == 6) v = p.in[12][l * DH + ch]; else v = ((const float*)(p.ws + WS_SP))[l * DH + ch];
        cst[i] = v; }
    const bf16* proj = (const bf16*)(p.ws + WS_PROJ);
    const bf16* Wr = (const bf16*)(p.ws + WS_GR) + (size_t)(l * 8 + wid) * 4096; const bf16* Wi = (const bf16*)(p.ws + WS_GI) + (size_t)(l * 8 + wid) * 4096;
    LAS bf16x8* wl = (LAS bf16x8*)(lds + 16384 + wid * 16384) + lane;
#pragma unroll
    for (int n = 0; n < 4; ++n)
#pragma unroll
        for (int ks = 0; ks < 2; ++ks) {
            wl[((n * 2 + ks) * 2 + 0) * 64] = *(const bf16x8*)(Wr + outchan(n, fr) * 64 + 32 * ks + 8 * fq);
            wl[((n * 2 + ks) * 2 + 1) * 64] = *(const bf16x8*)(Wi + outchan(n, fr) * 64 + 32 * ks + 8 * fq); }
    __syncthreads();
    bf16* hl = (bf16*)(p.ws + WS_HL); bf16* Pp = (bf16*)(p.ws + WS_P);
    float* carA = (float*)(p.ws + WS_CARA); float* carH = (float*)(p.ws + WS_CARH);
    for (int unit = blockIdx.x; unit < 256; unit += G) {
        const int b = unit >> 7, c = unit & 127, t0 = c ? NMETA + 64 * c : 0, NM = c ? 4 : 5;
        float Hc[16], Pc[16];
#pragma unroll
        for (int k = 0; k < 16; ++k) { Hc[k] = 0.f; Pc[k] = 1.f; }
        u32x4 raw[2][4];
#pragma unroll
        for (int ks = 0; ks < 2; ++ks)
#pragma unroll
            for (int d = 0; d < 4; ++d) { const int tt = t0 + fr - 3 + d; raw[ks][d] = (u32x4){0u, 0u, 0u, 0u};
                if (tt >= 0) raw[ks][d] = *(const u32x4*)(proj + ((size_t)b * TT + tt) * DIN + DH + wid * 64 + 32 * ks + 8 * fq); }
#pragma unroll 1
        for (int m = 0; m < NM; ++m) {
            const int t = t0 + 16 * m + fr; const size_t rowg = (size_t)b * TT + t;
            u32x4 nraw[2][4];
#pragma unroll
            for (int ks = 0; ks < 2; ++ks)
#pragma unroll
                for (int d = 0; d < 4; ++d) { nraw[ks][d] = (u32x4){0u, 0u, 0u, 0u};
                    if (m + 1 < NM) nraw[ks][d] = *(const u32x4*)(proj + ((size_t)b * TT + t + 13 + d) * DIN + DH + wid * 64 + 32 * ks + 8 * fq); }
            float xc[2][8]; bf16x8 frag[2];
#pragma unroll
            for (int ks = 0; ks < 2; ++ks) {
                const int chb = wid * 64 + 32 * ks + 8 * fq;
                { const f32x4 c0 = *(const LAS f32x4*)(cst + 4 * DH + chb), c1 = *(const LAS f32x4*)(cst + 4 * DH + chb + 4);
                  xc[ks][0] = c0.x; xc[ks][1] = c0.y; xc[ks][2] = c0.z; xc[ks][3] = c0.w; xc[ks][4] = c1.x; xc[ks][5] = c1.y; xc[ks][6] = c1.z; xc[ks][7] = c1.w; }
#pragma unroll
                for (int d = 0; d < 4; ++d) {
                    float u[8]; unpack8(raw[ks][d], u);
                    const f32x4 w0 = *(const LAS f32x4*)(cst + d * DH + chb), w1 = *(const LAS f32x4*)(cst + d * DH + chb + 4);
                    xc[ks][0] += u[0] * w0.x; xc[ks][1] += u[1] * w0.y; xc[ks][2] += u[2] * w0.z; xc[ks][3] += u[3] * w0.w;
                    xc[ks][4] += u[4] * w1.x; xc[ks][5] += u[5] * w1.y; xc[ks][6] += u[6] * w1.z; xc[ks][7] += u[7] * w1.w;
                    raw[ks][d] = nraw[ks][d];
                }
                frag[ks] = __builtin_bit_cast(bf16x8, pack8(xc[ks]));
            }
            f32x4 ar[4], ai[4];
#pragma unroll
            for (int n = 0; n < 4; ++n) { ar[n] = (f32x4){0.f, 0.f, 0.f, 0.f}; ai[n] = (f32x4){0.f, 0.f, 0.f, 0.f};
#pragma unroll
                for (int ks = 0; ks < 2; ++ks) {
                    const bf16x8 wr_ = wl[((n * 2 + ks) * 2 + 0) * 64], wi_ = wl[((n * 2 + ks) * 2 + 1) * 64];
                    ar[n] = __builtin_amdgcn_mfma_f32_16x16x32_bf16(wr_, frag[ks], ar[n], 0, 0, 0);
                    ai[n] = __builtin_amdgcn_mfma_f32_16x16x32_bf16(wi_, frag[ks], ai[n], 0, 0, 0);
                } }
            float Aa[16], Bb[16];
#pragma unroll
            for (int n = 0; n < 4; ++n) {
                const int cho = wid * 64 + 32 * (n >> 1) + 8 * fq + 4 * (n & 1);
                const f32x4 rb = *(const LAS f32x4*)(cst + 5 * DH + cho), ib = *(const LAS f32x4*)(cst + 6 * DH + cho), spv = *(const LAS f32x4*)(cst + 7 * DH + cho);
#pragma unroll
                for (int jj = 0; jj < 4; ++jj) {
                    const float r = sigm(ar[n][jj] + rb[jj]), ig = sigm(ai[n][jj] + ib[jj]);
                    const float la = -8.0f * r * spv[jj], a = __expf(la), x2 = 2.0f * la;
                    const float m2s = -x2 * (1.0f + x2 * (0.5f + x2 * (0.16666667f + x2 * 0.041666668f))), m2 = (x2 > -0.0625f) ? m2s : 1.0f - a * a;
                    Aa[n * 4 + jj] = a; Bb[n * 4 + jj] = __builtin_amdgcn_sqrtf(m2) * ig * xc[n >> 1][4 * (n & 1) + jj];
                }
            }
#pragma unroll
            for (int k = 0; k < 16; ++k) {
                float A = Aa[k], B = Bb[k], Ap, Bq;
                Ap = dppf<0x111>(1.f, A); Bq = dppf<0x111>(0.f, B); B = fmaf(A, Bq, B); A *= Ap;
                Ap = dppf<0x112>(1.f, A); Bq = dppf<0x112>(0.f, B); B = fmaf(A, Bq, B); A *= Ap;
                Ap = dppf<0x114>(1.f, A); Bq = dppf<0x114>(0.f, B); B = fmaf(A, Bq, B); A *= Ap;
                Ap = dppf<0x118>(1.f, A); Bq = dppf<0x118>(0.f, B); B = fmaf(A, Bq, B); A *= Ap;
                Bb[k] = fmaf(A, Hc[k], B); Aa[k] = A * Pc[k];
            }
#pragma unroll
            for (int ks = 0; ks < 2; ++ks) {
                const size_t o = rowg * DH + wid * 64 + 32 * ks + 8 * fq;
                { u32x4 wh; wh.x = cvt_pk(Bb[8 * ks + 0], Bb[8 * ks + 1]); wh.y = cvt_pk(Bb[8 * ks + 2], Bb[8 * ks + 3]); wh.z = cvt_pk(Bb[8 * ks + 4], Bb[8 * ks + 5]); wh.w = cvt_pk(Bb[8 * ks + 6], Bb[8 * ks + 7]);
                  *(u32x4*)(hl + o) = wh; }
                u32x4 w; w.x = cvt_pk(Aa[8 * ks + 0], Aa[8 * ks + 1]); w.y = cvt_pk(Aa[8 * ks + 2], Aa[8 * ks + 3]); w.z = cvt_pk(Aa[8 * ks + 4], Aa[8 * ks + 5]); w.w = cvt_pk(Aa[8 * ks + 6], Aa[8 * ks + 7]);
                *(u32x4*)(Pp + o) = w;
            }
            const int src = (lane & 48) | 15;
#pragma unroll
            for (int k = 0; k < 16; ++k) { Hc[k] = __shfl(Bb[k], src); Pc[k] = __shfl(Aa[k], src); }
        }
        if (fr == 0) {
#pragma unroll
            for (int ks = 0; ks < 2; ++ks) {
                const size_t o = (size_t)(b * 128 + c) * DH + wid * 64 + 32 * ks + 8 * fq;
                *(f32x4*)(carA + o) = (f32x4){Pc[8 * ks + 0], Pc[8 * ks + 1], Pc[8 * ks + 2], Pc[8 * ks + 3]}; *(f32x4*)(carA + o + 4) = (f32x4){Pc[8 * ks + 4], Pc[8 * ks + 5], Pc[8 * ks + 6], Pc[8 * ks + 7]};
                *(f32x4*)(carH + o) = (f32x4){Hc[8 * ks + 0], Hc[8 * ks + 1], Hc[8 * ks + 2], Hc[8 * ks + 3]}; *(f32x4*)(carH + o + 4) = (f32x4){Hc[8 * ks + 4], Hc[8 * ks + 5], Hc[8 * ks + 6], Hc[8 * ks + 7]};
            }
        }
    }
    __syncthreads();
}


template <int NMR, bool FROM_LDS> __device__ __forceinline__ void m2_rnn_round(LAS unsigned char* lds, const bf16* hl, const bf16* Pp, const bf16* proj, bf16* Y, LAS float* red1, const float (&cr)[16], int b, int t0, int mbase, int wid, int fr, int fq) {
    u32x4 hw[NMR][2], pw[NMR][2], gw[NMR][2];
#pragma unroll
    for (int m = 0; m < NMR; ++m)
#pragma unroll
        for (int ks = 0; ks < 2; ++ks) { const size_t rowg = (size_t)b * TT + t0 + 16 * (mbase + m) + fr; const int ch = wid * 64 + 32 * ks + 8 * fq; const size_t o = rowg * DH + ch;
            if (FROM_LDS) { const int lane = fq * 16 + fr; hw[m][ks] = *(const LAS u32x4*)(lds + LDS_HL + wid * 8192 + (((mbase + m) * 2 + ks) * 64 + lane) * 16); pw[m][ks] = *(const LAS u32x4*)(lds + LDS_P + wid * 8192 + (((mbase + m) * 2 + ks) * 64 + lane) * 16); }
            else { hw[m][ks] = *(const u32x4*)(hl + o); pw[m][ks] = *(const u32x4*)(Pp + o); } gw[m][ks] = *(const u32x4*)(proj + rowg * DIN + 2 * DH + ch); }
    float y[NMR][16];
#pragma unroll
    for (int m = 0; m < NMR; ++m) { float s = 0.f;
#pragma unroll
        for (int ks = 0; ks < 2; ++ks) { float pf[8], gt[8]; unpack8(pw[m][ks], pf); unpack8(gw[m][ks], gt);
            float hh[8]; unpack8(hw[m][ks], hh);
#pragma unroll
            for (int e = 0; e < 8; ++e) { const float hv = fmaf(pf[e], cr[8 * ks + e], hh[e]), x = gt[e];
                const float ge = x * __builtin_amdgcn_rcpf(1.0f + __expf(-1.5957691216f * (x + 0.044715f * x * x * x)));
                const float yy = hv * ge; y[m][8 * ks + e] = yy; s = fmaf(yy, yy, s); } }
        s += __shfl_xor(s, 16); s += __shfl_xor(s, 32);
        if (fq == 0) red1[(16 * (mbase + m) + fr) * 8 + wid] = s; }
    __syncthreads();
#pragma unroll
    for (int m = 0; m < NMR; ++m) { const size_t rowg = (size_t)b * TT + t0 + 16 * (mbase + m) + fr;
        const f32x4 r0 = *(const LAS f32x4*)(red1 + (16 * (mbase + m) + fr) * 8), r1 = *(const LAS f32x4*)(red1 + (16 * (mbase + m) + fr) * 8 + 4);
        const float rs = __builtin_amdgcn_rsqf((((r0.x + r0.y) + (r0.z + r0.w)) + ((r1.x + r1.y) + (r1.z + r1.w))) * (1.0f / DH) + EPS);
#pragma unroll
        for (int ks = 0; ks < 2; ++ks) { float yy[8];
#pragma unroll
            for (int e = 0; e < 8; ++e) yy[e] = y[m][8 * ks + e] * rs;
            *(u32x4*)(Y + rowg * D + DH + wid * 64 + 32 * ks + 8 * fq) = pack8(yy); } }
}


template <int NMR> __device__ __forceinline__ void m2_pool_round(const bf16* proj, bf16* Y, const bf16* Wp, const float* pbias, const float* pscale, LAS float* red2,
                                                                  int b, int t0, int mbase, int g, int half, int kwin, int wid, int fr, int fq) {
    const int tb = t0 + 16 * mbase;
    bf16x8 pfr[NMR][4];
#pragma unroll
    for (int ks = 0; ks < 4; ++ks) {
        const int chb = g * 128 + 32 * ks + 8 * fq;
        float pu[8], p2[8], p4[8], p8[8];
        if (tb) { const u32x4 raw = *(const u32x4*)(proj + ((size_t)b * TT + tb - 16 + fr) * DIN + chb); unpack8(raw, pu);
#pragma unroll
            for (int e = 0; e < 8; ++e) { p2[e] = pu[e] + dppf<0x111>(0.f, pu[e]); p4[e] = p2[e] + dppf<0x112>(0.f, p2[e]); p8[e] = p4[e] + dppf<0x114>(0.f, p4[e]); } }
        else {
#pragma unroll
            for (int e = 0; e < 8; ++e) { pu[e] = 0.f; p2[e] = 0.f; p4[e] = 0.f; p8[e] = 0.f; } }
#pragma unroll
        for (int m = 0; m < NMR; ++m) {
            const int t = tb + 16 * m + fr; const size_t rowg = (size_t)b * TT + t;
            const u32x4 raw = *(const u32x4*)(proj + rowg * DIN + chb); float u[8], po[8]; unpack8(raw, u);
            const int cnt = (t + 1 < kwin) ? t + 1 : kwin; const float rc = __builtin_amdgcn_rcpf((float)cnt);
#pragma unroll
            for (int e = 0; e < 8; ++e) {
                const float s2 = u[e] + shiftd<1>(u[e], pu[e]), s4 = s2 + shiftd<2>(s2, p2[e]), s8 = s4 + shiftd<4>(s4, p4[e]), s16 = s8 + shiftd<8>(s8, p8[e]);
                const float win = g == 0 ? s2 : (g == 1 ? s4 : (g == 2 ? s8 : s16));
                po[e] = fmaf(win, rc, -u[e]); pu[e] = u[e]; p2[e] = s2; p4[e] = s4; p8[e] = s8;
            }
            pfr[m][ks] = __builtin_bit_cast(bf16x8, pack8(po));
        }
    }
    bf16x8 wfr[4][4];
#pragma unroll
    for (int n = 0; n < 4; ++n)
#pragma unroll
        for (int ks = 0; ks < 4; ++ks) wfr[n][ks] = *(const bf16x8*)(Wp + (size_t)(64 * half + outchan(n, fr)) * 128 + 32 * ks + 8 * fq);
#pragma unroll 1
    for (int pass = 0; pass < 2; ++pass) {
#pragma unroll
        for (int m = 0; m < NMR; ++m) {
            const int t = tb + 16 * m + fr; const size_t rowg = (size_t)b * TT + t; float s = 0.f, rs = 0.f;
            if (pass) { const f32x4 r0 = *(const LAS f32x4*)(red2 + (16 * (mbase + m) + fr) * 8), r1 = *(const LAS f32x4*)(red2 + (16 * (mbase + m) + fr) * 8 + 4);
                rs = __builtin_amdgcn_rsqf((((r0.x + r0.y) + (r0.z + r0.w)) + ((r1.x + r1.y) + (r1.z + r1.w))) * (1.0f / DH) + EPS); }
#pragma unroll
            for (int np = 0; np < 2; ++np) {
                f32x4 o2[2];
#pragma unroll
                for (int nn = 0; nn < 2; ++nn) { const int n = 2 * np + nn;
                    f32x4 acc = {0.f, 0.f, 0.f, 0.f};
#pragma unroll
                    for (int ks = 0; ks < 4; ++ks) acc = __builtin_amdgcn_mfma_f32_16x16x32_bf16(wfr[n][ks], pfr[m][ks], acc, 0, 0, 0);
                    const int col = g * 128 + 64 * half + 32 * np + 8 * fq + 4 * nn;
                    const f32x4 pb = *(const f32x4*)(pbias + col), ps = *(const f32x4*)(pscale + col);
                    acc = (acc + pb) * ps; s += (acc.x * acc.x + acc.y * acc.y) + (acc.z * acc.z + acc.w * acc.w); o2[nn] = acc * rs; }
                if (pass) { u32x4 w; w.x = cvt_pk(o2[0].x, o2[0].y); w.y = cvt_pk(o2[0].z, o2[0].w); w.z = cvt_pk(o2[1].x, o2[1].y); w.w = cvt_pk(o2[1].z, o2[1].w);
                    *(u32x4*)(Y + rowg * D + g * 128 + 64 * half + 32 * np + 8 * fq) = w; }
            }
            if (!pass) { s += __shfl_xor(s, 16); s += __shfl_xor(s, 32); if (fq == 0) red2[(16 * (mbase + m) + fr) * 8 + wid] = s; }
        }
        if (!pass) __syncthreads();
    }
}

__device__ __forceinline__ void m2_phase(const Params& p_, LAS unsigned char* lds, int G, int l) {
    const Params p = launder(p_);
    int tid_ = threadIdx.x; asm volatile("" : "+v"(tid_));
    const int tid = tid_, lane = tid & 63, wid = __builtin_amdgcn_readfirstlane(tid >> 6), fr = lane & 15, fq = lane >> 4;
    LAS float* segA = (LAS float*)lds; LAS float* segH = (LAS float*)(lds + 16384); LAS float* carr = (LAS float*)(lds + 32768);
    LAS float* red1 = (LAS float*)(lds + 34816); LAS float* red2 = (LAS float*)(lds + 37888);
    const bf16* proj = (const bf16*)(p.ws + WS_PROJ); bf16* Y = (bf16*)(p.ws + WS_Y);
    const bf16* hl = (const bf16*)(p.ws + WS_HL); const bf16* Pp = (const bf16*)(p.ws + WS_P);
    const float* carA = (const float*)(p.ws + WS_CARA); const float* carH = (const float*)(p.ws + WS_CARH);
    const int g = wid >> 1, half = wid & 1, kwin = 2 << g;
    const bf16* Wp = (const bf16*)(p.ws + WS_POOLW) + (size_t)(l * 4 + g) * 16384;
    const float* pbias = p.in[5] + l * DH; const float* pscale = p.in[6] + l * DH;
    for (int unit = blockIdx.x; unit < 256; unit += G) {
        const int b = unit >> 7, c = unit & 127, t0 = c ? NMETA + 64 * c : 0, NM = c ? 4 : 5;
        {
            const int q = (c + 7) >> 3, jlo = wid * q, jhi = (jlo + q < c) ? jlo + q : c;
            f32x4 A0 = {1.f, 1.f, 1.f, 1.f}, A1 = A0, H0 = {0.f, 0.f, 0.f, 0.f}, H1 = H0;
            for (int j = jlo; j < jhi; j += 8) {
                f32x4 a0[8], a1[8], h0[8], h1[8];
#pragma unroll
                for (int i = 0; i < 8; ++i) { const int jj = (j + i < jhi) ? j + i : jhi - 1; const size_t o = (size_t)(b * 128 + jj) * DH + 8 * lane;
                    a0[i] = *(const f32x4*)(carA + o); a1[i] = *(const f32x4*)(carA + o + 4); h0[i] = *(const f32x4*)(carH + o); h1[i] = *(const f32x4*)(carH + o + 4); }
#pragma unroll
                for (int i = 0; i < 8; ++i) if (j + i < jhi) { H0 = a0[i] * H0 + h0[i]; A0 = A0 * a0[i]; H1 = a1[i] * H1 + h1[i]; A1 = A1 * a1[i]; }
            }
            *(LAS f32x4*)(segA + wid * DH + 8 * lane) = A0; *(LAS f32x4*)(segA + wid * DH + 8 * lane + 4) = A1;
            *(LAS f32x4*)(segH + wid * DH + 8 * lane) = H0; *(LAS f32x4*)(segH + wid * DH + 8 * lane + 4) = H1;
        }
        __syncthreads();
        { float cy = 0.f;
#pragma unroll
          for (int s8 = 0; s8 < 8; ++s8) cy = segA[s8 * DH + tid] * cy + segH[s8 * DH + tid];
          carr[tid] = cy; }
        __syncthreads();
        {
            float cr[16];
#pragma unroll
            for (int ks = 0; ks < 2; ++ks) { const f32x4 c0 = *(const LAS f32x4*)(carr + wid * 64 + 32 * ks + 8 * fq), c1 = *(const LAS f32x4*)(carr + wid * 64 + 32 * ks + 8 * fq + 4);
                cr[8 * ks + 0] = c0.x; cr[8 * ks + 1] = c0.y; cr[8 * ks + 2] = c0.z; cr[8 * ks + 3] = c0.w; cr[8 * ks + 4] = c1.x; cr[8 * ks + 5] = c1.y; cr[8 * ks + 6] = c1.z; cr[8 * ks + 7] = c1.w; }
            m2_rnn_round<4, false>(lds, hl, Pp, proj, Y, red1, cr, b, t0, 0, wid, fr, fq);
            if (NM == 5) m2_rnn_round<1, false>(lds, hl, Pp, proj, Y, red1, cr, b, t0, 4, wid, fr, fq);
        }
        m2_pool_round<4>(proj, Y, Wp, pbias, pscale, red2, b, t0, 0, g, half, kwin, wid, fr, fq);
        if (NM == 5) m2_pool_round<1>(proj, Y, Wp, pbias, pscale, red2, b, t0, 4, g, half, kwin, wid, fr, fq);
    }
    __syncthreads();
}

__device__ __forceinline__ void final_norm(const Params& p_, int G) {
    const Params p = launder(p_);
    int tid_ = threadIdx.x; asm volatile("" : "+v"(tid_));
    const int tid = tid_, lane = tid & 63, wid = tid >> 6; const int gw = blockIdx.x * 8 + wid, NGW = G * 8;
    const bf16* hb = (const bf16*)(p.ws + WS_HB);
    const f32x4* gp = (const f32x4*)p.in[19] + 2 * lane; f32x4 gg[2][2];
#pragma unroll
    for (int j = 0; j < 2; ++j) { gg[j][0] = gp[128 * j]; gg[j][1] = gp[128 * j + 1]; }
    for (int m = gw; m < M; m += NGW) {
        const u32x4* xr = (const u32x4*)(hb + (size_t)m * D) + lane; float v[2][8]; float s = 0.f;
#pragma unroll
        for (int j = 0; j < 2; ++j) { unpack8(xr[64 * j], v[j]);
#pragma unroll
            for (int e = 0; e < 8; ++e) s = fmaf(v[j][e], v[j][e], s); }
        const float rs = 1.0f / sqrtf(wave_sum(s) * (1.0f / D) + EPS);
        f32x4* orow = (f32x4*)(p.out + (size_t)m * D) + 2 * lane;
#pragma unroll
        for (int j = 0; j < 2; ++j) {
            orow[128 * j] = (f32x4){v[j][0] * rs * gg[j][0].x, v[j][1] * rs * gg[j][0].y, v[j][2] * rs * gg[j][0].z, v[j][3] * rs * gg[j][0].w};
            orow[128 * j + 1] = (f32x4){v[j][4] * rs * gg[j][1].x, v[j][5] * rs * gg[j][1].y, v[j][6] * rs * gg[j][1].z, v[j][7] * rs * gg[j][1].w}; }
    }
}


template <int KW> __device__ __forceinline__ float pool_win(float P, float Sp) {
    float w = P;
    if (KW < 16) w -= dppf<0x110 + (KW & 15)>(0.f, P);
    return w + dppf<0x100 + (17 - KW)>(0.f, Sp);
}
template <int KW, int MAXG> __device__ __forceinline__ void pool_frags(const bf16* proj, bf16x8 (&pfr)[MAXG][4], int b, int tb, int cnt, int g, int fr, int fq) {
#pragma unroll
    for (int ks = 0; ks < 4; ++ks) {
        const int chb = g * 128 + 32 * ks + 8 * fq;
        float Sp[8];
        if (tb) { const u32x4 raw = *(const u32x4*)(proj + ((size_t)b * TT + tb - 16 + fr) * DIN + chb); unpack8(raw, Sp);
#pragma unroll
            for (int e = 0; e < 8; ++e) { Sp[e] += dppf<0x101>(0.f, Sp[e]); Sp[e] += dppf<0x102>(0.f, Sp[e]); Sp[e] += dppf<0x104>(0.f, Sp[e]); Sp[e] += dppf<0x108>(0.f, Sp[e]); } }
        else {
#pragma unroll
            for (int e = 0; e < 8; ++e) Sp[e] = 0.f; }
#pragma unroll
        for (int mi = 0; mi < MAXG; ++mi) if (mi < cnt) {
            const int t = tb + 16 * mi + fr;
            const u32x4 raw = *(const u32x4*)(proj + ((size_t)b * TT + t) * DIN + chb); float u[8], po[8]; unpack8(raw, u);
            const int cn = (t + 1 < KW) ? t + 1 : KW; const float rc = __builtin_amdgcn_rcpf((float)cn);
#pragma unroll
            for (int e = 0; e < 8; ++e) {
                float P = u[e]; P += dppf<0x111>(0.f, P); P += dppf<0x112>(0.f, P); P += dppf<0x114>(0.f, P); P += dppf<0x118>(0.f, P);
                float S = u[e]; S += dppf<0x101>(0.f, S); S += dppf<0x102>(0.f, S); S += dppf<0x104>(0.f, S); S += dppf<0x108>(0.f, S);
                po[e] = fmaf(pool_win<KW>(P, Sp[e]), rc, -u[e]); Sp[e] = S;
            }
            pfr[mi][ks] = __builtin_bit_cast(bf16x8, pack8(po));
        }
    }
}
__device__ __forceinline__ void m2_pool2(const bf16* proj, bf16* Y, const bf16* Wp, const float* pbias, const float* pscale, LAS float* red2, int b, int t0, int NM, int g, int th, int fr, int fq) {
    const int m0 = th ? (NM == 5 ? 3 : 2) : 0, cnt = th ? 2 : (NM == 5 ? 3 : 2), tb = t0 + 16 * m0;
    bf16x8 pfr[3][4];
    switch (g) {
        case 0: pool_frags<2, 3>(proj, pfr, b, tb, cnt, g, fr, fq); break;
        case 1: pool_frags<4, 3>(proj, pfr, b, tb, cnt, g, fr, fq); break;
        case 2: pool_frags<8, 3>(proj, pfr, b, tb, cnt, g, fr, fq); break;
        default: pool_frags<16, 3>(proj, pfr, b, tb, cnt, g, fr, fq); break;
    }
    f32x4 ov[3][8]; float sq[3] = {0.f, 0.f, 0.f};
#pragma unroll
    for (int n = 0; n < 8; ++n) {
        bf16x8 wf[4];
#pragma unroll
        for (int ks = 0; ks < 4; ++ks) wf[ks] = *(const bf16x8*)(Wp + (size_t)outchan(n, fr) * 128 + 32 * ks + 8 * fq);
        const int col = g * 128 + 32 * (n >> 1) + 8 * fq + 4 * (n & 1);
        const f32x4 pb = *(const f32x4*)(pbias + col), ps = *(const f32x4*)(pscale + col);
#pragma unroll
        for (int mi = 0; mi < 3; ++mi) if (mi < cnt) {
            f32x4 acc = {0.f, 0.f, 0.f, 0.f};
#pragma unroll
            for (int ks = 0; ks < 4; ++ks) acc = __builtin_amdgcn_mfma_f32_16x16x32_bf16(wf[ks], pfr[mi][ks], acc, 0, 0, 0);
            acc = (acc + pb) * ps; ov[mi][n] = acc; sq[mi] += (acc.x * acc.x + acc.y * acc.y) + (acc.z * acc.z + acc.w * acc.w);
        }
    }
#pragma unroll
    for (int mi = 0; mi < 3; ++mi) if (mi < cnt) { float s = sq[mi]; s += __shfl_xor(s, 16); s += __shfl_xor(s, 32); if (fq == 0) red2[(16 * (m0 + mi) + fr) * 4 + g] = s; }
    __syncthreads();
#pragma unroll
    for (int mi = 0; mi < 3; ++mi) if (mi < cnt) {
        const size_t rowg = (size_t)b * TT + tb + 16 * mi + fr;
        const f32x4 r0 = *(const LAS f32x4*)(red2 + (16 * (m0 + mi) + fr) * 4);
        const float rs = __builtin_amdgcn_rsqf(((r0.x + r0.y) + (r0.z + r0.w)) * (1.0f / DH) + EPS);
#pragma unroll
        for (int np = 0; np < 4; ++np) {
            const f32x4 a = ov[mi][2 * np] * rs, bq = ov[mi][2 * np + 1] * rs;
            u32x4 w; w.x = cvt_pk(a.x, a.y); w.y = cvt_pk(a.z, a.w); w.z = cvt_pk(bq.x, bq.y); w.w = cvt_pk(bq.z, bq.w);
            *(u32x4*)(Y + rowg * D + g * 128 + 32 * np + 8 * fq) = w;
        }
    }
}

#ifndef PROBE_PHASE
#define PROBE_PHASE (-1)
#endif
#ifndef PROBE_BLOCK
#define PROBE_BLOCK 0
#endif
#define TIC() do { if (PROBE_PHASE >= 0) tic = __builtin_amdgcn_s_memrealtime(); } while (0)
#define TOC(k) do { if (PROBE_PHASE == (k)) tacc += __builtin_amdgcn_s_memrealtime() - tic; } while (0)

__device__ __forceinline__ void mixer_phase(const Params& p_, LAS unsigned char* lds, int G, int l, unsigned long long& tic, unsigned long long& tacc) {
    const Params p = launder(p_);
    int tid_ = threadIdx.x; asm volatile("" : "+v"(tid_));
    const int tid = tid_, lane = tid & 63, wid = __builtin_amdgcn_readfirstlane(tid >> 6), fr = lane & 15, fq = lane >> 4;
    LAS float* cst = (LAS float*)(lds + LDS_CST);
    const bf16* proj = (const bf16*)(p.ws + WS_PROJ);
    const bf16* Wr = (const bf16*)(p.ws + WS_GR) + (size_t)(l * 8 + wid) * 4096; const bf16* Wi = (const bf16*)(p.ws + WS_GI) + (size_t)(l * 8 + wid) * 4096;
    LAS float* segA = (LAS float*)(lds + LDS_CST); LAS float* segH = (LAS float*)(lds + LDS_CST + 8192); LAS float* carr = (LAS float*)(lds + LDS_CARR);
    LAS float* red1 = (LAS float*)(lds + LDS_RED1); LAS float* red2 = (LAS float*)(lds + LDS_RED2);
    bf16* Y = (bf16*)(p.ws + WS_Y);
    const int g = wid >> 1, half = wid & 1, kwin = 2 << g;
    const bf16* Wp = (const bf16*)(p.ws + WS_POOLW) + (size_t)(l * 4 + g) * 16384;
    const float* pbias = p.in[5] + l * DH; const float* pscale = p.in[6] + l * DH;
    unsigned* flags = (unsigned*)(p.ws + WS_FLAG); unsigned* car = (unsigned*)(p.ws + WS_CARA);
    bf16* hl = (bf16*)(p.ws + WS_HL); bf16* Pp = (bf16*)(p.ws + WS_P);
    float* carA = (float*)(p.ws + WS_CARA); float* carH = (float*)(p.ws + WS_CARH);
    const int unit = blockIdx.x;
    if (unit < 256) {
        const int b = unit >> 7, c = unit & 127, t0 = c ? NMETA + 64 * c : 0, NM = c ? 4 : 5;
        TIC();
        float cv[8];
#pragma unroll
        for (int k4 = 0; k4 < 4; ++k4) cv[k4] = p.in[7][(l * 4 + k4) * DH + tid];
        cv[4] = p.in[8][l * DH + tid]; cv[5] = p.in[10][l * DH + tid]; cv[6] = p.in[12][l * DH + tid]; cv[7] = ((const float*)(p.ws + WS_SP))[l * DH + tid];
        bf16x8 wfr[4][2][2];
#pragma unroll
        for (int n = 0; n < 4; ++n)
#pragma unroll
            for (int ks = 0; ks < 2; ++ks) { wfr[n][ks][0] = *(const bf16x8*)(Wr + outchan(n, fr) * 64 + 32 * ks + 8 * fq); wfr[n][ks][1] = *(const bf16x8*)(Wi + outchan(n, fr) * 64 + 32 * ks + 8 * fq); }
        LAS float* cslot = (LAS float*)(lds + LDS_CARRY) + (wid * 4 + fq) * 32;
        if (fr == 15) {
#pragma unroll
            for (int k4 = 0; k4 < 4; ++k4) { *(LAS f32x4*)(cslot + 4 * k4) = (f32x4){0.f, 0.f, 0.f, 0.f}; *(LAS f32x4*)(cslot + 16 + 4 * k4) = (f32x4){1.f, 1.f, 1.f, 1.f}; } }
        u32x4 raw[2][4];
#pragma unroll
        for (int ks = 0; ks < 2; ++ks)
#pragma unroll
            for (int d = 0; d < 4; ++d) { const int tt = t0 + fr - 3 + d; raw[ks][d] = (u32x4){0u, 0u, 0u, 0u};
                if (tt >= 0) raw[ks][d] = *(const u32x4*)(proj + ((size_t)b * TT + tt) * DIN + DH + wid * 64 + 32 * ks + 8 * fq); }
        __syncthreads();
#pragma unroll
        for (int k8 = 0; k8 < 8; ++k8) cst[k8 * DH + tid] = cv[k8];
        __syncthreads();
        TOC(10); TIC();
#pragma unroll 1
        for (int m = 0; m < NM; ++m) {
            const int t = t0 + 16 * m + fr; const size_t rowg = (size_t)b * TT + t;
            u32x4 nraw[2][4];
#pragma unroll
            for (int ks = 0; ks < 2; ++ks)
#pragma unroll
                for (int d = 0; d < 4; ++d) { nraw[ks][d] = (u32x4){0u, 0u, 0u, 0u};
                    if (m + 1 < NM) nraw[ks][d] = *(const u32x4*)(proj + ((size_t)b * TT + t + 13 + d) * DIN + DH + wid * 64 + 32 * ks + 8 * fq); }
            float xc[2][8]; bf16x8 frag[2];
#pragma unroll
            for (int ks = 0; ks < 2; ++ks) {
                const int chb = wid * 64 + 32 * ks + 8 * fq;
                { const f32x4 c0 = *(const LAS f32x4*)(cst + 4 * DH + chb), c1 = *(const LAS f32x4*)(cst + 4 * DH + chb + 4);
                  xc[ks][0] = c0.x; xc[ks][1] = c0.y; xc[ks][2] = c0.z; xc[ks][3] = c0.w; xc[ks][4] = c1.x; xc[ks][5] = c1.y; xc[ks][6] = c1.z; xc[ks][7] = c1.w; }
#pragma unroll
                for (int d = 0; d < 4; ++d) {
                    float u[8]; unpack8(raw[ks][d], u);
                    const f32x4 w0 = *(const LAS f32x4*)(cst + d * DH + chb), w1 = *(const LAS f32x4*)(cst + d * DH + chb + 4);
                    xc[ks][0] += u[0] * w0.x; xc[ks][1] += u[1] * w0.y; xc[ks][2] += u[2] * w0.z; xc[ks][3] += u[3] * w0.w;
                    xc[ks][4] += u[4] * w1.x; xc[ks][5] += u[5] * w1.y; xc[ks][6] += u[6] * w1.z; xc[ks][7] += u[7] * w1.w;
                    raw[ks][d] = nraw[ks][d];
                }
                frag[ks] = __builtin_bit_cast(bf16x8, pack8(xc[ks]));
            }
            f32x4 ar[4], ai[4];
#pragma unroll
            for (int n = 0; n < 4; ++n) { ar[n] = (f32x4){0.f, 0.f, 0.f, 0.f}; ai[n] = (f32x4){0.f, 0.f, 0.f, 0.f};
#pragma unroll
                for (int ks = 0; ks < 2; ++ks) {
                    const bf16x8 wr_ = wfr[n][ks][0], wi_ = wfr[n][ks][1];
                    ar[n] = __builtin_amdgcn_mfma_f32_16x16x32_bf16(wr_, frag[ks], ar[n], 0, 0, 0);
                    ai[n] = __builtin_amdgcn_mfma_f32_16x16x32_bf16(wi_, frag[ks], ai[n], 0, 0, 0);
                } }
            float Aa[16], Bb[16];
#pragma unroll
            for (int n = 0; n < 4; ++n) {
                const int cho = wid * 64 + 32 * (n >> 1) + 8 * fq + 4 * (n & 1);
                const f32x4 rb = *(const LAS f32x4*)(cst + 5 * DH + cho), ib = *(const LAS f32x4*)(cst + 6 * DH + cho), spv = *(const LAS f32x4*)(cst + 7 * DH + cho);
#pragma unroll
                for (int jj = 0; jj < 4; ++jj) {
                    const float r = sigm(ar[n][jj] + rb[jj]), ig = sigm(ai[n][jj] + ib[jj]);
                    const float la = -8.0f * r * spv[jj], a = __expf(la), x2 = 2.0f * la;
                    const float m2s = -x2 * (1.0f + x2 * (0.5f + x2 * (0.16666667f + x2 * 0.041666668f))), m2 = (x2 > -0.0625f) ? m2s : 1.0f - a * a;
                    Aa[n * 4 + jj] = a; Bb[n * 4 + jj] = __builtin_amdgcn_sqrtf(m2) * ig * xc[n >> 1][4 * (n & 1) + jj];
                }
            }
#pragma unroll
            for (int k = 0; k < 16; ++k) {
                float A = Aa[k], B = Bb[k], Ap, Bq;
                Ap = dppf<0x111>(1.f, A); Bq = dppf<0x111>(0.f, B); B = fmaf(A, Bq, B); A *= Ap;
                Ap = dppf<0x112>(1.f, A); Bq = dppf<0x112>(0.f, B); B = fmaf(A, Bq, B); A *= Ap;
                Ap = dppf<0x114>(1.f, A); Bq = dppf<0x114>(0.f, B); B = fmaf(A, Bq, B); A *= Ap;
                Ap = dppf<0x118>(1.f, A); Bq = dppf<0x118>(0.f, B); B = fmaf(A, Bq, B); A *= Ap;
                Bb[k] = B; Aa[k] = A;
            }
            {
                float Hc[16], Pc[16];
#pragma unroll
                for (int k4 = 0; k4 < 4; ++k4) { const f32x4 hq = *(const LAS f32x4*)(cslot + 4 * k4), pq = *(const LAS f32x4*)(cslot + 16 + 4 * k4);
                    Hc[4 * k4] = hq.x; Hc[4 * k4 + 1] = hq.y; Hc[4 * k4 + 2] = hq.z; Hc[4 * k4 + 3] = hq.w; Pc[4 * k4] = pq.x; Pc[4 * k4 + 1] = pq.y; Pc[4 * k4 + 2] = pq.z; Pc[4 * k4 + 3] = pq.w; }
#pragma unroll
                for (int k = 0; k < 16; ++k) { Bb[k] = fmaf(Aa[k], Hc[k], Bb[k]); Aa[k] *= Pc[k]; }
                if (fr == 15) {
#pragma unroll
                    for (int k4 = 0; k4 < 4; ++k4) { *(LAS f32x4*)(cslot + 4 * k4) = (f32x4){Bb[4 * k4], Bb[4 * k4 + 1], Bb[4 * k4 + 2], Bb[4 * k4 + 3]}; *(LAS f32x4*)(cslot + 16 + 4 * k4) = (f32x4){Aa[4 * k4], Aa[4 * k4 + 1], Aa[4 * k4 + 2], Aa[4 * k4 + 3]}; } }
            }
#pragma unroll
            for (int ks = 0; ks < 2; ++ks) {
                const size_t o = rowg * DH + wid * 64 + 32 * ks + 8 * fq;
                u32x4 wh; wh.x = cvt_pk(Bb[8 * ks + 0], Bb[8 * ks + 1]); wh.y = cvt_pk(Bb[8 * ks + 2], Bb[8 * ks + 3]); wh.z = cvt_pk(Bb[8 * ks + 4], Bb[8 * ks + 5]); wh.w = cvt_pk(Bb[8 * ks + 6], Bb[8 * ks + 7]);
                u32x4 w; w.x = cvt_pk(Aa[8 * ks + 0], Aa[8 * ks + 1]); w.y = cvt_pk(Aa[8 * ks + 2], Aa[8 * ks + 3]); w.z = cvt_pk(Aa[8 * ks + 4], Aa[8 * ks + 5]); w.w = cvt_pk(Aa[8 * ks + 6], Aa[8 * ks + 7]);
                if (m < 4) { *(LAS u32x4*)(lds + LDS_HL + wid * 8192 + ((m * 2 + ks) * 64 + lane) * 16) = wh; *(LAS u32x4*)(lds + LDS_P + wid * 8192 + ((m * 2 + ks) * 64 + lane) * 16) = w; }
                else { *(u32x4*)(hl + o) = wh; *(u32x4*)(Pp + o) = w; }
            }
        }
        TOC(11); TIC();
        if (fr == 0) {
            float Hc[16], Pc[16];
#pragma unroll
            for (int k4 = 0; k4 < 4; ++k4) { const f32x4 hq = *(const LAS f32x4*)(cslot + 4 * k4), pq = *(const LAS f32x4*)(cslot + 16 + 4 * k4);
                Hc[4 * k4] = hq.x; Hc[4 * k4 + 1] = hq.y; Hc[4 * k4 + 2] = hq.z; Hc[4 * k4 + 3] = hq.w; Pc[4 * k4] = pq.x; Pc[4 * k4 + 1] = pq.y; Pc[4 * k4 + 2] = pq.z; Pc[4 * k4 + 3] = pq.w; }
#pragma unroll
            for (int ks = 0; ks < 2; ++ks) {
                const size_t o = (size_t)(b * 128 + c) * DH + wid * 64 + 32 * ks + 8 * fq;
#pragma unroll
                for (int e2 = 0; e2 < 4; ++e2) {
                    const unsigned lo = cvt_pk(Pc[8 * ks + 2 * e2], Hc[8 * ks + 2 * e2]), hi = cvt_pk(Pc[8 * ks + 2 * e2 + 1], Hc[8 * ks + 2 * e2 + 1]);
                    __hip_atomic_store((unsigned long long*)(car + o) + e2, ((unsigned long long)hi << 32) | lo, __ATOMIC_RELAXED, __HIP_MEMORY_SCOPE_AGENT); }
            }
        }
        int fr2 = fr, fq2 = fq, tid2 = tid; asm volatile("" : "+v"(fr2), "+v"(fq2), "+v"(tid2));
        TOC(12); TIC();
#ifndef NO_MX_POOL
        m2_pool2(proj, Y, Wp, pbias, pscale, red2, b, t0, NM, g, half, fr2, fq2);
#endif
        asm volatile("s_waitcnt vmcnt(0)" ::: "memory");
        __syncthreads();
        if (tid2 == 0) __hip_atomic_store(flags + unit, (unsigned)(l + 1), __ATOMIC_RELAXED, __HIP_MEMORY_SCOPE_AGENT);
        TOC(13); TIC();
        if (tid2 < c) { unsigned sp = 0; while (__hip_atomic_load(flags + b * 128 + tid2, __ATOMIC_RELAXED, __HIP_MEMORY_SCOPE_AGENT) < (unsigned)(l + 1)) { __builtin_amdgcn_s_sleep(2); if (++sp > (1u << 22)) break; } }
#if defined(MIXER_ACQ_FENCE)
        if (tid2 < c) __builtin_amdgcn_fence(__ATOMIC_ACQUIRE, "agent");
#endif
        __syncthreads();
        TOC(14); TIC();
        {
            const int q = (c + 3) >> 2, seg = tid2 >> 7, cgi = tid2 & 127, jlo = seg * q, jhi = (jlo + q < c) ? jlo + q : c;
            f32x4 A0 = {1.f, 1.f, 1.f, 1.f}, H0 = {0.f, 0.f, 0.f, 0.f};
            for (int j = jlo; j < jhi; j += 16) {
                unsigned long long w0[16], w1[16];
#pragma unroll
                for (int i = 0; i < 16; ++i) { const int jj = (j + i < jhi) ? j + i : jhi - 1; const size_t o = (size_t)(b * 128 + jj) * DH + 4 * cgi;
                    w0[i] = __hip_atomic_load((const unsigned long long*)(car + o), __ATOMIC_RELAXED, __HIP_MEMORY_SCOPE_AGENT); w1[i] = __hip_atomic_load((const unsigned long long*)(car + o) + 1, __ATOMIC_RELAXED, __HIP_MEMORY_SCOPE_AGENT); }
#pragma unroll
                for (int i = 0; i < 16; ++i) if (j + i < jhi) {
                    const f32x4 a = {bf_lo((unsigned)w0[i]), bf_lo((unsigned)(w0[i] >> 32)), bf_lo((unsigned)w1[i]), bf_lo((unsigned)(w1[i] >> 32))};
                    const f32x4 h = {bf_hi((unsigned)w0[i]), bf_hi((unsigned)(w0[i] >> 32)), bf_hi((unsigned)w1[i]), bf_hi((unsigned)(w1[i] >> 32))};
                    H0 = a * H0 + h; A0 = A0 * a; }
            }
            *(LAS f32x4*)(segA + seg * DH + 4 * cgi) = A0; *(LAS f32x4*)(segH + seg * DH + 4 * cgi) = H0;
        }
        __syncthreads();
        { float cy = 0.f;
#pragma unroll
          for (int s4 = 0; s4 < 4; ++s4) cy = segA[s4 * DH + tid2] * cy + segH[s4 * DH + tid2];
          carr[tid2] = cy; }
        __syncthreads();
        TOC(15); TIC();
        {
            float cr[16];
#pragma unroll
            for (int ks = 0; ks < 2; ++ks) { const f32x4 c0 = *(const LAS f32x4*)(carr + wid * 64 + 32 * ks + 8 * fq2), c1 = *(const LAS f32x4*)(carr + wid * 64 + 32 * ks + 8 * fq2 + 4);
                cr[8 * ks + 0] = c0.x; cr[8 * ks + 1] = c0.y; cr[8 * ks + 2] = c0.z; cr[8 * ks + 3] = c0.w; cr[8 * ks + 4] = c1.x; cr[8 * ks + 5] = c1.y; cr[8 * ks + 6] = c1.z; cr[8 * ks + 7] = c1.w; }
#ifndef NO_MX_RNN
            m2_rnn_round<4, true>(lds, hl, Pp, proj, Y, red1, cr, b, t0, 0, wid, fr2, fq2);
            if (NM == 5) m2_rnn_round<1, false>(lds, hl, Pp, proj, Y, red1, cr, b, t0, 4, wid, fr2, fq2);
#endif
        }
        TOC(16);
    }
    __syncthreads();
}

#define XB_TMO      128
#define XB_XCNT(j)  (256  + 64 * (j))
#define XB_XSUB(j)  (1280 + 64 * (j))
#define XB_XGEN(j)  (2304 + 64 * (j))
#define XB_TOP      3328
#define XB_TOPGEN   3392
#define XCD_BAR_WORDS 3456
#define XB_SPIN_CAP (1u << 18)

__device__ __forceinline__ unsigned xb_ld(unsigned* p)              { return __hip_atomic_load(p, __ATOMIC_RELAXED, __HIP_MEMORY_SCOPE_AGENT); }
__device__ __forceinline__ unsigned xb_add(unsigned* p, unsigned v) { return __hip_atomic_fetch_add(p, v, __ATOMIC_RELAXED, __HIP_MEMORY_SCOPE_AGENT); }
__device__ __forceinline__ unsigned xb_xcc_id() { return (unsigned)__builtin_amdgcn_s_getreg((3 << 11) | 20) & 0xFu; }
#define XB_SPIN(cond, bar) do { unsigned _sp = 0; while (cond) { __builtin_amdgcn_s_sleep(1); \
    if ((++_sp & 255u) == 0u) { if (xb_ld(&(bar)[XB_TMO])) break; if (_sp > XB_SPIN_CAP) { atomicAdd(&(bar)[XB_TMO], 1u); break; } } } } while (0)

struct XcdBarrier {
    unsigned* bar; unsigned x;
    volatile LAS unsigned* st;
};

__device__ __forceinline__ XcdBarrier xcd_barrier_post(unsigned* bar, volatile LAS unsigned* st) {
    XcdBarrier b; b.bar = bar; b.x = xb_xcc_id(); b.st = st;
    if (threadIdx.x == 0) (void)xb_add(&bar[XB_XCNT(b.x)], 1u);
    return b;
}
__device__ __forceinline__ void xcd_barrier_complete(unsigned* bar, unsigned x, unsigned& nloc, unsigned& nx) {
    const unsigned G = gridDim.x * gridDim.y * gridDim.z;
    unsigned sum, cnt, mine, sp = 0u;
    for (;;) {
        sum = 0u; cnt = 0u; mine = 0u;
#pragma unroll
        for (unsigned j = 0; j < 16; ++j) { const unsigned c = xb_ld(&bar[XB_XCNT(j)]); sum += c; cnt += (c > 0u) ? 1u : 0u; mine = (j == x) ? c : mine; }
        if (sum == G) break;
        __builtin_amdgcn_s_sleep(1);
        if ((++sp & 255u) == 0u) { if (xb_ld(&bar[XB_TMO])) break; if (sp > XB_SPIN_CAP) { atomicAdd(&bar[XB_TMO], 1u); break; } }
    }
    nloc = mine > 0u ? mine : 1u; nx = cnt > 0u ? cnt : 1u;
}

__device__ __forceinline__ void xcd_barrier(const XcdBarrier& b) {
    asm volatile("s_waitcnt vmcnt(0)" ::: "memory");
    __syncthreads();
    if (threadIdx.x == 0) {
        unsigned* bar = b.bar;
        __builtin_amdgcn_s_waitcnt(0);
        unsigned nloc = b.st[0], nx = b.st[1];
        if (nloc == 0u) { xcd_barrier_complete(bar, b.x, nloc, nx); b.st[0] = nloc; b.st[1] = nx; }
        const unsigned old = xb_add(&bar[XB_XSUB(b.x)], 1u);
        const unsigned gen = old / nloc;
        if (old + 1u == (gen + 1u) * nloc) {
            __builtin_amdgcn_fence(__ATOMIC_RELEASE, "agent");
            asm volatile("s_waitcnt vmcnt(0)" ::: "memory");
            const unsigned og = xb_add(&bar[XB_TOP], 1u);
            const unsigned tg = og / nx;
            if (og + 1u == (tg + 1u) * nx) xb_add(&bar[XB_TOPGEN], 1u);
            else XB_SPIN(xb_ld(&bar[XB_TOPGEN]) == tg, bar);
            __builtin_amdgcn_fence(__ATOMIC_ACQUIRE, "agent");
            xb_add(&bar[XB_XGEN(b.x)], 1u);
            asm volatile("s_waitcnt vmcnt(0)" ::: "memory");
        } else {
            XB_SPIN(xb_ld(&bar[XB_XGEN(b.x)]) == gen, bar);
            __builtin_amdgcn_fence(__ATOMIC_ACQUIRE, "agent");
            asm volatile("s_waitcnt vmcnt(0)" ::: "memory");
        }
    }
    __syncthreads();
}

#ifndef PROBE_SYNC2
#define PROBE_SYNC2 0
#endif
#ifndef PROBE_M1X2
#define PROBE_M1X2 0
#endif
#ifndef PROBE_M2X2
#define PROBE_M2X2 0
#endif
#define GSYNC() do { { __attribute__((address_space(1))) unsigned* gb_ = (__attribute__((address_space(1))) unsigned*)xbar.bar; asm volatile("" : "+s"(gb_)); xbar.bar = (unsigned*)gb_; asm volatile("" : "+s"(xbar.x)); } xcd_barrier(xbar); if (PROBE_SYNC2) xcd_barrier(xbar); } while (0)
__device__ __forceinline__ int rstd_cache(LAS unsigned char* lds, const float* ss, const pg8::StaticOrder& S) {
    pg8::Unit u0; int pmc = -1;
    int tid = threadIdx.x; asm volatile("" : "+v"(tid));
    if (S.next(0, u0)) { pmc = u0.pm; if (tid < 256) ((LAS float*)(lds + 131072))[tid] = row_rstd(ss, u0.pm * 256 + tid); }
    asm volatile("s_waitcnt vmcnt(0) lgkmcnt(0)" ::: "memory");
    return pmc;
}
__global__ void __launch_bounds__(512, 2) fwd_megakernel(Params p) {
    extern __shared__ __attribute__((aligned(16))) unsigned char lds_raw[];
    LAS unsigned char* lds = (LAS unsigned char*)lds_raw;
    cg::grid_group grid = cg::this_grid();
    const int G = gridDim.x;
    unsigned long long tic = 0, tacc = 0;
    unsigned char* ws = p.ws;
    volatile LAS unsigned* xst = (volatile LAS unsigned*)(lds + LDS_XST);
    if (threadIdx.x < 2) xst[threadIdx.x] = 0u;
    __syncthreads();
    XcdBarrier xbar = xcd_barrier_post((unsigned*)(ws + WS_CTL), xst);
    bf16* hb = (bf16*)(ws + WS_HB); bf16* proj = (bf16*)(ws + WS_PROJ); bf16* Y = (bf16*)(ws + WS_Y); bf16* mid = (bf16*)(ws + WS_MID); float* ss = (float*)(ws + WS_SS);
    grid.sync();
    TIC();
#ifndef NO_PRO
    prologue(p, lds, G);
#endif
    GSYNC();
    TOC(0);
#pragma unroll 1
    for (int l = 0; l < DEPTH; ++l) {
        { __attribute__((address_space(1))) unsigned char* gws = (__attribute__((address_space(1))) unsigned char*)ws; asm volatile("" : "+s"(gws)); ws = (unsigned char*)gws; }
        const unsigned char* wl = ws + WS_W + (size_t)l * W_LAYER;
        const bf16* in_t = (const bf16*)(wl + W_IN); const bf16* out_t = (const bf16*)(wl + W_OUT); const bf16* up_t = (const bf16*)(wl + W_UP); const bf16* down_t = (const bf16*)(wl + W_DOWN);
        TIC();
#ifndef NO_GIN
        { pg8::Gemm g{hb, in_t, M, DIN, D, 0}; pg8::StaticOrder S; S.init(M, DIN, G, (int)blockIdx.x); const int pmc = rstd_cache(lds, ss, S); EpiIn E{proj, ss, (const LAS float*)(lds + 131072), pmc};
          pg8::gemm_phase<EpiIn, pg8::StaticOrder, true, true>(lds, g, S, E); }
#endif
#ifndef NO_META
        meta_tasks<0>(p, lds, G, nullptr, 0, in_t, D, DIN / 16);
#endif
        if (G == 256 && l + 1 < DEPTH && blockIdx.x >= 128)
            convert_items(p, lds, (l + 1) * TITEMS_PER_LAYER, (l + 2) * TITEMS_PER_LAYER, (int)blockIdx.x - 128, 128 * 8);
        GSYNC();
        TOC(1); TIC();
#ifndef FUSED_MIXER
#define FUSED_MIXER 1
#endif
#if FUSED_MIXER
        mixer_phase(p, lds, G, l, tic, tacc);
        GSYNC();
        TOC(2);
#else
        m1_phase(p, lds, G, l);
        GSYNC();
        TOC(2); TIC();
        m2_phase(p, lds, G, l);
        GSYNC();
#endif
        TOC(3); TIC();
#ifndef NO_GOUT
        { pg8::Gemm g{Y, out_t, M, D, D, NMETA}; pg8::StaticOrder S; S.init(M, D, G, (int)blockIdx.x); EpiRes E{hb, ss};
          pg8::gemm_phase<EpiRes, pg8::StaticOrder, false, true>(lds, g, S, E); }
#endif
#ifndef NO_META
        if (l < DEPTH - 1) meta_tasks<1>(p, lds, G, Y, D, out_t, D, D / 16);
#endif
        GSYNC();
        TOC(4); TIC();
#ifndef NO_GUP
#ifndef STAGGER_UP
#define STAGGER_UP 0
#endif
        if (STAGGER_UP > 0) {
            const unsigned long long w0 = __builtin_amdgcn_s_memrealtime(), dl = (unsigned long long)(((blockIdx.x >> 3) & 3) * STAGGER_UP);
            while (__builtin_amdgcn_s_memrealtime() - w0 < dl) __builtin_amdgcn_s_sleep(4);
        }
        { pg8::Gemm g{hb, up_t, M, FF, D, 0}; pg8::StaticOrder S; S.init(M, FF, G, (int)blockIdx.x); const int pmc = rstd_cache(lds, ss, S); EpiUp E{mid, ss, (const LAS float*)(lds + 131072), pmc};
          pg8::gemm_phase<EpiUp, pg8::StaticOrder, true, true>(lds, g, S, E); }
#endif
#ifndef NO_META
        if (l < DEPTH - 1) meta_tasks<2>(p, lds, G, nullptr, 0, up_t, D, FF / 16);
#endif
        GSYNC();
        TOC(5); TIC();
#ifndef NO_GDN
        { pg8::Gemm g{mid, down_t, M, D, FF, 0}; pg8::StaticOrder S; S.init(M, D, G, (int)blockIdx.x); EpiRes E{hb, ss};
          pg8::gemm_phase<EpiRes, pg8::StaticOrder, false, true>(lds, g, S, E); }
#endif
#ifndef NO_META
        if (l < DEPTH - 1) meta_tasks<1>(p, lds, G, (const bf16*)(ws + WS_MIDMETA), FF, down_t, FF, D / 16);
#endif
        GSYNC();
        TOC(6);
    }
    TIC();
    final_norm(p, G);
    TOC(7);
    if (PROBE_PHASE >= 0 && blockIdx.x == PROBE_BLOCK && threadIdx.x == 0) { const unsigned long long w0 = __builtin_amdgcn_s_memrealtime(); while (__builtin_amdgcn_s_memrealtime() - w0 < 4ull * tacc) __builtin_amdgcn_s_sleep(8); }
}

extern "C" void kernel_launch(void* const* d_in, const int* in_sizes, int n_in, void* d_out, int out_size, void* d_ws, size_t ws_size, hipStream_t stream) {
    static int grid = 0;
    if (grid == 0) {
        if (n_in != 20 || in_sizes[0] != M * D || out_size != M * D || ws_size < WS_END) { fprintf(stderr, "kernel_launch: unexpected shapes (n_in %d, in0 %d, out %d, ws %zu)\n", n_in, n_in > 0 ? in_sizes[0] : -1, out_size, ws_size); grid = -1; return; }
        int dev = 0, cus = 0, per_cu = 0;
        if (hipGetDevice(&dev) != hipSuccess || hipDeviceGetAttribute(&cus, hipDeviceAttributeMultiprocessorCount, dev) != hipSuccess) { grid = -1; return; }
        if (hipFuncSetAttribute((const void*)fwd_megakernel, hipFuncAttributeMaxDynamicSharedMemorySize, LDS_BYTES) != hipSuccess) { fprintf(stderr, "kernel_launch: hipFuncSetAttribute failed\n"); grid = -1; return; }
        if (hipOccupancyMaxActiveBlocksPerMultiprocessor(&per_cu, (const void*)fwd_megakernel, 512, LDS_BYTES) != hipSuccess || per_cu < 1) { fprintf(stderr, "kernel_launch: occupancy query gave %d\n", per_cu); (void)hipGetLastError(); grid = -1; return; }
        grid = cus * 1;
        if (grid < 256) { fprintf(stderr, "kernel_launch: %d CUs; the fused mixer phase needs 256 resident workgroups\n", cus); grid = -1; return; }
    }
    if (grid < 0) return;
    if (hipMemsetAsync((char*)d_ws + WS_CTL, 0, WS_FLAG + 256 * 4, stream) != hipSuccess) { fprintf(stderr, "kernel_launch: memset failed\n"); return; }
    Params p{};
    for (int i = 0; i < 20; ++i) p.in[i] = (const float*)d_in[i];
    p.out = (float*)d_out; p.ws = (unsigned char*)d_ws;
    void* args[] = {&p};
    hipError_t e = hipLaunchCooperativeKernel((const void*)fwd_megakernel, dim3(grid), dim3(512), args, LDS_BYTES, stream);
    if (e != hipSuccess) fprintf(stderr, "cooperative launch failed: %s (grid %d)\n", hipGetErrorString(e), grid);
}
```

```cpp
#include <hip/hip_runtime.h>
#include <hip/hip_cooperative_groups.h>
#include <cstdio>
#include <cstdint>
namespace cg = cooperative_groups;
namespace pg8 {
#define PG8_LAS __attribute__((address_space(3)))
typedef unsigned short bf16_t;
typedef short bf16x8 __attribute__((ext_vector_type(8)));
typedef float f32x4 __attribute__((ext_vector_type(4)));
typedef unsigned u32x4 __attribute__((ext_vector_type(4)));
constexpr int BM = 256, BK = 64, HALF = 128, HTB = HALF * BK * 2  , STAGE_BYTES = 8 * HTB, NXCD = 8, WGM = 8;

__host__ __device__ __forceinline__ int lds_byte(int r, int c) { const int st = (r >> 4) * 2 + (c >> 5), rr = r & 15, cc = c & 31, ob = rr * 64 + cc * 2; return st * 1024 + (ob ^ (((ob >> 9) & 1) << 5)); }
__host__ __device__ __forceinline__ void stage_rc(int b, int& R, int& C) { const int st = b / 1024, sb = b % 1024, swz = sb ^ (((sb >> 9) & 1) << 5); R = (st >> 1) * 16 + swz / 64; C = (st & 1) * 32 + (swz % 64) / 2; }
__host__ __device__ __forceinline__ int perm32(int rho) { const int n = rho >> 4, i = rho & 15; return 8 * (i >> 2) + 4 * n + (i & 3); }

struct Unit { int pm, pn; };
struct Gemm { const bf16_t* A; const bf16_t* Bt; int M, N, K, gap; };

struct StaticOrder {
    int nM, nN, nwg, G, c;
    __host__ __device__ void init(int M, int N, int G_, int c_) { nM = M / BM; nN = N / BM; nwg = nM * nN; G = G_; c = c_; }
    __host__ __device__ bool next(int i, Unit& u) const {
        const long L = (long)i * G + c; if (L >= nwg) return false;
        int wgid = (int)L; { const int q = nwg / NXCD, r = nwg % NXCD, xcd = wgid % NXCD, off = wgid / NXCD; wgid = (xcd < r ? xcd * (q + 1) : r * (q + 1) + (xcd - r) * q) + off; }
        const int nig = WGM * nN, gid = wgid / nig, fm = gid * WGM, gsz = (nM - fm) < WGM ? (nM - fm) : WGM;
        u.pm = fm + ((wgid % nig) % gsz); u.pn = (wgid % nig) / gsz; return true;
    }
    __device__ __forceinline__ void a_ready(const Unit&) const {}
    __device__ __forceinline__ void done(const Unit&) const {}
};
__device__ __forceinline__ unsigned cvt_pk_bf16(float lo, float hi) { unsigned r; asm volatile("v_cvt_pk_bf16_f32 %0, %1, %2" : "=v"(r) : "v"(lo), "v"(hi)); return r; }
template <class Epi, class Sched, bool ALIGN_EPI = false, bool SP2 = false>
__device__ __forceinline__ void gemm_phase(PG8_LAS unsigned char* lds, const Gemm g, const Sched& S, const Epi& E) {
    int tid_ = threadIdx.x; asm volatile("" : "+v"(tid_));
    const int tid = tid_, wid = __builtin_amdgcn_readfirstlane(tid >> 6), lane = tid & 63, wr = wid >> 2, wc = wid & 3, fr = lane & 15, fq = lane >> 4;
    const int K = g.K, nt = K / BK;
    unsigned voffA[2], voffB[2];
#pragma unroll
    for (int i = 0; i < 2; ++i) { int R, C; stage_rc(tid * 16 + i * 8192, R, C); const int Rb = Epi::PERM ? ((R & ~31) + perm32(R & 31)) : R;
        voffA[i] = (unsigned)(R * K + C) * 2u; voffB[i] = (unsigned)(Rb * K + C) * 2u; }
    const size_t kstep = (size_t)(BK * 2);
    const size_t hstep = (size_t)HALF * K * 2;
    const size_t tstep = 2 * hstep;
    const int agap = g.gap;
#define a_off(pm_) ((size_t)((pm_) * BM + agap * (1 + ((pm_) >> 5))) * (size_t)K * 2)
    const unsigned ldsw = (unsigned)wid * 1024u;
    const int aoff = lds_byte(wr * 64 + fr, fq * 8), boff = lds_byte(wc * 32 + fr, fq * 8);
#define PG8_SA(b, h) (((b) * 2 + (h)) * HTB)
#define PG8_SB(b, h) ((4 + (b) * 2 + (h)) * HTB)
#define PG8_STAGE(bufoff, gbase, voff) do { _Pragma("unroll") for (int _i = 0; _i < 2; ++_i) \
        __builtin_amdgcn_global_load_lds((const unsigned*)((const char*)(gbase) + (voff)[_i]), (PG8_LAS unsigned*)(lds + (bufoff) + ldsw + _i * 8192), 16, 0, 0); } while (0)
#define PG8_LDA(dst, b, h) do { _Pragma("unroll") for (int m = 0; m < 4; ++m) _Pragma("unroll") for (int k = 0; k < 2; ++k) dst[m][k] = *(const PG8_LAS bf16x8*)(lds + PG8_SA(b, h) + aoff + m * 2048 + k * 1024); } while (0)
#define PG8_LDB(dst, b, h) do { _Pragma("unroll") for (int n = 0; n < 2; ++n) _Pragma("unroll") for (int k = 0; k < 2; ++k) dst[n][k] = *(const PG8_LAS bf16x8*)(lds + PG8_SB(b, h) + boff + n * 2048 + k * 1024); } while (0)
#define PG8_MMA(ai, bj, At, Bt) do { __builtin_amdgcn_s_setprio(1); _Pragma("unroll") for (int m = 0; m < 4; ++m) _Pragma("unroll") for (int n = 0; n < 2; ++n) _Pragma("unroll") for (int k = 0; k < 2; ++k) \
        acc[ai][bj][m][n] = __builtin_amdgcn_mfma_f32_16x16x32_bf16(Bt[n][k], At[m][k], acc[ai][bj][m][n], 0, 0, 0); __builtin_amdgcn_s_setprio(0); } while (0)
#define PG8_WAIT_V(n) asm volatile("s_waitcnt vmcnt(" #n ")" ::: "memory")
#define PG8_WAIT_L(n) asm volatile("s_waitcnt lgkmcnt(" #n ")" ::: "memory")
#define PG8_BAR __builtin_amdgcn_s_barrier()
#define PG8_SCHED __builtin_amdgcn_sched_barrier(0)
    Unit cur, nxt; int ui = 0;
    if (!S.next(0, cur)) return;
    f32x4 acc[2][2][4][2];
#pragma unroll
    for (int a = 0; a < 2; ++a)
#pragma unroll
        for (int b = 0; b < 2; ++b)
#pragma unroll
            for (int m = 0; m < 4; ++m)
#pragma unroll
                for (int n = 0; n < 2; ++n) acc[a][b][m][n] = (f32x4){0.f, 0.f, 0.f, 0.f};
    if constexpr (Epi::PRELOAD) E.preload(acc, cur, wr, wc, fr, fq);
    bf16x8 At[4][2], B0[2][2], B1[2][2];
    const char* cA = (const char*)g.A + a_off(cur.pm); const char* cB = (const char*)g.Bt + (size_t)cur.pn * tstep;
    S.a_ready(cur);
    if constexpr (SP2) {
        PG8_STAGE(PG8_SB(0, 0), cB, voffB); PG8_STAGE(PG8_SB(0, 1), cB + hstep, voffB); PG8_STAGE(PG8_SA(0, 0), cA, voffA); PG8_STAGE(PG8_SA(0, 1), cA + hstep, voffA);
        if (wr == 1) PG8_BAR;
        PG8_WAIT_V(2); PG8_BAR;
        PG8_STAGE(PG8_SB(1, 0), cB + kstep, voffB); PG8_STAGE(PG8_SA(1, 0), cA + kstep, voffA); PG8_STAGE(PG8_SB(1, 1), cB + hstep + kstep, voffB);
        PG8_WAIT_V(6); PG8_BAR;
    } else {
        PG8_STAGE(PG8_SB(0, 0), cB, voffB); PG8_STAGE(PG8_SA(0, 0), cA, voffA); PG8_STAGE(PG8_SB(0, 1), cB + hstep, voffB); PG8_STAGE(PG8_SA(0, 1), cA + hstep, voffA);
        if (wr == 1) PG8_BAR;
        PG8_WAIT_V(4); PG8_BAR;
        PG8_STAGE(PG8_SB(1, 0), cB + kstep, voffB); PG8_STAGE(PG8_SA(1, 0), cA + kstep, voffA); PG8_STAGE(PG8_SB(1, 1), cB + hstep + kstep, voffB);
        PG8_WAIT_V(6); PG8_BAR;
    }
    for (;;) {
        const bool has_next = S.next(ui + 1, nxt);
        const char* nA = has_next ? (const char*)g.A + a_off(nxt.pm) : cA; const char* nB = has_next ? (const char*)g.Bt + (size_t)nxt.pn * tstep : cB;
        for (int t = 0; t < nt; t += 2) {
            const bool last = (t == nt - 2);
            const char* a1 = cA + (size_t)(t + 1) * kstep;
            const char* a2 = last ? nA : cA + (size_t)(t + 2) * kstep; const char* b2 = last ? nB : cB + (size_t)(t + 2) * kstep;
            const char* a3 = a2 + kstep; const char* b3 = b2 + kstep;
            if (last && has_next) S.a_ready(nxt);
            if constexpr (SP2) {
            PG8_LDB(B0, 0, 0); PG8_LDB(B1, 0, 1); PG8_SCHED; PG8_LDA(At, 0, 0); PG8_STAGE(PG8_SA(1, 1), a1 + hstep, voffA);
            PG8_WAIT_V(8); PG8_WAIT_L(0); PG8_BAR; PG8_MMA(0, 0, At, B0); PG8_MMA(0, 1, At, B1); PG8_BAR; PG8_SCHED;
            PG8_LDA(At, 0, 1); PG8_STAGE(PG8_SB(0, 0), b2, voffB); PG8_STAGE(PG8_SB(0, 1), b2 + hstep, voffB); PG8_STAGE(PG8_SA(0, 0), a2, voffA);
            PG8_WAIT_V(8); PG8_WAIT_L(0); PG8_BAR; PG8_MMA(1, 0, At, B0); PG8_MMA(1, 1, At, B1); PG8_BAR; PG8_SCHED;
            PG8_LDB(B0, 1, 0); PG8_LDB(B1, 1, 1); PG8_SCHED; PG8_LDA(At, 1, 0); PG8_STAGE(PG8_SA(0, 1), a2 + hstep, voffA);
            PG8_WAIT_V(8); PG8_WAIT_L(0); PG8_BAR; PG8_MMA(0, 0, At, B0); PG8_MMA(0, 1, At, B1); PG8_BAR; PG8_SCHED;
            PG8_LDA(At, 1, 1); PG8_STAGE(PG8_SB(1, 0), b3, voffB); PG8_STAGE(PG8_SB(1, 1), b3 + hstep, voffB); PG8_STAGE(PG8_SA(1, 0), a3, voffA);
            PG8_WAIT_V(8); PG8_WAIT_L(0); PG8_BAR; PG8_MMA(1, 0, At, B0); PG8_MMA(1, 1, At, B1); PG8_BAR; PG8_SCHED;
            } else {
            PG8_LDB(B0, 0, 0); PG8_SCHED; PG8_LDA(At, 0, 0); PG8_STAGE(PG8_SA(1, 1), a1 + hstep, voffA);
            PG8_WAIT_L(8); PG8_BAR; PG8_WAIT_L(0); PG8_MMA(0, 0, At, B0); PG8_BAR; PG8_SCHED;
            PG8_LDB(B1, 0, 1); PG8_STAGE(PG8_SB(0, 0), b2, voffB);
            PG8_BAR; PG8_WAIT_L(0); PG8_MMA(0, 1, At, B1); PG8_BAR;
            PG8_LDA(At, 0, 1); PG8_STAGE(PG8_SA(0, 0), a2, voffA);
            PG8_BAR; PG8_WAIT_L(0); PG8_MMA(1, 0, At, B0); PG8_BAR; PG8_SCHED;
            PG8_STAGE(PG8_SB(0, 1), b2 + hstep, voffB);
            PG8_WAIT_V(6); PG8_BAR; PG8_MMA(1, 1, At, B1); PG8_BAR;
            PG8_LDB(B0, 1, 0); PG8_SCHED; PG8_LDA(At, 1, 0); PG8_STAGE(PG8_SA(0, 1), a2 + hstep, voffA);
            PG8_WAIT_L(8); PG8_BAR; PG8_WAIT_L(0); PG8_MMA(0, 0, At, B0); PG8_BAR; PG8_SCHED;
            PG8_LDB(B1, 1, 1); PG8_STAGE(PG8_SB(1, 0), b3, voffB);
            PG8_BAR; PG8_WAIT_L(0); PG8_MMA(0, 1, At, B1); PG8_BAR;
            PG8_LDA(At, 1, 1); PG8_STAGE(PG8_SA(1, 0), a3, voffA);
            PG8_BAR; PG8_WAIT_L(0); PG8_MMA(1, 0, At, B0); PG8_BAR; PG8_SCHED;
            PG8_STAGE(PG8_SB(1, 1), b3 + hstep, voffB);
            PG8_WAIT_V(6); PG8_BAR; PG8_MMA(1, 1, At, B1); PG8_BAR;
            }
        }
        if constexpr (ALIGN_EPI) { if (wr == 0) PG8_BAR; }
        if constexpr (!Epi::AFTER_DRAIN) { E(acc, cur, wr, wc, fr, fq); S.done(cur); }
        if (!has_next) break;
#pragma unroll
        for (int a = 0; a < 2; ++a)
#pragma unroll
            for (int b = 0; b < 2; ++b)
#pragma unroll
                for (int m = 0; m < 4; ++m)
#pragma unroll
                    for (int n = 0; n < 2; ++n) acc[a][b][m][n] = (f32x4){0.f, 0.f, 0.f, 0.f};
        if constexpr (Epi::PRELOAD) { E.preload(acc, nxt, wr, wc, fr, fq); PG8_WAIT_V(0); }
        cur = nxt; cA = nA; cB = nB; ++ui;
        if constexpr (ALIGN_EPI) { if (wr == 1) PG8_BAR; }
    }
    PG8_WAIT_V(0);
    if constexpr (!ALIGN_EPI) { if (wr == 0) PG8_BAR; }
    PG8_BAR;
    if constexpr (Epi::AFTER_DRAIN) { E.fused(acc, cur, wr, wc, fr, fq, lds, wid, lane); S.done(cur); }
#undef PG8_SA
#undef PG8_SB
#undef PG8_STAGE
#undef PG8_LDA
#undef PG8_LDB
#undef PG8_MMA
#undef PG8_WAIT_V
#undef PG8_WAIT_L
#undef PG8_BAR
#undef PG8_SCHED
}
}

#define LAS __attribute__((address_space(3)))
typedef unsigned short bf16;
typedef unsigned u32x4 __attribute__((ext_vector_type(4)));
typedef unsigned u32x2 __attribute__((ext_vector_type(2)));
typedef float f32x4 __attribute__((ext_vector_type(4)));
typedef short bf16x8 __attribute__((ext_vector_type(8)));
constexpr int D = 1024, SEQ = 8192, NB = 2, NMETA = 16, TT = SEQ + NMETA, M = NB * SEQ, DEPTH = 4, DIN = 1536, FF = 4096, DH = 512;
constexpr float EPS = 1e-6f;
constexpr size_t MiB = 1u << 20;
constexpr size_t WS_CTL = 0;
constexpr size_t WS_POOLW = 1 * MiB, WS_GR = WS_POOLW + 512 * 1024, WS_GI = WS_GR + 256 * 1024;
constexpr size_t WS_SP = 2 * MiB, WS_HMETA = WS_SP + 64 * 1024, WS_MIDMETA = WS_HMETA + 64 * 1024;
constexpr size_t WS_SS = 3 * MiB, WS_CARA = 4 * MiB, WS_CARH = WS_CARA + 512 * 1024;
constexpr size_t WS_W = 8 * MiB, W_LAYER = 21 * MiB, W_IN = 0, W_OUT = 3 * MiB, W_UP = 5 * MiB, W_DOWN = 13 * MiB;
constexpr size_t WS_HB = 92 * MiB, WS_MID = 124 * MiB;
constexpr size_t WS_PROJ = WS_MID, WS_Y = WS_MID + 48 * MiB + 256 * 1024, WS_HL = WS_Y + 32 * MiB + 256 * 1024, WS_P = WS_HL + 32 * MiB + 256 * 1024, WS_END = 256 * MiB;
static_assert(WS_PROJ + (size_t)NB * TT * DIN * 2 <= WS_Y && WS_Y + (size_t)NB * TT * D * 2 <= WS_HL && WS_HL + (size_t)NB * TT * DH * 2 <= WS_P && WS_P + (size_t)NB * TT * DH * 2 <= WS_END, "ws map");
static_assert(WS_W + DEPTH * W_LAYER <= WS_HB && WS_HB + (size_t)M * D * 2 <= WS_MID && WS_MID + (size_t)M * FF * 2 <= WS_END, "ws map 2");
constexpr int LDS_HL = 0, LDS_P = 65536, LDS_CST = 131072, LDS_CARR = 147456, LDS_RED1 = 149504, LDS_RED2 = 152064, LDS_CARRY = 154624;
constexpr int LDS_XST = 163840 - 64;
constexpr int LDS_BYTES = 163840;
constexpr size_t WS_FLAG = 64 * 1024;

struct Params {
    const float* in[20];
    float* out;
    unsigned char* ws;
};

__device__ __forceinline__ Params launder(const Params& p) {
    Params q = p;
#pragma unroll
    for (int i = 0; i < 20; ++i) { const __attribute__((address_space(1))) float* g = (const __attribute__((address_space(1))) float*)q.in[i]; asm volatile("" : "+s"(g)); q.in[i] = (const float*)g; }
    { __attribute__((address_space(1))) float* g = (__attribute__((address_space(1))) float*)q.out; asm volatile("" : "+s"(g)); q.out = (float*)g; }
    { __attribute__((address_space(1))) unsigned char* g = (__attribute__((address_space(1))) unsigned char*)q.ws; asm volatile("" : "+s"(g)); q.ws = (unsigned char*)g; }
    return q;
}
__device__ __forceinline__ unsigned cvt_pk(float lo, float hi) { return pg8::cvt_pk_bf16(lo, hi); }
__device__ __forceinline__ float bf_lo(unsigned w) { return __builtin_bit_cast(float, w << 16); }
__device__ __forceinline__ float bf_hi(unsigned w) { return __builtin_bit_cast(float, w & 0xffff0000u); }
__device__ __forceinline__ void unpack8(const u32x4 w, float (&f)[8]) {
    f[0] = bf_lo(w.x); f[1] = bf_hi(w.x); f[2] = bf_lo(w.y); f[3] = bf_hi(w.y); f[4] = bf_lo(w.z); f[5] = bf_hi(w.z); f[6] = bf_lo(w.w); f[7] = bf_hi(w.w);
}
__device__ __forceinline__ u32x4 pack8(const float (&f)[8]) { u32x4 w; w.x = cvt_pk(f[0], f[1]); w.y = cvt_pk(f[2], f[3]); w.z = cvt_pk(f[4], f[5]); w.w = cvt_pk(f[6], f[7]); return w; }
__device__ __forceinline__ float wave_sum(float v) {
#pragma unroll
    for (int o = 1; o < 64; o <<= 1) v += __shfl_xor(v, o);
    return v;
}
template <int CTRL> __device__ __forceinline__ float dppf(float old, float src) {
    return __builtin_bit_cast(float, __builtin_amdgcn_update_dpp(__builtin_bit_cast(int, old), __builtin_bit_cast(int, src), CTRL, 0xf, 0xf, false));
}
template <int DD> __device__ __forceinline__ float shiftd(float cur, float prev) {
    const float t = dppf<0x100 + (16 - DD)>(0.f, prev);
    return dppf<0x110 + DD>(t, cur);
}
__device__ __forceinline__ float sigm(float v) { return __builtin_amdgcn_rcpf(1.0f + __expf(-v)); }
__device__ __forceinline__ int outchan(int n, int rho) { return 32 * (n >> 1) + 8 * (rho >> 2) + 4 * (n & 1) + (rho & 3); }

__device__ __forceinline__ float row_rstd(const float* ss, int r) {
    const f32x4* s4 = (const f32x4*)(ss + (size_t)r * 16);
    const f32x4 a = s4[0], b = s4[1], c = s4[2], d = s4[3];
    const float s = ((a.x + a.y) + (a.z + a.w)) + ((b.x + b.y) + (b.z + b.w)) + ((c.x + c.y) + (c.z + c.w)) + ((d.x + d.y) + (d.z + d.w));
    return 1.0f / sqrtf(s * (1.0f / D) + EPS);
}
__device__ __forceinline__ void rows_rstd(const float* ss, int rowbase  , int fr, float (&rs)[2][4]) {
    const int lane = threadIdx.x & 63;
    const float r0 = row_rstd(ss, rowbase + lane), r1 = row_rstd(ss, rowbase + 128 + lane);
#pragma unroll
    for (int m = 0; m < 4; ++m) { rs[0][m] = __shfl(r0, m * 16 + fr); rs[1][m] = __shfl(r1, m * 16 + fr); }
}
struct EpiIn {
    static constexpr bool PERM = true, AFTER_DRAIN = false, PRELOAD = false;
    bf16* P; const float* ss; const LAS float* rl; int pmc;
    __device__ __forceinline__ void operator()(const f32x4 (&acc)[2][2][4][2], const pg8::Unit& u, int wr, int wc, int fr, int fq) const {
        const int row0 = u.pm * 256 + wr * 64 + fr, col0 = u.pn * 256 + wc * 32 + 8 * fq;
        float rsv[2][4];
        if (u.pm == pmc) {
#pragma unroll
            for (int ai = 0; ai < 2; ++ai)
#pragma unroll
                for (int m = 0; m < 4; ++m) rsv[ai][m] = rl[ai * 128 + wr * 64 + m * 16 + fr];
        } else {
#pragma unroll
            for (int ai = 0; ai < 2; ++ai)
#pragma unroll
                for (int m = 0; m < 4; ++m) { rsv[ai][m] = row_rstd(ss, row0 + ai * 128 + m * 16); asm volatile("" ::: "memory"); }
        }
#pragma unroll
        for (int ai = 0; ai < 2; ++ai)
#pragma unroll
            for (int m = 0; m < 4; ++m) {
                const int r = row0 + ai * 128 + m * 16; const float rs = rsv[ai][m];
                bf16* rowp = P + (size_t)(r + NMETA * (1 + (r >> 13))) * DIN + col0;
#pragma unroll
                for (int bj = 0; bj < 2; ++bj) { const f32x4 v0 = acc[ai][bj][m][0] * rs, v1 = acc[ai][bj][m][1] * rs;
                    u32x4 w; w.x = cvt_pk(v0[0], v0[1]); w.y = cvt_pk(v0[2], v0[3]); w.z = cvt_pk(v1[0], v1[1]); w.w = cvt_pk(v1[2], v1[3]);
                    *(u32x4*)(rowp + bj * 128) = w; }
            }
    }
};
struct EpiUp {
    static constexpr bool PERM = true, AFTER_DRAIN = false, PRELOAD = false;
    bf16* O; const float* ss; const LAS float* rl; int pmc;
    __device__ __forceinline__ void operator()(const f32x4 (&acc)[2][2][4][2], const pg8::Unit& u, int wr, int wc, int fr, int fq) const {
        const int row0 = u.pm * 256 + wr * 64 + fr, col0 = u.pn * 256 + wc * 32 + 8 * fq;
        float rsv[2][4];
        if (u.pm == pmc) {
#pragma unroll
            for (int ai = 0; ai < 2; ++ai)
#pragma unroll
                for (int m = 0; m < 4; ++m) rsv[ai][m] = rl[ai * 128 + wr * 64 + m * 16 + fr];
        } else {
#pragma unroll
            for (int ai = 0; ai < 2; ++ai)
#pragma unroll
                for (int m = 0; m < 4; ++m) { rsv[ai][m] = row_rstd(ss, row0 + ai * 128 + m * 16); asm volatile("" ::: "memory"); }
        }
#pragma unroll
        for (int ai = 0; ai < 2; ++ai)
#pragma unroll
            for (int m = 0; m < 4; ++m) {
                const int r = row0 + ai * 128 + m * 16; const float rs = rsv[ai][m];
                bf16* rowp = O + (size_t)r * FF + col0;
#pragma unroll
                for (int bj = 0; bj < 2; ++bj) { f32x4 v0 = acc[ai][bj][m][0] * rs, v1 = acc[ai][bj][m][1] * rs;
#pragma unroll
                    for (int j = 0; j < 4; ++j) { v0[j] = fmaxf(v0[j], 0.f); v0[j] *= v0[j]; v1[j] = fmaxf(v1[j], 0.f); v1[j] *= v1[j]; }
                    u32x4 w; w.x = cvt_pk(v0[0], v0[1]); w.y = cvt_pk(v0[2], v0[3]); w.z = cvt_pk(v1[0], v1[1]); w.w = cvt_pk(v1[2], v1[3]);
                    *(u32x4*)(rowp + bj * 128) = w; }
            }
    }
};
struct EpiRes {
    static constexpr bool PERM = true, AFTER_DRAIN = false, PRELOAD = true;
    bf16* hb; float* ssn;
    __device__ __forceinline__ void preload(f32x4 (&acc)[2][2][4][2], const pg8::Unit& u, int wr, int wc, int fr, int fq) const {
        const int row0 = u.pm * 256 + wr * 64 + fr, col0 = u.pn * 256 + wc * 32 + 8 * fq;
#pragma unroll
        for (int ai = 0; ai < 2; ++ai)
#pragma unroll
            for (int m = 0; m < 4; ++m) { const size_t off = (size_t)(row0 + ai * 128 + m * 16) * D + col0;
#pragma unroll
                for (int bj = 0; bj < 2; ++bj) { const u32x4 w = *(const u32x4*)(hb + off + bj * 128);
                    acc[ai][bj][m][0] = (f32x4){bf_lo(w.x), bf_hi(w.x), bf_lo(w.y), bf_hi(w.y)}; acc[ai][bj][m][1] = (f32x4){bf_lo(w.z), bf_hi(w.z), bf_lo(w.w), bf_hi(w.w)}; } }
    }
    __device__ __forceinline__ void operator()(const f32x4 (&acc)[2][2][4][2], const pg8::Unit& u, int wr, int wc, int fr, int fq) const {
        const int row0 = u.pm * 256 + wr * 64 + fr, col0 = u.pn * 256 + wc * 32 + 8 * fq;
#pragma unroll
        for (int ai = 0; ai < 2; ++ai)
#pragma unroll
            for (int m = 0; m < 4; ++m) {
                const int r = row0 + ai * 128 + m * 16; const size_t off = (size_t)r * D + col0; float s = 0.f;
#pragma unroll
                for (int bj = 0; bj < 2; ++bj) {
                    const f32x4 o0 = acc[ai][bj][m][0], o1 = acc[ai][bj][m][1];
                    s += (o0[0] * o0[0] + o0[1] * o0[1]) + (o0[2] * o0[2] + o0[3] * o0[3]) + (o1[0] * o1[0] + o1[1] * o1[1]) + (o1[2] * o1[2] + o1[3] * o1[3]);
                    u32x4 w; w.x = cvt_pk(o0[0], o0[1]); w.y = cvt_pk(o0[2], o0[3]); w.z = cvt_pk(o1[0], o1[1]); w.w = cvt_pk(o1[2], o1[3]);
                    *(u32x4*)(hb + off + bj * 128) = w; }
                s += __shfl_xor(s, 16); s += __shfl_xor(s, 32);
                if (fq == 0) ssn[(size_t)r * 16 + u.pn * 4 + wc] = s;
            }
    }
};

struct TItem { const float* W; const float* gk; bf16* WT; int K, N, item; };
__device__ __forceinline__ void titem_load(const TItem& t, int lane, f32x4 (&v)[8], float (&gs)[8]) {
    const int nblk = t.N / 32, kb = t.item / nblk, nb = t.item % nblk, k0 = 64 * kb, n0 = 32 * nb, lr = lane >> 3, lc = (lane & 7) * 4;
#pragma unroll
    for (int i = 0; i < 8; ++i) { v[i] = *(const f32x4*)(t.W + (size_t)(k0 + 8 * i + lr) * t.N + n0 + lc); gs[i] = t.gk ? t.gk[k0 + 8 * i + lr] : 1.0f; }
}
__device__ __forceinline__ void titem_store(const TItem& t, int lane, const f32x4 (&v)[8], const float (&gs)[8], LAS float* scr) {
    const int nblk = t.N / 32, kb = t.item / nblk, nb = t.item % nblk, k0 = 64 * kb, n0 = 32 * nb, lr = lane >> 3, lc = (lane & 7) * 4;
#pragma unroll
    for (int i = 0; i < 8; ++i) { LAS float* d = scr + (8 * i + lr) * 33 + lc; d[0] = v[i].x * gs[i]; d[1] = v[i].y * gs[i]; d[2] = v[i].z * gs[i]; d[3] = v[i].w * gs[i]; }
    asm volatile("s_waitcnt lgkmcnt(0)" ::: "memory");
    const int c = lane & 7;
#pragma unroll
    for (int j = 0; j < 4; ++j) { const int n = (lane >> 3) + 8 * j; const LAS float* s = scr + (8 * c) * 33 + n;
        u32x4 o; o.x = cvt_pk(s[0 * 33], s[1 * 33]); o.y = cvt_pk(s[2 * 33], s[3 * 33]); o.z = cvt_pk(s[4 * 33], s[5 * 33]); o.w = cvt_pk(s[6 * 33], s[7 * 33]);
        *(u32x4*)(t.WT + (size_t)(n0 + n) * t.K + k0 + 8 * c) = o; }
    asm volatile("s_waitcnt lgkmcnt(0)" ::: "memory");
}
__device__ __forceinline__ TItem titem_decode(const Params& p, int it) {
    constexpr int I_IN = 16 * 48, I_OUT = 16 * 32, I_UP = 16 * 128, I_DN = 64 * 32, I_PW = 4 * 8, I_G = 8 * 2, I_L = I_IN + I_OUT + I_UP + I_DN + I_PW + 2 * I_G;
    const int l = it / I_L; int r = it % I_L; unsigned char* ws = p.ws; unsigned char* wl = ws + WS_W + (size_t)l * W_LAYER; TItem t;
    if (r < I_IN) { t = TItem{p.in[3] + (size_t)l * D * DIN, p.in[2] + l * D, (bf16*)(wl + W_IN), D, DIN, r}; return t; } r -= I_IN;
    if (r < I_OUT) { t = TItem{p.in[15] + (size_t)l * D * D, p.in[14] + l * D, (bf16*)(wl + W_OUT), D, D, r}; return t; } r -= I_OUT;
    if (r < I_UP) { t = TItem{p.in[17] + (size_t)l * D * FF, p.in[16] + l * D, (bf16*)(wl + W_UP), D, FF, r}; return t; } r -= I_UP;
    if (r < I_DN) { t = TItem{p.in[18] + (size_t)l * FF * D, nullptr, (bf16*)(wl + W_DOWN), FF, D, r}; return t; } r -= I_DN;
    if (r < I_PW) { const int g = r / 8; t = TItem{p.in[4] + (size_t)(l * 4 + g) * 16384, nullptr, (bf16*)(ws + WS_POOLW) + (size_t)(l * 4 + g) * 16384, 128, 128, r % 8}; return t; } r -= I_PW;
    if (r < I_G) { const int h = r / 2; t = TItem{p.in[9] + (size_t)(l * 8 + h) * 4096, nullptr, (bf16*)(ws + WS_GR) + (size_t)(l * 8 + h) * 4096, 64, 64, r % 2}; return t; } r -= I_G;
    { const int h = r / 2; t = TItem{p.in[11] + (size_t)(l * 8 + h) * 4096, nullptr, (bf16*)(ws + WS_GI) + (size_t)(l * 8 + h) * 4096, 64, 64, r % 2}; }
    return t;
}
constexpr int TITEMS_PER_LAYER = 16 * 48 + 16 * 32 + 16 * 128 + 64 * 32 + 4 * 8 + 2 * 8 * 2;
__device__ __forceinline__ void convert_items(const Params& p_, LAS unsigned char* lds, int it_lo, int it_hi, int wblock, int nworkers) {
    const Params p = launder(p_);
    int tid_ = threadIdx.x; asm volatile("" : "+v"(tid_));
    const int lane = tid_ & 63, wid = __builtin_amdgcn_readfirstlane(tid_ >> 6);
    LAS float* scr = (LAS float*)(lds + wid * 16384);
    const int worker = wblock * 8 + wid;
    if (it_lo + worker < it_hi) {
        TItem cur = titem_decode(p, it_lo + worker); f32x4 v[8]; float gs[8]; titem_load(cur, lane, v, gs);
        for (int it = it_lo + worker; it < it_hi; it += nworkers) {
            const bool more = it + nworkers < it_hi; TItem nxt = cur; f32x4 nv[8]; float ngs[8];
            if (more) { nxt = titem_decode(p, it + nworkers); titem_load(nxt, lane, nv, ngs); }
            titem_store(cur, lane, v, gs, scr);
            if (more) { cur = nxt;
#pragma unroll
                for (int i = 0; i < 8; ++i) { v[i] = nv[i]; gs[i] = ngs[i]; } }
        }
    }
}
__device__ __forceinline__ void prologue(const Params& p_, LAS unsigned char* lds, int G) {
    const Params p = launder(p_);
    int tid_ = threadIdx.x; asm volatile("" : "+v"(tid_));
    const int tid = tid_, lane = tid & 63, wid = __builtin_amdgcn_readfirstlane(tid >> 6);
    const int gw = blockIdx.x * 8 + wid, NGW = G * 8;
    unsigned char* ws = p.ws;
    convert_items(p_, lds, 0, (G == 256 ? 1 : DEPTH) * TITEMS_PER_LAYER, (int)blockIdx.x, NGW);
    const float* x = p.in[0]; bf16* hb = (bf16*)(ws + WS_HB); float* ss = (float*)(ws + WS_SS);
    for (int m2 = gw; m2 < M / 2; m2 += NGW) {
        f32x4 v[2][4]; float s[2] = {0.f, 0.f};
#pragma unroll
        for (int r = 0; r < 2; ++r) { const f32x4* xr = (const f32x4*)(x + (size_t)(2 * m2 + r) * D) + lane;
#pragma unroll
            for (int j = 0; j < 4; ++j) v[r][j] = xr[64 * j]; }
#pragma unroll
        for (int r = 0; r < 2; ++r) {
#pragma unroll
            for (int j = 0; j < 4; ++j) s[r] += (v[r][j].x * v[r][j].x + v[r][j].y * v[r][j].y) + (v[r][j].z * v[r][j].z + v[r][j].w * v[r][j].w);
            s[r] = wave_sum(s[r]);
            u32x2* o8 = (u32x2*)(hb + (size_t)(2 * m2 + r) * D) + lane;
#pragma unroll
            for (int j = 0; j < 4; ++j) { u32x2 w; w.x = cvt_pk(v[r][j].x, v[r][j].y); w.y = cvt_pk(v[r][j].z, v[r][j].w); o8[64 * j] = w; }
            if (lane < 16) ss[(size_t)(2 * m2 + r) * 16 + lane] = lane == 0 ? s[r] : 0.f;
        }
    }
    float* hm = (float*)(ws + WS_HMETA); float* sp = (float*)(ws + WS_SP);
    for (int i = blockIdx.x * 512 + tid; i < NMETA * D; i += G * 512) hm[i] = p.in[1][i];
    for (int i = blockIdx.x * 512 + tid; i < DEPTH * DH; i += G * 512) sp[i] = log1pf(expf(-p.in[13][i]));
}

template <int MODE, int NBATCH = 4> __device__ __forceinline__ void meta_tasks(const Params& p_, LAS unsigned char* lds, int G, const bf16* Ab, int lda, const bf16* Bt, int K, int ntasks) {
    const Params p = launder(p_);
    int tid_ = threadIdx.x; asm volatile("" : "+v"(tid_));
    const int tid = tid_, lane = tid & 63, wid = __builtin_amdgcn_readfirstlane(tid >> 6), fr = lane & 15, fq = lane >> 4;
    float* hm = (float*)(p.ws + WS_HMETA);
    LAS float* red = (LAS float*)lds;
    for (int task = G - 1 - (int)blockIdx.x; task < ntasks; task += G) {
        const int n0 = task * 16, kw = K / 8, k0 = wid * kw;
        f32x4 acc = {0.f, 0.f, 0.f, 0.f}; float ssq = 0.f;
        for (int kb = k0; kb < k0 + kw; kb += 32 * NBATCH) {
            bf16x8 af[NBATCH], bfr[NBATCH]; f32x4 a0[NBATCH], a1[NBATCH];
#pragma unroll
            for (int i = 0; i < NBATCH; ++i) { const int kk = kb + 32 * i;
                if (MODE == 1) af[i] = *(const bf16x8*)(Ab + (size_t)fr * lda + kk + 8 * fq);
                else { a0[i] = *(const f32x4*)(hm + fr * D + kk + 8 * fq); a1[i] = *(const f32x4*)(hm + fr * D + kk + 8 * fq + 4); }
                bfr[i] = *(const bf16x8*)(Bt + (size_t)(n0 + fr) * K + kk + 8 * fq); }
#pragma unroll
            for (int i = 0; i < NBATCH; ++i) {
                if (MODE != 1) { ssq += (a0[i].x * a0[i].x + a0[i].y * a0[i].y) + (a0[i].z * a0[i].z + a0[i].w * a0[i].w) + (a1[i].x * a1[i].x + a1[i].y * a1[i].y) + (a1[i].z * a1[i].z + a1[i].w * a1[i].w);
                    u32x4 w; w.x = cvt_pk(a0[i].x, a0[i].y); w.y = cvt_pk(a0[i].z, a0[i].w); w.z = cvt_pk(a1[i].x, a1[i].y); w.w = cvt_pk(a1[i].z, a1[i].w); af[i] = __builtin_bit_cast(bf16x8, w); }
                acc = __builtin_amdgcn_mfma_f32_16x16x32_bf16(bfr[i], af[i], acc, 0, 0, 0); }
        }
        ssq += __shfl_xor(ssq, 16); ssq += __shfl_xor(ssq, 32);
        LAS float* rp = red + (wid * 64 + lane) * 5;
        rp[0] = acc[0]; rp[1] = acc[1]; rp[2] = acc[2]; rp[3] = acc[3]; rp[4] = ssq;
        __syncthreads();
        if (wid == 0) {
            float a0 = 0.f, a1 = 0.f, a2 = 0.f, a3 = 0.f, sq = 0.f;
#pragma unroll
            for (int w = 0; w < 8; ++w) { const LAS float* q = red + (w * 64 + lane) * 5; a0 += q[0]; a1 += q[1]; a2 += q[2]; a3 += q[3]; sq += q[4]; }
            const int col = n0 + 4 * fq;
            if (MODE == 1) { f32x4* hp = (f32x4*)(hm + fr * D + col); f32x4 h = *hp; h.x += a0; h.y += a1; h.z += a2; h.w += a3; *hp = h; }
            else {
                const float rs = 1.0f / sqrtf(sq * (1.0f / D) + EPS); a0 *= rs; a1 *= rs; a2 *= rs; a3 *= rs;
                if (MODE == 0) { u32x2 w; w.x = cvt_pk(a0, a1); w.y = cvt_pk(a2, a3); bf16* pr = (bf16*)(p.ws + WS_PROJ);
                    *(u32x2*)(pr + (size_t)fr * DIN + col) = w; *(u32x2*)(pr + (size_t)(TT + fr) * DIN + col) = w; }
                else { a0 = fmaxf(a0, 0.f); a1 = fmaxf(a1, 0.f); a2 = fmaxf(a2, 0.f); a3 = fmaxf(a3, 0.f);
                    u32x2 w; w.x = cvt_pk(a0 * a0, a1 * a1); w.y = cvt_pk(a2 * a2, a3 * a3); *(u32x2*)((bf16*)(p.ws + WS_MIDMETA) + (size_t)fr * FF + col) = w; }
            }
        }
        __syncthreads();
    }
}

__device__ __forceinline__ void m1_phase(const Params& p_, LAS unsigned char* lds, int G, int l) {
    const Params p = launder(p_);
    int tid_ = threadIdx.x; asm volatile("" : "+v"(tid_));
    const int tid = tid_, lane = tid & 63, wid = __builtin_amdgcn_readfirstlane(tid >> 6), fr = lane & 15, fq = lane >> 4;
    LAS float* cst = (LAS float*)lds;
    for (int i = tid; i < 8 * DH; i += 512) { const int row = i >> 9, ch = i & 511; float v;
        if (row < 4) v = p.in[7][(l * 4 + row) * DH + ch]; else if (row == 4) v = p.in[8][l * DH + ch]; else if (row == 5) v = p.in[10][l * DH + ch];
        else if (row == 6) v = p.in[12][l * DH + ch]; else v = ((const float*)(p.ws + WS_SP))[l * DH + ch];
        cst[i] = v; }
    const bf16* proj = (const bf16*)(p.ws + WS_PROJ);
    const bf16* Wr = (const bf16*)(p.ws + WS_GR) + (size_t)(l * 8 + wid) * 4096; const bf16* Wi = (const bf16*)(p.ws + WS_GI) + (size_t)(l * 8 + wid) * 4096;
    LAS bf16x8* wl = (LAS bf16x8*)(lds + 16384 + wid * 16384) + lane;
#pragma unroll
    for (int n = 0; n < 4; ++n)
#pragma unroll
        for (int ks = 0; ks < 2; ++ks) {
            wl[((n * 2 + ks) * 2 + 0) * 64] = *(const bf16x8*)(Wr + outchan(n, fr) * 64 + 32 * ks + 8 * fq);
            wl[((n * 2 + ks) * 2 + 1) * 64] = *(const bf16x8*)(Wi + outchan(n, fr) * 64 + 32 * ks + 8 * fq); }
    __syncthreads();
    bf16* hl = (bf16*)(p.ws + WS_HL); bf16* Pp = (bf16*)(p.ws + WS_P);
    float* carA = (float*)(p.ws + WS_CARA); float* carH = (float*)(p.ws + WS_CARH);
    for (int unit = blockIdx.x; unit < 256; unit += G) {
        const int b = unit >> 7, c = unit & 127, t0 = c ? NMETA + 64 * c : 0, NM = c ? 4 : 5;
        float Hc[16], Pc[16];
#pragma unroll
        for (int k = 0; k < 16; ++k) { Hc[k] = 0.f; Pc[k] = 1.f; }
        u32x4 raw[2][4];
#pragma unroll
        for (int ks = 0; ks < 2; ++ks)
#pragma unroll
            for (int d = 0; d < 4; ++d) { const int tt = t0 + fr - 3 + d; raw[ks][d] = (u32x4){0u, 0u, 0u, 0u};
                if (tt >= 0) raw[ks][d] = *(const u32x4*)(proj + ((size_t)b * TT + tt) * DIN + DH + wid * 64 + 32 * ks + 8 * fq); }
#pragma unroll 1
        for (int m = 0; m < NM; ++m) {
            const int t = t0 + 16 * m + fr; const size_t rowg = (size_t)b * TT + t;
            u32x4 nraw[2][4];
#pragma unroll
            for (int ks = 0; ks < 2; ++ks)
#pragma unroll
                for (int d = 0; d < 4; ++d) { nraw[ks][d] = (u32x4){0u, 0u, 0u, 0u};
                    if (m + 1 < NM) nraw[ks][d] = *(const u32x4*)(proj + ((size_t)b * TT + t + 13 + d) * DIN + DH + wid * 64 + 32 * ks + 8 * fq); }
            float xc[2][8]; bf16x8 frag[2];
#pragma unroll
            for (int ks = 0; ks < 2; ++ks) {
                const int chb = wid * 64 + 32 * ks + 8 * fq;
                { const f32x4 c0 = *(const LAS f32x4*)(cst + 4 * DH + chb), c1 = *(const LAS f32x4*)(cst + 4 * DH + chb + 4);
                  xc[ks][0] = c0.x; xc[ks][1] = c0.y; xc[ks][2] = c0.z; xc[ks][3] = c0.w; xc[ks][4] = c1.x; xc[ks][5] = c1.y; xc[ks][6] = c1.z; xc[ks][7] = c1.w; }
#pragma unroll
                for (int d = 0; d < 4; ++d) {
                    float u[8]; unpack8(raw[ks][d], u);
                    const f32x4 w0 = *(const LAS f32x4*)(cst + d * DH + chb), w1 = *(const LAS f32x4*)(cst + d * DH + chb + 4);
                    xc[ks][0] += u[0] * w0.x; xc[ks][1] += u[1] * w0.y; xc[ks][2] += u[2] * w0.z; xc[ks][3] += u[3] * w0.w;
                    xc[ks][4] += u[4] * w1.x; xc[ks][5] += u[5] * w1.y; xc[ks][6] += u[6] * w1.z; xc[ks][7] += u[7] * w1.w;
                    raw[ks][d] = nraw[ks][d];
                }
                frag[ks] = __builtin_bit_cast(bf16x8, pack8(xc[ks]));
            }
            f32x4 ar[4], ai[4];
#pragma unroll
            for (int n = 0; n < 4; ++n) { ar[n] = (f32x4){0.f, 0.f, 0.f, 0.f}; ai[n] = (f32x4){0.f, 0.f, 0.f, 0.f};
#pragma unroll
                for (int ks = 0; ks < 2; ++ks) {
                    const bf16x8 wr_ = wl[((n * 2 + ks) * 2 + 0) * 64], wi_ = wl[((n * 2 + ks) * 2 + 1) * 64];
                    ar[n] = __builtin_amdgcn_mfma_f32_16x16x32_bf16(wr_, frag[ks], ar[n], 0, 0, 0);
                    ai[n] = __builtin_amdgcn_mfma_f32_16x16x32_bf16(wi_, frag[ks], ai[n], 0, 0, 0);
                } }
            float Aa[16], Bb[16];
#pragma unroll
            for (int n = 0; n < 4; ++n) {
                const int cho = wid * 64 + 32 * (n >> 1) + 8 * fq + 4 * (n & 1);
                const f32x4 rb = *(const LAS f32x4*)(cst + 5 * DH + cho), ib = *(const LAS f32x4*)(cst + 6 * DH + cho), spv = *(const LAS f32x4*)(cst + 7 * DH + cho);
#pragma unroll
                for (int jj = 0; jj < 4; ++jj) {
                    const float r = sigm(ar[n][jj] + rb[jj]), ig = sigm(ai[n][jj] + ib[jj]);
                    const float la = -8.0f * r * spv[jj], a = __expf(la), x2 = 2.0f * la;
                    const float m2s = -x2 * (1.0f + x2 * (0.5f + x2 * (0.16666667f + x2 * 0.041666668f))), m2 = (x2 > -0.0625f) ? m2s : 1.0f - a * a;
                    Aa[n * 4 + jj] = a; Bb[n * 4 + jj] = __builtin_amdgcn_sqrtf(m2) * ig * xc[n >> 1][4 * (n & 1) + jj];
                }
            }
#pragma unroll
            for (int k = 0; k < 16; ++k) {
                float A = Aa[k], B = Bb[k], Ap, Bq;
                Ap = dppf<0x111>(1.f, A); Bq = dppf<0x111>(0.f, B); B = fmaf(A, Bq, B); A *= Ap;
                Ap = dppf<0x112>(1.f, A); Bq = dppf<0x112>(0.f, B); B = fmaf(A, Bq, B); A *= Ap;
                Ap = dppf<0x114>(1.f, A); Bq = dppf<0x114>(0.f, B); B = fmaf(A, Bq, B); A *= Ap;
                Ap = dppf<0x118>(1.f, A); Bq = dppf<0x118>(0.f, B); B = fmaf(A, Bq, B); A *= Ap;
                Bb[k] = fmaf(A, Hc[k], B); Aa[k] = A * Pc[k];
            }
#pragma unroll
            for (int ks = 0; ks < 2; ++ks) {
                const size_t o = rowg * DH + wid * 64 + 32 * ks + 8 * fq;
                { u32x4 wh; wh.x = cvt_pk(Bb[8 * ks + 0], Bb[8 * ks + 1]); wh.y = cvt_pk(Bb[8 * ks + 2], Bb[8 * ks + 3]); wh.z = cvt_pk(Bb[8 * ks + 4], Bb[8 * ks + 5]); wh.w = cvt_pk(Bb[8 * ks + 6], Bb[8 * ks + 7]);
                  *(u32x4*)(hl + o) = wh; }
                u32x4 w; w.x = cvt_pk(Aa[8 * ks + 0], Aa[8 * ks + 1]); w.y = cvt_pk(Aa[8 * ks + 2], Aa[8 * ks + 3]); w.z = cvt_pk(Aa[8 * ks + 4], Aa[8 * ks + 5]); w.w = cvt_pk(Aa[8 * ks + 6], Aa[8 * ks + 7]);
                *(u32x4*)(Pp + o) = w;
            }
            const int src = (lane & 48) | 15;
#pragma unroll
            for (int k = 0; k < 16; ++k) { Hc[k] = __shfl(Bb[k], src); Pc[k] = __shfl(Aa[k], src); }
        }
        if (fr == 0) {
#pragma unroll
            for (int ks = 0; ks < 2; ++ks) {
                const size_t o = (size_t)(b * 128 + c) * DH + wid * 64 + 32 * ks + 8 * fq;
                *(f32x4*)(carA + o) = (f32x4){Pc[8 * ks + 0], Pc[8 * ks + 1], Pc[8 * ks + 2], Pc[8 * ks + 3]}; *(f32x4*)(carA + o + 4) = (f32x4){Pc[8 * ks + 4], Pc[8 * ks + 5], Pc[8 * ks + 6], Pc[8 * ks + 7]};
                *(f32x4*)(carH + o) = (f32x4){Hc[8 * ks + 0], Hc[8 * ks + 1], Hc[8 * ks + 2], Hc[8 * ks + 3]}; *(f32x4*)(carH + o + 4) = (f32x4){Hc[8 * ks + 4], Hc[8 * ks + 5], Hc[8 * ks + 6], Hc[8 * ks + 7]};
            }
        }
    }
    __syncthreads();
}


template <int NMR, bool FROM_LDS> __device__ __forceinline__ void m2_rnn_round(LAS unsigned char* lds, const bf16* hl, const bf16* Pp, const bf16* proj, bf16* Y, LAS float* red1, const float (&cr)[16], int b, int t0, int mbase, int wid, int fr, int fq) {
    u32x4 hw[NMR][2], pw[NMR][2], gw[NMR][2];
#pragma unroll
    for (int m = 0; m < NMR; ++m)
#pragma unroll
        for (int ks = 0; ks < 2; ++ks) { const size_t rowg = (size_t)b * TT + t0 + 16 * (mbase + m) + fr; const int ch = wid * 64 + 32 * ks + 8 * fq; const size_t o = rowg * DH + ch;
            if (FROM_LDS) { const int lane = fq * 16 + fr; hw[m][ks] = *(const LAS u32x4*)(lds + LDS_HL + wid * 8192 + (((mbase + m) * 2 + ks) * 64 + lane) * 16); pw[m][ks] = *(const LAS u32x4*)(lds + LDS_P + wid * 8192 + (((mbase + m) * 2 + ks) * 64 + lane) * 16); }
            else { hw[m][ks] = *(const u32x4*)(hl + o); pw[m][ks] = *(const u32x4*)(Pp + o); } gw[m][ks] = *(const u32x4*)(proj + rowg * DIN + 2 * DH + ch); }
    float y[NMR][16];
#pragma unroll
    for (int m = 0; m < NMR; ++m) { float s = 0.f;
#pragma unroll
        for (int ks = 0; ks < 2; ++ks) { float pf[8], gt[8]; unpack8(pw[m][ks], pf); unpack8(gw[m][ks], gt);
            float hh[8]; unpack8(hw[m][ks], hh);
#pragma unroll
            for (int e = 0; e < 8; ++e) { const float hv = fmaf(pf[e], cr[8 * ks + e], hh[e]), x = gt[e];
                const float ge = x * __builtin_amdgcn_rcpf(1.0f + __expf(-1.5957691216f * (x + 0.044715f * x * x * x)));
                const float yy = hv * ge; y[m][8 * ks + e] = yy; s = fmaf(yy, yy, s); } }
        s += __shfl_xor(s, 16); s += __shfl_xor(s, 32);
        if (fq == 0) red1[(16 * (mbase + m) + fr) * 8 + wid] = s; }
    __syncthreads();
#pragma unroll
    for (int m = 0; m < NMR; ++m) { const size_t rowg = (size_t)b * TT + t0 + 16 * (mbase + m) + fr;
        const f32x4 r0 = *(const LAS f32x4*)(red1 + (16 * (mbase + m) + fr) * 8), r1 = *(const LAS f32x4*)(red1 + (16 * (mbase + m) + fr) * 8 + 4);
        const float rs = __builtin_amdgcn_rsqf((((r0.x + r0.y) + (r0.z + r0.w)) + ((r1.x + r1.y) + (r1.z + r1.w))) * (1.0f / DH) + EPS);
#pragma unroll
        for (int ks = 0; ks < 2; ++ks) { float yy[8];
#pragma unroll
            for (int e = 0; e < 8; ++e) yy[e] = y[m][8 * ks + e] * rs;
            *(u32x4*)(Y + rowg * D + DH + wid * 64 + 32 * ks + 8 * fq) = pack8(yy); } }
}


template <int NMR> __device__ __forceinline__ void m2_pool_round(const bf16* proj, bf16* Y, const bf16* Wp, const float* pbias, const float* pscale, LAS float* red2,
                                                                  int b, int t0, int mbase, int g, int half, int kwin, int wid, int fr, int fq) {
    const int tb = t0 + 16 * mbase;
    bf16x8 pfr[NMR][4];
#pragma unroll
    for (int ks = 0; ks < 4; ++ks) {
        const int chb = g * 128 + 32 * ks + 8 * fq;
        float pu[8], p2[8], p4[8], p8[8];
        if (tb) { const u32x4 raw = *(const u32x4*)(proj + ((size_t)b * TT + tb - 16 + fr) * DIN + chb); unpack8(raw, pu);
#pragma unroll
            for (int e = 0; e < 8; ++e) { p2[e] = pu[e] + dppf<0x111>(0.f, pu[e]); p4[e] = p2[e] + dppf<0x112>(0.f, p2[e]); p8[e] = p4[e] + dppf<0x114>(0.f, p4[e]); } }
        else {
#pragma unroll
            for (int e = 0; e < 8; ++e) { pu[e] = 0.f; p2[e] = 0.f; p4[e] = 0.f; p8[e] = 0.f; } }
#pragma unroll
        for (int m = 0; m < NMR; ++m) {
            const int t = tb + 16 * m + fr; const size_t rowg = (size_t)b * TT + t;
            const u32x4 raw = *(const u32x4*)(proj + rowg * DIN + chb); float u[8], po[8]; unpack8(raw, u);
            const int cnt = (t + 1 < kwin) ? t + 1 : kwin; const float rc = __builtin_amdgcn_rcpf((float)cnt);
#pragma unroll
            for (int e = 0; e < 8; ++e) {
                const float s2 = u[e] + shiftd<1>(u[e], pu[e]), s4 = s2 + shiftd<2>(s2, p2[e]), s8 = s4 + shiftd<4>(s4, p4[e]), s16 = s8 + shiftd<8>(s8, p8[e]);
                const float win = g == 0 ? s2 : (g == 1 ? s4 : (g == 2 ? s8 : s16));
                po[e] = fmaf(win, rc, -u[e]); pu[e] = u[e]; p2[e] = s2; p4[e] = s4; p8[e] = s8;
            }
            pfr[m][ks] = __builtin_bit_cast(bf16x8, pack8(po));
        }
    }
    bf16x8 wfr[4][4];
#pragma unroll
    for (int n = 0; n < 4; ++n)
#pragma unroll
        for (int ks = 0; ks < 4; ++ks) wfr[n][ks] = *(const bf16x8*)(Wp + (size_t)(64 * half + outchan(n, fr)) * 128 + 32 * ks + 8 * fq);
#pragma unroll 1
    for (int pass = 0; pass < 2; ++pass) {
#pragma unroll
        for (int m = 0; m < NMR; ++m) {
            const int t = tb + 16 * m + fr; const size_t rowg = (size_t)b * TT + t; float s = 0.f, rs = 0.f;
            if (pass) { const f32x4 r0 = *(const LAS f32x4*)(red2 + (16 * (mbase + m) + fr) * 8), r1 = *(const LAS f32x4*)(red2 + (16 * (mbase + m) + fr) * 8 + 4);
                rs = __builtin_amdgcn_rsqf((((r0.x + r0.y) + (r0.z + r0.w)) + ((r1.x + r1.y) + (r1.z + r1.w))) * (1.0f / DH) + EPS); }
#pragma unroll
            for (int np = 0; np < 2; ++np) {
                f32x4 o2[2];
#pragma unroll
                for (int nn = 0; nn < 2; ++nn) { const int n = 2 * np + nn;
                    f32x4 acc = {0.f, 0.f, 0.f, 0.f};
#pragma unroll
                    for (int ks = 0; ks < 4; ++ks) acc = __builtin_amdgcn_mfma_f32_16x16x32_bf16(wfr[n][ks], pfr[m][ks], acc, 0, 0, 0);
                    const int col = g * 128 + 64 * half + 32 * np + 8 * fq + 4 * nn;
                    const f32x4 pb = *(const f32x4*)(pbias + col), ps = *(const f32x4*)(pscale + col);
                    acc = (acc + pb) * ps; s += (acc.x * acc.x + acc.y * acc.y) + (acc.z * acc.z + acc.w * acc.w); o2[nn] = acc * rs; }
                if (pass) { u32x4 w; w.x = cvt_pk(o2[0].x, o2[0].y); w.y = cvt_pk(o2[0].z, o2[0].w); w.z = cvt_pk(o2[1].x, o2[1].y); w.w = cvt_pk(o2[1].z, o2[1].w);
                    *(u32x4*)(Y + rowg * D + g * 128 + 64 * half + 32 * np + 8 * fq) = w; }
            }
            if (!pass) { s += __shfl_xor(s, 16); s += __shfl_xor(s, 32); if (fq == 0) red2[(16 * (mbase + m) + fr) * 8 + wid] = s; }
        }
        if (!pass) __syncthreads();
    }
}

__device__ __forceinline__ void m2_phase(const Params& p_, LAS unsigned char* lds, int G, int l) {
    const Params p = launder(p_);
    int tid_ = threadIdx.x; asm volatile("" : "+v"(tid_));
    const int tid = tid_, lane = tid & 63, wid = __builtin_amdgcn_readfirstlane(tid >> 6), fr = lane & 15, fq = lane >> 4;
    LAS float* segA = (LAS float*)lds; LAS float* segH = (LAS float*)(lds + 16384); LAS float* carr = (LAS float*)(lds + 32768);
    LAS float* red1 = (LAS float*)(lds + 34816); LAS float* red2 = (LAS float*)(lds + 37888);
    const bf16* proj = (const bf16*)(p.ws + WS_PROJ); bf16* Y = (bf16*)(p.ws + WS_Y);
    const bf16* hl = (const bf16*)(p.ws + WS_HL); const bf16* Pp = (const bf16*)(p.ws + WS_P);
    const float* carA = (const float*)(p.ws + WS_CARA); const float* carH = (const float*)(p.ws + WS_CARH);
    const int g = wid >> 1, half = wid & 1, kwin = 2 << g;
    const bf16* Wp = (const bf16*)(p.ws + WS_POOLW) + (size_t)(l * 4 + g) * 16384;
    const float* pbias = p.in[5] + l * DH; const float* pscale = p.in[6] + l * DH;
    for (int unit = blockIdx.x; unit < 256; unit += G) {
        const int b = unit >> 7, c = unit & 127, t0 = c ? NMETA + 64 * c : 0, NM = c ? 4 : 5;
        {
            const int q = (c + 7) >> 3, jlo = wid * q, jhi = (jlo + q < c) ? jlo + q : c;
            f32x4 A0 = {1.f, 1.f, 1.f, 1.f}, A1 = A0, H0 = {0.f, 0.f, 0.f, 0.f}, H1 = H0;
            for (int j = jlo; j < jhi; j += 8) {
                f32x4 a0[8], a1[8], h0[8], h1[8];
#pragma unroll
                for (int i = 0; i < 8; ++i) { const int jj = (j + i < jhi) ? j + i : jhi - 1; const size_t o = (size_t)(b * 128 + jj) * DH + 8 * lane;
                    a0[i] = *(const f32x4*)(carA + o); a1[i] = *(const f32x4*)(carA + o + 4); h0[i] = *(const f32x4*)(carH + o); h1[i] = *(const f32x4*)(carH + o + 4); }
#pragma unroll
                for (int i = 0; i < 8; ++i) if (j + i < jhi) { H0 = a0[i] * H0 + h0[i]; A0 = A0 * a0[i]; H1 = a1[i] * H1 + h1[i]; A1 = A1 * a1[i]; }
            }
            *(LAS f32x4*)(segA + wid * DH + 8 * lane) = A0; *(LAS f32x4*)(segA + wid * DH + 8 * lane + 4) = A1;
            *(LAS f32x4*)(segH + wid * DH + 8 * lane) = H0; *(LAS f32x4*)(segH + wid * DH + 8 * lane + 4) = H1;
        }
        __syncthreads();
        { float cy = 0.f;
#pragma unroll
          for (int s8 = 0; s8 < 8; ++s8) cy = segA[s8 * DH + tid] * cy + segH[s8 * DH + tid];
          carr[tid] = cy; }
        __syncthreads();
        {
            float cr[16];
#pragma unroll
            for (int ks = 0; ks < 2; ++ks) { const f32x4 c0 = *(const LAS f32x4*)(carr + wid * 64 + 32 * ks + 8 * fq), c1 = *(const LAS f32x4*)(carr + wid * 64 + 32 * ks + 8 * fq + 4);
                cr[8 * ks + 0] = c0.x; cr[8 * ks + 1] = c0.y; cr[8 * ks + 2] = c0.z; cr[8 * ks + 3] = c0.w; cr[8 * ks + 4] = c1.x; cr[8 * ks + 5] = c1.y; cr[8 * ks + 6] = c1.z; cr[8 * ks + 7] = c1.w; }
            m2_rnn_round<4, false>(lds, hl, Pp, proj, Y, red1, cr, b, t0, 0, wid, fr, fq);
            if (NM == 5) m2_rnn_round<1, false>(lds, hl, Pp, proj, Y, red1, cr, b, t0, 4, wid, fr, fq);
        }
        m2_pool_round<4>(proj, Y, Wp, pbias, pscale, red2, b, t0, 0, g, half, kwin, wid, fr, fq);
        if (NM == 5) m2_pool_round<1>(proj, Y, Wp, pbias, pscale, red2, b, t0, 4, g, half, kwin, wid, fr, fq);
    }
    __syncthreads();
}

__device__ __forceinline__ void final_norm(const Params& p_, int G) {
    const Params p = launder(p_);
    int tid_ = threadIdx.x; asm volatile("" : "+v"(tid_));
    const int tid = tid_, lane = tid & 63, wid = tid >> 6; const int gw = blockIdx.x * 8 + wid, NGW = G * 8;
    const bf16* hb = (const bf16*)(p.ws + WS_HB);
    const f32x4* gp = (const f32x4*)p.in[19] + 2 * lane; f32x4 gg[2][2];
#pragma unroll
    for (int j = 0; j < 2; ++j) { gg[j][0] = gp[128 * j]; gg[j][1] = gp[128 * j + 1]; }
    for (int m = gw; m < M; m += NGW) {
        const u32x4* xr = (const u32x4*)(hb + (size_t)m * D) + lane; float v[2][8]; float s = 0.f;
#pragma unroll
        for (int j = 0; j < 2; ++j) { unpack8(xr[64 * j], v[j]);
#pragma unroll
            for (int e = 0; e < 8; ++e) s = fmaf(v[j][e], v[j][e], s); }
        const float rs = 1.0f / sqrtf(wave_sum(s) * (1.0f / D) + EPS);
        f32x4* orow = (f32x4*)(p.out + (size_t)m * D) + 2 * lane;
#pragma unroll
        for (int j = 0; j < 2; ++j) {
            orow[128 * j] = (f32x4){v[j][0] * rs * gg[j][0].x, v[j][1] * rs * gg[j][0].y, v[j][2] * rs * gg[j][0].z, v[j][3] * rs * gg[j][0].w};
            orow[128 * j + 1] = (f32x4){v[j][4] * rs * gg[j][1].x, v[j][5] * rs * gg[j][1].y, v[j][6] * rs * gg[j][1].z, v[j][7] * rs * gg[j][1].w}; }
    }
}


template <int KW> __device__ __forceinline__ float pool_win(float P, float Sp) {
    float w = P;
    if (KW < 16) w -= dppf<0x110 + (KW & 15)>(0.f, P);
    return w + dppf<0x100 + (17 - KW)>(0.f, Sp);
}
template <int KW, int MAXG> __device__ __forceinline__ void pool_frags(const bf16* proj, bf16x8 (&pfr)[MAXG][4], int b, int tb, int cnt, int g, int fr, int fq) {
#pragma unroll
    for (int ks = 0; ks < 4; ++ks) {
        const int chb = g * 128 + 32 * ks + 8 * fq;
        float Sp[8];
        if (tb) { const u32x4 raw = *(const u32x4*)(proj + ((size_t)b * TT + tb - 16 + fr) * DIN + chb); unpack8(raw, Sp);
#pragma unroll
            for (int e = 0; e < 8; ++e) { Sp[e] += dppf<0x101>(0.f, Sp[e]); Sp[e] += dppf<0x102>(0.f, Sp[e]); Sp[e] += dppf<0x104>(0.f, Sp[e]); Sp[e] += dppf<0x108>(0.f, Sp[e]); } }
        else {
#pragma unroll
            for (int e = 0; e < 8; ++e) Sp[e] = 0.f; }
#pragma unroll
        for (int mi = 0; mi < MAXG; ++mi) if (mi < cnt) {
            const int t = tb + 16 * mi + fr;
            const u32x4 raw = *(const u32x4*)(proj + ((size_t)b * TT + t) * DIN + chb); float u[8], po[8]; unpack8(raw, u);
            const int cn = (t + 1 < KW) ? t + 1 : KW; const float rc = __builtin_amdgcn_rcpf((float)cn);
#pragma unroll
            for (int e = 0; e < 8; ++e) {
                float P = u[e]; P += dppf<0x111>(0.f, P); P += dppf<0x112>(0.f, P); P += dppf<0x114>(0.f, P); P += dppf<0x118>(0.f, P);
                float S = u[e]; S += dppf<0x101>(0.f, S); S += dppf<0x102>(0.f, S); S += dppf<0x104>(0.f, S); S += dppf<0x108>(0.f, S);
                po[e] = fmaf(pool_win<KW>(P, Sp[e]), rc, -u[e]); Sp[e] = S;
            }
            pfr[mi][ks] = __builtin_bit_cast(bf16x8, pack8(po));
        }
    }
}
__device__ __forceinline__ void m2_pool2(const bf16* proj, bf16* Y, const bf16* Wp, const float* pbias, const float* pscale, LAS float* red2, int b, int t0, int NM, int g, int th, int fr, int fq) {
    const int m0 = th ? (NM == 5 ? 3 : 2) : 0, cnt = th ? 2 : (NM == 5 ? 3 : 2), tb = t0 + 16 * m0;
    bf16x8 pfr[3][4];
    switch (g) {
        case 0: pool_frags<2, 3>(proj, pfr, b, tb, cnt, g, fr, fq); break;
        case 1: pool_frags<4, 3>(proj, pfr, b, tb, cnt, g, fr, fq); break;
        case 2: pool_frags<8, 3>(proj, pfr, b, tb, cnt, g, fr, fq); break;
        default: pool_frags<16, 3>(proj, pfr, b, tb, cnt, g, fr, fq); break;
    }
    f32x4 ov[3][8]; float sq[3] = {0.f, 0.f, 0.f};
#pragma unroll
    for (int n = 0; n < 8; ++n) {
        bf16x8 wf[4];
#pragma unroll
        for (int ks = 0; ks < 4; ++ks) wf[ks] = *(const bf16x8*)(Wp + (size_t)outchan(n, fr) * 128 + 32 * ks + 8 * fq);
        const int col = g * 128 + 32 * (n >> 1) + 8 * fq + 4 * (n & 1);
        const f32x4 pb = *(const f32x4*)(pbias + col), ps = *(const f32x4*)(pscale + col);
#pragma unroll
        for (int mi = 0; mi < 3; ++mi) if (mi < cnt) {
            f32x4 acc = {0.f, 0.f, 0.f, 0.f};
#pragma unroll
            for (int ks = 0; ks < 4; ++ks) acc = __builtin_amdgcn_mfma_f32_16x16x32_bf16(wf[ks], pfr[mi][ks], acc, 0, 0, 0);
            acc = (acc + pb) * ps; ov[mi][n] = acc; sq[mi] += (acc.x * acc.x + acc.y * acc.y) + (acc.z * acc.z + acc.w * acc.w);
        }
    }
#pragma unroll
    for (int mi = 0; mi < 3; ++mi) if (mi < cnt) { float s = sq[mi]; s += __shfl_xor(s, 16); s += __shfl_xor(s, 32); if (fq == 0) red2[(16 * (m0 + mi) + fr) * 4 + g] = s; }
    __syncthreads();
#pragma unroll
    for (int mi = 0; mi < 3; ++mi) if (mi < cnt) {
        const size_t rowg = (size_t)b * TT + tb + 16 * mi + fr;
        const f32x4 r0 = *(const LAS f32x4*)(red2 + (16 * (m0 + mi) + fr) * 4);
        const float rs = __builtin_amdgcn_rsqf(((r0.x + r0.y) + (r0.z + r0.w)) * (1.0f / DH) + EPS);
#pragma unroll
        for (int np = 0; np < 4; ++np) {
            const f32x4 a = ov[mi][2 * np] * rs, bq = ov[mi][2 * np + 1] * rs;
            u32x4 w; w.x = cvt_pk(a.x, a.y); w.y = cvt_pk(a.z, a.w); w.z = cvt_pk(bq.x, bq.y); w.w = cvt_pk(bq.z, bq.w);
            *(u32x4*)(Y + rowg * D + g * 128 + 32 * np + 8 * fq) = w;
        }
    }
}

#ifndef PROBE_PHASE
#define PROBE_PHASE (-1)
#endif
#ifndef PROBE_BLOCK
#define PROBE_BLOCK 0
#endif
#define TIC() do { if (PROBE_PHASE >= 0) tic = __builtin_amdgcn_s_memrealtime(); } while (0)
#define TOC(k) do { if (PROBE_PHASE == (k)) tacc += __builtin_amdgcn_s_memrealtime() - tic; } while (0)

__device__ __forceinline__ void mixer_phase(const Params& p_, LAS unsigned char* lds, int G, int l, unsigned long long& tic, unsigned long long& tacc) {
    const Params p = launder(p_);
    int tid_ = threadIdx.x; asm volatile("" : "+v"(tid_));
    const int tid = tid_, lane = tid & 63, wid = __builtin_amdgcn_readfirstlane(tid >> 6), fr = lane & 15, fq = lane >> 4;
    LAS float* cst = (LAS float*)(lds + LDS_CST);
    const bf16* proj = (const bf16*)(p.ws + WS_PROJ);
    const bf16* Wr = (const bf16*)(p.ws + WS_GR) + (size_t)(l * 8 + wid) * 4096; const bf16* Wi = (const bf16*)(p.ws + WS_GI) + (size_t)(l * 8 + wid) * 4096;
    LAS float* segA = (LAS float*)(lds + LDS_CST); LAS float* segH = (LAS float*)(lds + LDS_CST + 8192); LAS float* carr = (LAS float*)(lds + LDS_CARR);
    LAS float* red1 = (LAS float*)(lds + LDS_RED1); LAS float* red2 = (LAS float*)(lds + LDS_RED2);
    bf16* Y = (bf16*)(p.ws + WS_Y);
    const int g = wid >> 1, half = wid & 1, kwin = 2 << g;
    const bf16* Wp = (const bf16*)(p.ws + WS_POOLW) + (size_t)(l * 4 + g) * 16384;
    const float* pbias = p.in[5] + l * DH; const float* pscale = p.in[6] + l * DH;
    unsigned* flags = (unsigned*)(p.ws + WS_FLAG); unsigned* car = (unsigned*)(p.ws + WS_CARA);
    bf16* hl = (bf16*)(p.ws + WS_HL); bf16* Pp = (bf16*)(p.ws + WS_P);
    float* carA = (float*)(p.ws + WS_CARA); float* carH = (float*)(p.ws + WS_CARH);
    const int unit = blockIdx.x;
    if (unit < 256) {
        const int b = unit >> 7, c = unit & 127, t0 = c ? NMETA + 64 * c : 0, NM = c ? 4 : 5;
        TIC();
        float cv[8];
#pragma unroll
        for (int k4 = 0; k4 < 4; ++k4) cv[k4] = p.in[7][(l * 4 + k4) * DH + tid];
        cv[4] = p.in[8][l * DH + tid]; cv[5] = p.in[10][l * DH + tid]; cv[6] = p.in[12][l * DH + tid]; cv[7] = ((const float*)(p.ws + WS_SP))[l * DH + tid];
        bf16x8 wfr[4][2][2];
#pragma unroll
        for (int n = 0; n < 4; ++n)
#pragma unroll
            for (int ks = 0; ks < 2; ++ks) { wfr[n][ks][0] = *(const bf16x8*)(Wr + outchan(n, fr) * 64 + 32 * ks + 8 * fq); wfr[n][ks][1] = *(const bf16x8*)(Wi + outchan(n, fr) * 64 + 32 * ks + 8 * fq); }
        LAS float* cslot = (LAS float*)(lds + LDS_CARRY) + (wid * 4 + fq) * 32;
        if (fr == 15) {
#pragma unroll
            for (int k4 = 0; k4 < 4; ++k4) { *(LAS f32x4*)(cslot + 4 * k4) = (f32x4){0.f, 0.f, 0.f, 0.f}; *(LAS f32x4*)(cslot + 16 + 4 * k4) = (f32x4){1.f, 1.f, 1.f, 1.f}; } }
        u32x4 raw[2][4];
#pragma unroll
        for (int ks = 0; ks < 2; ++ks)
#pragma unroll
            for (int d = 0; d < 4; ++d) { const int tt = t0 + fr - 3 + d; raw[ks][d] = (u32x4){0u, 0u, 0u, 0u};
                if (tt >= 0) raw[ks][d] = *(const u32x4*)(proj + ((size_t)b * TT + tt) * DIN + DH + wid * 64 + 32 * ks + 8 * fq); }
        __syncthreads();
#pragma unroll
        for (int k8 = 0; k8 < 8; ++k8) cst[k8 * DH + tid] = cv[k8];
        __syncthreads();
        TOC(10); TIC();
#pragma unroll 1
        for (int m = 0; m < NM; ++m) {
            const int t = t0 + 16 * m + fr; const size_t rowg = (size_t)b * TT + t;
            u32x4 nraw[2][4];
#pragma unroll
            for (int ks = 0; ks < 2; ++ks)
#pragma unroll
                for (int d = 0; d < 4; ++d) { nraw[ks][d] = (u32x4){0u, 0u, 0u, 0u};
                    if (m + 1 < NM) nraw[ks][d] = *(const u32x4*)(proj + ((size_t)b * TT + t + 13 + d) * DIN + DH + wid * 64 + 32 * ks + 8 * fq); }
            float xc[2][8]; bf16x8 frag[2];
#pragma unroll
            for (int ks = 0; ks < 2; ++ks) {
                const int chb = wid * 64 + 32 * ks + 8 * fq;
                { const f32x4 c0 = *(const LAS f32x4*)(cst + 4 * DH + chb), c1 = *(const LAS f32x4*)(cst + 4 * DH + chb + 4);
                  xc[ks][0] = c0.x; xc[ks][1] = c0.y; xc[ks][2] = c0.z; xc[ks][3] = c0.w; xc[ks][4] = c1.x; xc[ks][5] = c1.y; xc[ks][6] = c1.z; xc[ks][7] = c1.w; }
#pragma unroll
                for (int d = 0; d < 4; ++d) {
                    float u[8]; unpack8(raw[ks][d], u);
                    const f32x4 w0 = *(const LAS f32x4*)(cst + d * DH + chb), w1 = *(const LAS f32x4*)(cst + d * DH + chb + 4);
                    xc[ks][0] += u[0] * w0.x; xc[ks][1] += u[1] * w0.y; xc[ks][2] += u[2] * w0.z; xc[ks][3] += u[3] * w0.w;
                    xc[ks][4] += u[4] * w1.x; xc[ks][5] += u[5] * w1.y; xc[ks][6] += u[6] * w1.z; xc[ks][7] += u[7] * w1.w;
                    raw[ks][d] = nraw[ks][d];
                }
                frag[ks] = __builtin_bit_cast(bf16x8, pack8(xc[ks]));
            }
            f32x4 ar[4], ai[4];
#pragma unroll
            for (int n = 0; n < 4; ++n) { ar[n] = (f32x4){0.f, 0.f, 0.f, 0.f}; ai[n] = (f32x4){0.f, 0.f, 0.f, 0.f};
#pragma unroll
                for (int ks = 0; ks < 2; ++ks) {
                    const bf16x8 wr_ = wfr[n][ks][0], wi_ = wfr[n][ks][1];
                    ar[n] = __builtin_amdgcn_mfma_f32_16x16x32_bf16(wr_, frag[ks], ar[n], 0, 0, 0);
                    ai[n] = __builtin_amdgcn_mfma_f32_16x16x32_bf16(wi_, frag[ks], ai[n], 0, 0, 0);
                } }
            float Aa[16], Bb[16];
#pragma unroll
            for (int n = 0; n < 4; ++n) {
                const int cho = wid * 64 + 32 * (n >> 1) + 8 * fq + 4 * (n & 1);
                const f32x4 rb = *(const LAS f32x4*)(cst + 5 * DH + cho), ib = *(const LAS f32x4*)(cst + 6 * DH + cho), spv = *(const LAS f32x4*)(cst + 7 * DH + cho);
#pragma unroll
                for (int jj = 0; jj < 4; ++jj) {
                    const float r = sigm(ar[n][jj] + rb[jj]), ig = sigm(ai[n][jj] + ib[jj]);
                    const float la = -8.0f * r * spv[jj], a = __expf(la), x2 = 2.0f * la;
                    const float m2s = -x2 * (1.0f + x2 * (0.5f + x2 * (0.16666667f + x2 * 0.041666668f))), m2 = (x2 > -0.0625f) ? m2s : 1.0f - a * a;
                    Aa[n * 4 + jj] = a; Bb[n * 4 + jj] = __builtin_amdgcn_sqrtf(m2) * ig * xc[n >> 1][4 * (n & 1) + jj];
                }
            }
#pragma unroll
            for (int k = 0; k < 16; ++k) {
                float A = Aa[k], B = Bb[k], Ap, Bq;
                Ap = dppf<0x111>(1.f, A); Bq = dppf<0x111>(0.f, B); B = fmaf(A, Bq, B); A *= Ap;
                Ap = dppf<0x112>(1.f, A); Bq = dppf<0x112>(0.f, B); B = fmaf(A, Bq, B); A *= Ap;
                Ap = dppf<0x114>(1.f, A); Bq = dppf<0x114>(0.f, B); B = fmaf(A, Bq, B); A *= Ap;
                Ap = dppf<0x118>(1.f, A); Bq = dppf<0x118>(0.f, B); B = fmaf(A, Bq, B); A *= Ap;
                Bb[k] = B; Aa[k] = A;
            }
            {
                float Hc[16], Pc[16];
#pragma unroll
                for (int k4 = 0; k4 < 4; ++k4) { const f32x4 hq = *(const LAS f32x4*)(cslot + 4 * k4), pq = *(const LAS f32x4*)(cslot + 16 + 4 * k4);
                    Hc[4 * k4] = hq.x; Hc[4 * k4 + 1] = hq.y; Hc[4 * k4 + 2] = hq.z; Hc[4 * k4 + 3] = hq.w; Pc[4 * k4] = pq.x; Pc[4 * k4 + 1] = pq.y; Pc[4 * k4 + 2] = pq.z; Pc[4 * k4 + 3] = pq.w; }
#pragma unroll
                for (int k = 0; k < 16; ++k) { Bb[k] = fmaf(Aa[k], Hc[k], Bb[k]); Aa[k] *= Pc[k]; }
                if (fr == 15) {
#pragma unroll
                    for (int k4 = 0; k4 < 4; ++k4) { *(LAS f32x4*)(cslot + 4 * k4) = (f32x4){Bb[4 * k4], Bb[4 * k4 + 1], Bb[4 * k4 + 2], Bb[4 * k4 + 3]}; *(LAS f32x4*)(cslot + 16 + 4 * k4) = (f32x4){Aa[4 * k4], Aa[4 * k4 + 1], Aa[4 * k4 + 2], Aa[4 * k4 + 3]}; } }
            }
#pragma unroll
            for (int ks = 0; ks < 2; ++ks) {
                const size_t o = rowg * DH + wid * 64 + 32 * ks + 8 * fq;
                u32x4 wh; wh.x = cvt_pk(Bb[8 * ks + 0], Bb[8 * ks + 1]); wh.y = cvt_pk(Bb[8 * ks + 2], Bb[8 * ks + 3]); wh.z = cvt_pk(Bb[8 * ks + 4], Bb[8 * ks + 5]); wh.w = cvt_pk(Bb[8 * ks + 6], Bb[8 * ks + 7]);
                u32x4 w; w.x = cvt_pk(Aa[8 * ks + 0], Aa[8 * ks + 1]); w.y = cvt_pk(Aa[8 * ks + 2], Aa[8 * ks + 3]); w.z = cvt_pk(Aa[8 * ks + 4], Aa[8 * ks + 5]); w.w = cvt_pk(Aa[8 * ks + 6], Aa[8 * ks + 7]);
                if (m < 4) { *(LAS u32x4*)(lds + LDS_HL + wid * 8192 + ((m * 2 + ks) * 64 + lane) * 16) = wh; *(LAS u32x4*)(lds + LDS_P + wid * 8192 + ((m * 2 + ks) * 64 + lane) * 16) = w; }
                else { *(u32x4*)(hl + o) = wh; *(u32x4*)(Pp + o) = w; }
            }
        }
        TOC(11); TIC();
        if (fr == 0) {
            float Hc[16], Pc[16];
#pragma unroll
            for (int k4 = 0; k4 < 4; ++k4) { const f32x4 hq = *(const LAS f32x4*)(cslot + 4 * k4), pq = *(const LAS f32x4*)(cslot + 16 + 4 * k4);
                Hc[4 * k4] = hq.x; Hc[4 * k4 + 1] = hq.y; Hc[4 * k4 + 2] = hq.z; Hc[4 * k4 + 3] = hq.w; Pc[4 * k4] = pq.x; Pc[4 * k4 + 1] = pq.y; Pc[4 * k4 + 2] = pq.z; Pc[4 * k4 + 3] = pq.w; }
#pragma unroll
            for (int ks = 0; ks < 2; ++ks) {
                const size_t o = (size_t)(b * 128 + c) * DH + wid * 64 + 32 * ks + 8 * fq;
#pragma unroll
                for (int e2 = 0; e2 < 4; ++e2) {
                    const unsigned lo = cvt_pk(Pc[8 * ks + 2 * e2], Hc[8 * ks + 2 * e2]), hi = cvt_pk(Pc[8 * ks + 2 * e2 + 1], Hc[8 * ks + 2 * e2 + 1]);
                    __hip_atomic_store((unsigned long long*)(car + o) + e2, ((unsigned long long)hi << 32) | lo, __ATOMIC_RELAXED, __HIP_MEMORY_SCOPE_AGENT); }
            }
        }
        int fr2 = fr, fq2 = fq, tid2 = tid; asm volatile("" : "+v"(fr2), "+v"(fq2), "+v"(tid2));
        TOC(12); TIC();
#ifndef NO_MX_POOL
        m2_pool2(proj, Y, Wp, pbias, pscale, red2, b, t0, NM, g, half, fr2, fq2);
#endif
        asm volatile("s_waitcnt vmcnt(0)" ::: "memory");
        __syncthreads();
        if (tid2 == 0) __hip_atomic_store(flags + unit, (unsigned)(l + 1), __ATOMIC_RELAXED, __HIP_MEMORY_SCOPE_AGENT);
        TOC(13); TIC();
        if (tid2 < c) { unsigned sp = 0; while (__hip_atomic_load(flags + b * 128 + tid2, __ATOMIC_RELAXED, __HIP_MEMORY_SCOPE_AGENT) < (unsigned)(l + 1)) { __builtin_amdgcn_s_sleep(2); if (++sp > (1u << 22)) break; } }
#if defined(MIXER_ACQ_FENCE)
        if (tid2 < c) __builtin_amdgcn_fence(__ATOMIC_ACQUIRE, "agent");
#endif
        __syncthreads();
        TOC(14); TIC();
        {
            const int q = (c + 3) >> 2, seg = tid2 >> 7, cgi = tid2 & 127, jlo = seg * q, jhi = (jlo + q < c) ? jlo + q : c;
            f32x4 A0 = {1.f, 1.f, 1.f, 1.f}, H0 = {0.f, 0.f, 0.f, 0.f};
            for (int j = jlo; j < jhi; j += 16) {
                unsigned long long w0[16], w1[16];
#pragma unroll
                for (int i = 0; i < 16; ++i) { const int jj = (j + i < jhi) ? j + i : jhi - 1; const size_t o = (size_t)(b * 128 + jj) * DH + 4 * cgi;
                    w0[i] = __hip_atomic_load((const unsigned long long*)(car + o), __ATOMIC_RELAXED, __HIP_MEMORY_SCOPE_AGENT); w1[i] = __hip_atomic_load((const unsigned long long*)(car + o) + 1, __ATOMIC_RELAXED, __HIP_MEMORY_SCOPE_AGENT); }
#pragma unroll
                for (int i = 0; i < 16; ++i) if (j + i < jhi) {
                    const f32x4 a = {bf_lo((unsigned)w0[i]), bf_lo((unsigned)(w0[i] >> 32)), bf_lo((unsigned)w1[i]), bf_lo((unsigned)(w1[i] >> 32))};
                    const f32x4 h = {bf_hi((unsigned)w0[i]), bf_hi((unsigned)(w0[i] >> 32)), bf_hi((unsigned)w1[i]), bf_hi((unsigned)(w1[i] >> 32))};
                    H0 = a * H0 + h; A0 = A0 * a; }
            }
            *(LAS f32x4*)(segA + seg * DH + 4 * cgi) = A0; *(LAS f32x4*)(segH + seg * DH + 4 * cgi) = H0;
        }
        __syncthreads();
        { float cy = 0.f;
#pragma unroll
          for (int s4 = 0; s4 < 4; ++s4) cy = segA[s4 * DH + tid2] * cy + segH[s4 * DH + tid2];
          carr[tid2] = cy; }
        __syncthreads();
        TOC(15); TIC();
        {
            float cr[16];
#pragma unroll
            for (int ks = 0; ks < 2; ++ks) { const f32x4 c0 = *(const LAS f32x4*)(carr + wid * 64 + 32 * ks + 8 * fq2), c1 = *(const LAS f32x4*)(carr + wid * 64 + 32 * ks + 8 * fq2 + 4);
                cr[8 * ks + 0] = c0.x; cr[8 * ks + 1] = c0.y; cr[8 * ks + 2] = c0.z; cr[8 * ks + 3] = c0.w; cr[8 * ks + 4] = c1.x; cr[8 * ks + 5] = c1.y; cr[8 * ks + 6] = c1.z; cr[8 * ks + 7] = c1.w; }
#ifndef NO_MX_RNN
            m2_rnn_round<4, true>(lds, hl, Pp, proj, Y, red1, cr, b, t0, 0, wid, fr2, fq2);
            if (NM == 5) m2_rnn_round<1, false>(lds, hl, Pp, proj, Y, red1, cr, b, t0, 4, wid, fr2, fq2);
#endif
        }
        TOC(16);
    }
    __syncthreads();
}

#define XB_TMO      128
#define XB_XCNT(j)  (256  + 64 * (j))
#define XB_XSUB(j)  (1280 + 64 * (j))
#define XB_XGEN(j)  (2304 + 64 * (j))
#define XB_TOP      3328
#define XB_TOPGEN   3392
#define XCD_BAR_WORDS 3456
#define XB_SPIN_CAP (1u << 18)

__device__ __forceinline__ unsigned xb_ld(unsigned* p)              { return __hip_atomic_load(p, __ATOMIC_RELAXED, __HIP_MEMORY_SCOPE_AGENT); }
__device__ __forceinline__ unsigned xb_add(unsigned* p, unsigned v) { return __hip_atomic_fetch_add(p, v, __ATOMIC_RELAXED, __HIP_MEMORY_SCOPE_AGENT); }
__device__ __forceinline__ unsigned xb_xcc_id() { return (unsigned)__builtin_amdgcn_s_getreg((3 << 11) | 20) & 0xFu; }
#define XB_SPIN(cond, bar) do { unsigned _sp = 0; while (cond) { __builtin_amdgcn_s_sleep(1); \
    if ((++_sp & 255u) == 0u) { if (xb_ld(&(bar)[XB_TMO])) break; if (_sp > XB_SPIN_CAP) { atomicAdd(&(bar)[XB_TMO], 1u); break; } } } } while (0)

struct XcdBarrier {
    unsigned* bar; unsigned x;
    volatile LAS unsigned* st;
};

__device__ __forceinline__ XcdBarrier xcd_barrier_post(unsigned* bar, volatile LAS unsigned* st) {
    XcdBarrier b; b.bar = bar; b.x = xb_xcc_id(); b.st = st;
    if (threadIdx.x == 0) (void)xb_add(&bar[XB_XCNT(b.x)], 1u);
    return b;
}
__device__ __forceinline__ void xcd_barrier_complete(unsigned* bar, unsigned x, unsigned& nloc, unsigned& nx) {
    const unsigned G = gridDim.x * gridDim.y * gridDim.z;
    unsigned sum, cnt, mine, sp = 0u;
    for (;;) {
        sum = 0u; cnt = 0u; mine = 0u;
#pragma unroll
        for (unsigned j = 0; j < 16; ++j) { const unsigned c = xb_ld(&bar[XB_XCNT(j)]); sum += c; cnt += (c > 0u) ? 1u : 0u; mine = (j == x) ? c : mine; }
        if (sum == G) break;
        __builtin_amdgcn_s_sleep(1);
        if ((++sp & 255u) == 0u) { if (xb_ld(&bar[XB_TMO])) break; if (sp > XB_SPIN_CAP) { atomicAdd(&bar[XB_TMO], 1u); break; } }
    }
    nloc = mine > 0u ? mine : 1u; nx = cnt > 0u ? cnt : 1u;
}

__device__ __forceinline__ void xcd_barrier(const XcdBarrier& b) {
    asm volatile("s_waitcnt vmcnt(0)" ::: "memory");
    __syncthreads();
    if (threadIdx.x == 0) {
        unsigned* bar = b.bar;
        __builtin_amdgcn_s_waitcnt(0);
        unsigned nloc = b.st[0], nx = b.st[1];
        if (nloc == 0u) { xcd_barrier_complete(bar, b.x, nloc, nx); b.st[0] = nloc; b.st[1] = nx; }
        const unsigned old = xb_add(&bar[XB_XSUB(b.x)], 1u);
        const unsigned gen = old / nloc;
        if (old + 1u == (gen + 1u) * nloc) {
            __builtin_amdgcn_fence(__ATOMIC_RELEASE, "agent");
            asm volatile("s_waitcnt vmcnt(0)" ::: "memory");
            const unsigned og = xb_add(&bar[XB_TOP], 1u);
            const unsigned tg = og / nx;
            if (og + 1u == (tg + 1u) * nx) xb_add(&bar[XB_TOPGEN], 1u);
            else XB_SPIN(xb_ld(&bar[XB_TOPGEN]) == tg, bar);
            __builtin_amdgcn_fence(__ATOMIC_ACQUIRE, "agent");
            xb_add(&bar[XB_XGEN(b.x)], 1u);
            asm volatile("s_waitcnt vmcnt(0)" ::: "memory");
        } else {
            XB_SPIN(xb_ld(&bar[XB_XGEN(b.x)]) == gen, bar);
            __builtin_amdgcn_fence(__ATOMIC_ACQUIRE, "agent");
            asm volatile("s_waitcnt vmcnt(0)" ::: "memory");
        }
    }
    __syncthreads();
}

#ifndef PROBE_SYNC2
#define PROBE_SYNC2 0
#endif
#ifndef PROBE_M1X2
#define PROBE_M1X2 0
#endif
#ifndef PROBE_M2X2
#define PROBE_M2X2 0
#endif
#define GSYNC() do { { __attribute__((address_space(1))) unsigned* gb_ = (__attribute__((address_space(1))) unsigned*)xbar.bar; asm volatile("" : "+s"(gb_)); xbar.bar = (unsigned*)gb_; asm volatile("" : "+s"(xbar.x)); } xcd_barrier(xbar); if (PROBE_SYNC2) xcd_barrier(xbar); } while (0)
__device__ __forceinline__ int rstd_cache(LAS unsigned char* lds, const float* ss, const pg8::StaticOrder& S) {
    pg8::Unit u0; int pmc = -1;
    int tid = threadIdx.x; asm volatile("" : "+v"(tid));
    if (S.next(0, u0)) { pmc = u0.pm; if (tid < 256) ((LAS float*)(lds + 131072))[tid] = row_rstd(ss, u0.pm * 256 + tid); }
    asm volatile("s_waitcnt vmcnt(0) lgkmcnt(0)" ::: "memory");
    return pmc;
}
__global__ void __launch_bounds__(512, 2) fwd_megakernel(Params p) {
    extern __shared__ __attribute__((aligned(16))) unsigned char lds_raw[];
    LAS unsigned char* lds = (LAS unsigned char*)lds_raw;
    cg::grid_group grid = cg::this_grid();
    const int G = gridDim.x;
    unsigned long long tic = 0, tacc = 0;
    unsigned char* ws = p.ws;
    volatile LAS unsigned* xst = (volatile LAS unsigned*)(lds + LDS_XST);
    if (threadIdx.x < 2) xst[threadIdx.x] = 0u;
    __syncthreads();
    XcdBarrier xbar = xcd_barrier_post((unsigned*)(ws + WS_CTL), xst);
    bf16* hb = (bf16*)(ws + WS_HB); bf16* proj = (bf16*)(ws + WS_PROJ); bf16* Y = (bf16*)(ws + WS_Y); bf16* mid = (bf16*)(ws + WS_MID); float* ss = (float*)(ws + WS_SS);
    grid.sync();
    TIC();
#ifndef NO_PRO
    prologue(p, lds, G);
#endif
    GSYNC();
    TOC(0);
#pragma unroll 1
    for (int l = 0; l < DEPTH; ++l) {
        { __attribute__((address_space(1))) unsigned char* gws = (__attribute__((address_space(1))) unsigned char*)ws; asm volatile("" : "+s"(gws)); ws = (unsigned char*)gws; }
        const unsigned char* wl = ws + WS_W + (size_t)l * W_LAYER;
        const bf16* in_t = (const bf16*)(wl + W_IN); const bf16* out_t = (const bf16*)(wl + W_OUT); const bf16* up_t = (const bf16*)(wl + W_UP); const bf16* down_t = (const bf16*)(wl + W_DOWN);
        TIC();
#ifndef NO_GIN
        { pg8::Gemm g{hb, in_t, M, DIN, D, 0}; pg8::StaticOrder S; S.init(M, DIN, G, (int)blockIdx.x); const int pmc = rstd_cache(lds, ss, S); EpiIn E{proj, ss, (const LAS float*)(lds + 131072), pmc};
          pg8::gemm_phase<EpiIn, pg8::StaticOrder, true, true>(lds, g, S, E); }
#endif
#ifndef NO_META
        meta_tasks<0>(p, lds, G, nullptr, 0, in_t, D, DIN / 16);
#endif
        if (G == 256 && l + 1 < DEPTH && blockIdx.x >= 128)
            convert_items(p, lds, (l + 1) * TITEMS_PER_LAYER, (l + 2) * TITEMS_PER_LAYER, (int)blockIdx.x - 128, 128 * 8);
        GSYNC();
        TOC(1); TIC();
#ifndef FUSED_MIXER
#define FUSED_MIXER 1
#endif
#if FUSED_MIXER
        mixer_phase(p, lds, G, l, tic, tacc);
        GSYNC();
        TOC(2);
#else
        m1_phase(p, lds, G, l);
        GSYNC();
        TOC(2); TIC();
        m2_phase(p, lds, G, l);
        GSYNC();
#endif
        TOC(3); TIC();
#ifndef NO_GOUT
        { pg8::Gemm g{Y, out_t, M, D, D, NMETA}; pg8::StaticOrder S; S.init(M, D, G, (int)blockIdx.x); EpiRes E{hb, ss};
          pg8::gemm_phase<EpiRes, pg8::StaticOrder, false, true>(lds, g, S, E); }
#endif
#ifndef NO_META
        if (l < DEPTH - 1) meta_tasks<1>(p, lds, G, Y, D, out_t, D, D / 16);
#endif
        GSYNC();
        TOC(4); TIC();
#ifndef NO_GUP
#ifndef STAGGER_UP
#define STAGGER_UP 0
#endif
        if (STAGGER_UP > 0) {
            const unsigned long long w0 = __builtin_amdgcn_s_memrealtime(), dl = (unsigned long long)(((blockIdx.x >> 3) & 3) * STAGGER_UP);
            while (__builtin_amdgcn_s_memrealtime() - w0 < dl) __builtin_amdgcn_s_sleep(4);
        }
        { pg8::Gemm g{hb, up_t, M, FF, D, 0}; pg8::StaticOrder S; S.init(M, FF, G, (int)blockIdx.x); const int pmc = rstd_cache(lds, ss, S); EpiUp E{mid, ss, (const LAS float*)(lds + 131072), pmc};
          pg8::gemm_phase<EpiUp, pg8::StaticOrder, true, true>(lds, g, S, E); }
#endif
#ifndef NO_META
        if (l < DEPTH - 1) meta_tasks<2>(p, lds, G, nullptr, 0, up_t, D, FF / 16);
#endif
        GSYNC();
        TOC(5); TIC();
#ifndef NO_GDN
        { pg8::Gemm g{mid, down_t, M, D, FF, 0}; pg8::StaticOrder S; S.init(M, D, G, (int)blockIdx.x); EpiRes E{hb, ss};
          pg8::gemm_phase<EpiRes, pg8::StaticOrder, false, true>(lds, g, S, E); }
#endif
#ifndef NO_META
        if (l < DEPTH - 1) meta_tasks<1, 16>(p, lds, G, (const bf16*)(ws + WS_MIDMETA), FF, down_t, FF, D / 16);
#endif
        GSYNC();
        TOC(6);
    }
    TIC();
    final_norm(p, G);
    TOC(7);
    if (PROBE_PHASE >= 0 && blockIdx.x == PROBE_BLOCK && threadIdx.x == 0) { const unsigned long long w0 = __builtin_amdgcn_s_memrealtime(); while (__builtin_amdgcn_s_memrealtime() - w0 < 4ull * tacc) __builtin_amdgcn_s_sleep(8); }
}

extern "C" void kernel_launch(void* const* d_in, const int* in_sizes, int n_in, void* d_out, int out_size, void* d_ws, size_t ws_size, hipStream_t stream) {
    static int grid = 0;
    if (grid == 0) {
        if (n_in != 20 || in_sizes[0] != M * D || out_size != M * D || ws_size < WS_END) { fprintf(stderr, "kernel_launch: unexpected shapes (n_in %d, in0 %d, out %d, ws %zu)\n", n_in, n_in > 0 ? in_sizes[0] : -1, out_size, ws_size); grid = -1; return; }
        int dev = 0, cus = 0, per_cu = 0;
        if (hipGetDevice(&dev) != hipSuccess || hipDeviceGetAttribute(&cus, hipDeviceAttributeMultiprocessorCount, dev) != hipSuccess) { grid = -1; return; }
        if (hipFuncSetAttribute((const void*)fwd_megakernel, hipFuncAttributeMaxDynamicSharedMemorySize, LDS_BYTES) != hipSuccess) { fprintf(stderr, "kernel_launch: hipFuncSetAttribute failed\n"); grid = -1; return; }
        if (hipOccupancyMaxActiveBlocksPerMultiprocessor(&per_cu, (const void*)fwd_megakernel, 512, LDS_BYTES) != hipSuccess || per_cu < 1) { fprintf(stderr, "kernel_launch: occupancy query gave %d\n", per_cu); (void)hipGetLastError(); grid = -1; return; }
        grid = cus * 1;
        if (grid < 256) { fprintf(stderr, "kernel_launch: %d CUs; the fused mixer phase needs 256 resident workgroups\n", cus); grid = -1; return; }
    }
    if (grid < 0) return;
    if (hipMemsetAsync((char*)d_ws + WS_CTL, 0, WS_FLAG + 256 * 4, stream) != hipSuccess) { fprintf(stderr, "kernel_launch: memset failed\n"); return; }
    Params p{};
    for (int i = 0; i < 20; ++i) p.in[i] = (const float*)d_in[i];
    p.out = (float*)d_out; p.ws = (unsigned char*)d_ws;
    void* args[] = {&p};
    hipError_t e = hipLaunchCooperativeKernel((const void*)fwd_megakernel, dim3(grid), dim3(512), args, LDS_BYTES, stream);
    if (e != hipSuccess) fprintf(stderr, "cooperative launch failed: %s (grid %d)\n", hipGetErrorString(e), grid);
}
```

```cpp
#include <hip/hip_runtime.h>
#include <hip/hip_cooperative_groups.h>
#include <cstdio>
#include <cstdint>
namespace cg = cooperative_groups;
namespace pg8 {
#define PG8_LAS __attribute__((address_space(3)))
typedef unsigned short bf16_t;
typedef short bf16x8 __attribute__((ext_vector_type(8)));
typedef float f32x4 __attribute__((ext_vector_type(4)));
typedef unsigned u32x4 __attribute__((ext_vector_type(4)));
constexpr int BM = 256, BK = 64, HALF = 128, HTB = HALF * BK * 2  , STAGE_BYTES = 8 * HTB, NXCD = 8, WGM = 8;

__host__ __device__ __forceinline__ int lds_byte(int r, int c) { const int st = (r >> 4) * 2 + (c >> 5), rr = r & 15, cc = c & 31, ob = rr * 64 + cc * 2; return st * 1024 + (ob ^ (((ob >> 9) & 1) << 5)); }
__host__ __device__ __forceinline__ void stage_rc(int b, int& R, int& C) { const int st = b / 1024, sb = b % 1024, swz = sb ^ (((sb >> 9) & 1) << 5); R = (st >> 1) * 16 + swz / 64; C = (st & 1) * 32 + (swz % 64) / 2; }
__host__ __device__ __forceinline__ int perm32(int rho) { const int n = rho >> 4, i = rho & 15; return 8 * (i >> 2) + 4 * n + (i & 3); }

struct Unit { int pm, pn; };
struct Gemm { const bf16_t* A; const bf16_t* Bt; int M, N, K, gap; };

struct StaticOrder {
    int nM, nN, nwg, G, c;
    __host__ __device__ void init(int M, int N, int G_, int c_) { nM = M / BM; nN = N / BM; nwg = nM * nN; G = G_; c = c_; }
    __host__ __device__ bool next(int i, Unit& u) const {
        const long L = (long)i * G + c; if (L >= nwg) return false;
        int wgid = (int)L; { const int q = nwg / NXCD, r = nwg % NXCD, xcd = wgid % NXCD, off = wgid / NXCD; wgid = (xcd < r ? xcd * (q + 1) : r * (q + 1) + (xcd - r) * q) + off; }
        const int nig = WGM * nN, gid = wgid / nig, fm = gid * WGM, gsz = (nM - fm) < WGM ? (nM - fm) : WGM;
        u.pm = fm + ((wgid % nig) % gsz); u.pn = (wgid % nig) / gsz; return true;
    }
    __device__ __forceinline__ void a_ready(const Unit&) const {}
    __device__ __forceinline__ void done(const Unit&) const {}
};
__device__ __forceinline__ unsigned cvt_pk_bf16(float lo, float hi) { unsigned r; asm volatile("v_cvt_pk_bf16_f32 %0, %1, %2" : "=v"(r) : "v"(lo), "v"(hi)); return r; }
template <class Epi, class Sched, bool ALIGN_EPI = false, bool SP2 = false>
__device__ __forceinline__ void gemm_phase(PG8_LAS unsigned char* lds, const Gemm g, const Sched& S, const Epi& E) {
    int tid_ = threadIdx.x; asm volatile("" : "+v"(tid_));
    const int tid = tid_, wid = __builtin_amdgcn_readfirstlane(tid >> 6), lane = tid & 63, wr = wid >> 2, wc = wid & 3, fr = lane & 15, fq = lane >> 4;
    const int K = g.K, nt = K / BK;
    unsigned voffA[2], voffB[2];
#pragma unroll
    for (int i = 0; i < 2; ++i) { int R, C; stage_rc(tid * 16 + i * 8192, R, C); const int Rb = Epi::PERM ? ((R & ~31) + perm32(R & 31)) : R;
        voffA[i] = (unsigned)(R * K + C) * 2u; voffB[i] = (unsigned)(Rb * K + C) * 2u; }
    const size_t kstep = (size_t)(BK * 2);
    const size_t hstep = (size_t)HALF * K * 2;
    const size_t tstep = 2 * hstep;
    const int agap = g.gap;
#define a_off(pm_) ((size_t)((pm_) * BM + agap * (1 + ((pm_) >> 5))) * (size_t)K * 2)
    const unsigned ldsw = (unsigned)wid * 1024u;
    const int aoff = lds_byte(wr * 64 + fr, fq * 8), boff = lds_byte(wc * 32 + fr, fq * 8);
#define PG8_SA(b, h) (((b) * 2 + (h)) * HTB)
#define PG8_SB(b, h) ((4 + (b) * 2 + (h)) * HTB)
#define PG8_STAGE(bufoff, gbase, voff) do { _Pragma("unroll") for (int _i = 0; _i < 2; ++_i) \
        __builtin_amdgcn_global_load_lds((const unsigned*)((const char*)(gbase) + (voff)[_i]), (PG8_LAS unsigned*)(lds + (bufoff) + ldsw + _i * 8192), 16, 0, 0); } while (0)
#define PG8_LDA(dst, b, h) do { _Pragma("unroll") for (int m = 0; m < 4; ++m) _Pragma("unroll") for (int k = 0; k < 2; ++k) dst[m][k] = *(const PG8_LAS bf16x8*)(lds + PG8_SA(b, h) + aoff + m * 2048 + k * 1024); } while (0)
#define PG8_LDB(dst, b, h) do { _Pragma("unroll") for (int n = 0; n < 2; ++n) _Pragma("unroll") for (int k = 0; k < 2; ++k) dst[n][k] = *(const PG8_LAS bf16x8*)(lds + PG8_SB(b, h) + boff + n * 2048 + k * 1024); } while (0)
#define PG8_MMA(ai, bj, At, Bt) do { __builtin_amdgcn_s_setprio(1); _Pragma("unroll") for (int m = 0; m < 4; ++m) _Pragma("unroll") for (int n = 0; n < 2; ++n) _Pragma("unroll") for (int k = 0; k < 2; ++k) \
        acc[ai][bj][m][n] = __builtin_amdgcn_mfma_f32_16x16x32_bf16(Bt[n][k], At[m][k], acc[ai][bj][m][n], 0, 0, 0); __builtin_amdgcn_s_setprio(0); } while (0)
#define PG8_WAIT_V(n) asm volatile("s_waitcnt vmcnt(" #n ")" ::: "memory")
#define PG8_WAIT_L(n) asm volatile("s_waitcnt lgkmcnt(" #n ")" ::: "memory")
#define PG8_BAR __builtin_amdgcn_s_barrier()
#define PG8_SCHED __builtin_amdgcn_sched_barrier(0)
    Unit cur, nxt; int ui = 0;
    if (!S.next(0, cur)) return;
    f32x4 acc[2][2][4][2];
#pragma unroll
    for (int a = 0; a < 2; ++a)
#pragma unroll
        for (int b = 0; b < 2; ++b)
#pragma unroll
            for (int m = 0; m < 4; ++m)
#pragma unroll
                for (int n = 0; n < 2; ++n) acc[a][b][m][n] = (f32x4){0.f, 0.f, 0.f, 0.f};
    if constexpr (Epi::PRELOAD) E.preload(acc, cur, wr, wc, fr, fq);
    bf16x8 At[4][2], B0[2][2], B1[2][2];
    const char* cA = (const char*)g.A + a_off(cur.pm); const char* cB = (const char*)g.Bt + (size_t)cur.pn * tstep;
    S.a_ready(cur);
    if constexpr (SP2) {
        PG8_STAGE(PG8_SB(0, 0), cB, voffB); PG8_STAGE(PG8_SB(0, 1), cB + hstep, voffB); PG8_STAGE(PG8_SA(0, 0), cA, voffA); PG8_STAGE(PG8_SA(0, 1), cA + hstep, voffA);
        if (wr == 1) PG8_BAR;
        PG8_WAIT_V(2); PG8_BAR;
        PG8_STAGE(PG8_SB(1, 0), cB + kstep, voffB); PG8_STAGE(PG8_SA(1, 0), cA + kstep, voffA); PG8_STAGE(PG8_SB(1, 1), cB + hstep + kstep, voffB);
        PG8_WAIT_V(6); PG8_BAR;
    } else {
        PG8_STAGE(PG8_SB(0, 0), cB, voffB); PG8_STAGE(PG8_SA(0, 0), cA, voffA); PG8_STAGE(PG8_SB(0, 1), cB + hstep, voffB); PG8_STAGE(PG8_SA(0, 1), cA + hstep, voffA);
        if (wr == 1) PG8_BAR;
        PG8_WAIT_V(4); PG8_BAR;
        PG8_STAGE(PG8_SB(1, 0), cB + kstep, voffB); PG8_STAGE(PG8_SA(1, 0), cA + kstep, voffA); PG8_STAGE(PG8_SB(1, 1), cB + hstep + kstep, voffB);
        PG8_WAIT_V(6); PG8_BAR;
    }
    for (;;) {
        const bool has_next = S.next(ui + 1, nxt);
        const char* nA = has_next ? (const char*)g.A + a_off(nxt.pm) : cA; const char* nB = has_next ? (const char*)g.Bt + (size_t)nxt.pn * tstep : cB;
        for (int t = 0; t < nt; t += 2) {
            const bool last = (t == nt - 2);
            const char* a1 = cA + (size_t)(t + 1) * kstep;
            const char* a2 = last ? nA : cA + (size_t)(t + 2) * kstep; const char* b2 = last ? nB : cB + (size_t)(t + 2) * kstep;
            const char* a3 = a2 + kstep; const char* b3 = b2 + kstep;
            if (last && has_next) S.a_ready(nxt);
            if constexpr (SP2) {
            PG8_LDB(B0, 0, 0); PG8_LDB(B1, 0, 1); PG8_SCHED; PG8_LDA(At, 0, 0); PG8_STAGE(PG8_SA(1, 1), a1 + hstep, voffA);
            PG8_WAIT_V(8); PG8_WAIT_L(0); PG8_BAR; PG8_MMA(0, 0, At, B0); PG8_MMA(0, 1, At, B1); PG8_BAR; PG8_SCHED;
            PG8_LDA(At, 0, 1); PG8_STAGE(PG8_SB(0, 0), b2, voffB); PG8_STAGE(PG8_SB(0, 1), b2 + hstep, voffB); PG8_STAGE(PG8_SA(0, 0), a2, voffA);
            PG8_WAIT_V(8); PG8_WAIT_L(0); PG8_BAR; PG8_MMA(1, 0, At, B0); PG8_MMA(1, 1, At, B1); PG8_BAR; PG8_SCHED;
            PG8_LDB(B0, 1, 0); PG8_LDB(B1, 1, 1); PG8_SCHED; PG8_LDA(At, 1, 0); PG8_STAGE(PG8_SA(0, 1), a2 + hstep, voffA);
            PG8_WAIT_V(8); PG8_WAIT_L(0); PG8_BAR; PG8_MMA(0, 0, At, B0); PG8_MMA(0, 1, At, B1); PG8_BAR; PG8_SCHED;
            PG8_LDA(At, 1, 1); PG8_STAGE(PG8_SB(1, 0), b3, voffB); PG8_STAGE(PG8_SB(1, 1), b3 + hstep, voffB); PG8_STAGE(PG8_SA(1, 0), a3, voffA);
            PG8_WAIT_V(8); PG8_WAIT_L(0); PG8_BAR; PG8_MMA(1, 0, At, B0); PG8_MMA(1, 1, At, B1); PG8_BAR; PG8_SCHED;
            } else {
            PG8_LDB(B0, 0, 0); PG8_SCHED; PG8_LDA(At, 0, 0); PG8_STAGE(PG8_SA(1, 1), a1 + hstep, voffA);
            PG8_WAIT_L(8); PG8_BAR; PG8_WAIT_L(0); PG8_MMA(0, 0, At, B0); PG8_BAR; PG8_SCHED;
            PG8_LDB(B1, 0, 1); PG8_STAGE(PG8_SB(0, 0), b2, voffB);
            PG8_BAR; PG8_WAIT_L(0); PG8_MMA(0, 1, At, B1); PG8_BAR;
            PG8_LDA(At, 0, 1); PG8_STAGE(PG8_SA(0, 0), a2, voffA);
            PG8_BAR; PG8_WAIT_L(0); PG8_MMA(1, 0, At, B0); PG8_BAR; PG8_SCHED;
            PG8_STAGE(PG8_SB(0, 1), b2 + hstep, voffB);
            PG8_WAIT_V(6); PG8_BAR; PG8_MMA(1, 1, At, B1); PG8_BAR;
            PG8_LDB(B0, 1, 0); PG8_SCHED; PG8_LDA(At, 1, 0); PG8_STAGE(PG8_SA(0, 1), a2 + hstep, voffA);
            PG8_WAIT_L(8); PG8_BAR; PG8_WAIT_L(0); PG8_MMA(0, 0, At, B0); PG8_BAR; PG8_SCHED;
            PG8_LDB(B1, 1, 1); PG8_STAGE(PG8_SB(1, 0), b3, voffB);
            PG8_BAR; PG8_WAIT_L(0); PG8_MMA(0, 1, At, B1); PG8_BAR;
            PG8_LDA(At, 1, 1); PG8_STAGE(PG8_SA(1, 0), a3, voffA);
            PG8_BAR; PG8_WAIT_L(0); PG8_MMA(1, 0, At, B0); PG8_BAR; PG8_SCHED;
            PG8_STAGE(PG8_SB(1, 1), b3 + hstep, voffB);
            PG8_WAIT_V(6); PG8_BAR; PG8_MMA(1, 1, At, B1); PG8_BAR;
            }
        }
        if constexpr (ALIGN_EPI) { if (wr == 0) PG8_BAR; }
        if constexpr (!Epi::AFTER_DRAIN) { E(acc, cur, wr, wc, fr, fq); S.done(cur); }
        if (!has_next) break;
#pragma unroll
        for (int a = 0; a < 2; ++a)
#pragma unroll
            for (int b = 0; b < 2; ++b)
#pragma unroll
                for (int m = 0; m < 4; ++m)
#pragma unroll
                    for (int n = 0; n < 2; ++n) acc[a][b][m][n] = (f32x4){0.f, 0.f, 0.f, 0.f};
        if constexpr (Epi::PRELOAD) { E.preload(acc, nxt, wr, wc, fr, fq); PG8_WAIT_V(0); }
        cur = nxt; cA = nA; cB = nB; ++ui;
        if constexpr (ALIGN_EPI) { if (wr == 1) PG8_BAR; }
    }
    PG8_WAIT_V(0);
    if constexpr (!ALIGN_EPI) { if (wr == 0) PG8_BAR; }
    PG8_BAR;
    if constexpr (Epi::AFTER_DRAIN) { E.fused(acc, cur, wr, wc, fr, fq, lds, wid, lane); S.done(cur); }
#undef PG8_SA
#undef PG8_SB
#undef PG8_STAGE
#undef PG8_LDA
#undef PG8_LDB
#undef PG8_MMA
#undef PG8_WAIT_V
#undef PG8_WAIT_L
#undef PG8_BAR
#undef PG8_SCHED
}
}

#define LAS __attribute__((address_space(3)))
typedef unsigned short bf16;
typedef unsigned u32x4 __attribute__((ext_vector_type(4)));
typedef unsigned u32x2 __attribute__((ext_vector_type(2)));
typedef float f32x4 __attribute__((ext_vector_type(4)));
typedef short bf16x8 __attribute__((ext_vector_type(8)));
constexpr int D = 1024, SEQ = 8192, NB = 2, NMETA = 16, TT = SEQ + NMETA, M = NB * SEQ, DEPTH = 4, DIN = 1536, FF = 4096, DH = 512;
constexpr float EPS = 1e-6f;
constexpr size_t MiB = 1u << 20;
constexpr size_t WS_CTL = 0;
constexpr size_t WS_POOLW = 1 * MiB, WS_GR = WS_POOLW + 512 * 1024, WS_GI = WS_GR + 256 * 1024;
constexpr size_t WS_SP = 2 * MiB, WS_HMETA = WS_SP + 64 * 1024, WS_MIDMETA = WS_HMETA + 64 * 1024;
constexpr size_t WS_SS = 3 * MiB, WS_CARA = 4 * MiB, WS_CARH = WS_CARA + 512 * 1024;
constexpr size_t WS_W = 8 * MiB, W_LAYER = 21 * MiB, W_IN = 0, W_OUT = 3 * MiB, W_UP = 5 * MiB, W_DOWN = 13 * MiB;
constexpr size_t WS_HB = 92 * MiB, WS_MID = 124 * MiB;
constexpr size_t WS_PROJ = WS_MID, WS_Y = WS_MID + 48 * MiB + 256 * 1024, WS_HL = WS_Y + 32 * MiB + 256 * 1024, WS_P = WS_HL + 32 * MiB + 256 * 1024, WS_END = 256 * MiB;
static_assert(WS_PROJ + (size_t)NB * TT * DIN * 2 <= WS_Y && WS_Y + (size_t)NB * TT * D * 2 <= WS_HL && WS_HL + (size_t)NB * TT * DH * 2 <= WS_P && WS_P + (size_t)NB * TT * DH * 2 <= WS_END, "ws map");
static_assert(WS_W + DEPTH * W_LAYER <= WS_HB && WS_HB + (size_t)M * D * 2 <= WS_MID && WS_MID + (size_t)M * FF * 2 <= WS_END, "ws map 2");
constexpr int LDS_HL = 0, LDS_P = 65536, LDS_CST = 131072, LDS_CARR = 147456, LDS_RED1 = 149504, LDS_RED2 = 152064, LDS_CARRY = 154624;
constexpr int LDS_XST = 163840 - 64;
constexpr int LDS_BYTES = 163840;
constexpr size_t WS_FLAG = 64 * 1024;

struct Params {
    const float* in[20];
    float* out;
    unsigned char* ws;
};

__device__ __forceinline__ Params launder(const Params& p) {
    Params q = p;
#pragma unroll
    for (int i = 0; i < 20; ++i) { const __attribute__((address_space(1))) float* g = (const __attribute__((address_space(1))) float*)q.in[i]; asm volatile("" : "+s"(g)); q.in[i] = (const float*)g; }
    { __attribute__((address_space(1))) float* g = (__attribute__((address_space(1))) float*)q.out; asm volatile("" : "+s"(g)); q.out = (float*)g; }
    { __attribute__((address_space(1))) unsigned char* g = (__attribute__((address_space(1))) unsigned char*)q.ws; asm volatile("" : "+s"(g)); q.ws = (unsigned char*)g; }
    return q;
}
__device__ __forceinline__ unsigned cvt_pk(float lo, float hi) { return pg8::cvt_pk_bf16(lo, hi); }
__device__ __forceinline__ float bf_lo(unsigned w) { return __builtin_bit_cast(float, w << 16); }
__device__ __forceinline__ float bf_hi(unsigned w) { return __builtin_bit_cast(float, w & 0xffff0000u); }
__device__ __forceinline__ void unpack8(const u32x4 w, float (&f)[8]) {
    f[0] = bf_lo(w.x); f[1] = bf_hi(w.x); f[2] = bf_lo(w.y); f[3] = bf_hi(w.y); f[4] = bf_lo(w.z); f[5] = bf_hi(w.z); f[6] = bf_lo(w.w); f[7] = bf_hi(w.w);
}
__device__ __forceinline__ u32x4 pack8(const float (&f)[8]) { u32x4 w; w.x = cvt_pk(f[0], f[1]); w.y = cvt_pk(f[2], f[3]); w.z = cvt_pk(f[4], f[5]); w.w = cvt_pk(f[6], f[7]); return w; }
__device__ __forceinline__ float wave_sum(float v) {
#pragma unroll
    for (int o = 1; o < 64; o <<= 1) v += __shfl_xor(v, o);
    return v;
}
template <int CTRL> __device__ __forceinline__ float dppf(float old, float src) {
    return __builtin_bit_cast(float, __builtin_amdgcn_update_dpp(__builtin_bit_cast(int, old), __builtin_bit_cast(int, src), CTRL, 0xf, 0xf, false));
}
template <int DD> __device__ __forceinline__ float shiftd(float cur, float prev) {
    const float t = dppf<0x100 + (16 - DD)>(0.f, prev);
    return dppf<0x110 + DD>(t, cur);
}
__device__ __forceinline__ float sigm(float v) { return __builtin_amdgcn_rcpf(1.0f + __expf(-v)); }
__device__ __forceinline__ int outchan(int n, int rho) { return 32 * (n >> 1) + 8 * (rho >> 2) + 4 * (n & 1) + (rho & 3); }

__device__ __forceinline__ float row_rstd(const float* ss, int r) {
    const f32x4* s4 = (const f32x4*)(ss + (size_t)r * 16);
    const f32x4 a = s4[0], b = s4[1], c = s4[2], d = s4[3];
    const float s = ((a.x + a.y) + (a.z + a.w)) + ((b.x + b.y) + (b.z + b.w)) + ((c.x + c.y) + (c.z + c.w)) + ((d.x + d.y) + (d.z + d.w));
    return 1.0f / sqrtf(s * (1.0f / D) + EPS);
}
__device__ __forceinline__ void rows_rstd(const float* ss, int rowbase  , int fr, float (&rs)[2][4]) {
    const int lane = threadIdx.x & 63;
    const float r0 = row_rstd(ss, rowbase + lane), r1 = row_rstd(ss, rowbase + 128 + lane);
#pragma unroll
    for (int m = 0; m < 4; ++m) { rs[0][m] = __shfl(r0, m * 16 + fr); rs[1][m] = __shfl(r1, m * 16 + fr); }
}
struct EpiIn {
    static constexpr bool PERM = true, AFTER_DRAIN = false, PRELOAD = false;
    bf16* P; const float* ss; const LAS float* rl; int pmc;
    __device__ __forceinline__ void operator()(const f32x4 (&acc)[2][2][4][2], const pg8::Unit& u, int wr, int wc, int fr, int fq) const {
        const int row0 = u.pm * 256 + wr * 64 + fr, col0 = u.pn * 256 + wc * 32 + 8 * fq;
        float rsv[2][4];
        if (u.pm == pmc) {
#pragma unroll
            for (int ai = 0; ai < 2; ++ai)
#pragma unroll
                for (int m = 0; m < 4; ++m) rsv[ai][m] = rl[ai * 128 + wr * 64 + m * 16 + fr];
        } else {
#pragma unroll
            for (int ai = 0; ai < 2; ++ai)
#pragma unroll
                for (int m = 0; m < 4; ++m) { rsv[ai][m] = row_rstd(ss, row0 + ai * 128 + m * 16); asm volatile("" ::: "memory"); }
        }
#pragma unroll
        for (int ai = 0; ai < 2; ++ai)
#pragma unroll
            for (int m = 0; m < 4; ++m) {
                const int r = row0 + ai * 128 + m * 16; const float rs = rsv[ai][m];
                bf16* rowp = P + (size_t)(r + NMETA * (1 + (r >> 13))) * DIN + col0;
#pragma unroll
                for (int bj = 0; bj < 2; ++bj) { const f32x4 v0 = acc[ai][bj][m][0] * rs, v1 = acc[ai][bj][m][1] * rs;
                    u32x4 w; w.x = cvt_pk(v0[0], v0[1]); w.y = cvt_pk(v0[2], v0[3]); w.z = cvt_pk(v1[0], v1[1]); w.w = cvt_pk(v1[2], v1[3]);
                    *(u32x4*)(rowp + bj * 128) = w; }
            }
    }
};
struct EpiUp {
    static constexpr bool PERM = true, AFTER_DRAIN = false, PRELOAD = false;
    bf16* O; const float* ss; const LAS float* rl; int pmc;
    __device__ __forceinline__ void operator()(const f32x4 (&acc)[2][2][4][2], const pg8::Unit& u, int wr, int wc, int fr, int fq) const {
        const int row0 = u.pm * 256 + wr * 64 + fr, col0 = u.pn * 256 + wc * 32 + 8 * fq;
        float rsv[2][4];
        if (u.pm == pmc) {
#pragma unroll
            for (int ai = 0; ai < 2; ++ai)
#pragma unroll
                for (int m = 0; m < 4; ++m) rsv[ai][m] = rl[ai * 128 + wr * 64 + m * 16 + fr];
        } else {
#pragma unroll
            for (int ai = 0; ai < 2; ++ai)
#pragma unroll
                for (int m = 0; m < 4; ++m) { rsv[ai][m] = row_rstd(ss, row0 + ai * 128 + m * 16); asm volatile("" ::: "memory"); }
        }
#pragma unroll
        for (int ai = 0; ai < 2; ++ai)
#pragma unroll
            for (int m = 0; m < 4; ++m) {
                const int r = row0 + ai * 128 + m * 16; const float rs = rsv[ai][m];
                bf16* rowp = O + (size_t)r * FF + col0;
#pragma unroll
                for (int bj = 0; bj < 2; ++bj) { f32x4 v0 = acc[ai][bj][m][0] * rs, v1 = acc[ai][bj][m][1] * rs;
#pragma unroll
                    for (int j = 0; j < 4; ++j) { v0[j] = fmaxf(v0[j], 0.f); v0[j] *= v0[j]; v1[j] = fmaxf(v1[j], 0.f); v1[j] *= v1[j]; }
                    u32x4 w; w.x = cvt_pk(v0[0], v0[1]); w.y = cvt_pk(v0[2], v0[3]); w.z = cvt_pk(v1[0], v1[1]); w.w = cvt_pk(v1[2], v1[3]);
                    *(u32x4*)(rowp + bj * 128) = w; }
            }
    }
};
struct EpiRes {
    static constexpr bool PERM = true, AFTER_DRAIN = false, PRELOAD = true;
    bf16* hb; float* ssn;
    __device__ __forceinline__ void preload(f32x4 (&acc)[2][2][4][2], const pg8::Unit& u, int wr, int wc, int fr, int fq) const {
        const int row0 = u.pm * 256 + wr * 64 + fr, col0 = u.pn * 256 + wc * 32 + 8 * fq;
#pragma unroll
        for (int ai = 0; ai < 2; ++ai)
#pragma unroll
            for (int m = 0; m < 4; ++m) { const size_t off = (size_t)(row0 + ai * 128 + m * 16) * D + col0;
#pragma unroll
                for (int bj = 0; bj < 2; ++bj) { const u32x4 w = *(const u32x4*)(hb + off + bj * 128);
                    acc[ai][bj][m][0] = (f32x4){bf_lo(w.x), bf_hi(w.x), bf_lo(w.y), bf_hi(w.y)}; acc[ai][bj][m][1] = (f32x4){bf_lo(w.z), bf_hi(w.z), bf_lo(w.w), bf_hi(w.w)}; } }
    }
    __device__ __forceinline__ void operator()(const f32x4 (&acc)[2][2][4][2], const pg8::Unit& u, int wr, int wc, int fr, int fq) const {
        const int row0 = u.pm * 256 + wr * 64 + fr, col0 = u.pn * 256 + wc * 32 + 8 * fq;
#pragma unroll
        for (int ai = 0; ai < 2; ++ai)
#pragma unroll
            for (int m = 0; m < 4; ++m) {
                const int r = row0 + ai * 128 + m * 16; const size_t off = (size_t)r * D + col0; float s = 0.f;
#pragma unroll
                for (int bj = 0; bj < 2; ++bj) {
                    const f32x4 o0 = acc[ai][bj][m][0], o1 = acc[ai][bj][m][1];
                    s += (o0[0] * o0[0] + o0[1] * o0[1]) + (o0[2] * o0[2] + o0[3] * o0[3]) + (o1[0] * o1[0] + o1[1] * o1[1]) + (o1[2] * o1[2] + o1[3] * o1[3]);
                    u32x4 w; w.x = cvt_pk(o0[0], o0[1]); w.y = cvt_pk(o0[2], o0[3]); w.z = cvt_pk(o1[0], o1[1]); w.w = cvt_pk(o1[2], o1[3]);
                    *(u32x4*)(hb + off + bj * 128) = w; }
                s += __shfl_xor(s, 16); s += __shfl_xor(s, 32);
                if (fq == 0) ssn[(size_t)r * 16 + u.pn * 4 + wc] = s;
            }
    }
};

struct TItem { const float* W; const float* gk; bf16* WT; int K, N, item; };
__device__ __forceinline__ void titem_load(const TItem& t, int lane, f32x4 (&v)[8], float (&gs)[8]) {
    const int nblk = t.N / 32, kb = t.item / nblk, nb = t.item % nblk, k0 = 64 * kb, n0 = 32 * nb, lr = lane >> 3, lc = (lane & 7) * 4;
#pragma unroll
    for (int i = 0; i < 8; ++i) { v[i] = *(const f32x4*)(t.W + (size_t)(k0 + 8 * i + lr) * t.N + n0 + lc); gs[i] = t.gk ? t.gk[k0 + 8 * i + lr] : 1.0f; }
}
__device__ __forceinline__ void titem_store(const TItem& t, int lane, const f32x4 (&v)[8], const float (&gs)[8], LAS float* scr) {
    const int nblk = t.N / 32, kb = t.item / nblk, nb = t.item % nblk, k0 = 64 * kb, n0 = 32 * nb, lr = lane >> 3, lc = (lane & 7) * 4;
#pragma unroll
    for (int i = 0; i < 8; ++i) { LAS float* d = scr + (8 * i + lr) * 33 + lc; d[0] = v[i].x * gs[i]; d[1] = v[i].y * gs[i]; d[2] = v[i].z * gs[i]; d[3] = v[i].w * gs[i]; }
    asm volatile("s_waitcnt lgkmcnt(0)" ::: "memory");
    const int c = lane & 7;
#pragma unroll
    for (int j = 0; j < 4; ++j) { const int n = (lane >> 3) + 8 * j; const LAS float* s = scr + (8 * c) * 33 + n;
        u32x4 o; o.x = cvt_pk(s[0 * 33], s[1 * 33]); o.y = cvt_pk(s[2 * 33], s[3 * 33]); o.z = cvt_pk(s[4 * 33], s[5 * 33]); o.w = cvt_pk(s[6 * 33], s[7 * 33]);
        *(u32x4*)(t.WT + (size_t)(n0 + n) * t.K + k0 + 8 * c) = o; }
    asm volatile("s_waitcnt lgkmcnt(0)" ::: "memory");
}
__device__ __forceinline__ TItem titem_decode(const Params& p, int it) {
    constexpr int I_IN = 16 * 48, I_OUT = 16 * 32, I_UP = 16 * 128, I_DN = 64 * 32, I_PW = 4 * 8, I_G = 8 * 2, I_L = I_IN + I_OUT + I_UP + I_DN + I_PW + 2 * I_G;
    const int l = it / I_L; int r = it % I_L; unsigned char* ws = p.ws; unsigned char* wl = ws + WS_W + (size_t)l * W_LAYER; TItem t;
    if (r < I_IN) { t = TItem{p.in[3] + (size_t)l * D * DIN, p.in[2] + l * D, (bf16*)(wl + W_IN), D, DIN, r}; return t; } r -= I_IN;
    if (r < I_OUT) { t = TItem{p.in[15] + (size_t)l * D * D, p.in[14] + l * D, (bf16*)(wl + W_OUT), D, D, r}; return t; } r -= I_OUT;
    if (r < I_UP) { t = TItem{p.in[17] + (size_t)l * D * FF, p.in[16] + l * D, (bf16*)(wl + W_UP), D, FF, r}; return t; } r -= I_UP;
    if (r < I_DN) { t = TItem{p.in[18] + (size_t)l * FF * D, nullptr, (bf16*)(wl + W_DOWN), FF, D, r}; return t; } r -= I_DN;
    if (r < I_PW) { const int g = r / 8; t = TItem{p.in[4] + (size_t)(l * 4 + g) * 16384, nullptr, (bf16*)(ws + WS_POOLW) + (size_t)(l * 4 + g) * 16384, 128, 128, r % 8}; return t; } r -= I_PW;
    if (r < I_G) { const int h = r / 2; t = TItem{p.in[9] + (size_t)(l * 8 + h) * 4096, nullptr, (bf16*)(ws + WS_GR) + (size_t)(l * 8 + h) * 4096, 64, 64, r % 2}; return t; } r -= I_G;
    { const int h = r / 2; t = TItem{p.in[11] + (size_t)(l * 8 + h) * 4096, nullptr, (bf16*)(ws + WS_GI) + (size_t)(l * 8 + h) * 4096, 64, 64, r % 2}; }
    return t;
}
constexpr int TITEMS_PER_LAYER = 16 * 48 + 16 * 32 + 16 * 128 + 64 * 32 + 4 * 8 + 2 * 8 * 2;
__device__ __forceinline__ void convert_items(const Params& p_, LAS unsigned char* lds, int it_lo, int it_hi, int wblock, int nworkers) {
    const Params p = launder(p_);
    int tid_ = threadIdx.x; asm volatile("" : "+v"(tid_));
    const int lane = tid_ & 63, wid = __builtin_amdgcn_readfirstlane(tid_ >> 6);
    LAS float* scr = (LAS float*)(lds + wid * 16384);
    const int worker = wblock * 8 + wid;
    if (it_lo + worker < it_hi) {
        TItem cur = titem_decode(p, it_lo + worker); f32x4 v[8]; float gs[8]; titem_load(cur, lane, v, gs);
        for (int it = it_lo + worker; it < it_hi; it += nworkers) {
            const bool more = it + nworkers < it_hi; TItem nxt = cur; f32x4 nv[8]; float ngs[8];
            if (more) { nxt = titem_decode(p, it + nworkers); titem_load(nxt, lane, nv, ngs); }
            titem_store(cur, lane, v, gs, scr);
            if (more) { cur = nxt;
#pragma unroll
                for (int i = 0; i < 8; ++i) { v[i] = nv[i]; gs[i] = ngs[i]; } }
        }
    }
}
__device__ __forceinline__ void prologue(const Params& p_, LAS unsigned char* lds, int G) {
    const Params p = launder(p_);
    int tid_ = threadIdx.x; asm volatile("" : "+v"(tid_));
    const int tid = tid_, lane = tid & 63, wid = __builtin_amdgcn_readfirstlane(tid >> 6);
    const int gw = blockIdx.x * 8 + wid, NGW = G * 8;
    unsigned char* ws = p.ws;
    convert_items(p_, lds, 0, (G == 256 ? 1 : DEPTH) * TITEMS_PER_LAYER, (int)blockIdx.x, NGW);
    const float* x = p.in[0]; bf16* hb = (bf16*)(ws + WS_HB); float* ss = (float*)(ws + WS_SS);
    for (int m2 = gw; m2 < M / 2; m2 += NGW) {
        f32x4 v[2][4]; float s[2] = {0.f, 0.f};
#pragma unroll
        for (int r = 0; r < 2; ++r) { const f32x4* xr = (const f32x4*)(x + (size_t)(2 * m2 + r) * D) + lane;
#pragma unroll
            for (int j = 0; j < 4; ++j) v[r][j] = xr[64 * j]; }
#pragma unroll
        for (int r = 0; r < 2; ++r) {
#pragma unroll
            for (int j = 0; j < 4; ++j) s[r] += (v[r][j].x * v[r][j].x + v[r][j].y * v[r][j].y) + (v[r][j].z * v[r][j].z + v[r][j].w * v[r][j].w);
            s[r] = wave_sum(s[r]);
            u32x2* o8 = (u32x2*)(hb + (size_t)(2 * m2 + r) * D) + lane;
#pragma unroll
            for (int j = 0; j < 4; ++j) { u32x2 w; w.x = cvt_pk(v[r][j].x, v[r][j].y); w.y = cvt_pk(v[r][j].z, v[r][j].w); o8[64 * j] = w; }
            if (lane < 16) ss[(size_t)(2 * m2 + r) * 16 + lane] = lane == 0 ? s[r] : 0.f;
        }
    }
    float* hm = (float*)(ws + WS_HMETA); float* sp = (float*)(ws + WS_SP);
    for (int i = blockIdx.x * 512 + tid; i < NMETA * D; i += G * 512) hm[i] = p.in[1][i];
    for (int i = blockIdx.x * 512 + tid; i < DEPTH * DH; i += G * 512) sp[i] = log1pf(expf(-p.in[13][i]));
}

template <int MODE, int NBATCH = 4> __device__ __forceinline__ void meta_tasks(const Params& p_, LAS unsigned char* lds, int G, const bf16* Ab, int lda, const bf16* Bt, int K, int ntasks) {
    const Params p = launder(p_);
    int tid_ = threadIdx.x; asm volatile("" : "+v"(tid_));
    const int tid = tid_, lane = tid & 63, wid = __builtin_amdgcn_readfirstlane(tid >> 6), fr = lane & 15, fq = lane >> 4;
    float* hm = (float*)(p.ws + WS_HMETA);
    LAS float* red = (LAS float*)lds;
    for (int task = G - 1 - (int)blockIdx.x; task < ntasks; task += G) {
        const int n0 = task * 16, kw = K / 8, k0 = wid * kw;
        f32x4 acc = {0.f, 0.f, 0.f, 0.f}; float ssq = 0.f;
        for (int kb = k0; kb < k0 + kw; kb += 32 * NBATCH) {
            bf16x8 af[NBATCH], bfr[NBATCH]; f32x4 a0[NBATCH], a1[NBATCH];
#pragma unroll
            for (int i = 0; i < NBATCH; ++i) { const int kk = kb + 32 * i;
                if (MODE == 1) af[i] = *(const bf16x8*)(Ab + (size_t)fr * lda + kk + 8 * fq);
                else { a0[i] = *(const f32x4*)(hm + fr * D + kk + 8 * fq); a1[i] = *(const f32x4*)(hm + fr * D + kk + 8 * fq + 4); }
                bfr[i] = *(const bf16x8*)(Bt + (size_t)(n0 + fr) * K + kk + 8 * fq); }
#pragma unroll
            for (int i = 0; i < NBATCH; ++i) {
                if (MODE != 1) { ssq += (a0[i].x * a0[i].x + a0[i].y * a0[i].y) + (a0[i].z * a0[i].z + a0[i].w * a0[i].w) + (a1[i].x * a1[i].x + a1[i].y * a1[i].y) + (a1[i].z * a1[i].z + a1[i].w * a1[i].w);
                    u32x4 w; w.x = cvt_pk(a0[i].x, a0[i].y); w.y = cvt_pk(a0[i].z, a0[i].w); w.z = cvt_pk(a1[i].x, a1[i].y); w.w = cvt_pk(a1[i].z, a1[i].w); af[i] = __builtin_bit_cast(bf16x8, w); }
                acc = __builtin_amdgcn_mfma_f32_16x16x32_bf16(bfr[i], af[i], acc, 0, 0, 0); }
        }
        ssq += __shfl_xor(ssq, 16); ssq += __shfl_xor(ssq, 32);
        LAS float* rp = red + (wid * 64 + lane) * 5;
        rp[0] = acc[0]; rp[1] = acc[1]; rp[2] = acc[2]; rp[3] = acc[3]; rp[4] = ssq;
        __syncthreads();
        if (wid == 0) {
            float a0 = 0.f, a1 = 0.f, a2 = 0.f, a3 = 0.f, sq = 0.f;
#pragma unroll
            for (int w = 0; w < 8; ++w) { const LAS float* q = red + (w * 64 + lane) * 5; a0 += q[0]; a1 += q[1]; a2 += q[2]; a3 += q[3]; sq += q[4]; }
            const int col = n0 + 4 * fq;
            if (MODE == 1) { f32x4* hp = (f32x4*)(hm + fr * D + col); f32x4 h = *hp; h.x += a0; h.y += a1; h.z += a2; h.w += a3; *hp = h; }
            else {
                const float rs = 1.0f / sqrtf(sq * (1.0f / D) + EPS); a0 *= rs; a1 *= rs; a2 *= rs; a3 *= rs;
                if (MODE == 0) { u32x2 w; w.x = cvt_pk(a0, a1); w.y = cvt_pk(a2, a3); bf16* pr = (bf16*)(p.ws + WS_PROJ);
                    *(u32x2*)(pr + (size_t)fr * DIN + col) = w; *(u32x2*)(pr + (size_t)(TT + fr) * DIN + col) = w; }
                else { a0 = fmaxf(a0, 0.f); a1 = fmaxf(a1, 0.f); a2 = fmaxf(a2, 0.f); a3 = fmaxf(a3, 0.f);
                    u32x2 w; w.x = cvt_pk(a0 * a0, a1 * a1); w.y = cvt_pk(a2 * a2, a3 * a3); *(u32x2*)((bf16*)(p.ws + WS_MIDMETA) + (size_t)fr * FF + col) = w; }
            }
        }
        __syncthreads();
    }
}

__device__ __forceinline__ void m1_phase(const Params& p_, LAS unsigned char* lds, int G, int l) {
    const Params p = launder(p_);
    int tid_ = threadIdx.x; asm volatile("" : "+v"(tid_));
    const int tid = tid_, lane = tid & 63, wid = __builtin_amdgcn_readfirstlane(tid >> 6), fr = lane & 15, fq = lane >> 4;
    LAS float* cst = (LAS float*)lds;
    for (int i = tid; i < 8 * DH; i += 512) { const int row = i >> 9, ch = i & 511; float v;
        if (row < 4) v = p.in[7][(l * 4 + row) * DH + ch]; else if (row == 4) v = p.in[8][l * DH + ch]; else if (row == 5) v = p.in[10][l * DH + ch];
        else if (row == 6) v = p.in[12][l * DH + ch]; else v = ((const float*)(p.ws + WS_SP))[l * DH + ch];
        cst[i] = v; }
    const bf16* proj = (const bf16*)(p.ws + WS_PROJ);
    const bf16* Wr = (const bf16*)(p.ws + WS_GR) + (size_t)(l * 8 + wid) * 4096; const bf16* Wi = (const bf16*)(p.ws + WS_GI) + (size_t)(l * 8 + wid) * 4096;
    LAS bf16x8* wl = (LAS bf16x8*)(lds + 16384 + wid * 16384) + lane;
#pragma unroll
    for (int n = 0; n < 4; ++n)
#pragma unroll
        for (int ks = 0; ks < 2; ++ks) {
            wl[((n * 2 + ks) * 2 + 0) * 64] = *(const bf16x8*)(Wr + outchan(n, fr) * 64 + 32 * ks + 8 * fq);
            wl[((n * 2 + ks) * 2 + 1) * 64] = *(const bf16x8*)(Wi + outchan(n, fr) * 64 + 32 * ks + 8 * fq); }
    __syncthreads();
    bf16* hl = (bf16*)(p.ws + WS_HL); bf16* Pp = (bf16*)(p.ws + WS_P);
    float* carA = (float*)(p.ws + WS_CARA); float* carH = (float*)(p.ws + WS_CARH);
    for (int unit = blockIdx.x; unit < 256; unit += G) {
        const int b = unit >> 7, c = unit & 127, t0 = c ? NMETA + 64 * c : 0, NM = c ? 4 : 5;
        float Hc[16], Pc[16];
#pragma unroll
        for (int k = 0; k < 16; ++k) { Hc[k] = 0.f; Pc[k] = 1.f; }
        u32x4 raw[2][4];
#pragma unroll
        for (int ks = 0; ks < 2; ++ks)
#pragma unroll
            for (int d = 0; d < 4; ++d) { const int tt = t0 + fr - 3 + d; raw[ks][d] = (u32x4){0u, 0u, 0u, 0u};
                if (tt >= 0) raw[ks][d] = *(const u32x4*)(proj + ((size_t)b * TT + tt) * DIN + DH + wid * 64 + 32 * ks + 8 * fq); }
#pragma unroll 1
        for (int m = 0; m < NM; ++m) {
            const int t = t0 + 16 * m + fr; const size_t rowg = (size_t)b * TT + t;
            u32x4 nraw[2][4];
#pragma unroll
            for (int ks = 0; ks < 2; ++ks)
#pragma unroll
                for (int d = 0; d < 4; ++d) { nraw[ks][d] = (u32x4){0u, 0u, 0u, 0u};
                    if (m + 1 < NM) nraw[ks][d] = *(const u32x4*)(proj + ((size_t)b * TT + t + 13 + d) * DIN + DH + wid * 64 + 32 * ks + 8 * fq); }
            float xc[2][8]; bf16x8 frag[2];
#pragma unroll
            for (int ks = 0; ks < 2; ++ks) {
                const int chb = wid * 64 + 32 * ks + 8 * fq;
                { const f32x4 c0 = *(const LAS f32x4*)(cst + 4 * DH + chb), c1 = *(const LAS f32x4*)(cst + 4 * DH + chb + 4);
                  xc[ks][0] = c0.x; xc[ks][1] = c0.y; xc[ks][2] = c0.z; xc[ks][3] = c0.w; xc[ks][4] = c1.x; xc[ks][5] = c1.y; xc[ks][6] = c1.z; xc[ks][7] = c1.w; }
#pragma unroll
                for (int d = 0; d < 4; ++d) {
                    float u[8]; unpack8(raw[ks][d], u);
                    const f32x4 w0 = *(const LAS f32x4*)(cst + d * DH + chb), w1 = *(const LAS f32x4*)(cst + d * DH + chb + 4);
                    xc[ks][0] += u[0] * w0.x; xc[ks][1] += u[1] * w0.y; xc[ks][2] += u[2] * w0.z; xc[ks][3] += u[3] * w0.w;
                    xc[ks][4] += u[4] * w1.x; xc[ks][5] += u[5] * w1.y; xc[ks][6] += u[6] * w1.z; xc[ks][7] += u[7] * w1.w;
                    raw[ks][d] = nraw[ks][d];
                }
                frag[ks] = __builtin_bit_cast(bf16x8, pack8(xc[ks]));
            }
            f32x4 ar[4], ai[4];
#pragma unroll
            for (int n = 0; n < 4; ++n) { ar[n] = (f32x4){0.f, 0.f, 0.f, 0.f}; ai[n] = (f32x4){0.f, 0.f, 0.f, 0.f};
#pragma unroll
                for (int ks = 0; ks < 2; ++ks) {
                    const bf16x8 wr_ = wl[((n * 2 + ks) * 2 + 0) * 64], wi_ = wl[((n * 2 + ks) * 2 + 1) * 64];
                    ar[n] = __builtin_amdgcn_mfma_f32_16x16x32_bf16(wr_, frag[ks], ar[n], 0, 0, 0);
                    ai[n] = __builtin_amdgcn_mfma_f32_16x16x32_bf16(wi_, frag[ks], ai[n], 0, 0, 0);
                } }
            float Aa[16], Bb[16];
#pragma unroll
            for (int n = 0; n < 4; ++n) {
                const int cho = wid * 64 + 32 * (n >> 1) + 8 * fq + 4 * (n & 1);
                const f32x4 rb = *(const LAS f32x4*)(cst + 5 * DH + cho), ib = *(const LAS f32x4*)(cst + 6 * DH + cho), spv = *(const LAS f32x4*)(cst + 7 * DH + cho);
#pragma unroll
                for (int jj = 0; jj < 4; ++jj) {
                    const float r = sigm(ar[n][jj] + rb[jj]), ig = sigm(ai[n][jj] + ib[jj]);
                    const float la = -8.0f * r * spv[jj], a = __expf(la), x2 = 2.0f * la;
                    const float m2s = -x2 * (1.0f + x2 * (0.5f + x2 * (0.16666667f + x2 * 0.041666668f))), m2 = (x2 > -0.0625f) ? m2s : 1.0f - a * a;
                    Aa[n * 4 + jj] = a; Bb[n * 4 + jj] = __builtin_amdgcn_sqrtf(m2) * ig * xc[n >> 1][4 * (n & 1) + jj];
                }
            }
#pragma unroll
            for (int k = 0; k < 16; ++k) {
                float A = Aa[k], B = Bb[k], Ap, Bq;
                Ap = dppf<0x111>(1.f, A); Bq = dppf<0x111>(0.f, B); B = fmaf(A, Bq, B); A *= Ap;
                Ap = dppf<0x112>(1.f, A); Bq = dppf<0x112>(0.f, B); B = fmaf(A, Bq, B); A *= Ap;
                Ap = dppf<0x114>(1.f, A); Bq = dppf<0x114>(0.f, B); B = fmaf(A, Bq, B); A *= Ap;
                Ap = dppf<0x118>(1.f, A); Bq = dppf<0x118>(0.f, B); B = fmaf(A, Bq, B); A *= Ap;
                Bb[k] = fmaf(A, Hc[k], B); Aa[k] = A * Pc[k];
            }
#pragma unroll
            for (int ks = 0; ks < 2; ++ks) {
                const size_t o = rowg * DH + wid * 64 + 32 * ks + 8 * fq;
                { u32x4 wh; wh.x = cvt_pk(Bb[8 * ks + 0], Bb[8 * ks + 1]); wh.y = cvt_pk(Bb[8 * ks + 2], Bb[8 * ks + 3]); wh.z = cvt_pk(Bb[8 * ks + 4], Bb[8 * ks + 5]); wh.w = cvt_pk(Bb[8 * ks + 6], Bb[8 * ks + 7]);
                  *(u32x4*)(hl + o) = wh; }
                u32x4 w; w.x = cvt_pk(Aa[8 * ks + 0], Aa[8 * ks + 1]); w.y = cvt_pk(Aa[8 * ks + 2], Aa[8 * ks + 3]); w.z = cvt_pk(Aa[8 * ks + 4], Aa[8 * ks + 5]); w.w = cvt_pk(Aa[8 * ks + 6], Aa[8 * ks + 7]);
                *(u32x4*)(Pp + o) = w;
            }
            const int src = (lane & 48) | 15;
#pragma unroll
            for (int k = 0; k < 16; ++k) { Hc[k] = __shfl(Bb[k], src); Pc[k] = __shfl(Aa[k], src); }
        }
        if (fr == 0) {
#pragma unroll
            for (int ks = 0; ks < 2; ++ks) {
                const size_t o = (size_t)(b * 128 + c) * DH + wid * 64 + 32 * ks + 8 * fq;
                *(f32x4*)(carA + o) = (f32x4){Pc[8 * ks + 0], Pc[8 * ks + 1], Pc[8 * ks + 2], Pc[8 * ks + 3]}; *(f32x4*)(carA + o + 4) = (f32x4){Pc[8 * ks + 4], Pc[8 * ks + 5], Pc[8 * ks + 6], Pc[8 * ks + 7]};
                *(f32x4*)(carH + o) = (f32x4){Hc[8 * ks + 0], Hc[8 * ks + 1], Hc[8 * ks + 2], Hc[8 * ks + 3]}; *(f32x4*)(carH + o + 4) = (f32x4){Hc[8 * ks + 4], Hc[8 * ks + 5], Hc[8 * ks + 6], Hc[8 * ks + 7]};
            }
        }
    }
    __syncthreads();
}


template <int NMR, bool FROM_LDS> __device__ __forceinline__ void m2_rnn_round(LAS unsigned char* lds, const bf16* hl, const bf16* Pp, const bf16* proj, bf16* Y, LAS float* red1, const float (&cr)[16], int b, int t0, int mbase, int wid, int fr, int fq) {
    u32x4 hw[NMR][2], pw[NMR][2], gw[NMR][2];
#pragma unroll
    for (int m = 0; m < NMR; ++m)
#pragma unroll
        for (int ks = 0; ks < 2; ++ks) { const size_t rowg = (size_t)b * TT + t0 + 16 * (mbase + m) + fr; const int ch = wid * 64 + 32 * ks + 8 * fq; const size_t o = rowg * DH + ch;
            if (FROM_LDS) { const int lane = fq * 16 + fr; hw[m][ks] = *(const LAS u32x4*)(lds + LDS_HL + wid * 8192 + (((mbase + m) * 2 + ks) * 64 + lane) * 16); pw[m][ks] = *(const LAS u32x4*)(lds + LDS_P + wid * 8192 + (((mbase + m) * 2 + ks) * 64 + lane) * 16); }
            else { hw[m][ks] = *(const u32x4*)(hl + o); pw[m][ks] = *(const u32x4*)(Pp + o); } gw[m][ks] = *(const u32x4*)(proj + rowg * DIN + 2 * DH + ch); }
    float y[NMR][16];
#pragma unroll
    for (int m = 0; m < NMR; ++m) { float s = 0.f;
#pragma unroll
        for (int ks = 0; ks < 2; ++ks) { float pf[8], gt[8]; unpack8(pw[m][ks], pf); unpack8(gw[m][ks], gt);
            float hh[8]; unpack8(hw[m][ks], hh);
#pragma unroll
            for (int e = 0; e < 8; ++e) { const float hv = fmaf(pf[e], cr[8 * ks + e], hh[e]), x = gt[e];
                const float ge = x * __builtin_amdgcn_rcpf(1.0f + __expf(-1.5957691216f * (x + 0.044715f * x * x * x)));
                const float yy = hv * ge; y[m][8 * ks + e] = yy; s = fmaf(yy, yy, s); } }
        s += __shfl_xor(s, 16); s += __shfl_xor(s, 32);
        if (fq == 0) red1[(16 * (mbase + m) + fr) * 8 + wid] = s; }
    __syncthreads();
#pragma unroll
    for (int m = 0; m < NMR; ++m) { const size_t rowg = (size_t)b * TT + t0 + 16 * (mbase + m) + fr;
        const f32x4 r0 = *(const LAS f32x4*)(red1 + (16 * (mbase + m) + fr) * 8), r1 = *(const LAS f32x4*)(red1 + (16 * (mbase + m) + fr) * 8 + 4);
        const float rs = __builtin_amdgcn_rsqf((((r0.x + r0.y) + (r0.z + r0.w)) + ((r1.x + r1.y) + (r1.z + r1.w))) * (1.0f / DH) + EPS);
#pragma unroll
        for (int ks = 0; ks < 2; ++ks) { float yy[8];
#pragma unroll
            for (int e = 0; e < 8; ++e) yy[e] = y[m][8 * ks + e] * rs;
            *(u32x4*)(Y + rowg * D + DH + wid * 64 + 32 * ks + 8 * fq) = pack8(yy); } }
}


template <int NMR> __device__ __forceinline__ void m2_pool_round(const bf16* proj, bf16* Y, const bf16* Wp, const float* pbias, const float* pscale, LAS float* red2,
                                                                  int b, int t0, int mbase, int g, int half, int kwin, int wid, int fr, int fq) {
    const int tb = t0 + 16 * mbase;
    bf16x8 pfr[NMR][4];
#pragma unroll
    for (int ks = 0; ks < 4; ++ks) {
        const int chb = g * 128 + 32 * ks + 8 * fq;
        float pu[8], p2[8], p4[8], p8[8];
        if (tb) { const u32x4 raw = *(const u32x4*)(proj + ((size_t)b * TT + tb - 16 + fr) * DIN + chb); unpack8(raw, pu);
#pragma unroll
            for (int e = 0; e < 8; ++e) { p2[e] = pu[e] + dppf<0x111>(0.f, pu[e]); p4[e] = p2[e] + dppf<0x112>(0.f, p2[e]); p8[e] = p4[e] + dppf<0x114>(0.f, p4[e]); } }
        else {
#pragma unroll
            for (int e = 0; e < 8; ++e) { pu[e] = 0.f; p2[e] = 0.f; p4[e] = 0.f; p8[e] = 0.f; } }
#pragma unroll
        for (int m = 0; m < NMR; ++m) {
            const int t = tb + 16 * m + fr; const size_t rowg = (size_t)b * TT + t;
            const u32x4 raw = *(const u32x4*)(proj + rowg * DIN + chb); float u[8], po[8]; unpack8(raw, u);
            const int cnt = (t + 1 < kwin) ? t + 1 : kwin; const float rc = __builtin_amdgcn_rcpf((float)cnt);
#pragma unroll
            for (int e = 0; e < 8; ++e) {
                const float s2 = u[e] + shiftd<1>(u[e], pu[e]), s4 = s2 + shiftd<2>(s2, p2[e]), s8 = s4 + shiftd<4>(s4, p4[e]), s16 = s8 + shiftd<8>(s8, p8[e]);
                const float win = g == 0 ? s2 : (g == 1 ? s4 : (g == 2 ? s8 : s16));
                po[e] = fmaf(win, rc, -u[e]); pu[e] = u[e]; p2[e] = s2; p4[e] = s4; p8[e] = s8;
            }
            pfr[m][ks] = __builtin_bit_cast(bf16x8, pack8(po));
        }
    }
    bf16x8 wfr[4][4];
#pragma unroll
    for (int n = 0; n < 4; ++n)
#pragma unroll
        for (int ks = 0; ks < 4; ++ks) wfr[n][ks] = *(const bf16x8*)(Wp + (size_t)(64 * half + outchan(n, fr)) * 128 + 32 * ks + 8 * fq);
#pragma unroll 1
    for (int pass = 0; pass < 2; ++pass) {
#pragma unroll
        for (int m = 0; m < NMR; ++m) {
            const int t = tb + 16 * m + fr; const size_t rowg = (size_t)b * TT + t; float s = 0.f, rs = 0.f;
            if (pass) { const f32x4 r0 = *(const LAS f32x4*)(red2 + (16 * (mbase + m) + fr) * 8), r1 = *(const LAS f32x4*)(red2 + (16 * (mbase + m) + fr) * 8 + 4);
                rs = __builtin_amdgcn_rsqf((((r0.x + r0.y) + (r0.z + r0.w)) + ((r1.x + r1.y) + (r1.z + r1.w))) * (1.0f / DH) + EPS); }
#pragma unroll
            for (int np = 0; np < 2; ++np) {
                f32x4 o2[2];
#pragma unroll
                for (int nn = 0; nn < 2; ++nn) { const int n = 2 * np + nn;
                    f32x4 acc = {0.f, 0.f, 0.f, 0.f};
#pragma unroll
                    for (int ks = 0; ks < 4; ++ks) acc = __builtin_amdgcn_mfma_f32_16x16x32_bf16(wfr[n][ks], pfr[m][ks], acc, 0, 0, 0);
                    const int col = g * 128 + 64 * half + 32 * np + 8 * fq + 4 * nn;
                    const f32x4 pb = *(const f32x4*)(pbias + col), ps = *(const f32x4*)(pscale + col);
                    acc = (acc + pb) * ps; s += (acc.x * acc.x + acc.y * acc.y) + (acc.z * acc.z + acc.w * acc.w); o2[nn] = acc * rs; }
                if (pass) { u32x4 w; w.x = cvt_pk(o2[0].x, o2[0].y); w.y = cvt_pk(o2[0].z, o2[0].w); w.z = cvt_pk(o2[1].x, o2[1].y); w.w = cvt_pk(o2[1].z, o2[1].w);
                    *(u32x4*)(Y + rowg * D + g * 128 + 64 * half + 32 * np + 8 * fq) = w; }
            }
            if (!pass) { s += __shfl_xor(s, 16); s += __shfl_xor(s, 32); if (fq == 0) red2[(16 * (mbase + m) + fr) * 8 + wid] = s; }
        }
        if (!pass) __syncthreads();
    }
}

__device__ __forceinline__ void m2_phase(const Params& p_, LAS unsigned char* lds, int G, int l) {
    const Params p = launder(p_);
    int tid_ = threadIdx.x; asm volatile("" : "+v"(tid_));
    const int tid = tid_, lane = tid & 63, wid = __builtin_amdgcn_readfirstlane(tid >> 6), fr = lane & 15, fq = lane >> 4;
    LAS float* segA = (LAS float*)lds; LAS float* segH = (LAS float*)(lds + 16384); LAS float* carr = (LAS float*)(lds + 32768);
    LAS float* red1 = (LAS float*)(lds + 34816); LAS float* red2 = (LAS float*)(lds + 37888);
    const bf16* proj = (const bf16*)(p.ws + WS_PROJ); bf16* Y = (bf16*)(p.ws + WS_Y);
    const bf16* hl = (const bf16*)(p.ws + WS_HL); const bf16* Pp = (const bf16*)(p.ws + WS_P);
    const float* carA = (const float*)(p.ws + WS_CARA); const float* carH = (const float*)(p.ws + WS_CARH);
    const int g = wid >> 1, half = wid & 1, kwin = 2 << g;
    const bf16* Wp = (const bf16*)(p.ws + WS_POOLW) + (size_t)(l * 4 + g) * 16384;
    const float* pbias = p.in[5] + l * DH; const float* pscale = p.in[6] + l * DH;
    for (int unit = blockIdx.x; unit < 256; unit += G) {
        const int b = unit >> 7, c = unit & 127, t0 = c ? NMETA + 64 * c : 0, NM = c ? 4 : 5;
        {
            const int q = (c + 7) >> 3, jlo = wid * q, jhi = (jlo + q < c) ? jlo + q : c;
            f32x4 A0 = {1.f, 1.f, 1.f, 1.f}, A1 = A0, H0 = {0.f, 0.f, 0.f, 0.f}, H1 = H0;
            for (int j = jlo; j < jhi; j += 8) {
                f32x4 a0[8], a1[8], h0[8], h1[8];
#pragma unroll
                for (int i = 0; i < 8; ++i) { const int jj = (j + i < jhi) ? j + i : jhi - 1; const size_t o = (size_t)(b * 128 + jj) * DH + 8 * lane;
                    a0[i] = *(const f32x4*)(carA + o); a1[i] = *(const f32x4*)(carA + o + 4); h0[i] = *(const f32x4*)(carH + o); h1[i] = *(const f32x4*)(carH + o + 4); }
#pragma unroll
                for (int i = 0; i < 8; ++i) if (j + i < jhi) { H0 = a0[i] * H0 + h0[i]; A0 = A0 * a0[i]; H1 = a1[i] * H1 + h1[i]; A1 = A1 * a1[i]; }
            }
            *(LAS f32x4*)(segA + wid * DH + 8 * lane) = A0; *(LAS f32x4*)(segA + wid * DH + 8 * lane + 4) = A1;
            *(LAS f32x4*)(segH + wid * DH + 8 * lane) = H0; *(LAS f32x4*)(segH + wid * DH + 8 * lane + 4) = H1;
        }
        __syncthreads();
        { float cy = 0.f;
#pragma unroll
          for (int s8 = 0; s8 < 8; ++s8) cy = segA[s8 * DH + tid] * cy + segH[s8 * DH + tid];
          carr[tid] = cy; }
        __syncthreads();
        {
            float cr[16];
#pragma unroll
            for (int ks = 0; ks < 2; ++ks) { const f32x4 c0 = *(const LAS f32x4*)(carr + wid * 64 + 32 * ks + 8 * fq), c1 = *(const LAS f32x4*)(carr + wid * 64 + 32 * ks + 8 * fq + 4);
                cr[8 * ks + 0] = c0.x; cr[8 * ks + 1] = c0.y; cr[8 * ks + 2] = c0.z; cr[8 * ks + 3] = c0.w; cr[8 * ks + 4] = c1.x; cr[8 * ks + 5] = c1.y; cr[8 * ks + 6] = c1.z; cr[8 * ks + 7] = c1.w; }
            m2_rnn_round<4, false>(lds, hl, Pp, proj, Y, red1, cr, b, t0, 0, wid, fr, fq);
            if (NM == 5) m2_rnn_round<1, false>(lds, hl, Pp, proj, Y, red1, cr, b, t0, 4, wid, fr, fq);
        }
        m2_pool_round<4>(proj, Y, Wp, pbias, pscale, red2, b, t0, 0, g, half, kwin, wid, fr, fq);
        if (NM == 5) m2_pool_round<1>(proj, Y, Wp, pbias, pscale, red2, b, t0, 4, g, half, kwin, wid, fr, fq);
    }
    __syncthreads();
}

__device__ __forceinline__ void final_norm(const Params& p_, int G) {
    const Params p = launder(p_);
    int tid_ = threadIdx.x; asm volatile("" : "+v"(tid_));
    const int tid = tid_, lane = tid & 63, wid = tid >> 6; const int gw = blockIdx.x * 8 + wid, NGW = G * 8;
    const bf16* hb = (const bf16*)(p.ws + WS_HB);
    const f32x4* gp = (const f32x4*)p.in[19] + 2 * lane; f32x4 gg[2][2];
#pragma unroll
    for (int j = 0; j < 2; ++j) { gg[j][0] = gp[128 * j]; gg[j][1] = gp[128 * j + 1]; }
    for (int m = gw; m < M; m += NGW) {
        const u32x4* xr = (const u32x4*)(hb + (size_t)m * D) + lane; float v[2][8]; float s = 0.f;
#pragma unroll
        for (int j = 0; j < 2; ++j) { unpack8(xr[64 * j], v[j]);
#pragma unroll
            for (int e = 0; e < 8; ++e) s = fmaf(v[j][e], v[j][e], s); }
        const float rs = 1.0f / sqrtf(wave_sum(s) * (1.0f / D) + EPS);
        f32x4* orow = (f32x4*)(p.out + (size_t)m * D) + 2 * lane;
#pragma unroll
        for (int j = 0; j < 2; ++j) {
            orow[128 * j] = (f32x4){v[j][0] * rs * gg[j][0].x, v[j][1] * rs * gg[j][0].y, v[j][2] * rs * gg[j][0].z, v[j][3] * rs * gg[j][0].w};
            orow[128 * j + 1] = (f32x4){v[j][4] * rs * gg[j][1].x, v[j][5] * rs * gg[j][1].y, v[j][6] * rs * gg[j][1].z, v[j][7] * rs * gg[j][1].w}; }
    }
}


template <int KW> __device__ __forceinline__ float pool_win(float P, float Sp) {
    float w = P;
    if (KW < 16) w -= dppf<0x110 + (KW & 15)>(0.f, P);
    return w + dppf<0x100 + (17 - KW)>(0.f, Sp);
}
template <int KW, int MAXG> __device__ __forceinline__ void pool_frags(const bf16* proj, bf16x8 (&pfr)[MAXG][4], int b, int tb, int cnt, int g, int fr, int fq) {
#pragma unroll
    for (int ks = 0; ks < 4; ++ks) {
        const int chb = g * 128 + 32 * ks + 8 * fq;
        float Sp[8];
        if (tb) { const u32x4 raw = *(const u32x4*)(proj + ((size_t)b * TT + tb - 16 + fr) * DIN + chb); unpack8(raw, Sp);
#pragma unroll
            for (int e = 0; e < 8; ++e) { Sp[e] += dppf<0x101>(0.f, Sp[e]); Sp[e] += dppf<0x102>(0.f, Sp[e]); Sp[e] += dppf<0x104>(0.f, Sp[e]); Sp[e] += dppf<0x108>(0.f, Sp[e]); } }
        else {
#pragma unroll
            for (int e = 0; e < 8; ++e) Sp[e] = 0.f; }
#pragma unroll
        for (int mi = 0; mi < MAXG; ++mi) if (mi < cnt) {
            const int t = tb + 16 * mi + fr;
            const u32x4 raw = *(const u32x4*)(proj + ((size_t)b * TT + t) * DIN + chb); float u[8], po[8]; unpack8(raw, u);
            const int cn = (t + 1 < KW) ? t + 1 : KW; const float rc = __builtin_amdgcn_rcpf((float)cn);
#pragma unroll
            for (int e = 0; e < 8; ++e) {
                float P = u[e]; P += dppf<0x111>(0.f, P); P += dppf<0x112>(0.f, P); P += dppf<0x114>(0.f, P); P += dppf<0x118>(0.f, P);
                float S = u[e]; S += dppf<0x101>(0.f, S); S += dppf<0x102>(0.f, S); S += dppf<0x104>(0.f, S); S += dppf<0x108>(0.f, S);
                po[e] = fmaf(pool_win<KW>(P, Sp[e]), rc, -u[e]); Sp[e] = S;
            }
            pfr[mi][ks] = __builtin_bit_cast(bf16x8, pack8(po));
        }
    }
}
__device__ __forceinline__ void m2_pool2(const bf16* proj, bf16* Y, const bf16* Wp, const float* pbias, const float* pscale, LAS float* red2, int b, int t0, int NM, int g, int th, int fr, int fq) {
    const int m0 = th ? (NM == 5 ? 3 : 2) : 0, cnt = th ? 2 : (NM == 5 ? 3 : 2), tb = t0 + 16 * m0;
    bf16x8 pfr[3][4];
    switch (g) {
        case 0: pool_frags<2, 3>(proj, pfr, b, tb, cnt, g, fr, fq); break;
        case 1: pool_frags<4, 3>(proj, pfr, b, tb, cnt, g, fr, fq); break;
        case 2: pool_frags<8, 3>(proj, pfr, b, tb, cnt, g, fr, fq); break;
        default: pool_frags<16, 3>(proj, pfr, b, tb, cnt, g, fr, fq); break;
    }
    f32x4 ov[3][8]; float sq[3] = {0.f, 0.f, 0.f};
#pragma unroll
    for (int n = 0; n < 8; ++n) {
        bf16x8 wf[4];
#pragma unroll
        for (int ks = 0; ks < 4; ++ks) wf[ks] = *(const bf16x8*)(Wp + (size_t)outchan(n, fr) * 128 + 32 * ks + 8 * fq);
        const int col = g * 128 + 32 * (n >> 1) + 8 * fq + 4 * (n & 1);
        const f32x4 pb = *(const f32x4*)(pbias + col), ps = *(const f32x4*)(pscale + col);
#pragma unroll
        for (int mi = 0; mi < 3; ++mi) if (mi < cnt) {
            f32x4 acc = {0.f, 0.f, 0.f, 0.f};
#pragma unroll
            for (int ks = 0; ks < 4; ++ks) acc = __builtin_amdgcn_mfma_f32_16x16x32_bf16(wf[ks], pfr[mi][ks], acc, 0, 0, 0);
            acc = (acc + pb) * ps; ov[mi][n] = acc; sq[mi] += (acc.x * acc.x + acc.y * acc.y) + (acc.z * acc.z + acc.w * acc.w);
        }
    }
#pragma unroll
    for (int mi = 0; mi < 3; ++mi) if (mi < cnt) { float s = sq[mi]; s += __shfl_xor(s, 16); s += __shfl_xor(s, 32); if (fq == 0) red2[(16 * (m0 + mi) + fr) * 4 + g] = s; }
    __syncthreads();
#pragma unroll
    for (int mi = 0; mi < 3; ++mi) if (mi < cnt) {
        const size_t rowg = (size_t)b * TT + tb + 16 * mi + fr;
        const f32x4 r0 = *(const LAS f32x4*)(red2 + (16 * (m0 + mi) + fr) * 4);
        const float rs = __builtin_amdgcn_rsqf(((r0.x + r0.y) + (r0.z + r0.w)) * (1.0f / DH) + EPS);
#pragma unroll
        for (int np = 0; np < 4; ++np) {
            const f32x4 a = ov[mi][2 * np] * rs, bq = ov[mi][2 * np + 1] * rs;
            u32x4 w; w.x = cvt_pk(a.x, a.y); w.y = cvt_pk(a.z, a.w); w.z = cvt_pk(bq.x, bq.y); w.w = cvt_pk(bq.z, bq.w);
            *(u32x4*)(Y + rowg * D + g * 128 + 32 * np + 8 * fq) = w;
        }
    }
}

#ifndef PROBE_PHASE
#define PROBE_PHASE (-1)
#endif
#ifndef PROBE_BLOCK
#define PROBE_BLOCK 0
#endif
#define TIC() do { if (PROBE_PHASE >= 0) tic = __builtin_amdgcn_s_memrealtime(); } while (0)
#define TOC(k) do { if (PROBE_PHASE == (k)) tacc += __builtin_amdgcn_s_memrealtime() - tic; } while (0)

__device__ __forceinline__ void mixer_phase(const Params& p_, LAS unsigned char* lds, int G, int l, unsigned long long& tic, unsigned long long& tacc) {
    const Params p = launder(p_);
    int tid_ = threadIdx.x; asm volatile("" : "+v"(tid_));
    const int tid = tid_, lane = tid & 63, wid = __builtin_amdgcn_readfirstlane(tid >> 6), fr = lane & 15, fq = lane >> 4;
    LAS float* cst = (LAS float*)(lds + LDS_CST);
    const bf16* proj = (const bf16*)(p.ws + WS_PROJ);
    const bf16* Wr = (const bf16*)(p.ws + WS_GR) + (size_t)(l * 8 + wid) * 4096; const bf16* Wi = (const bf16*)(p.ws + WS_GI) + (size_t)(l * 8 + wid) * 4096;
    LAS float* segA = (LAS float*)(lds + LDS_CST); LAS float* segH = (LAS float*)(lds + LDS_CST + 8192); LAS float* carr = (LAS float*)(lds + LDS_CARR);
    LAS float* red1 = (LAS float*)(lds + LDS_RED1); LAS float* red2 = (LAS float*)(lds + LDS_RED2);
    bf16* Y = (bf16*)(p.ws + WS_Y);
    const int g = wid >> 1, half = wid & 1, kwin = 2 << g;
    const bf16* Wp = (const bf16*)(p.ws + WS_POOLW) + (size_t)(l * 4 + g) * 16384;
    const float* pbias = p.in[5] + l * DH; const float* pscale = p.in[6] + l * DH;
    unsigned* flags = (unsigned*)(p.ws + WS_FLAG); unsigned* car = (unsigned*)(p.ws + WS_CARA);
    bf16* hl = (bf16*)(p.ws + WS_HL); bf16* Pp = (bf16*)(p.ws + WS_P);
    float* carA = (float*)(p.ws + WS_CARA); float* carH = (float*)(p.ws + WS_CARH);
    const int unit = blockIdx.x;
    if (unit < 256) {
        const int b = unit >> 7, c = unit & 127, t0 = c ? NMETA + 64 * c : 0, NM = c ? 4 : 5;
        TIC();
        float cv[8];
#pragma unroll
        for (int k4 = 0; k4 < 4; ++k4) cv[k4] = p.in[7][(l * 4 + k4) * DH + tid];
        cv[4] = p.in[8][l * DH + tid]; cv[5] = p.in[10][l * DH + tid]; cv[6] = p.in[12][l * DH + tid]; cv[7] = ((const float*)(p.ws + WS_SP))[l * DH + tid];
        bf16x8 wfr[4][2][2];
#pragma unroll
        for (int n = 0; n < 4; ++n)
#pragma unroll
            for (int ks = 0; ks < 2; ++ks) { wfr[n][ks][0] = *(const bf16x8*)(Wr + outchan(n, fr) * 64 + 32 * ks + 8 * fq); wfr[n][ks][1] = *(const bf16x8*)(Wi + outchan(n, fr) * 64 + 32 * ks + 8 * fq); }
        LAS float* cslot = (LAS float*)(lds + LDS_CARRY) + (wid * 4 + fq) * 32;
        if (fr == 15) {
#pragma unroll
            for (int k4 = 0; k4 < 4; ++k4) { *(LAS f32x4*)(cslot + 4 * k4) = (f32x4){0.f, 0.f, 0.f, 0.f}; *(LAS f32x4*)(cslot + 16 + 4 * k4) = (f32x4){1.f, 1.f, 1.f, 1.f}; } }
        u32x4 raw[2][4];
#pragma unroll
        for (int ks = 0; ks < 2; ++ks)
#pragma unroll
            for (int d = 0; d < 4; ++d) { const int tt = t0 + fr - 3 + d; raw[ks][d] = (u32x4){0u, 0u, 0u, 0u};
                if (tt >= 0) raw[ks][d] = *(const u32x4*)(proj + ((size_t)b * TT + tt) * DIN + DH + wid * 64 + 32 * ks + 8 * fq); }
        __syncthreads();
#pragma unroll
        for (int k8 = 0; k8 < 8; ++k8) cst[k8 * DH + tid] = cv[k8];
        __syncthreads();
        TOC(10); TIC();
#pragma unroll 1
        for (int m = 0; m < NM; ++m) {
            const int t = t0 + 16 * m + fr; const size_t rowg = (size_t)b * TT + t;
            u32x4 nraw[2][4];
#pragma unroll
            for (int ks = 0; ks < 2; ++ks)
#pragma unroll
                for (int d = 0; d < 4; ++d) { nraw[ks][d] = (u32x4){0u, 0u, 0u, 0u};
                    if (m + 1 < NM) nraw[ks][d] = *(const u32x4*)(proj + ((size_t)b * TT + t + 13 + d) * DIN + DH + wid * 64 + 32 * ks + 8 * fq); }
            float xc[2][8]; bf16x8 frag[2];
#pragma unroll
            for (int ks = 0; ks < 2; ++ks) {
                const int chb = wid * 64 + 32 * ks + 8 * fq;
                { const f32x4 c0 = *(const LAS f32x4*)(cst + 4 * DH + chb), c1 = *(const LAS f32x4*)(cst + 4 * DH + chb + 4);
                  xc[ks][0] = c0.x; xc[ks][1] = c0.y; xc[ks][2] = c0.z; xc[ks][3] = c0.w; xc[ks][4] = c1.x; xc[ks][5] = c1.y; xc[ks][6] = c1.z; xc[ks][7] = c1.w; }
#pragma unroll
                for (int d = 0; d < 4; ++d) {
                    float u[8]; unpack8(raw[ks][d], u);
                    const f32x4 w0 = *(const LAS f32x4*)(cst + d * DH + chb), w1 = *(const LAS f32x4*)(cst + d * DH + chb + 4);
                    xc[ks][0] += u[0] * w0.x; xc[ks][1] += u[1] * w0.y; xc[ks][2] += u[2] * w0.z; xc[ks][3] += u[3] * w0.w;
                    xc[ks][4] += u[4] * w1.x; xc[ks][5] += u[5] * w1.y; xc[ks][6] += u[6] * w1.z; xc[ks][7] += u[7] * w1.w;
                    raw[ks][d] = nraw[ks][d];
                }
                frag[ks] = __builtin_bit_cast(bf16x8, pack8(xc[ks]));
            }
            f32x4 ar[4], ai[4];
#pragma unroll
            for (int n = 0; n < 4; ++n) { ar[n] = (f32x4){0.f, 0.f, 0.f, 0.f}; ai[n] = (f32x4){0.f, 0.f, 0.f, 0.f};
#pragma unroll
                for (int ks = 0; ks < 2; ++ks) {
                    const bf16x8 wr_ = wfr[n][ks][0], wi_ = wfr[n][ks][1];
                    ar[n] = __builtin_amdgcn_mfma_f32_16x16x32_bf16(wr_, frag[ks], ar[n], 0, 0, 0);
                    ai[n] = __builtin_amdgcn_mfma_f32_16x16x32_bf16(wi_, frag[ks], ai[n], 0, 0, 0);
                } }
            float Aa[16], Bb[16];
#pragma unroll
            for (int n = 0; n < 4; ++n) {
                const int cho = wid * 64 + 32 * (n >> 1) + 8 * fq + 4 * (n & 1);
                const f32x4 rb = *(const LAS f32x4*)(cst + 5 * DH + cho), ib = *(const LAS f32x4*)(cst + 6 * DH + cho), spv = *(const LAS f32x4*)(cst + 7 * DH + cho);
#pragma unroll
                for (int jj = 0; jj < 4; ++jj) {
                    const float r = sigm(ar[n][jj] + rb[jj]), ig = sigm(ai[n][jj] + ib[jj]);
                    const float la = -8.0f * r * spv[jj], a = __expf(la), x2 = 2.0f * la;
                    const float m2s = -x2 * (1.0f + x2 * (0.5f + x2 * (0.16666667f + x2 * 0.041666668f))), m2 = (x2 > -0.0625f) ? m2s : 1.0f - a * a;
                    Aa[n * 4 + jj] = a; Bb[n * 4 + jj] = __builtin_amdgcn_sqrtf(m2) * ig * xc[n >> 1][4 * (n & 1) + jj];
                }
            }
#pragma unroll
            for (int k = 0; k < 16; ++k) {
                float A = Aa[k], B = Bb[k], Ap, Bq;
                Ap = dppf<0x111>(1.f, A); Bq = dppf<0x111>(0.f, B); B = fmaf(A, Bq, B); A *= Ap;
                Ap = dppf<0x112>(1.f, A); Bq = dppf<0x112>(0.f, B); B = fmaf(A, Bq, B); A *= Ap;
                Ap = dppf<0x114>(1.f, A); Bq = dppf<0x114>(0.f, B); B = fmaf(A, Bq, B); A *= Ap;
                Ap = dppf<0x118>(1.f, A); Bq = dppf<0x118>(0.f, B); B = fmaf(A, Bq, B); A *= Ap;
                Bb[k] = B; Aa[k] = A;
            }
            {
                float Hc[16], Pc[16];
#pragma unroll
                for (int k4 = 0; k4 < 4; ++k4) { const f32x4 hq = *(const LAS f32x4*)(cslot + 4 * k4), pq = *(const LAS f32x4*)(cslot + 16 + 4 * k4);
                    Hc[4 * k4] = hq.x; Hc[4 * k4 + 1] = hq.y; Hc[4 * k4 + 2] = hq.z; Hc[4 * k4 + 3] = hq.w; Pc[4 * k4] = pq.x; Pc[4 * k4 + 1] = pq.y; Pc[4 * k4 + 2] = pq.z; Pc[4 * k4 + 3] = pq.w; }
#pragma unroll
                for (int k = 0; k < 16; ++k) { Bb[k] = fmaf(Aa[k], Hc[k], Bb[k]); Aa[k] *= Pc[k]; }
                if (fr == 15) {
#pragma unroll
                    for (int k4 = 0; k4 < 4; ++k4) { *(LAS f32x4*)(cslot + 4 * k4) = (f32x4){Bb[4 * k4], Bb[4 * k4 + 1], Bb[4 * k4 + 2], Bb[4 * k4 + 3]}; *(LAS f32x4*)(cslot + 16 + 4 * k4) = (f32x4){Aa[4 * k4], Aa[4 * k4 + 1], Aa[4 * k4 + 2], Aa[4 * k4 + 3]}; } }
            }
#pragma unroll
            for (int ks = 0; ks < 2; ++ks) {
                const size_t o = rowg * DH + wid * 64 + 32 * ks + 8 * fq;
                u32x4 wh; wh.x = cvt_pk(Bb[8 * ks + 0], Bb[8 * ks + 1]); wh.y = cvt_pk(Bb[8 * ks + 2], Bb[8 * ks + 3]); wh.z = cvt_pk(Bb[8 * ks + 4], Bb[8 * ks + 5]); wh.w = cvt_pk(Bb[8 * ks + 6], Bb[8 * ks + 7]);
                u32x4 w; w.x = cvt_pk(Aa[8 * ks + 0], Aa[8 * ks + 1]); w.y = cvt_pk(Aa[8 * ks + 2], Aa[8 * ks + 3]); w.z = cvt_pk(Aa[8 * ks + 4], Aa[8 * ks + 5]); w.w = cvt_pk(Aa[8 * ks + 6], Aa[8 * ks + 7]);
                if (m < 4) { *(LAS u32x4*)(lds + LDS_HL + wid * 8192 + ((m * 2 + ks) * 64 + lane) * 16) = wh; *(LAS u32x4*)(lds + LDS_P + wid * 8192 + ((m * 2 + ks) * 64 + lane) * 16) = w; }
                else { *(u32x4*)(hl + o) = wh; *(u32x4*)(Pp + o) = w; }
            }
        }
        TOC(11); TIC();
        if (fr == 0) {
            float Hc[16], Pc[16];
#pragma unroll
            for (int k4 = 0; k4 < 4; ++k4) { const f32x4 hq = *(const LAS f32x4*)(cslot + 4 * k4), pq = *(const LAS f32x4*)(cslot + 16 + 4 * k4);
                Hc[4 * k4] = hq.x; Hc[4 * k4 + 1] = hq.y; Hc[4 * k4 + 2] = hq.z; Hc[4 * k4 + 3] = hq.w; Pc[4 * k4] = pq.x; Pc[4 * k4 + 1] = pq.y; Pc[4 * k4 + 2] = pq.z; Pc[4 * k4 + 3] = pq.w; }
#pragma unroll
            for (int ks = 0; ks < 2; ++ks) {
                const size_t o = (size_t)(b * 128 + c) * DH + wid * 64 + 32 * ks + 8 * fq;
#pragma unroll
                for (int e2 = 0; e2 < 4; ++e2) {
                    const unsigned lo = cvt_pk(Pc[8 * ks + 2 * e2], Hc[8 * ks + 2 * e2]), hi = cvt_pk(Pc[8 * ks + 2 * e2 + 1], Hc[8 * ks + 2 * e2 + 1]);
                    __hip_atomic_store((unsigned long long*)(car + o) + e2, ((unsigned long long)hi << 32) | lo, __ATOMIC_RELAXED, __HIP_MEMORY_SCOPE_AGENT); }
            }
        }
        int fr2 = fr, fq2 = fq, tid2 = tid; asm volatile("" : "+v"(fr2), "+v"(fq2), "+v"(tid2));
        TOC(12); TIC();
#ifndef NO_MX_POOL
        m2_pool2(proj, Y, Wp, pbias, pscale, red2, b, t0, NM, g, half, fr2, fq2);
#endif
        asm volatile("s_waitcnt vmcnt(0)" ::: "memory");
        __syncthreads();
        if (tid2 == 0) __hip_atomic_store(flags + unit, (unsigned)(l + 1), __ATOMIC_RELAXED, __HIP_MEMORY_SCOPE_AGENT);
        TOC(13); TIC();
        if (tid2 < c) { unsigned sp = 0; while (__hip_atomic_load(flags + b * 128 + tid2, __ATOMIC_RELAXED, __HIP_MEMORY_SCOPE_AGENT) < (unsigned)(l + 1)) { __builtin_amdgcn_s_sleep(2); if (++sp > (1u << 22)) break; } }
#if defined(MIXER_ACQ_FENCE)
        if (tid2 < c) __builtin_amdgcn_fence(__ATOMIC_ACQUIRE, "agent");
#endif
        __syncthreads();
        TOC(14); TIC();
        {
            const int q = (c + 3) >> 2, seg = tid2 >> 7, cgi = tid2 & 127, jlo = seg * q, jhi = (jlo + q < c) ? jlo + q : c;
            f32x4 A0 = {1.f, 1.f, 1.f, 1.f}, H0 = {0.f, 0.f, 0.f, 0.f};
            for (int j = jlo; j < jhi; j += 16) {
                unsigned long long w0[16], w1[16];
#pragma unroll
                for (int i = 0; i < 16; ++i) { const int jj = (j + i < jhi) ? j + i : jhi - 1; const size_t o = (size_t)(b * 128 + jj) * DH + 4 * cgi;
                    w0[i] = __hip_atomic_load((const unsigned long long*)(car + o), __ATOMIC_RELAXED, __HIP_MEMORY_SCOPE_AGENT); w1[i] = __hip_atomic_load((const unsigned long long*)(car + o) + 1, __ATOMIC_RELAXED, __HIP_MEMORY_SCOPE_AGENT); }
#pragma unroll
                for (int i = 0; i < 16; ++i) if (j + i < jhi) {
                    const f32x4 a = {bf_lo((unsigned)w0[i]), bf_lo((unsigned)(w0[i] >> 32)), bf_lo((unsigned)w1[i]), bf_lo((unsigned)(w1[i] >> 32))};
                    const f32x4 h = {bf_hi((unsigned)w0[i]), bf_hi((unsigned)(w0[i] >> 32)), bf_hi((unsigned)w1[i]), bf_hi((unsigned)(w1[i] >> 32))};
                    H0 = a * H0 + h; A0 = A0 * a; }
            }
            *(LAS f32x4*)(segA + seg * DH + 4 * cgi) = A0; *(LAS f32x4*)(segH + seg * DH + 4 * cgi) = H0;
        }
        __syncthreads();
        { float cy = 0.f;
#pragma unroll
          for (int s4 = 0; s4 < 4; ++s4) cy = segA[s4 * DH + tid2] * cy + segH[s4 * DH + tid2];
          carr[tid2] = cy; }
        __syncthreads();
        TOC(15); TIC();
        {
            float cr[16];
#pragma unroll
            for (int ks = 0; ks < 2; ++ks) { const f32x4 c0 = *(const LAS f32x4*)(carr + wid * 64 + 32 * ks + 8 * fq2), c1 = *(const LAS f32x4*)(carr + wid * 64 + 32 * ks + 8 * fq2 + 4);
                cr[8 * ks + 0] = c0.x; cr[8 * ks + 1] = c0.y; cr[8 * ks + 2] = c0.z; cr[8 * ks + 3] = c0.w; cr[8 * ks + 4] = c1.x; cr[8 * ks + 5] = c1.y; cr[8 * ks + 6] = c1.z; cr[8 * ks + 7] = c1.w; }
#ifndef NO_MX_RNN
            m2_rnn_round<4, true>(lds, hl, Pp, proj, Y, red1, cr, b, t0, 0, wid, fr2, fq2);
            if (NM == 5) m2_rnn_round<1, false>(lds, hl, Pp, proj, Y, red1, cr, b, t0, 4, wid, fr2, fq2);
#endif
        }
        TOC(16);
    }
    __syncthreads();
}

#define XB_TMO      128
#define XB_XCNT(j)  (256  + 64 * (j))
#define XB_XSUB(j)  (1280 + 64 * (j))
#define XB_XGEN(j)  (2304 + 64 * (j))
#define XB_TOP      3328
#define XB_TOPGEN   3392
#define XCD_BAR_WORDS 3456
#define XB_SPIN_CAP (1u << 18)

__device__ __forceinline__ unsigned xb_ld(unsigned* p)              { return __hip_atomic_load(p, __ATOMIC_RELAXED, __HIP_MEMORY_SCOPE_AGENT); }
__device__ __forceinline__ unsigned xb_add(unsigned* p, unsigned v) { return __hip_atomic_fetch_add(p, v, __ATOMIC_RELAXED, __HIP_MEMORY_SCOPE_AGENT); }
__device__ __forceinline__ unsigned xb_xcc_id() { return (unsigned)__builtin_amdgcn_s_getreg((3 << 11) | 20) & 0xFu; }
#define XB_SPIN(cond, bar) do { unsigned _sp = 0; while (cond) { __builtin_amdgcn_s_sleep(1); \
    if ((++_sp & 255u) == 0u) { if (xb_ld(&(bar)[XB_TMO])) break; if (_sp > XB_SPIN_CAP) { atomicAdd(&(bar)[XB_TMO], 1u); break; } } } } while (0)

struct XcdBarrier {
    unsigned* bar; unsigned x;
    volatile LAS unsigned* st;
};

__device__ __forceinline__ XcdBarrier xcd_barrier_post(unsigned* bar, volatile LAS unsigned* st) {
    XcdBarrier b; b.bar = bar; b.x = xb_xcc_id(); b.st = st;
    if (threadIdx.x == 0) (void)xb_add(&bar[XB_XCNT(b.x)], 1u);
    return b;
}
__device__ __forceinline__ void xcd_barrier_complete(unsigned* bar, unsigned x, unsigned& nloc, unsigned& nx) {
    const unsigned G = gridDim.x * gridDim.y * gridDim.z;
    unsigned sum, cnt, mine, sp = 0u;
    for (;;) {
        sum = 0u; cnt = 0u; mine = 0u;
#pragma unroll
        for (unsigned j = 0; j < 16; ++j) { const unsigned c = xb_ld(&bar[XB_XCNT(j)]); sum += c; cnt += (c > 0u) ? 1u : 0u; mine = (j == x) ? c : mine; }
        if (sum == G) break;
        __builtin_amdgcn_s_sleep(1);
        if ((++sp & 255u) == 0u) { if (xb_ld(&bar[XB_TMO])) break; if (sp > XB_SPIN_CAP) { atomicAdd(&bar[XB_TMO], 1u); break; } }
    }
    nloc = mine > 0u ? mine : 1u; nx = cnt > 0u ? cnt : 1u;
}

__device__ __forceinline__ void xcd_barrier(const XcdBarrier& b) {
    asm volatile("s_waitcnt vmcnt(0)" ::: "memory");
    __syncthreads();
    if (threadIdx.x == 0) {
        unsigned* bar = b.bar;
        __builtin_amdgcn_s_waitcnt(0);
        unsigned nloc = b.st[0], nx = b.st[1];
        if (nloc == 0u) { xcd_barrier_complete(bar, b.x, nloc, nx); b.st[0] = nloc; b.st[1] = nx; }
        const unsigned old = xb_add(&bar[XB_XSUB(b.x)], 1u);
        const unsigned gen = old / nloc;
        if (old + 1u == (gen + 1u) * nloc) {
            __builtin_amdgcn_fence(__ATOMIC_RELEASE, "agent");
            asm volatile("s_waitcnt vmcnt(0)" ::: "memory");
            const unsigned og = xb_add(&bar[XB_TOP], 1u);
            const unsigned tg = og / nx;
            if (og + 1u == (tg + 1u) * nx) xb_add(&bar[XB_TOPGEN], 1u);
            else XB_SPIN(xb_ld(&bar[XB_TOPGEN]) == tg, bar);
            __builtin_amdgcn_fence(__ATOMIC_ACQUIRE, "agent");
            asm volatile("s_waitcnt vmcnt(0)" ::: "memory");
        } else {
            XB_SPIN(xb_ld(&bar[XB_TOPGEN]) == gen, bar);
            __builtin_amdgcn_fence(__ATOMIC_ACQUIRE, "agent");
            asm volatile("s_waitcnt vmcnt(0)" ::: "memory");
        }
    }
    __syncthreads();
}

#ifndef PROBE_SYNC2
#define PROBE_SYNC2 0
#endif
#ifndef PROBE_M1X2
#define PROBE_M1X2 0
#endif
#ifndef PROBE_M2X2
#define PROBE_M2X2 0
#endif
#define GSYNC() do { { __attribute__((address_space(1))) unsigned* gb_ = (__attribute__((address_space(1))) unsigned*)xbar.bar; asm volatile("" : "+s"(gb_)); xbar.bar = (unsigned*)gb_; asm volatile("" : "+s"(xbar.x)); } xcd_barrier(xbar); if (PROBE_SYNC2) xcd_barrier(xbar); } while (0)
__device__ __forceinline__ int rstd_cache(LAS unsigned char* lds, const float* ss, const pg8::StaticOrder& S) {
    pg8::Unit u0; int pmc = -1;
    int tid = threadIdx.x; asm volatile("" : "+v"(tid));
    if (S.next(0, u0)) { pmc = u0.pm; if (tid < 256) ((LAS float*)(lds + 131072))[tid] = row_rstd(ss, u0.pm * 256 + tid); }
    asm volatile("s_waitcnt vmcnt(0) lgkmcnt(0)" ::: "memory");
    return pmc;
}
__global__ void __launch_bounds__(512, 2) fwd_megakernel(Params p) {
    extern __shared__ __attribute__((aligned(16))) unsigned char lds_raw[];
    LAS unsigned char* lds = (LAS unsigned char*)lds_raw;
    cg::grid_group grid = cg::this_grid();
    const int G = gridDim.x;
    unsigned long long tic = 0, tacc = 0;
    unsigned char* ws = p.ws;
    volatile LAS unsigned* xst = (volatile LAS unsigned*)(lds + LDS_XST);
    if (threadIdx.x < 2) xst[threadIdx.x] = 0u;
    __syncthreads();
    XcdBarrier xbar = xcd_barrier_post((unsigned*)(ws + WS_CTL), xst);
    bf16* hb = (bf16*)(ws + WS_HB); bf16* proj = (bf16*)(ws + WS_PROJ); bf16* Y = (bf16*)(ws + WS_Y); bf16* mid = (bf16*)(ws + WS_MID); float* ss = (float*)(ws + WS_SS);
    grid.sync();
    TIC();
#ifndef NO_PRO
    prologue(p, lds, G);
#endif
    GSYNC();
    TOC(0);
#pragma unroll 1
    for (int l = 0; l < DEPTH; ++l) {
        { __attribute__((address_space(1))) unsigned char* gws = (__attribute__((address_space(1))) unsigned char*)ws; asm volatile("" : "+s"(gws)); ws = (unsigned char*)gws; }
        const unsigned char* wl = ws + WS_W + (size_t)l * W_LAYER;
        const bf16* in_t = (const bf16*)(wl + W_IN); const bf16* out_t = (const bf16*)(wl + W_OUT); const bf16* up_t = (const bf16*)(wl + W_UP); const bf16* down_t = (const bf16*)(wl + W_DOWN);
        TIC();
#ifndef NO_GIN
        { pg8::Gemm g{hb, in_t, M, DIN, D, 0}; pg8::StaticOrder S; S.init(M, DIN, G, (int)blockIdx.x); const int pmc = rstd_cache(lds, ss, S); EpiIn E{proj, ss, (const LAS float*)(lds + 131072), pmc};
          pg8::gemm_phase<EpiIn, pg8::StaticOrder, true, true>(lds, g, S, E); }
#endif
#ifndef NO_META
        meta_tasks<0>(p, lds, G, nullptr, 0, in_t, D, DIN / 16);
#endif
        if (G == 256 && l + 1 < DEPTH && blockIdx.x >= 128)
            convert_items(p, lds, (l + 1) * TITEMS_PER_LAYER, (l + 2) * TITEMS_PER_LAYER, (int)blockIdx.x - 128, 128 * 8);
        GSYNC();
        TOC(1); TIC();
#ifndef FUSED_MIXER
#define FUSED_MIXER 1
#endif
#if FUSED_MIXER
        mixer_phase(p, lds, G, l, tic, tacc);
        GSYNC();
        TOC(2);
#else
        m1_phase(p, lds, G, l);
        GSYNC();
        TOC(2); TIC();
        m2_phase(p, lds, G, l);
        GSYNC();
#endif
        TOC(3); TIC();
#ifndef NO_GOUT
        { pg8::Gemm g{Y, out_t, M, D, D, NMETA}; pg8::StaticOrder S; S.init(M, D, G, (int)blockIdx.x); EpiRes E{hb, ss};
          pg8::gemm_phase<EpiRes, pg8::StaticOrder, false, true>(lds, g, S, E); }
#endif
#ifndef NO_META
        if (l < DEPTH - 1) meta_tasks<1>(p, lds, G, Y, D, out_t, D, D / 16);
#endif
        GSYNC();
        TOC(4); TIC();
#ifndef NO_GUP
#ifndef STAGGER_UP
#define STAGGER_UP 0
#endif
        if (STAGGER_UP > 0) {
            const unsigned long long w0 = __builtin_amdgcn_s_memrealtime(), dl = (unsigned long long)(((blockIdx.x >> 3) & 3) * STAGGER_UP);
            while (__builtin_amdgcn_s_memrealtime() - w0 < dl) __builtin_amdgcn_s_sleep(4);
        }
        { pg8::Gemm g{hb, up_t, M, FF, D, 0}; pg8::StaticOrder S; S.init(M, FF, G, (int)blockIdx.x); const int pmc = rstd_cache(lds, ss, S); EpiUp E{mid, ss, (const LAS float*)(lds + 131072), pmc};
          pg8::gemm_phase<EpiUp, pg8::StaticOrder, true, true>(lds, g, S, E); }
#endif
#ifndef NO_META
        if (l < DEPTH - 1) meta_tasks<2>(p, lds, G, nullptr, 0, up_t, D, FF / 16);
#endif
        GSYNC();
        TOC(5); TIC();
#ifndef NO_GDN
        { pg8::Gemm g{mid, down_t, M, D, FF, 0}; pg8::StaticOrder S; S.init(M, D, G, (int)blockIdx.x); EpiRes E{hb, ss};
          pg8::gemm_phase<EpiRes, pg8::StaticOrder, false, true>(lds, g, S, E); }
#endif
#ifndef NO_META
        if (l < DEPTH - 1) meta_tasks<1, 16>(p, lds, G, (const bf16*)(ws + WS_MIDMETA), FF, down_t, FF, D / 16);
#endif
        GSYNC();
        TOC(6);
    }
    TIC();
    final_norm(p, G);
    TOC(7);
    if (PROBE_PHASE >= 0 && blockIdx.x == PROBE_BLOCK && threadIdx.x == 0) { const unsigned long long w0 = __builtin_amdgcn_s_memrealtime(); while (__builtin_amdgcn_s_memrealtime() - w0 < 4ull * tacc) __builtin_amdgcn_s_sleep(8); }
}

extern "C" void kernel_launch(void* const* d_in, const int* in_sizes, int n_in, void* d_out, int out_size, void* d_ws, size_t ws_size, hipStream_t stream) {
    static int grid = 0;
    if (grid == 0) {
        if (n_in != 20 || in_sizes[0] != M * D || out_size != M * D || ws_size < WS_END) { fprintf(stderr, "kernel_launch: unexpected shapes (n_in %d, in0 %d, out %d, ws %zu)\n", n_in, n_in > 0 ? in_sizes[0] : -1, out_size, ws_size); grid = -1; return; }
        int dev = 0, cus = 0, per_cu = 0;
        if (hipGetDevice(&dev) != hipSuccess || hipDeviceGetAttribute(&cus, hipDeviceAttributeMultiprocessorCount, dev) != hipSuccess) { grid = -1; return; }
        if (hipFuncSetAttribute((const void*)fwd_megakernel, hipFuncAttributeMaxDynamicSharedMemorySize, LDS_BYTES) != hipSuccess) { fprintf(stderr, "kernel_launch: hipFuncSetAttribute failed\n"); grid = -1; return; }
        if (hipOccupancyMaxActiveBlocksPerMultiprocessor(&per_cu, (const void*)fwd_megakernel, 512, LDS_BYTES) != hipSuccess || per_cu < 1) { fprintf(stderr, "kernel_launch: occupancy query gave %d\n", per_cu); (void)hipGetLastError(); grid = -1; return; }
        grid = cus * 1;
        if (grid < 256) { fprintf(stderr, "kernel_launch: %d CUs; the fused mixer phase needs 256 resident workgroups\n", cus); grid = -1; return; }
    }
    if (grid < 0) return;
    if (hipMemsetAsync((char*)d_ws + WS_CTL, 0, WS_FLAG + 256 * 4, stream) != hipSuccess) { fprintf(stderr, "kernel_launch: memset failed\n"); return; }
    Params p{};
    for (int i = 0; i < 20; ++i) p.in[i] = (const float*)d_in[i];
    p.out = (float*)d_out; p.ws = (unsigned char*)d_ws;
    void* args[] = {&p};
    hipError_t e = hipLaunchCooperativeKernel((const void*)fwd_megakernel, dim3(grid), dim3(512), args, LDS_BYTES, stream);
    if (e != hipSuccess) fprintf(stderr, "cooperative launch failed: %s (grid %d)\n", hipGetErrorString(e), grid);
}
```

```cpp
#include <hip/hip_runtime.h>
#include <hip/hip_cooperative_groups.h>
#include <cstdio>
#include <cstdint>
namespace cg = cooperative_groups;
namespace pg8 {
#define PG8_LAS __attribute__((address_space(3)))
typedef unsigned short bf16_t;
typedef short bf16x8 __attribute__((ext_vector_type(8)));
typedef float f32x4 __attribute__((ext_vector_type(4)));
typedef unsigned u32x4 __attribute__((ext_vector_type(4)));
constexpr int BM = 256, BK = 64, HALF = 128, HTB = HALF * BK * 2  , STAGE_BYTES = 8 * HTB, NXCD = 8, WGM = 8;

__host__ __device__ __forceinline__ int lds_byte(int r, int c) { const int st = (r >> 4) * 2 + (c >> 5), rr = r & 15, cc = c & 31, ob = rr * 64 + cc * 2; return st * 1024 + (ob ^ (((ob >> 9) & 1) << 5)); }
__host__ __device__ __forceinline__ void stage_rc(int b, int& R, int& C) { const int st = b / 1024, sb = b % 1024, swz = sb ^ (((sb >> 9) & 1) << 5); R = (st >> 1) * 16 + swz / 64; C = (st & 1) * 32 + (swz % 64) / 2; }
__host__ __device__ __forceinline__ int perm32(int rho) { const int n = rho >> 4, i = rho & 15; return 8 * (i >> 2) + 4 * n + (i & 3); }

struct Unit { int pm, pn; };
struct Gemm { const bf16_t* A; const bf16_t* Bt; int M, N, K, gap; };

struct StaticOrder {
    int nM, nN, nwg, G, c;
    __host__ __device__ void init(int M, int N, int G_, int c_) { nM = M / BM; nN = N / BM; nwg = nM * nN; G = G_; c = c_; }
    __host__ __device__ bool next(int i, Unit& u) const {
        const long L = (long)i * G + c; if (L >= nwg) return false;
        int wgid = (int)L; { const int q = nwg / NXCD, r = nwg % NXCD, xcd = wgid % NXCD, off = wgid / NXCD; wgid = (xcd < r ? xcd * (q + 1) : r * (q + 1) + (xcd - r) * q) + off; }
        const int nig = WGM * nN, gid = wgid / nig, fm = gid * WGM, gsz = (nM - fm) < WGM ? (nM - fm) : WGM;
        u.pm = fm + ((wgid % nig) % gsz); u.pn = (wgid % nig) / gsz; return true;
    }
    __device__ __forceinline__ void a_ready(const Unit&) const {}
    __device__ __forceinline__ void done(const Unit&) const {}
};
__device__ __forceinline__ unsigned cvt_pk_bf16(float lo, float hi) { unsigned r; asm volatile("v_cvt_pk_bf16_f32 %0, %1, %2" : "=v"(r) : "v"(lo), "v"(hi)); return r; }
template <class Epi, class Sched, bool ALIGN_EPI = false, bool SP2 = false>
__device__ __forceinline__ void gemm_phase(PG8_LAS unsigned char* lds, const Gemm g, const Sched& S, const Epi& E) {
    int tid_ = threadIdx.x; asm volatile("" : "+v"(tid_));
    const int tid = tid_, wid = __builtin_amdgcn_readfirstlane(tid >> 6), lane = tid & 63, wr = wid >> 2, wc = wid & 3, fr = lane & 15, fq = lane >> 4;
    const int K = g.K, nt = K / BK;
    unsigned voffA[2], voffB[2];
#pragma unroll
    for (int i = 0; i < 2; ++i) { int R, C; stage_rc(tid * 16 + i * 8192, R, C); const int Rb = Epi::PERM ? ((R & ~31) + perm32(R & 31)) : R;
        voffA[i] = (unsigned)(R * K + C) * 2u; voffB[i] = (unsigned)(Rb * K + C) * 2u; }
    const size_t kstep = (size_t)(BK * 2);
    const size_t hstep = (size_t)HALF * K * 2;
    const size_t tstep = 2 * hstep;
    const int agap = g.gap;
#define a_off(pm_) ((size_t)((pm_) * BM + agap * (1 + ((pm_) >> 5))) * (size_t)K * 2)
    const unsigned ldsw = (unsigned)wid * 1024u;
    const int aoff = lds_byte(wr * 64 + fr, fq * 8), boff = lds_byte(wc * 32 + fr, fq * 8);
#define PG8_SA(b, h) (((b) * 2 + (h)) * HTB)
#define PG8_SB(b, h) ((4 + (b) * 2 + (h)) * HTB)
#define PG8_STAGE(bufoff, gbase, voff) do { _Pragma("unroll") for (int _i = 0; _i < 2; ++_i) \
        __builtin_amdgcn_global_load_lds((const unsigned*)((const char*)(gbase) + (voff)[_i]), (PG8_LAS unsigned*)(lds + (bufoff) + ldsw + _i * 8192), 16, 0, 0); } while (0)
#define PG8_LDA(dst, b, h) do { _Pragma("unroll") for (int m = 0; m < 4; ++m) _Pragma("unroll") for (int k = 0; k < 2; ++k) dst[m][k] = *(const PG8_LAS bf16x8*)(lds + PG8_SA(b, h) + aoff + m * 2048 + k * 1024); } while (0)
#define PG8_LDB(dst, b, h) do { _Pragma("unroll") for (int n = 0; n < 2; ++n) _Pragma("unroll") for (int k = 0; k < 2; ++k) dst[n][k] = *(const PG8_LAS bf16x8*)(lds + PG8_SB(b, h) + boff + n * 2048 + k * 1024); } while (0)
#define PG8_MMA(ai, bj, At, Bt) do { __builtin_amdgcn_s_setprio(1); _Pragma("unroll") for (int m = 0; m < 4; ++m) _Pragma("unroll") for (int n = 0; n < 2; ++n) _Pragma("unroll") for (int k = 0; k < 2; ++k) \
        acc[ai][bj][m][n] = __builtin_amdgcn_mfma_f32_16x16x32_bf16(Bt[n][k], At[m][k], acc[ai][bj][m][n], 0, 0, 0); __builtin_amdgcn_s_setprio(0); } while (0)
#define PG8_WAIT_V(n) asm volatile("s_waitcnt vmcnt(" #n ")" ::: "memory")
#define PG8_WAIT_L(n) asm volatile("s_waitcnt lgkmcnt(" #n ")" ::: "memory")
#define PG8_BAR __builtin_amdgcn_s_barrier()
#define PG8_SCHED __builtin_amdgcn_sched_barrier(0)
    Unit cur, nxt; int ui = 0;
    if (!S.next(0, cur)) return;
    f32x4 acc[2][2][4][2];
#pragma unroll
    for (int a = 0; a < 2; ++a)
#pragma unroll
        for (int b = 0; b < 2; ++b)
#pragma unroll
            for (int m = 0; m < 4; ++m)
#pragma unroll
                for (int n = 0; n < 2; ++n) acc[a][b][m][n] = (f32x4){0.f, 0.f, 0.f, 0.f};
    if constexpr (Epi::PRELOAD) E.preload(acc, cur, wr, wc, fr, fq);
    bf16x8 At[4][2], B0[2][2], B1[2][2];
    const char* cA = (const char*)g.A + a_off(cur.pm); const char* cB = (const char*)g.Bt + (size_t)cur.pn * tstep;
    S.a_ready(cur);
    if constexpr (SP2) {
        PG8_STAGE(PG8_SB(0, 0), cB, voffB); PG8_STAGE(PG8_SB(0, 1), cB + hstep, voffB); PG8_STAGE(PG8_SA(0, 0), cA, voffA); PG8_STAGE(PG8_SA(0, 1), cA + hstep, voffA);
        if (wr == 1) PG8_BAR;
        PG8_WAIT_V(2); PG8_BAR;
        PG8_STAGE(PG8_SB(1, 0), cB + kstep, voffB); PG8_STAGE(PG8_SA(1, 0), cA + kstep, voffA); PG8_STAGE(PG8_SB(1, 1), cB + hstep + kstep, voffB);
        PG8_WAIT_V(6); PG8_BAR;
    } else {
        PG8_STAGE(PG8_SB(0, 0), cB, voffB); PG8_STAGE(PG8_SA(0, 0), cA, voffA); PG8_STAGE(PG8_SB(0, 1), cB + hstep, voffB); PG8_STAGE(PG8_SA(0, 1), cA + hstep, voffA);
        if (wr == 1) PG8_BAR;
        PG8_WAIT_V(4); PG8_BAR;
        PG8_STAGE(PG8_SB(1, 0), cB + kstep, voffB); PG8_STAGE(PG8_SA(1, 0), cA + kstep, voffA); PG8_STAGE(PG8_SB(1, 1), cB + hstep + kstep, voffB);
        PG8_WAIT_V(6); PG8_BAR;
    }
    for (;;) {
        const bool has_next = S.next(ui + 1, nxt);
        const char* nA = has_next ? (const char*)g.A + a_off(nxt.pm) : cA; const char* nB = has_next ? (const char*)g.Bt + (size_t)nxt.pn * tstep : cB;
        for (int t = 0; t < nt; t += 2) {
            const bool last = (t == nt - 2);
            const char* a1 = cA + (size_t)(t + 1) * kstep;
            const char* a2 = last ? nA : cA + (size_t)(t + 2) * kstep; const char* b2 = last ? nB : cB + (size_t)(t + 2) * kstep;
            const char* a3 = a2 + kstep; const char* b3 = b2 + kstep;
            if (last && has_next) S.a_ready(nxt);
            if constexpr (SP2) {
            PG8_LDB(B0, 0, 0); PG8_LDB(B1, 0, 1); PG8_SCHED; PG8_LDA(At, 0, 0); PG8_STAGE(PG8_SA(1, 1), a1 + hstep, voffA);
            PG8_WAIT_V(8); PG8_WAIT_L(0); PG8_BAR; PG8_MMA(0, 0, At, B0); PG8_MMA(0, 1, At, B1); PG8_BAR; PG8_SCHED;
            PG8_LDA(At, 0, 1); PG8_STAGE(PG8_SB(0, 0), b2, voffB); PG8_STAGE(PG8_SB(0, 1), b2 + hstep, voffB); PG8_STAGE(PG8_SA(0, 0), a2, voffA);
            PG8_WAIT_V(8); PG8_WAIT_L(0); PG8_BAR; PG8_MMA(1, 0, At, B0); PG8_MMA(1, 1, At, B1); PG8_BAR; PG8_SCHED;
            PG8_LDB(B0, 1, 0); PG8_LDB(B1, 1, 1); PG8_SCHED; PG8_LDA(At, 1, 0); PG8_STAGE(PG8_SA(0, 1), a2 + hstep, voffA);
            PG8_WAIT_V(8); PG8_WAIT_L(0); PG8_BAR; PG8_MMA(0, 0, At, B0); PG8_MMA(0, 1, At, B1); PG8_BAR; PG8_SCHED;
            PG8_LDA(At, 1, 1); PG8_STAGE(PG8_SB(1, 0), b3, voffB); PG8_STAGE(PG8_SB(1, 1), b3 + hstep, voffB); PG8_STAGE(PG8_SA(1, 0), a3, voffA);
            PG8_WAIT_V(8); PG8_WAIT_L(0); PG8_BAR; PG8_MMA(1, 0, At, B0); PG8_MMA(1, 1, At, B1); PG8_BAR; PG8_SCHED;
            } else {
            PG8_LDB(B0, 0, 0); PG8_SCHED; PG8_LDA(At, 0, 0); PG8_STAGE(PG8_SA(1, 1), a1 + hstep, voffA);
            PG8_WAIT_L(8); PG8_BAR; PG8_WAIT_L(0); PG8_MMA(0, 0, At, B0); PG8_BAR; PG8_SCHED;
            PG8_LDB(B1, 0, 1); PG8_STAGE(PG8_SB(0, 0), b2, voffB);
            PG8_BAR; PG8_WAIT_L(0); PG8_MMA(0, 1, At, B1); PG8_BAR;
            PG8_LDA(At, 0, 1); PG8_STAGE(PG8_SA(0, 0), a2, voffA);
            PG8_BAR; PG8_WAIT_L(0); PG8_MMA(1, 0, At, B0); PG8_BAR; PG8_SCHED;
            PG8_STAGE(PG8_SB(0, 1), b2 + hstep, voffB);
            PG8_WAIT_V(6); PG8_BAR; PG8_MMA(1, 1, At, B1); PG8_BAR;
            PG8_LDB(B0, 1, 0); PG8_SCHED; PG8_LDA(At, 1, 0); PG8_STAGE(PG8_SA(0, 1), a2 + hstep, voffA);
            PG8_WAIT_L(8); PG8_BAR; PG8_WAIT_L(0); PG8_MMA(0, 0, At, B0); PG8_BAR; PG8_SCHED;
            PG8_LDB(B1, 1, 1); PG8_STAGE(PG8_SB(1, 0), b3, voffB);
            PG8_BAR; PG8_WAIT_L(0); PG8_MMA(0, 1, At, B1); PG8_BAR;
            PG8_LDA(At, 1, 1); PG8_STAGE(PG8_SA(1, 0), a3, voffA);
            PG8_BAR; PG8_WAIT_L(0); PG8_MMA(1, 0, At, B0); PG8_BAR; PG8_SCHED;
            PG8_STAGE(PG8_SB(1, 1), b3 + hstep, voffB);
            PG8_WAIT_V(6); PG8_BAR; PG8_MMA(1, 1, At, B1); PG8_BAR;
            }
        }
        if constexpr (ALIGN_EPI) { if (wr == 0) PG8_BAR; }
        if constexpr (!Epi::AFTER_DRAIN) { E(acc, cur, wr, wc, fr, fq); S.done(cur); }
        if (!has_next) break;
#pragma unroll
        for (int a = 0; a < 2; ++a)
#pragma unroll
            for (int b = 0; b < 2; ++b)
#pragma unroll
                for (int m = 0; m < 4; ++m)
#pragma unroll
                    for (int n = 0; n < 2; ++n) acc[a][b][m][n] = (f32x4){0.f, 0.f, 0.f, 0.f};
        if constexpr (Epi::PRELOAD) { E.preload(acc, nxt, wr, wc, fr, fq); PG8_WAIT_V(0); }
        cur = nxt; cA = nA; cB = nB; ++ui;
        if constexpr (ALIGN_EPI) { if (wr == 1) PG8_BAR; }
    }
    PG8_WAIT_V(0);
    if constexpr (!ALIGN_EPI) { if (wr == 0) PG8_BAR; }
    PG8_BAR;
    if constexpr (Epi::AFTER_DRAIN) { E.fused(acc, cur, wr, wc, fr, fq, lds, wid, lane); S.done(cur); }
#undef PG8_SA
#undef PG8_SB
#undef PG8_STAGE
#undef PG8_LDA
#undef PG8_LDB
#undef PG8_MMA
#undef PG8_WAIT_V
#undef PG8_WAIT_L
#undef PG8_BAR
#undef PG8_SCHED
}
}

#define LAS __attribute__((address_space(3)))
typedef unsigned short bf16;
typedef unsigned u32x4 __attribute__((ext_vector_type(4)));
typedef unsigned u32x2 __attribute__((ext_vector_type(2)));
typedef float f32x4 __attribute__((ext_vector_type(4)));
typedef short bf16x8 __attribute__((ext_vector_type(8)));
constexpr int D = 1024, SEQ = 8192, NB = 2, NMETA = 16, TT = SEQ + NMETA, M = NB * SEQ, DEPTH = 4, DIN = 1536, FF = 4096, DH = 512;
constexpr float EPS = 1e-6f;
constexpr size_t MiB = 1u << 20;
constexpr size_t WS_CTL = 0;
constexpr size_t WS_POOLW = 1 * MiB, WS_GR = WS_POOLW + 512 * 1024, WS_GI = WS_GR + 256 * 1024;
constexpr size_t WS_SP = 2 * MiB, WS_HMETA = WS_SP + 64 * 1024, WS_MIDMETA = WS_HMETA + 64 * 1024;
constexpr size_t WS_SS = 3 * MiB, WS_CARA = 4 * MiB, WS_CARH = WS_CARA + 512 * 1024;
constexpr size_t WS_W = 8 * MiB, W_LAYER = 21 * MiB, W_IN = 0, W_OUT = 3 * MiB, W_UP = 5 * MiB, W_DOWN = 13 * MiB;
constexpr size_t WS_HB = 92 * MiB, WS_MID = 124 * MiB;
constexpr size_t WS_PROJ = WS_MID, WS_Y = WS_MID + 48 * MiB + 256 * 1024, WS_HL = WS_Y + 32 * MiB + 256 * 1024, WS_P = WS_HL + 32 * MiB + 256 * 1024, WS_END = 256 * MiB;
static_assert(WS_PROJ + (size_t)NB * TT * DIN * 2 <= WS_Y && WS_Y + (size_t)NB * TT * D * 2 <= WS_HL && WS_HL + (size_t)NB * TT * DH * 2 <= WS_P && WS_P + (size_t)NB * TT * DH * 2 <= WS_END, "ws map");
static_assert(WS_W + DEPTH * W_LAYER <= WS_HB && WS_HB + (size_t)M * D * 2 <= WS_MID && WS_MID + (size_t)M * FF * 2 <= WS_END, "ws map 2");
constexpr int LDS_HL = 0, LDS_P = 65536, LDS_CST = 131072, LDS_CARR = 147456, LDS_RED1 = 149504, LDS_RED2 = 152064, LDS_CARRY = 154624;
constexpr int LDS_XST = 163840 - 64;
constexpr int LDS_BYTES = 163840;
constexpr size_t WS_FLAG = 64 * 1024;

struct Params {
    const float* in[20];
    float* out;
    unsigned char* ws;
};

__device__ __forceinline__ Params launder(const Params& p) {
    Params q = p;
#pragma unroll
    for (int i = 0; i < 20; ++i) { const __attribute__((address_space(1))) float* g = (const __attribute__((address_space(1))) float*)q.in[i]; asm volatile("" : "+s"(g)); q.in[i] = (const float*)g; }
    { __attribute__((address_space(1))) float* g = (__attribute__((address_space(1))) float*)q.out; asm volatile("" : "+s"(g)); q.out = (float*)g; }
    { __attribute__((address_space(1))) unsigned char* g = (__attribute__((address_space(1))) unsigned char*)q.ws; asm volatile("" : "+s"(g)); q.ws = (unsigned char*)g; }
    return q;
}
__device__ __forceinline__ unsigned cvt_pk(float lo, float hi) { return pg8::cvt_pk_bf16(lo, hi); }
__device__ __forceinline__ float bf_lo(unsigned w) { return __builtin_bit_cast(float, w << 16); }
__device__ __forceinline__ float bf_hi(unsigned w) { return __builtin_bit_cast(float, w & 0xffff0000u); }
__device__ __forceinline__ void unpack8(const u32x4 w, float (&f)[8]) {
    f[0] = bf_lo(w.x); f[1] = bf_hi(w.x); f[2] = bf_lo(w.y); f[3] = bf_hi(w.y); f[4] = bf_lo(w.z); f[5] = bf_hi(w.z); f[6] = bf_lo(w.w); f[7] = bf_hi(w.w);
}
__device__ __forceinline__ u32x4 pack8(const float (&f)[8]) { u32x4 w; w.x = cvt_pk(f[0], f[1]); w.y = cvt_pk(f[2], f[3]); w.z = cvt_pk(f[4], f[5]); w.w = cvt_pk(f[6], f[7]); return w; }
__device__ __forceinline__ float wave_sum(float v) {
#pragma unroll
    for (int o = 1; o < 64; o <<= 1) v += __shfl_xor(v, o);
    return v;
}
template <int CTRL> __device__ __forceinline__ float dppf(float old, float src) {
    return __builtin_bit_cast(float, __builtin_amdgcn_update_dpp(__builtin_bit_cast(int, old), __builtin_bit_cast(int, src), CTRL, 0xf, 0xf, false));
}
template <int DD> __device__ __forceinline__ float shiftd(float cur, float prev) {
    const float t = dppf<0x100 + (16 - DD)>(0.f, prev);
    return dppf<0x110 + DD>(t, cur);
}
__device__ __forceinline__ float sigm(float v) { return __builtin_amdgcn_rcpf(1.0f + __expf(-v)); }
__device__ __forceinline__ int outchan(int n, int rho) { return 32 * (n >> 1) + 8 * (rho >> 2) + 4 * (n & 1) + (rho & 3); }

__device__ __forceinline__ float row_rstd(const float* ss, int r) {
    const f32x4* s4 = (const f32x4*)(ss + (size_t)r * 16);
    const f32x4 a = s4[0], b = s4[1], c = s4[2], d = s4[3];
    const float s = ((a.x + a.y) + (a.z + a.w)) + ((b.x + b.y) + (b.z + b.w)) + ((c.x + c.y) + (c.z + c.w)) + ((d.x + d.y) + (d.z + d.w));
    return 1.0f / sqrtf(s * (1.0f / D) + EPS);
}
__device__ __forceinline__ void rows_rstd(const float* ss, int rowbase  , int fr, float (&rs)[2][4]) {
    const int lane = threadIdx.x & 63;
    const float r0 = row_rstd(ss, rowbase + lane), r1 = row_rstd(ss, rowbase + 128 + lane);
#pragma unroll
    for (int m = 0; m < 4; ++m) { rs[0][m] = __shfl(r0, m * 16 + fr); rs[1][m] = __shfl(r1, m * 16 + fr); }
}
struct EpiIn {
    static constexpr bool PERM = true, AFTER_DRAIN = false, PRELOAD = false;
    bf16* P; const float* ss; const LAS float* rl; int pmc;
    __device__ __forceinline__ void operator()(const f32x4 (&acc)[2][2][4][2], const pg8::Unit& u, int wr, int wc, int fr, int fq) const {
        const int row0 = u.pm * 256 + wr * 64 + fr, col0 = u.pn * 256 + wc * 32 + 8 * fq;
        float rsv[2][4];
        if (u.pm == pmc) {
#pragma unroll
            for (int ai = 0; ai < 2; ++ai)
#pragma unroll
                for (int m = 0; m < 4; ++m) rsv[ai][m] = rl[ai * 128 + wr * 64 + m * 16 + fr];
        } else {
#pragma unroll
            for (int ai = 0; ai < 2; ++ai)
#pragma unroll
                for (int m = 0; m < 4; ++m) { rsv[ai][m] = row_rstd(ss, row0 + ai * 128 + m * 16); asm volatile("" ::: "memory"); }
        }
#pragma unroll
        for (int ai = 0; ai < 2; ++ai)
#pragma unroll
            for (int m = 0; m < 4; ++m) {
                const int r = row0 + ai * 128 + m * 16; const float rs = rsv[ai][m];
                bf16* rowp = P + (size_t)(r + NMETA * (1 + (r >> 13))) * DIN + col0;
#pragma unroll
                for (int bj = 0; bj < 2; ++bj) { const f32x4 v0 = acc[ai][bj][m][0] * rs, v1 = acc[ai][bj][m][1] * rs;
                    u32x4 w; w.x = cvt_pk(v0[0], v0[1]); w.y = cvt_pk(v0[2], v0[3]); w.z = cvt_pk(v1[0], v1[1]); w.w = cvt_pk(v1[2], v1[3]);
                    *(u32x4*)(rowp + bj * 128) = w; }
            }
    }
};
struct EpiUp {
    static constexpr bool PERM = true, AFTER_DRAIN = false, PRELOAD = false;
    bf16* O; const float* ss; const LAS float* rl; int pmc;
    __device__ __forceinline__ void operator()(const f32x4 (&acc)[2][2][4][2], const pg8::Unit& u, int wr, int wc, int fr, int fq) const {
        const int row0 = u.pm * 256 + wr * 64 + fr, col0 = u.pn * 256 + wc * 32 + 8 * fq;
        float rsv[2][4];
        if (u.pm == pmc) {
#pragma unroll
            for (int ai = 0; ai < 2; ++ai)
#pragma unroll
                for (int m = 0; m < 4; ++m) rsv[ai][m] = rl[ai * 128 + wr * 64 + m * 16 + fr];
        } else {
#pragma unroll
            for (int ai = 0; ai < 2; ++ai)
#pragma unroll
                for (int m = 0; m < 4; ++m) { rsv[ai][m] = row_rstd(ss, row0 + ai * 128 + m * 16); asm volatile("" ::: "memory"); }
        }
#pragma unroll
        for (int ai = 0; ai < 2; ++ai)
#pragma unroll
            for (int m = 0; m < 4; ++m) {
                const int r = row0 + ai * 128 + m * 16; const float rs = rsv[ai][m];
                bf16* rowp = O + (size_t)r * FF + col0;
#pragma unroll
                for (int bj = 0; bj < 2; ++bj) { f32x4 v0 = acc[ai][bj][m][0] * rs, v1 = acc[ai][bj][m][1] * rs;
#pragma unroll
                    for (int j = 0; j < 4; ++j) { v0[j] = fmaxf(v0[j], 0.f); v0[j] *= v0[j]; v1[j] = fmaxf(v1[j], 0.f); v1[j] *= v1[j]; }
                    u32x4 w; w.x = cvt_pk(v0[0], v0[1]); w.y = cvt_pk(v0[2], v0[3]); w.z = cvt_pk(v1[0], v1[1]); w.w = cvt_pk(v1[2], v1[3]);
                    *(u32x4*)(rowp + bj * 128) = w; }
            }
    }
};
struct EpiRes {
    static constexpr bool PERM = true, AFTER_DRAIN = false, PRELOAD = true;
    bf16* hb; float* ssn;
    __device__ __forceinline__ void preload(f32x4 (&acc)[2][2][4][2], const pg8::Unit& u, int wr, int wc, int fr, int fq) const {
        const int row0 = u.pm * 256 + wr * 64 + fr, col0 = u.pn * 256 + wc * 32 + 8 * fq;
#pragma unroll
        for (int ai = 0; ai < 2; ++ai)
#pragma unroll
            for (int m = 0; m < 4; ++m) { const size_t off = (size_t)(row0 + ai * 128 + m * 16) * D + col0;
#pragma unroll
                for (int bj = 0; bj < 2; ++bj) { const u32x4 w = *(const u32x4*)(hb + off + bj * 128);
                    acc[ai][bj][m][0] = (f32x4){bf_lo(w.x), bf_hi(w.x), bf_lo(w.y), bf_hi(w.y)}; acc[ai][bj][m][1] = (f32x4){bf_lo(w.z), bf_hi(w.z), bf_lo(w.w), bf_hi(w.w)}; } }
    }
    __device__ __forceinline__ void operator()(const f32x4 (&acc)[2][2][4][2], const pg8::Unit& u, int wr, int wc, int fr, int fq) const {
        const int row0 = u.pm * 256 + wr * 64 + fr, col0 = u.pn * 256 + wc * 32 + 8 * fq;
#pragma unroll
        for (int ai = 0; ai < 2; ++ai)
#pragma unroll
            for (int m = 0; m < 4; ++m) {
                const int r = row0 + ai * 128 + m * 16; const size_t off = (size_t)r * D + col0; float s = 0.f;
#pragma unroll
                for (int bj = 0; bj < 2; ++bj) {
                    const f32x4 o0 = acc[ai][bj][m][0], o1 = acc[ai][bj][m][1];
                    s += (o0[0] * o0[0] + o0[1] * o0[1]) + (o0[2] * o0[2] + o0[3] * o0[3]) + (o1[0] * o1[0] + o1[1] * o1[1]) + (o1[2] * o1[2] + o1[3] * o1[3]);
                    u32x4 w; w.x = cvt_pk(o0[0], o0[1]); w.y = cvt_pk(o0[2], o0[3]); w.z = cvt_pk(o1[0], o1[1]); w.w = cvt_pk(o1[2], o1[3]);
                    *(u32x4*)(hb + off + bj * 128) = w; }
                s += __shfl_xor(s, 16); s += __shfl_xor(s, 32);
                if (fq == 0) ssn[(size_t)r * 16 + u.pn * 4 + wc] = s;
            }
    }
};

struct TItem { const float* W; const float* gk; bf16* WT; int K, N, item; };
__device__ __forceinline__ void titem_load(const TItem& t, int lane, f32x4 (&v)[8], float (&gs)[8]) {
    const int nblk = t.N / 32, kb = t.item / nblk, nb = t.item % nblk, k0 = 64 * kb, n0 = 32 * nb, lr = lane >> 3, lc = (lane & 7) * 4;
#pragma unroll
    for (int i = 0; i < 8; ++i) { v[i] = *(const f32x4*)(t.W + (size_t)(k0 + 8 * i + lr) * t.N + n0 + lc); gs[i] = t.gk ? t.gk[k0 + 8 * i + lr] : 1.0f; }
}
__device__ __forceinline__ void titem_store(const TItem& t, int lane, const f32x4 (&v)[8], const float (&gs)[8], LAS float* scr) {
    const int nblk = t.N / 32, kb = t.item / nblk, nb = t.item % nblk, k0 = 64 * kb, n0 = 32 * nb, lr = lane >> 3, lc = (lane & 7) * 4;
#pragma unroll
    for (int i = 0; i < 8; ++i) { LAS float* d = scr + (8 * i + lr) * 33 + lc; d[0] = v[i].x * gs[i]; d[1] = v[i].y * gs[i]; d[2] = v[i].z * gs[i]; d[3] = v[i].w * gs[i]; }
    asm volatile("s_waitcnt lgkmcnt(0)" ::: "memory");
    const int c = lane & 7;
#pragma unroll
    for (int j = 0; j < 4; ++j) { const int n = (lane >> 3) + 8 * j; const LAS float* s = scr + (8 * c) * 33 + n;
        u32x4 o; o.x = cvt_pk(s[0 * 33], s[1 * 33]); o.y = cvt_pk(s[2 * 33], s[3 * 33]); o.z = cvt_pk(s[4 * 33], s[5 * 33]); o.w = cvt_pk(s[6 * 33], s[7 * 33]);
        *(u32x4*)(t.WT + (size_t)(n0 + n) * t.K + k0 + 8 * c) = o; }
    asm volatile("s_waitcnt lgkmcnt(0)" ::: "memory");
}
__device__ __forceinline__ TItem titem_decode(const Params& p, int it) {
    constexpr int I_IN = 16 * 48, I_OUT = 16 * 32, I_UP = 16 * 128, I_DN = 64 * 32, I_PW = 4 * 8, I_G = 8 * 2, I_L = I_IN + I_OUT + I_UP + I_DN + I_PW + 2 * I_G;
    const int l = it / I_L; int r = it % I_L; unsigned char* ws = p.ws; unsigned char* wl = ws + WS_W + (size_t)l * W_LAYER; TItem t;
    if (r < I_IN) { t = TItem{p.in[3] + (size_t)l * D * DIN, p.in[2] + l * D, (bf16*)(wl + W_IN), D, DIN, r}; return t; } r -= I_IN;
    if (r < I_OUT) { t = TItem{p.in[15] + (size_t)l * D * D, p.in[14] + l * D, (bf16*)(wl + W_OUT), D, D, r}; return t; } r -= I_OUT;
    if (r < I_UP) { t = TItem{p.in[17] + (size_t)l * D * FF, p.in[16] + l * D, (bf16*)(wl + W_UP), D, FF, r}; return t; } r -= I_UP;
    if (r < I_DN) { t = TItem{p.in[18] + (size_t)l * FF * D, nullptr, (bf16*)(wl + W_DOWN), FF, D, r}; return t; } r -= I_DN;
    if (r < I_PW) { const int g = r / 8; t = TItem{p.in[4] + (size_t)(l * 4 + g) * 16384, nullptr, (bf16*)(ws + WS_POOLW) + (size_t)(l * 4 + g) * 16384, 128, 128, r % 8}; return t; } r -= I_PW;
    if (r < I_G) { const int h = r / 2; t = TItem{p.in[9] + (size_t)(l * 8 + h) * 4096, nullptr, (bf16*)(ws + WS_GR) + (size_t)(l * 8 + h) * 4096, 64, 64, r % 2}; return t; } r -= I_G;
    { const int h = r / 2; t = TItem{p.in[11] + (size_t)(l * 8 + h) * 4096, nullptr, (bf16*)(ws + WS_GI) + (size_t)(l * 8 + h) * 4096, 64, 64, r % 2}; }
    return t;
}
constexpr int TITEMS_PER_LAYER = 16 * 48 + 16 * 32 + 16 * 128 + 64 * 32 + 4 * 8 + 2 * 8 * 2, TITEMS_IN = 16 * 48;
__device__ __forceinline__ void convert_items(const Params& p_, LAS unsigned char* lds, int it_lo, int it_hi, int wblock, int nworkers) {
    const Params p = launder(p_);
    int tid_ = threadIdx.x; asm volatile("" : "+v"(tid_));
    const int lane = tid_ & 63, wid = __builtin_amdgcn_readfirstlane(tid_ >> 6);
    LAS float* scr = (LAS float*)(lds + wid * 16384);
    const int worker = wblock * 8 + wid;
    if (it_lo + worker < it_hi) {
        TItem cur = titem_decode(p, it_lo + worker); f32x4 v[8]; float gs[8]; titem_load(cur, lane, v, gs);
        for (int it = it_lo + worker; it < it_hi; it += nworkers) {
            const bool more = it + nworkers < it_hi; TItem nxt = cur; f32x4 nv[8]; float ngs[8];
            if (more) { nxt = titem_decode(p, it + nworkers); titem_load(nxt, lane, nv, ngs); }
            titem_store(cur, lane, v, gs, scr);
            if (more) { cur = nxt;
#pragma unroll
                for (int i = 0; i < 8; ++i) { v[i] = nv[i]; gs[i] = ngs[i]; } }
        }
    }
}
__device__ __forceinline__ void prologue(const Params& p_, LAS unsigned char* lds, int G) {
    const Params p = launder(p_);
    int tid_ = threadIdx.x; asm volatile("" : "+v"(tid_));
    const int tid = tid_, lane = tid & 63, wid = __builtin_amdgcn_readfirstlane(tid >> 6);
    const int gw = blockIdx.x * 8 + wid, NGW = G * 8;
    unsigned char* ws = p.ws;
    convert_items(p_, lds, 0, G == 256 ? TITEMS_IN : DEPTH * TITEMS_PER_LAYER, (int)blockIdx.x, NGW);
    const float* x = p.in[0]; bf16* hb = (bf16*)(ws + WS_HB); float* ss = (float*)(ws + WS_SS);
    for (int m2 = gw; m2 < M / 2; m2 += NGW) {
        f32x4 v[2][4]; float s[2] = {0.f, 0.f};
#pragma unroll
        for (int r = 0; r < 2; ++r) { const f32x4* xr = (const f32x4*)(x + (size_t)(2 * m2 + r) * D) + lane;
#pragma unroll
            for (int j = 0; j < 4; ++j) v[r][j] = xr[64 * j]; }
#pragma unroll
        for (int r = 0; r < 2; ++r) {
#pragma unroll
            for (int j = 0; j < 4; ++j) s[r] += (v[r][j].x * v[r][j].x + v[r][j].y * v[r][j].y) + (v[r][j].z * v[r][j].z + v[r][j].w * v[r][j].w);
            s[r] = wave_sum(s[r]);
            u32x2* o8 = (u32x2*)(hb + (size_t)(2 * m2 + r) * D) + lane;
#pragma unroll
            for (int j = 0; j < 4; ++j) { u32x2 w; w.x = cvt_pk(v[r][j].x, v[r][j].y); w.y = cvt_pk(v[r][j].z, v[r][j].w); o8[64 * j] = w; }
            if (lane < 16) ss[(size_t)(2 * m2 + r) * 16 + lane] = lane == 0 ? s[r] : 0.f;
        }
    }
    float* hm = (float*)(ws + WS_HMETA); float* sp = (float*)(ws + WS_SP);
    for (int i = blockIdx.x * 512 + tid; i < NMETA * D; i += G * 512) hm[i] = p.in[1][i];
    for (int i = blockIdx.x * 512 + tid; i < DEPTH * DH; i += G * 512) sp[i] = log1pf(expf(-p.in[13][i]));
}

template <int MODE, int NBATCH = 4> __device__ __forceinline__ void meta_tasks(const Params& p_, LAS unsigned char* lds, int G, const bf16* Ab, int lda, const bf16* Bt, int K, int ntasks) {
    const Params p = launder(p_);
    int tid_ = threadIdx.x; asm volatile("" : "+v"(tid_));
    const int tid = tid_, lane = tid & 63, wid = __builtin_amdgcn_readfirstlane(tid >> 6), fr = lane & 15, fq = lane >> 4;
    float* hm = (float*)(p.ws + WS_HMETA);
    LAS float* red = (LAS float*)lds;
    for (int task = G - 1 - (int)blockIdx.x; task < ntasks; task += G) {
        const int n0 = task * 16, kw = K / 8, k0 = wid * kw;
        f32x4 acc = {0.f, 0.f, 0.f, 0.f}; float ssq = 0.f;
        for (int kb = k0; kb < k0 + kw; kb += 32 * NBATCH) {
            bf16x8 af[NBATCH], bfr[NBATCH]; f32x4 a0[NBATCH], a1[NBATCH];
#pragma unroll
            for (int i = 0; i < NBATCH; ++i) { const int kk = kb + 32 * i;
                if (MODE == 1) af[i] = *(const bf16x8*)(Ab + (size_t)fr * lda + kk + 8 * fq);
                else { a0[i] = *(const f32x4*)(hm + fr * D + kk + 8 * fq); a1[i] = *(const f32x4*)(hm + fr * D + kk + 8 * fq + 4); }
                bfr[i] = *(const bf16x8*)(Bt + (size_t)(n0 + fr) * K + kk + 8 * fq); }
#pragma unroll
            for (int i = 0; i < NBATCH; ++i) {
                if (MODE != 1) { ssq += (a0[i].x * a0[i].x + a0[i].y * a0[i].y) + (a0[i].z * a0[i].z + a0[i].w * a0[i].w) + (a1[i].x * a1[i].x + a1[i].y * a1[i].y) + (a1[i].z * a1[i].z + a1[i].w * a1[i].w);
                    u32x4 w; w.x = cvt_pk(a0[i].x, a0[i].y); w.y = cvt_pk(a0[i].z, a0[i].w); w.z = cvt_pk(a1[i].x, a1[i].y); w.w = cvt_pk(a1[i].z, a1[i].w); af[i] = __builtin_bit_cast(bf16x8, w); }
                acc = __builtin_amdgcn_mfma_f32_16x16x32_bf16(bfr[i], af[i], acc, 0, 0, 0); }
        }
        ssq += __shfl_xor(ssq, 16); ssq += __shfl_xor(ssq, 32);
        LAS float* rp = red + (wid * 64 + lane) * 5;
        rp[0] = acc[0]; rp[1] = acc[1]; rp[2] = acc[2]; rp[3] = acc[3]; rp[4] = ssq;
        __syncthreads();
        if (wid == 0) {
            float a0 = 0.f, a1 = 0.f, a2 = 0.f, a3 = 0.f, sq = 0.f;
#pragma unroll
            for (int w = 0; w < 8; ++w) { const LAS float* q = red + (w * 64 + lane) * 5; a0 += q[0]; a1 += q[1]; a2 += q[2]; a3 += q[3]; sq += q[4]; }
            const int col = n0 + 4 * fq;
            if (MODE == 1) { f32x4* hp = (f32x4*)(hm + fr * D + col); f32x4 h = *hp; h.x += a0; h.y += a1; h.z += a2; h.w += a3; *hp = h; }
            else {
                const float rs = 1.0f / sqrtf(sq * (1.0f / D) + EPS); a0 *= rs; a1 *= rs; a2 *= rs; a3 *= rs;
                if (MODE == 0) { u32x2 w; w.x = cvt_pk(a0, a1); w.y = cvt_pk(a2, a3); bf16* pr = (bf16*)(p.ws + WS_PROJ);
                    *(u32x2*)(pr + (size_t)fr * DIN + col) = w; *(u32x2*)(pr + (size_t)(TT + fr) * DIN + col) = w; }
                else { a0 = fmaxf(a0, 0.f); a1 = fmaxf(a1, 0.f); a2 = fmaxf(a2, 0.f); a3 = fmaxf(a3, 0.f);
                    u32x2 w; w.x = cvt_pk(a0 * a0, a1 * a1); w.y = cvt_pk(a2 * a2, a3 * a3); *(u32x2*)((bf16*)(p.ws + WS_MIDMETA) + (size_t)fr * FF + col) = w; }
            }
        }
        __syncthreads();
    }
}

__device__ __forceinline__ void m1_phase(const Params& p_, LAS unsigned char* lds, int G, int l) {
    const Params p = launder(p_);
    int tid_ = threadIdx.x; asm volatile("" : "+v"(tid_));
    const int tid = tid_, lane = tid & 63, wid = __builtin_amdgcn_readfirstlane(tid >> 6), fr = lane & 15, fq = lane >> 4;
    LAS float* cst = (LAS float*)lds;
    for (int i = tid; i < 8 * DH; i += 512) { const int row = i >> 9, ch = i & 511; float v;
        if (row < 4) v = p.in[7][(l * 4 + row) * DH + ch]; else if (row == 4) v = p.in[8][l * DH + ch]; else if (row == 5) v = p.in[10][l * DH + ch];
        else if (row == 6) v = p.in[12][l * DH + ch]; else v = ((const float*)(p.ws + WS_SP))[l * DH + ch];
        cst[i] = v; }
    const bf16* proj = (const bf16*)(p.ws + WS_PROJ);
    const bf16* Wr = (const bf16*)(p.ws + WS_GR) + (size_t)(l * 8 + wid) * 4096; const bf16* Wi = (const bf16*)(p.ws + WS_GI) + (size_t)(l * 8 + wid) * 4096;
    LAS bf16x8* wl = (LAS bf16x8*)(lds + 16384 + wid * 16384) + lane;
#pragma unroll
    for (int n = 0; n < 4; ++n)
#pragma unroll
        for (int ks = 0; ks < 2; ++ks) {
            wl[((n * 2 + ks) * 2 + 0) * 64] = *(const bf16x8*)(Wr + outchan(n, fr) * 64 + 32 * ks + 8 * fq);
            wl[((n * 2 + ks) * 2 + 1) * 64] = *(const bf16x8*)(Wi + outchan(n, fr) * 64 + 32 * ks + 8 * fq); }
    __syncthreads();
    bf16* hl = (bf16*)(p.ws + WS_HL); bf16* Pp = (bf16*)(p.ws + WS_P);
    float* carA = (float*)(p.ws + WS_CARA); float* carH = (float*)(p.ws + WS_CARH);
    for (int unit = blockIdx.x; unit < 256; unit += G) {
        const int b = unit >> 7, c = unit & 127, t0 = c ? NMETA + 64 * c : 0, NM = c ? 4 : 5;
        float Hc[16], Pc[16];
#pragma unroll
        for (int k = 0; k < 16; ++k) { Hc[k] = 0.f; Pc[k] = 1.f; }
        u32x4 raw[2][4];
#pragma unroll
        for (int ks = 0; ks < 2; ++ks)
#pragma unroll
            for (int d = 0; d < 4; ++d) { const int tt = t0 + fr - 3 + d; raw[ks][d] = (u32x4){0u, 0u, 0u, 0u};
                if (tt >= 0) raw[ks][d] = *(const u32x4*)(proj + ((size_t)b * TT + tt) * DIN + DH + wid * 64 + 32 * ks + 8 * fq); }
#pragma unroll 1
        for (int m = 0; m < NM; ++m) {
            const int t = t0 + 16 * m + fr; const size_t rowg = (size_t)b * TT + t;
            u32x4 nraw[2][4];
#pragma unroll
            for (int ks = 0; ks < 2; ++ks)
#pragma unroll
                for (int d = 0; d < 4; ++d) { nraw[ks][d] = (u32x4){0u, 0u, 0u, 0u};
                    if (m + 1 < NM) nraw[ks][d] = *(const u32x4*)(proj + ((size_t)b * TT + t + 13 + d) * DIN + DH + wid * 64 + 32 * ks + 8 * fq); }
            float xc[2][8]; bf16x8 frag[2];
#pragma unroll
            for (int ks = 0; ks < 2; ++ks) {
                const int chb = wid * 64 + 32 * ks + 8 * fq;
                { const f32x4 c0 = *(const LAS f32x4*)(cst + 4 * DH + chb), c1 = *(const LAS f32x4*)(cst + 4 * DH + chb + 4);
                  xc[ks][0] = c0.x; xc[ks][1] = c0.y; xc[ks][2] = c0.z; xc[ks][3] = c0.w; xc[ks][4] = c1.x; xc[ks][5] = c1.y; xc[ks][6] = c1.z; xc[ks][7] = c1.w; }
#pragma unroll
                for (int d = 0; d < 4; ++d) {
                    float u[8]; unpack8(raw[ks][d], u);
                    const f32x4 w0 = *(const LAS f32x4*)(cst + d * DH + chb), w1 = *(const LAS f32x4*)(cst + d * DH + chb + 4);
                    xc[ks][0] += u[0] * w0.x; xc[ks][1] += u[1] * w0.y; xc[ks][2] += u[2] * w0.z; xc[ks][3] += u[3] * w0.w;
                    xc[ks][4] += u[4] * w1.x; xc[ks][5] += u[5] * w1.y; xc[ks][6] += u[6] * w1.z; xc[ks][7] += u[7] * w1.w;
                    raw[ks][d] = nraw[ks][d];
                }
                frag[ks] = __builtin_bit_cast(bf16x8, pack8(xc[ks]));
            }
            f32x4 ar[4], ai[4];
#pragma unroll
            for (int n = 0; n < 4; ++n) { ar[n] = (f32x4){0.f, 0.f, 0.f, 0.f}; ai[n] = (f32x4){0.f, 0.f, 0.f, 0.f};
#pragma unroll
                for (int ks = 0; ks < 2; ++ks) {
                    const bf16x8 wr_ = wl[((n * 2 + ks) * 2 + 0) * 64], wi_ = wl[((n * 2 + ks) * 2 + 1) * 64];
                    ar[n] = __builtin_amdgcn_mfma_f32_16x16x32_bf16(wr_, frag[ks], ar[n], 0, 0, 0);
                    ai[n] = __builtin_amdgcn_mfma_f32_16x16x32_bf16(wi_, frag[ks], ai[n], 0, 0, 0);
                } }
            float Aa[16], Bb[16];
#pragma unroll
            for (int n = 0; n < 4; ++n) {
                const int cho = wid * 64 + 32 * (n >> 1) + 8 * fq + 4 * (n & 1);
                const f32x4 rb = *(const LAS f32x4*)(cst + 5 * DH + cho), ib = *(const LAS f32x4*)(cst + 6 * DH + cho), spv = *(const LAS f32x4*)(cst + 7 * DH + cho);
#pragma unroll
                for (int jj = 0; jj < 4; ++jj) {
                    const float r = sigm(ar[n][jj] + rb[jj]), ig = sigm(ai[n][jj] + ib[jj]);
                    const float la = -8.0f * r * spv[jj], a = __expf(la), x2 = 2.0f * la;
                    const float m2s = -x2 * (1.0f + x2 * (0.5f + x2 * (0.16666667f + x2 * 0.041666668f))), m2 = (x2 > -0.0625f) ? m2s : 1.0f - a * a;
                    Aa[n * 4 + jj] = a; Bb[n * 4 + jj] = __builtin_amdgcn_sqrtf(m2) * ig * xc[n >> 1][4 * (n & 1) + jj];
                }
            }
#pragma unroll
            for (int k = 0; k < 16; ++k) {
                float A = Aa[k], B = Bb[k], Ap, Bq;
                Ap = dppf<0x111>(1.f, A); Bq = dppf<0x111>(0.f, B); B = fmaf(A, Bq, B); A *= Ap;
                Ap = dppf<0x112>(1.f, A); Bq = dppf<0x112>(0.f, B); B = fmaf(A, Bq, B); A *= Ap;
                Ap = dppf<0x114>(1.f, A); Bq = dppf<0x114>(0.f, B); B = fmaf(A, Bq, B); A *= Ap;
                Ap = dppf<0x118>(1.f, A); Bq = dppf<0x118>(0.f, B); B = fmaf(A, Bq, B); A *= Ap;
                Bb[k] = fmaf(A, Hc[k], B); Aa[k] = A * Pc[k];
            }
#pragma unroll
            for (int ks = 0; ks < 2; ++ks) {
                const size_t o = rowg * DH + wid * 64 + 32 * ks + 8 * fq;
                { u32x4 wh; wh.x = cvt_pk(Bb[8 * ks + 0], Bb[8 * ks + 1]); wh.y = cvt_pk(Bb[8 * ks + 2], Bb[8 * ks + 3]); wh.z = cvt_pk(Bb[8 * ks + 4], Bb[8 * ks + 5]); wh.w = cvt_pk(Bb[8 * ks + 6], Bb[8 * ks + 7]);
                  *(u32x4*)(hl + o) = wh; }
                u32x4 w; w.x = cvt_pk(Aa[8 * ks + 0], Aa[8 * ks + 1]); w.y = cvt_pk(Aa[8 * ks + 2], Aa[8 * ks + 3]); w.z = cvt_pk(Aa[8 * ks + 4], Aa[8 * ks + 5]); w.w = cvt_pk(Aa[8 * ks + 6], Aa[8 * ks + 7]);
                *(u32x4*)(Pp + o) = w;
            }
            const int src = (lane & 48) | 15;
#pragma unroll
            for (int k = 0; k < 16; ++k) { Hc[k] = __shfl(Bb[k], src); Pc[k] = __shfl(Aa[k], src); }
        }
        if (fr == 0) {
#pragma unroll
            for (int ks = 0; ks < 2; ++ks) {
                const size_t o = (size_t)(b * 128 + c) * DH + wid * 64 + 32 * ks + 8 * fq;
                *(f32x4*)(carA + o) = (f32x4){Pc[8 * ks + 0], Pc[8 * ks + 1], Pc[8 * ks + 2], Pc[8 * ks + 3]}; *(f32x4*)(carA + o + 4) = (f32x4){Pc[8 * ks + 4], Pc[8 * ks + 5], Pc[8 * ks + 6], Pc[8 * ks + 7]};
                *(f32x4*)(carH + o) = (f32x4){Hc[8 * ks + 0], Hc[8 * ks + 1], Hc[8 * ks + 2], Hc[8 * ks + 3]}; *(f32x4*)(carH + o + 4) = (f32x4){Hc[8 * ks + 4], Hc[8 * ks + 5], Hc[8 * ks + 6], Hc[8 * ks + 7]};
            }
        }
    }
    __syncthreads();
}


template <int NMR, bool FROM_LDS> __device__ __forceinline__ void m2_rnn_round(LAS unsigned char* lds, const bf16* hl, const bf16* Pp, const bf16* proj, bf16* Y, LAS float* red1, const float (&cr)[16], int b, int t0, int mbase, int wid, int fr, int fq) {
    u32x4 hw[NMR][2], pw[NMR][2], gw[NMR][2];
#pragma unroll
    for (int m = 0; m < NMR; ++m)
#pragma unroll
        for (int ks = 0; ks < 2; ++ks) { const size_t rowg = (size_t)b * TT + t0 + 16 * (mbase + m) + fr; const int ch = wid * 64 + 32 * ks + 8 * fq; const size_t o = rowg * DH + ch;
            if (FROM_LDS) { const int lane = fq * 16 + fr; hw[m][ks] = *(const LAS u32x4*)(lds + LDS_HL + wid * 8192 + (((mbase + m) * 2 + ks) * 64 + lane) * 16); pw[m][ks] = *(const LAS u32x4*)(lds + LDS_P + wid * 8192 + (((mbase + m) * 2 + ks) * 64 + lane) * 16); }
            else { hw[m][ks] = *(const u32x4*)(hl + o); pw[m][ks] = *(const u32x4*)(Pp + o); } gw[m][ks] = *(const u32x4*)(proj + rowg * DIN + 2 * DH + ch); }
    float y[NMR][16];
#pragma unroll
    for (int m = 0; m < NMR; ++m) { float s = 0.f;
#pragma unroll
        for (int ks = 0; ks < 2; ++ks) { float pf[8], gt[8]; unpack8(pw[m][ks], pf); unpack8(gw[m][ks], gt);
            float hh[8]; unpack8(hw[m][ks], hh);
#pragma unroll
            for (int e = 0; e < 8; ++e) { const float hv = fmaf(pf[e], cr[8 * ks + e], hh[e]), x = gt[e];
                const float ge = x * __builtin_amdgcn_rcpf(1.0f + __expf(-1.5957691216f * (x + 0.044715f * x * x * x)));
                const float yy = hv * ge; y[m][8 * ks + e] = yy; s = fmaf(yy, yy, s); } }
        s += __shfl_xor(s, 16); s += __shfl_xor(s, 32);
        if (fq == 0) red1[(16 * (mbase + m) + fr) * 8 + wid] = s; }
    __syncthreads();
#pragma unroll
    for (int m = 0; m < NMR; ++m) { const size_t rowg = (size_t)b * TT + t0 + 16 * (mbase + m) + fr;
        const f32x4 r0 = *(const LAS f32x4*)(red1 + (16 * (mbase + m) + fr) * 8), r1 = *(const LAS f32x4*)(red1 + (16 * (mbase + m) + fr) * 8 + 4);
        const float rs = __builtin_amdgcn_rsqf((((r0.x + r0.y) + (r0.z + r0.w)) + ((r1.x + r1.y) + (r1.z + r1.w))) * (1.0f / DH) + EPS);
#pragma unroll
        for (int ks = 0; ks < 2; ++ks) { float yy[8];
#pragma unroll
            for (int e = 0; e < 8; ++e) yy[e] = y[m][8 * ks + e] * rs;
            *(u32x4*)(Y + rowg * D + DH + wid * 64 + 32 * ks + 8 * fq) = pack8(yy); } }
}


template <int NMR> __device__ __forceinline__ void m2_pool_round(const bf16* proj, bf16* Y, const bf16* Wp, const float* pbias, const float* pscale, LAS float* red2,
                                                                  int b, int t0, int mbase, int g, int half, int kwin, int wid, int fr, int fq) {
    const int tb = t0 + 16 * mbase;
    bf16x8 pfr[NMR][4];
#pragma unroll
    for (int ks = 0; ks < 4; ++ks) {
        const int chb = g * 128 + 32 * ks + 8 * fq;
        float pu[8], p2[8], p4[8], p8[8];
        if (tb) { const u32x4 raw = *(const u32x4*)(proj + ((size_t)b * TT + tb - 16 + fr) * DIN + chb); unpack8(raw, pu);
#pragma unroll
            for (int e = 0; e < 8; ++e) { p2[e] = pu[e] + dppf<0x111>(0.f, pu[e]); p4[e] = p2[e] + dppf<0x112>(0.f, p2[e]); p8[e] = p4[e] + dppf<0x114>(0.f, p4[e]); } }
        else {
#pragma unroll
            for (int e = 0; e < 8; ++e) { pu[e] = 0.f; p2[e] = 0.f; p4[e] = 0.f; p8[e] = 0.f; } }
#pragma unroll
        for (int m = 0; m < NMR; ++m) {
            const int t = tb + 16 * m + fr; const size_t rowg = (size_t)b * TT + t;
            const u32x4 raw = *(const u32x4*)(proj + rowg * DIN + chb); float u[8], po[8]; unpack8(raw, u);
            const int cnt = (t + 1 < kwin) ? t + 1 : kwin; const float rc = __builtin_amdgcn_rcpf((float)cnt);
#pragma unroll
            for (int e = 0; e < 8; ++e) {
                const float s2 = u[e] + shiftd<1>(u[e], pu[e]), s4 = s2 + shiftd<2>(s2, p2[e]), s8 = s4 + shiftd<4>(s4, p4[e]), s16 = s8 + shiftd<8>(s8, p8[e]);
                const float win = g == 0 ? s2 : (g == 1 ? s4 : (g == 2 ? s8 : s16));
                po[e] = fmaf(win, rc, -u[e]); pu[e] = u[e]; p2[e] = s2; p4[e] = s4; p8[e] = s8;
            }
            pfr[m][ks] = __builtin_bit_cast(bf16x8, pack8(po));
        }
    }
    bf16x8 wfr[4][4];
#pragma unroll
    for (int n = 0; n < 4; ++n)
#pragma unroll
        for (int ks = 0; ks < 4; ++ks) wfr[n][ks] = *(const bf16x8*)(Wp + (size_t)(64 * half + outchan(n, fr)) * 128 + 32 * ks + 8 * fq);
#pragma unroll 1
    for (int pass = 0; pass < 2; ++pass) {
#pragma unroll
        for (int m = 0; m < NMR; ++m) {
            const int t = tb + 16 * m + fr; const size_t rowg = (size_t)b * TT + t; float s = 0.f, rs = 0.f;
            if (pass) { const f32x4 r0 = *(const LAS f32x4*)(red2 + (16 * (mbase + m) + fr) * 8), r1 = *(const LAS f32x4*)(red2 + (16 * (mbase + m) + fr) * 8 + 4);
                rs = __builtin_amdgcn_rsqf((((r0.x + r0.y) + (r0.z + r0.w)) + ((r1.x + r1.y) + (r1.z + r1.w))) * (1.0f / DH) + EPS); }
#pragma unroll
            for (int np = 0; np < 2; ++np) {
                f32x4 o2[2];
#pragma unroll
                for (int nn = 0; nn < 2; ++nn) { const int n = 2 * np + nn;
                    f32x4 acc = {0.f, 0.f, 0.f, 0.f};
#pragma unroll
                    for (int ks = 0; ks < 4; ++ks) acc = __builtin_amdgcn_mfma_f32_16x16x32_bf16(wfr[n][ks], pfr[m][ks], acc, 0, 0, 0);
                    const int col = g * 128 + 64 * half + 32 * np + 8 * fq + 4 * nn;
                    const f32x4 pb = *(const f32x4*)(pbias + col), ps = *(const f32x4*)(pscale + col);
                    acc = (acc + pb) * ps; s += (acc.x * acc.x + acc.y * acc.y) + (acc.z * acc.z + acc.w * acc.w); o2[nn] = acc * rs; }
                if (pass) { u32x4 w; w.x = cvt_pk(o2[0].x, o2[0].y); w.y = cvt_pk(o2[0].z, o2[0].w); w.z = cvt_pk(o2[1].x, o2[1].y); w.w = cvt_pk(o2[1].z, o2[1].w);
                    *(u32x4*)(Y + rowg * D + g * 128 + 64 * half + 32 * np + 8 * fq) = w; }
            }
            if (!pass) { s += __shfl_xor(s, 16); s += __shfl_xor(s, 32); if (fq == 0) red2[(16 * (mbase + m) + fr) * 8 + wid] = s; }
        }
        if (!pass) __syncthreads();
    }
}

__device__ __forceinline__ void m2_phase(const Params& p_, LAS unsigned char* lds, int G, int l) {
    const Params p = launder(p_);
    int tid_ = threadIdx.x; asm volatile("" : "+v"(tid_));
    const int tid = tid_, lane = tid & 63, wid = __builtin_amdgcn_readfirstlane(tid >> 6), fr = lane & 15, fq = lane >> 4;
    LAS float* segA = (LAS float*)lds; LAS float* segH = (LAS float*)(lds + 16384); LAS float* carr = (LAS float*)(lds + 32768);
    LAS float* red1 = (LAS float*)(lds + 34816); LAS float* red2 = (LAS float*)(lds + 37888);
    const bf16* proj = (const bf16*)(p.ws + WS_PROJ); bf16* Y = (bf16*)(p.ws + WS_Y);
    const bf16* hl = (const bf16*)(p.ws + WS_HL); const bf16* Pp = (const bf16*)(p.ws + WS_P);
    const float* carA = (const float*)(p.ws + WS_CARA); const float* carH = (const float*)(p.ws + WS_CARH);
    const int g = wid >> 1, half = wid & 1, kwin = 2 << g;
    const bf16* Wp = (const bf16*)(p.ws + WS_POOLW) + (size_t)(l * 4 + g) * 16384;
    const float* pbias = p.in[5] + l * DH; const float* pscale = p.in[6] + l * DH;
    for (int unit = blockIdx.x; unit < 256; unit += G) {
        const int b = unit >> 7, c = unit & 127, t0 = c ? NMETA + 64 * c : 0, NM = c ? 4 : 5;
        {
            const int q = (c + 7) >> 3, jlo = wid * q, jhi = (jlo + q < c) ? jlo + q : c;
            f32x4 A0 = {1.f, 1.f, 1.f, 1.f}, A1 = A0, H0 = {0.f, 0.f, 0.f, 0.f}, H1 = H0;
            for (int j = jlo; j < jhi; j += 8) {
                f32x4 a0[8], a1[8], h0[8], h1[8];
#pragma unroll
                for (int i = 0; i < 8; ++i) { const int jj = (j + i < jhi) ? j + i : jhi - 1; const size_t o = (size_t)(b * 128 + jj) * DH + 8 * lane;
                    a0[i] = *(const f32x4*)(carA + o); a1[i] = *(const f32x4*)(carA + o + 4); h0[i] = *(const f32x4*)(carH + o); h1[i] = *(const f32x4*)(carH + o + 4); }
#pragma unroll
                for (int i = 0; i < 8; ++i) if (j + i < jhi) { H0 = a0[i] * H0 + h0[i]; A0 = A0 * a0[i]; H1 = a1[i] * H1 + h1[i]; A1 = A1 * a1[i]; }
            }
            *(LAS f32x4*)(segA + wid * DH + 8 * lane) = A0; *(LAS f32x4*)(segA + wid * DH + 8 * lane + 4) = A1;
            *(LAS f32x4*)(segH + wid * DH + 8 * lane) = H0; *(LAS f32x4*)(segH + wid * DH + 8 * lane + 4) = H1;
        }
        __syncthreads();
        { float cy = 0.f;
#pragma unroll
          for (int s8 = 0; s8 < 8; ++s8) cy = segA[s8 * DH + tid] * cy + segH[s8 * DH + tid];
          carr[tid] = cy; }
        __syncthreads();
        {
            float cr[16];
#pragma unroll
            for (int ks = 0; ks < 2; ++ks) { const f32x4 c0 = *(const LAS f32x4*)(carr + wid * 64 + 32 * ks + 8 * fq), c1 = *(const LAS f32x4*)(carr + wid * 64 + 32 * ks + 8 * fq + 4);
                cr[8 * ks + 0] = c0.x; cr[8 * ks + 1] = c0.y; cr[8 * ks + 2] = c0.z; cr[8 * ks + 3] = c0.w; cr[8 * ks + 4] = c1.x; cr[8 * ks + 5] = c1.y; cr[8 * ks + 6] = c1.z; cr[8 * ks + 7] = c1.w; }
            m2_rnn_round<4, false>(lds, hl, Pp, proj, Y, red1, cr, b, t0, 0, wid, fr, fq);
            if (NM == 5) m2_rnn_round<1, false>(lds, hl, Pp, proj, Y, red1, cr, b, t0, 4, wid, fr, fq);
        }
        m2_pool_round<4>(proj, Y, Wp, pbias, pscale, red2, b, t0, 0, g, half, kwin, wid, fr, fq);
        if (NM == 5) m2_pool_round<1>(proj, Y, Wp, pbias, pscale, red2, b, t0, 4, g, half, kwin, wid, fr, fq);
    }
    __syncthreads();
}

__device__ __forceinline__ void final_norm(const Params& p_, int G) {
    const Params p = launder(p_);
    int tid_ = threadIdx.x; asm volatile("" : "+v"(tid_));
    const int tid = tid_, lane = tid & 63, wid = tid >> 6; const int gw = blockIdx.x * 8 + wid, NGW = G * 8;
    const bf16* hb = (const bf16*)(p.ws + WS_HB);
    const f32x4* gp = (const f32x4*)p.in[19] + 2 * lane; f32x4 gg[2][2];
#pragma unroll
    for (int j = 0; j < 2; ++j) { gg[j][0] = gp[128 * j]; gg[j][1] = gp[128 * j + 1]; }
    for (int m = gw; m < M; m += NGW) {
        const u32x4* xr = (const u32x4*)(hb + (size_t)m * D) + lane; float v[2][8]; float s = 0.f;
#pragma unroll
        for (int j = 0; j < 2; ++j) { unpack8(xr[64 * j], v[j]);
#pragma unroll
            for (int e = 0; e < 8; ++e) s = fmaf(v[j][e], v[j][e], s); }
        const float rs = 1.0f / sqrtf(wave_sum(s) * (1.0f / D) + EPS);
        f32x4* orow = (f32x4*)(p.out + (size_t)m * D) + 2 * lane;
#pragma unroll
        for (int j = 0; j < 2; ++j) {
            orow[128 * j] = (f32x4){v[j][0] * rs * gg[j][0].x, v[j][1] * rs * gg[j][0].y, v[j][2] * rs * gg[j][0].z, v[j][3] * rs * gg[j][0].w};
            orow[128 * j + 1] = (f32x4){v[j][4] * rs * gg[j][1].x, v[j][5] * rs * gg[j][1].y, v[j][6] * rs * gg[j][1].z, v[j][7] * rs * gg[j][1].w}; }
    }
}


template <int KW> __device__ __forceinline__ float pool_win(float P, float Sp) {
    float w = P;
    if (KW < 16) w -= dppf<0x110 + (KW & 15)>(0.f, P);
    return w + dppf<0x100 + (17 - KW)>(0.f, Sp);
}
template <int KW, int MAXG> __device__ __forceinline__ void pool_frags(const bf16* proj, bf16x8 (&pfr)[MAXG][4], int b, int tb, int cnt, int g, int fr, int fq) {
#pragma unroll
    for (int ks = 0; ks < 4; ++ks) {
        const int chb = g * 128 + 32 * ks + 8 * fq;
        float Sp[8];
        if (tb) { const u32x4 raw = *(const u32x4*)(proj + ((size_t)b * TT + tb - 16 + fr) * DIN + chb); unpack8(raw, Sp);
#pragma unroll
            for (int e = 0; e < 8; ++e) { Sp[e] += dppf<0x101>(0.f, Sp[e]); Sp[e] += dppf<0x102>(0.f, Sp[e]); Sp[e] += dppf<0x104>(0.f, Sp[e]); Sp[e] += dppf<0x108>(0.f, Sp[e]); } }
        else {
#pragma unroll
            for (int e = 0; e < 8; ++e) Sp[e] = 0.f; }
#pragma unroll
        for (int mi = 0; mi < MAXG; ++mi) if (mi < cnt) {
            const int t = tb + 16 * mi + fr;
            const u32x4 raw = *(const u32x4*)(proj + ((size_t)b * TT + t) * DIN + chb); float u[8], po[8]; unpack8(raw, u);
            const int cn = (t + 1 < KW) ? t + 1 : KW; const float rc = __builtin_amdgcn_rcpf((float)cn);
#pragma unroll
            for (int e = 0; e < 8; ++e) {
                float P = u[e]; P += dppf<0x111>(0.f, P); P += dppf<0x112>(0.f, P); P += dppf<0x114>(0.f, P); P += dppf<0x118>(0.f, P);
                float S = u[e]; S += dppf<0x101>(0.f, S); S += dppf<0x102>(0.f, S); S += dppf<0x104>(0.f, S); S += dppf<0x108>(0.f, S);
                po[e] = fmaf(pool_win<KW>(P, Sp[e]), rc, -u[e]); Sp[e] = S;
            }
            pfr[mi][ks] = __builtin_bit_cast(bf16x8, pack8(po));
        }
    }
}
__device__ __forceinline__ void m2_pool2(const bf16* proj, bf16* Y, const bf16* Wp, const float* pbias, const float* pscale, LAS float* red2, int b, int t0, int NM, int g, int th, int fr, int fq) {
    const int m0 = th ? (NM == 5 ? 3 : 2) : 0, cnt = th ? 2 : (NM == 5 ? 3 : 2), tb = t0 + 16 * m0;
    bf16x8 pfr[3][4];
    switch (g) {
        case 0: pool_frags<2, 3>(proj, pfr, b, tb, cnt, g, fr, fq); break;
        case 1: pool_frags<4, 3>(proj, pfr, b, tb, cnt, g, fr, fq); break;
        case 2: pool_frags<8, 3>(proj, pfr, b, tb, cnt, g, fr, fq); break;
        default: pool_frags<16, 3>(proj, pfr, b, tb, cnt, g, fr, fq); break;
    }
    f32x4 ov[3][8]; float sq[3] = {0.f, 0.f, 0.f};
#pragma unroll
    for (int n = 0; n < 8; ++n) {
        bf16x8 wf[4];
#pragma unroll
        for (int ks = 0; ks < 4; ++ks) wf[ks] = *(const bf16x8*)(Wp + (size_t)outchan(n, fr) * 128 + 32 * ks + 8 * fq);
        const int col = g * 128 + 32 * (n >> 1) + 8 * fq + 4 * (n & 1);
        const f32x4 pb = *(const f32x4*)(pbias + col), ps = *(const f32x4*)(pscale + col);
#pragma unroll
        for (int mi = 0; mi < 3; ++mi) if (mi < cnt) {
            f32x4 acc = {0.f, 0.f, 0.f, 0.f};
#pragma unroll
            for (int ks = 0; ks < 4; ++ks) acc = __builtin_amdgcn_mfma_f32_16x16x32_bf16(wf[ks], pfr[mi][ks], acc, 0, 0, 0);
            acc = (acc + pb) * ps; ov[mi][n] = acc; sq[mi] += (acc.x * acc.x + acc.y * acc.y) + (acc.z * acc.z + acc.w * acc.w);
        }
    }
#pragma unroll
    for (int mi = 0; mi < 3; ++mi) if (mi < cnt) { float s = sq[mi]; s += __shfl_xor(s, 16); s += __shfl_xor(s, 32); if (fq == 0) red2[(16 * (m0 + mi) + fr) * 4 + g] = s; }
    __syncthreads();
#pragma unroll
    for (int mi = 0; mi < 3; ++mi) if (mi < cnt) {
        const size_t rowg = (size_t)b * TT + tb + 16 * mi + fr;
        const f32x4 r0 = *(const LAS f32x4*)(red2 + (16 * (m0 + mi) + fr) * 4);
        const float rs = __builtin_amdgcn_rsqf(((r0.x + r0.y) + (r0.z + r0.w)) * (1.0f / DH) + EPS);
#pragma unroll
        for (int np = 0; np < 4; ++np) {
            const f32x4 a = ov[mi][2 * np] * rs, bq = ov[mi][2 * np + 1] * rs;
            u32x4 w; w.x = cvt_pk(a.x, a.y); w.y = cvt_pk(a.z, a.w); w.z = cvt_pk(bq.x, bq.y); w.w = cvt_pk(bq.z, bq.w);
            *(u32x4*)(Y + rowg * D + g * 128 + 32 * np + 8 * fq) = w;
        }
    }
}

#ifndef PROBE_PHASE
#define PROBE_PHASE (-1)
#endif
#ifndef PROBE_BLOCK
#define PROBE_BLOCK 0
#endif
#define TIC() do { if (PROBE_PHASE >= 0) tic = __builtin_amdgcn_s_memrealtime(); } while (0)
#define TOC(k) do { if (PROBE_PHASE == (k)) tacc += __builtin_amdgcn_s_memrealtime() - tic; } while (0)

__device__ __forceinline__ void mixer_phase(const Params& p_, LAS unsigned char* lds, int G, int l, unsigned long long& tic, unsigned long long& tacc) {
    const Params p = launder(p_);
    int tid_ = threadIdx.x; asm volatile("" : "+v"(tid_));
    const int tid = tid_, lane = tid & 63, wid = __builtin_amdgcn_readfirstlane(tid >> 6), fr = lane & 15, fq = lane >> 4;
    LAS float* cst = (LAS float*)(lds + LDS_CST);
    const bf16* proj = (const bf16*)(p.ws + WS_PROJ);
    const bf16* Wr = (const bf16*)(p.ws + WS_GR) + (size_t)(l * 8 + wid) * 4096; const bf16* Wi = (const bf16*)(p.ws + WS_GI) + (size_t)(l * 8 + wid) * 4096;
    LAS float* segA = (LAS float*)(lds + LDS_CST); LAS float* segH = (LAS float*)(lds + LDS_CST + 8192); LAS float* carr = (LAS float*)(lds + LDS_CARR);
    LAS float* red1 = (LAS float*)(lds + LDS_RED1); LAS float* red2 = (LAS float*)(lds + LDS_RED2);
    bf16* Y = (bf16*)(p.ws + WS_Y);
    const int g = wid >> 1, half = wid & 1, kwin = 2 << g;
    const bf16* Wp = (const bf16*)(p.ws + WS_POOLW) + (size_t)(l * 4 + g) * 16384;
    const float* pbias = p.in[5] + l * DH; const float* pscale = p.in[6] + l * DH;
    unsigned* flags = (unsigned*)(p.ws + WS_FLAG); unsigned* car = (unsigned*)(p.ws + WS_CARA);
    bf16* hl = (bf16*)(p.ws + WS_HL); bf16* Pp = (bf16*)(p.ws + WS_P);
    float* carA = (float*)(p.ws + WS_CARA); float* carH = (float*)(p.ws + WS_CARH);
    const int unit = blockIdx.x;
    if (unit < 256) {
        const int b = unit >> 7, c = unit & 127, t0 = c ? NMETA + 64 * c : 0, NM = c ? 4 : 5;
        TIC();
        float cv[8];
#pragma unroll
        for (int k4 = 0; k4 < 4; ++k4) cv[k4] = p.in[7][(l * 4 + k4) * DH + tid];
        cv[4] = p.in[8][l * DH + tid]; cv[5] = p.in[10][l * DH + tid]; cv[6] = p.in[12][l * DH + tid]; cv[7] = ((const float*)(p.ws + WS_SP))[l * DH + tid];
        bf16x8 wfr[4][2][2];
#pragma unroll
        for (int n = 0; n < 4; ++n)
#pragma unroll
            for (int ks = 0; ks < 2; ++ks) { wfr[n][ks][0] = *(const bf16x8*)(Wr + outchan(n, fr) * 64 + 32 * ks + 8 * fq); wfr[n][ks][1] = *(const bf16x8*)(Wi + outchan(n, fr) * 64 + 32 * ks + 8 * fq); }
        LAS float* cslot = (LAS float*)(lds + LDS_CARRY) + (wid * 4 + fq) * 32;
        if (fr == 15) {
#pragma unroll
            for (int k4 = 0; k4 < 4; ++k4) { *(LAS f32x4*)(cslot + 4 * k4) = (f32x4){0.f, 0.f, 0.f, 0.f}; *(LAS f32x4*)(cslot + 16 + 4 * k4) = (f32x4){1.f, 1.f, 1.f, 1.f}; } }
        u32x4 raw[2][4];
#pragma unroll
        for (int ks = 0; ks < 2; ++ks)
#pragma unroll
            for (int d = 0; d < 4; ++d) { const int tt = t0 + fr - 3 + d; raw[ks][d] = (u32x4){0u, 0u, 0u, 0u};
                if (tt >= 0) raw[ks][d] = *(const u32x4*)(proj + ((size_t)b * TT + tt) * DIN + DH + wid * 64 + 32 * ks + 8 * fq); }
        __syncthreads();
#pragma unroll
        for (int k8 = 0; k8 < 8; ++k8) cst[k8 * DH + tid] = cv[k8];
        __syncthreads();
        TOC(10); TIC();
#pragma unroll 1
        for (int m = 0; m < NM; ++m) {
            const int t = t0 + 16 * m + fr; const size_t rowg = (size_t)b * TT + t;
            u32x4 nraw[2][4];
#pragma unroll
            for (int ks = 0; ks < 2; ++ks)
#pragma unroll
                for (int d = 0; d < 4; ++d) { nraw[ks][d] = (u32x4){0u, 0u, 0u, 0u};
                    if (m + 1 < NM) nraw[ks][d] = *(const u32x4*)(proj + ((size_t)b * TT + t + 13 + d) * DIN + DH + wid * 64 + 32 * ks + 8 * fq); }
            float xc[2][8]; bf16x8 frag[2];
#pragma unroll
            for (int ks = 0; ks < 2; ++ks) {
                const int chb = wid * 64 + 32 * ks + 8 * fq;
                { const f32x4 c0 = *(const LAS f32x4*)(cst + 4 * DH + chb), c1 = *(const LAS f32x4*)(cst + 4 * DH + chb + 4);
                  xc[ks][0] = c0.x; xc[ks][1] = c0.y; xc[ks][2] = c0.z; xc[ks][3] = c0.w; xc[ks][4] = c1.x; xc[ks][5] = c1.y; xc[ks][6] = c1.z; xc[ks][7] = c1.w; }
#pragma unroll
                for (int d = 0; d < 4; ++d) {
                    float u[8]; unpack8(raw[ks][d], u);
                    const f32x4 w0 = *(const LAS f32x4*)(cst + d * DH + chb), w1 = *(const LAS f32x4*)(cst + d * DH + chb + 4);
                    xc[ks][0] += u[0] * w0.x; xc[ks][1] += u[1] * w0.y; xc[ks][2] += u[2] * w0.z; xc[ks][3] += u[3] * w0.w;
                    xc[ks][4] += u[4] * w1.x; xc[ks][5] += u[5] * w1.y; xc[ks][6] += u[6] * w1.z; xc[ks][7] += u[7] * w1.w;
                    raw[ks][d] = nraw[ks][d];
                }
                frag[ks] = __builtin_bit_cast(bf16x8, pack8(xc[ks]));
            }
            f32x4 ar[4], ai[4];
#pragma unroll
            for (int n = 0; n < 4; ++n) { ar[n] = (f32x4){0.f, 0.f, 0.f, 0.f}; ai[n] = (f32x4){0.f, 0.f, 0.f, 0.f};
#pragma unroll
                for (int ks = 0; ks < 2; ++ks) {
                    const bf16x8 wr_ = wfr[n][ks][0], wi_ = wfr[n][ks][1];
                    ar[n] = __builtin_amdgcn_mfma_f32_16x16x32_bf16(wr_, frag[ks], ar[n], 0, 0, 0);
                    ai[n] = __builtin_amdgcn_mfma_f32_16x16x32_bf16(wi_, frag[ks], ai[n], 0, 0, 0);
                } }
            float Aa[16], Bb[16];
#pragma unroll
            for (int n = 0; n < 4; ++n) {
                const int cho = wid * 64 + 32 * (n >> 1) + 8 * fq + 4 * (n & 1);
                const f32x4 rb = *(const LAS f32x4*)(cst + 5 * DH + cho), ib = *(const LAS f32x4*)(cst + 6 * DH + cho), spv = *(const LAS f32x4*)(cst + 7 * DH + cho);
#pragma unroll
                for (int jj = 0; jj < 4; ++jj) {
                    const float r = sigm(ar[n][jj] + rb[jj]), ig = sigm(ai[n][jj] + ib[jj]);
                    const float la = -8.0f * r * spv[jj], a = __expf(la), x2 = 2.0f * la;
                    const float m2s = -x2 * (1.0f + x2 * (0.5f + x2 * (0.16666667f + x2 * 0.041666668f))), m2 = (x2 > -0.0625f) ? m2s : 1.0f - a * a;
                    Aa[n * 4 + jj] = a; Bb[n * 4 + jj] = __builtin_amdgcn_sqrtf(m2) * ig * xc[n >> 1][4 * (n & 1) + jj];
                }
            }
#pragma unroll
            for (int k = 0; k < 16; ++k) {
                float A = Aa[k], B = Bb[k], Ap, Bq;
                Ap = dppf<0x111>(1.f, A); Bq = dppf<0x111>(0.f, B); B = fmaf(A, Bq, B); A *= Ap;
                Ap = dppf<0x112>(1.f, A); Bq = dppf<0x112>(0.f, B); B = fmaf(A, Bq, B); A *= Ap;
                Ap = dppf<0x114>(1.f, A); Bq = dppf<0x114>(0.f, B); B = fmaf(A, Bq, B); A *= Ap;
                Ap = dppf<0x118>(1.f, A); Bq = dppf<0x118>(0.f, B); B = fmaf(A, Bq, B); A *= Ap;
                Bb[k] = B; Aa[k] = A;
            }
            {
                float Hc[16], Pc[16];
#pragma unroll
                for (int k4 = 0; k4 < 4; ++k4) { const f32x4 hq = *(const LAS f32x4*)(cslot + 4 * k4), pq = *(const LAS f32x4*)(cslot + 16 + 4 * k4);
                    Hc[4 * k4] = hq.x; Hc[4 * k4 + 1] = hq.y; Hc[4 * k4 + 2] = hq.z; Hc[4 * k4 + 3] = hq.w; Pc[4 * k4] = pq.x; Pc[4 * k4 + 1] = pq.y; Pc[4 * k4 + 2] = pq.z; Pc[4 * k4 + 3] = pq.w; }
#pragma unroll
                for (int k = 0; k < 16; ++k) { Bb[k] = fmaf(Aa[k], Hc[k], Bb[k]); Aa[k] *= Pc[k]; }
                if (fr == 15) {
#pragma unroll
                    for (int k4 = 0; k4 < 4; ++k4) { *(LAS f32x4*)(cslot + 4 * k4) = (f32x4){Bb[4 * k4], Bb[4 * k4 + 1], Bb[4 * k4 + 2], Bb[4 * k4 + 3]}; *(LAS f32x4*)(cslot + 16 + 4 * k4) = (f32x4){Aa[4 * k4], Aa[4 * k4 + 1], Aa[4 * k4 + 2], Aa[4 * k4 + 3]}; } }
            }
#pragma unroll
            for (int ks = 0; ks < 2; ++ks) {
                const size_t o = rowg * DH + wid * 64 + 32 * ks + 8 * fq;
                u32x4 wh; wh.x = cvt_pk(Bb[8 * ks + 0], Bb[8 * ks + 1]); wh.y = cvt_pk(Bb[8 * ks + 2], Bb[8 * ks + 3]); wh.z = cvt_pk(Bb[8 * ks + 4], Bb[8 * ks + 5]); wh.w = cvt_pk(Bb[8 * ks + 6], Bb[8 * ks + 7]);
                u32x4 w; w.x = cvt_pk(Aa[8 * ks + 0], Aa[8 * ks + 1]); w.y = cvt_pk(Aa[8 * ks + 2], Aa[8 * ks + 3]); w.z = cvt_pk(Aa[8 * ks + 4], Aa[8 * ks + 5]); w.w = cvt_pk(Aa[8 * ks + 6], Aa[8 * ks + 7]);
                if (m < 4) { *(LAS u32x4*)(lds + LDS_HL + wid * 8192 + ((m * 2 + ks) * 64 + lane) * 16) = wh; *(LAS u32x4*)(lds + LDS_P + wid * 8192 + ((m * 2 + ks) * 64 + lane) * 16) = w; }
                else { *(u32x4*)(hl + o) = wh; *(u32x4*)(Pp + o) = w; }
            }
        }
        TOC(11); TIC();
        if (fr == 0) {
            float Hc[16], Pc[16];
#pragma unroll
            for (int k4 = 0; k4 < 4; ++k4) { const f32x4 hq = *(const LAS f32x4*)(cslot + 4 * k4), pq = *(const LAS f32x4*)(cslot + 16 + 4 * k4);
                Hc[4 * k4] = hq.x; Hc[4 * k4 + 1] = hq.y; Hc[4 * k4 + 2] = hq.z; Hc[4 * k4 + 3] = hq.w; Pc[4 * k4] = pq.x; Pc[4 * k4 + 1] = pq.y; Pc[4 * k4 + 2] = pq.z; Pc[4 * k4 + 3] = pq.w; }
#pragma unroll
            for (int ks = 0; ks < 2; ++ks) {
                const size_t o = (size_t)(b * 128 + c) * DH + wid * 64 + 32 * ks + 8 * fq;
#pragma unroll
                for (int e2 = 0; e2 < 4; ++e2) {
                    const unsigned lo = cvt_pk(Pc[8 * ks + 2 * e2], Hc[8 * ks + 2 * e2]), hi = cvt_pk(Pc[8 * ks + 2 * e2 + 1], Hc[8 * ks + 2 * e2 + 1]);
                    __hip_atomic_store((unsigned long long*)(car + o) + e2, ((unsigned long long)hi << 32) | lo, __ATOMIC_RELAXED, __HIP_MEMORY_SCOPE_AGENT); }
            }
        }
        int fr2 = fr, fq2 = fq, tid2 = tid; asm volatile("" : "+v"(fr2), "+v"(fq2), "+v"(tid2));
        TOC(12); TIC();
#ifndef NO_MX_POOL
        m2_pool2(proj, Y, Wp, pbias, pscale, red2, b, t0, NM, g, half, fr2, fq2);
#endif
        asm volatile("s_waitcnt vmcnt(0)" ::: "memory");
        __syncthreads();
        if (tid2 == 0) __hip_atomic_store(flags + unit, (unsigned)(l + 1), __ATOMIC_RELAXED, __HIP_MEMORY_SCOPE_AGENT);
        TOC(13); TIC();
        if (tid2 < c) { unsigned sp = 0; while (__hip_atomic_load(flags + b * 128 + tid2, __ATOMIC_RELAXED, __HIP_MEMORY_SCOPE_AGENT) < (unsigned)(l + 1)) { __builtin_amdgcn_s_sleep(2); if (++sp > (1u << 22)) break; } }
#if defined(MIXER_ACQ_FENCE)
        if (tid2 < c) __builtin_amdgcn_fence(__ATOMIC_ACQUIRE, "agent");
#endif
        __syncthreads();
        TOC(14); TIC();
        {
            const int q = (c + 3) >> 2, seg = tid2 >> 7, cgi = tid2 & 127, jlo = seg * q, jhi = (jlo + q < c) ? jlo + q : c;
            f32x4 A0 = {1.f, 1.f, 1.f, 1.f}, H0 = {0.f, 0.f, 0.f, 0.f};
            for (int j = jlo; j < jhi; j += 16) {
                unsigned long long w0[16], w1[16];
#pragma unroll
                for (int i = 0; i < 16; ++i) { const int jj = (j + i < jhi) ? j + i : jhi - 1; const size_t o = (size_t)(b * 128 + jj) * DH + 4 * cgi;
                    w0[i] = __hip_atomic_load((const unsigned long long*)(car + o), __ATOMIC_RELAXED, __HIP_MEMORY_SCOPE_AGENT); w1[i] = __hip_atomic_load((const unsigned long long*)(car + o) + 1, __ATOMIC_RELAXED, __HIP_MEMORY_SCOPE_AGENT); }
#pragma unroll
                for (int i = 0; i < 16; ++i) if (j + i < jhi) {
                    const f32x4 a = {bf_lo((unsigned)w0[i]), bf_lo((unsigned)(w0[i] >> 32)), bf_lo((unsigned)w1[i]), bf_lo((unsigned)(w1[i] >> 32))};
                    const f32x4 h = {bf_hi((unsigned)w0[i]), bf_hi((unsigned)(w0[i] >> 32)), bf_hi((unsigned)w1[i]), bf_hi((unsigned)(w1[i] >> 32))};
                    H0 = a * H0 + h; A0 = A0 * a; }
            }
            *(LAS f32x4*)(segA + seg * DH + 4 * cgi) = A0; *(LAS f32x4*)(segH + seg * DH + 4 * cgi) = H0;
        }
        __syncthreads();
        { float cy = 0.f;
#pragma unroll
          for (int s4 = 0; s4 < 4; ++s4) cy = segA[s4 * DH + tid2] * cy + segH[s4 * DH + tid2];
          carr[tid2] = cy; }
        __syncthreads();
        TOC(15); TIC();
        {
            float cr[16];
#pragma unroll
            for (int ks = 0; ks < 2; ++ks) { const f32x4 c0 = *(const LAS f32x4*)(carr + wid * 64 + 32 * ks + 8 * fq2), c1 = *(const LAS f32x4*)(carr + wid * 64 + 32 * ks + 8 * fq2 + 4);
                cr[8 * ks + 0] = c0.x; cr[8 * ks + 1] = c0.y; cr[8 * ks + 2] = c0.z; cr[8 * ks + 3] = c0.w; cr[8 * ks + 4] = c1.x; cr[8 * ks + 5] = c1.y; cr[8 * ks + 6] = c1.z; cr[8 * ks + 7] = c1.w; }
#ifndef NO_MX_RNN
            m2_rnn_round<4, true>(lds, hl, Pp, proj, Y, red1, cr, b, t0, 0, wid, fr2, fq2);
            if (NM == 5) m2_rnn_round<1, false>(lds, hl, Pp, proj, Y, red1, cr, b, t0, 4, wid, fr2, fq2);
#endif
        }
        TOC(16);
    }
    __syncthreads();
}

#define XB_TMO      128
#define XB_XCNT(j)  (256  + 64 * (j))
#define XB_XSUB(j)  (1280 + 64 * (j))
#define XB_XGEN(j)  (2304 + 64 * (j))
#define XB_TOP      3328
#define XB_TOPGEN   3392
#define XCD_BAR_WORDS 3456
#define XB_SPIN_CAP (1u << 18)

__device__ __forceinline__ unsigned xb_ld(unsigned* p)              { return __hip_atomic_load(p, __ATOMIC_RELAXED, __HIP_MEMORY_SCOPE_AGENT); }
__device__ __forceinline__ unsigned xb_add(unsigned* p, unsigned v) { return __hip_atomic_fetch_add(p, v, __ATOMIC_RELAXED, __HIP_MEMORY_SCOPE_AGENT); }
__device__ __forceinline__ unsigned xb_xcc_id() { return (unsigned)__builtin_amdgcn_s_getreg((3 << 11) | 20) & 0xFu; }
#define XB_SPIN(cond, bar) do { unsigned _sp = 0; while (cond) { __builtin_amdgcn_s_sleep(1); \
    if ((++_sp & 255u) == 0u) { if (xb_ld(&(bar)[XB_TMO])) break; if (_sp > XB_SPIN_CAP) { atomicAdd(&(bar)[XB_TMO], 1u); break; } } } } while (0)

struct XcdBarrier {
    unsigned* bar; unsigned x;
    volatile LAS unsigned* st;
};

__device__ __forceinline__ XcdBarrier xcd_barrier_post(unsigned* bar, volatile LAS unsigned* st) {
    XcdBarrier b; b.bar = bar; b.x = xb_xcc_id(); b.st = st;
    if (threadIdx.x == 0) (void)xb_add(&bar[XB_XCNT(b.x)], 1u);
    return b;
}
__device__ __forceinline__ void xcd_barrier_complete(unsigned* bar, unsigned x, unsigned& nloc, unsigned& nx) {
    const unsigned G = gridDim.x * gridDim.y * gridDim.z;
    unsigned sum, cnt, mine, sp = 0u;
    for (;;) {
        sum = 0u; cnt = 0u; mine = 0u;
#pragma unroll
        for (unsigned j = 0; j < 16; ++j) { const unsigned c = xb_ld(&bar[XB_XCNT(j)]); sum += c; cnt += (c > 0u) ? 1u : 0u; mine = (j == x) ? c : mine; }
        if (sum == G) break;
        __builtin_amdgcn_s_sleep(1);
        if ((++sp & 255u) == 0u) { if (xb_ld(&bar[XB_TMO])) break; if (sp > XB_SPIN_CAP) { atomicAdd(&bar[XB_TMO], 1u); break; } }
    }
    nloc = mine > 0u ? mine : 1u; nx = cnt > 0u ? cnt : 1u;
}

__device__ __forceinline__ void xcd_barrier(const XcdBarrier& b) {
    asm volatile("s_waitcnt vmcnt(0)" ::: "memory");
    __syncthreads();
    if (threadIdx.x == 0) {
        unsigned* bar = b.bar;
        __builtin_amdgcn_s_waitcnt(0);
        unsigned nloc = b.st[0], nx = b.st[1];
        if (nloc == 0u) { xcd_barrier_complete(bar, b.x, nloc, nx); b.st[0] = nloc; b.st[1] = nx; }
        const unsigned old = xb_add(&bar[XB_XSUB(b.x)], 1u);
        const unsigned gen = old / nloc;
        if (old + 1u == (gen + 1u) * nloc) {
            __builtin_amdgcn_fence(__ATOMIC_RELEASE, "agent");
            asm volatile("s_waitcnt vmcnt(0)" ::: "memory");
            const unsigned og = xb_add(&bar[XB_TOP], 1u);
            const unsigned tg = og / nx;
            if (og + 1u == (tg + 1u) * nx) xb_add(&bar[XB_TOPGEN], 1u);
            else XB_SPIN(xb_ld(&bar[XB_TOPGEN]) == tg, bar);
            __builtin_amdgcn_fence(__ATOMIC_ACQUIRE, "agent");
            asm volatile("s_waitcnt vmcnt(0)" ::: "memory");
        } else {
            XB_SPIN(xb_ld(&bar[XB_TOPGEN]) == gen, bar);
            __builtin_amdgcn_fence(__ATOMIC_ACQUIRE, "agent");
            asm volatile("s_waitcnt vmcnt(0)" ::: "memory");
        }
    }
    __syncthreads();
}

#ifndef PROBE_SYNC2
#define PROBE_SYNC2 0
#endif
#ifndef PROBE_M1X2
#define PROBE_M1X2 0
#endif
#ifndef PROBE_M2X2
#define PROBE_M2X2 0
#endif
#define GSYNC() do { { __attribute__((address_space(1))) unsigned* gb_ = (__attribute__((address_space(1))) unsigned*)xbar.bar; asm volatile("" : "+s"(gb_)); xbar.bar = (unsigned*)gb_; asm volatile("" : "+s"(xbar.x)); } xcd_barrier(xbar); if (PROBE_SYNC2) xcd_barrier(xbar); } while (0)
__device__ __forceinline__ int rstd_cache(LAS unsigned char* lds, const float* ss, const pg8::StaticOrder& S) {
    pg8::Unit u0; int pmc = -1;
    int tid = threadIdx.x; asm volatile("" : "+v"(tid));
    if (S.next(0, u0)) { pmc = u0.pm; if (tid < 256) ((LAS float*)(lds + 131072))[tid] = row_rstd(ss, u0.pm * 256 + tid); }
    asm volatile("s_waitcnt vmcnt(0) lgkmcnt(0)" ::: "memory");
    return pmc;
}
__global__ void __launch_bounds__(512, 2) fwd_megakernel(Params p) {
    extern __shared__ __attribute__((aligned(16))) unsigned char lds_raw[];
    LAS unsigned char* lds = (LAS unsigned char*)lds_raw;
    cg::grid_group grid = cg::this_grid();
    const int G = gridDim.x;
    unsigned long long tic = 0, tacc = 0;
    unsigned char* ws = p.ws;
    volatile LAS unsigned* xst = (volatile LAS unsigned*)(lds + LDS_XST);
    if (threadIdx.x < 2) xst[threadIdx.x] = 0u;
    __syncthreads();
    XcdBarrier xbar = xcd_barrier_post((unsigned*)(ws + WS_CTL), xst);
    bf16* hb = (bf16*)(ws + WS_HB); bf16* proj = (bf16*)(ws + WS_PROJ); bf16* Y = (bf16*)(ws + WS_Y); bf16* mid = (bf16*)(ws + WS_MID); float* ss = (float*)(ws + WS_SS);
    grid.sync();
    TIC();
#ifndef NO_PRO
    prologue(p, lds, G);
#endif
    GSYNC();
    TOC(0);
#pragma unroll 1
    for (int l = 0; l < DEPTH; ++l) {
        { __attribute__((address_space(1))) unsigned char* gws = (__attribute__((address_space(1))) unsigned char*)ws; asm volatile("" : "+s"(gws)); ws = (unsigned char*)gws; }
        const unsigned char* wl = ws + WS_W + (size_t)l * W_LAYER;
        const bf16* in_t = (const bf16*)(wl + W_IN); const bf16* out_t = (const bf16*)(wl + W_OUT); const bf16* up_t = (const bf16*)(wl + W_UP); const bf16* down_t = (const bf16*)(wl + W_DOWN);
        TIC();
#ifndef NO_GIN
        { pg8::Gemm g{hb, in_t, M, DIN, D, 0}; pg8::StaticOrder S; S.init(M, DIN, G, (int)blockIdx.x); const int pmc = rstd_cache(lds, ss, S); EpiIn E{proj, ss, (const LAS float*)(lds + 131072), pmc};
          pg8::gemm_phase<EpiIn, pg8::StaticOrder, true, true>(lds, g, S, E); }
#endif
#ifndef NO_META
        meta_tasks<0>(p, lds, G, nullptr, 0, in_t, D, DIN / 16);
#endif
        if (G == 256 && blockIdx.x >= 128) {
            const int lo = l * TITEMS_PER_LAYER + TITEMS_IN, hi = (l + 1 < DEPTH) ? (l + 1) * TITEMS_PER_LAYER + TITEMS_IN : DEPTH * TITEMS_PER_LAYER;
            convert_items(p, lds, lo, hi, (int)blockIdx.x - 128, 128 * 8);
        }
        GSYNC();
        TOC(1); TIC();
#ifndef FUSED_MIXER
#define FUSED_MIXER 1
#endif
#if FUSED_MIXER
        mixer_phase(p, lds, G, l, tic, tacc);
        GSYNC();
        TOC(2);
#else
        m1_phase(p, lds, G, l);
        GSYNC();
        TOC(2); TIC();
        m2_phase(p, lds, G, l);
        GSYNC();
#endif
        TOC(3); TIC();
#ifndef NO_GOUT
        { pg8::Gemm g{Y, out_t, M, D, D, NMETA}; pg8::StaticOrder S; S.init(M, D, G, (int)blockIdx.x); EpiRes E{hb, ss};
          pg8::gemm_phase<EpiRes, pg8::StaticOrder, false, true>(lds, g, S, E); }
#endif
#ifndef NO_META
        if (l < DEPTH - 1) meta_tasks<1>(p, lds, G, Y, D, out_t, D, D / 16);
#endif
        GSYNC();
        TOC(4); TIC();
#ifndef NO_GUP
#ifndef STAGGER_UP
#define STAGGER_UP 0
#endif
        if (STAGGER_UP > 0) {
            const unsigned long long w0 = __builtin_amdgcn_s_memrealtime(), dl = (unsigned long long)(((blockIdx.x >> 3) & 3) * STAGGER_UP);
            while (__builtin_amdgcn_s_memrealtime() - w0 < dl) __builtin_amdgcn_s_sleep(4);
        }
        { pg8::Gemm g{hb, up_t, M, FF, D, 0}; pg8::StaticOrder S; S.init(M, FF, G, (int)blockIdx.x); const int pmc = rstd_cache(lds, ss, S); EpiUp E{mid, ss, (const LAS float*)(lds + 131072), pmc};
          pg8::gemm_phase<EpiUp, pg8::StaticOrder, true, true>(lds, g, S, E); }
#endif
#ifndef NO_META
        if (l < DEPTH - 1) meta_tasks<2>(p, lds, G, nullptr, 0, up_t, D, FF / 16);
#endif
        GSYNC();
        TOC(5); TIC();
#ifndef NO_GDN
        { pg8::Gemm g{mid, down_t, M, D, FF, 0}; pg8::StaticOrder S; S.init(M, D, G, (int)blockIdx.x); EpiRes E{hb, ss};
          pg8::gemm_phase<EpiRes, pg8::StaticOrder, false, true>(lds, g, S, E); }
#endif
#ifndef NO_META
        if (l < DEPTH - 1) meta_tasks<1, 16>(p, lds, G, (const bf16*)(ws + WS_MIDMETA), FF, down_t, FF, D / 16);
#endif
        GSYNC();
        TOC(6);
    }
    TIC();
    final_norm(p, G);
    TOC(7);
    if (PROBE_PHASE >= 0 && blockIdx.x == PROBE_BLOCK && threadIdx.x == 0) { const unsigned long long w0 = __builtin_amdgcn_s_memrealtime(); while (__builtin_amdgcn_s_memrealtime() - w0 < 4ull * tacc) __builtin_amdgcn_s_sleep(8); }
}

extern "C" void kernel_launch(void* const* d_in, const int* in_sizes, int n_in, void* d_out, int out_size, void* d_ws, size_t ws_size, hipStream_t stream) {
    static int grid = 0;
    if (grid == 0) {
        if (n_in != 20 || in_sizes[0] != M * D || out_size != M * D || ws_size < WS_END) { fprintf(stderr, "kernel_launch: unexpected shapes (n_in %d, in0 %d, out %d, ws %zu)\n", n_in, n_in > 0 ? in_sizes[0] : -1, out_size, ws_size); grid = -1; return; }
        int dev = 0, cus = 0, per_cu = 0;
        if (hipGetDevice(&dev) != hipSuccess || hipDeviceGetAttribute(&cus, hipDeviceAttributeMultiprocessorCount, dev) != hipSuccess) { grid = -1; return; }
        if (hipFuncSetAttribute((const void*)fwd_megakernel, hipFuncAttributeMaxDynamicSharedMemorySize, LDS_BYTES) != hipSuccess) { fprintf(stderr, "kernel_launch: hipFuncSetAttribute failed\n"); grid = -1; return; }
        if (hipOccupancyMaxActiveBlocksPerMultiprocessor(&per_cu, (const void*)fwd_megakernel, 512, LDS_BYTES) != hipSuccess || per_cu < 1) { fprintf(stderr, "kernel_launch: occupancy query gave %d\n", per_cu); (void)hipGetLastError(); grid = -1; return; }
        grid = cus * 1;
        if (grid < 256) { fprintf(stderr, "kernel_launch: %d CUs; the fused mixer phase needs 256 resident workgroups\n", cus); grid = -1; return; }
    }
    if (grid < 0) return;
    if (hipMemsetAsync((char*)d_ws + WS_CTL, 0, WS_FLAG + 256 * 4, stream) != hipSuccess) { fprintf(stderr, "kernel_launch: memset failed\n"); return; }
    Params p{};
    for (int i = 0; i < 20; ++i) p.in[i] = (const float*)d_in[i];
    p.out = (float*)d_out; p.ws = (unsigned char*)d_ws;
    void* args[] = {&p};
    hipError_t e = hipLaunchCooperativeKernel((const void*)fwd_megakernel, dim3(grid), dim3(512), args, LDS_BYTES, stream);
    if (e != hipSuccess) fprintf(stderr, "cooperative launch failed: %s (grid %d)\n", hipGetErrorString(e), grid);
}
```

```cpp
#include <hip/hip_runtime.h>
#include <hip/hip_cooperative_groups.h>
#include <cstdio>
#include <cstdint>
namespace cg = cooperative_groups;
namespace pg8 {
#define PG8_LAS __attribute__((address_space(3)))
typedef unsigned short bf16_t;
typedef short bf16x8 __attribute__((ext_vector_type(8)));
typedef float f32x4 __attribute__((ext_vector_type(4)));
typedef unsigned u32x4 __attribute__((ext_vector_type(4)));
constexpr int BM = 256, BK = 64, HALF = 128, HTB = HALF * BK * 2  , STAGE_BYTES = 8 * HTB, NXCD = 8, WGM = 8;

__host__ __device__ __forceinline__ int lds_byte(int r, int c) { const int st = (r >> 4) * 2 + (c >> 5), rr = r & 15, cc = c & 31, ob = rr * 64 + cc * 2; return st * 1024 + (ob ^ (((ob >> 9) & 1) << 5)); }
__host__ __device__ __forceinline__ void stage_rc(int b, int& R, int& C) { const int st = b / 1024, sb = b % 1024, swz = sb ^ (((sb >> 9) & 1) << 5); R = (st >> 1) * 16 + swz / 64; C = (st & 1) * 32 + (swz % 64) / 2; }
__host__ __device__ __forceinline__ int perm32(int rho) { const int n = rho >> 4, i = rho & 15; return 8 * (i >> 2) + 4 * n + (i & 3); }

struct Unit { int pm, pn; };
struct Gemm { const bf16_t* A; const bf16_t* Bt; int M, N, K, gap; };

struct StaticOrder {
    int nM, nN, nwg, G, c;
    __host__ __device__ void init(int M, int N, int G_, int c_) { nM = M / BM; nN = N / BM; nwg = nM * nN; G = G_; c = c_; }
    __host__ __device__ bool next(int i, Unit& u) const {
        const long L = (long)i * G + c; if (L >= nwg) return false;
        int wgid = (int)L; { const int q = nwg / NXCD, r = nwg % NXCD, xcd = wgid % NXCD, off = wgid / NXCD; wgid = (xcd < r ? xcd * (q + 1) : r * (q + 1) + (xcd - r) * q) + off; }
        const int nig = WGM * nN, gid = wgid / nig, fm = gid * WGM, gsz = (nM - fm) < WGM ? (nM - fm) : WGM;
        u.pm = fm + ((wgid % nig) % gsz); u.pn = (wgid % nig) / gsz; return true;
    }
    __device__ __forceinline__ void a_ready(const Unit&) const {}
    __device__ __forceinline__ void done(const Unit&) const {}
};
__device__ __forceinline__ unsigned cvt_pk_bf16(float lo, float hi) { unsigned r; asm volatile("v_cvt_pk_bf16_f32 %0, %1, %2" : "=v"(r) : "v"(lo), "v"(hi)); return r; }
template <class Epi, class Sched, bool ALIGN_EPI = false, bool SP2 = false>
__device__ __forceinline__ void gemm_phase(PG8_LAS unsigned char* lds, const Gemm g, const Sched& S, const Epi& E) {
    int tid_ = threadIdx.x; asm volatile("" : "+v"(tid_));
    const int tid = tid_, wid = __builtin_amdgcn_readfirstlane(tid >> 6), lane = tid & 63, wr = wid >> 2, wc = wid & 3, fr = lane & 15, fq = lane >> 4;
    const int K = g.K, nt = K / BK;
    unsigned voffA[2], voffB[2];
#pragma unroll
    for (int i = 0; i < 2; ++i) { int R, C; stage_rc(tid * 16 + i * 8192, R, C); const int Rb = Epi::PERM ? ((R & ~31) + perm32(R & 31)) : R;
        voffA[i] = (unsigned)(R * K + C) * 2u; voffB[i] = (unsigned)(Rb * K + C) * 2u; }
    const size_t kstep = (size_t)(BK * 2);
    const size_t hstep = (size_t)HALF * K * 2;
    const size_t tstep = 2 * hstep;
    const int agap = g.gap;
#define a_off(pm_) ((size_t)((pm_) * BM + agap * (1 + ((pm_) >> 5))) * (size_t)K * 2)
    const unsigned ldsw = (unsigned)wid * 1024u;
    const int aoff = lds_byte(wr * 64 + fr, fq * 8), boff = lds_byte(wc * 32 + fr, fq * 8);
#define PG8_SA(b, h) (((b) * 2 + (h)) * HTB)
#define PG8_SB(b, h) ((4 + (b) * 2 + (h)) * HTB)
#define PG8_STAGE(bufoff, gbase, voff) do { _Pragma("unroll") for (int _i = 0; _i < 2; ++_i) \
        __builtin_amdgcn_global_load_lds((const unsigned*)((const char*)(gbase) + (voff)[_i]), (PG8_LAS unsigned*)(lds + (bufoff) + ldsw + _i * 8192), 16, 0, 0); } while (0)
#define PG8_LDA(dst, b, h) do { _Pragma("unroll") for (int m = 0; m < 4; ++m) _Pragma("unroll") for (int k = 0; k < 2; ++k) dst[m][k] = *(const PG8_LAS bf16x8*)(lds + PG8_SA(b, h) + aoff + m * 2048 + k * 1024); } while (0)
#define PG8_LDB(dst, b, h) do { _Pragma("unroll") for (int n = 0; n < 2; ++n) _Pragma("unroll") for (int k = 0; k < 2; ++k) dst[n][k] = *(const PG8_LAS bf16x8*)(lds + PG8_SB(b, h) + boff + n * 2048 + k * 1024); } while (0)
#define PG8_MMA(ai, bj, At, Bt) do { __builtin_amdgcn_s_setprio(1); _Pragma("unroll") for (int m = 0; m < 4; ++m) _Pragma("unroll") for (int n = 0; n < 2; ++n) _Pragma("unroll") for (int k = 0; k < 2; ++k) \
        acc[ai][bj][m][n] = __builtin_amdgcn_mfma_f32_16x16x32_bf16(Bt[n][k], At[m][k], acc[ai][bj][m][n], 0, 0, 0); __builtin_amdgcn_s_setprio(0); } while (0)
#define PG8_WAIT_V(n) asm volatile("s_waitcnt vmcnt(" #n ")" ::: "memory")
#define PG8_WAIT_L(n) asm volatile("s_waitcnt lgkmcnt(" #n ")" ::: "memory")
#define PG8_BAR __builtin_amdgcn_s_barrier()
#define PG8_SCHED __builtin_amdgcn_sched_barrier(0)
    Unit cur, nxt; int ui = 0;
    if (!S.next(0, cur)) return;
    f32x4 acc[2][2][4][2];
#pragma unroll
    for (int a = 0; a < 2; ++a)
#pragma unroll
        for (int b = 0; b < 2; ++b)
#pragma unroll
            for (int m = 0; m < 4; ++m)
#pragma unroll
                for (int n = 0; n < 2; ++n) acc[a][b][m][n] = (f32x4){0.f, 0.f, 0.f, 0.f};
    if constexpr (Epi::PRELOAD) E.preload(acc, cur, wr, wc, fr, fq);
    bf16x8 At[4][2], B0[2][2], B1[2][2];
    const char* cA = (const char*)g.A + a_off(cur.pm); const char* cB = (const char*)g.Bt + (size_t)cur.pn * tstep;
    S.a_ready(cur);
    if constexpr (SP2) {
        PG8_STAGE(PG8_SB(0, 0), cB, voffB); PG8_STAGE(PG8_SB(0, 1), cB + hstep, voffB); PG8_STAGE(PG8_SA(0, 0), cA, voffA); PG8_STAGE(PG8_SA(0, 1), cA + hstep, voffA);
        if (wr == 1) PG8_BAR;
        PG8_WAIT_V(2); PG8_BAR;
        PG8_STAGE(PG8_SB(1, 0), cB + kstep, voffB); PG8_STAGE(PG8_SA(1, 0), cA + kstep, voffA); PG8_STAGE(PG8_SB(1, 1), cB + hstep + kstep, voffB);
        PG8_WAIT_V(6); PG8_BAR;
    } else {
        PG8_STAGE(PG8_SB(0, 0), cB, voffB); PG8_STAGE(PG8_SA(0, 0), cA, voffA); PG8_STAGE(PG8_SB(0, 1), cB + hstep, voffB); PG8_STAGE(PG8_SA(0, 1), cA + hstep, voffA);
        if (wr == 1) PG8_BAR;
        PG8_WAIT_V(4); PG8_BAR;
        PG8_STAGE(PG8_SB(1, 0), cB + kstep, voffB); PG8_STAGE(PG8_SA(1, 0), cA + kstep, voffA); PG8_STAGE(PG8_SB(1, 1), cB + hstep + kstep, voffB);
        PG8_WAIT_V(6); PG8_BAR;
    }
    for (;;) {
        const bool has_next = S.next(ui + 1, nxt);
        const char* nA = has_next ? (const char*)g.A + a_off(nxt.pm) : cA; const char* nB = has_next ? (const char*)g.Bt + (size_t)nxt.pn * tstep : cB;
        for (int t = 0; t < nt; t += 2) {
            const bool last = (t == nt - 2);
            const char* a1 = cA + (size_t)(t + 1) * kstep;
            const char* a2 = last ? nA : cA + (size_t)(t + 2) * kstep; const char* b2 = last ? nB : cB + (size_t)(t + 2) * kstep;
            const char* a3 = a2 + kstep; const char* b3 = b2 + kstep;
            if (last && has_next) S.a_ready(nxt);
            if constexpr (SP2) {
            PG8_LDB(B0, 0, 0); PG8_LDB(B1, 0, 1); PG8_SCHED; PG8_LDA(At, 0, 0); PG8_STAGE(PG8_SA(1, 1), a1 + hstep, voffA);
            PG8_WAIT_V(8); PG8_WAIT_L(0); PG8_BAR; PG8_MMA(0, 0, At, B0); PG8_MMA(0, 1, At, B1); PG8_BAR; PG8_SCHED;
            PG8_LDA(At, 0, 1); PG8_STAGE(PG8_SB(0, 0), b2, voffB); PG8_STAGE(PG8_SB(0, 1), b2 + hstep, voffB); PG8_STAGE(PG8_SA(0, 0), a2, voffA);
            PG8_WAIT_V(8); PG8_WAIT_L(0); PG8_BAR; PG8_MMA(1, 0, At, B0); PG8_MMA(1, 1, At, B1); PG8_BAR; PG8_SCHED;
            PG8_LDB(B0, 1, 0); PG8_LDB(B1, 1, 1); PG8_SCHED; PG8_LDA(At, 1, 0); PG8_STAGE(PG8_SA(0, 1), a2 + hstep, voffA);
            PG8_WAIT_V(8); PG8_WAIT_L(0); PG8_BAR; PG8_MMA(0, 0, At, B0); PG8_MMA(0, 1, At, B1); PG8_BAR; PG8_SCHED;
            PG8_LDA(At, 1, 1); PG8_STAGE(PG8_SB(1, 0), b3, voffB); PG8_STAGE(PG8_SB(1, 1), b3 + hstep, voffB); PG8_STAGE(PG8_SA(1, 0), a3, voffA);
            PG8_WAIT_V(8); PG8_WAIT_L(0); PG8_BAR; PG8_MMA(1, 0, At, B0); PG8_MMA(1, 1, At, B1); PG8_BAR; PG8_SCHED;
            } else {
            PG8_LDB(B0, 0, 0); PG8_SCHED; PG8_LDA(At, 0, 0); PG8_STAGE(PG8_SA(1, 1), a1 + hstep, voffA);
            PG8_WAIT_L(8); PG8_BAR; PG8_WAIT_L(0); PG8_MMA(0, 0, At, B0); PG8_BAR; PG8_SCHED;
            PG8_LDB(B1, 0, 1); PG8_STAGE(PG8_SB(0, 0), b2, voffB);
            PG8_BAR; PG8_WAIT_L(0); PG8_MMA(0, 1, At, B1); PG8_BAR;
            PG8_LDA(At, 0, 1); PG8_STAGE(PG8_SA(0, 0), a2, voffA);
            PG8_BAR; PG8_WAIT_L(0); PG8_MMA(1, 0, At, B0); PG8_BAR; PG8_SCHED;
            PG8_STAGE(PG8_SB(0, 1), b2 + hstep, voffB);
            PG8_WAIT_V(6); PG8_BAR; PG8_MMA(1, 1, At, B1); PG8_BAR;
            PG8_LDB(B0, 1, 0); PG8_SCHED; PG8_LDA(At, 1, 0); PG8_STAGE(PG8_SA(0, 1), a2 + hstep, voffA);
            PG8_WAIT_L(8); PG8_BAR; PG8_WAIT_L(0); PG8_MMA(0, 0, At, B0); PG8_BAR; PG8_SCHED;
            PG8_LDB(B1, 1, 1); PG8_STAGE(PG8_SB(1, 0), b3, voffB);
            PG8_BAR; PG8_WAIT_L(0); PG8_MMA(0, 1, At, B1); PG8_BAR;
            PG8_LDA(At, 1, 1); PG8_STAGE(PG8_SA(1, 0), a3, voffA);
            PG8_BAR; PG8_WAIT_L(0); PG8_MMA(1, 0, At, B0); PG8_BAR; PG8_SCHED;
            PG8_STAGE(PG8_SB(1, 1), b3 + hstep, voffB);
            PG8_WAIT_V(6); PG8_BAR; PG8_MMA(1, 1, At, B1); PG8_BAR;
            }
        }
        if constexpr (ALIGN_EPI) { if (wr == 0) PG8_BAR; }
        if constexpr (!Epi::AFTER_DRAIN) { E(acc, cur, wr, wc, fr, fq); S.done(cur); }
        if (!has_next) break;
#pragma unroll
        for (int a = 0; a < 2; ++a)
#pragma unroll
            for (int b = 0; b < 2; ++b)
#pragma unroll
                for (int m = 0; m < 4; ++m)
#pragma unroll
                    for (int n = 0; n < 2; ++n) acc[a][b][m][n] = (f32x4){0.f, 0.f, 0.f, 0.f};
        if constexpr (Epi::PRELOAD) { E.preload(acc, nxt, wr, wc, fr, fq); PG8_WAIT_V(0); }
        cur = nxt; cA = nA; cB = nB; ++ui;
        if constexpr (ALIGN_EPI) { if (wr == 1) PG8_BAR; }
    }
    PG8_WAIT_V(0);
    if constexpr (!ALIGN_EPI) { if (wr == 0) PG8_BAR; }
    PG8_BAR;
    if constexpr (Epi::AFTER_DRAIN) { E.fused(acc, cur, wr, wc, fr, fq, lds, wid, lane); S.done(cur); }
#undef PG8_SA
#undef PG8_SB
#undef PG8_STAGE
#undef PG8_LDA
#undef PG8_LDB
#undef PG8_MMA
#undef PG8_WAIT_V
#undef PG8_WAIT_L
#undef PG8_BAR
#undef PG8_SCHED
}
}

#define LAS __attribute__((address_space(3)))
typedef unsigned short bf16;
typedef unsigned u32x4 __attribute__((ext_vector_type(4)));
typedef unsigned u32x2 __attribute__((ext_vector_type(2)));
typedef float f32x4 __attribute__((ext_vector_type(4)));
typedef short bf16x8 __attribute__((ext_vector_type(8)));
constexpr int D = 1024, SEQ = 8192, NB = 2, NMETA = 16, TT = SEQ + NMETA, M = NB * SEQ, DEPTH = 4, DIN = 1536, FF = 4096, DH = 512;
constexpr float EPS = 1e-6f;
constexpr size_t MiB = 1u << 20;
constexpr size_t WS_CTL = 0;
constexpr size_t WS_POOLW = 1 * MiB, WS_GR = WS_POOLW + 512 * 1024, WS_GI = WS_GR + 256 * 1024;
constexpr size_t WS_SP = 2 * MiB, WS_HMETA = WS_SP + 64 * 1024, WS_MIDMETA = WS_HMETA + 64 * 1024;
constexpr size_t WS_SS = 3 * MiB, WS_CARA = 4 * MiB, WS_CARH = WS_CARA + 512 * 1024;
constexpr size_t WS_W = 8 * MiB, W_LAYER = 21 * MiB, W_IN = 0, W_OUT = 3 * MiB, W_UP = 5 * MiB, W_DOWN = 13 * MiB;
constexpr size_t WS_HB = 92 * MiB, WS_MID = 124 * MiB;
constexpr size_t WS_PROJ = WS_MID, WS_Y = WS_MID + 48 * MiB + 256 * 1024, WS_HL = WS_Y + 32 * MiB + 256 * 1024, WS_P = WS_HL + 32 * MiB + 256 * 1024, WS_END = 256 * MiB;
static_assert(WS_PROJ + (size_t)NB * TT * DIN * 2 <= WS_Y && WS_Y + (size_t)NB * TT * D * 2 <= WS_HL && WS_HL + (size_t)NB * TT * DH * 2 <= WS_P && WS_P + (size_t)NB * TT * DH * 2 <= WS_END, "ws map");
static_assert(WS_W + DEPTH * W_LAYER <= WS_HB && WS_HB + (size_t)M * D * 2 <= WS_MID && WS_MID + (size_t)M * FF * 2 <= WS_END, "ws map 2");
constexpr int LDS_HL = 0, LDS_P = 65536, LDS_CST = 131072, LDS_CARR = 147456, LDS_RED1 = 149504, LDS_RED2 = 152064, LDS_CARRY = 154624;
constexpr int LDS_XST = 163840 - 64;
constexpr int LDS_BYTES = 163840;
constexpr size_t WS_FLAG = 64 * 1024;

struct Params {
    const float* in[20];
    float* out;
    unsigned char* ws;
};

__device__ __forceinline__ Params launder(const Params& p) {
    Params q = p;
#pragma unroll
    for (int i = 0; i < 20; ++i) { const __attribute__((address_space(1))) float* g = (const __attribute__((address_space(1))) float*)q.in[i]; asm volatile("" : "+s"(g)); q.in[i] = (const float*)g; }
    { __attribute__((address_space(1))) float* g = (__attribute__((address_space(1))) float*)q.out; asm volatile("" : "+s"(g)); q.out = (float*)g; }
    { __attribute__((address_space(1))) unsigned char* g = (__attribute__((address_space(1))) unsigned char*)q.ws; asm volatile("" : "+s"(g)); q.ws = (unsigned char*)g; }
    return q;
}
__device__ __forceinline__ unsigned cvt_pk(float lo, float hi) { return pg8::cvt_pk_bf16(lo, hi); }
__device__ __forceinline__ float bf_lo(unsigned w) { return __builtin_bit_cast(float, w << 16); }
__device__ __forceinline__ float bf_hi(unsigned w) { return __builtin_bit_cast(float, w & 0xffff0000u); }
__device__ __forceinline__ void unpack8(const u32x4 w, float (&f)[8]) {
    f[0] = bf_lo(w.x); f[1] = bf_hi(w.x); f[2] = bf_lo(w.y); f[3] = bf_hi(w.y); f[4] = bf_lo(w.z); f[5] = bf_hi(w.z); f[6] = bf_lo(w.w); f[7] = bf_hi(w.w);
}
__device__ __forceinline__ u32x4 pack8(const float (&f)[8]) { u32x4 w; w.x = cvt_pk(f[0], f[1]); w.y = cvt_pk(f[2], f[3]); w.z = cvt_pk(f[4], f[5]); w.w = cvt_pk(f[6], f[7]); return w; }
__device__ __forceinline__ float wave_sum(float v) {
#pragma unroll
    for (int o = 1; o < 64; o <<= 1) v += __shfl_xor(v, o);
    return v;
}
template <int CTRL> __device__ __forceinline__ float dppf(float old, float src) {
    return __builtin_bit_cast(float, __builtin_amdgcn_update_dpp(__builtin_bit_cast(int, old), __builtin_bit_cast(int, src), CTRL, 0xf, 0xf, false));
}
template <int DD> __device__ __forceinline__ float shiftd(float cur, float prev) {
    const float t = dppf<0x100 + (16 - DD)>(0.f, prev);
    return dppf<0x110 + DD>(t, cur);
}
__device__ __forceinline__ float sigm(float v) { return __builtin_amdgcn_rcpf(1.0f + __expf(-v)); }
__device__ __forceinline__ int outchan(int n, int rho) { return 32 * (n >> 1) + 8 * (rho >> 2) + 4 * (n & 1) + (rho & 3); }

__device__ __forceinline__ float row_rstd(const float* ss, int r) {
    const f32x4* s4 = (const f32x4*)(ss + (size_t)r * 16);
    const f32x4 a = s4[0], b = s4[1], c = s4[2], d = s4[3];
    const float s = ((a.x + a.y) + (a.z + a.w)) + ((b.x + b.y) + (b.z + b.w)) + ((c.x + c.y) + (c.z + c.w)) + ((d.x + d.y) + (d.z + d.w));
    return 1.0f / sqrtf(s * (1.0f / D) + EPS);
}
__device__ __forceinline__ void rows_rstd(const float* ss, int rowbase  , int fr, float (&rs)[2][4]) {
    const int lane = threadIdx.x & 63;
    const float r0 = row_rstd(ss, rowbase + lane), r1 = row_rstd(ss, rowbase + 128 + lane);
#pragma unroll
    for (int m = 0; m < 4; ++m) { rs[0][m] = __shfl(r0, m * 16 + fr); rs[1][m] = __shfl(r1, m * 16 + fr); }
}
struct EpiIn {
    static constexpr bool PERM = true, AFTER_DRAIN = false, PRELOAD = false;
    bf16* P; const float* ss; const LAS float* rl; int pmc;
    __device__ __forceinline__ void operator()(const f32x4 (&acc)[2][2][4][2], const pg8::Unit& u, int wr, int wc, int fr, int fq) const {
        const int row0 = u.pm * 256 + wr * 64 + fr, col0 = u.pn * 256 + wc * 32 + 8 * fq;
        float rsv[2][4];
        if (u.pm == pmc) {
#pragma unroll
            for (int ai = 0; ai < 2; ++ai)
#pragma unroll
                for (int m = 0; m < 4; ++m) rsv[ai][m] = rl[ai * 128 + wr * 64 + m * 16 + fr];
        } else {
#pragma unroll
            for (int ai = 0; ai < 2; ++ai)
#pragma unroll
                for (int m = 0; m < 4; ++m) { rsv[ai][m] = row_rstd(ss, row0 + ai * 128 + m * 16); asm volatile("" ::: "memory"); }
        }
#pragma unroll
        for (int ai = 0; ai < 2; ++ai)
#pragma unroll
            for (int m = 0; m < 4; ++m) {
                const int r = row0 + ai * 128 + m * 16; const float rs = rsv[ai][m];
                bf16* rowp = P + (size_t)(r + NMETA * (1 + (r >> 13))) * DIN + col0;
#pragma unroll
                for (int bj = 0; bj < 2; ++bj) { const f32x4 v0 = acc[ai][bj][m][0] * rs, v1 = acc[ai][bj][m][1] * rs;
                    u32x4 w; w.x = cvt_pk(v0[0], v0[1]); w.y = cvt_pk(v0[2], v0[3]); w.z = cvt_pk(v1[0], v1[1]); w.w = cvt_pk(v1[2], v1[3]);
                    *(u32x4*)(rowp + bj * 128) = w; }
            }
    }
};
struct EpiUp {
    static constexpr bool PERM = true, AFTER_DRAIN = false, PRELOAD = false;
    bf16* O; const float* ss; const LAS float* rl; int pmc;
    __device__ __forceinline__ void operator()(const f32x4 (&acc)[2][2][4][2], const pg8::Unit& u, int wr, int wc, int fr, int fq) const {
        const int row0 = u.pm * 256 + wr * 64 + fr, col0 = u.pn * 256 + wc * 32 + 8 * fq;
        float rsv[2][4];
        if (u.pm == pmc) {
#pragma unroll
            for (int ai = 0; ai < 2; ++ai)
#pragma unroll
                for (int m = 0; m < 4; ++m) rsv[ai][m] = rl[ai * 128 + wr * 64 + m * 16 + fr];
        } else {
#pragma unroll
            for (int ai = 0; ai < 2; ++ai)
#pragma unroll
                for (int m = 0; m < 4; ++m) { rsv[ai][m] = row_rstd(ss, row0 + ai * 128 + m * 16); asm volatile("" ::: "memory"); }
        }
#pragma unroll
        for (int ai = 0; ai < 2; ++ai)
#pragma unroll
            for (int m = 0; m < 4; ++m) {
                const int r = row0 + ai * 128 + m * 16; const float rs = rsv[ai][m];
                bf16* rowp = O + (size_t)r * FF + col0;
#pragma unroll
                for (int bj = 0; bj < 2; ++bj) { f32x4 v0 = acc[ai][bj][m][0] * rs, v1 = acc[ai][bj][m][1] * rs;
#pragma unroll
                    for (int j = 0; j < 4; ++j) { v0[j] = fmaxf(v0[j], 0.f); v0[j] *= v0[j]; v1[j] = fmaxf(v1[j], 0.f); v1[j] *= v1[j]; }
                    u32x4 w; w.x = cvt_pk(v0[0], v0[1]); w.y = cvt_pk(v0[2], v0[3]); w.z = cvt_pk(v1[0], v1[1]); w.w = cvt_pk(v1[2], v1[3]);
                    *(u32x4*)(rowp + bj * 128) = w; }
            }
    }
};
struct EpiRes {
    static constexpr bool PERM = true, AFTER_DRAIN = false, PRELOAD = true;
    bf16* hb; float* ssn;
    __device__ __forceinline__ void preload(f32x4 (&acc)[2][2][4][2], const pg8::Unit& u, int wr, int wc, int fr, int fq) const {
        const int row0 = u.pm * 256 + wr * 64 + fr, col0 = u.pn * 256 + wc * 32 + 8 * fq;
#pragma unroll
        for (int ai = 0; ai < 2; ++ai)
#pragma unroll
            for (int m = 0; m < 4; ++m) { const size_t off = (size_t)(row0 + ai * 128 + m * 16) * D + col0;
#pragma unroll
                for (int bj = 0; bj < 2; ++bj) { const u32x4 w = *(const u32x4*)(hb + off + bj * 128);
                    acc[ai][bj][m][0] = (f32x4){bf_lo(w.x), bf_hi(w.x), bf_lo(w.y), bf_hi(w.y)}; acc[ai][bj][m][1] = (f32x4){bf_lo(w.z), bf_hi(w.z), bf_lo(w.w), bf_hi(w.w)}; } }
    }
    __device__ __forceinline__ void operator()(const f32x4 (&acc)[2][2][4][2], const pg8::Unit& u, int wr, int wc, int fr, int fq) const {
        const int row0 = u.pm * 256 + wr * 64 + fr, col0 = u.pn * 256 + wc * 32 + 8 * fq;
#pragma unroll
        for (int ai = 0; ai < 2; ++ai)
#pragma unroll
            for (int m = 0; m < 4; ++m) {
                const int r = row0 + ai * 128 + m * 16; const size_t off = (size_t)r * D + col0; float s = 0.f;
#pragma unroll
                for (int bj = 0; bj < 2; ++bj) {
                    const f32x4 o0 = acc[ai][bj][m][0], o1 = acc[ai][bj][m][1];
                    s += (o0[0] * o0[0] + o0[1] * o0[1]) + (o0[2] * o0[2] + o0[3] * o0[3]) + (o1[0] * o1[0] + o1[1] * o1[1]) + (o1[2] * o1[2] + o1[3] * o1[3]);
                    u32x4 w; w.x = cvt_pk(o0[0], o0[1]); w.y = cvt_pk(o0[2], o0[3]); w.z = cvt_pk(o1[0], o1[1]); w.w = cvt_pk(o1[2], o1[3]);
                    *(u32x4*)(hb + off + bj * 128) = w; }
                s += __shfl_xor(s, 16); s += __shfl_xor(s, 32);
                if (fq == 0) ssn[(size_t)r * 16 + u.pn * 4 + wc] = s;
            }
    }
};

struct TItem { const float* W; const float* gk; bf16* WT; int K, N, item; };
__device__ __forceinline__ void titem_load(const TItem& t, int lane, f32x4 (&v)[8], float (&gs)[8]) {
    const int nblk = t.N / 32, kb = t.item / nblk, nb = t.item % nblk, k0 = 64 * kb, n0 = 32 * nb, lr = lane >> 3, lc = (lane & 7) * 4;
#pragma unroll
    for (int i = 0; i < 8; ++i) { v[i] = *(const f32x4*)(t.W + (size_t)(k0 + 8 * i + lr) * t.N + n0 + lc); gs[i] = t.gk ? t.gk[k0 + 8 * i + lr] : 1.0f; }
}
__device__ __forceinline__ void titem_store(const TItem& t, int lane, const f32x4 (&v)[8], const float (&gs)[8], LAS float* scr) {
    const int nblk = t.N / 32, kb = t.item / nblk, nb = t.item % nblk, k0 = 64 * kb, n0 = 32 * nb, lr = lane >> 3, lc = (lane & 7) * 4;
#pragma unroll
    for (int i = 0; i < 8; ++i) { LAS float* d = scr + (8 * i + lr) * 33 + lc; d[0] = v[i].x * gs[i]; d[1] = v[i].y * gs[i]; d[2] = v[i].z * gs[i]; d[3] = v[i].w * gs[i]; }
    asm volatile("s_waitcnt lgkmcnt(0)" ::: "memory");
    const int c = lane & 7;
#pragma unroll
    for (int j = 0; j < 4; ++j) { const int n = (lane >> 3) + 8 * j; const LAS float* s = scr + (8 * c) * 33 + n;
        u32x4 o; o.x = cvt_pk(s[0 * 33], s[1 * 33]); o.y = cvt_pk(s[2 * 33], s[3 * 33]); o.z = cvt_pk(s[4 * 33], s[5 * 33]); o.w = cvt_pk(s[6 * 33], s[7 * 33]);
        *(u32x4*)(t.WT + (size_t)(n0 + n) * t.K + k0 + 8 * c) = o; }
    asm volatile("s_waitcnt lgkmcnt(0)" ::: "memory");
}
__device__ __forceinline__ TItem titem_decode(const Params& p, int it) {
    constexpr int I_IN = 16 * 48, I_OUT = 16 * 32, I_UP = 16 * 128, I_DN = 64 * 32, I_PW = 4 * 8, I_G = 8 * 2, I_L = I_IN + I_OUT + I_UP + I_DN + I_PW + 2 * I_G;
    const int l = it / I_L; int r = it % I_L; unsigned char* ws = p.ws; unsigned char* wl = ws + WS_W + (size_t)l * W_LAYER; TItem t;
    if (r < I_IN) { t = TItem{p.in[3] + (size_t)l * D * DIN, p.in[2] + l * D, (bf16*)(wl + W_IN), D, DIN, r}; return t; } r -= I_IN;
    if (r < I_OUT) { t = TItem{p.in[15] + (size_t)l * D * D, p.in[14] + l * D, (bf16*)(wl + W_OUT), D, D, r}; return t; } r -= I_OUT;
    if (r < I_UP) { t = TItem{p.in[17] + (size_t)l * D * FF, p.in[16] + l * D, (bf16*)(wl + W_UP), D, FF, r}; return t; } r -= I_UP;
    if (r < I_DN) { t = TItem{p.in[18] + (size_t)l * FF * D, nullptr, (bf16*)(wl + W_DOWN), FF, D, r}; return t; } r -= I_DN;
    if (r < I_PW) { const int g = r / 8; t = TItem{p.in[4] + (size_t)(l * 4 + g) * 16384, nullptr, (bf16*)(ws + WS_POOLW) + (size_t)(l * 4 + g) * 16384, 128, 128, r % 8}; return t; } r -= I_PW;
    if (r < I_G) { const int h = r / 2; t = TItem{p.in[9] + (size_t)(l * 8 + h) * 4096, nullptr, (bf16*)(ws + WS_GR) + (size_t)(l * 8 + h) * 4096, 64, 64, r % 2}; return t; } r -= I_G;
    { const int h = r / 2; t = TItem{p.in[11] + (size_t)(l * 8 + h) * 4096, nullptr, (bf16*)(ws + WS_GI) + (size_t)(l * 8 + h) * 4096, 64, 64, r % 2}; }
    return t;
}
constexpr int TITEMS_PER_LAYER = 16 * 48 + 16 * 32 + 16 * 128 + 64 * 32 + 4 * 8 + 2 * 8 * 2, TITEMS_IN = 16 * 48;
__device__ __forceinline__ void convert_items(const Params& p_, LAS unsigned char* lds, int it_lo, int it_hi, int wblock, int nworkers) {
    const Params p = launder(p_);
    int tid_ = threadIdx.x; asm volatile("" : "+v"(tid_));
    const int lane = tid_ & 63, wid = __builtin_amdgcn_readfirstlane(tid_ >> 6);
    LAS float* scr = (LAS float*)(lds + wid * 16384);
    const int worker = wblock * 8 + wid;
    if (it_lo + worker < it_hi) {
        TItem cur = titem_decode(p, it_lo + worker); f32x4 v[8]; float gs[8]; titem_load(cur, lane, v, gs);
        for (int it = it_lo + worker; it < it_hi; it += nworkers) {
            const bool more = it + nworkers < it_hi; TItem nxt = cur; f32x4 nv[8]; float ngs[8];
            if (more) { nxt = titem_decode(p, it + nworkers); titem_load(nxt, lane, nv, ngs); }
            titem_store(cur, lane, v, gs, scr);
            if (more) { cur = nxt;
#pragma unroll
                for (int i = 0; i < 8; ++i) { v[i] = nv[i]; gs[i] = ngs[i]; } }
        }
    }
}
__device__ __forceinline__ void prologue(const Params& p_, LAS unsigned char* lds, int G) {
    const Params p = launder(p_);
    int tid_ = threadIdx.x; asm volatile("" : "+v"(tid_));
    const int tid = tid_, lane = tid & 63, wid = __builtin_amdgcn_readfirstlane(tid >> 6);
    const int gw = blockIdx.x * 8 + wid, NGW = G * 8;
    unsigned char* ws = p.ws;
    convert_items(p_, lds, 0, G == 256 ? TITEMS_IN : DEPTH * TITEMS_PER_LAYER, (int)blockIdx.x, NGW);
    const float* x = p.in[0]; bf16* hb = (bf16*)(ws + WS_HB); float* ss = (float*)(ws + WS_SS);
    for (int m2 = gw; m2 < M / 2; m2 += NGW) {
        f32x4 v[2][4]; float s[2] = {0.f, 0.f};
#pragma unroll
        for (int r = 0; r < 2; ++r) { const f32x4* xr = (const f32x4*)(x + (size_t)(2 * m2 + r) * D) + lane;
#pragma unroll
            for (int j = 0; j < 4; ++j) v[r][j] = xr[64 * j]; }
#pragma unroll
        for (int r = 0; r < 2; ++r) {
#pragma unroll
            for (int j = 0; j < 4; ++j) s[r] += (v[r][j].x * v[r][j].x + v[r][j].y * v[r][j].y) + (v[r][j].z * v[r][j].z + v[r][j].w * v[r][j].w);
            s[r] = wave_sum(s[r]);
            u32x2* o8 = (u32x2*)(hb + (size_t)(2 * m2 + r) * D) + lane;
#pragma unroll
            for (int j = 0; j < 4; ++j) { u32x2 w; w.x = cvt_pk(v[r][j].x, v[r][j].y); w.y = cvt_pk(v[r][j].z, v[r][j].w); o8[64 * j] = w; }
            if (lane < 16) ss[(size_t)(2 * m2 + r) * 16 + lane] = lane == 0 ? s[r] : 0.f;
        }
    }
    float* hm = (float*)(ws + WS_HMETA); float* sp = (float*)(ws + WS_SP);
    for (int i = blockIdx.x * 512 + tid; i < NMETA * D; i += G * 512) hm[i] = p.in[1][i];
    for (int i = blockIdx.x * 512 + tid; i < DEPTH * DH; i += G * 512) sp[i] = log1pf(expf(-p.in[13][i]));
}

template <int MODE, int NBATCH = 4> __device__ __forceinline__ void meta_tasks(const Params& p_, LAS unsigned char* lds, int G, const bf16* Ab, int lda, const bf16* Bt, int K, int ntasks) {
    const Params p = launder(p_);
    int tid_ = threadIdx.x; asm volatile("" : "+v"(tid_));
    const int tid = tid_, lane = tid & 63, wid = __builtin_amdgcn_readfirstlane(tid >> 6), fr = lane & 15, fq = lane >> 4;
    float* hm = (float*)(p.ws + WS_HMETA);
    LAS float* red = (LAS float*)lds;
    for (int task = G - 1 - (int)blockIdx.x; task < ntasks; task += G) {
        const int n0 = task * 16, kw = K / 8, k0 = wid * kw;
        f32x4 acc = {0.f, 0.f, 0.f, 0.f}; float ssq = 0.f;
        for (int kb = k0; kb < k0 + kw; kb += 32 * NBATCH) {
            bf16x8 af[NBATCH], bfr[NBATCH]; f32x4 a0[NBATCH], a1[NBATCH];
#pragma unroll
            for (int i = 0; i < NBATCH; ++i) { const int kk = kb + 32 * i;
                if (MODE == 1) af[i] = *(const bf16x8*)(Ab + (size_t)fr * lda + kk + 8 * fq);
                else { a0[i] = *(const f32x4*)(hm + fr * D + kk + 8 * fq); a1[i] = *(const f32x4*)(hm + fr * D + kk + 8 * fq + 4); }
                bfr[i] = *(const bf16x8*)(Bt + (size_t)(n0 + fr) * K + kk + 8 * fq); }
#pragma unroll
            for (int i = 0; i < NBATCH; ++i) {
                if (MODE != 1) { ssq += (a0[i].x * a0[i].x + a0[i].y * a0[i].y) + (a0[i].z * a0[i].z + a0[i].w * a0[i].w) + (a1[i].x * a1[i].x + a1[i].y * a1[i].y) + (a1[i].z * a1[i].z + a1[i].w * a1[i].w);
                    u32x4 w; w.x = cvt_pk(a0[i].x, a0[i].y); w.y = cvt_pk(a0[i].z, a0[i].w); w.z = cvt_pk(a1[i].x, a1[i].y); w.w = cvt_pk(a1[i].z, a1[i].w); af[i] = __builtin_bit_cast(bf16x8, w); }
                acc = __builtin_amdgcn_mfma_f32_16x16x32_bf16(bfr[i], af[i], acc, 0, 0, 0); }
        }
        ssq += __shfl_xor(ssq, 16); ssq += __shfl_xor(ssq, 32);
        LAS float* rp = red + (wid * 64 + lane) * 5;
        rp[0] = acc[0]; rp[1] = acc[1]; rp[2] = acc[2]; rp[3] = acc[3]; rp[4] = ssq;
        __syncthreads();
        if (wid == 0) {
            float a0 = 0.f, a1 = 0.f, a2 = 0.f, a3 = 0.f, sq = 0.f;
#pragma unroll
            for (int w = 0; w < 8; ++w) { const LAS float* q = red + (w * 64 + lane) * 5; a0 += q[0]; a1 += q[1]; a2 += q[2]; a3 += q[3]; sq += q[4]; }
            const int col = n0 + 4 * fq;
            if (MODE == 1) { f32x4* hp = (f32x4*)(hm + fr * D + col); f32x4 h = *hp; h.x += a0; h.y += a1; h.z += a2; h.w += a3; *hp = h; }
            else {
                const float rs = 1.0f / sqrtf(sq * (1.0f / D) + EPS); a0 *= rs; a1 *= rs; a2 *= rs; a3 *= rs;
                if (MODE == 0) { u32x2 w; w.x = cvt_pk(a0, a1); w.y = cvt_pk(a2, a3); bf16* pr = (bf16*)(p.ws + WS_PROJ);
                    *(u32x2*)(pr + (size_t)fr * DIN + col) = w; *(u32x2*)(pr + (size_t)(TT + fr) * DIN + col) = w; }
                else { a0 = fmaxf(a0, 0.f); a1 = fmaxf(a1, 0.f); a2 = fmaxf(a2, 0.f); a3 = fmaxf(a3, 0.f);
                    u32x2 w; w.x = cvt_pk(a0 * a0, a1 * a1); w.y = cvt_pk(a2 * a2, a3 * a3); *(u32x2*)((bf16*)(p.ws + WS_MIDMETA) + (size_t)fr * FF + col) = w; }
            }
        }
        __syncthreads();
    }
}

__device__ __forceinline__ void m1_phase(const Params& p_, LAS unsigned char* lds, int G, int l) {
    const Params p = launder(p_);
    int tid_ = threadIdx.x; asm volatile("" : "+v"(tid_));
    const int tid = tid_, lane = tid & 63, wid = __builtin_amdgcn_readfirstlane(tid >> 6), fr = lane & 15, fq = lane >> 4;
    LAS float* cst = (LAS float*)lds;
    for (int i = tid; i < 8 * DH; i += 512) { const int row = i >> 9, ch = i & 511; float v;
        if (row < 4) v = p.in[7][(l * 4 + row) * DH + ch]; else if (row == 4) v = p.in[8][l * DH + ch]; else if (row == 5) v = p.in[10][l * DH + ch];
        else if (row == 6) v = p.in[12][l * DH + ch]; else v = ((const float*)(p.ws + WS_SP))[l * DH + ch];
        cst[i] = v; }
    const bf16* proj = (const bf16*)(p.ws + WS_PROJ);
    const bf16* Wr = (const bf16*)(p.ws + WS_GR) + (size_t)(l * 8 + wid) * 4096; const bf16* Wi = (const bf16*)(p.ws + WS_GI) + (size_t)(l * 8 + wid) * 4096;
    LAS bf16x8* wl = (LAS bf16x8*)(lds + 16384 + wid * 16384) + lane;
#pragma unroll
    for (int n = 0; n < 4; ++n)
#pragma unroll
        for (int ks = 0; ks < 2; ++ks) {
            wl[((n * 2 + ks) * 2 + 0) * 64] = *(const bf16x8*)(Wr + outchan(n, fr) * 64 + 32 * ks + 8 * fq);
            wl[((n * 2 + ks) * 2 + 1) * 64] = *(const bf16x8*)(Wi + outchan(n, fr) * 64 + 32 * ks + 8 * fq); }
    __syncthreads();
    bf16* hl = (bf16*)(p.ws + WS_HL); bf16* Pp = (bf16*)(p.ws + WS_P);
    float* carA = (float*)(p.ws + WS_CARA); float* carH = (float*)(p.ws + WS_CARH);
    for (int unit = blockIdx.x; unit < 256; unit += G) {
        const int b = unit >> 7, c = unit & 127, t0 = c ? NMETA + 64 * c : 0, NM = c ? 4 : 5;
        float Hc[16], Pc[16];
#pragma unroll
        for (int k = 0; k < 16; ++k) { Hc[k] = 0.f; Pc[k] = 1.f; }
        u32x4 raw[2][4];
#pragma unroll
        for (int ks = 0; ks < 2; ++ks)
#pragma unroll
            for (int d = 0; d < 4; ++d) { const int tt = t0 + fr - 3 + d; raw[ks][d] = (u32x4){0u, 0u, 0u, 0u};
                if (tt >= 0) raw[ks][d] = *(const u32x4*)(proj + ((size_t)b * TT + tt) * DIN + DH + wid * 64 + 32 * ks + 8 * fq); }
#pragma unroll 1
        for (int m = 0; m < NM; ++m) {
            const int t = t0 + 16 * m + fr; const size_t rowg = (size_t)b * TT + t;
            u32x4 nraw[2][4];
#pragma unroll
            for (int ks = 0; ks < 2; ++ks)
#pragma unroll
                for (int d = 0; d < 4; ++d) { nraw[ks][d] = (u32x4){0u, 0u, 0u, 0u};
                    if (m + 1 < NM) nraw[ks][d] = *(const u32x4*)(proj + ((size_t)b * TT + t + 13 + d) * DIN + DH + wid * 64 + 32 * ks + 8 * fq); }
            float xc[2][8]; bf16x8 frag[2];
#pragma unroll
            for (int ks = 0; ks < 2; ++ks) {
                const int chb = wid * 64 + 32 * ks + 8 * fq;
                { const f32x4 c0 = *(const LAS f32x4*)(cst + 4 * DH + chb), c1 = *(const LAS f32x4*)(cst + 4 * DH + chb + 4);
                  xc[ks][0] = c0.x; xc[ks][1] = c0.y; xc[ks][2] = c0.z; xc[ks][3] = c0.w; xc[ks][4] = c1.x; xc[ks][5] = c1.y; xc[ks][6] = c1.z; xc[ks][7] = c1.w; }
#pragma unroll
                for (int d = 0; d < 4; ++d) {
                    float u[8]; unpack8(raw[ks][d], u);
                    const f32x4 w0 = *(const LAS f32x4*)(cst + d * DH + chb), w1 = *(const LAS f32x4*)(cst + d * DH + chb + 4);
                    xc[ks][0] += u[0] * w0.x; xc[ks][1] += u[1] * w0.y; xc[ks][2] += u[2] * w0.z; xc[ks][3] += u[3] * w0.w;
                    xc[ks][4] += u[4] * w1.x; xc[ks][5] += u[5] * w1.y; xc[ks][6] += u[6] * w1.z; xc[ks][7] += u[7] * w1.w;
                    raw[ks][d] = nraw[ks][d];
                }
                frag[ks] = __builtin_bit_cast(bf16x8, pack8(xc[ks]));
            }
            f32x4 ar[4], ai[4];
#pragma unroll
            for (int n = 0; n < 4; ++n) { ar[n] = (f32x4){0.f, 0.f, 0.f, 0.f}; ai[n] = (f32x4){0.f, 0.f, 0.f, 0.f};
#pragma unroll
                for (int ks = 0; ks < 2; ++ks) {
                    const bf16x8 wr_ = wl[((n * 2 + ks) * 2 + 0) * 64], wi_ = wl[((n * 2 + ks) * 2 + 1) * 64];
                    ar[n] = __builtin_amdgcn_mfma_f32_16x16x32_bf16(wr_, frag[ks], ar[n], 0, 0, 0);
                    ai[n] = __builtin_amdgcn_mfma_f32_16x16x32_bf16(wi_, frag[ks], ai[n], 0, 0, 0);
                } }
            float Aa[16], Bb[16];
#pragma unroll
            for (int n = 0; n < 4; ++n) {
                const int cho = wid * 64 + 32 * (n >> 1) + 8 * fq + 4 * (n & 1);
                const f32x4 rb = *(const LAS f32x4*)(cst + 5 * DH + cho), ib = *(const LAS f32x4*)(cst + 6 * DH + cho), spv = *(const LAS f32x4*)(cst + 7 * DH + cho);
#pragma unroll
                for (int jj = 0; jj < 4; ++jj) {
                    const float r = sigm(ar[n][jj] + rb[jj]), ig = sigm(ai[n][jj] + ib[jj]);
                    const float la = -8.0f * r * spv[jj], a = __expf(la), x2 = 2.0f * la;
                    const float m2s = -x2 * (1.0f + x2 * (0.5f + x2 * (0.16666667f + x2 * 0.041666668f))), m2 = (x2 > -0.0625f) ? m2s : 1.0f - a * a;
                    Aa[n * 4 + jj] = a; Bb[n * 4 + jj] = __builtin_amdgcn_sqrtf(m2) * ig * xc[n >> 1][4 * (n & 1) + jj];
                }
            }
#pragma unroll
            for (int k = 0; k < 16; ++k) {
                float A = Aa[k], B = Bb[k], Ap, Bq;
                Ap = dppf<0x111>(1.f, A); Bq = dppf<0x111>(0.f, B); B = fmaf(A, Bq, B); A *= Ap;
                Ap = dppf<0x112>(1.f, A); Bq = dppf<0x112>(0.f, B); B = fmaf(A, Bq, B); A *= Ap;
                Ap = dppf<0x114>(1.f, A); Bq = dppf<0x114>(0.f, B); B = fmaf(A, Bq, B); A *= Ap;
                Ap = dppf<0x118>(1.f, A); Bq = dppf<0x118>(0.f, B); B = fmaf(A, Bq, B); A *= Ap;
                Bb[k] = fmaf(A, Hc[k], B); Aa[k] = A * Pc[k];
            }
#pragma unroll
            for (int ks = 0; ks < 2; ++ks) {
                const size_t o = rowg * DH + wid * 64 + 32 * ks + 8 * fq;
                { u32x4 wh; wh.x = cvt_pk(Bb[8 * ks + 0], Bb[8 * ks + 1]); wh.y = cvt_pk(Bb[8 * ks + 2], Bb[8 * ks + 3]); wh.z = cvt_pk(Bb[8 * ks + 4], Bb[8 * ks + 5]); wh.w = cvt_pk(Bb[8 * ks + 6], Bb[8 * ks + 7]);
                  *(u32x4*)(hl + o) = wh; }
                u32x4 w; w.x = cvt_pk(Aa[8 * ks + 0], Aa[8 * ks + 1]); w.y = cvt_pk(Aa[8 * ks + 2], Aa[8 * ks + 3]); w.z = cvt_pk(Aa[8 * ks + 4], Aa[8 * ks + 5]); w.w = cvt_pk(Aa[8 * ks + 6], Aa[8 * ks + 7]);
                *(u32x4*)(Pp + o) = w;
            }
            const int src = (lane & 48) | 15;
#pragma unroll
            for (int k = 0; k < 16; ++k) { Hc[k] = __shfl(Bb[k], src); Pc[k] = __shfl(Aa[k], src); }
        }
        if (fr == 0) {
#pragma unroll
            for (int ks = 0; ks < 2; ++ks) {
                const size_t o = (size_t)(b * 128 + c) * DH + wid * 64 + 32 * ks + 8 * fq;
                *(f32x4*)(carA + o) = (f32x4){Pc[8 * ks + 0], Pc[8 * ks + 1], Pc[8 * ks + 2], Pc[8 * ks + 3]}; *(f32x4*)(carA + o + 4) = (f32x4){Pc[8 * ks + 4], Pc[8 * ks + 5], Pc[8 * ks + 6], Pc[8 * ks + 7]};
                *(f32x4*)(carH + o) = (f32x4){Hc[8 * ks + 0], Hc[8 * ks + 1], Hc[8 * ks + 2], Hc[8 * ks + 3]}; *(f32x4*)(carH + o + 4) = (f32x4){Hc[8 * ks + 4], Hc[8 * ks + 5], Hc[8 * ks + 6], Hc[8 * ks + 7]};
            }
        }
    }
    __syncthreads();
}


template <int NMR, bool FROM_LDS> __device__ __forceinline__ void m2_rnn_round(LAS unsigned char* lds, const bf16* hl, const bf16* Pp, const bf16* proj, bf16* Y, LAS float* red1, const float (&cr)[16], int b, int t0, int mbase, int wid, int fr, int fq) {
    u32x4 hw[NMR][2], pw[NMR][2], gw[NMR][2];
#pragma unroll
    for (int m = 0; m < NMR; ++m)
#pragma unroll
        for (int ks = 0; ks < 2; ++ks) { const size_t rowg = (size_t)b * TT + t0 + 16 * (mbase + m) + fr; const int ch = wid * 64 + 32 * ks + 8 * fq; const size_t o = rowg * DH + ch;
            if (FROM_LDS) { const int lane = fq * 16 + fr; hw[m][ks] = *(const LAS u32x4*)(lds + LDS_HL + wid * 8192 + (((mbase + m) * 2 + ks) * 64 + lane) * 16); pw[m][ks] = *(const LAS u32x4*)(lds + LDS_P + wid * 8192 + (((mbase + m) * 2 + ks) * 64 + lane) * 16); }
            else { hw[m][ks] = *(const u32x4*)(hl + o); pw[m][ks] = *(const u32x4*)(Pp + o); } gw[m][ks] = *(const u32x4*)(proj + rowg * DIN + 2 * DH + ch); }
    float y[NMR][16];
#pragma unroll
    for (int m = 0; m < NMR; ++m) { float s = 0.f;
#pragma unroll
        for (int ks = 0; ks < 2; ++ks) { float pf[8], gt[8]; unpack8(pw[m][ks], pf); unpack8(gw[m][ks], gt);
            float hh[8]; unpack8(hw[m][ks], hh);
#pragma unroll
            for (int e = 0; e < 8; ++e) { const float hv = fmaf(pf[e], cr[8 * ks + e], hh[e]), x = gt[e];
                const float ge = x * __builtin_amdgcn_rcpf(1.0f + __expf(-1.5957691216f * (x + 0.044715f * x * x * x)));
                const float yy = hv * ge; y[m][8 * ks + e] = yy; s = fmaf(yy, yy, s); } }
        s += __shfl_xor(s, 16); s += __shfl_xor(s, 32);
        if (fq == 0) red1[(16 * (mbase + m) + fr) * 8 + wid] = s; }
    __syncthreads();
#pragma unroll
    for (int m = 0; m < NMR; ++m) { const size_t rowg = (size_t)b * TT + t0 + 16 * (mbase + m) + fr;
        const f32x4 r0 = *(const LAS f32x4*)(red1 + (16 * (mbase + m) + fr) * 8), r1 = *(const LAS f32x4*)(red1 + (16 * (mbase + m) + fr) * 8 + 4);
        const float rs = __builtin_amdgcn_rsqf((((r0.x + r0.y) + (r0.z + r0.w)) + ((r1.x + r1.y) + (r1.z + r1.w))) * (1.0f / DH) + EPS);
#pragma unroll
        for (int ks = 0; ks < 2; ++ks) { float yy[8];
#pragma unroll
            for (int e = 0; e < 8; ++e) yy[e] = y[m][8 * ks + e] * rs;
            *(u32x4*)(Y + rowg * D + DH + wid * 64 + 32 * ks + 8 * fq) = pack8(yy); } }
}


template <int NMR> __device__ __forceinline__ void m2_pool_round(const bf16* proj, bf16* Y, const bf16* Wp, const float* pbias, const float* pscale, LAS float* red2,
                                                                  int b, int t0, int mbase, int g, int half, int kwin, int wid, int fr, int fq) {
    const int tb = t0 + 16 * mbase;
    bf16x8 pfr[NMR][4];
#pragma unroll
    for (int ks = 0; ks < 4; ++ks) {
        const int chb = g * 128 + 32 * ks + 8 * fq;
        float pu[8], p2[8], p4[8], p8[8];
        if (tb) { const u32x4 raw = *(const u32x4*)(proj + ((size_t)b * TT + tb - 16 + fr) * DIN + chb); unpack8(raw, pu);
#pragma unroll
            for (int e = 0; e < 8; ++e) { p2[e] = pu[e] + dppf<0x111>(0.f, pu[e]); p4[e] = p2[e] + dppf<0x112>(0.f, p2[e]); p8[e] = p4[e] + dppf<0x114>(0.f, p4[e]); } }
        else {
#pragma unroll
            for (int e = 0; e < 8; ++e) { pu[e] = 0.f; p2[e] = 0.f; p4[e] = 0.f; p8[e] = 0.f; } }
#pragma unroll
        for (int m = 0; m < NMR; ++m) {
            const int t = tb + 16 * m + fr; const size_t rowg = (size_t)b * TT + t;
            const u32x4 raw = *(const u32x4*)(proj + rowg * DIN + chb); float u[8], po[8]; unpack8(raw, u);
            const int cnt = (t + 1 < kwin) ? t + 1 : kwin; const float rc = __builtin_amdgcn_rcpf((float)cnt);
#pragma unroll
            for (int e = 0; e < 8; ++e) {
                const float s2 = u[e] + shiftd<1>(u[e], pu[e]), s4 = s2 + shiftd<2>(s2, p2[e]), s8 = s4 + shiftd<4>(s4, p4[e]), s16 = s8 + shiftd<8>(s8, p8[e]);
                const float win = g == 0 ? s2 : (g == 1 ? s4 : (g == 2 ? s8 : s16));
                po[e] = fmaf(win, rc, -u[e]); pu[e] = u[e]; p2[e] = s2; p4[e] = s4; p8[e] = s8;
            }
            pfr[m][ks] = __builtin_bit_cast(bf16x8, pack8(po));
        }
    }
    bf16x8 wfr[4][4];
#pragma unroll
    for (int n = 0; n < 4; ++n)
#pragma unroll
        for (int ks = 0; ks < 4; ++ks) wfr[n][ks] = *(const bf16x8*)(Wp + (size_t)(64 * half + outchan(n, fr)) * 128 + 32 * ks + 8 * fq);
#pragma unroll 1
    for (int pass = 0; pass < 2; ++pass) {
#pragma unroll
        for (int m = 0; m < NMR; ++m) {
            const int t = tb + 16 * m + fr; const size_t rowg = (size_t)b * TT + t; float s = 0.f, rs = 0.f;
            if (pass) { const f32x4 r0 = *(const LAS f32x4*)(red2 + (16 * (mbase + m) + fr) * 8), r1 = *(const LAS f32x4*)(red2 + (16 * (mbase + m) + fr) * 8 + 4);
                rs = __builtin_amdgcn_rsqf((((r0.x + r0.y) + (r0.z + r0.w)) + ((r1.x + r1.y) + (r1.z + r1.w))) * (1.0f / DH) + EPS); }
#pragma unroll
            for (int np = 0; np < 2; ++np) {
                f32x4 o2[2];
#pragma unroll
                for (int nn = 0; nn < 2; ++nn) { const int n = 2 * np + nn;
                    f32x4 acc = {0.f, 0.f, 0.f, 0.f};
#pragma unroll
                    for (int ks = 0; ks < 4; ++ks) acc = __builtin_amdgcn_mfma_f32_16x16x32_bf16(wfr[n][ks], pfr[m][ks], acc, 0, 0, 0);
                    const int col = g * 128 + 64 * half + 32 * np + 8 * fq + 4 * nn;
                    const f32x4 pb = *(const f32x4*)(pbias + col), ps = *(const f32x4*)(pscale + col);
                    acc = (acc + pb) * ps; s += (acc.x * acc.x + acc.y * acc.y) + (acc.z * acc.z + acc.w * acc.w); o2[nn] = acc * rs; }
                if (pass) { u32x4 w; w.x = cvt_pk(o2[0].x, o2[0].y); w.y = cvt_pk(o2[0].z, o2[0].w); w.z = cvt_pk(o2[1].x, o2[1].y); w.w = cvt_pk(o2[1].z, o2[1].w);
                    *(u32x4*)(Y + rowg * D + g * 128 + 64 * half + 32 * np + 8 * fq) = w; }
            }
            if (!pass) { s += __shfl_xor(s, 16); s += __shfl_xor(s, 32); if (fq == 0) red2[(16 * (mbase + m) + fr) * 8 + wid] = s; }
        }
        if (!pass) __syncthreads();
    }
}

__device__ __forceinline__ void m2_phase(const Params& p_, LAS unsigned char* lds, int G, int l) {
    const Params p = launder(p_);
    int tid_ = threadIdx.x; asm volatile("" : "+v"(tid_));
    const int tid = tid_, lane = tid & 63, wid = __builtin_amdgcn_readfirstlane(tid >> 6), fr = lane & 15, fq = lane >> 4;
    LAS float* segA = (LAS float*)lds; LAS float* segH = (LAS float*)(lds + 16384); LAS float* carr = (LAS float*)(lds + 32768);
    LAS float* red1 = (LAS float*)(lds + 34816); LAS float* red2 = (LAS float*)(lds + 37888);
    const bf16* proj = (const bf16*)(p.ws + WS_PROJ); bf16* Y = (bf16*)(p.ws + WS_Y);
    const bf16* hl = (const bf16*)(p.ws + WS_HL); const bf16* Pp = (const bf16*)(p.ws + WS_P);
    const float* carA = (const float*)(p.ws + WS_CARA); const float* carH = (const float*)(p.ws + WS_CARH);
    const int g = wid >> 1, half = wid & 1, kwin = 2 << g;
    const bf16* Wp = (const bf16*)(p.ws + WS_POOLW) + (size_t)(l * 4 + g) * 16384;
    const float* pbias = p.in[5] + l * DH; const float* pscale = p.in[6] + l * DH;
    for (int unit = blockIdx.x; unit < 256; unit += G) {
        const int b = unit >> 7, c = unit & 127, t0 = c ? NMETA + 64 * c : 0, NM = c ? 4 : 5;
        {
            const int q = (c + 7) >> 3, jlo = wid * q, jhi = (jlo + q < c) ? jlo + q : c;
            f32x4 A0 = {1.f, 1.f, 1.f, 1.f}, A1 = A0, H0 = {0.f, 0.f, 0.f, 0.f}, H1 = H0;
            for (int j = jlo; j < jhi; j += 8) {
                f32x4 a0[8], a1[8], h0[8], h1[8];
#pragma unroll
                for (int i = 0; i < 8; ++i) { const int jj = (j + i < jhi) ? j + i : jhi - 1; const size_t o = (size_t)(b * 128 + jj) * DH + 8 * lane;
                    a0[i] = *(const f32x4*)(carA + o); a1[i] = *(const f32x4*)(carA + o + 4); h0[i] = *(const f32x4*)(carH + o); h1[i] = *(const f32x4*)(carH + o + 4); }
#pragma unroll
                for (int i = 0; i < 8; ++i) if (j + i < jhi) { H0 = a0[i] * H0 + h0[i]; A0 = A0 * a0[i]; H1 = a1[i] * H1 + h1[i]; A1 = A1 * a1[i]; }
            }
            *(LAS f32x4*)(segA + wid * DH + 8 * lane) = A0; *(LAS f32x4*)(segA + wid * DH + 8 * lane + 4) = A1;
            *(LAS f32x4*)(segH + wid * DH + 8 * lane) = H0; *(LAS f32x4*)(segH + wid * DH + 8 * lane + 4) = H1;
        }
        __syncthreads();
        { float cy = 0.f;
#pragma unroll
          for (int s8 = 0; s8 < 8; ++s8) cy = segA[s8 * DH + tid] * cy + segH[s8 * DH + tid];
          carr[tid] = cy; }
        __syncthreads();
        {
            float cr[16];
#pragma unroll
            for (int ks = 0; ks < 2; ++ks) { const f32x4 c0 = *(const LAS f32x4*)(carr + wid * 64 + 32 * ks + 8 * fq), c1 = *(const LAS f32x4*)(carr + wid * 64 + 32 * ks + 8 * fq + 4);
                cr[8 * ks + 0] = c0.x; cr[8 * ks + 1] = c0.y; cr[8 * ks + 2] = c0.z; cr[8 * ks + 3] = c0.w; cr[8 * ks + 4] = c1.x; cr[8 * ks + 5] = c1.y; cr[8 * ks + 6] = c1.z; cr[8 * ks + 7] = c1.w; }
            m2_rnn_round<4, false>(lds, hl, Pp, proj, Y, red1, cr, b, t0, 0, wid, fr, fq);
            if (NM == 5) m2_rnn_round<1, false>(lds, hl, Pp, proj, Y, red1, cr, b, t0, 4, wid, fr, fq);
        }
        m2_pool_round<4>(proj, Y, Wp, pbias, pscale, red2, b, t0, 0, g, half, kwin, wid, fr, fq);
        if (NM == 5) m2_pool_round<1>(proj, Y, Wp, pbias, pscale, red2, b, t0, 4, g, half, kwin, wid, fr, fq);
    }
    __syncthreads();
}

__device__ __forceinline__ void final_norm(const Params& p_, int G) {
    const Params p = launder(p_);
    int tid_ = threadIdx.x; asm volatile("" : "+v"(tid_));
    const int tid = tid_, lane = tid & 63, wid = tid >> 6; const int gw = blockIdx.x * 8 + wid, NGW = G * 8;
    const bf16* hb = (const bf16*)(p.ws + WS_HB);
    const f32x4* gp = (const f32x4*)p.in[19] + 2 * lane; f32x4 gg[2][2];
#pragma unroll
    for (int j = 0; j < 2; ++j) { gg[j][0] = gp[128 * j]; gg[j][1] = gp[128 * j + 1]; }
    for (int m = gw; m < M; m += NGW) {
        const u32x4* xr = (const u32x4*)(hb + (size_t)m * D) + lane; float v[2][8]; float s = 0.f;
#pragma unroll
        for (int j = 0; j < 2; ++j) { unpack8(xr[64 * j], v[j]);
#pragma unroll
            for (int e = 0; e < 8; ++e) s = fmaf(v[j][e], v[j][e], s); }
        const float rs = 1.0f / sqrtf(wave_sum(s) * (1.0f / D) + EPS);
        f32x4* orow = (f32x4*)(p.out + (size_t)m * D) + 2 * lane;
#pragma unroll
        for (int j = 0; j < 2; ++j) {
            orow[128 * j] = (f32x4){v[j][0] * rs * gg[j][0].x, v[j][1] * rs * gg[j][0].y, v[j][2] * rs * gg[j][0].z, v[j][3] * rs * gg[j][0].w};
            orow[128 * j + 1] = (f32x4){v[j][4] * rs * gg[j][1].x, v[j][5] * rs * gg[j][1].y, v[j][6] * rs * gg[j][1].z, v[j][7] * rs * gg[j][1].w}; }
    }
}


template <int KW> __device__ __forceinline__ float pool_win(float P, float Sp) {
    float w = P;
    if (KW < 16) w -= dppf<0x110 + (KW & 15)>(0.f, P);
    return w + dppf<0x100 + (17 - KW)>(0.f, Sp);
}
template <int KW, int MAXG> __device__ __forceinline__ void pool_frags(const bf16* proj, bf16x8 (&pfr)[MAXG][4], int b, int tb, int cnt, int g, int fr, int fq) {
#pragma unroll
    for (int ks = 0; ks < 4; ++ks) {
        const int chb = g * 128 + 32 * ks + 8 * fq;
        float Sp[8];
        if (tb) { const u32x4 raw = *(const u32x4*)(proj + ((size_t)b * TT + tb - 16 + fr) * DIN + chb); unpack8(raw, Sp);
#pragma unroll
            for (int e = 0; e < 8; ++e) { Sp[e] += dppf<0x101>(0.f, Sp[e]); Sp[e] += dppf<0x102>(0.f, Sp[e]); Sp[e] += dppf<0x104>(0.f, Sp[e]); Sp[e] += dppf<0x108>(0.f, Sp[e]); } }
        else {
#pragma unroll
            for (int e = 0; e < 8; ++e) Sp[e] = 0.f; }
#pragma unroll
        for (int mi = 0; mi < MAXG; ++mi) if (mi < cnt) {
            const int t = tb + 16 * mi + fr;
            const u32x4 raw = *(const u32x4*)(proj + ((size_t)b * TT + t) * DIN + chb); float u[8], po[8]; unpack8(raw, u);
            const int cn = (t + 1 < KW) ? t + 1 : KW; const float rc = __builtin_amdgcn_rcpf((float)cn);
#pragma unroll
            for (int e = 0; e < 8; ++e) {
                float P = u[e]; P += dppf<0x111>(0.f, P); P += dppf<0x112>(0.f, P); P += dppf<0x114>(0.f, P); P += dppf<0x118>(0.f, P);
                float S = u[e]; S += dppf<0x101>(0.f, S); S += dppf<0x102>(0.f, S); S += dppf<0x104>(0.f, S); S += dppf<0x108>(0.f, S);
                po[e] = fmaf(pool_win<KW>(P, Sp[e]), rc, -u[e]); Sp[e] = S;
            }
            pfr[mi][ks] = __builtin_bit_cast(bf16x8, pack8(po));
        }
    }
}
__device__ __forceinline__ void m2_pool2(const bf16* proj, bf16* Y, const bf16* Wp, const float* pbias, const float* pscale, LAS float* red2, int b, int t0, int NM, int g, int th, int fr, int fq) {
    const int m0 = th ? (NM == 5 ? 3 : 2) : 0, cnt = th ? 2 : (NM == 5 ? 3 : 2), tb = t0 + 16 * m0;
    bf16x8 pfr[3][4];
    switch (g) {
        case 0: pool_frags<2, 3>(proj, pfr, b, tb, cnt, g, fr, fq); break;
        case 1: pool_frags<4, 3>(proj, pfr, b, tb, cnt, g, fr, fq); break;
        case 2: pool_frags<8, 3>(proj, pfr, b, tb, cnt, g, fr, fq); break;
        default: pool_frags<16, 3>(proj, pfr, b, tb, cnt, g, fr, fq); break;
    }
    f32x4 ov[3][8]; float sq[3] = {0.f, 0.f, 0.f};
#pragma unroll
    for (int n = 0; n < 8; ++n) {
        bf16x8 wf[4];
#pragma unroll
        for (int ks = 0; ks < 4; ++ks) wf[ks] = *(const bf16x8*)(Wp + (size_t)outchan(n, fr) * 128 + 32 * ks + 8 * fq);
        const int col = g * 128 + 32 * (n >> 1) + 8 * fq + 4 * (n & 1);
        const f32x4 pb = *(const f32x4*)(pbias + col), ps = *(const f32x4*)(pscale + col);
#pragma unroll
        for (int mi = 0; mi < 3; ++mi) if (mi < cnt) {
            f32x4 acc = {0.f, 0.f, 0.f, 0.f};
#pragma unroll
            for (int ks = 0; ks < 4; ++ks) acc = __builtin_amdgcn_mfma_f32_16x16x32_bf16(wf[ks], pfr[mi][ks], acc, 0, 0, 0);
            acc = (acc + pb) * ps; ov[mi][n] = acc; sq[mi] += (acc.x * acc.x + acc.y * acc.y) + (acc.z * acc.z + acc.w * acc.w);
        }
    }
#pragma unroll
    for (int mi = 0; mi < 3; ++mi) if (mi < cnt) { float s = sq[mi]; s += __shfl_xor(s, 16); s += __shfl_xor(s, 32); if (fq == 0) red2[(16 * (m0 + mi) + fr) * 4 + g] = s; }
    __syncthreads();
#pragma unroll
    for (int mi = 0; mi < 3; ++mi) if (mi < cnt) {
        const size_t rowg = (size_t)b * TT + tb + 16 * mi + fr;
        const f32x4 r0 = *(const LAS f32x4*)(red2 + (16 * (m0 + mi) + fr) * 4);
        const float rs = __builtin_amdgcn_rsqf(((r0.x + r0.y) + (r0.z + r0.w)) * (1.0f / DH) + EPS);
#pragma unroll
        for (int np = 0; np < 4; ++np) {
            const f32x4 a = ov[mi][2 * np] * rs, bq = ov[mi][2 * np + 1] * rs;
            u32x4 w; w.x = cvt_pk(a.x, a.y); w.y = cvt_pk(a.z, a.w); w.z = cvt_pk(bq.x, bq.y); w.w = cvt_pk(bq.z, bq.w);
            *(u32x4*)(Y + rowg * D + g * 128 + 32 * np + 8 * fq) = w;
        }
    }
}

#ifndef PROBE_PHASE
#define PROBE_PHASE (-1)
#endif
#ifndef PROBE_BLOCK
#define PROBE_BLOCK 0
#endif
#define TIC() do { if (PROBE_PHASE >= 0) tic = __builtin_amdgcn_s_memrealtime(); } while (0)
#define TOC(k) do { if (PROBE_PHASE == (k)) tacc += __builtin_amdgcn_s_memrealtime() - tic; } while (0)

__device__ __forceinline__ void mixer_phase(const Params& p_, LAS unsigned char* lds, int G, int l, unsigned long long& tic, unsigned long long& tacc) {
    const Params p = launder(p_);
    int tid_ = threadIdx.x; asm volatile("" : "+v"(tid_));
    const int tid = tid_, lane = tid & 63, wid = __builtin_amdgcn_readfirstlane(tid >> 6), fr = lane & 15, fq = lane >> 4;
    LAS float* cst = (LAS float*)(lds + LDS_CST);
    const bf16* proj = (const bf16*)(p.ws + WS_PROJ);
    const bf16* Wr = (const bf16*)(p.ws + WS_GR) + (size_t)(l * 8 + wid) * 4096; const bf16* Wi = (const bf16*)(p.ws + WS_GI) + (size_t)(l * 8 + wid) * 4096;
    LAS float* segA = (LAS float*)(lds + LDS_CST); LAS float* segH = (LAS float*)(lds + LDS_CST + 8192); LAS float* carr = (LAS float*)(lds + LDS_CARR);
    LAS float* red1 = (LAS float*)(lds + LDS_RED1); LAS float* red2 = (LAS float*)(lds + LDS_RED2);
    bf16* Y = (bf16*)(p.ws + WS_Y);
    const int g = wid >> 1, half = wid & 1, kwin = 2 << g;
    const bf16* Wp = (const bf16*)(p.ws + WS_POOLW) + (size_t)(l * 4 + g) * 16384;
    const float* pbias = p.in[5] + l * DH; const float* pscale = p.in[6] + l * DH;
    unsigned* flags = (unsigned*)(p.ws + WS_FLAG); unsigned* car = (unsigned*)(p.ws + WS_CARA);
    bf16* hl = (bf16*)(p.ws + WS_HL); bf16* Pp = (bf16*)(p.ws + WS_P);
    float* carA = (float*)(p.ws + WS_CARA); float* carH = (float*)(p.ws + WS_CARH);
    const int unit = blockIdx.x;
    if (unit < 256) {
        const int b = unit >> 7, c = unit & 127, t0 = c ? NMETA + 64 * c : 0, NM = c ? 4 : 5;
        TIC();
        float cv[8];
#pragma unroll
        for (int k4 = 0; k4 < 4; ++k4) cv[k4] = p.in[7][(l * 4 + k4) * DH + tid];
        cv[4] = p.in[8][l * DH + tid]; cv[5] = p.in[10][l * DH + tid]; cv[6] = p.in[12][l * DH + tid]; cv[7] = ((const float*)(p.ws + WS_SP))[l * DH + tid];
        bf16x8 wfr[4][2][2];
#pragma unroll
        for (int n = 0; n < 4; ++n)
#pragma unroll
            for (int ks = 0; ks < 2; ++ks) { wfr[n][ks][0] = *(const bf16x8*)(Wr + outchan(n, fr) * 64 + 32 * ks + 8 * fq); wfr[n][ks][1] = *(const bf16x8*)(Wi + outchan(n, fr) * 64 + 32 * ks + 8 * fq); }
        LAS float* cslot = (LAS float*)(lds + LDS_CARRY) + (wid * 4 + fq) * 32;
        if (fr == 15) {
#pragma unroll
            for (int k4 = 0; k4 < 4; ++k4) { *(LAS f32x4*)(cslot + 4 * k4) = (f32x4){0.f, 0.f, 0.f, 0.f}; *(LAS f32x4*)(cslot + 16 + 4 * k4) = (f32x4){1.f, 1.f, 1.f, 1.f}; } }
        u32x4 raw[2][4];
#pragma unroll
        for (int ks = 0; ks < 2; ++ks)
#pragma unroll
            for (int d = 0; d < 4; ++d) { const int tt = t0 + fr - 3 + d; raw[ks][d] = (u32x4){0u, 0u, 0u, 0u};
                if (tt >= 0) raw[ks][d] = *(const u32x4*)(proj + ((size_t)b * TT + tt) * DIN + DH + wid * 64 + 32 * ks + 8 * fq); }
        __syncthreads();
#pragma unroll
        for (int k8 = 0; k8 < 8; ++k8) cst[k8 * DH + tid] = cv[k8];
        __syncthreads();
        TOC(10); TIC();
#pragma unroll 1
        for (int m = 0; m < NM; ++m) {
            const int t = t0 + 16 * m + fr; const size_t rowg = (size_t)b * TT + t;
            u32x4 nraw[2][4];
#pragma unroll
            for (int ks = 0; ks < 2; ++ks)
#pragma unroll
                for (int d = 0; d < 4; ++d) { nraw[ks][d] = (u32x4){0u, 0u, 0u, 0u};
                    if (m + 1 < NM) nraw[ks][d] = *(const u32x4*)(proj + ((size_t)b * TT + t + 13 + d) * DIN + DH + wid * 64 + 32 * ks + 8 * fq); }
            float xc[2][8]; bf16x8 frag[2];
#pragma unroll
            for (int ks = 0; ks < 2; ++ks) {
                const int chb = wid * 64 + 32 * ks + 8 * fq;
                { const f32x4 c0 = *(const LAS f32x4*)(cst + 4 * DH + chb), c1 = *(const LAS f32x4*)(cst + 4 * DH + chb + 4);
                  xc[ks][0] = c0.x; xc[ks][1] = c0.y; xc[ks][2] = c0.z; xc[ks][3] = c0.w; xc[ks][4] = c1.x; xc[ks][5] = c1.y; xc[ks][6] = c1.z; xc[ks][7] = c1.w; }
#pragma unroll
                for (int d = 0; d < 4; ++d) {
                    float u[8]; unpack8(raw[ks][d], u);
                    const f32x4 w0 = *(const LAS f32x4*)(cst + d * DH + chb), w1 = *(const LAS f32x4*)(cst + d * DH + chb + 4);
                    xc[ks][0] += u[0] * w0.x; xc[ks][1] += u[1] * w0.y; xc[ks][2] += u[2] * w0.z; xc[ks][3] += u[3] * w0.w;
                    xc[ks][4] += u[4] * w1.x; xc[ks][5] += u[5] * w1.y; xc[ks][6] += u[6] * w1.z; xc[ks][7] += u[7] * w1.w;
                    raw[ks][d] = nraw[ks][d];
                }
                frag[ks] = __builtin_bit_cast(bf16x8, pack8(xc[ks]));
            }
            f32x4 ar[4], ai[4];
#pragma unroll
            for (int n = 0; n < 4; ++n) { ar[n] = (f32x4){0.f, 0.f, 0.f, 0.f}; ai[n] = (f32x4){0.f, 0.f, 0.f, 0.f};
#pragma unroll
                for (int ks = 0; ks < 2; ++ks) {
                    const bf16x8 wr_ = wfr[n][ks][0], wi_ = wfr[n][ks][1];
                    ar[n] = __builtin_amdgcn_mfma_f32_16x16x32_bf16(wr_, frag[ks], ar[n], 0, 0, 0);
                    ai[n] = __builtin_amdgcn_mfma_f32_16x16x32_bf16(wi_, frag[ks], ai[n], 0, 0, 0);
                } }
            float Aa[16], Bb[16];
#pragma unroll
            for (int n = 0; n < 4; ++n) {
                const int cho = wid * 64 + 32 * (n >> 1) + 8 * fq + 4 * (n & 1);
                const f32x4 rb = *(const LAS f32x4*)(cst + 5 * DH + cho), ib = *(const LAS f32x4*)(cst + 6 * DH + cho), spv = *(const LAS f32x4*)(cst + 7 * DH + cho);
#pragma unroll
                for (int jj = 0; jj < 4; ++jj) {
                    const float r = sigm(ar[n][jj] + rb[jj]), ig = sigm(ai[n][jj] + ib[jj]);
                    const float la = -8.0f * r * spv[jj], a = __expf(la), x2 = 2.0f * la;
                    const float m2s = -x2 * (1.0f + x2 * (0.5f + x2 * (0.16666667f + x2 * 0.041666668f))), m2 = (x2 > -0.0625f) ? m2s : 1.0f - a * a;
                    Aa[n * 4 + jj] = a; Bb[n * 4 + jj] = __builtin_amdgcn_sqrtf(m2) * ig * xc[n >> 1][4 * (n & 1) + jj];
                }
            }
#pragma unroll
            for (int k = 0; k < 16; ++k) {
                float A = Aa[k], B = Bb[k], Ap, Bq;
                Ap = dppf<0x111>(1.f, A); Bq = dppf<0x111>(0.f, B); B = fmaf(A, Bq, B); A *= Ap;
                Ap = dppf<0x112>(1.f, A); Bq = dppf<0x112>(0.f, B); B = fmaf(A, Bq, B); A *= Ap;
                Ap = dppf<0x114>(1.f, A); Bq = dppf<0x114>(0.f, B); B = fmaf(A, Bq, B); A *= Ap;
                Ap = dppf<0x118>(1.f, A); Bq = dppf<0x118>(0.f, B); B = fmaf(A, Bq, B); A *= Ap;
                Bb[k] = B; Aa[k] = A;
            }
            {
                float Hc[16], Pc[16];
#pragma unroll
                for (int k4 = 0; k4 < 4; ++k4) { const f32x4 hq = *(const LAS f32x4*)(cslot + 4 * k4), pq = *(const LAS f32x4*)(cslot + 16 + 4 * k4);
                    Hc[4 * k4] = hq.x; Hc[4 * k4 + 1] = hq.y; Hc[4 * k4 + 2] = hq.z; Hc[4 * k4 + 3] = hq.w; Pc[4 * k4] = pq.x; Pc[4 * k4 + 1] = pq.y; Pc[4 * k4 + 2] = pq.z; Pc[4 * k4 + 3] = pq.w; }
#pragma unroll
                for (int k = 0; k < 16; ++k) { Bb[k] = fmaf(Aa[k], Hc[k], Bb[k]); Aa[k] *= Pc[k]; }
                if (fr == 15) {
#pragma unroll
                    for (int k4 = 0; k4 < 4; ++k4) { *(LAS f32x4*)(cslot + 4 * k4) = (f32x4){Bb[4 * k4], Bb[4 * k4 + 1], Bb[4 * k4 + 2], Bb[4 * k4 + 3]}; *(LAS f32x4*)(cslot + 16 + 4 * k4) = (f32x4){Aa[4 * k4], Aa[4 * k4 + 1], Aa[4 * k4 + 2], Aa[4 * k4 + 3]}; } }
            }
#pragma unroll
            for (int ks = 0; ks < 2; ++ks) {
                const size_t o = rowg * DH + wid * 64 + 32 * ks + 8 * fq;
                u32x4 wh; wh.x = cvt_pk(Bb[8 * ks + 0], Bb[8 * ks + 1]); wh.y = cvt_pk(Bb[8 * ks + 2], Bb[8 * ks + 3]); wh.z = cvt_pk(Bb[8 * ks + 4], Bb[8 * ks + 5]); wh.w = cvt_pk(Bb[8 * ks + 6], Bb[8 * ks + 7]);
                u32x4 w; w.x = cvt_pk(Aa[8 * ks + 0], Aa[8 * ks + 1]); w.y = cvt_pk(Aa[8 * ks + 2], Aa[8 * ks + 3]); w.z = cvt_pk(Aa[8 * ks + 4], Aa[8 * ks + 5]); w.w = cvt_pk(Aa[8 * ks + 6], Aa[8 * ks + 7]);
                if (m < 4) { *(LAS u32x4*)(lds + LDS_HL + wid * 8192 + ((m * 2 + ks) * 64 + lane) * 16) = wh; *(LAS u32x4*)(lds + LDS_P + wid * 8192 + ((m * 2 + ks) * 64 + lane) * 16) = w; }
                else { *(u32x4*)(hl + o) = wh; *(u32x4*)(Pp + o) = w; }
            }
        }
        TOC(11); TIC();
        if (fr == 0) {
            float Hc[16], Pc[16];
#pragma unroll
            for (int k4 = 0; k4 < 4; ++k4) { const f32x4 hq = *(const LAS f32x4*)(cslot + 4 * k4), pq = *(const LAS f32x4*)(cslot + 16 + 4 * k4);
                Hc[4 * k4] = hq.x; Hc[4 * k4 + 1] = hq.y; Hc[4 * k4 + 2] = hq.z; Hc[4 * k4 + 3] = hq.w; Pc[4 * k4] = pq.x; Pc[4 * k4 + 1] = pq.y; Pc[4 * k4 + 2] = pq.z; Pc[4 * k4 + 3] = pq.w; }
#pragma unroll
            for (int ks = 0; ks < 2; ++ks) {
                const size_t o = (size_t)(b * 128 + c) * DH + wid * 64 + 32 * ks + 8 * fq;
#pragma unroll
                for (int e2 = 0; e2 < 4; ++e2) {
                    const unsigned lo = cvt_pk(Pc[8 * ks + 2 * e2], Hc[8 * ks + 2 * e2]), hi = cvt_pk(Pc[8 * ks + 2 * e2 + 1], Hc[8 * ks + 2 * e2 + 1]);
                    __hip_atomic_store((unsigned long long*)(car + o) + e2, ((unsigned long long)hi << 32) | lo, __ATOMIC_RELAXED, __HIP_MEMORY_SCOPE_AGENT); }
            }
        }
        int fr2 = fr, fq2 = fq, tid2 = tid; asm volatile("" : "+v"(fr2), "+v"(fq2), "+v"(tid2));
        TOC(12); TIC();
#ifndef NO_MX_POOL
        m2_pool2(proj, Y, Wp, pbias, pscale, red2, b, t0, NM, g, half, fr2, fq2);
#endif
        asm volatile("s_waitcnt vmcnt(0)" ::: "memory");
        __syncthreads();
        if (tid2 == 0) __hip_atomic_store(flags + unit, (unsigned)(l + 1), __ATOMIC_RELAXED, __HIP_MEMORY_SCOPE_AGENT);
        TOC(13); TIC();
        if (tid2 < c) { unsigned sp = 0; while (__hip_atomic_load(flags + b * 128 + tid2, __ATOMIC_RELAXED, __HIP_MEMORY_SCOPE_AGENT) < (unsigned)(l + 1)) { __builtin_amdgcn_s_sleep(2); if (++sp > (1u << 22)) break; } }
#if defined(MIXER_ACQ_FENCE)
        if (tid2 < c) __builtin_amdgcn_fence(__ATOMIC_ACQUIRE, "agent");
#endif
        __syncthreads();
        TOC(14); TIC();
        {
            const int q = (c + 3) >> 2, seg = tid2 >> 7, cgi = tid2 & 127, jlo = seg * q, jhi = (jlo + q < c) ? jlo + q : c;
            f32x4 A0 = {1.f, 1.f, 1.f, 1.f}, H0 = {0.f, 0.f, 0.f, 0.f};
            for (int j = jlo; j < jhi; j += 16) {
                unsigned long long w0[16], w1[16];
#pragma unroll
                for (int i = 0; i < 16; ++i) { const int jj = (j + i < jhi) ? j + i : jhi - 1; const size_t o = (size_t)(b * 128 + jj) * DH + 4 * cgi;
                    w0[i] = __hip_atomic_load((const unsigned long long*)(car + o), __ATOMIC_RELAXED, __HIP_MEMORY_SCOPE_AGENT); w1[i] = __hip_atomic_load((const unsigned long long*)(car + o) + 1, __ATOMIC_RELAXED, __HIP_MEMORY_SCOPE_AGENT); }
#pragma unroll
                for (int i = 0; i < 16; ++i) if (j + i < jhi) {
                    const f32x4 a = {bf_lo((unsigned)w0[i]), bf_lo((unsigned)(w0[i] >> 32)), bf_lo((unsigned)w1[i]), bf_lo((unsigned)(w1[i] >> 32))};
                    const f32x4 h = {bf_hi((unsigned)w0[i]), bf_hi((unsigned)(w0[i] >> 32)), bf_hi((unsigned)w1[i]), bf_hi((unsigned)(w1[i] >> 32))};
                    H0 = a * H0 + h; A0 = A0 * a; }
            }
            *(LAS f32x4*)(segA + seg * DH + 4 * cgi) = A0; *(LAS f32x4*)(segH + seg * DH + 4 * cgi) = H0;
        }
        __syncthreads();
        { float cy = 0.f;
#pragma unroll
          for (int s4 = 0; s4 < 4; ++s4) cy = segA[s4 * DH + tid2] * cy + segH[s4 * DH + tid2];
          carr[tid2] = cy; }
        __syncthreads();
        TOC(15); TIC();
        {
            float cr[16];
#pragma unroll
            for (int ks = 0; ks < 2; ++ks) { const f32x4 c0 = *(const LAS f32x4*)(carr + wid * 64 + 32 * ks + 8 * fq2), c1 = *(const LAS f32x4*)(carr + wid * 64 + 32 * ks + 8 * fq2 + 4);
                cr[8 * ks + 0] = c0.x; cr[8 * ks + 1] = c0.y; cr[8 * ks + 2] = c0.z; cr[8 * ks + 3] = c0.w; cr[8 * ks + 4] = c1.x; cr[8 * ks + 5] = c1.y; cr[8 * ks + 6] = c1.z; cr[8 * ks + 7] = c1.w; }
#ifndef NO_MX_RNN
            m2_rnn_round<4, true>(lds, hl, Pp, proj, Y, red1, cr, b, t0, 0, wid, fr2, fq2);
            if (NM == 5) m2_rnn_round<1, false>(lds, hl, Pp, proj, Y, red1, cr, b, t0, 4, wid, fr2, fq2);
#endif
        }
        TOC(16);
    }
    __syncthreads();
}

#define XB_TMO      128
#define XB_XCNT(j)  (256  + 64 * (j))
#define XB_XSUB(j)  (1280 + 64 * (j))
#define XB_XGEN(j)  (2304 + 64 * (j))
#define XB_TOP      3328
#define XB_TOPGEN   3392
#define XCD_BAR_WORDS 3456
#define XB_SPIN_CAP (1u << 18)

__device__ __forceinline__ unsigned xb_ld(unsigned* p)              { return __hip_atomic_load(p, __ATOMIC_RELAXED, __HIP_MEMORY_SCOPE_AGENT); }
__device__ __forceinline__ unsigned xb_add(unsigned* p, unsigned v) { return __hip_atomic_fetch_add(p, v, __ATOMIC_RELAXED, __HIP_MEMORY_SCOPE_AGENT); }
__device__ __forceinline__ unsigned xb_xcc_id() { return (unsigned)__builtin_amdgcn_s_getreg((3 << 11) | 20) & 0xFu; }
#define XB_SPIN(cond, bar) do { unsigned _sp = 0; while (cond) { __builtin_amdgcn_s_sleep(1); \
    if ((++_sp & 255u) == 0u) { if (xb_ld(&(bar)[XB_TMO])) break; if (_sp > XB_SPIN_CAP) { atomicAdd(&(bar)[XB_TMO], 1u); break; } } } } while (0)

struct XcdBarrier {
    unsigned* bar; unsigned x;
    volatile LAS unsigned* st;
};

__device__ __forceinline__ XcdBarrier xcd_barrier_post(unsigned* bar, volatile LAS unsigned* st) {
    XcdBarrier b; b.bar = bar; b.x = xb_xcc_id(); b.st = st;
    if (threadIdx.x == 0) (void)xb_add(&bar[XB_XCNT(b.x)], 1u);
    return b;
}
__device__ __forceinline__ void xcd_barrier_complete(unsigned* bar, unsigned x, unsigned& nloc, unsigned& nx) {
    const unsigned G = gridDim.x * gridDim.y * gridDim.z;
    unsigned sum, cnt, mine, sp = 0u;
    for (;;) {
        sum = 0u; cnt = 0u; mine = 0u;
#pragma unroll
        for (unsigned j = 0; j < 16; ++j) { const unsigned c = xb_ld(&bar[XB_XCNT(j)]); sum += c; cnt += (c > 0u) ? 1u : 0u; mine = (j == x) ? c : mine; }
        if (sum == G) break;
        __builtin_amdgcn_s_sleep(1);
        if ((++sp & 255u) == 0u) { if (xb_ld(&bar[XB_TMO])) break; if (sp > XB_SPIN_CAP) { atomicAdd(&bar[XB_TMO], 1u); break; } }
    }
    nloc = mine > 0u ? mine : 1u; nx = cnt > 0u ? cnt : 1u;
}

__device__ __forceinline__ void xcd_barrier(const XcdBarrier& b) {
    asm volatile("s_waitcnt vmcnt(0)" ::: "memory");
    __syncthreads();
    if (threadIdx.x == 0) {
        unsigned* bar = b.bar;
        __builtin_amdgcn_s_waitcnt(0);
        unsigned nloc = b.st[0], nx = b.st[1];
        if (nloc == 0u) { xcd_barrier_complete(bar, b.x, nloc, nx); b.st[0] = nloc; b.st[1] = nx; }
        const unsigned old = xb_add(&bar[XB_XSUB(b.x)], 1u);
        const unsigned gen = old / nloc;
        if (old + 1u == (gen + 1u) * nloc) {
            __builtin_amdgcn_fence(__ATOMIC_RELEASE, "agent");
            asm volatile("s_waitcnt vmcnt(0)" ::: "memory");
            const unsigned og = xb_add(&bar[XB_TOP], 1u);
            const unsigned tg = og / nx;
            if (og + 1u == (tg + 1u) * nx) xb_add(&bar[XB_TOPGEN], 1u);
            else XB_SPIN(xb_ld(&bar[XB_TOPGEN]) == tg, bar);
            __builtin_amdgcn_fence(__ATOMIC_ACQUIRE, "agent");
            asm volatile("s_waitcnt vmcnt(0)" ::: "memory");
        } else {
            XB_SPIN(xb_ld(&bar[XB_TOPGEN]) == gen, bar);
            __builtin_amdgcn_fence(__ATOMIC_ACQUIRE, "agent");
            asm volatile("s_waitcnt vmcnt(0)" ::: "memory");
        }
    }
    __syncthreads();
}

#ifndef PROBE_SYNC2
#define PROBE_SYNC2 0
#endif
#ifndef PROBE_M1X2
#define PROBE_M1X2 0
#endif
#ifndef PROBE_M2X2
#define PROBE_M2X2 0
#endif
#define GSYNC() do { { __attribute__((address_space(1))) unsigned* gb_ = (__attribute__((address_space(1))) unsigned*)xbar.bar; asm volatile("" : "+s"(gb_)); xbar.bar = (unsigned*)gb_; asm volatile("" : "+s"(xbar.x)); } xcd_barrier(xbar); if (PROBE_SYNC2) xcd_barrier(xbar); } while (0)
__device__ __forceinline__ int rstd_cache(LAS unsigned char* lds, const float* ss, const pg8::StaticOrder& S) {
    pg8::Unit u0; int pmc = -1;
    int tid = threadIdx.x; asm volatile("" : "+v"(tid));
    if (S.next(0, u0)) { pmc = u0.pm; if (tid < 256) ((LAS float*)(lds + 131072))[tid] = row_rstd(ss, u0.pm * 256 + tid); }
    asm volatile("s_waitcnt vmcnt(0) lgkmcnt(0)" ::: "memory");
    return pmc;
}
__global__ void __launch_bounds__(512, 2) fwd_megakernel(Params p) {
    extern __shared__ __attribute__((aligned(16))) unsigned char lds_raw[];
    LAS unsigned char* lds = (LAS unsigned char*)lds_raw;
#if defined(KEEP_CG_SYNC)
    cg::grid_group grid = cg::this_grid();
#endif
    const int G = gridDim.x;
    unsigned long long tic = 0, tacc = 0;
    unsigned char* ws = p.ws;
    volatile LAS unsigned* xst = (volatile LAS unsigned*)(lds + LDS_XST);
    if (threadIdx.x < 2) xst[threadIdx.x] = 0u;
    __syncthreads();
    XcdBarrier xbar = xcd_barrier_post((unsigned*)(ws + WS_CTL), xst);
    bf16* hb = (bf16*)(ws + WS_HB); bf16* proj = (bf16*)(ws + WS_PROJ); bf16* Y = (bf16*)(ws + WS_Y); bf16* mid = (bf16*)(ws + WS_MID); float* ss = (float*)(ws + WS_SS);
#if defined(KEEP_CG_SYNC)
    grid.sync();
#endif
    TIC();
#ifndef NO_PRO
    prologue(p, lds, G);
#endif
    GSYNC();
    TOC(0);
#pragma unroll 1
    for (int l = 0; l < DEPTH; ++l) {
        { __attribute__((address_space(1))) unsigned char* gws = (__attribute__((address_space(1))) unsigned char*)ws; asm volatile("" : "+s"(gws)); ws = (unsigned char*)gws; }
        const unsigned char* wl = ws + WS_W + (size_t)l * W_LAYER;
        const bf16* in_t = (const bf16*)(wl + W_IN); const bf16* out_t = (const bf16*)(wl + W_OUT); const bf16* up_t = (const bf16*)(wl + W_UP); const bf16* down_t = (const bf16*)(wl + W_DOWN);
        TIC();
#ifndef NO_GIN
        { pg8::Gemm g{hb, in_t, M, DIN, D, 0}; pg8::StaticOrder S; S.init(M, DIN, G, (int)blockIdx.x); const int pmc = rstd_cache(lds, ss, S); EpiIn E{proj, ss, (const LAS float*)(lds + 131072), pmc};
          pg8::gemm_phase<EpiIn, pg8::StaticOrder, true, true>(lds, g, S, E); }
#endif
#ifndef NO_META
        meta_tasks<0>(p, lds, G, nullptr, 0, in_t, D, DIN / 16);
#endif
        if (G == 256 && blockIdx.x >= 128) {
            const int lo = l * TITEMS_PER_LAYER + TITEMS_IN, hi = (l + 1 < DEPTH) ? (l + 1) * TITEMS_PER_LAYER + TITEMS_IN : DEPTH * TITEMS_PER_LAYER;
            convert_items(p, lds, lo, hi, (int)blockIdx.x - 128, 128 * 8);
        }
        GSYNC();
        TOC(1); TIC();
#ifndef FUSED_MIXER
#define FUSED_MIXER 1
#endif
#if FUSED_MIXER
        mixer_phase(p, lds, G, l, tic, tacc);
        GSYNC();
        TOC(2);
#else
        m1_phase(p, lds, G, l);
        GSYNC();
        TOC(2); TIC();
        m2_phase(p, lds, G, l);
        GSYNC();
#endif
        TOC(3); TIC();
#ifndef NO_GOUT
        { pg8::Gemm g{Y, out_t, M, D, D, NMETA}; pg8::StaticOrder S; S.init(M, D, G, (int)blockIdx.x); EpiRes E{hb, ss};
          pg8::gemm_phase<EpiRes, pg8::StaticOrder, false, true>(lds, g, S, E); }
#endif
#ifndef NO_META
        if (l < DEPTH - 1) meta_tasks<1>(p, lds, G, Y, D, out_t, D, D / 16);
#endif
        GSYNC();
        TOC(4); TIC();
#ifndef NO_GUP
#ifndef STAGGER_UP
#define STAGGER_UP 0
#endif
        if (STAGGER_UP > 0) {
            const unsigned long long w0 = __builtin_amdgcn_s_memrealtime(), dl = (unsigned long long)(((blockIdx.x >> 3) & 3) * STAGGER_UP);
            while (__builtin_amdgcn_s_memrealtime() - w0 < dl) __builtin_amdgcn_s_sleep(4);
        }
        { pg8::Gemm g{hb, up_t, M, FF, D, 0}; pg8::StaticOrder S; S.init(M, FF, G, (int)blockIdx.x); const int pmc = rstd_cache(lds, ss, S); EpiUp E{mid, ss, (const LAS float*)(lds + 131072), pmc};
          pg8::gemm_phase<EpiUp, pg8::StaticOrder, true, true>(lds, g, S, E); }
#endif
#ifndef NO_META
        if (l < DEPTH - 1) meta_tasks<2>(p, lds, G, nullptr, 0, up_t, D, FF / 16);
#endif
        GSYNC();
        TOC(5); TIC();
#ifndef NO_GDN
        { pg8::Gemm g{mid, down_t, M, D, FF, 0}; pg8::StaticOrder S; S.init(M, D, G, (int)blockIdx.x); EpiRes E{hb, ss};
          pg8::gemm_phase<EpiRes, pg8::StaticOrder, false, true>(lds, g, S, E); }
#endif
#ifndef NO_META
        if (l < DEPTH - 1) meta_tasks<1, 16>(p, lds, G, (const bf16*)(ws + WS_MIDMETA), FF, down_t, FF, D / 16);
#endif
        GSYNC();
        TOC(6);
    }
    TIC();
    final_norm(p, G);
    TOC(7);
    if (PROBE_PHASE >= 0 && blockIdx.x == PROBE_BLOCK && threadIdx.x == 0) { const unsigned long long w0 = __builtin_amdgcn_s_memrealtime(); while (__builtin_amdgcn_s_memrealtime() - w0 < 4ull * tacc) __builtin_amdgcn_s_sleep(8); }
}

extern "C" void kernel_launch(void* const* d_in, const int* in_sizes, int n_in, void* d_out, int out_size, void* d_ws, size_t ws_size, hipStream_t stream) {
    static int grid = 0;
    if (grid == 0) {
        if (n_in != 20 || in_sizes[0] != M * D || out_size != M * D || ws_size < WS_END) { fprintf(stderr, "kernel_launch: unexpected shapes (n_in %d, in0 %d, out %d, ws %zu)\n", n_in, n_in > 0 ? in_sizes[0] : -1, out_size, ws_size); grid = -1; return; }
        int dev = 0, cus = 0, per_cu = 0;
        if (hipGetDevice(&dev) != hipSuccess || hipDeviceGetAttribute(&cus, hipDeviceAttributeMultiprocessorCount, dev) != hipSuccess) { grid = -1; return; }
        if (hipFuncSetAttribute((const void*)fwd_megakernel, hipFuncAttributeMaxDynamicSharedMemorySize, LDS_BYTES) != hipSuccess) { fprintf(stderr, "kernel_launch: hipFuncSetAttribute failed\n"); grid = -1; return; }
        if (hipOccupancyMaxActiveBlocksPerMultiprocessor(&per_cu, (const void*)fwd_megakernel, 512, LDS_BYTES) != hipSuccess || per_cu < 1) { fprintf(stderr, "kernel_launch: occupancy query gave %d\n", per_cu); (void)hipGetLastError(); grid = -1; return; }
        grid = cus * 1;
        if (grid < 256) { fprintf(stderr, "kernel_launch: %d CUs; the fused mixer phase needs 256 resident workgroups\n", cus); grid = -1; return; }
    }
    if (grid < 0) return;
    if (hipMemsetAsync((char*)d_ws + WS_CTL, 0, WS_FLAG + 256 * 4, stream) != hipSuccess) { fprintf(stderr, "kernel_launch: memset failed\n"); return; }
    Params p{};
    for (int i = 0; i < 20; ++i) p.in[i] = (const float*)d_in[i];
    p.out = (float*)d_out; p.ws = (unsigned char*)d_ws;
    void* args[] = {&p};
    hipError_t e = hipLaunchCooperativeKernel((const void*)fwd_megakernel, dim3(grid), dim3(512), args, LDS_BYTES, stream);
    if (e != hipSuccess) fprintf(stderr, "cooperative launch failed: %s (grid %d)\n", hipGetErrorString(e), grid);
}
```

```cpp
#include <hip/hip_runtime.h>
#include <hip/hip_cooperative_groups.h>
#include <cstdio>
#include <cstdint>
namespace cg = cooperative_groups;
namespace pg8 {
#define PG8_LAS __attribute__((address_space(3)))
typedef unsigned short bf16_t;
typedef short bf16x8 __attribute__((ext_vector_type(8)));
typedef float f32x4 __attribute__((ext_vector_type(4)));
typedef unsigned u32x4 __attribute__((ext_vector_type(4)));
constexpr int BM = 256, BK = 64, HALF = 128, HTB = HALF * BK * 2  , STAGE_BYTES = 8 * HTB, NXCD = 8, WGM = 8;

__host__ __device__ __forceinline__ int lds_byte(int r, int c) { const int st = (r >> 4) * 2 + (c >> 5), rr = r & 15, cc = c & 31, ob = rr * 64 + cc * 2; return st * 1024 + (ob ^ (((ob >> 9) & 1) << 5)); }
__host__ __device__ __forceinline__ void stage_rc(int b, int& R, int& C) { const int st = b / 1024, sb = b % 1024, swz = sb ^ (((sb >> 9) & 1) << 5); R = (st >> 1) * 16 + swz / 64; C = (st & 1) * 32 + (swz % 64) / 2; }
__host__ __device__ __forceinline__ int perm32(int rho) { const int n = rho >> 4, i = rho & 15; return 8 * (i >> 2) + 4 * n + (i & 3); }

struct Unit { int pm, pn; };
struct Gemm { const bf16_t* A; const bf16_t* Bt; int M, N, K, gap; };

struct StaticOrder {
    int nM, nN, nwg, G, c;
    __host__ __device__ void init(int M, int N, int G_, int c_) { nM = M / BM; nN = N / BM; nwg = nM * nN; G = G_; c = c_; }
    __host__ __device__ bool next(int i, Unit& u) const {
        const long L = (long)i * G + c; if (L >= nwg) return false;
        int wgid = (int)L; { const int q = nwg / NXCD, r = nwg % NXCD, xcd = wgid % NXCD, off = wgid / NXCD; wgid = (xcd < r ? xcd * (q + 1) : r * (q + 1) + (xcd - r) * q) + off; }
        const int nig = WGM * nN, gid = wgid / nig, fm = gid * WGM, gsz = (nM - fm) < WGM ? (nM - fm) : WGM;
        u.pm = fm + ((wgid % nig) % gsz); u.pn = (wgid % nig) / gsz; return true;
    }
    __device__ __forceinline__ void a_ready(const Unit&) const {}
    __device__ __forceinline__ void done(const Unit&) const {}
};
__device__ __forceinline__ unsigned cvt_pk_bf16(float lo, float hi) { unsigned r; asm volatile("v_cvt_pk_bf16_f32 %0, %1, %2" : "=v"(r) : "v"(lo), "v"(hi)); return r; }
template <class Epi, class Sched, bool ALIGN_EPI = false, bool SP2 = false, bool PRE_DONE = false>
__device__ __forceinline__ void gemm_phase_acc(PG8_LAS unsigned char* lds, const Gemm g, const Sched& S, const Epi& E, f32x4 (&acc)[2][2][4][2]) {
    int tid_ = threadIdx.x; asm volatile("" : "+v"(tid_));
    const int tid = tid_, wid = __builtin_amdgcn_readfirstlane(tid >> 6), lane = tid & 63, wr = wid >> 2, wc = wid & 3, fr = lane & 15, fq = lane >> 4;
    const int K = g.K, nt = K / BK;
    unsigned voffA[2], voffB[2];
#pragma unroll
    for (int i = 0; i < 2; ++i) { int R, C; stage_rc(tid * 16 + i * 8192, R, C); const int Rb = Epi::PERM ? ((R & ~31) + perm32(R & 31)) : R;
        voffA[i] = (unsigned)(R * K + C) * 2u; voffB[i] = (unsigned)(Rb * K + C) * 2u; }
    const size_t kstep = (size_t)(BK * 2);
    const size_t hstep = (size_t)HALF * K * 2;
    const size_t tstep = 2 * hstep;
    const int agap = g.gap;
#define a_off(pm_) ((size_t)((pm_) * BM + agap * (1 + ((pm_) >> 5))) * (size_t)K * 2)
    const unsigned ldsw = (unsigned)wid * 1024u;
    const int aoff = lds_byte(wr * 64 + fr, fq * 8), boff = lds_byte(wc * 32 + fr, fq * 8);
#define PG8_SA(b, h) (((b) * 2 + (h)) * HTB)
#define PG8_SB(b, h) ((4 + (b) * 2 + (h)) * HTB)
#define PG8_STAGE(bufoff, gbase, voff) do { _Pragma("unroll") for (int _i = 0; _i < 2; ++_i) \
        __builtin_amdgcn_global_load_lds((const unsigned*)((const char*)(gbase) + (voff)[_i]), (PG8_LAS unsigned*)(lds + (bufoff) + ldsw + _i * 8192), 16, 0, 0); } while (0)
#define PG8_LDA(dst, b, h) do { _Pragma("unroll") for (int m = 0; m < 4; ++m) _Pragma("unroll") for (int k = 0; k < 2; ++k) dst[m][k] = *(const PG8_LAS bf16x8*)(lds + PG8_SA(b, h) + aoff + m * 2048 + k * 1024); } while (0)
#define PG8_LDB(dst, b, h) do { _Pragma("unroll") for (int n = 0; n < 2; ++n) _Pragma("unroll") for (int k = 0; k < 2; ++k) dst[n][k] = *(const PG8_LAS bf16x8*)(lds + PG8_SB(b, h) + boff + n * 2048 + k * 1024); } while (0)
#define PG8_MMA(ai, bj, At, Bt) do { __builtin_amdgcn_s_setprio(1); _Pragma("unroll") for (int m = 0; m < 4; ++m) _Pragma("unroll") for (int n = 0; n < 2; ++n) _Pragma("unroll") for (int k = 0; k < 2; ++k) \
        acc[ai][bj][m][n] = __builtin_amdgcn_mfma_f32_16x16x32_bf16(Bt[n][k], At[m][k], acc[ai][bj][m][n], 0, 0, 0); __builtin_amdgcn_s_setprio(0); } while (0)
#define PG8_WAIT_V(n) asm volatile("s_waitcnt vmcnt(" #n ")" ::: "memory")
#define PG8_WAIT_L(n) asm volatile("s_waitcnt lgkmcnt(" #n ")" ::: "memory")
#define PG8_BAR __builtin_amdgcn_s_barrier()
#define PG8_SCHED __builtin_amdgcn_sched_barrier(0)
    Unit cur, nxt; int ui = 0;
    if (!S.next(0, cur)) return;
    if (!(PRE_DONE && wid != 0)) {
#pragma unroll
    for (int a = 0; a < 2; ++a)
#pragma unroll
        for (int b = 0; b < 2; ++b)
#pragma unroll
            for (int m = 0; m < 4; ++m)
#pragma unroll
                for (int n = 0; n < 2; ++n) acc[a][b][m][n] = (f32x4){0.f, 0.f, 0.f, 0.f};
    if constexpr (Epi::PRELOAD) E.preload(acc, cur, wr, wc, fr, fq);
    }
    bf16x8 At[4][2], B0[2][2], B1[2][2];
    const char* cA = (const char*)g.A + a_off(cur.pm); const char* cB = (const char*)g.Bt + (size_t)cur.pn * tstep;
    S.a_ready(cur);
    if constexpr (SP2) {
        PG8_STAGE(PG8_SB(0, 0), cB, voffB); PG8_STAGE(PG8_SB(0, 1), cB + hstep, voffB); PG8_STAGE(PG8_SA(0, 0), cA, voffA); PG8_STAGE(PG8_SA(0, 1), cA + hstep, voffA);
        if (wr == 1) PG8_BAR;
        PG8_WAIT_V(2); PG8_BAR;
        PG8_STAGE(PG8_SB(1, 0), cB + kstep, voffB); PG8_STAGE(PG8_SA(1, 0), cA + kstep, voffA); PG8_STAGE(PG8_SB(1, 1), cB + hstep + kstep, voffB);
        PG8_WAIT_V(6); PG8_BAR;
    } else {
        PG8_STAGE(PG8_SB(0, 0), cB, voffB); PG8_STAGE(PG8_SA(0, 0), cA, voffA); PG8_STAGE(PG8_SB(0, 1), cB + hstep, voffB); PG8_STAGE(PG8_SA(0, 1), cA + hstep, voffA);
        if (wr == 1) PG8_BAR;
        PG8_WAIT_V(4); PG8_BAR;
        PG8_STAGE(PG8_SB(1, 0), cB + kstep, voffB); PG8_STAGE(PG8_SA(1, 0), cA + kstep, voffA); PG8_STAGE(PG8_SB(1, 1), cB + hstep + kstep, voffB);
        PG8_WAIT_V(6); PG8_BAR;
    }
    for (;;) {
        const bool has_next = S.next(ui + 1, nxt);
        const char* nA = has_next ? (const char*)g.A + a_off(nxt.pm) : cA; const char* nB = has_next ? (const char*)g.Bt + (size_t)nxt.pn * tstep : cB;
        for (int t = 0; t < nt; t += 2) {
            const bool last = (t == nt - 2);
            const char* a1 = cA + (size_t)(t + 1) * kstep;
            const char* a2 = last ? nA : cA + (size_t)(t + 2) * kstep; const char* b2 = last ? nB : cB + (size_t)(t + 2) * kstep;
            const char* a3 = a2 + kstep; const char* b3 = b2 + kstep;
            if (last && has_next) S.a_ready(nxt);
            if constexpr (SP2) {
            PG8_LDB(B0, 0, 0); PG8_LDB(B1, 0, 1); PG8_SCHED; PG8_LDA(At, 0, 0); PG8_STAGE(PG8_SA(1, 1), a1 + hstep, voffA);
            PG8_WAIT_V(8); PG8_WAIT_L(0); PG8_BAR; PG8_MMA(0, 0, At, B0); PG8_MMA(0, 1, At, B1); PG8_BAR; PG8_SCHED;
            PG8_LDA(At, 0, 1); PG8_STAGE(PG8_SB(0, 0), b2, voffB); PG8_STAGE(PG8_SB(0, 1), b2 + hstep, voffB); PG8_STAGE(PG8_SA(0, 0), a2, voffA);
            PG8_WAIT_V(8); PG8_WAIT_L(0); PG8_BAR; PG8_MMA(1, 0, At, B0); PG8_MMA(1, 1, At, B1); PG8_BAR; PG8_SCHED;
            PG8_LDB(B0, 1, 0); PG8_LDB(B1, 1, 1); PG8_SCHED; PG8_LDA(At, 1, 0); PG8_STAGE(PG8_SA(0, 1), a2 + hstep, voffA);
            PG8_WAIT_V(8); PG8_WAIT_L(0); PG8_BAR; PG8_MMA(0, 0, At, B0); PG8_MMA(0, 1, At, B1); PG8_BAR; PG8_SCHED;
            PG8_LDA(At, 1, 1); PG8_STAGE(PG8_SB(1, 0), b3, voffB); PG8_STAGE(PG8_SB(1, 1), b3 + hstep, voffB); PG8_STAGE(PG8_SA(1, 0), a3, voffA);
            PG8_WAIT_V(8); PG8_WAIT_L(0); PG8_BAR; PG8_MMA(1, 0, At, B0); PG8_MMA(1, 1, At, B1); PG8_BAR; PG8_SCHED;
            } else {
            PG8_LDB(B0, 0, 0); PG8_SCHED; PG8_LDA(At, 0, 0); PG8_STAGE(PG8_SA(1, 1), a1 + hstep, voffA);
            PG8_WAIT_L(8); PG8_BAR; PG8_WAIT_L(0); PG8_MMA(0, 0, At, B0); PG8_BAR; PG8_SCHED;
            PG8_LDB(B1, 0, 1); PG8_STAGE(PG8_SB(0, 0), b2, voffB);
            PG8_BAR; PG8_WAIT_L(0); PG8_MMA(0, 1, At, B1); PG8_BAR;
            PG8_LDA(At, 0, 1); PG8_STAGE(PG8_SA(0, 0), a2, voffA);
            PG8_BAR; PG8_WAIT_L(0); PG8_MMA(1, 0, At, B0); PG8_BAR; PG8_SCHED;
            PG8_STAGE(PG8_SB(0, 1), b2 + hstep, voffB);
            PG8_WAIT_V(6); PG8_BAR; PG8_MMA(1, 1, At, B1); PG8_BAR;
            PG8_LDB(B0, 1, 0); PG8_SCHED; PG8_LDA(At, 1, 0); PG8_STAGE(PG8_SA(0, 1), a2 + hstep, voffA);
            PG8_WAIT_L(8); PG8_BAR; PG8_WAIT_L(0); PG8_MMA(0, 0, At, B0); PG8_BAR; PG8_SCHED;
            PG8_LDB(B1, 1, 1); PG8_STAGE(PG8_SB(1, 0), b3, voffB);
            PG8_BAR; PG8_WAIT_L(0); PG8_MMA(0, 1, At, B1); PG8_BAR;
            PG8_LDA(At, 1, 1); PG8_STAGE(PG8_SA(1, 0), a3, voffA);
            PG8_BAR; PG8_WAIT_L(0); PG8_MMA(1, 0, At, B0); PG8_BAR; PG8_SCHED;
            PG8_STAGE(PG8_SB(1, 1), b3 + hstep, voffB);
            PG8_WAIT_V(6); PG8_BAR; PG8_MMA(1, 1, At, B1); PG8_BAR;
            }
        }
        if constexpr (ALIGN_EPI) { if (wr == 0) PG8_BAR; }
        if constexpr (!Epi::AFTER_DRAIN) { E(acc, cur, wr, wc, fr, fq); S.done(cur); }
        if (!has_next) break;
#pragma unroll
        for (int a = 0; a < 2; ++a)
#pragma unroll
            for (int b = 0; b < 2; ++b)
#pragma unroll
                for (int m = 0; m < 4; ++m)
#pragma unroll
                    for (int n = 0; n < 2; ++n) acc[a][b][m][n] = (f32x4){0.f, 0.f, 0.f, 0.f};
        if constexpr (Epi::PRELOAD) { E.preload(acc, nxt, wr, wc, fr, fq); PG8_WAIT_V(0); }
        cur = nxt; cA = nA; cB = nB; ++ui;
        if constexpr (ALIGN_EPI) { if (wr == 1) PG8_BAR; }
    }
    PG8_WAIT_V(0);
    if constexpr (!ALIGN_EPI) { if (wr == 0) PG8_BAR; }
    PG8_BAR;
    if constexpr (Epi::AFTER_DRAIN) { E.fused(acc, cur, wr, wc, fr, fq, lds, wid, lane); S.done(cur); }
#undef PG8_SA
#undef PG8_SB
#undef PG8_STAGE
#undef PG8_LDA
#undef PG8_LDB
#undef PG8_MMA
#undef PG8_WAIT_V
#undef PG8_WAIT_L
#undef PG8_BAR
#undef PG8_SCHED
}
template <class Epi, class Sched, bool ALIGN_EPI = false, bool SP2 = false>
__device__ __forceinline__ void gemm_phase(PG8_LAS unsigned char* lds, const Gemm g, const Sched& S, const Epi& E) {
    f32x4 acc[2][2][4][2];
    gemm_phase_acc<Epi, Sched, ALIGN_EPI, SP2, false>(lds, g, S, E, acc);
}
}

#define LAS __attribute__((address_space(3)))
typedef unsigned short bf16;
typedef unsigned u32x4 __attribute__((ext_vector_type(4)));
typedef unsigned u32x2 __attribute__((ext_vector_type(2)));
typedef float f32x4 __attribute__((ext_vector_type(4)));
typedef short bf16x8 __attribute__((ext_vector_type(8)));
constexpr int D = 1024, SEQ = 8192, NB = 2, NMETA = 16, TT = SEQ + NMETA, M = NB * SEQ, DEPTH = 4, DIN = 1536, FF = 4096, DH = 512;
constexpr float EPS = 1e-6f;
constexpr size_t MiB = 1u << 20;
constexpr size_t WS_CTL = 0;
constexpr size_t WS_POOLW = 1 * MiB, WS_GR = WS_POOLW + 512 * 1024, WS_GI = WS_GR + 256 * 1024;
constexpr size_t WS_SP = 2 * MiB, WS_HMETA = WS_SP + 64 * 1024, WS_MIDMETA = WS_HMETA + 64 * 1024;
constexpr size_t WS_SS = 3 * MiB, WS_CARA = 4 * MiB, WS_CARH = WS_CARA + 512 * 1024;
constexpr size_t WS_W = 8 * MiB, W_LAYER = 21 * MiB, W_IN = 0, W_OUT = 3 * MiB, W_UP = 5 * MiB, W_DOWN = 13 * MiB;
constexpr size_t WS_HB = 92 * MiB, WS_MID = 124 * MiB;
constexpr size_t WS_PROJ = WS_MID, WS_Y = WS_MID + 48 * MiB + 256 * 1024, WS_HL = WS_Y + 32 * MiB + 256 * 1024, WS_P = WS_HL + 32 * MiB + 256 * 1024, WS_END = 256 * MiB;
static_assert(WS_PROJ + (size_t)NB * TT * DIN * 2 <= WS_Y && WS_Y + (size_t)NB * TT * D * 2 <= WS_HL && WS_HL + (size_t)NB * TT * DH * 2 <= WS_P && WS_P + (size_t)NB * TT * DH * 2 <= WS_END, "ws map");
static_assert(WS_W + DEPTH * W_LAYER <= WS_HB && WS_HB + (size_t)M * D * 2 <= WS_MID && WS_MID + (size_t)M * FF * 2 <= WS_END, "ws map 2");
constexpr int LDS_HL = 0, LDS_P = 65536, LDS_CST = 131072, LDS_CARR = 147456, LDS_RED1 = 149504, LDS_RED2 = 152064, LDS_CARRY = 154624;
constexpr int LDS_XST = 163840 - 64;
constexpr int LDS_BYTES = 163840;
constexpr size_t WS_FLAG = 64 * 1024;

struct Params {
    const float* in[20];
    float* out;
    unsigned char* ws;
};

__device__ __forceinline__ Params launder(const Params& p) {
    Params q = p;
#pragma unroll
    for (int i = 0; i < 20; ++i) { const __attribute__((address_space(1))) float* g = (const __attribute__((address_space(1))) float*)q.in[i]; asm volatile("" : "+s"(g)); q.in[i] = (const float*)g; }
    { __attribute__((address_space(1))) float* g = (__attribute__((address_space(1))) float*)q.out; asm volatile("" : "+s"(g)); q.out = (float*)g; }
    { __attribute__((address_space(1))) unsigned char* g = (__attribute__((address_space(1))) unsigned char*)q.ws; asm volatile("" : "+s"(g)); q.ws = (unsigned char*)g; }
    return q;
}
__device__ __forceinline__ unsigned cvt_pk(float lo, float hi) { return pg8::cvt_pk_bf16(lo, hi); }
__device__ __forceinline__ float bf_lo(unsigned w) { return __builtin_bit_cast(float, w << 16); }
__device__ __forceinline__ float bf_hi(unsigned w) { return __builtin_bit_cast(float, w & 0xffff0000u); }
__device__ __forceinline__ void unpack8(const u32x4 w, float (&f)[8]) {
    f[0] = bf_lo(w.x); f[1] = bf_hi(w.x); f[2] = bf_lo(w.y); f[3] = bf_hi(w.y); f[4] = bf_lo(w.z); f[5] = bf_hi(w.z); f[6] = bf_lo(w.w); f[7] = bf_hi(w.w);
}
__device__ __forceinline__ u32x4 pack8(const float (&f)[8]) { u32x4 w; w.x = cvt_pk(f[0], f[1]); w.y = cvt_pk(f[2], f[3]); w.z = cvt_pk(f[4], f[5]); w.w = cvt_pk(f[6], f[7]); return w; }
__device__ __forceinline__ float wave_sum(float v) {
#pragma unroll
    for (int o = 1; o < 64; o <<= 1) v += __shfl_xor(v, o);
    return v;
}
template <int CTRL> __device__ __forceinline__ float dppf(float old, float src) {
    return __builtin_bit_cast(float, __builtin_amdgcn_update_dpp(__builtin_bit_cast(int, old), __builtin_bit_cast(int, src), CTRL, 0xf, 0xf, false));
}
template <int DD> __device__ __forceinline__ float shiftd(float cur, float prev) {
    const float t = dppf<0x100 + (16 - DD)>(0.f, prev);
    return dppf<0x110 + DD>(t, cur);
}
__device__ __forceinline__ float sigm(float v) { return __builtin_amdgcn_rcpf(1.0f + __expf(-v)); }
__device__ __forceinline__ int outchan(int n, int rho) { return 32 * (n >> 1) + 8 * (rho >> 2) + 4 * (n & 1) + (rho & 3); }

__device__ __forceinline__ float row_rstd(const float* ss, int r) {
    const f32x4* s4 = (const f32x4*)(ss + (size_t)r * 16);
    const f32x4 a = s4[0], b = s4[1], c = s4[2], d = s4[3];
    const float s = ((a.x + a.y) + (a.z + a.w)) + ((b.x + b.y) + (b.z + b.w)) + ((c.x + c.y) + (c.z + c.w)) + ((d.x + d.y) + (d.z + d.w));
    return 1.0f / sqrtf(s * (1.0f / D) + EPS);
}
__device__ __forceinline__ void rows_rstd(const float* ss, int rowbase  , int fr, float (&rs)[2][4]) {
    const int lane = threadIdx.x & 63;
    const float r0 = row_rstd(ss, rowbase + lane), r1 = row_rstd(ss, rowbase + 128 + lane);
#pragma unroll
    for (int m = 0; m < 4; ++m) { rs[0][m] = __shfl(r0, m * 16 + fr); rs[1][m] = __shfl(r1, m * 16 + fr); }
}
struct EpiIn {
    static constexpr bool PERM = true, AFTER_DRAIN = false, PRELOAD = false;
    bf16* P; const float* ss; const LAS float* rl; int pmc;
    __device__ __forceinline__ void operator()(const f32x4 (&acc)[2][2][4][2], const pg8::Unit& u, int wr, int wc, int fr, int fq) const {
        const int row0 = u.pm * 256 + wr * 64 + fr, col0 = u.pn * 256 + wc * 32 + 8 * fq;
        float rsv[2][4];
        if (u.pm == pmc) {
#pragma unroll
            for (int ai = 0; ai < 2; ++ai)
#pragma unroll
                for (int m = 0; m < 4; ++m) rsv[ai][m] = rl[ai * 128 + wr * 64 + m * 16 + fr];
        } else {
#pragma unroll
            for (int ai = 0; ai < 2; ++ai)
#pragma unroll
                for (int m = 0; m < 4; ++m) { rsv[ai][m] = row_rstd(ss, row0 + ai * 128 + m * 16); asm volatile("" ::: "memory"); }
        }
#pragma unroll
        for (int ai = 0; ai < 2; ++ai)
#pragma unroll
            for (int m = 0; m < 4; ++m) {
                const int r = row0 + ai * 128 + m * 16; const float rs = rsv[ai][m];
                bf16* rowp = P + (size_t)(r + NMETA * (1 + (r >> 13))) * DIN + col0;
#pragma unroll
                for (int bj = 0; bj < 2; ++bj) { const f32x4 v0 = acc[ai][bj][m][0] * rs, v1 = acc[ai][bj][m][1] * rs;
                    u32x4 w; w.x = cvt_pk(v0[0], v0[1]); w.y = cvt_pk(v0[2], v0[3]); w.z = cvt_pk(v1[0], v1[1]); w.w = cvt_pk(v1[2], v1[3]);
                    *(u32x4*)(rowp + bj * 128) = w; }
            }
    }
};
struct EpiUp {
    static constexpr bool PERM = true, AFTER_DRAIN = false, PRELOAD = false;
    bf16* O; const float* ss; const LAS float* rl; int pmc;
    __device__ __forceinline__ void operator()(const f32x4 (&acc)[2][2][4][2], const pg8::Unit& u, int wr, int wc, int fr, int fq) const {
        const int row0 = u.pm * 256 + wr * 64 + fr, col0 = u.pn * 256 + wc * 32 + 8 * fq;
        float rsv[2][4];
        if (u.pm == pmc) {
#pragma unroll
            for (int ai = 0; ai < 2; ++ai)
#pragma unroll
                for (int m = 0; m < 4; ++m) rsv[ai][m] = rl[ai * 128 + wr * 64 + m * 16 + fr];
        } else {
#pragma unroll
            for (int ai = 0; ai < 2; ++ai)
#pragma unroll
                for (int m = 0; m < 4; ++m) { rsv[ai][m] = row_rstd(ss, row0 + ai * 128 + m * 16); asm volatile("" ::: "memory"); }
        }
#pragma unroll
        for (int ai = 0; ai < 2; ++ai)
#pragma unroll
            for (int m = 0; m < 4; ++m) {
                const int r = row0 + ai * 128 + m * 16; const float rs = rsv[ai][m];
                bf16* rowp = O + (size_t)r * FF + col0;
#pragma unroll
                for (int bj = 0; bj < 2; ++bj) { f32x4 v0 = acc[ai][bj][m][0] * rs, v1 = acc[ai][bj][m][1] * rs;
#pragma unroll
                    for (int j = 0; j < 4; ++j) { v0[j] = fmaxf(v0[j], 0.f); v0[j] *= v0[j]; v1[j] = fmaxf(v1[j], 0.f); v1[j] *= v1[j]; }
                    u32x4 w; w.x = cvt_pk(v0[0], v0[1]); w.y = cvt_pk(v0[2], v0[3]); w.z = cvt_pk(v1[0], v1[1]); w.w = cvt_pk(v1[2], v1[3]);
                    *(u32x4*)(rowp + bj * 128) = w; }
            }
    }
};
struct EpiRes {
    static constexpr bool PERM = true, AFTER_DRAIN = false, PRELOAD = true;
    bf16* hb; float* ssn;
    __device__ __forceinline__ void preload(f32x4 (&acc)[2][2][4][2], const pg8::Unit& u, int wr, int wc, int fr, int fq) const {
        const int row0 = u.pm * 256 + wr * 64 + fr, col0 = u.pn * 256 + wc * 32 + 8 * fq;
#pragma unroll
        for (int ai = 0; ai < 2; ++ai)
#pragma unroll
            for (int m = 0; m < 4; ++m) { const size_t off = (size_t)(row0 + ai * 128 + m * 16) * D + col0;
#pragma unroll
                for (int bj = 0; bj < 2; ++bj) { const u32x4 w = *(const u32x4*)(hb + off + bj * 128);
                    acc[ai][bj][m][0] = (f32x4){bf_lo(w.x), bf_hi(w.x), bf_lo(w.y), bf_hi(w.y)}; acc[ai][bj][m][1] = (f32x4){bf_lo(w.z), bf_hi(w.z), bf_lo(w.w), bf_hi(w.w)}; } }
    }
    __device__ __forceinline__ void operator()(const f32x4 (&acc)[2][2][4][2], const pg8::Unit& u, int wr, int wc, int fr, int fq) const {
        const int row0 = u.pm * 256 + wr * 64 + fr, col0 = u.pn * 256 + wc * 32 + 8 * fq;
#pragma unroll
        for (int ai = 0; ai < 2; ++ai)
#pragma unroll
            for (int m = 0; m < 4; ++m) {
                const int r = row0 + ai * 128 + m * 16; const size_t off = (size_t)r * D + col0; float s = 0.f;
#pragma unroll
                for (int bj = 0; bj < 2; ++bj) {
                    const f32x4 o0 = acc[ai][bj][m][0], o1 = acc[ai][bj][m][1];
                    s += (o0[0] * o0[0] + o0[1] * o0[1]) + (o0[2] * o0[2] + o0[3] * o0[3]) + (o1[0] * o1[0] + o1[1] * o1[1]) + (o1[2] * o1[2] + o1[3] * o1[3]);
                    u32x4 w; w.x = cvt_pk(o0[0], o0[1]); w.y = cvt_pk(o0[2], o0[3]); w.z = cvt_pk(o1[0], o1[1]); w.w = cvt_pk(o1[2], o1[3]);
                    *(u32x4*)(hb + off + bj * 128) = w; }
                s += __shfl_xor(s, 16); s += __shfl_xor(s, 32);
                if (fq == 0) ssn[(size_t)r * 16 + u.pn * 4 + wc] = s;
            }
    }
};

struct TItem { const float* W; const float* gk; bf16* WT; int K, N, item; };
__device__ __forceinline__ void titem_load(const TItem& t, int lane, f32x4 (&v)[8], float (&gs)[8]) {
    const int nblk = t.N / 32, kb = t.item / nblk, nb = t.item % nblk, k0 = 64 * kb, n0 = 32 * nb, lr = lane >> 3, lc = (lane & 7) * 4;
#pragma unroll
    for (int i = 0; i < 8; ++i) { v[i] = *(const f32x4*)(t.W + (size_t)(k0 + 8 * i + lr) * t.N + n0 + lc); gs[i] = t.gk ? t.gk[k0 + 8 * i + lr] : 1.0f; }
}
__device__ __forceinline__ void titem_store(const TItem& t, int lane, const f32x4 (&v)[8], const float (&gs)[8], LAS float* scr) {
    const int nblk = t.N / 32, kb = t.item / nblk, nb = t.item % nblk, k0 = 64 * kb, n0 = 32 * nb, lr = lane >> 3, lc = (lane & 7) * 4;
#pragma unroll
    for (int i = 0; i < 8; ++i) { LAS float* d = scr + (8 * i + lr) * 33 + lc; d[0] = v[i].x * gs[i]; d[1] = v[i].y * gs[i]; d[2] = v[i].z * gs[i]; d[3] = v[i].w * gs[i]; }
    asm volatile("s_waitcnt lgkmcnt(0)" ::: "memory");
    const int c = lane & 7;
#pragma unroll
    for (int j = 0; j < 4; ++j) { const int n = (lane >> 3) + 8 * j; const LAS float* s = scr + (8 * c) * 33 + n;
        u32x4 o; o.x = cvt_pk(s[0 * 33], s[1 * 33]); o.y = cvt_pk(s[2 * 33], s[3 * 33]); o.z = cvt_pk(s[4 * 33], s[5 * 33]); o.w = cvt_pk(s[6 * 33], s[7 * 33]);
        *(u32x4*)(t.WT + (size_t)(n0 + n) * t.K + k0 + 8 * c) = o; }
    asm volatile("s_waitcnt lgkmcnt(0)" ::: "memory");
}
__device__ __forceinline__ TItem titem_decode(const Params& p, int it) {
    constexpr int I_IN = 16 * 48, I_OUT = 16 * 32, I_UP = 16 * 128, I_DN = 64 * 32, I_PW = 4 * 8, I_G = 8 * 2, I_L = I_IN + I_OUT + I_UP + I_DN + I_PW + 2 * I_G;
    const int l = it / I_L; int r = it % I_L; unsigned char* ws = p.ws; unsigned char* wl = ws + WS_W + (size_t)l * W_LAYER; TItem t;
    if (r < I_IN) { t = TItem{p.in[3] + (size_t)l * D * DIN, p.in[2] + l * D, (bf16*)(wl + W_IN), D, DIN, r}; return t; } r -= I_IN;
    if (r < I_OUT) { t = TItem{p.in[15] + (size_t)l * D * D, p.in[14] + l * D, (bf16*)(wl + W_OUT), D, D, r}; return t; } r -= I_OUT;
    if (r < I_UP) { t = TItem{p.in[17] + (size_t)l * D * FF, p.in[16] + l * D, (bf16*)(wl + W_UP), D, FF, r}; return t; } r -= I_UP;
    if (r < I_DN) { t = TItem{p.in[18] + (size_t)l * FF * D, nullptr, (bf16*)(wl + W_DOWN), FF, D, r}; return t; } r -= I_DN;
    if (r < I_PW) { const int g = r / 8; t = TItem{p.in[4] + (size_t)(l * 4 + g) * 16384, nullptr, (bf16*)(ws + WS_POOLW) + (size_t)(l * 4 + g) * 16384, 128, 128, r % 8}; return t; } r -= I_PW;
    if (r < I_G) { const int h = r / 2; t = TItem{p.in[9] + (size_t)(l * 8 + h) * 4096, nullptr, (bf16*)(ws + WS_GR) + (size_t)(l * 8 + h) * 4096, 64, 64, r % 2}; return t; } r -= I_G;
    { const int h = r / 2; t = TItem{p.in[11] + (size_t)(l * 8 + h) * 4096, nullptr, (bf16*)(ws + WS_GI) + (size_t)(l * 8 + h) * 4096, 64, 64, r % 2}; }
    return t;
}
constexpr int TITEMS_PER_LAYER = 16 * 48 + 16 * 32 + 16 * 128 + 64 * 32 + 4 * 8 + 2 * 8 * 2, TITEMS_IN = 16 * 48;
__device__ __forceinline__ void convert_items(const Params& p_, LAS unsigned char* lds, int it_lo, int it_hi, int wblock, int nworkers) {
    const Params p = launder(p_);
    int tid_ = threadIdx.x; asm volatile("" : "+v"(tid_));
    const int lane = tid_ & 63, wid = __builtin_amdgcn_readfirstlane(tid_ >> 6);
    LAS float* scr = (LAS float*)(lds + wid * 16384);
    const int worker = wblock * 8 + wid;
    if (it_lo + worker < it_hi) {
        TItem cur = titem_decode(p, it_lo + worker); f32x4 v[8]; float gs[8]; titem_load(cur, lane, v, gs);
        for (int it = it_lo + worker; it < it_hi; it += nworkers) {
            const bool more = it + nworkers < it_hi; TItem nxt = cur; f32x4 nv[8]; float ngs[8];
            if (more) { nxt = titem_decode(p, it + nworkers); titem_load(nxt, lane, nv, ngs); }
            titem_store(cur, lane, v, gs, scr);
            if (more) { cur = nxt;
#pragma unroll
                for (int i = 0; i < 8; ++i) { v[i] = nv[i]; gs[i] = ngs[i]; } }
        }
    }
}
__device__ __forceinline__ void prologue(const Params& p_, LAS unsigned char* lds, int G) {
    const Params p = launder(p_);
    int tid_ = threadIdx.x; asm volatile("" : "+v"(tid_));
    const int tid = tid_, lane = tid & 63, wid = __builtin_amdgcn_readfirstlane(tid >> 6);
    const int gw = blockIdx.x * 8 + wid, NGW = G * 8;
    unsigned char* ws = p.ws;
    convert_items(p_, lds, 0, G == 256 ? TITEMS_IN : DEPTH * TITEMS_PER_LAYER, (int)blockIdx.x, NGW);
    const float* x = p.in[0]; bf16* hb = (bf16*)(ws + WS_HB); float* ss = (float*)(ws + WS_SS);
    for (int m2 = gw; m2 < M / 2; m2 += NGW) {
        f32x4 v[2][4]; float s[2] = {0.f, 0.f};
#pragma unroll
        for (int r = 0; r < 2; ++r) { const f32x4* xr = (const f32x4*)(x + (size_t)(2 * m2 + r) * D) + lane;
#pragma unroll
            for (int j = 0; j < 4; ++j) v[r][j] = xr[64 * j]; }
#pragma unroll
        for (int r = 0; r < 2; ++r) {
#pragma unroll
            for (int j = 0; j < 4; ++j) s[r] += (v[r][j].x * v[r][j].x + v[r][j].y * v[r][j].y) + (v[r][j].z * v[r][j].z + v[r][j].w * v[r][j].w);
            s[r] = wave_sum(s[r]);
            u32x2* o8 = (u32x2*)(hb + (size_t)(2 * m2 + r) * D) + lane;
#pragma unroll
            for (int j = 0; j < 4; ++j) { u32x2 w; w.x = cvt_pk(v[r][j].x, v[r][j].y); w.y = cvt_pk(v[r][j].z, v[r][j].w); o8[64 * j] = w; }
            if (lane < 16) ss[(size_t)(2 * m2 + r) * 16 + lane] = lane == 0 ? s[r] : 0.f;
        }
    }
    float* hm = (float*)(ws + WS_HMETA); float* sp = (float*)(ws + WS_SP);
    for (int i = blockIdx.x * 512 + tid; i < NMETA * D; i += G * 512) hm[i] = p.in[1][i];
    for (int i = blockIdx.x * 512 + tid; i < DEPTH * DH; i += G * 512) sp[i] = log1pf(expf(-p.in[13][i]));
}

template <int MODE, int NBATCH = 4> __device__ __forceinline__ void meta_tasks(const Params& p_, LAS unsigned char* lds, int G, const bf16* Ab, int lda, const bf16* Bt, int K, int ntasks) {
    const Params p = launder(p_);
    int tid_ = threadIdx.x; asm volatile("" : "+v"(tid_));
    const int tid = tid_, lane = tid & 63, wid = __builtin_amdgcn_readfirstlane(tid >> 6), fr = lane & 15, fq = lane >> 4;
    float* hm = (float*)(p.ws + WS_HMETA);
    LAS float* red = (LAS float*)lds;
    for (int task = G - 1 - (int)blockIdx.x; task < ntasks; task += G) {
        const int n0 = task * 16, kw = K / 8, k0 = wid * kw;
        f32x4 acc = {0.f, 0.f, 0.f, 0.f}; float ssq = 0.f;
        for (int kb = k0; kb < k0 + kw; kb += 32 * NBATCH) {
            bf16x8 af[NBATCH], bfr[NBATCH]; f32x4 a0[NBATCH], a1[NBATCH];
#pragma unroll
            for (int i = 0; i < NBATCH; ++i) { const int kk = kb + 32 * i;
                if (MODE == 1) af[i] = *(const bf16x8*)(Ab + (size_t)fr * lda + kk + 8 * fq);
                else { a0[i] = *(const f32x4*)(hm + fr * D + kk + 8 * fq); a1[i] = *(const f32x4*)(hm + fr * D + kk + 8 * fq + 4); }
                bfr[i] = *(const bf16x8*)(Bt + (size_t)(n0 + fr) * K + kk + 8 * fq); }
#pragma unroll
            for (int i = 0; i < NBATCH; ++i) {
                if (MODE != 1) { ssq += (a0[i].x * a0[i].x + a0[i].y * a0[i].y) + (a0[i].z * a0[i].z + a0[i].w * a0[i].w) + (a1[i].x * a1[i].x + a1[i].y * a1[i].y) + (a1[i].z * a1[i].z + a1[i].w * a1[i].w);
                    u32x4 w; w.x = cvt_pk(a0[i].x, a0[i].y); w.y = cvt_pk(a0[i].z, a0[i].w); w.z = cvt_pk(a1[i].x, a1[i].y); w.w = cvt_pk(a1[i].z, a1[i].w); af[i] = __builtin_bit_cast(bf16x8, w); }
                acc = __builtin_amdgcn_mfma_f32_16x16x32_bf16(bfr[i], af[i], acc, 0, 0, 0); }
        }
        ssq += __shfl_xor(ssq, 16); ssq += __shfl_xor(ssq, 32);
        LAS float* rp = red + (wid * 64 + lane) * 5;
        rp[0] = acc[0]; rp[1] = acc[1]; rp[2] = acc[2]; rp[3] = acc[3]; rp[4] = ssq;
        __syncthreads();
        if (wid == 0) {
            float a0 = 0.f, a1 = 0.f, a2 = 0.f, a3 = 0.f, sq = 0.f;
#pragma unroll
            for (int w = 0; w < 8; ++w) { const LAS float* q = red + (w * 64 + lane) * 5; a0 += q[0]; a1 += q[1]; a2 += q[2]; a3 += q[3]; sq += q[4]; }
            const int col = n0 + 4 * fq;
            if (MODE == 1) { f32x4* hp = (f32x4*)(hm + fr * D + col); f32x4 h = *hp; h.x += a0; h.y += a1; h.z += a2; h.w += a3; *hp = h; }
            else {
                const float rs = 1.0f / sqrtf(sq * (1.0f / D) + EPS); a0 *= rs; a1 *= rs; a2 *= rs; a3 *= rs;
                if (MODE == 0) { u32x2 w; w.x = cvt_pk(a0, a1); w.y = cvt_pk(a2, a3); bf16* pr = (bf16*)(p.ws + WS_PROJ);
                    *(u32x2*)(pr + (size_t)fr * DIN + col) = w; *(u32x2*)(pr + (size_t)(TT + fr) * DIN + col) = w; }
                else { a0 = fmaxf(a0, 0.f); a1 = fmaxf(a1, 0.f); a2 = fmaxf(a2, 0.f); a3 = fmaxf(a3, 0.f);
                    u32x2 w; w.x = cvt_pk(a0 * a0, a1 * a1); w.y = cvt_pk(a2 * a2, a3 * a3); *(u32x2*)((bf16*)(p.ws + WS_MIDMETA) + (size_t)fr * FF + col) = w; }
            }
        }
        __syncthreads();
    }
}

__device__ __forceinline__ void m1_phase(const Params& p_, LAS unsigned char* lds, int G, int l) {
    const Params p = launder(p_);
    int tid_ = threadIdx.x; asm volatile("" : "+v"(tid_));
    const int tid = tid_, lane = tid & 63, wid = __builtin_amdgcn_readfirstlane(tid >> 6), fr = lane & 15, fq = lane >> 4;
    LAS float* cst = (LAS float*)lds;
    for (int i = tid; i < 8 * DH; i += 512) { const int row = i >> 9, ch = i & 511; float v;
        if (row < 4) v = p.in[7][(l * 4 + row) * DH + ch]; else if (row == 4) v = p.in[8][l * DH + ch]; else if (row == 5) v = p.in[10][l * DH + ch];
        else if (row == 6) v = p.in[12][l * DH + ch]; else v = ((const float*)(p.ws + WS_SP))[l * DH + ch];
        cst[i] = v; }
    const bf16* proj = (const bf16*)(p.ws + WS_PROJ);
    const bf16* Wr = (const bf16*)(p.ws + WS_GR) + (size_t)(l * 8 + wid) * 4096; const bf16* Wi = (const bf16*)(p.ws + WS_GI) + (size_t)(l * 8 + wid) * 4096;
    LAS bf16x8* wl = (LAS bf16x8*)(lds + 16384 + wid * 16384) + lane;
#pragma unroll
    for (int n = 0; n < 4; ++n)
#pragma unroll
        for (int ks = 0; ks < 2; ++ks) {
            wl[((n * 2 + ks) * 2 + 0) * 64] = *(const bf16x8*)(Wr + outchan(n, fr) * 64 + 32 * ks + 8 * fq);
            wl[((n * 2 + ks) * 2 + 1) * 64] = *(const bf16x8*)(Wi + outchan(n, fr) * 64 + 32 * ks + 8 * fq); }
    __syncthreads();
    bf16* hl = (bf16*)(p.ws + WS_HL); bf16* Pp = (bf16*)(p.ws + WS_P);
    float* carA = (float*)(p.ws + WS_CARA); float* carH = (float*)(p.ws + WS_CARH);
    for (int unit = blockIdx.x; unit < 256; unit += G) {
        const int b = unit >> 7, c = unit & 127, t0 = c ? NMETA + 64 * c : 0, NM = c ? 4 : 5;
        float Hc[16], Pc[16];
#pragma unroll
        for (int k = 0; k < 16; ++k) { Hc[k] = 0.f; Pc[k] = 1.f; }
        u32x4 raw[2][4];
#pragma unroll
        for (int ks = 0; ks < 2; ++ks)
#pragma unroll
            for (int d = 0; d < 4; ++d) { const int tt = t0 + fr - 3 + d; raw[ks][d] = (u32x4){0u, 0u, 0u, 0u};
                if (tt >= 0) raw[ks][d] = *(const u32x4*)(proj + ((size_t)b * TT + tt) * DIN + DH + wid * 64 + 32 * ks + 8 * fq); }
#pragma unroll 1
        for (int m = 0; m < NM; ++m) {
            const int t = t0 + 16 * m + fr; const size_t rowg = (size_t)b * TT + t;
            u32x4 nraw[2][4];
#pragma unroll
            for (int ks = 0; ks < 2; ++ks)
#pragma unroll
                for (int d = 0; d < 4; ++d) { nraw[ks][d] = (u32x4){0u, 0u, 0u, 0u};
                    if (m + 1 < NM) nraw[ks][d] = *(const u32x4*)(proj + ((size_t)b * TT + t + 13 + d) * DIN + DH + wid * 64 + 32 * ks + 8 * fq); }
            float xc[2][8]; bf16x8 frag[2];
#pragma unroll
            for (int ks = 0; ks < 2; ++ks) {
                const int chb = wid * 64 + 32 * ks + 8 * fq;
                { const f32x4 c0 = *(const LAS f32x4*)(cst + 4 * DH + chb), c1 = *(const LAS f32x4*)(cst + 4 * DH + chb + 4);
                  xc[ks][0] = c0.x; xc[ks][1] = c0.y; xc[ks][2] = c0.z; xc[ks][3] = c0.w; xc[ks][4] = c1.x; xc[ks][5] = c1.y; xc[ks][6] = c1.z; xc[ks][7] = c1.w; }
#pragma unroll
                for (int d = 0; d < 4; ++d) {
                    float u[8]; unpack8(raw[ks][d], u);
                    const f32x4 w0 = *(const LAS f32x4*)(cst + d * DH + chb), w1 = *(const LAS f32x4*)(cst + d * DH + chb + 4);
                    xc[ks][0] += u[0] * w0.x; xc[ks][1] += u[1] * w0.y; xc[ks][2] += u[2] * w0.z; xc[ks][3] += u[3] * w0.w;
                    xc[ks][4] += u[4] * w1.x; xc[ks][5] += u[5] * w1.y; xc[ks][6] += u[6] * w1.z; xc[ks][7] += u[7] * w1.w;
                    raw[ks][d] = nraw[ks][d];
                }
                frag[ks] = __builtin_bit_cast(bf16x8, pack8(xc[ks]));
            }
            f32x4 ar[4], ai[4];
#pragma unroll
            for (int n = 0; n < 4; ++n) { ar[n] = (f32x4){0.f, 0.f, 0.f, 0.f}; ai[n] = (f32x4){0.f, 0.f, 0.f, 0.f};
#pragma unroll
                for (int ks = 0; ks < 2; ++ks) {
                    const bf16x8 wr_ = wl[((n * 2 + ks) * 2 + 0) * 64], wi_ = wl[((n * 2 + ks) * 2 + 1) * 64];
                    ar[n] = __builtin_amdgcn_mfma_f32_16x16x32_bf16(wr_, frag[ks], ar[n], 0, 0, 0);
                    ai[n] = __builtin_amdgcn_mfma_f32_16x16x32_bf16(wi_, frag[ks], ai[n], 0, 0, 0);
                } }
            float Aa[16], Bb[16];
#pragma unroll
            for (int n = 0; n < 4; ++n) {
                const int cho = wid * 64 + 32 * (n >> 1) + 8 * fq + 4 * (n & 1);
                const f32x4 rb = *(const LAS f32x4*)(cst + 5 * DH + cho), ib = *(const LAS f32x4*)(cst + 6 * DH + cho), spv = *(const LAS f32x4*)(cst + 7 * DH + cho);
#pragma unroll
                for (int jj = 0; jj < 4; ++jj) {
                    const float r = sigm(ar[n][jj] + rb[jj]), ig = sigm(ai[n][jj] + ib[jj]);
                    const float la = -8.0f * r * spv[jj], a = __expf(la), x2 = 2.0f * la;
                    const float m2s = -x2 * (1.0f + x2 * (0.5f + x2 * (0.16666667f + x2 * 0.041666668f))), m2 = (x2 > -0.0625f) ? m2s : 1.0f - a * a;
                    Aa[n * 4 + jj] = a; Bb[n * 4 + jj] = __builtin_amdgcn_sqrtf(m2) * ig * xc[n >> 1][4 * (n & 1) + jj];
                }
            }
#pragma unroll
            for (int k = 0; k < 16; ++k) {
                float A = Aa[k], B = Bb[k], Ap, Bq;
                Ap = dppf<0x111>(1.f, A); Bq = dppf<0x111>(0.f, B); B = fmaf(A, Bq, B); A *= Ap;
                Ap = dppf<0x112>(1.f, A); Bq = dppf<0x112>(0.f, B); B = fmaf(A, Bq, B); A *= Ap;
                Ap = dppf<0x114>(1.f, A); Bq = dppf<0x114>(0.f, B); B = fmaf(A, Bq, B); A *= Ap;
                Ap = dppf<0x118>(1.f, A); Bq = dppf<0x118>(0.f, B); B = fmaf(A, Bq, B); A *= Ap;
                Bb[k] = fmaf(A, Hc[k], B); Aa[k] = A * Pc[k];
            }
#pragma unroll
            for (int ks = 0; ks < 2; ++ks) {
                const size_t o = rowg * DH + wid * 64 + 32 * ks + 8 * fq;
                { u32x4 wh; wh.x = cvt_pk(Bb[8 * ks + 0], Bb[8 * ks + 1]); wh.y = cvt_pk(Bb[8 * ks + 2], Bb[8 * ks + 3]); wh.z = cvt_pk(Bb[8 * ks + 4], Bb[8 * ks + 5]); wh.w = cvt_pk(Bb[8 * ks + 6], Bb[8 * ks + 7]);
                  *(u32x4*)(hl + o) = wh; }
                u32x4 w; w.x = cvt_pk(Aa[8 * ks + 0], Aa[8 * ks + 1]); w.y = cvt_pk(Aa[8 * ks + 2], Aa[8 * ks + 3]); w.z = cvt_pk(Aa[8 * ks + 4], Aa[8 * ks + 5]); w.w = cvt_pk(Aa[8 * ks + 6], Aa[8 * ks + 7]);
                *(u32x4*)(Pp + o) = w;
            }
            const int src = (lane & 48) | 15;
#pragma unroll
            for (int k = 0; k < 16; ++k) { Hc[k] = __shfl(Bb[k], src); Pc[k] = __shfl(Aa[k], src); }
        }
        if (fr == 0) {
#pragma unroll
            for (int ks = 0; ks < 2; ++ks) {
                const size_t o = (size_t)(b * 128 + c) * DH + wid * 64 + 32 * ks + 8 * fq;
                *(f32x4*)(carA + o) = (f32x4){Pc[8 * ks + 0], Pc[8 * ks + 1], Pc[8 * ks + 2], Pc[8 * ks + 3]}; *(f32x4*)(carA + o + 4) = (f32x4){Pc[8 * ks + 4], Pc[8 * ks + 5], Pc[8 * ks + 6], Pc[8 * ks + 7]};
                *(f32x4*)(carH + o) = (f32x4){Hc[8 * ks + 0], Hc[8 * ks + 1], Hc[8 * ks + 2], Hc[8 * ks + 3]}; *(f32x4*)(carH + o + 4) = (f32x4){Hc[8 * ks + 4], Hc[8 * ks + 5], Hc[8 * ks + 6], Hc[8 * ks + 7]};
            }
        }
    }
    __syncthreads();
}


template <int NMR, bool FROM_LDS> __device__ __forceinline__ void m2_rnn_round(LAS unsigned char* lds, const bf16* hl, const bf16* Pp, const bf16* proj, bf16* Y, LAS float* red1, const float (&cr)[16], int b, int t0, int mbase, int wid, int fr, int fq) {
    u32x4 hw[NMR][2], pw[NMR][2], gw[NMR][2];
#pragma unroll
    for (int m = 0; m < NMR; ++m)
#pragma unroll
        for (int ks = 0; ks < 2; ++ks) { const size_t rowg = (size_t)b * TT + t0 + 16 * (mbase + m) + fr; const int ch = wid * 64 + 32 * ks + 8 * fq; const size_t o = rowg * DH + ch;
            if (FROM_LDS) { const int lane = fq * 16 + fr; hw[m][ks] = *(const LAS u32x4*)(lds + LDS_HL + wid * 8192 + (((mbase + m) * 2 + ks) * 64 + lane) * 16); pw[m][ks] = *(const LAS u32x4*)(lds + LDS_P + wid * 8192 + (((mbase + m) * 2 + ks) * 64 + lane) * 16); }
            else { hw[m][ks] = *(const u32x4*)(hl + o); pw[m][ks] = *(const u32x4*)(Pp + o); } gw[m][ks] = *(const u32x4*)(proj + rowg * DIN + 2 * DH + ch); }
    float y[NMR][16];
#pragma unroll
    for (int m = 0; m < NMR; ++m) { float s = 0.f;
#pragma unroll
        for (int ks = 0; ks < 2; ++ks) { float pf[8], gt[8]; unpack8(pw[m][ks], pf); unpack8(gw[m][ks], gt);
            float hh[8]; unpack8(hw[m][ks], hh);
#pragma unroll
            for (int e = 0; e < 8; ++e) { const float hv = fmaf(pf[e], cr[8 * ks + e], hh[e]), x = gt[e];
                const float ge = x * __builtin_amdgcn_rcpf(1.0f + __expf(-1.5957691216f * (x + 0.044715f * x * x * x)));
                const float yy = hv * ge; y[m][8 * ks + e] = yy; s = fmaf(yy, yy, s); } }
        s += __shfl_xor(s, 16); s += __shfl_xor(s, 32);
        if (fq == 0) red1[(16 * (mbase + m) + fr) * 8 + wid] = s; }
    __syncthreads();
#pragma unroll
    for (int m = 0; m < NMR; ++m) { const size_t rowg = (size_t)b * TT + t0 + 16 * (mbase + m) + fr;
        const f32x4 r0 = *(const LAS f32x4*)(red1 + (16 * (mbase + m) + fr) * 8), r1 = *(const LAS f32x4*)(red1 + (16 * (mbase + m) + fr) * 8 + 4);
        const float rs = __builtin_amdgcn_rsqf((((r0.x + r0.y) + (r0.z + r0.w)) + ((r1.x + r1.y) + (r1.z + r1.w))) * (1.0f / DH) + EPS);
#pragma unroll
        for (int ks = 0; ks < 2; ++ks) { float yy[8];
#pragma unroll
            for (int e = 0; e < 8; ++e) yy[e] = y[m][8 * ks + e] * rs;
            *(u32x4*)(Y + rowg * D + DH + wid * 64 + 32 * ks + 8 * fq) = pack8(yy); } }
}


template <int NMR> __device__ __forceinline__ void m2_pool_round(const bf16* proj, bf16* Y, const bf16* Wp, const float* pbias, const float* pscale, LAS float* red2,
                                                                  int b, int t0, int mbase, int g, int half, int kwin, int wid, int fr, int fq) {
    const int tb = t0 + 16 * mbase;
    bf16x8 pfr[NMR][4];
#pragma unroll
    for (int ks = 0; ks < 4; ++ks) {
        const int chb = g * 128 + 32 * ks + 8 * fq;
        float pu[8], p2[8], p4[8], p8[8];
        if (tb) { const u32x4 raw = *(const u32x4*)(proj + ((size_t)b * TT + tb - 16 + fr) * DIN + chb); unpack8(raw, pu);
#pragma unroll
            for (int e = 0; e < 8; ++e) { p2[e] = pu[e] + dppf<0x111>(0.f, pu[e]); p4[e] = p2[e] + dppf<0x112>(0.f, p2[e]); p8[e] = p4[e] + dppf<0x114>(0.f, p4[e]); } }
        else {
#pragma unroll
            for (int e = 0; e < 8; ++e) { pu[e] = 0.f; p2[e] = 0.f; p4[e] = 0.f; p8[e] = 0.f; } }
#pragma unroll
        for (int m = 0; m < NMR; ++m) {
            const int t = tb + 16 * m + fr; const size_t rowg = (size_t)b * TT + t;
            const u32x4 raw = *(const u32x4*)(proj + rowg * DIN + chb); float u[8], po[8]; unpack8(raw, u);
            const int cnt = (t + 1 < kwin) ? t + 1 : kwin; const float rc = __builtin_amdgcn_rcpf((float)cnt);
#pragma unroll
            for (int e = 0; e < 8; ++e) {
                const float s2 = u[e] + shiftd<1>(u[e], pu[e]), s4 = s2 + shiftd<2>(s2, p2[e]), s8 = s4 + shiftd<4>(s4, p4[e]), s16 = s8 + shiftd<8>(s8, p8[e]);
                const float win = g == 0 ? s2 : (g == 1 ? s4 : (g == 2 ? s8 : s16));
                po[e] = fmaf(win, rc, -u[e]); pu[e] = u[e]; p2[e] = s2; p4[e] = s4; p8[e] = s8;
            }
            pfr[m][ks] = __builtin_bit_cast(bf16x8, pack8(po));
        }
    }
    bf16x8 wfr[4][4];
#pragma unroll
    for (int n = 0; n < 4; ++n)
#pragma unroll
        for (int ks = 0; ks < 4; ++ks) wfr[n][ks] = *(const bf16x8*)(Wp + (size_t)(64 * half + outchan(n, fr)) * 128 + 32 * ks + 8 * fq);
#pragma unroll 1
    for (int pass = 0; pass < 2; ++pass) {
#pragma unroll
        for (int m = 0; m < NMR; ++m) {
            const int t = tb + 16 * m + fr; const size_t rowg = (size_t)b * TT + t; float s = 0.f, rs = 0.f;
            if (pass) { const f32x4 r0 = *(const LAS f32x4*)(red2 + (16 * (mbase + m) + fr) * 8), r1 = *(const LAS f32x4*)(red2 + (16 * (mbase + m) + fr) * 8 + 4);
                rs = __builtin_amdgcn_rsqf((((r0.x + r0.y) + (r0.z + r0.w)) + ((r1.x + r1.y) + (r1.z + r1.w))) * (1.0f / DH) + EPS); }
#pragma unroll
            for (int np = 0; np < 2; ++np) {
                f32x4 o2[2];
#pragma unroll
                for (int nn = 0; nn < 2; ++nn) { const int n = 2 * np + nn;
                    f32x4 acc = {0.f, 0.f, 0.f, 0.f};
#pragma unroll
                    for (int ks = 0; ks < 4; ++ks) acc = __builtin_amdgcn_mfma_f32_16x16x32_bf16(wfr[n][ks], pfr[m][ks], acc, 0, 0, 0);
                    const int col = g * 128 + 64 * half + 32 * np + 8 * fq + 4 * nn;
                    const f32x4 pb = *(const f32x4*)(pbias + col), ps = *(const f32x4*)(pscale + col);
                    acc = (acc + pb) * ps; s += (acc.x * acc.x + acc.y * acc.y) + (acc.z * acc.z + acc.w * acc.w); o2[nn] = acc * rs; }
                if (pass) { u32x4 w; w.x = cvt_pk(o2[0].x, o2[0].y); w.y = cvt_pk(o2[0].z, o2[0].w); w.z = cvt_pk(o2[1].x, o2[1].y); w.w = cvt_pk(o2[1].z, o2[1].w);
                    *(u32x4*)(Y + rowg * D + g * 128 + 64 * half + 32 * np + 8 * fq) = w; }
            }
            if (!pass) { s += __shfl_xor(s, 16); s += __shfl_xor(s, 32); if (fq == 0) red2[(16 * (mbase + m) + fr) * 8 + wid] = s; }
        }
        if (!pass) __syncthreads();
    }
}

__device__ __forceinline__ void m2_phase(const Params& p_, LAS unsigned char* lds, int G, int l) {
    const Params p = launder(p_);
    int tid_ = threadIdx.x; asm volatile("" : "+v"(tid_));
    const int tid = tid_, lane = tid & 63, wid = __builtin_amdgcn_readfirstlane(tid >> 6), fr = lane & 15, fq = lane >> 4;
    LAS float* segA = (LAS float*)lds; LAS float* segH = (LAS float*)(lds + 16384); LAS float* carr = (LAS float*)(lds + 32768);
    LAS float* red1 = (LAS float*)(lds + 34816); LAS float* red2 = (LAS float*)(lds + 37888);
    const bf16* proj = (const bf16*)(p.ws + WS_PROJ); bf16* Y = (bf16*)(p.ws + WS_Y);
    const bf16* hl = (const bf16*)(p.ws + WS_HL); const bf16* Pp = (const bf16*)(p.ws + WS_P);
    const float* carA = (const float*)(p.ws + WS_CARA); const float* carH = (const float*)(p.ws + WS_CARH);
    const int g = wid >> 1, half = wid & 1, kwin = 2 << g;
    const bf16* Wp = (const bf16*)(p.ws + WS_POOLW) + (size_t)(l * 4 + g) * 16384;
    const float* pbias = p.in[5] + l * DH; const float* pscale = p.in[6] + l * DH;
    for (int unit = blockIdx.x; unit < 256; unit += G) {
        const int b = unit >> 7, c = unit & 127, t0 = c ? NMETA + 64 * c : 0, NM = c ? 4 : 5;
        {
            const int q = (c + 7) >> 3, jlo = wid * q, jhi = (jlo + q < c) ? jlo + q : c;
            f32x4 A0 = {1.f, 1.f, 1.f, 1.f}, A1 = A0, H0 = {0.f, 0.f, 0.f, 0.f}, H1 = H0;
            for (int j = jlo; j < jhi; j += 8) {
                f32x4 a0[8], a1[8], h0[8], h1[8];
#pragma unroll
                for (int i = 0; i < 8; ++i) { const int jj = (j + i < jhi) ? j + i : jhi - 1; const size_t o = (size_t)(b * 128 + jj) * DH + 8 * lane;
                    a0[i] = *(const f32x4*)(carA + o); a1[i] = *(const f32x4*)(carA + o + 4); h0[i] = *(const f32x4*)(carH + o); h1[i] = *(const f32x4*)(carH + o + 4); }
#pragma unroll
                for (int i = 0; i < 8; ++i) if (j + i < jhi) { H0 = a0[i] * H0 + h0[i]; A0 = A0 * a0[i]; H1 = a1[i] * H1 + h1[i]; A1 = A1 * a1[i]; }
            }
            *(LAS f32x4*)(segA + wid * DH + 8 * lane) = A0; *(LAS f32x4*)(segA + wid * DH + 8 * lane + 4) = A1;
            *(LAS f32x4*)(segH + wid * DH + 8 * lane) = H0; *(LAS f32x4*)(segH + wid * DH + 8 * lane + 4) = H1;
        }
        __syncthreads();
        { float cy = 0.f;
#pragma unroll
          for (int s8 = 0; s8 < 8; ++s8) cy = segA[s8 * DH + tid] * cy + segH[s8 * DH + tid];
          carr[tid] = cy; }
        __syncthreads();
        {
            float cr[16];
#pragma unroll
            for (int ks = 0; ks < 2; ++ks) { const f32x4 c0 = *(const LAS f32x4*)(carr + wid * 64 + 32 * ks + 8 * fq), c1 = *(const LAS f32x4*)(carr + wid * 64 + 32 * ks + 8 * fq + 4);
                cr[8 * ks + 0] = c0.x; cr[8 * ks + 1] = c0.y; cr[8 * ks + 2] = c0.z; cr[8 * ks + 3] = c0.w; cr[8 * ks + 4] = c1.x; cr[8 * ks + 5] = c1.y; cr[8 * ks + 6] = c1.z; cr[8 * ks + 7] = c1.w; }
            m2_rnn_round<4, false>(lds, hl, Pp, proj, Y, red1, cr, b, t0, 0, wid, fr, fq);
            if (NM == 5) m2_rnn_round<1, false>(lds, hl, Pp, proj, Y, red1, cr, b, t0, 4, wid, fr, fq);
        }
        m2_pool_round<4>(proj, Y, Wp, pbias, pscale, red2, b, t0, 0, g, half, kwin, wid, fr, fq);
        if (NM == 5) m2_pool_round<1>(proj, Y, Wp, pbias, pscale, red2, b, t0, 4, g, half, kwin, wid, fr, fq);
    }
    __syncthreads();
}

__device__ __forceinline__ void final_norm(const Params& p_, int G) {
    const Params p = launder(p_);
    int tid_ = threadIdx.x; asm volatile("" : "+v"(tid_));
    const int tid = tid_, lane = tid & 63, wid = tid >> 6; const int gw = blockIdx.x * 8 + wid, NGW = G * 8;
    const bf16* hb = (const bf16*)(p.ws + WS_HB);
    const f32x4* gp = (const f32x4*)p.in[19] + 2 * lane; f32x4 gg[2][2];
#pragma unroll
    for (int j = 0; j < 2; ++j) { gg[j][0] = gp[128 * j]; gg[j][1] = gp[128 * j + 1]; }
    for (int m = gw; m < M; m += NGW) {
        const u32x4* xr = (const u32x4*)(hb + (size_t)m * D) + lane; float v[2][8]; float s = 0.f;
#pragma unroll
        for (int j = 0; j < 2; ++j) { unpack8(xr[64 * j], v[j]);
#pragma unroll
            for (int e = 0; e < 8; ++e) s = fmaf(v[j][e], v[j][e], s); }
        const float rs = 1.0f / sqrtf(wave_sum(s) * (1.0f / D) + EPS);
        f32x4* orow = (f32x4*)(p.out + (size_t)m * D) + 2 * lane;
#pragma unroll
        for (int j = 0; j < 2; ++j) {
            orow[128 * j] = (f32x4){v[j][0] * rs * gg[j][0].x, v[j][1] * rs * gg[j][0].y, v[j][2] * rs * gg[j][0].z, v[j][3] * rs * gg[j][0].w};
            orow[128 * j + 1] = (f32x4){v[j][4] * rs * gg[j][1].x, v[j][5] * rs * gg[j][1].y, v[j][6] * rs * gg[j][1].z, v[j][7] * rs * gg[j][1].w}; }
    }
}


template <int KW> __device__ __forceinline__ float pool_win(float P, float Sp) {
    float w = P;
    if (KW < 16) w -= dppf<0x110 + (KW & 15)>(0.f, P);
    return w + dppf<0x100 + (17 - KW)>(0.f, Sp);
}
template <int KW, int MAXG> __device__ __forceinline__ void pool_frags(const bf16* proj, bf16x8 (&pfr)[MAXG][4], int b, int tb, int cnt, int g, int fr, int fq) {
#pragma unroll
    for (int ks = 0; ks < 4; ++ks) {
        const int chb = g * 128 + 32 * ks + 8 * fq;
        float Sp[8];
        if (tb) { const u32x4 raw = *(const u32x4*)(proj + ((size_t)b * TT + tb - 16 + fr) * DIN + chb); unpack8(raw, Sp);
#pragma unroll
            for (int e = 0; e < 8; ++e) { Sp[e] += dppf<0x101>(0.f, Sp[e]); Sp[e] += dppf<0x102>(0.f, Sp[e]); Sp[e] += dppf<0x104>(0.f, Sp[e]); Sp[e] += dppf<0x108>(0.f, Sp[e]); } }
        else {
#pragma unroll
            for (int e = 0; e < 8; ++e) Sp[e] = 0.f; }
#pragma unroll
        for (int mi = 0; mi < MAXG; ++mi) if (mi < cnt) {
            const int t = tb + 16 * mi + fr;
            const u32x4 raw = *(const u32x4*)(proj + ((size_t)b * TT + t) * DIN + chb); float u[8], po[8]; unpack8(raw, u);
            const int cn = (t + 1 < KW) ? t + 1 : KW; const float rc = __builtin_amdgcn_rcpf((float)cn);
#pragma unroll
            for (int e = 0; e < 8; ++e) {
                float P = u[e]; P += dppf<0x111>(0.f, P); P += dppf<0x112>(0.f, P); P += dppf<0x114>(0.f, P); P += dppf<0x118>(0.f, P);
                float S = u[e]; S += dppf<0x101>(0.f, S); S += dppf<0x102>(0.f, S); S += dppf<0x104>(0.f, S); S += dppf<0x108>(0.f, S);
                po[e] = fmaf(pool_win<KW>(P, Sp[e]), rc, -u[e]); Sp[e] = S;
            }
            pfr[mi][ks] = __builtin_bit_cast(bf16x8, pack8(po));
        }
    }
}
__device__ __forceinline__ void m2_pool2(const bf16* proj, bf16* Y, const bf16* Wp, const float* pbias, const float* pscale, LAS float* red2, int b, int t0, int NM, int g, int th, int fr, int fq) {
    const int m0 = th ? (NM == 5 ? 3 : 2) : 0, cnt = th ? 2 : (NM == 5 ? 3 : 2), tb = t0 + 16 * m0;
    bf16x8 pfr[3][4];
    switch (g) {
        case 0: pool_frags<2, 3>(proj, pfr, b, tb, cnt, g, fr, fq); break;
        case 1: pool_frags<4, 3>(proj, pfr, b, tb, cnt, g, fr, fq); break;
        case 2: pool_frags<8, 3>(proj, pfr, b, tb, cnt, g, fr, fq); break;
        default: pool_frags<16, 3>(proj, pfr, b, tb, cnt, g, fr, fq); break;
    }
    f32x4 ov[3][8]; float sq[3] = {0.f, 0.f, 0.f};
#pragma unroll
    for (int n = 0; n < 8; ++n) {
        bf16x8 wf[4];
#pragma unroll
        for (int ks = 0; ks < 4; ++ks) wf[ks] = *(const bf16x8*)(Wp + (size_t)outchan(n, fr) * 128 + 32 * ks + 8 * fq);
        const int col = g * 128 + 32 * (n >> 1) + 8 * fq + 4 * (n & 1);
        const f32x4 pb = *(const f32x4*)(pbias + col), ps = *(const f32x4*)(pscale + col);
#pragma unroll
        for (int mi = 0; mi < 3; ++mi) if (mi < cnt) {
            f32x4 acc = {0.f, 0.f, 0.f, 0.f};
#pragma unroll
            for (int ks = 0; ks < 4; ++ks) acc = __builtin_amdgcn_mfma_f32_16x16x32_bf16(wf[ks], pfr[mi][ks], acc, 0, 0, 0);
            acc = (acc + pb) * ps; ov[mi][n] = acc; sq[mi] += (acc.x * acc.x + acc.y * acc.y) + (acc.z * acc.z + acc.w * acc.w);
        }
    }
#pragma unroll
    for (int mi = 0; mi < 3; ++mi) if (mi < cnt) { float s = sq[mi]; s += __shfl_xor(s, 16); s += __shfl_xor(s, 32); if (fq == 0) red2[(16 * (m0 + mi) + fr) * 4 + g] = s; }
    __syncthreads();
#pragma unroll
    for (int mi = 0; mi < 3; ++mi) if (mi < cnt) {
        const size_t rowg = (size_t)b * TT + tb + 16 * mi + fr;
        const f32x4 r0 = *(const LAS f32x4*)(red2 + (16 * (m0 + mi) + fr) * 4);
        const float rs = __builtin_amdgcn_rsqf(((r0.x + r0.y) + (r0.z + r0.w)) * (1.0f / DH) + EPS);
#pragma unroll
        for (int np = 0; np < 4; ++np) {
            const f32x4 a = ov[mi][2 * np] * rs, bq = ov[mi][2 * np + 1] * rs;
            u32x4 w; w.x = cvt_pk(a.x, a.y); w.y = cvt_pk(a.z, a.w); w.z = cvt_pk(bq.x, bq.y); w.w = cvt_pk(bq.z, bq.w);
            *(u32x4*)(Y + rowg * D + g * 128 + 32 * np + 8 * fq) = w;
        }
    }
}

#ifndef PROBE_PHASE
#define PROBE_PHASE (-1)
#endif
#ifndef PROBE_BLOCK
#define PROBE_BLOCK 0
#endif
#define TIC() do { if (PROBE_PHASE >= 0) tic = __builtin_amdgcn_s_memrealtime(); } while (0)
#define TOC(k) do { if (PROBE_PHASE == (k)) tacc += __builtin_amdgcn_s_memrealtime() - tic; } while (0)

__device__ __forceinline__ void mixer_phase(const Params& p_, LAS unsigned char* lds, int G, int l, unsigned long long& tic, unsigned long long& tacc) {
    const Params p = launder(p_);
    int tid_ = threadIdx.x; asm volatile("" : "+v"(tid_));
    const int tid = tid_, lane = tid & 63, wid = __builtin_amdgcn_readfirstlane(tid >> 6), fr = lane & 15, fq = lane >> 4;
    LAS float* cst = (LAS float*)(lds + LDS_CST);
    const bf16* proj = (const bf16*)(p.ws + WS_PROJ);
    const bf16* Wr = (const bf16*)(p.ws + WS_GR) + (size_t)(l * 8 + wid) * 4096; const bf16* Wi = (const bf16*)(p.ws + WS_GI) + (size_t)(l * 8 + wid) * 4096;
    LAS float* segA = (LAS float*)(lds + LDS_CST); LAS float* segH = (LAS float*)(lds + LDS_CST + 8192); LAS float* carr = (LAS float*)(lds + LDS_CARR);
    LAS float* red1 = (LAS float*)(lds + LDS_RED1); LAS float* red2 = (LAS float*)(lds + LDS_RED2);
    bf16* Y = (bf16*)(p.ws + WS_Y);
    const int g = wid >> 1, half = wid & 1, kwin = 2 << g;
    const bf16* Wp = (const bf16*)(p.ws + WS_POOLW) + (size_t)(l * 4 + g) * 16384;
    const float* pbias = p.in[5] + l * DH; const float* pscale = p.in[6] + l * DH;
    unsigned* flags = (unsigned*)(p.ws + WS_FLAG); unsigned* car = (unsigned*)(p.ws + WS_CARA);
    bf16* hl = (bf16*)(p.ws + WS_HL); bf16* Pp = (bf16*)(p.ws + WS_P);
    float* carA = (float*)(p.ws + WS_CARA); float* carH = (float*)(p.ws + WS_CARH);
    const int unit = blockIdx.x;
    if (unit < 256) {
        const int b = unit >> 7, c = unit & 127, t0 = c ? NMETA + 64 * c : 0, NM = c ? 4 : 5;
        TIC();
        float cv[8];
#pragma unroll
        for (int k4 = 0; k4 < 4; ++k4) cv[k4] = p.in[7][(l * 4 + k4) * DH + tid];
        cv[4] = p.in[8][l * DH + tid]; cv[5] = p.in[10][l * DH + tid]; cv[6] = p.in[12][l * DH + tid]; cv[7] = ((const float*)(p.ws + WS_SP))[l * DH + tid];
        bf16x8 wfr[4][2][2];
#pragma unroll
        for (int n = 0; n < 4; ++n)
#pragma unroll
            for (int ks = 0; ks < 2; ++ks) { wfr[n][ks][0] = *(const bf16x8*)(Wr + outchan(n, fr) * 64 + 32 * ks + 8 * fq); wfr[n][ks][1] = *(const bf16x8*)(Wi + outchan(n, fr) * 64 + 32 * ks + 8 * fq); }
        LAS float* cslot = (LAS float*)(lds + LDS_CARRY) + (wid * 4 + fq) * 32;
        if (fr == 15) {
#pragma unroll
            for (int k4 = 0; k4 < 4; ++k4) { *(LAS f32x4*)(cslot + 4 * k4) = (f32x4){0.f, 0.f, 0.f, 0.f}; *(LAS f32x4*)(cslot + 16 + 4 * k4) = (f32x4){1.f, 1.f, 1.f, 1.f}; } }
        u32x4 raw[2][4];
#pragma unroll
        for (int ks = 0; ks < 2; ++ks)
#pragma unroll
            for (int d = 0; d < 4; ++d) { const int tt = t0 + fr - 3 + d; raw[ks][d] = (u32x4){0u, 0u, 0u, 0u};
                if (tt >= 0) raw[ks][d] = *(const u32x4*)(proj + ((size_t)b * TT + tt) * DIN + DH + wid * 64 + 32 * ks + 8 * fq); }
        __syncthreads();
#pragma unroll
        for (int k8 = 0; k8 < 8; ++k8) cst[k8 * DH + tid] = cv[k8];
        __syncthreads();
        TOC(10); TIC();
#pragma unroll 1
        for (int m = 0; m < NM; ++m) {
            const int t = t0 + 16 * m + fr; const size_t rowg = (size_t)b * TT + t;
            u32x4 nraw[2][4];
#pragma unroll
            for (int ks = 0; ks < 2; ++ks)
#pragma unroll
                for (int d = 0; d < 4; ++d) { nraw[ks][d] = (u32x4){0u, 0u, 0u, 0u};
                    if (m + 1 < NM) nraw[ks][d] = *(const u32x4*)(proj + ((size_t)b * TT + t + 13 + d) * DIN + DH + wid * 64 + 32 * ks + 8 * fq); }
            float xc[2][8]; bf16x8 frag[2];
#pragma unroll
            for (int ks = 0; ks < 2; ++ks) {
                const int chb = wid * 64 + 32 * ks + 8 * fq;
                { const f32x4 c0 = *(const LAS f32x4*)(cst + 4 * DH + chb), c1 = *(const LAS f32x4*)(cst + 4 * DH + chb + 4);
                  xc[ks][0] = c0.x; xc[ks][1] = c0.y; xc[ks][2] = c0.z; xc[ks][3] = c0.w; xc[ks][4] = c1.x; xc[ks][5] = c1.y; xc[ks][6] = c1.z; xc[ks][7] = c1.w; }
#pragma unroll
                for (int d = 0; d < 4; ++d) {
                    float u[8]; unpack8(raw[ks][d], u);
                    const f32x4 w0 = *(const LAS f32x4*)(cst + d * DH + chb), w1 = *(const LAS f32x4*)(cst + d * DH + chb + 4);
                    xc[ks][0] += u[0] * w0.x; xc[ks][1] += u[1] * w0.y; xc[ks][2] += u[2] * w0.z; xc[ks][3] += u[3] * w0.w;
                    xc[ks][4] += u[4] * w1.x; xc[ks][5] += u[5] * w1.y; xc[ks][6] += u[6] * w1.z; xc[ks][7] += u[7] * w1.w;
                    raw[ks][d] = nraw[ks][d];
                }
                frag[ks] = __builtin_bit_cast(bf16x8, pack8(xc[ks]));
            }
            f32x4 ar[4], ai[4];
#pragma unroll
            for (int n = 0; n < 4; ++n) { ar[n] = (f32x4){0.f, 0.f, 0.f, 0.f}; ai[n] = (f32x4){0.f, 0.f, 0.f, 0.f};
#pragma unroll
                for (int ks = 0; ks < 2; ++ks) {
                    const bf16x8 wr_ = wfr[n][ks][0], wi_ = wfr[n][ks][1];
                    ar[n] = __builtin_amdgcn_mfma_f32_16x16x32_bf16(wr_, frag[ks], ar[n], 0, 0, 0);
                    ai[n] = __builtin_amdgcn_mfma_f32_16x16x32_bf16(wi_, frag[ks], ai[n], 0, 0, 0);
                } }
            float Aa[16], Bb[16];
#pragma unroll
            for (int n = 0; n < 4; ++n) {
                const int cho = wid * 64 + 32 * (n >> 1) + 8 * fq + 4 * (n & 1);
                const f32x4 rb = *(const LAS f32x4*)(cst + 5 * DH + cho), ib = *(const LAS f32x4*)(cst + 6 * DH + cho), spv = *(const LAS f32x4*)(cst + 7 * DH + cho);
#pragma unroll
                for (int jj = 0; jj < 4; ++jj) {
                    const float r = sigm(ar[n][jj] + rb[jj]), ig = sigm(ai[n][jj] + ib[jj]);
                    const float la = -8.0f * r * spv[jj], a = __expf(la), x2 = 2.0f * la;
                    const float m2s = -x2 * (1.0f + x2 * (0.5f + x2 * (0.16666667f + x2 * 0.041666668f))), m2 = (x2 > -0.0625f) ? m2s : 1.0f - a * a;
                    Aa[n * 4 + jj] = a; Bb[n * 4 + jj] = __builtin_amdgcn_sqrtf(m2) * ig * xc[n >> 1][4 * (n & 1) + jj];
                }
            }
#pragma unroll
            for (int k = 0; k < 16; ++k) {
                float A = Aa[k], B = Bb[k], Ap, Bq;
                Ap = dppf<0x111>(1.f, A); Bq = dppf<0x111>(0.f, B); B = fmaf(A, Bq, B); A *= Ap;
                Ap = dppf<0x112>(1.f, A); Bq = dppf<0x112>(0.f, B); B = fmaf(A, Bq, B); A *= Ap;
                Ap = dppf<0x114>(1.f, A); Bq = dppf<0x114>(0.f, B); B = fmaf(A, Bq, B); A *= Ap;
                Ap = dppf<0x118>(1.f, A); Bq = dppf<0x118>(0.f, B); B = fmaf(A, Bq, B); A *= Ap;
                Bb[k] = B; Aa[k] = A;
            }
            {
                float Hc[16], Pc[16];
#pragma unroll
                for (int k4 = 0; k4 < 4; ++k4) { const f32x4 hq = *(const LAS f32x4*)(cslot + 4 * k4), pq = *(const LAS f32x4*)(cslot + 16 + 4 * k4);
                    Hc[4 * k4] = hq.x; Hc[4 * k4 + 1] = hq.y; Hc[4 * k4 + 2] = hq.z; Hc[4 * k4 + 3] = hq.w; Pc[4 * k4] = pq.x; Pc[4 * k4 + 1] = pq.y; Pc[4 * k4 + 2] = pq.z; Pc[4 * k4 + 3] = pq.w; }
#pragma unroll
                for (int k = 0; k < 16; ++k) { Bb[k] = fmaf(Aa[k], Hc[k], Bb[k]); Aa[k] *= Pc[k]; }
                if (fr == 15) {
#pragma unroll
                    for (int k4 = 0; k4 < 4; ++k4) { *(LAS f32x4*)(cslot + 4 * k4) = (f32x4){Bb[4 * k4], Bb[4 * k4 + 1], Bb[4 * k4 + 2], Bb[4 * k4 + 3]}; *(LAS f32x4*)(cslot + 16 + 4 * k4) = (f32x4){Aa[4 * k4], Aa[4 * k4 + 1], Aa[4 * k4 + 2], Aa[4 * k4 + 3]}; } }
            }
#pragma unroll
            for (int ks = 0; ks < 2; ++ks) {
                const size_t o = rowg * DH + wid * 64 + 32 * ks + 8 * fq;
                u32x4 wh; wh.x = cvt_pk(Bb[8 * ks + 0], Bb[8 * ks + 1]); wh.y = cvt_pk(Bb[8 * ks + 2], Bb[8 * ks + 3]); wh.z = cvt_pk(Bb[8 * ks + 4], Bb[8 * ks + 5]); wh.w = cvt_pk(Bb[8 * ks + 6], Bb[8 * ks + 7]);
                u32x4 w; w.x = cvt_pk(Aa[8 * ks + 0], Aa[8 * ks + 1]); w.y = cvt_pk(Aa[8 * ks + 2], Aa[8 * ks + 3]); w.z = cvt_pk(Aa[8 * ks + 4], Aa[8 * ks + 5]); w.w = cvt_pk(Aa[8 * ks + 6], Aa[8 * ks + 7]);
                if (m < 4) { *(LAS u32x4*)(lds + LDS_HL + wid * 8192 + ((m * 2 + ks) * 64 + lane) * 16) = wh; *(LAS u32x4*)(lds + LDS_P + wid * 8192 + ((m * 2 + ks) * 64 + lane) * 16) = w; }
                else { *(u32x4*)(hl + o) = wh; *(u32x4*)(Pp + o) = w; }
            }
        }
        TOC(11); TIC();
        if (fr == 0) {
            float Hc[16], Pc[16];
#pragma unroll
            for (int k4 = 0; k4 < 4; ++k4) { const f32x4 hq = *(const LAS f32x4*)(cslot + 4 * k4), pq = *(const LAS f32x4*)(cslot + 16 + 4 * k4);
                Hc[4 * k4] = hq.x; Hc[4 * k4 + 1] = hq.y; Hc[4 * k4 + 2] = hq.z; Hc[4 * k4 + 3] = hq.w; Pc[4 * k4] = pq.x; Pc[4 * k4 + 1] = pq.y; Pc[4 * k4 + 2] = pq.z; Pc[4 * k4 + 3] = pq.w; }
#pragma unroll
            for (int ks = 0; ks < 2; ++ks) {
                const size_t o = (size_t)(b * 128 + c) * DH + wid * 64 + 32 * ks + 8 * fq;
#pragma unroll
                for (int e2 = 0; e2 < 4; ++e2) {
                    const unsigned lo = cvt_pk(Pc[8 * ks + 2 * e2], Hc[8 * ks + 2 * e2]), hi = cvt_pk(Pc[8 * ks + 2 * e2 + 1], Hc[8 * ks + 2 * e2 + 1]);
                    __hip_atomic_store((unsigned long long*)(car + o) + e2, ((unsigned long long)hi << 32) | lo, __ATOMIC_RELAXED, __HIP_MEMORY_SCOPE_AGENT); }
            }
        }
        int fr2 = fr, fq2 = fq, tid2 = tid; asm volatile("" : "+v"(fr2), "+v"(fq2), "+v"(tid2));
        TOC(12); TIC();
#ifndef NO_MX_POOL
        m2_pool2(proj, Y, Wp, pbias, pscale, red2, b, t0, NM, g, half, fr2, fq2);
#endif
        asm volatile("s_waitcnt vmcnt(0)" ::: "memory");
        __syncthreads();
        if (tid2 == 0) __hip_atomic_store(flags + unit, (unsigned)(l + 1), __ATOMIC_RELAXED, __HIP_MEMORY_SCOPE_AGENT);
        TOC(13); TIC();
        if (tid2 < c) { unsigned sp = 0; while (__hip_atomic_load(flags + b * 128 + tid2, __ATOMIC_RELAXED, __HIP_MEMORY_SCOPE_AGENT) < (unsigned)(l + 1)) { __builtin_amdgcn_s_sleep(2); if (++sp > (1u << 22)) break; } }
#if defined(MIXER_ACQ_FENCE)
        if (tid2 < c) __builtin_amdgcn_fence(__ATOMIC_ACQUIRE, "agent");
#endif
        __syncthreads();
        TOC(14); TIC();
        {
            const int q = (c + 3) >> 2, seg = tid2 >> 7, cgi = tid2 & 127, jlo = seg * q, jhi = (jlo + q < c) ? jlo + q : c;
            f32x4 A0 = {1.f, 1.f, 1.f, 1.f}, H0 = {0.f, 0.f, 0.f, 0.f};
            for (int j = jlo; j < jhi; j += 16) {
                unsigned long long w0[16], w1[16];
#pragma unroll
                for (int i = 0; i < 16; ++i) { const int jj = (j + i < jhi) ? j + i : jhi - 1; const size_t o = (size_t)(b * 128 + jj) * DH + 4 * cgi;
                    w0[i] = __hip_atomic_load((const unsigned long long*)(car + o), __ATOMIC_RELAXED, __HIP_MEMORY_SCOPE_AGENT); w1[i] = __hip_atomic_load((const unsigned long long*)(car + o) + 1, __ATOMIC_RELAXED, __HIP_MEMORY_SCOPE_AGENT); }
#pragma unroll
                for (int i = 0; i < 16; ++i) if (j + i < jhi) {
                    const f32x4 a = {bf_lo((unsigned)w0[i]), bf_lo((unsigned)(w0[i] >> 32)), bf_lo((unsigned)w1[i]), bf_lo((unsigned)(w1[i] >> 32))};
                    const f32x4 h = {bf_hi((unsigned)w0[i]), bf_hi((unsigned)(w0[i] >> 32)), bf_hi((unsigned)w1[i]), bf_hi((unsigned)(w1[i] >> 32))};
                    H0 = a * H0 + h; A0 = A0 * a; }
            }
            *(LAS f32x4*)(segA + seg * DH + 4 * cgi) = A0; *(LAS f32x4*)(segH + seg * DH + 4 * cgi) = H0;
        }
        __syncthreads();
        { float cy = 0.f;
#pragma unroll
          for (int s4 = 0; s4 < 4; ++s4) cy = segA[s4 * DH + tid2] * cy + segH[s4 * DH + tid2];
          carr[tid2] = cy; }
        __syncthreads();
        TOC(15); TIC();
        {
            float cr[16];
#pragma unroll
            for (int ks = 0; ks < 2; ++ks) { const f32x4 c0 = *(const LAS f32x4*)(carr + wid * 64 + 32 * ks + 8 * fq2), c1 = *(const LAS f32x4*)(carr + wid * 64 + 32 * ks + 8 * fq2 + 4);
                cr[8 * ks + 0] = c0.x; cr[8 * ks + 1] = c0.y; cr[8 * ks + 2] = c0.z; cr[8 * ks + 3] = c0.w; cr[8 * ks + 4] = c1.x; cr[8 * ks + 5] = c1.y; cr[8 * ks + 6] = c1.z; cr[8 * ks + 7] = c1.w; }
#ifndef NO_MX_RNN
            m2_rnn_round<4, true>(lds, hl, Pp, proj, Y, red1, cr, b, t0, 0, wid, fr2, fq2);
            if (NM == 5) m2_rnn_round<1, false>(lds, hl, Pp, proj, Y, red1, cr, b, t0, 4, wid, fr2, fq2);
#endif
        }
        TOC(16);
    }
    __syncthreads();
}

#define XB_TMO      128
#define XB_XCNT(j)  (256  + 64 * (j))
#define XB_XSUB(j)  (1280 + 64 * (j))
#define XB_XGEN(j)  (2304 + 64 * (j))
#define XB_TOP      3328
#define XB_TOPGEN   3392
#define XCD_BAR_WORDS 3456
#define XB_SPIN_CAP (1u << 18)

__device__ __forceinline__ unsigned xb_ld(unsigned* p)              { return __hip_atomic_load(p, __ATOMIC_RELAXED, __HIP_MEMORY_SCOPE_AGENT); }
__device__ __forceinline__ unsigned xb_add(unsigned* p, unsigned v) { return __hip_atomic_fetch_add(p, v, __ATOMIC_RELAXED, __HIP_MEMORY_SCOPE_AGENT); }
__device__ __forceinline__ unsigned xb_xcc_id() { return (unsigned)__builtin_amdgcn_s_getreg((3 << 11) | 20) & 0xFu; }
#define XB_SPIN(cond, bar) do { unsigned _sp = 0; while (cond) { __builtin_amdgcn_s_sleep(1); \
    if ((++_sp & 255u) == 0u) { if (xb_ld(&(bar)[XB_TMO])) break; if (_sp > XB_SPIN_CAP) { atomicAdd(&(bar)[XB_TMO], 1u); break; } } } } while (0)

struct XcdBarrier {
    unsigned* bar; unsigned x;
    volatile LAS unsigned* st;
};

__device__ __forceinline__ XcdBarrier xcd_barrier_post(unsigned* bar, volatile LAS unsigned* st) {
    XcdBarrier b; b.bar = bar; b.x = xb_xcc_id(); b.st = st;
    if (threadIdx.x == 0) (void)xb_add(&bar[XB_XCNT(b.x)], 1u);
    return b;
}
__device__ __forceinline__ void xcd_barrier_complete(unsigned* bar, unsigned x, unsigned& nloc, unsigned& nx) {
    const unsigned G = gridDim.x * gridDim.y * gridDim.z;
    unsigned sum, cnt, mine, sp = 0u;
    for (;;) {
        sum = 0u; cnt = 0u; mine = 0u;
#pragma unroll
        for (unsigned j = 0; j < 16; ++j) { const unsigned c = xb_ld(&bar[XB_XCNT(j)]); sum += c; cnt += (c > 0u) ? 1u : 0u; mine = (j == x) ? c : mine; }
        if (sum == G) break;
        __builtin_amdgcn_s_sleep(1);
        if ((++sp & 255u) == 0u) { if (xb_ld(&bar[XB_TMO])) break; if (sp > XB_SPIN_CAP) { atomicAdd(&bar[XB_TMO], 1u); break; } }
    }
    nloc = mine > 0u ? mine : 1u; nx = cnt > 0u ? cnt : 1u;
}

__device__ __forceinline__ void xcd_barrier_head() {
    asm volatile("s_waitcnt vmcnt(0)" ::: "memory");
    __syncthreads();
}
__device__ __forceinline__ void xcd_barrier_tail(const XcdBarrier& b) {
    if (threadIdx.x == 0) {
        unsigned* bar = b.bar;
        __builtin_amdgcn_s_waitcnt(0);
        unsigned nloc = b.st[0], nx = b.st[1];
        if (nloc == 0u) { xcd_barrier_complete(bar, b.x, nloc, nx); b.st[0] = nloc; b.st[1] = nx; }
        const unsigned old = xb_add(&bar[XB_XSUB(b.x)], 1u);
        const unsigned gen = old / nloc;
        if (old + 1u == (gen + 1u) * nloc) {
            __builtin_amdgcn_fence(__ATOMIC_RELEASE, "agent");
            asm volatile("s_waitcnt vmcnt(0)" ::: "memory");
            const unsigned og = xb_add(&bar[XB_TOP], 1u);
            const unsigned tg = og / nx;
            if (og + 1u == (tg + 1u) * nx) xb_add(&bar[XB_TOPGEN], 1u);
            else XB_SPIN(xb_ld(&bar[XB_TOPGEN]) == tg, bar);
            __builtin_amdgcn_fence(__ATOMIC_ACQUIRE, "agent");
            asm volatile("s_waitcnt vmcnt(0)" ::: "memory");
        } else {
            XB_SPIN(xb_ld(&bar[XB_TOPGEN]) == gen, bar);
            __builtin_amdgcn_fence(__ATOMIC_ACQUIRE, "agent");
            asm volatile("s_waitcnt vmcnt(0)" ::: "memory");
        }
    }
    __syncthreads();
}
__device__ __forceinline__ void xcd_barrier(const XcdBarrier& b) { xcd_barrier_head(); xcd_barrier_tail(b); }

#define GSYNC_PRELOAD() do { { __attribute__((address_space(1))) unsigned* gb_ = (__attribute__((address_space(1))) unsigned*)xbar.bar; asm volatile("" : "+s"(gb_)); xbar.bar = (unsigned*)gb_; asm volatile("" : "+s"(xbar.x)); } \
    xcd_barrier_head(); \
    { _Pragma("unroll") for (int a_ = 0; a_ < 2; ++a_) _Pragma("unroll") for (int b_ = 0; b_ < 2; ++b_) _Pragma("unroll") for (int m_ = 0; m_ < 4; ++m_) { accx[a_][b_][m_][0] = (f32x4){0.f, 0.f, 0.f, 0.f}; accx[a_][b_][m_][1] = (f32x4){0.f, 0.f, 0.f, 0.f}; } \
      int t_ = threadIdx.x; asm volatile("" : "+v"(t_)); const int w_ = __builtin_amdgcn_readfirstlane(t_ >> 6), l_ = t_ & 63; \
      if (w_ != 0) { pg8::StaticOrder S0; S0.init(M, D, G, (int)blockIdx.x); pg8::Unit u0; if (S0.next(0, u0)) { EpiRes E0{hb, ss}; E0.preload(accx, u0, w_ >> 2, w_ & 3, l_ & 15, l_ >> 4); } } } \
    xcd_barrier_tail(xbar); } while (0)
#ifndef PROBE_SYNC2
#define PROBE_SYNC2 0
#endif
#ifndef PROBE_M1X2
#define PROBE_M1X2 0
#endif
#ifndef PROBE_M2X2
#define PROBE_M2X2 0
#endif
#define GSYNC() do { { __attribute__((address_space(1))) unsigned* gb_ = (__attribute__((address_space(1))) unsigned*)xbar.bar; asm volatile("" : "+s"(gb_)); xbar.bar = (unsigned*)gb_; asm volatile("" : "+s"(xbar.x)); } xcd_barrier(xbar); if (PROBE_SYNC2) xcd_barrier(xbar); } while (0)
__device__ __forceinline__ int rstd_cache(LAS unsigned char* lds, const float* ss, const pg8::StaticOrder& S) {
    pg8::Unit u0; int pmc = -1;
    int tid = threadIdx.x; asm volatile("" : "+v"(tid));
    if (S.next(0, u0)) { pmc = u0.pm; if (tid < 256) ((LAS float*)(lds + 131072))[tid] = row_rstd(ss, u0.pm * 256 + tid); }
    asm volatile("s_waitcnt vmcnt(0) lgkmcnt(0)" ::: "memory");
    return pmc;
}
__global__ void __launch_bounds__(512, 2) fwd_megakernel(Params p) {
    extern __shared__ __attribute__((aligned(16))) unsigned char lds_raw[];
    LAS unsigned char* lds = (LAS unsigned char*)lds_raw;
#if defined(KEEP_CG_SYNC)
    cg::grid_group grid = cg::this_grid();
#endif
    const int G = gridDim.x;
    unsigned long long tic = 0, tacc = 0;
    f32x4 accx[2][2][4][2];
    unsigned char* ws = p.ws;
    volatile LAS unsigned* xst = (volatile LAS unsigned*)(lds + LDS_XST);
    if (threadIdx.x < 2) xst[threadIdx.x] = 0u;
    __syncthreads();
    XcdBarrier xbar = xcd_barrier_post((unsigned*)(ws + WS_CTL), xst);
    bf16* hb = (bf16*)(ws + WS_HB); bf16* proj = (bf16*)(ws + WS_PROJ); bf16* Y = (bf16*)(ws + WS_Y); bf16* mid = (bf16*)(ws + WS_MID); float* ss = (float*)(ws + WS_SS);
#if defined(KEEP_CG_SYNC)
    grid.sync();
#endif
    TIC();
#ifndef NO_PRO
    prologue(p, lds, G);
#endif
    GSYNC();
    TOC(0);
#pragma unroll 1
    for (int l = 0; l < DEPTH; ++l) {
        { __attribute__((address_space(1))) unsigned char* gws = (__attribute__((address_space(1))) unsigned char*)ws; asm volatile("" : "+s"(gws)); ws = (unsigned char*)gws; }
        const unsigned char* wl = ws + WS_W + (size_t)l * W_LAYER;
        const bf16* in_t = (const bf16*)(wl + W_IN); const bf16* out_t = (const bf16*)(wl + W_OUT); const bf16* up_t = (const bf16*)(wl + W_UP); const bf16* down_t = (const bf16*)(wl + W_DOWN);
        TIC();
#ifndef NO_GIN
        { pg8::Gemm g{hb, in_t, M, DIN, D, 0}; pg8::StaticOrder S; S.init(M, DIN, G, (int)blockIdx.x); const int pmc = rstd_cache(lds, ss, S); EpiIn E{proj, ss, (const LAS float*)(lds + 131072), pmc};
          pg8::gemm_phase<EpiIn, pg8::StaticOrder, true, true>(lds, g, S, E); }
#endif
#ifndef NO_META
        meta_tasks<0>(p, lds, G, nullptr, 0, in_t, D, DIN / 16);
#endif
        if (G == 256 && blockIdx.x >= 128) {
            const int lo = l * TITEMS_PER_LAYER + TITEMS_IN, hi = (l + 1 < DEPTH) ? (l + 1) * TITEMS_PER_LAYER + TITEMS_IN : DEPTH * TITEMS_PER_LAYER;
            convert_items(p, lds, lo, hi, (int)blockIdx.x - 128, 128 * 8);
        }
        GSYNC();
        TOC(1); TIC();
#ifndef FUSED_MIXER
#define FUSED_MIXER 1
#endif
#if FUSED_MIXER
        mixer_phase(p, lds, G, l, tic, tacc);
        GSYNC_PRELOAD();
        TOC(2);
#else
        m1_phase(p, lds, G, l);
        GSYNC();
        TOC(2); TIC();
        m2_phase(p, lds, G, l);
        GSYNC();
#endif
        TOC(3); TIC();
#ifndef NO_GOUT
        { pg8::Gemm g{Y, out_t, M, D, D, NMETA}; pg8::StaticOrder S; S.init(M, D, G, (int)blockIdx.x); EpiRes E{hb, ss};
          pg8::gemm_phase_acc<EpiRes, pg8::StaticOrder, false, true, true>(lds, g, S, E, accx); }
#endif
#ifndef NO_META
        if (l < DEPTH - 1) meta_tasks<1>(p, lds, G, Y, D, out_t, D, D / 16);
#endif
        GSYNC();
        TOC(4); TIC();
#ifndef NO_GUP
#ifndef STAGGER_UP
#define STAGGER_UP 0
#endif
        if (STAGGER_UP > 0) {
            const unsigned long long w0 = __builtin_amdgcn_s_memrealtime(), dl = (unsigned long long)(((blockIdx.x >> 3) & 3) * STAGGER_UP);
            while (__builtin_amdgcn_s_memrealtime() - w0 < dl) __builtin_amdgcn_s_sleep(4);
        }
        { pg8::Gemm g{hb, up_t, M, FF, D, 0}; pg8::StaticOrder S; S.init(M, FF, G, (int)blockIdx.x); const int pmc = rstd_cache(lds, ss, S); EpiUp E{mid, ss, (const LAS float*)(lds + 131072), pmc};
          pg8::gemm_phase<EpiUp, pg8::StaticOrder, true, true>(lds, g, S, E); }
#endif
#ifndef NO_META
        if (l < DEPTH - 1) meta_tasks<2>(p, lds, G, nullptr, 0, up_t, D, FF / 16);
#endif
        GSYNC_PRELOAD();
        TOC(5); TIC();
#ifndef NO_GDN
        { pg8::Gemm g{mid, down_t, M, D, FF, 0}; pg8::StaticOrder S; S.init(M, D, G, (int)blockIdx.x); EpiRes E{hb, ss};
          pg8::gemm_phase_acc<EpiRes, pg8::StaticOrder, false, true, true>(lds, g, S, E, accx); }
#endif
#ifndef NO_META
        if (l < DEPTH - 1) meta_tasks<1, 16>(p, lds, G, (const bf16*)(ws + WS_MIDMETA), FF, down_t, FF, D / 16);
#endif
        GSYNC();
        TOC(6);
    }
    TIC();
    final_norm(p, G);
    TOC(7);
    if (PROBE_PHASE >= 0 && blockIdx.x == PROBE_BLOCK && threadIdx.x == 0) { const unsigned long long w0 = __builtin_amdgcn_s_memrealtime(); while (__builtin_amdgcn_s_memrealtime() - w0 < 4ull * tacc) __builtin_amdgcn_s_sleep(8); }
}

extern "C" void kernel_launch(void* const* d_in, const int* in_sizes, int n_in, void* d_out, int out_size, void* d_ws, size_t ws_size, hipStream_t stream) {
    static int grid = 0;
    if (grid == 0) {
        if (n_in != 20 || in_sizes[0] != M * D || out_size != M * D || ws_size < WS_END) { fprintf(stderr, "kernel_launch: unexpected shapes (n_in %d, in0 %d, out %d, ws %zu)\n", n_in, n_in > 0 ? in_sizes[0] : -1, out_size, ws_size); grid = -1; return; }
        int dev = 0, cus = 0, per_cu = 0;
        if (hipGetDevice(&dev) != hipSuccess || hipDeviceGetAttribute(&cus, hipDeviceAttributeMultiprocessorCount, dev) != hipSuccess) { grid = -1; return; }
        if (hipFuncSetAttribute((const void*)fwd_megakernel, hipFuncAttributeMaxDynamicSharedMemorySize, LDS_BYTES) != hipSuccess) { fprintf(stderr, "kernel_launch: hipFuncSetAttribute failed\n"); grid = -1; return; }
        if (hipOccupancyMaxActiveBlocksPerMultiprocessor(&per_cu, (const void*)fwd_megakernel, 512, LDS_BYTES) != hipSuccess || per_cu < 1) { fprintf(stderr, "kernel_launch: occupancy query gave %d\n", per_cu); (void)hipGetLastError(); grid = -1; return; }
        grid = cus * 1;
        if (grid < 256) { fprintf(stderr, "kernel_launch: %d CUs; the fused mixer phase needs 256 resident workgroups\n", cus); grid = -1; return; }
    }
    if (grid < 0) return;
    if (hipMemsetAsync((char*)d_ws + WS_CTL, 0, WS_FLAG + 256 * 4, stream) != hipSuccess) { fprintf(stderr, "kernel_launch: memset failed\n"); return; }
    Params p{};
    for (int i = 0; i < 20; ++i) p.in[i] = (const float*)d_in[i];
    p.out = (float*)d_out; p.ws = (unsigned char*)d_ws;
    void* args[] = {&p};
    hipError_t e = hipLaunchCooperativeKernel((const void*)fwd_megakernel, dim3(grid), dim3(512), args, LDS_BYTES, stream);
    if (e != hipSuccess) fprintf(stderr, "cooperative launch failed: %s (grid %d)\n", hipGetErrorString(e), grid);
}
```

```cpp
#include <hip/hip_runtime.h>
#include <hip/hip_cooperative_groups.h>
#include <cstdio>
#include <cstdint>
namespace cg = cooperative_groups;
namespace pg8 {
#define PG8_LAS __attribute__((address_space(3)))
typedef unsigned short bf16_t;
typedef short bf16x8 __attribute__((ext_vector_type(8)));
typedef float f32x4 __attribute__((ext_vector_type(4)));
typedef unsigned u32x4 __attribute__((ext_vector_type(4)));
constexpr int BM = 256, BK = 64, HALF = 128, HTB = HALF * BK * 2  , STAGE_BYTES = 8 * HTB, NXCD = 8, WGM = 8;

__host__ __device__ __forceinline__ int lds_byte(int r, int c) { const int st = (r >> 4) * 2 + (c >> 5), rr = r & 15, cc = c & 31, ob = rr * 64 + cc * 2; return st * 1024 + (ob ^ (((ob >> 9) & 1) << 5)); }
__host__ __device__ __forceinline__ void stage_rc(int b, int& R, int& C) { const int st = b / 1024, sb = b % 1024, swz = sb ^ (((sb >> 9) & 1) << 5); R = (st >> 1) * 16 + swz / 64; C = (st & 1) * 32 + (swz % 64) / 2; }
__host__ __device__ __forceinline__ int perm32(int rho) { const int n = rho >> 4, i = rho & 15; return 8 * (i >> 2) + 4 * n + (i & 3); }

struct Unit { int pm, pn; };
struct Gemm { const bf16_t* A; const bf16_t* Bt; int M, N, K, gap; };

struct StaticOrder {
    int nM, nN, nwg, G, c;
    __host__ __device__ void init(int M, int N, int G_, int c_) { nM = M / BM; nN = N / BM; nwg = nM * nN; G = G_; c = c_; }
    __host__ __device__ bool next(int i, Unit& u) const {
        const long L = (long)i * G + c; if (L >= nwg) return false;
        int wgid = (int)L; { const int q = nwg / NXCD, r = nwg % NXCD, xcd = wgid % NXCD, off = wgid / NXCD; wgid = (xcd < r ? xcd * (q + 1) : r * (q + 1) + (xcd - r) * q) + off; }
        const int nig = WGM * nN, gid = wgid / nig, fm = gid * WGM, gsz = (nM - fm) < WGM ? (nM - fm) : WGM;
        u.pm = fm + ((wgid % nig) % gsz); u.pn = (wgid % nig) / gsz; return true;
    }
    __device__ __forceinline__ void a_ready(const Unit&) const {}
    __device__ __forceinline__ void done(const Unit&) const {}
};
__device__ __forceinline__ unsigned cvt_pk_bf16(float lo, float hi) { unsigned r; asm volatile("v_cvt_pk_bf16_f32 %0, %1, %2" : "=v"(r) : "v"(lo), "v"(hi)); return r; }
template <class Epi, class Sched, bool ALIGN_EPI = false, bool SP2 = false>
__device__ __forceinline__ void gemm_phase(PG8_LAS unsigned char* lds, const Gemm g, const Sched& S, const Epi& E) {
    int tid_ = threadIdx.x; asm volatile("" : "+v"(tid_));
    const int tid = tid_, wid = __builtin_amdgcn_readfirstlane(tid >> 6), lane = tid & 63, wr = wid >> 2, wc = wid & 3, fr = lane & 15, fq = lane >> 4;
    const int K = g.K, nt = K / BK;
    unsigned voffA[2], voffB[2];
#pragma unroll
    for (int i = 0; i < 2; ++i) { int R, C; stage_rc(tid * 16 + i * 8192, R, C); const int Rb = Epi::PERM ? ((R & ~31) + perm32(R & 31)) : R;
        voffA[i] = (unsigned)(R * K + C) * 2u; voffB[i] = (unsigned)(Rb * K + C) * 2u; }
    const size_t kstep = (size_t)(BK * 2);
    const size_t hstep = (size_t)HALF * K * 2;
    const size_t tstep = 2 * hstep;
    const int agap = g.gap;
#define a_off(pm_) ((size_t)((pm_) * BM + agap * (1 + ((pm_) >> 5))) * (size_t)K * 2)
    const unsigned ldsw = (unsigned)wid * 1024u;
    const int aoff = lds_byte(wr * 64 + fr, fq * 8), boff = lds_byte(wc * 32 + fr, fq * 8);
#define PG8_SA(b, h) (((b) * 2 + (h)) * HTB)
#define PG8_SB(b, h) ((4 + (b) * 2 + (h)) * HTB)
#define PG8_STAGE(bufoff, gbase, voff) do { _Pragma("unroll") for (int _i = 0; _i < 2; ++_i) \
        __builtin_amdgcn_global_load_lds((const unsigned*)((const char*)(gbase) + (voff)[_i]), (PG8_LAS unsigned*)(lds + (bufoff) + ldsw + _i * 8192), 16, 0, 0); } while (0)
#define PG8_LDA(dst, b, h) do { _Pragma("unroll") for (int m = 0; m < 4; ++m) _Pragma("unroll") for (int k = 0; k < 2; ++k) dst[m][k] = *(const PG8_LAS bf16x8*)(lds + PG8_SA(b, h) + aoff + m * 2048 + k * 1024); } while (0)
#define PG8_LDB(dst, b, h) do { _Pragma("unroll") for (int n = 0; n < 2; ++n) _Pragma("unroll") for (int k = 0; k < 2; ++k) dst[n][k] = *(const PG8_LAS bf16x8*)(lds + PG8_SB(b, h) + boff + n * 2048 + k * 1024); } while (0)
#define PG8_MMA(ai, bj, At, Bt) do { __builtin_amdgcn_s_setprio(1); _Pragma("unroll") for (int m = 0; m < 4; ++m) _Pragma("unroll") for (int n = 0; n < 2; ++n) _Pragma("unroll") for (int k = 0; k < 2; ++k) \
        acc[ai][bj][m][n] = __builtin_amdgcn_mfma_f32_16x16x32_bf16(Bt[n][k], At[m][k], acc[ai][bj][m][n], 0, 0, 0); __builtin_amdgcn_s_setprio(0); } while (0)
#define PG8_WAIT_V(n) asm volatile("s_waitcnt vmcnt(" #n ")" ::: "memory")
#define PG8_WAIT_L(n) asm volatile("s_waitcnt lgkmcnt(" #n ")" ::: "memory")
#define PG8_BAR __builtin_amdgcn_s_barrier()
#define PG8_SCHED __builtin_amdgcn_sched_barrier(0)
    Unit cur, nxt; int ui = 0;
    if (!S.next(0, cur)) return;
    f32x4 acc[2][2][4][2];
#pragma unroll
    for (int a = 0; a < 2; ++a)
#pragma unroll
        for (int b = 0; b < 2; ++b)
#pragma unroll
            for (int m = 0; m < 4; ++m)
#pragma unroll
                for (int n = 0; n < 2; ++n) acc[a][b][m][n] = (f32x4){0.f, 0.f, 0.f, 0.f};
    if constexpr (Epi::PRELOAD) E.preload(acc, cur, wr, wc, fr, fq);
    bf16x8 At[4][2], B0[2][2], B1[2][2];
    const char* cA = (const char*)g.A + a_off(cur.pm); const char* cB = (const char*)g.Bt + (size_t)cur.pn * tstep;
    S.a_ready(cur);
    if constexpr (SP2) {
        PG8_STAGE(PG8_SB(0, 0), cB, voffB); PG8_STAGE(PG8_SB(0, 1), cB + hstep, voffB); PG8_STAGE(PG8_SA(0, 0), cA, voffA); PG8_STAGE(PG8_SA(0, 1), cA + hstep, voffA);
        if (wr == 1) PG8_BAR;
        PG8_WAIT_V(2); PG8_BAR;
        PG8_STAGE(PG8_SB(1, 0), cB + kstep, voffB); PG8_STAGE(PG8_SA(1, 0), cA + kstep, voffA); PG8_STAGE(PG8_SB(1, 1), cB + hstep + kstep, voffB);
        PG8_WAIT_V(6); PG8_BAR;
    } else {
        PG8_STAGE(PG8_SB(0, 0), cB, voffB); PG8_STAGE(PG8_SA(0, 0), cA, voffA); PG8_STAGE(PG8_SB(0, 1), cB + hstep, voffB); PG8_STAGE(PG8_SA(0, 1), cA + hstep, voffA);
        if (wr == 1) PG8_BAR;
        PG8_WAIT_V(4); PG8_BAR;
        PG8_STAGE(PG8_SB(1, 0), cB + kstep, voffB); PG8_STAGE(PG8_SA(1, 0), cA + kstep, voffA); PG8_STAGE(PG8_SB(1, 1), cB + hstep + kstep, voffB);
        PG8_WAIT_V(6); PG8_BAR;
    }
    for (;;) {
        const bool has_next = S.next(ui + 1, nxt);
        const char* nA = has_next ? (const char*)g.A + a_off(nxt.pm) : cA; const char* nB = has_next ? (const char*)g.Bt + (size_t)nxt.pn * tstep : cB;
        for (int t = 0; t < nt; t += 2) {
            const bool last = (t == nt - 2);
            const char* a1 = cA + (size_t)(t + 1) * kstep;
            const char* a2 = last ? nA : cA + (size_t)(t + 2) * kstep; const char* b2 = last ? nB : cB + (size_t)(t + 2) * kstep;
            const char* a3 = a2 + kstep; const char* b3 = b2 + kstep;
            if (last && has_next) S.a_ready(nxt);
            if constexpr (SP2) {
            PG8_LDB(B0, 0, 0); PG8_LDB(B1, 0, 1); PG8_SCHED; PG8_LDA(At, 0, 0); PG8_STAGE(PG8_SA(1, 1), a1 + hstep, voffA);
            PG8_WAIT_V(8); PG8_WAIT_L(0); PG8_BAR; PG8_MMA(0, 0, At, B0); PG8_MMA(0, 1, At, B1); PG8_BAR; PG8_SCHED;
            PG8_LDA(At, 0, 1); PG8_STAGE(PG8_SB(0, 0), b2, voffB); PG8_STAGE(PG8_SB(0, 1), b2 + hstep, voffB); PG8_STAGE(PG8_SA(0, 0), a2, voffA);
            PG8_WAIT_V(8); PG8_WAIT_L(0); PG8_BAR; PG8_MMA(1, 0, At, B0); PG8_MMA(1, 1, At, B1); PG8_BAR; PG8_SCHED;
            PG8_LDB(B0, 1, 0); PG8_LDB(B1, 1, 1); PG8_SCHED; PG8_LDA(At, 1, 0); PG8_STAGE(PG8_SA(0, 1), a2 + hstep, voffA);
            PG8_WAIT_V(8); PG8_WAIT_L(0); PG8_BAR; PG8_MMA(0, 0, At, B0); PG8_MMA(0, 1, At, B1); PG8_BAR; PG8_SCHED;
            PG8_LDA(At, 1, 1); PG8_STAGE(PG8_SB(1, 0), b3, voffB); PG8_STAGE(PG8_SB(1, 1), b3 + hstep, voffB); PG8_STAGE(PG8_SA(1, 0), a3, voffA);
            PG8_WAIT_V(8); PG8_WAIT_L(0); PG8_BAR; PG8_MMA(1, 0, At, B0); PG8_MMA(1, 1, At, B1); PG8_BAR; PG8_SCHED;
            } else {
            PG8_LDB(B0, 0, 0); PG8_SCHED; PG8_LDA(At, 0, 0); PG8_STAGE(PG8_SA(1, 1), a1 + hstep, voffA);
            PG8_WAIT_L(8); PG8_BAR; PG8_WAIT_L(0); PG8_MMA(0, 0, At, B0); PG8_BAR; PG8_SCHED;
            PG8_LDB(B1, 0, 1); PG8_STAGE(PG8_SB(0, 0), b2, voffB);
            PG8_BAR; PG8_WAIT_L(0); PG8_MMA(0, 1, At, B1); PG8_BAR;
            PG8_LDA(At, 0, 1); PG8_STAGE(PG8_SA(0, 0), a2, voffA);
            PG8_BAR; PG8_WAIT_L(0); PG8_MMA(1, 0, At, B0); PG8_BAR; PG8_SCHED;
            PG8_STAGE(PG8_SB(0, 1), b2 + hstep, voffB);
            PG8_WAIT_V(6); PG8_BAR; PG8_MMA(1, 1, At, B1); PG8_BAR;
            PG8_LDB(B0, 1, 0); PG8_SCHED; PG8_LDA(At, 1, 0); PG8_STAGE(PG8_SA(0, 1), a2 + hstep, voffA);
            PG8_WAIT_L(8); PG8_BAR; PG8_WAIT_L(0); PG8_MMA(0, 0, At, B0); PG8_BAR; PG8_SCHED;
            PG8_LDB(B1, 1, 1); PG8_STAGE(PG8_SB(1, 0), b3, voffB);
            PG8_BAR; PG8_WAIT_L(0); PG8_MMA(0, 1, At, B1); PG8_BAR;
            PG8_LDA(At, 1, 1); PG8_STAGE(PG8_SA(1, 0), a3, voffA);
            PG8_BAR; PG8_WAIT_L(0); PG8_MMA(1, 0, At, B0); PG8_BAR; PG8_SCHED;
            PG8_STAGE(PG8_SB(1, 1), b3 + hstep, voffB);
            PG8_WAIT_V(6); PG8_BAR; PG8_MMA(1, 1, At, B1); PG8_BAR;
            }
        }
        if constexpr (ALIGN_EPI) { if (wr == 0) PG8_BAR; }
        if constexpr (!Epi::AFTER_DRAIN) { E(acc, cur, wr, wc, fr, fq); S.done(cur); }
        if (!has_next) break;
#pragma unroll
        for (int a = 0; a < 2; ++a)
#pragma unroll
            for (int b = 0; b < 2; ++b)
#pragma unroll
                for (int m = 0; m < 4; ++m)
#pragma unroll
                    for (int n = 0; n < 2; ++n) acc[a][b][m][n] = (f32x4){0.f, 0.f, 0.f, 0.f};
        if constexpr (Epi::PRELOAD) { E.preload(acc, nxt, wr, wc, fr, fq); PG8_WAIT_V(0); }
        cur = nxt; cA = nA; cB = nB; ++ui;
        if constexpr (ALIGN_EPI) { if (wr == 1) PG8_BAR; }
    }
    PG8_WAIT_V(0);
    if constexpr (!ALIGN_EPI) { if (wr == 0) PG8_BAR; }
    PG8_BAR;
    if constexpr (Epi::AFTER_DRAIN) { E.fused(acc, cur, wr, wc, fr, fq, lds, wid, lane); S.done(cur); }
#undef PG8_SA
#undef PG8_SB
#undef PG8_STAGE
#undef PG8_LDA
#undef PG8_LDB
#undef PG8_MMA
#undef PG8_WAIT_V
#undef PG8_WAIT_L
#undef PG8_BAR
#undef PG8_SCHED
}
}

#define LAS __attribute__((address_space(3)))
typedef unsigned short bf16;
typedef unsigned u32x4 __attribute__((ext_vector_type(4)));
typedef unsigned u32x2 __attribute__((ext_vector_type(2)));
typedef float f32x4 __attribute__((ext_vector_type(4)));
typedef short bf16x8 __attribute__((ext_vector_type(8)));
constexpr int D = 1024, SEQ = 8192, NB = 2, NMETA = 16, TT = SEQ + NMETA, M = NB * SEQ, DEPTH = 4, DIN = 1536, FF = 4096, DH = 512;
constexpr float EPS = 1e-6f;
constexpr size_t MiB = 1u << 20;
constexpr size_t WS_CTL = 0;
constexpr size_t WS_POOLW = 1 * MiB, WS_GR = WS_POOLW + 512 * 1024, WS_GI = WS_GR + 256 * 1024;
constexpr size_t WS_SP = 2 * MiB, WS_HMETA = WS_SP + 64 * 1024, WS_MIDMETA = WS_HMETA + 64 * 1024;
constexpr size_t WS_SS = 3 * MiB, WS_CARA = 4 * MiB, WS_CARH = WS_CARA + 512 * 1024;
constexpr size_t WS_W = 8 * MiB, W_LAYER = 21 * MiB, W_IN = 0, W_OUT = 3 * MiB, W_UP = 5 * MiB, W_DOWN = 13 * MiB;
constexpr size_t WS_HB = 92 * MiB, WS_MID = 124 * MiB;
constexpr size_t WS_PROJ = WS_MID, WS_Y = WS_MID + 48 * MiB + 256 * 1024, WS_HL = WS_Y + 32 * MiB + 256 * 1024, WS_P = WS_HL + 32 * MiB + 256 * 1024, WS_END = 256 * MiB;
static_assert(WS_PROJ + (size_t)NB * TT * DIN * 2 <= WS_Y && WS_Y + (size_t)NB * TT * D * 2 <= WS_HL && WS_HL + (size_t)NB * TT * DH * 2 <= WS_P && WS_P + (size_t)NB * TT * DH * 2 <= WS_END, "ws map");
static_assert(WS_W + DEPTH * W_LAYER <= WS_HB && WS_HB + (size_t)M * D * 2 <= WS_MID && WS_MID + (size_t)M * FF * 2 <= WS_END, "ws map 2");
constexpr int LDS_HL = 0, LDS_P = 65536, LDS_CST = 131072, LDS_CARR = 147456, LDS_RED1 = 149504, LDS_RED2 = 152064, LDS_CARRY = 154624;
constexpr int LDS_XST = 163840 - 64;
constexpr int LDS_BYTES = 163840;
constexpr size_t WS_FLAG = 64 * 1024;

struct Params {
    const float* in[20];
    float* out;
    unsigned char* ws;
};

__device__ __forceinline__ Params launder(const Params& p) {
    Params q = p;
#pragma unroll
    for (int i = 0; i < 20; ++i) { const __attribute__((address_space(1))) float* g = (const __attribute__((address_space(1))) float*)q.in[i]; asm volatile("" : "+s"(g)); q.in[i] = (const float*)g; }
    { __attribute__((address_space(1))) float* g = (__attribute__((address_space(1))) float*)q.out; asm volatile("" : "+s"(g)); q.out = (float*)g; }
    { __attribute__((address_space(1))) unsigned char* g = (__attribute__((address_space(1))) unsigned char*)q.ws; asm volatile("" : "+s"(g)); q.ws = (unsigned char*)g; }
    return q;
}
__device__ __forceinline__ unsigned cvt_pk(float lo, float hi) { return pg8::cvt_pk_bf16(lo, hi); }
__device__ __forceinline__ float bf_lo(unsigned w) { return __builtin_bit_cast(float, w << 16); }
__device__ __forceinline__ float bf_hi(unsigned w) { return __builtin_bit_cast(float, w & 0xffff0000u); }
__device__ __forceinline__ void unpack8(const u32x4 w, float (&f)[8]) {
    f[0] = bf_lo(w.x); f[1] = bf_hi(w.x); f[2] = bf_lo(w.y); f[3] = bf_hi(w.y); f[4] = bf_lo(w.z); f[5] = bf_hi(w.z); f[6] = bf_lo(w.w); f[7] = bf_hi(w.w);
}
__device__ __forceinline__ u32x4 pack8(const float (&f)[8]) { u32x4 w; w.x = cvt_pk(f[0], f[1]); w.y = cvt_pk(f[2], f[3]); w.z = cvt_pk(f[4], f[5]); w.w = cvt_pk(f[6], f[7]); return w; }
__device__ __forceinline__ float wave_sum(float v) {
#pragma unroll
    for (int o = 1; o < 64; o <<= 1) v += __shfl_xor(v, o);
    return v;
}
template <int CTRL> __device__ __forceinline__ float dppf(float old, float src) {
    return __builtin_bit_cast(float, __builtin_amdgcn_update_dpp(__builtin_bit_cast(int, old), __builtin_bit_cast(int, src), CTRL, 0xf, 0xf, false));
}
template <int DD> __device__ __forceinline__ float shiftd(float cur, float prev) {
    const float t = dppf<0x100 + (16 - DD)>(0.f, prev);
    return dppf<0x110 + DD>(t, cur);
}
__device__ __forceinline__ float sigm(float v) { return __builtin_amdgcn_rcpf(1.0f + __expf(-v)); }
__device__ __forceinline__ int outchan(int n, int rho) { return 32 * (n >> 1) + 8 * (rho >> 2) + 4 * (n & 1) + (rho & 3); }

__device__ __forceinline__ float row_rstd(const float* ss, int r) {
    const f32x4* s4 = (const f32x4*)(ss + (size_t)r * 16);
    const f32x4 a = s4[0], b = s4[1], c = s4[2], d = s4[3];
    const float s = ((a.x + a.y) + (a.z + a.w)) + ((b.x + b.y) + (b.z + b.w)) + ((c.x + c.y) + (c.z + c.w)) + ((d.x + d.y) + (d.z + d.w));
    return 1.0f / sqrtf(s * (1.0f / D) + EPS);
}
__device__ __forceinline__ void rows_rstd(const float* ss, int rowbase  , int fr, float (&rs)[2][4]) {
    const int lane = threadIdx.x & 63;
    const float r0 = row_rstd(ss, rowbase + lane), r1 = row_rstd(ss, rowbase + 128 + lane);
#pragma unroll
    for (int m = 0; m < 4; ++m) { rs[0][m] = __shfl(r0, m * 16 + fr); rs[1][m] = __shfl(r1, m * 16 + fr); }
}
struct EpiIn {
    static constexpr bool PERM = true, AFTER_DRAIN = false, PRELOAD = false;
    bf16* P; const float* ss; const LAS float* rl; int pmc;
    __device__ __forceinline__ void operator()(const f32x4 (&acc)[2][2][4][2], const pg8::Unit& u, int wr, int wc, int fr, int fq) const {
        const int row0 = u.pm * 256 + wr * 64 + fr, col0 = u.pn * 256 + wc * 32 + 8 * fq;
        float rsv[2][4];
        if (u.pm == pmc) {
#pragma unroll
            for (int ai = 0; ai < 2; ++ai)
#pragma unroll
                for (int m = 0; m < 4; ++m) rsv[ai][m] = rl[ai * 128 + wr * 64 + m * 16 + fr];
        } else {
#pragma unroll
            for (int ai = 0; ai < 2; ++ai)
#pragma unroll
                for (int m = 0; m < 4; ++m) { rsv[ai][m] = row_rstd(ss, row0 + ai * 128 + m * 16); asm volatile("" ::: "memory"); }
        }
#pragma unroll
        for (int ai = 0; ai < 2; ++ai)
#pragma unroll
            for (int m = 0; m < 4; ++m) {
                const int r = row0 + ai * 128 + m * 16; const float rs = rsv[ai][m];
                bf16* rowp = P + (size_t)(r + NMETA * (1 + (r >> 13))) * DIN + col0;
#pragma unroll
                for (int bj = 0; bj < 2; ++bj) { const f32x4 v0 = acc[ai][bj][m][0] * rs, v1 = acc[ai][bj][m][1] * rs;
                    u32x4 w; w.x = cvt_pk(v0[0], v0[1]); w.y = cvt_pk(v0[2], v0[3]); w.z = cvt_pk(v1[0], v1[1]); w.w = cvt_pk(v1[2], v1[3]);
                    *(u32x4*)(rowp + bj * 128) = w; }
            }
    }
};
struct EpiUp {
    static constexpr bool PERM = true, AFTER_DRAIN = false, PRELOAD = false;
    bf16* O; const float* ss; const LAS float* rl; int pmc;
    __device__ __forceinline__ void operator()(const f32x4 (&acc)[2][2][4][2], const pg8::Unit& u, int wr, int wc, int fr, int fq) const {
        const int row0 = u.pm * 256 + wr * 64 + fr, col0 = u.pn * 256 + wc * 32 + 8 * fq;
        float rsv[2][4];
        if (u.pm == pmc) {
#pragma unroll
            for (int ai = 0; ai < 2; ++ai)
#pragma unroll
                for (int m = 0; m < 4; ++m) rsv[ai][m] = rl[ai * 128 + wr * 64 + m * 16 + fr];
        } else {
#pragma unroll
            for (int ai = 0; ai < 2; ++ai)
#pragma unroll
                for (int m = 0; m < 4; ++m) { rsv[ai][m] = row_rstd(ss, row0 + ai * 128 + m * 16); asm volatile("" ::: "memory"); }
        }
#pragma unroll
        for (int ai = 0; ai < 2; ++ai)
#pragma unroll
            for (int m = 0; m < 4; ++m) {
                const int r = row0 + ai * 128 + m * 16; const float rs = rsv[ai][m];
                bf16* rowp = O + (size_t)r * FF + col0;
#pragma unroll
                for (int bj = 0; bj < 2; ++bj) { f32x4 v0 = acc[ai][bj][m][0] * rs, v1 = acc[ai][bj][m][1] * rs;
#pragma unroll
                    for (int j = 0; j < 4; ++j) { v0[j] = fmaxf(v0[j], 0.f); v0[j] *= v0[j]; v1[j] = fmaxf(v1[j], 0.f); v1[j] *= v1[j]; }
                    u32x4 w; w.x = cvt_pk(v0[0], v0[1]); w.y = cvt_pk(v0[2], v0[3]); w.z = cvt_pk(v1[0], v1[1]); w.w = cvt_pk(v1[2], v1[3]);
                    *(u32x4*)(rowp + bj * 128) = w; }
            }
    }
};
struct EpiRes {
    static constexpr bool PERM = true, AFTER_DRAIN = false, PRELOAD = true;
    bf16* hb; float* ssn;
    __device__ __forceinline__ void preload(f32x4 (&acc)[2][2][4][2], const pg8::Unit& u, int wr, int wc, int fr, int fq) const {
        const int row0 = u.pm * 256 + wr * 64 + fr, col0 = u.pn * 256 + wc * 32 + 8 * fq;
#pragma unroll
        for (int ai = 0; ai < 2; ++ai)
#pragma unroll
            for (int m = 0; m < 4; ++m) { const size_t off = (size_t)(row0 + ai * 128 + m * 16) * D + col0;
#pragma unroll
                for (int bj = 0; bj < 2; ++bj) { const u32x4 w = *(const u32x4*)(hb + off + bj * 128);
                    acc[ai][bj][m][0] = (f32x4){bf_lo(w.x), bf_hi(w.x), bf_lo(w.y), bf_hi(w.y)}; acc[ai][bj][m][1] = (f32x4){bf_lo(w.z), bf_hi(w.z), bf_lo(w.w), bf_hi(w.w)}; } }
    }
    __device__ __forceinline__ void operator()(const f32x4 (&acc)[2][2][4][2], const pg8::Unit& u, int wr, int wc, int fr, int fq) const {
        const int row0 = u.pm * 256 + wr * 64 + fr, col0 = u.pn * 256 + wc * 32 + 8 * fq;
#pragma unroll
        for (int ai = 0; ai < 2; ++ai)
#pragma unroll
            for (int m = 0; m < 4; ++m) {
                const int r = row0 + ai * 128 + m * 16; const size_t off = (size_t)r * D + col0; float s = 0.f;
#pragma unroll
                for (int bj = 0; bj < 2; ++bj) {
                    const f32x4 o0 = acc[ai][bj][m][0], o1 = acc[ai][bj][m][1];
                    s += (o0[0] * o0[0] + o0[1] * o0[1]) + (o0[2] * o0[2] + o0[3] * o0[3]) + (o1[0] * o1[0] + o1[1] * o1[1]) + (o1[2] * o1[2] + o1[3] * o1[3]);
                    u32x4 w; w.x = cvt_pk(o0[0], o0[1]); w.y = cvt_pk(o0[2], o0[3]); w.z = cvt_pk(o1[0], o1[1]); w.w = cvt_pk(o1[2], o1[3]);
                    *(u32x4*)(hb + off + bj * 128) = w; }
                s += __shfl_xor(s, 16); s += __shfl_xor(s, 32);
                if (fq == 0) ssn[(size_t)r * 16 + u.pn * 4 + wc] = s;
            }
    }
};

struct TItem { const float* W; const float* gk; bf16* WT; int K, N, item; };
__device__ __forceinline__ void titem_load(const TItem& t, int lane, f32x4 (&v)[8], float (&gs)[8]) {
    const int nblk = t.N / 32, kb = t.item / nblk, nb = t.item % nblk, k0 = 64 * kb, n0 = 32 * nb, lr = lane >> 3, lc = (lane & 7) * 4;
#pragma unroll
    for (int i = 0; i < 8; ++i) { v[i] = __builtin_nontemporal_load((const f32x4*)(t.W + (size_t)(k0 + 8 * i + lr) * t.N + n0 + lc)); gs[i] = t.gk ? t.gk[k0 + 8 * i + lr] : 1.0f; }
}
__device__ __forceinline__ void titem_store(const TItem& t, int lane, const f32x4 (&v)[8], const float (&gs)[8], LAS float* scr) {
    const int nblk = t.N / 32, kb = t.item / nblk, nb = t.item % nblk, k0 = 64 * kb, n0 = 32 * nb, lr = lane >> 3, lc = (lane & 7) * 4;
#pragma unroll
    for (int i = 0; i < 8; ++i) { LAS float* d = scr + (8 * i + lr) * 33 + lc; d[0] = v[i].x * gs[i]; d[1] = v[i].y * gs[i]; d[2] = v[i].z * gs[i]; d[3] = v[i].w * gs[i]; }
    asm volatile("s_waitcnt lgkmcnt(0)" ::: "memory");
    const int c = lane & 7;
#pragma unroll
    for (int j = 0; j < 4; ++j) { const int n = (lane >> 3) + 8 * j; const LAS float* s = scr + (8 * c) * 33 + n;
        u32x4 o; o.x = cvt_pk(s[0 * 33], s[1 * 33]); o.y = cvt_pk(s[2 * 33], s[3 * 33]); o.z = cvt_pk(s[4 * 33], s[5 * 33]); o.w = cvt_pk(s[6 * 33], s[7 * 33]);
        *(u32x4*)(t.WT + (size_t)(n0 + n) * t.K + k0 + 8 * c) = o; }
    asm volatile("s_waitcnt lgkmcnt(0)" ::: "memory");
}
__device__ __forceinline__ TItem titem_decode(const Params& p, int it) {
    constexpr int I_IN = 16 * 48, I_OUT = 16 * 32, I_UP = 16 * 128, I_DN = 64 * 32, I_PW = 4 * 8, I_G = 8 * 2, I_L = I_IN + I_OUT + I_UP + I_DN + I_PW + 2 * I_G;
    const int l = it / I_L; int r = it % I_L; unsigned char* ws = p.ws; unsigned char* wl = ws + WS_W + (size_t)l * W_LAYER; TItem t;
    if (r < I_IN) { t = TItem{p.in[3] + (size_t)l * D * DIN, p.in[2] + l * D, (bf16*)(wl + W_IN), D, DIN, r}; return t; } r -= I_IN;
    if (r < I_OUT) { t = TItem{p.in[15] + (size_t)l * D * D, p.in[14] + l * D, (bf16*)(wl + W_OUT), D, D, r}; return t; } r -= I_OUT;
    if (r < I_UP) { t = TItem{p.in[17] + (size_t)l * D * FF, p.in[16] + l * D, (bf16*)(wl + W_UP), D, FF, r}; return t; } r -= I_UP;
    if (r < I_DN) { t = TItem{p.in[18] + (size_t)l * FF * D, nullptr, (bf16*)(wl + W_DOWN), FF, D, r}; return t; } r -= I_DN;
    if (r < I_PW) { const int g = r / 8; t = TItem{p.in[4] + (size_t)(l * 4 + g) * 16384, nullptr, (bf16*)(ws + WS_POOLW) + (size_t)(l * 4 + g) * 16384, 128, 128, r % 8}; return t; } r -= I_PW;
    if (r < I_G) { const int h = r / 2; t = TItem{p.in[9] + (size_t)(l * 8 + h) * 4096, nullptr, (bf16*)(ws + WS_GR) + (size_t)(l * 8 + h) * 4096, 64, 64, r % 2}; return t; } r -= I_G;
    { const int h = r / 2; t = TItem{p.in[11] + (size_t)(l * 8 + h) * 4096, nullptr, (bf16*)(ws + WS_GI) + (size_t)(l * 8 + h) * 4096, 64, 64, r % 2}; }
    return t;
}
constexpr int TITEMS_PER_LAYER = 16 * 48 + 16 * 32 + 16 * 128 + 64 * 32 + 4 * 8 + 2 * 8 * 2, TITEMS_IN = 16 * 48;
__device__ __forceinline__ void convert_items(const Params& p_, LAS unsigned char* lds, int it_lo, int it_hi, int wblock, int nworkers) {
    const Params p = launder(p_);
    int tid_ = threadIdx.x; asm volatile("" : "+v"(tid_));
    const int lane = tid_ & 63, wid = __builtin_amdgcn_readfirstlane(tid_ >> 6);
    LAS float* scr = (LAS float*)(lds + wid * 16384);
    const int worker = wblock * 8 + wid;
    if (it_lo + worker < it_hi) {
        TItem cur = titem_decode(p, it_lo + worker); f32x4 v[8]; float gs[8]; titem_load(cur, lane, v, gs);
        for (int it = it_lo + worker; it < it_hi; it += nworkers) {
            const bool more = it + nworkers < it_hi; TItem nxt = cur; f32x4 nv[8]; float ngs[8];
            if (more) { nxt = titem_decode(p, it + nworkers); titem_load(nxt, lane, nv, ngs); }
            titem_store(cur, lane, v, gs, scr);
            if (more) { cur = nxt;
#pragma unroll
                for (int i = 0; i < 8; ++i) { v[i] = nv[i]; gs[i] = ngs[i]; } }
        }
    }
}
__device__ __forceinline__ void prologue(const Params& p_, LAS unsigned char* lds, int G) {
    const Params p = launder(p_);
    int tid_ = threadIdx.x; asm volatile("" : "+v"(tid_));
    const int tid = tid_, lane = tid & 63, wid = __builtin_amdgcn_readfirstlane(tid >> 6);
    const int gw = blockIdx.x * 8 + wid, NGW = G * 8;
    unsigned char* ws = p.ws;
    convert_items(p_, lds, 0, G == 256 ? TITEMS_IN : DEPTH * TITEMS_PER_LAYER, (int)blockIdx.x, NGW);
    const float* x = p.in[0]; bf16* hb = (bf16*)(ws + WS_HB); float* ss = (float*)(ws + WS_SS);
    for (int m2 = gw; m2 < M / 2; m2 += NGW) {
        f32x4 v[2][4]; float s[2] = {0.f, 0.f};
#pragma unroll
        for (int r = 0; r < 2; ++r) { const f32x4* xr = (const f32x4*)(x + (size_t)(2 * m2 + r) * D) + lane;
#pragma unroll
            for (int j = 0; j < 4; ++j) v[r][j] = __builtin_nontemporal_load(xr + 64 * j); }
#pragma unroll
        for (int r = 0; r < 2; ++r) {
#pragma unroll
            for (int j = 0; j < 4; ++j) s[r] += (v[r][j].x * v[r][j].x + v[r][j].y * v[r][j].y) + (v[r][j].z * v[r][j].z + v[r][j].w * v[r][j].w);
            s[r] = wave_sum(s[r]);
            u32x2* o8 = (u32x2*)(hb + (size_t)(2 * m2 + r) * D) + lane;
#pragma unroll
            for (int j = 0; j < 4; ++j) { u32x2 w; w.x = cvt_pk(v[r][j].x, v[r][j].y); w.y = cvt_pk(v[r][j].z, v[r][j].w); o8[64 * j] = w; }
            if (lane < 16) ss[(size_t)(2 * m2 + r) * 16 + lane] = lane == 0 ? s[r] : 0.f;
        }
    }
    float* hm = (float*)(ws + WS_HMETA); float* sp = (float*)(ws + WS_SP);
    for (int i = blockIdx.x * 512 + tid; i < NMETA * D; i += G * 512) hm[i] = p.in[1][i];
    for (int i = blockIdx.x * 512 + tid; i < DEPTH * DH; i += G * 512) sp[i] = log1pf(expf(-p.in[13][i]));
}

template <int MODE, int NBATCH = 4> __device__ __forceinline__ void meta_tasks(const Params& p_, LAS unsigned char* lds, int G, const bf16* Ab, int lda, const bf16* Bt, int K, int ntasks) {
    const Params p = launder(p_);
    int tid_ = threadIdx.x; asm volatile("" : "+v"(tid_));
    const int tid = tid_, lane = tid & 63, wid = __builtin_amdgcn_readfirstlane(tid >> 6), fr = lane & 15, fq = lane >> 4;
    float* hm = (float*)(p.ws + WS_HMETA);
    LAS float* red = (LAS float*)lds;
    for (int task = G - 1 - (int)blockIdx.x; task < ntasks; task += G) {
        const int n0 = task * 16, kw = K / 8, k0 = wid * kw;
        f32x4 acc = {0.f, 0.f, 0.f, 0.f}; float ssq = 0.f;
        for (int kb = k0; kb < k0 + kw; kb += 32 * NBATCH) {
            bf16x8 af[NBATCH], bfr[NBATCH]; f32x4 a0[NBATCH], a1[NBATCH];
#pragma unroll
            for (int i = 0; i < NBATCH; ++i) { const int kk = kb + 32 * i;
                if (MODE == 1) af[i] = *(const bf16x8*)(Ab + (size_t)fr * lda + kk + 8 * fq);
                else { a0[i] = *(const f32x4*)(hm + fr * D + kk + 8 * fq); a1[i] = *(const f32x4*)(hm + fr * D + kk + 8 * fq + 4); }
                bfr[i] = *(const bf16x8*)(Bt + (size_t)(n0 + fr) * K + kk + 8 * fq); }
#pragma unroll
            for (int i = 0; i < NBATCH; ++i) {
                if (MODE != 1) { ssq += (a0[i].x * a0[i].x + a0[i].y * a0[i].y) + (a0[i].z * a0[i].z + a0[i].w * a0[i].w) + (a1[i].x * a1[i].x + a1[i].y * a1[i].y) + (a1[i].z * a1[i].z + a1[i].w * a1[i].w);
                    u32x4 w; w.x = cvt_pk(a0[i].x, a0[i].y); w.y = cvt_pk(a0[i].z, a0[i].w); w.z = cvt_pk(a1[i].x, a1[i].y); w.w = cvt_pk(a1[i].z, a1[i].w); af[i] = __builtin_bit_cast(bf16x8, w); }
                acc = __builtin_amdgcn_mfma_f32_16x16x32_bf16(bfr[i], af[i], acc, 0, 0, 0); }
        }
        ssq += __shfl_xor(ssq, 16); ssq += __shfl_xor(ssq, 32);
        LAS float* rp = red + (wid * 64 + lane) * 5;
        rp[0] = acc[0]; rp[1] = acc[1]; rp[2] = acc[2]; rp[3] = acc[3]; rp[4] = ssq;
        __syncthreads();
        if (wid == 0) {
            float a0 = 0.f, a1 = 0.f, a2 = 0.f, a3 = 0.f, sq = 0.f;
#pragma unroll
            for (int w = 0; w < 8; ++w) { const LAS float* q = red + (w * 64 + lane) * 5; a0 += q[0]; a1 += q[1]; a2 += q[2]; a3 += q[3]; sq += q[4]; }
            const int col = n0 + 4 * fq;
            if (MODE == 1) { f32x4* hp = (f32x4*)(hm + fr * D + col); f32x4 h = *hp; h.x += a0; h.y += a1; h.z += a2; h.w += a3; *hp = h; }
            else {
                const float rs = 1.0f / sqrtf(sq * (1.0f / D) + EPS); a0 *= rs; a1 *= rs; a2 *= rs; a3 *= rs;
                if (MODE == 0) { u32x2 w; w.x = cvt_pk(a0, a1); w.y = cvt_pk(a2, a3); bf16* pr = (bf16*)(p.ws + WS_PROJ);
                    *(u32x2*)(pr + (size_t)fr * DIN + col) = w; *(u32x2*)(pr + (size_t)(TT + fr) * DIN + col) = w; }
                else { a0 = fmaxf(a0, 0.f); a1 = fmaxf(a1, 0.f); a2 = fmaxf(a2, 0.f); a3 = fmaxf(a3, 0.f);
                    u32x2 w; w.x = cvt_pk(a0 * a0, a1 * a1); w.y = cvt_pk(a2 * a2, a3 * a3); *(u32x2*)((bf16*)(p.ws + WS_MIDMETA) + (size_t)fr * FF + col) = w; }
            }
        }
        __syncthreads();
    }
}

__device__ __forceinline__ void m1_phase(const Params& p_, LAS unsigned char* lds, int G, int l) {
    const Params p = launder(p_);
    int tid_ = threadIdx.x; asm volatile("" : "+v"(tid_));
    const int tid = tid_, lane = tid & 63, wid = __builtin_amdgcn_readfirstlane(tid >> 6), fr = lane & 15, fq = lane >> 4;
    LAS float* cst = (LAS float*)lds;
    for (int i = tid; i < 8 * DH; i += 512) { const int row = i >> 9, ch = i & 511; float v;
        if (row < 4) v = p.in[7][(l * 4 + row) * DH + ch]; else if (row == 4) v = p.in[8][l * DH + ch]; else if (row == 5) v = p.in[10][l * DH + ch];
        else if (row == 6) v = p.in[12][l * DH + ch]; else v = ((const float*)(p.ws + WS_SP))[l * DH + ch];
        cst[i] = v; }
    const bf16* proj = (const bf16*)(p.ws + WS_PROJ);
    const bf16* Wr = (const bf16*)(p.ws + WS_GR) + (size_t)(l * 8 + wid) * 4096; const bf16* Wi = (const bf16*)(p.ws + WS_GI) + (size_t)(l * 8 + wid) * 4096;
    LAS bf16x8* wl = (LAS bf16x8*)(lds + 16384 + wid * 16384) + lane;
#pragma unroll
    for (int n = 0; n < 4; ++n)
#pragma unroll
        for (int ks = 0; ks < 2; ++ks) {
            wl[((n * 2 + ks) * 2 + 0) * 64] = *(const bf16x8*)(Wr + outchan(n, fr) * 64 + 32 * ks + 8 * fq);
            wl[((n * 2 + ks) * 2 + 1) * 64] = *(const bf16x8*)(Wi + outchan(n, fr) * 64 + 32 * ks + 8 * fq); }
    __syncthreads();
    bf16* hl = (bf16*)(p.ws + WS_HL); bf16* Pp = (bf16*)(p.ws + WS_P);
    float* carA = (float*)(p.ws + WS_CARA); float* carH = (float*)(p.ws + WS_CARH);
    for (int unit = blockIdx.x; unit < 256; unit += G) {
        const int b = unit >> 7, c = unit & 127, t0 = c ? NMETA + 64 * c : 0, NM = c ? 4 : 5;
        float Hc[16], Pc[16];
#pragma unroll
        for (int k = 0; k < 16; ++k) { Hc[k] = 0.f; Pc[k] = 1.f; }
        u32x4 raw[2][4];
#pragma unroll
        for (int ks = 0; ks < 2; ++ks)
#pragma unroll
            for (int d = 0; d < 4; ++d) { const int tt = t0 + fr - 3 + d; raw[ks][d] = (u32x4){0u, 0u, 0u, 0u};
                if (tt >= 0) raw[ks][d] = *(const u32x4*)(proj + ((size_t)b * TT + tt) * DIN + DH + wid * 64 + 32 * ks + 8 * fq); }
#pragma unroll 1
        for (int m = 0; m < NM; ++m) {
            const int t = t0 + 16 * m + fr; const size_t rowg = (size_t)b * TT + t;
            u32x4 nraw[2][4];
#pragma unroll
            for (int ks = 0; ks < 2; ++ks)
#pragma unroll
                for (int d = 0; d < 4; ++d) { nraw[ks][d] = (u32x4){0u, 0u, 0u, 0u};
                    if (m + 1 < NM) nraw[ks][d] = *(const u32x4*)(proj + ((size_t)b * TT + t + 13 + d) * DIN + DH + wid * 64 + 32 * ks + 8 * fq); }
            float xc[2][8]; bf16x8 frag[2];
#pragma unroll
            for (int ks = 0; ks < 2; ++ks) {
                const int chb = wid * 64 + 32 * ks + 8 * fq;
                { const f32x4 c0 = *(const LAS f32x4*)(cst + 4 * DH + chb), c1 = *(const LAS f32x4*)(cst + 4 * DH + chb + 4);
                  xc[ks][0] = c0.x; xc[ks][1] = c0.y; xc[ks][2] = c0.z; xc[ks][3] = c0.w; xc[ks][4] = c1.x; xc[ks][5] = c1.y; xc[ks][6] = c1.z; xc[ks][7] = c1.w; }
#pragma unroll
                for (int d = 0; d < 4; ++d) {
                    float u[8]; unpack8(raw[ks][d], u);
                    const f32x4 w0 = *(const LAS f32x4*)(cst + d * DH + chb), w1 = *(const LAS f32x4*)(cst + d * DH + chb + 4);
                    xc[ks][0] += u[0] * w0.x; xc[ks][1] += u[1] * w0.y; xc[ks][2] += u[2] * w0.z; xc[ks][3] += u[3] * w0.w;
                    xc[ks][4] += u[4] * w1.x; xc[ks][5] += u[5] * w1.y; xc[ks][6] += u[6] * w1.z; xc[ks][7] += u[7] * w1.w;
                    raw[ks][d] = nraw[ks][d];
                }
                frag[ks] = __builtin_bit_cast(bf16x8, pack8(xc[ks]));
            }
            f32x4 ar[4], ai[4];
#pragma unroll
            for (int n = 0; n < 4; ++n) { ar[n] = (f32x4){0.f, 0.f, 0.f, 0.f}; ai[n] = (f32x4){0.f, 0.f, 0.f, 0.f};
#pragma unroll
                for (int ks = 0; ks < 2; ++ks) {
                    const bf16x8 wr_ = wl[((n * 2 + ks) * 2 + 0) * 64], wi_ = wl[((n * 2 + ks) * 2 + 1) * 64];
                    ar[n] = __builtin_amdgcn_mfma_f32_16x16x32_bf16(wr_, frag[ks], ar[n], 0, 0, 0);
                    ai[n] = __builtin_amdgcn_mfma_f32_16x16x32_bf16(wi_, frag[ks], ai[n], 0, 0, 0);
                } }
            float Aa[16], Bb[16];
#pragma unroll
            for (int n = 0; n < 4; ++n) {
                const int cho = wid * 64 + 32 * (n >> 1) + 8 * fq + 4 * (n & 1);
                const f32x4 rb = *(const LAS f32x4*)(cst + 5 * DH + cho), ib = *(const LAS f32x4*)(cst + 6 * DH + cho), spv = *(const LAS f32x4*)(cst + 7 * DH + cho);
#pragma unroll
                for (int jj = 0; jj < 4; ++jj) {
                    const float r = sigm(ar[n][jj] + rb[jj]), ig = sigm(ai[n][jj] + ib[jj]);
                    const float la = -8.0f * r * spv[jj], a = __expf(la), x2 = 2.0f * la;
                    const float m2s = -x2 * (1.0f + x2 * (0.5f + x2 * (0.16666667f + x2 * 0.041666668f))), m2 = (x2 > -0.0625f) ? m2s : 1.0f - a * a;
                    Aa[n * 4 + jj] = a; Bb[n * 4 + jj] = __builtin_amdgcn_sqrtf(m2) * ig * xc[n >> 1][4 * (n & 1) + jj];
                }
            }
#pragma unroll
            for (int k = 0; k < 16; ++k) {
                float A = Aa[k], B = Bb[k], Ap, Bq;
                Ap = dppf<0x111>(1.f, A); Bq = dppf<0x111>(0.f, B); B = fmaf(A, Bq, B); A *= Ap;
                Ap = dppf<0x112>(1.f, A); Bq = dppf<0x112>(0.f, B); B = fmaf(A, Bq, B); A *= Ap;
                Ap = dppf<0x114>(1.f, A); Bq = dppf<0x114>(0.f, B); B = fmaf(A, Bq, B); A *= Ap;
                Ap = dppf<0x118>(1.f, A); Bq = dppf<0x118>(0.f, B); B = fmaf(A, Bq, B); A *= Ap;
                Bb[k] = fmaf(A, Hc[k], B); Aa[k] = A * Pc[k];
            }
#pragma unroll
            for (int ks = 0; ks < 2; ++ks) {
                const size_t o = rowg * DH + wid * 64 + 32 * ks + 8 * fq;
                { u32x4 wh; wh.x = cvt_pk(Bb[8 * ks + 0], Bb[8 * ks + 1]); wh.y = cvt_pk(Bb[8 * ks + 2], Bb[8 * ks + 3]); wh.z = cvt_pk(Bb[8 * ks + 4], Bb[8 * ks + 5]); wh.w = cvt_pk(Bb[8 * ks + 6], Bb[8 * ks + 7]);
                  *(u32x4*)(hl + o) = wh; }
                u32x4 w; w.x = cvt_pk(Aa[8 * ks + 0], Aa[8 * ks + 1]); w.y = cvt_pk(Aa[8 * ks + 2], Aa[8 * ks + 3]); w.z = cvt_pk(Aa[8 * ks + 4], Aa[8 * ks + 5]); w.w = cvt_pk(Aa[8 * ks + 6], Aa[8 * ks + 7]);
                *(u32x4*)(Pp + o) = w;
            }
            const int src = (lane & 48) | 15;
#pragma unroll
            for (int k = 0; k < 16; ++k) { Hc[k] = __shfl(Bb[k], src); Pc[k] = __shfl(Aa[k], src); }
        }
        if (fr == 0) {
#pragma unroll
            for (int ks = 0; ks < 2; ++ks) {
                const size_t o = (size_t)(b * 128 + c) * DH + wid * 64 + 32 * ks + 8 * fq;
                *(f32x4*)(carA + o) = (f32x4){Pc[8 * ks + 0], Pc[8 * ks + 1], Pc[8 * ks + 2], Pc[8 * ks + 3]}; *(f32x4*)(carA + o + 4) = (f32x4){Pc[8 * ks + 4], Pc[8 * ks + 5], Pc[8 * ks + 6], Pc[8 * ks + 7]};
                *(f32x4*)(carH + o) = (f32x4){Hc[8 * ks + 0], Hc[8 * ks + 1], Hc[8 * ks + 2], Hc[8 * ks + 3]}; *(f32x4*)(carH + o + 4) = (f32x4){Hc[8 * ks + 4], Hc[8 * ks + 5], Hc[8 * ks + 6], Hc[8 * ks + 7]};
            }
        }
    }
    __syncthreads();
}


template <int NMR, bool FROM_LDS> __device__ __forceinline__ void m2_rnn_round(LAS unsigned char* lds, const bf16* hl, const bf16* Pp, const bf16* proj, bf16* Y, LAS float* red1, const float (&cr)[16], int b, int t0, int mbase, int wid, int fr, int fq) {
    u32x4 hw[NMR][2], pw[NMR][2], gw[NMR][2];
#pragma unroll
    for (int m = 0; m < NMR; ++m)
#pragma unroll
        for (int ks = 0; ks < 2; ++ks) { const size_t rowg = (size_t)b * TT + t0 + 16 * (mbase + m) + fr; const int ch = wid * 64 + 32 * ks + 8 * fq; const size_t o = rowg * DH + ch;
            if (FROM_LDS) { const int lane = fq * 16 + fr; hw[m][ks] = *(const LAS u32x4*)(lds + LDS_HL + wid * 8192 + (((mbase + m) * 2 + ks) * 64 + lane) * 16); pw[m][ks] = *(const LAS u32x4*)(lds + LDS_P + wid * 8192 + (((mbase + m) * 2 + ks) * 64 + lane) * 16); }
            else { hw[m][ks] = *(const u32x4*)(hl + o); pw[m][ks] = *(const u32x4*)(Pp + o); } gw[m][ks] = *(const u32x4*)(proj + rowg * DIN + 2 * DH + ch); }
    float y[NMR][16];
#pragma unroll
    for (int m = 0; m < NMR; ++m) { float s = 0.f;
#pragma unroll
        for (int ks = 0; ks < 2; ++ks) { float pf[8], gt[8]; unpack8(pw[m][ks], pf); unpack8(gw[m][ks], gt);
            float hh[8]; unpack8(hw[m][ks], hh);
#pragma unroll
            for (int e = 0; e < 8; ++e) { const float hv = fmaf(pf[e], cr[8 * ks + e], hh[e]), x = gt[e];
                const float ge = x * __builtin_amdgcn_rcpf(1.0f + __expf(-1.5957691216f * (x + 0.044715f * x * x * x)));
                const float yy = hv * ge; y[m][8 * ks + e] = yy; s = fmaf(yy, yy, s); } }
        s += __shfl_xor(s, 16); s += __shfl_xor(s, 32);
        if (fq == 0) red1[(16 * (mbase + m) + fr) * 8 + wid] = s; }
    __syncthreads();
#pragma unroll
    for (int m = 0; m < NMR; ++m) { const size_t rowg = (size_t)b * TT + t0 + 16 * (mbase + m) + fr;
        const f32x4 r0 = *(const LAS f32x4*)(red1 + (16 * (mbase + m) + fr) * 8), r1 = *(const LAS f32x4*)(red1 + (16 * (mbase + m) + fr) * 8 + 4);
        const float rs = __builtin_amdgcn_rsqf((((r0.x + r0.y) + (r0.z + r0.w)) + ((r1.x + r1.y) + (r1.z + r1.w))) * (1.0f / DH) + EPS);
#pragma unroll
        for (int ks = 0; ks < 2; ++ks) { float yy[8];
#pragma unroll
            for (int e = 0; e < 8; ++e) yy[e] = y[m][8 * ks + e] * rs;
            *(u32x4*)(Y + rowg * D + DH + wid * 64 + 32 * ks + 8 * fq) = pack8(yy); } }
}


template <int NMR> __device__ __forceinline__ void m2_pool_round(const bf16* proj, bf16* Y, const bf16* Wp, const float* pbias, const float* pscale, LAS float* red2,
                                                                  int b, int t0, int mbase, int g, int half, int kwin, int wid, int fr, int fq) {
    const int tb = t0 + 16 * mbase;
    bf16x8 pfr[NMR][4];
#pragma unroll
    for (int ks = 0; ks < 4; ++ks) {
        const int chb = g * 128 + 32 * ks + 8 * fq;
        float pu[8], p2[8], p4[8], p8[8];
        if (tb) { const u32x4 raw = *(const u32x4*)(proj + ((size_t)b * TT + tb - 16 + fr) * DIN + chb); unpack8(raw, pu);
#pragma unroll
            for (int e = 0; e < 8; ++e) { p2[e] = pu[e] + dppf<0x111>(0.f, pu[e]); p4[e] = p2[e] + dppf<0x112>(0.f, p2[e]); p8[e] = p4[e] + dppf<0x114>(0.f, p4[e]); } }
        else {
#pragma unroll
            for (int e = 0; e < 8; ++e) { pu[e] = 0.f; p2[e] = 0.f; p4[e] = 0.f; p8[e] = 0.f; } }
#pragma unroll
        for (int m = 0; m < NMR; ++m) {
            const int t = tb + 16 * m + fr; const size_t rowg = (size_t)b * TT + t;
            const u32x4 raw = *(const u32x4*)(proj + rowg * DIN + chb); float u[8], po[8]; unpack8(raw, u);
            const int cnt = (t + 1 < kwin) ? t + 1 : kwin; const float rc = __builtin_amdgcn_rcpf((float)cnt);
#pragma unroll
            for (int e = 0; e < 8; ++e) {
                const float s2 = u[e] + shiftd<1>(u[e], pu[e]), s4 = s2 + shiftd<2>(s2, p2[e]), s8 = s4 + shiftd<4>(s4, p4[e]), s16 = s8 + shiftd<8>(s8, p8[e]);
                const float win = g == 0 ? s2 : (g == 1 ? s4 : (g == 2 ? s8 : s16));
                po[e] = fmaf(win, rc, -u[e]); pu[e] = u[e]; p2[e] = s2; p4[e] = s4; p8[e] = s8;
            }
            pfr[m][ks] = __builtin_bit_cast(bf16x8, pack8(po));
        }
    }
    bf16x8 wfr[4][4];
#pragma unroll
    for (int n = 0; n < 4; ++n)
#pragma unroll
        for (int ks = 0; ks < 4; ++ks) wfr[n][ks] = *(const bf16x8*)(Wp + (size_t)(64 * half + outchan(n, fr)) * 128 + 32 * ks + 8 * fq);
#pragma unroll 1
    for (int pass = 0; pass < 2; ++pass) {
#pragma unroll
        for (int m = 0; m < NMR; ++m) {
            const int t = tb + 16 * m + fr; const size_t rowg = (size_t)b * TT + t; float s = 0.f, rs = 0.f;
            if (pass) { const f32x4 r0 = *(const LAS f32x4*)(red2 + (16 * (mbase + m) + fr) * 8), r1 = *(const LAS f32x4*)(red2 + (16 * (mbase + m) + fr) * 8 + 4);
                rs = __builtin_amdgcn_rsqf((((r0.x + r0.y) + (r0.z + r0.w)) + ((r1.x + r1.y) + (r1.z + r1.w))) * (1.0f / DH) + EPS); }
#pragma unroll
            for (int np = 0; np < 2; ++np) {
                f32x4 o2[2];
#pragma unroll
                for (int nn = 0; nn < 2; ++nn) { const int n = 2 * np + nn;
                    f32x4 acc = {0.f, 0.f, 0.f, 0.f};
#pragma unroll
                    for (int ks = 0; ks < 4; ++ks) acc = __builtin_amdgcn_mfma_f32_16x16x32_bf16(wfr[n][ks], pfr[m][ks], acc, 0, 0, 0);
                    const int col = g * 128 + 64 * half + 32 * np + 8 * fq + 4 * nn;
                    const f32x4 pb = *(const f32x4*)(pbias + col), ps = *(const f32x4*)(pscale + col);
                    acc = (acc + pb) * ps; s += (acc.x * acc.x + acc.y * acc.y) + (acc.z * acc.z + acc.w * acc.w); o2[nn] = acc * rs; }
                if (pass) { u32x4 w; w.x = cvt_pk(o2[0].x, o2[0].y); w.y = cvt_pk(o2[0].z, o2[0].w); w.z = cvt_pk(o2[1].x, o2[1].y); w.w = cvt_pk(o2[1].z, o2[1].w);
                    *(u32x4*)(Y + rowg * D + g * 128 + 64 * half + 32 * np + 8 * fq) = w; }
            }
            if (!pass) { s += __shfl_xor(s, 16); s += __shfl_xor(s, 32); if (fq == 0) red2[(16 * (mbase + m) + fr) * 8 + wid] = s; }
        }
        if (!pass) __syncthreads();
    }
}

__device__ __forceinline__ void m2_phase(const Params& p_, LAS unsigned char* lds, int G, int l) {
    const Params p = launder(p_);
    int tid_ = threadIdx.x; asm volatile("" : "+v"(tid_));
    const int tid = tid_, lane = tid & 63, wid = __builtin_amdgcn_readfirstlane(tid >> 6), fr = lane & 15, fq = lane >> 4;
    LAS float* segA = (LAS float*)lds; LAS float* segH = (LAS float*)(lds + 16384); LAS float* carr = (LAS float*)(lds + 32768);
    LAS float* red1 = (LAS float*)(lds + 34816); LAS float* red2 = (LAS float*)(lds + 37888);
    const bf16* proj = (const bf16*)(p.ws + WS_PROJ); bf16* Y = (bf16*)(p.ws + WS_Y);
    const bf16* hl = (const bf16*)(p.ws + WS_HL); const bf16* Pp = (const bf16*)(p.ws + WS_P);
    const float* carA = (const float*)(p.ws + WS_CARA); const float* carH = (const float*)(p.ws + WS_CARH);
    const int g = wid >> 1, half = wid & 1, kwin = 2 << g;
    const bf16* Wp = (const bf16*)(p.ws + WS_POOLW) + (size_t)(l * 4 + g) * 16384;
    const float* pbias = p.in[5] + l * DH; const float* pscale = p.in[6] + l * DH;
    for (int unit = blockIdx.x; unit < 256; unit += G) {
        const int b = unit >> 7, c = unit & 127, t0 = c ? NMETA + 64 * c : 0, NM = c ? 4 : 5;
        {
            const int q = (c + 7) >> 3, jlo = wid * q, jhi = (jlo + q < c) ? jlo + q : c;
            f32x4 A0 = {1.f, 1.f, 1.f, 1.f}, A1 = A0, H0 = {0.f, 0.f, 0.f, 0.f}, H1 = H0;
            for (int j = jlo; j < jhi; j += 8) {
                f32x4 a0[8], a1[8], h0[8], h1[8];
#pragma unroll
                for (int i = 0; i < 8; ++i) { const int jj = (j + i < jhi) ? j + i : jhi - 1; const size_t o = (size_t)(b * 128 + jj) * DH + 8 * lane;
                    a0[i] = *(const f32x4*)(carA + o); a1[i] = *(const f32x4*)(carA + o + 4); h0[i] = *(const f32x4*)(carH + o); h1[i] = *(const f32x4*)(carH + o + 4); }
#pragma unroll
                for (int i = 0; i < 8; ++i) if (j + i < jhi) { H0 = a0[i] * H0 + h0[i]; A0 = A0 * a0[i]; H1 = a1[i] * H1 + h1[i]; A1 = A1 * a1[i]; }
            }
            *(LAS f32x4*)(segA + wid * DH + 8 * lane) = A0; *(LAS f32x4*)(segA + wid * DH + 8 * lane + 4) = A1;
            *(LAS f32x4*)(segH + wid * DH + 8 * lane) = H0; *(LAS f32x4*)(segH + wid * DH + 8 * lane + 4) = H1;
        }
        __syncthreads();
        { float cy = 0.f;
#pragma unroll
          for (int s8 = 0; s8 < 8; ++s8) cy = segA[s8 * DH + tid] * cy + segH[s8 * DH + tid];
          carr[tid] = cy; }
        __syncthreads();
        {
            float cr[16];
#pragma unroll
            for (int ks = 0; ks < 2; ++ks) { const f32x4 c0 = *(const LAS f32x4*)(carr + wid * 64 + 32 * ks + 8 * fq), c1 = *(const LAS f32x4*)(carr + wid * 64 + 32 * ks + 8 * fq + 4);
                cr[8 * ks + 0] = c0.x; cr[8 * ks + 1] = c0.y; cr[8 * ks + 2] = c0.z; cr[8 * ks + 3] = c0.w; cr[8 * ks + 4] = c1.x; cr[8 * ks + 5] = c1.y; cr[8 * ks + 6] = c1.z; cr[8 * ks + 7] = c1.w; }
            m2_rnn_round<4, false>(lds, hl, Pp, proj, Y, red1, cr, b, t0, 0, wid, fr, fq);
            if (NM == 5) m2_rnn_round<1, false>(lds, hl, Pp, proj, Y, red1, cr, b, t0, 4, wid, fr, fq);
        }
        m2_pool_round<4>(proj, Y, Wp, pbias, pscale, red2, b, t0, 0, g, half, kwin, wid, fr, fq);
        if (NM == 5) m2_pool_round<1>(proj, Y, Wp, pbias, pscale, red2, b, t0, 4, g, half, kwin, wid, fr, fq);
    }
    __syncthreads();
}

__device__ __forceinline__ void final_norm(const Params& p_, int G) {
    const Params p = launder(p_);
    int tid_ = threadIdx.x; asm volatile("" : "+v"(tid_));
    const int tid = tid_, lane = tid & 63, wid = tid >> 6; const int gw = blockIdx.x * 8 + wid, NGW = G * 8;
    const bf16* hb = (const bf16*)(p.ws + WS_HB);
    const f32x4* gp = (const f32x4*)p.in[19] + 2 * lane; f32x4 gg[2][2];
#pragma unroll
    for (int j = 0; j < 2; ++j) { gg[j][0] = gp[128 * j]; gg[j][1] = gp[128 * j + 1]; }
    for (int m = gw; m < M; m += NGW) {
        const u32x4* xr = (const u32x4*)(hb + (size_t)m * D) + lane; float v[2][8]; float s = 0.f;
#pragma unroll
        for (int j = 0; j < 2; ++j) { unpack8(xr[64 * j], v[j]);
#pragma unroll
            for (int e = 0; e < 8; ++e) s = fmaf(v[j][e], v[j][e], s); }
        const float rs = 1.0f / sqrtf(wave_sum(s) * (1.0f / D) + EPS);
        f32x4* orow = (f32x4*)(p.out + (size_t)m * D) + 2 * lane;
#pragma unroll
        for (int j = 0; j < 2; ++j) {
            __builtin_nontemporal_store((f32x4){v[j][0] * rs * gg[j][0].x, v[j][1] * rs * gg[j][0].y, v[j][2] * rs * gg[j][0].z, v[j][3] * rs * gg[j][0].w}, orow + 128 * j);
            __builtin_nontemporal_store((f32x4){v[j][4] * rs * gg[j][1].x, v[j][5] * rs * gg[j][1].y, v[j][6] * rs * gg[j][1].z, v[j][7] * rs * gg[j][1].w}, orow + 128 * j + 1); }
    }
}


template <int KW> __device__ __forceinline__ float pool_win(float P, float Sp) {
    float w = P;
    if (KW < 16) w -= dppf<0x110 + (KW & 15)>(0.f, P);
    return w + dppf<0x100 + (17 - KW)>(0.f, Sp);
}
template <int KW, int MAXG> __device__ __forceinline__ void pool_frags(const bf16* proj, bf16x8 (&pfr)[MAXG][4], int b, int tb, int cnt, int g, int fr, int fq) {
#pragma unroll
    for (int ks = 0; ks < 4; ++ks) {
        const int chb = g * 128 + 32 * ks + 8 * fq;
        float Sp[8];
        if (tb) { const u32x4 raw = *(const u32x4*)(proj + ((size_t)b * TT + tb - 16 + fr) * DIN + chb); unpack8(raw, Sp);
#pragma unroll
            for (int e = 0; e < 8; ++e) { Sp[e] += dppf<0x101>(0.f, Sp[e]); Sp[e] += dppf<0x102>(0.f, Sp[e]); Sp[e] += dppf<0x104>(0.f, Sp[e]); Sp[e] += dppf<0x108>(0.f, Sp[e]); } }
        else {
#pragma unroll
            for (int e = 0; e < 8; ++e) Sp[e] = 0.f; }
#pragma unroll
        for (int mi = 0; mi < MAXG; ++mi) if (mi < cnt) {
            const int t = tb + 16 * mi + fr;
            const u32x4 raw = *(const u32x4*)(proj + ((size_t)b * TT + t) * DIN + chb); float u[8], po[8]; unpack8(raw, u);
            const int cn = (t + 1 < KW) ? t + 1 : KW; const float rc = __builtin_amdgcn_rcpf((float)cn);
#pragma unroll
            for (int e = 0; e < 8; ++e) {
                float P = u[e]; P += dppf<0x111>(0.f, P); P += dppf<0x112>(0.f, P); P += dppf<0x114>(0.f, P); P += dppf<0x118>(0.f, P);
                float S = u[e]; S += dppf<0x101>(0.f, S); S += dppf<0x102>(0.f, S); S += dppf<0x104>(0.f, S); S += dppf<0x108>(0.f, S);
                po[e] = fmaf(pool_win<KW>(P, Sp[e]), rc, -u[e]); Sp[e] = S;
            }
            pfr[mi][ks] = __builtin_bit_cast(bf16x8, pack8(po));
        }
    }
}
__device__ __forceinline__ void m2_pool2(const bf16* proj, bf16* Y, const bf16* Wp, const float* pbias, const float* pscale, LAS float* red2, int b, int t0, int NM, int g, int th, int fr, int fq) {
    const int m0 = th ? (NM == 5 ? 3 : 2) : 0, cnt = th ? 2 : (NM == 5 ? 3 : 2), tb = t0 + 16 * m0;
    bf16x8 pfr[3][4];
    switch (g) {
        case 0: pool_frags<2, 3>(proj, pfr, b, tb, cnt, g, fr, fq); break;
        case 1: pool_frags<4, 3>(proj, pfr, b, tb, cnt, g, fr, fq); break;
        case 2: pool_frags<8, 3>(proj, pfr, b, tb, cnt, g, fr, fq); break;
        default: pool_frags<16, 3>(proj, pfr, b, tb, cnt, g, fr, fq); break;
    }
    f32x4 ov[3][8]; float sq[3] = {0.f, 0.f, 0.f};
#pragma unroll
    for (int n = 0; n < 8; ++n) {
        bf16x8 wf[4];
#pragma unroll
        for (int ks = 0; ks < 4; ++ks) wf[ks] = *(const bf16x8*)(Wp + (size_t)outchan(n, fr) * 128 + 32 * ks + 8 * fq);
        const int col = g * 128 + 32 * (n >> 1) + 8 * fq + 4 * (n & 1);
        const f32x4 pb = *(const f32x4*)(pbias + col), ps = *(const f32x4*)(pscale + col);
#pragma unroll
        for (int mi = 0; mi < 3; ++mi) if (mi < cnt) {
            f32x4 acc = {0.f, 0.f, 0.f, 0.f};
#pragma unroll
            for (int ks = 0; ks < 4; ++ks) acc = __builtin_amdgcn_mfma_f32_16x16x32_bf16(wf[ks], pfr[mi][ks], acc, 0, 0, 0);
            acc = (acc + pb) * ps; ov[mi][n] = acc; sq[mi] += (acc.x * acc.x + acc.y * acc.y) + (acc.z * acc.z + acc.w * acc.w);
        }
    }
#pragma unroll
    for (int mi = 0; mi < 3; ++mi) if (mi < cnt) { float s = sq[mi]; s += __shfl_xor(s, 16); s += __shfl_xor(s, 32); if (fq == 0) red2[(16 * (m0 + mi) + fr) * 4 + g] = s; }
    __syncthreads();
#pragma unroll
    for (int mi = 0; mi < 3; ++mi) if (mi < cnt) {
        const size_t rowg = (size_t)b * TT + tb + 16 * mi + fr;
        const f32x4 r0 = *(const LAS f32x4*)(red2 + (16 * (m0 + mi) + fr) * 4);
        const float rs = __builtin_amdgcn_rsqf(((r0.x + r0.y) + (r0.z + r0.w)) * (1.0f / DH) + EPS);
#pragma unroll
        for (int np = 0; np < 4; ++np) {
            const f32x4 a = ov[mi][2 * np] * rs, bq = ov[mi][2 * np + 1] * rs;
            u32x4 w; w.x = cvt_pk(a.x, a.y); w.y = cvt_pk(a.z, a.w); w.z = cvt_pk(bq.x, bq.y); w.w = cvt_pk(bq.z, bq.w);
            *(u32x4*)(Y + rowg * D + g * 128 + 32 * np + 8 * fq) = w;
        }
    }
}

#ifndef PROBE_PHASE
#define PROBE_PHASE (-1)
#endif
#ifndef PROBE_BLOCK
#define PROBE_BLOCK 0
#endif
#define TIC() do { if (PROBE_PHASE >= 0) tic = __builtin_amdgcn_s_memrealtime(); } while (0)
#define TOC(k) do { if (PROBE_PHASE == (k)) tacc += __builtin_amdgcn_s_memrealtime() - tic; } while (0)

__device__ __forceinline__ void mixer_phase(const Params& p_, LAS unsigned char* lds, int G, int l, unsigned long long& tic, unsigned long long& tacc) {
    const Params p = launder(p_);
    int tid_ = threadIdx.x; asm volatile("" : "+v"(tid_));
    const int tid = tid_, lane = tid & 63, wid = __builtin_amdgcn_readfirstlane(tid >> 6), fr = lane & 15, fq = lane >> 4;
    LAS float* cst = (LAS float*)(lds + LDS_CST);
    const bf16* proj = (const bf16*)(p.ws + WS_PROJ);
    const bf16* Wr = (const bf16*)(p.ws + WS_GR) + (size_t)(l * 8 + wid) * 4096; const bf16* Wi = (const bf16*)(p.ws + WS_GI) + (size_t)(l * 8 + wid) * 4096;
    LAS float* segA = (LAS float*)(lds + LDS_CST); LAS float* segH = (LAS float*)(lds + LDS_CST + 8192); LAS float* carr = (LAS float*)(lds + LDS_CARR);
    LAS float* red1 = (LAS float*)(lds + LDS_RED1); LAS float* red2 = (LAS float*)(lds + LDS_RED2);
    bf16* Y = (bf16*)(p.ws + WS_Y);
    const int g = wid >> 1, half = wid & 1, kwin = 2 << g;
    const bf16* Wp = (const bf16*)(p.ws + WS_POOLW) + (size_t)(l * 4 + g) * 16384;
    const float* pbias = p.in[5] + l * DH; const float* pscale = p.in[6] + l * DH;
    unsigned* flags = (unsigned*)(p.ws + WS_FLAG); unsigned* car = (unsigned*)(p.ws + WS_CARA);
    bf16* hl = (bf16*)(p.ws + WS_HL); bf16* Pp = (bf16*)(p.ws + WS_P);
    float* carA = (float*)(p.ws + WS_CARA); float* carH = (float*)(p.ws + WS_CARH);
    const int unit = blockIdx.x;
    if (unit < 256) {
        const int b = unit >> 7, c = unit & 127, t0 = c ? NMETA + 64 * c : 0, NM = c ? 4 : 5;
        TIC();
        float cv[8];
#pragma unroll
        for (int k4 = 0; k4 < 4; ++k4) cv[k4] = p.in[7][(l * 4 + k4) * DH + tid];
        cv[4] = p.in[8][l * DH + tid]; cv[5] = p.in[10][l * DH + tid]; cv[6] = p.in[12][l * DH + tid]; cv[7] = ((const float*)(p.ws + WS_SP))[l * DH + tid];
        bf16x8 wfr[4][2][2];
#pragma unroll
        for (int n = 0; n < 4; ++n)
#pragma unroll
            for (int ks = 0; ks < 2; ++ks) { wfr[n][ks][0] = *(const bf16x8*)(Wr + outchan(n, fr) * 64 + 32 * ks + 8 * fq); wfr[n][ks][1] = *(const bf16x8*)(Wi + outchan(n, fr) * 64 + 32 * ks + 8 * fq); }
        LAS float* cslot = (LAS float*)(lds + LDS_CARRY) + (wid * 4 + fq) * 32;
        if (fr == 15) {
#pragma unroll
            for (int k4 = 0; k4 < 4; ++k4) { *(LAS f32x4*)(cslot + 4 * k4) = (f32x4){0.f, 0.f, 0.f, 0.f}; *(LAS f32x4*)(cslot + 16 + 4 * k4) = (f32x4){1.f, 1.f, 1.f, 1.f}; } }
        u32x4 raw[2][4];
#pragma unroll
        for (int ks = 0; ks < 2; ++ks)
#pragma unroll
            for (int d = 0; d < 4; ++d) { const int tt = t0 + fr - 3 + d; raw[ks][d] = (u32x4){0u, 0u, 0u, 0u};
                if (tt >= 0) raw[ks][d] = *(const u32x4*)(proj + ((size_t)b * TT + tt) * DIN + DH + wid * 64 + 32 * ks + 8 * fq); }
        __syncthreads();
#pragma unroll
        for (int k8 = 0; k8 < 8; ++k8) cst[k8 * DH + tid] = cv[k8];
        __syncthreads();
        TOC(10); TIC();
#pragma unroll 1
        for (int m = 0; m < NM; ++m) {
            const int t = t0 + 16 * m + fr; const size_t rowg = (size_t)b * TT + t;
            u32x4 nraw[2][4];
#pragma unroll
            for (int ks = 0; ks < 2; ++ks)
#pragma unroll
                for (int d = 0; d < 4; ++d) { nraw[ks][d] = (u32x4){0u, 0u, 0u, 0u};
                    if (m + 1 < NM) nraw[ks][d] = *(const u32x4*)(proj + ((size_t)b * TT + t + 13 + d) * DIN + DH + wid * 64 + 32 * ks + 8 * fq); }
            float xc[2][8]; bf16x8 frag[2];
#pragma unroll
            for (int ks = 0; ks < 2; ++ks) {
                const int chb = wid * 64 + 32 * ks + 8 * fq;
                { const f32x4 c0 = *(const LAS f32x4*)(cst + 4 * DH + chb), c1 = *(const LAS f32x4*)(cst + 4 * DH + chb + 4);
                  xc[ks][0] = c0.x; xc[ks][1] = c0.y; xc[ks][2] = c0.z; xc[ks][3] = c0.w; xc[ks][4] = c1.x; xc[ks][5] = c1.y; xc[ks][6] = c1.z; xc[ks][7] = c1.w; }
#pragma unroll
                for (int d = 0; d < 4; ++d) {
                    float u[8]; unpack8(raw[ks][d], u);
                    const f32x4 w0 = *(const LAS f32x4*)(cst + d * DH + chb), w1 = *(const LAS f32x4*)(cst + d * DH + chb + 4);
                    xc[ks][0] += u[0] * w0.x; xc[ks][1] += u[1] * w0.y; xc[ks][2] += u[2] * w0.z; xc[ks][3] += u[3] * w0.w;
                    xc[ks][4] += u[4] * w1.x; xc[ks][5] += u[5] * w1.y; xc[ks][6] += u[6] * w1.z; xc[ks][7] += u[7] * w1.w;
                    raw[ks][d] = nraw[ks][d];
                }
                frag[ks] = __builtin_bit_cast(bf16x8, pack8(xc[ks]));
            }
            f32x4 ar[4], ai[4];
#pragma unroll
            for (int n = 0; n < 4; ++n) { ar[n] = (f32x4){0.f, 0.f, 0.f, 0.f}; ai[n] = (f32x4){0.f, 0.f, 0.f, 0.f};
#pragma unroll
                for (int ks = 0; ks < 2; ++ks) {
                    const bf16x8 wr_ = wfr[n][ks][0], wi_ = wfr[n][ks][1];
                    ar[n] = __builtin_amdgcn_mfma_f32_16x16x32_bf16(wr_, frag[ks], ar[n], 0, 0, 0);
                    ai[n] = __builtin_amdgcn_mfma_f32_16x16x32_bf16(wi_, frag[ks], ai[n], 0, 0, 0);
                } }
            float Aa[16], Bb[16];
#pragma unroll
            for (int n = 0; n < 4; ++n) {
                const int cho = wid * 64 + 32 * (n >> 1) + 8 * fq + 4 * (n & 1);
                const f32x4 rb = *(const LAS f32x4*)(cst + 5 * DH + cho), ib = *(const LAS f32x4*)(cst + 6 * DH + cho), spv = *(const LAS f32x4*)(cst + 7 * DH + cho);
#pragma unroll
                for (int jj = 0; jj < 4; ++jj) {
                    const float r = sigm(ar[n][jj] + rb[jj]), ig = sigm(ai[n][jj] + ib[jj]);
                    const float la = -8.0f * r * spv[jj], a = __expf(la), x2 = 2.0f * la;
                    const float m2s = -x2 * (1.0f + x2 * (0.5f + x2 * (0.16666667f + x2 * 0.041666668f))), m2 = (x2 > -0.0625f) ? m2s : 1.0f - a * a;
                    Aa[n * 4 + jj] = a; Bb[n * 4 + jj] = __builtin_amdgcn_sqrtf(m2) * ig * xc[n >> 1][4 * (n & 1) + jj];
                }
            }
#pragma unroll
            for (int k = 0; k < 16; ++k) {
                float A = Aa[k], B = Bb[k], Ap, Bq;
                Ap = dppf<0x111>(1.f, A); Bq = dppf<0x111>(0.f, B); B = fmaf(A, Bq, B); A *= Ap;
                Ap = dppf<0x112>(1.f, A); Bq = dppf<0x112>(0.f, B); B = fmaf(A, Bq, B); A *= Ap;
                Ap = dppf<0x114>(1.f, A); Bq = dppf<0x114>(0.f, B); B = fmaf(A, Bq, B); A *= Ap;
                Ap = dppf<0x118>(1.f, A); Bq = dppf<0x118>(0.f, B); B = fmaf(A, Bq, B); A *= Ap;
                Bb[k] = B; Aa[k] = A;
            }
            {
                float Hc[16], Pc[16];
#pragma unroll
                for (int k4 = 0; k4 < 4; ++k4) { const f32x4 hq = *(const LAS f32x4*)(cslot + 4 * k4), pq = *(const LAS f32x4*)(cslot + 16 + 4 * k4);
                    Hc[4 * k4] = hq.x; Hc[4 * k4 + 1] = hq.y; Hc[4 * k4 + 2] = hq.z; Hc[4 * k4 + 3] = hq.w; Pc[4 * k4] = pq.x; Pc[4 * k4 + 1] = pq.y; Pc[4 * k4 + 2] = pq.z; Pc[4 * k4 + 3] = pq.w; }
#pragma unroll
                for (int k = 0; k < 16; ++k) { Bb[k] = fmaf(Aa[k], Hc[k], Bb[k]); Aa[k] *= Pc[k]; }
                if (fr == 15) {
#pragma unroll
                    for (int k4 = 0; k4 < 4; ++k4) { *(LAS f32x4*)(cslot + 4 * k4) = (f32x4){Bb[4 * k4], Bb[4 * k4 + 1], Bb[4 * k4 + 2], Bb[4 * k4 + 3]}; *(LAS f32x4*)(cslot + 16 + 4 * k4) = (f32x4){Aa[4 * k4], Aa[4 * k4 + 1], Aa[4 * k4 + 2], Aa[4 * k4 + 3]}; } }
            }
#pragma unroll
            for (int ks = 0; ks < 2; ++ks) {
                const size_t o = rowg * DH + wid * 64 + 32 * ks + 8 * fq;
                u32x4 wh; wh.x = cvt_pk(Bb[8 * ks + 0], Bb[8 * ks + 1]); wh.y = cvt_pk(Bb[8 * ks + 2], Bb[8 * ks + 3]); wh.z = cvt_pk(Bb[8 * ks + 4], Bb[8 * ks + 5]); wh.w = cvt_pk(Bb[8 * ks + 6], Bb[8 * ks + 7]);
                u32x4 w; w.x = cvt_pk(Aa[8 * ks + 0], Aa[8 * ks + 1]); w.y = cvt_pk(Aa[8 * ks + 2], Aa[8 * ks + 3]); w.z = cvt_pk(Aa[8 * ks + 4], Aa[8 * ks + 5]); w.w = cvt_pk(Aa[8 * ks + 6], Aa[8 * ks + 7]);
                if (m < 4) { *(LAS u32x4*)(lds + LDS_HL + wid * 8192 + ((m * 2 + ks) * 64 + lane) * 16) = wh; *(LAS u32x4*)(lds + LDS_P + wid * 8192 + ((m * 2 + ks) * 64 + lane) * 16) = w; }
                else { *(u32x4*)(hl + o) = wh; *(u32x4*)(Pp + o) = w; }
            }
        }
        TOC(11); TIC();
        if (fr == 0) {
            float Hc[16], Pc[16];
#pragma unroll
            for (int k4 = 0; k4 < 4; ++k4) { const f32x4 hq = *(const LAS f32x4*)(cslot + 4 * k4), pq = *(const LAS f32x4*)(cslot + 16 + 4 * k4);
                Hc[4 * k4] = hq.x; Hc[4 * k4 + 1] = hq.y; Hc[4 * k4 + 2] = hq.z; Hc[4 * k4 + 3] = hq.w; Pc[4 * k4] = pq.x; Pc[4 * k4 + 1] = pq.y; Pc[4 * k4 + 2] = pq.z; Pc[4 * k4 + 3] = pq.w; }
#pragma unroll
            for (int ks = 0; ks < 2; ++ks) {
                const size_t o = (size_t)(b * 128 + c) * DH + wid * 64 + 32 * ks + 8 * fq;
#pragma unroll
                for (int e2 = 0; e2 < 4; ++e2) {
                    const unsigned lo = cvt_pk(Pc[8 * ks + 2 * e2], Hc[8 * ks + 2 * e2]), hi = cvt_pk(Pc[8 * ks + 2 * e2 + 1], Hc[8 * ks + 2 * e2 + 1]);
                    __hip_atomic_store((unsigned long long*)(car + o) + e2, ((unsigned long long)hi << 32) | lo, __ATOMIC_RELAXED, __HIP_MEMORY_SCOPE_AGENT); }
            }
        }
        int fr2 = fr, fq2 = fq, tid2 = tid; asm volatile("" : "+v"(fr2), "+v"(fq2), "+v"(tid2));
        TOC(12); TIC();
#ifndef NO_MX_POOL
        m2_pool2(proj, Y, Wp, pbias, pscale, red2, b, t0, NM, g, half, fr2, fq2);
#endif
        asm volatile("s_waitcnt vmcnt(0)" ::: "memory");
        __syncthreads();
        if (tid2 == 0) __hip_atomic_store(flags + unit, (unsigned)(l + 1), __ATOMIC_RELAXED, __HIP_MEMORY_SCOPE_AGENT);
        TOC(13); TIC();
        if (tid2 < c) { unsigned sp = 0; while (__hip_atomic_load(flags + b * 128 + tid2, __ATOMIC_RELAXED, __HIP_MEMORY_SCOPE_AGENT) < (unsigned)(l + 1)) { __builtin_amdgcn_s_sleep(2); if (++sp > (1u << 22)) break; } }
#if defined(MIXER_ACQ_FENCE)
        if (tid2 < c) __builtin_amdgcn_fence(__ATOMIC_ACQUIRE, "agent");
#endif
        __syncthreads();
        TOC(14); TIC();
        {
            const int q = (c + 3) >> 2, seg = tid2 >> 7, cgi = tid2 & 127, jlo = seg * q, jhi = (jlo + q < c) ? jlo + q : c;
            f32x4 A0 = {1.f, 1.f, 1.f, 1.f}, H0 = {0.f, 0.f, 0.f, 0.f};
            for (int j = jlo; j < jhi; j += 16) {
                unsigned long long w0[16], w1[16];
#pragma unroll
                for (int i = 0; i < 16; ++i) { const int jj = (j + i < jhi) ? j + i : jhi - 1; const size_t o = (size_t)(b * 128 + jj) * DH + 4 * cgi;
                    w0[i] = __hip_atomic_load((const unsigned long long*)(car + o), __ATOMIC_RELAXED, __HIP_MEMORY_SCOPE_AGENT); w1[i] = __hip_atomic_load((const unsigned long long*)(car + o) + 1, __ATOMIC_RELAXED, __HIP_MEMORY_SCOPE_AGENT); }
#pragma unroll
                for (int i = 0; i < 16; ++i) if (j + i < jhi) {
                    const f32x4 a = {bf_lo((unsigned)w0[i]), bf_lo((unsigned)(w0[i] >> 32)), bf_lo((unsigned)w1[i]), bf_lo((unsigned)(w1[i] >> 32))};
                    const f32x4 h = {bf_hi((unsigned)w0[i]), bf_hi((unsigned)(w0[i] >> 32)), bf_hi((unsigned)w1[i]), bf_hi((unsigned)(w1[i] >> 32))};
                    H0 = a * H0 + h; A0 = A0 * a; }
            }
            *(LAS f32x4*)(segA + seg * DH + 4 * cgi) = A0; *(LAS f32x4*)(segH + seg * DH + 4 * cgi) = H0;
        }
        __syncthreads();
        { float cy = 0.f;
#pragma unroll
          for (int s4 = 0; s4 < 4; ++s4) cy = segA[s4 * DH + tid2] * cy + segH[s4 * DH + tid2];
          carr[tid2] = cy; }
        __syncthreads();
        TOC(15); TIC();
        {
            float cr[16];
#pragma unroll
            for (int ks = 0; ks < 2; ++ks) { const f32x4 c0 = *(const LAS f32x4*)(carr + wid * 64 + 32 * ks + 8 * fq2), c1 = *(const LAS f32x4*)(carr + wid * 64 + 32 * ks + 8 * fq2 + 4);
                cr[8 * ks + 0] = c0.x; cr[8 * ks + 1] = c0.y; cr[8 * ks + 2] = c0.z; cr[8 * ks + 3] = c0.w; cr[8 * ks + 4] = c1.x; cr[8 * ks + 5] = c1.y; cr[8 * ks + 6] = c1.z; cr[8 * ks + 7] = c1.w; }
#ifndef NO_MX_RNN
            m2_rnn_round<4, true>(lds, hl, Pp, proj, Y, red1, cr, b, t0, 0, wid, fr2, fq2);
            if (NM == 5) m2_rnn_round<1, false>(lds, hl, Pp, proj, Y, red1, cr, b, t0, 4, wid, fr2, fq2);
#endif
        }
        TOC(16);
    }
    __syncthreads();
}

#define XB_TMO      128
#define XB_XCNT(j)  (256  + 64 * (j))
#define XB_XSUB(j)  (1280 + 64 * (j))
#define XB_XGEN(j)  (2304 + 64 * (j))
#define XB_TOP      3328
#define XB_TOPGEN   3392
#define XCD_BAR_WORDS 3456
#define XB_SPIN_CAP (1u << 18)

__device__ __forceinline__ unsigned xb_ld(unsigned* p)              { return __hip_atomic_load(p, __ATOMIC_RELAXED, __HIP_MEMORY_SCOPE_AGENT); }
__device__ __forceinline__ unsigned xb_add(unsigned* p, unsigned v) { return __hip_atomic_fetch_add(p, v, __ATOMIC_RELAXED, __HIP_MEMORY_SCOPE_AGENT); }
__device__ __forceinline__ unsigned xb_xcc_id() { return (unsigned)__builtin_amdgcn_s_getreg((3 << 11) | 20) & 0xFu; }
#define XB_SPIN(cond, bar) do { unsigned _sp = 0; while (cond) { __builtin_amdgcn_s_sleep(1); \
    if ((++_sp & 255u) == 0u) { if (xb_ld(&(bar)[XB_TMO])) break; if (_sp > XB_SPIN_CAP) { atomicAdd(&(bar)[XB_TMO], 1u); break; } } } } while (0)

struct XcdBarrier {
    unsigned* bar; unsigned x;
    volatile LAS unsigned* st;
};

__device__ __forceinline__ XcdBarrier xcd_barrier_post(unsigned* bar, volatile LAS unsigned* st) {
    XcdBarrier b; b.bar = bar; b.x = xb_xcc_id(); b.st = st;
    if (threadIdx.x == 0) (void)xb_add(&bar[XB_XCNT(b.x)], 1u);
    return b;
}
__device__ __forceinline__ void xcd_barrier_complete(unsigned* bar, unsigned x, unsigned& nloc, unsigned& nx) {
    const unsigned G = gridDim.x * gridDim.y * gridDim.z;
    unsigned sum, cnt, mine, sp = 0u;
    for (;;) {
        sum = 0u; cnt = 0u; mine = 0u;
#pragma unroll
        for (unsigned j = 0; j < 16; ++j) { const unsigned c = xb_ld(&bar[XB_XCNT(j)]); sum += c; cnt += (c > 0u) ? 1u : 0u; mine = (j == x) ? c : mine; }
        if (sum == G) break;
        __builtin_amdgcn_s_sleep(1);
        if ((++sp & 255u) == 0u) { if (xb_ld(&bar[XB_TMO])) break; if (sp > XB_SPIN_CAP) { atomicAdd(&bar[XB_TMO], 1u); break; } }
    }
    nloc = mine > 0u ? mine : 1u; nx = cnt > 0u ? cnt : 1u;
}

__device__ __forceinline__ void xcd_barrier(const XcdBarrier& b) {
    asm volatile("s_waitcnt vmcnt(0)" ::: "memory");
    __syncthreads();
    if (threadIdx.x == 0) {
        unsigned* bar = b.bar;
        __builtin_amdgcn_s_waitcnt(0);
        unsigned nloc = b.st[0], nx = b.st[1];
        if (nloc == 0u) { xcd_barrier_complete(bar, b.x, nloc, nx); b.st[0] = nloc; b.st[1] = nx; }
        const unsigned old = xb_add(&bar[XB_XSUB(b.x)], 1u);
        const unsigned gen = old / nloc;
        if (old + 1u == (gen + 1u) * nloc) {
            __builtin_amdgcn_fence(__ATOMIC_RELEASE, "agent");
            asm volatile("s_waitcnt vmcnt(0)" ::: "memory");
            const unsigned og = xb_add(&bar[XB_TOP], 1u);
            const unsigned tg = og / nx;
            if (og + 1u == (tg + 1u) * nx) xb_add(&bar[XB_TOPGEN], 1u);
            else XB_SPIN(xb_ld(&bar[XB_TOPGEN]) == tg, bar);
            __builtin_amdgcn_fence(__ATOMIC_ACQUIRE, "agent");
            asm volatile("s_waitcnt vmcnt(0)" ::: "memory");
        } else {
            XB_SPIN(xb_ld(&bar[XB_TOPGEN]) == gen, bar);
            __builtin_amdgcn_fence(__ATOMIC_ACQUIRE, "agent");
            asm volatile("s_waitcnt vmcnt(0)" ::: "memory");
        }
    }
    __syncthreads();
}

#ifndef PROBE_SYNC2
#define PROBE_SYNC2 0
#endif
#ifndef PROBE_M1X2
#define PROBE_M1X2 0
#endif
#ifndef PROBE_M2X2
#define PROBE_M2X2 0
#endif
#define GSYNC() do { { __attribute__((address_space(1))) unsigned* gb_ = (__attribute__((address_space(1))) unsigned*)xbar.bar; asm volatile("" : "+s"(gb_)); xbar.bar = (unsigned*)gb_; asm volatile("" : "+s"(xbar.x)); } xcd_barrier(xbar); if (PROBE_SYNC2) xcd_barrier(xbar); } while (0)
__device__ __forceinline__ int rstd_cache(LAS unsigned char* lds, const float* ss, const pg8::StaticOrder& S) {
    pg8::Unit u0; int pmc = -1;
    int tid = threadIdx.x; asm volatile("" : "+v"(tid));
    if (S.next(0, u0)) { pmc = u0.pm; if (tid < 256) ((LAS float*)(lds + 131072))[tid] = row_rstd(ss, u0.pm * 256 + tid); }
    asm volatile("s_waitcnt vmcnt(0) lgkmcnt(0)" ::: "memory");
    return pmc;
}
__global__ void __launch_bounds__(512, 2) fwd_megakernel(Params p) {
    extern __shared__ __attribute__((aligned(16))) unsigned char lds_raw[];
    LAS unsigned char* lds = (LAS unsigned char*)lds_raw;
#if defined(KEEP_CG_SYNC)
    cg::grid_group grid = cg::this_grid();
#endif
    const int G = gridDim.x;
    unsigned long long tic = 0, tacc = 0;
    unsigned char* ws = p.ws;
    volatile LAS unsigned* xst = (volatile LAS unsigned*)(lds + LDS_XST);
    if (threadIdx.x < 2) xst[threadIdx.x] = 0u;
    __syncthreads();
    XcdBarrier xbar = xcd_barrier_post((unsigned*)(ws + WS_CTL), xst);
    bf16* hb = (bf16*)(ws + WS_HB); bf16* proj = (bf16*)(ws + WS_PROJ); bf16* Y = (bf16*)(ws + WS_Y); bf16* mid = (bf16*)(ws + WS_MID); float* ss = (float*)(ws + WS_SS);
#if defined(KEEP_CG_SYNC)
    grid.sync();
#endif
    TIC();
#ifndef NO_PRO
    prologue(p, lds, G);
#endif
    GSYNC();
    TOC(0);
#pragma unroll 1
    for (int l = 0; l < DEPTH; ++l) {
        { __attribute__((address_space(1))) unsigned char* gws = (__attribute__((address_space(1))) unsigned char*)ws; asm volatile("" : "+s"(gws)); ws = (unsigned char*)gws; }
        const unsigned char* wl = ws + WS_W + (size_t)l * W_LAYER;
        const bf16* in_t = (const bf16*)(wl + W_IN); const bf16* out_t = (const bf16*)(wl + W_OUT); const bf16* up_t = (const bf16*)(wl + W_UP); const bf16* down_t = (const bf16*)(wl + W_DOWN);
        TIC();
#ifndef NO_GIN
        { pg8::Gemm g{hb, in_t, M, DIN, D, 0}; pg8::StaticOrder S; S.init(M, DIN, G, (int)blockIdx.x); const int pmc = rstd_cache(lds, ss, S); EpiIn E{proj, ss, (const LAS float*)(lds + 131072), pmc};
          pg8::gemm_phase<EpiIn, pg8::StaticOrder, true, true>(lds, g, S, E); }
#endif
#ifndef NO_META
        meta_tasks<0>(p, lds, G, nullptr, 0, in_t, D, DIN / 16);
#endif
        if (G == 256 && blockIdx.x >= 128) {
            const int lo = l * TITEMS_PER_LAYER + TITEMS_IN, hi = (l + 1 < DEPTH) ? (l + 1) * TITEMS_PER_LAYER + TITEMS_IN : DEPTH * TITEMS_PER_LAYER;
            convert_items(p, lds, lo, hi, (int)blockIdx.x - 128, 128 * 8);
        }
        GSYNC();
        TOC(1); TIC();
#ifndef FUSED_MIXER
#define FUSED_MIXER 1
#endif
#if FUSED_MIXER
        mixer_phase(p, lds, G, l, tic, tacc);
        GSYNC();
        TOC(2);
#else
        m1_phase(p, lds, G, l);
        GSYNC();
        TOC(2); TIC();
        m2_phase(p, lds, G, l);
        GSYNC();
#endif
        TOC(3); TIC();
#ifndef NO_GOUT
        { pg8::Gemm g{Y, out_t, M, D, D, NMETA}; pg8::StaticOrder S; S.init(M, D, G, (int)blockIdx.x); EpiRes E{hb, ss};
          pg8::gemm_phase<EpiRes, pg8::StaticOrder, false, true>(lds, g, S, E); }
#endif
#ifndef NO_META
        if (l < DEPTH - 1) meta_tasks<1>(p, lds, G, Y, D, out_t, D, D / 16);
#endif
        GSYNC();
        TOC(4); TIC();
#ifndef NO_GUP
#ifndef STAGGER_UP
#define STAGGER_UP 0
#endif
        if (STAGGER_UP > 0) {
            const unsigned long long w0 = __builtin_amdgcn_s_memrealtime(), dl = (unsigned long long)(((blockIdx.x >> 3) & 3) * STAGGER_UP);
            while (__builtin_amdgcn_s_memrealtime() - w0 < dl) __builtin_amdgcn_s_sleep(4);
        }
        { pg8::Gemm g{hb, up_t, M, FF, D, 0}; pg8::StaticOrder S; S.init(M, FF, G, (int)blockIdx.x); const int pmc = rstd_cache(lds, ss, S); EpiUp E{mid, ss, (const LAS float*)(lds + 131072), pmc};
          pg8::gemm_phase<EpiUp, pg8::StaticOrder, true, true>(lds, g, S, E); }
#endif
#ifndef NO_META
        if (l < DEPTH - 1) meta_tasks<2>(p, lds, G, nullptr, 0, up_t, D, FF / 16);
#endif
        GSYNC();
        TOC(5); TIC();
#ifndef NO_GDN
        { pg8::Gemm g{mid, down_t, M, D, FF, 0}; pg8::StaticOrder S; S.init(M, D, G, (int)blockIdx.x); EpiRes E{hb, ss};
          pg8::gemm_phase<EpiRes, pg8::StaticOrder, false, true>(lds, g, S, E); }
#endif
#ifndef NO_META
        if (l < DEPTH - 1) meta_tasks<1, 16>(p, lds, G, (const bf16*)(ws + WS_MIDMETA), FF, down_t, FF, D / 16);
#endif
        GSYNC();
        TOC(6);
    }
    TIC();
    final_norm(p, G);
    TOC(7);
    if (PROBE_PHASE >= 0 && blockIdx.x == PROBE_BLOCK && threadIdx.x == 0) { const unsigned long long w0 = __builtin_amdgcn_s_memrealtime(); while (__builtin_amdgcn_s_memrealtime() - w0 < 4ull * tacc) __builtin_amdgcn_s_sleep(8); }
}

extern "C" void kernel_launch(void* const* d_in, const int* in_sizes, int n_in, void* d_out, int out_size, void* d_ws, size_t ws_size, hipStream_t stream) {
    static int grid = 0;
    if (grid == 0) {
        if (n_in != 20 || in_sizes[0] != M * D || out_size != M * D || ws_size < WS_END) { fprintf(stderr, "kernel_launch: unexpected shapes (n_in %d, in0 %d, out %d, ws %zu)\n", n_in, n_in > 0 ? in_sizes[0] : -1, out_size, ws_size); grid = -1; return; }
        int dev = 0, cus = 0, per_cu = 0;
        if (hipGetDevice(&dev) != hipSuccess || hipDeviceGetAttribute(&cus, hipDeviceAttributeMultiprocessorCount, dev) != hipSuccess) { grid = -1; return; }
        if (hipFuncSetAttribute((const void*)fwd_megakernel, hipFuncAttributeMaxDynamicSharedMemorySize, LDS_BYTES) != hipSuccess) { fprintf(stderr, "kernel_launch: hipFuncSetAttribute failed\n"); grid = -1; return; }
        if (hipOccupancyMaxActiveBlocksPerMultiprocessor(&per_cu, (const void*)fwd_megakernel, 512, LDS_BYTES) != hipSuccess || per_cu < 1) { fprintf(stderr, "kernel_launch: occupancy query gave %d\n", per_cu); (void)hipGetLastError(); grid = -1; return; }
        grid = cus * 1;
        if (grid < 256) { fprintf(stderr, "kernel_launch: %d CUs; the fused mixer phase needs 256 resident workgroups\n", cus); grid = -1; return; }
    }
    if (grid < 0) return;
    if (hipMemsetAsync((char*)d_ws + WS_CTL, 0, WS_FLAG + 256 * 4, stream) != hipSuccess) { fprintf(stderr, "kernel_launch: memset failed\n"); return; }
    Params p{};
    for (int i = 0; i < 20; ++i) p.in[i] = (const float*)d_in[i];
    p.out = (float*)d_out; p.ws = (unsigned char*)d_ws;
    void* args[] = {&p};
    hipError_t e = hipLaunchCooperativeKernel((const void*)fwd_megakernel, dim3(grid), dim3(512), args, LDS_BYTES, stream);
    if (e != hipSuccess) fprintf(stderr, "cooperative launch failed: %s (grid %d)\n", hipGetErrorString(e), grid);
}
```

```cpp
#include <hip/hip_runtime.h>
#include <hip/hip_cooperative_groups.h>
#include <cstdio>
#include <cstdint>
namespace cg = cooperative_groups;
namespace pg8 {
#define PG8_LAS __attribute__((address_space(3)))
typedef unsigned short bf16_t;
typedef short bf16x8 __attribute__((ext_vector_type(8)));
typedef float f32x4 __attribute__((ext_vector_type(4)));
typedef unsigned u32x4 __attribute__((ext_vector_type(4)));
constexpr int BM = 256, BK = 64, HALF = 128, HTB = HALF * BK * 2  , STAGE_BYTES = 8 * HTB, NXCD = 8, WGM = 8;

__host__ __device__ __forceinline__ int lds_byte(int r, int c) { const int st = (r >> 4) * 2 + (c >> 5), rr = r & 15, cc = c & 31, ob = rr * 64 + cc * 2; return st * 1024 + (ob ^ (((ob >> 9) & 1) << 5)); }
__host__ __device__ __forceinline__ void stage_rc(int b, int& R, int& C) { const int st = b / 1024, sb = b % 1024, swz = sb ^ (((sb >> 9) & 1) << 5); R = (st >> 1) * 16 + swz / 64; C = (st & 1) * 32 + (swz % 64) / 2; }
__host__ __device__ __forceinline__ int perm32(int rho) { const int n = rho >> 4, i = rho & 15; return 8 * (i >> 2) + 4 * n + (i & 3); }

struct Unit { int pm, pn; };
struct Gemm { const bf16_t* A; const bf16_t* Bt; int M, N, K, gap; };

struct StaticOrder {
    int nM, nN, nwg, G, c;
    __host__ __device__ void init(int M, int N, int G_, int c_) { nM = M / BM; nN = N / BM; nwg = nM * nN; G = G_; c = c_; }
    __host__ __device__ bool next(int i, Unit& u) const {
        const long L = (long)i * G + c; if (L >= nwg) return false;
        int wgid = (int)L; { const int q = nwg / NXCD, r = nwg % NXCD, xcd = wgid % NXCD, off = wgid / NXCD; wgid = (xcd < r ? xcd * (q + 1) : r * (q + 1) + (xcd - r) * q) + off; }
        const int nig = WGM * nN, gid = wgid / nig, fm = gid * WGM, gsz = (nM - fm) < WGM ? (nM - fm) : WGM;
        u.pm = fm + ((wgid % nig) % gsz); u.pn = (wgid % nig) / gsz; return true;
    }
    __device__ __forceinline__ void a_ready(const Unit&) const {}
    __device__ __forceinline__ void done(const Unit&) const {}
};
__device__ __forceinline__ unsigned cvt_pk_bf16(float lo, float hi) { unsigned r; asm volatile("v_cvt_pk_bf16_f32 %0, %1, %2" : "=v"(r) : "v"(lo), "v"(hi)); return r; }
template <class Epi, class Sched, bool ALIGN_EPI = false, bool SP2 = false>
__device__ __forceinline__ void gemm_phase(PG8_LAS unsigned char* lds, const Gemm g, const Sched& S, const Epi& E) {
    int tid_ = threadIdx.x; asm volatile("" : "+v"(tid_));
    const int tid = tid_, wid = __builtin_amdgcn_readfirstlane(tid >> 6), lane = tid & 63, wr = wid >> 2, wc = wid & 3, fr = lane & 15, fq = lane >> 4;
    const int K = g.K, nt = K / BK;
    unsigned voffA[2], voffB[2];
#pragma unroll
    for (int i = 0; i < 2; ++i) { int R, C; stage_rc(tid * 16 + i * 8192, R, C); const int Rb = Epi::PERM ? ((R & ~31) + perm32(R & 31)) : R;
        voffA[i] = (unsigned)(R * K + C) * 2u; voffB[i] = (unsigned)(Rb * K + C) * 2u; }
    const size_t kstep = (size_t)(BK * 2);
    const size_t hstep = (size_t)HALF * K * 2;
    const size_t tstep = 2 * hstep;
    const int agap = g.gap;
#define a_off(pm_) ((size_t)((pm_) * BM + agap * (1 + ((pm_) >> 5))) * (size_t)K * 2)
    const unsigned ldsw = (unsigned)wid * 1024u;
    const int aoff = lds_byte(wr * 64 + fr, fq * 8), boff = lds_byte(wc * 32 + fr, fq * 8);
#define PG8_SA(b, h) (((b) * 2 + (h)) * HTB)
#define PG8_SB(b, h) ((4 + (b) * 2 + (h)) * HTB)
#define PG8_STAGE(bufoff, gbase, voff) do { _Pragma("unroll") for (int _i = 0; _i < 2; ++_i) \
        __builtin_amdgcn_global_load_lds((const unsigned*)((const char*)(gbase) + (voff)[_i]), (PG8_LAS unsigned*)(lds + (bufoff) + ldsw + _i * 8192), 16, 0, 0); } while (0)
#define PG8_LDA(dst, b, h) do { _Pragma("unroll") for (int m = 0; m < 4; ++m) _Pragma("unroll") for (int k = 0; k < 2; ++k) dst[m][k] = *(const PG8_LAS bf16x8*)(lds + PG8_SA(b, h) + aoff + m * 2048 + k * 1024); } while (0)
#define PG8_LDB(dst, b, h) do { _Pragma("unroll") for (int n = 0; n < 2; ++n) _Pragma("unroll") for (int k = 0; k < 2; ++k) dst[n][k] = *(const PG8_LAS bf16x8*)(lds + PG8_SB(b, h) + boff + n * 2048 + k * 1024); } while (0)
#define PG8_MMA(ai, bj, At, Bt) do { __builtin_amdgcn_s_setprio(1); _Pragma("unroll") for (int m = 0; m < 4; ++m) _Pragma("unroll") for (int n = 0; n < 2; ++n) _Pragma("unroll") for (int k = 0; k < 2; ++k) \
        acc[ai][bj][m][n] = __builtin_amdgcn_mfma_f32_16x16x32_bf16(Bt[n][k], At[m][k], acc[ai][bj][m][n], 0, 0, 0); __builtin_amdgcn_s_setprio(0); } while (0)
#define PG8_WAIT_V(n) asm volatile("s_waitcnt vmcnt(" #n ")" ::: "memory")
#define PG8_WAIT_L(n) asm volatile("s_waitcnt lgkmcnt(" #n ")" ::: "memory")
#define PG8_BAR __builtin_amdgcn_s_barrier()
#define PG8_SCHED __builtin_amdgcn_sched_barrier(0)
    Unit cur, nxt; int ui = 0;
    if (!S.next(0, cur)) return;
    f32x4 acc[2][2][4][2];
#pragma unroll
    for (int a = 0; a < 2; ++a)
#pragma unroll
        for (int b = 0; b < 2; ++b)
#pragma unroll
            for (int m = 0; m < 4; ++m)
#pragma unroll
                for (int n = 0; n < 2; ++n) acc[a][b][m][n] = (f32x4){0.f, 0.f, 0.f, 0.f};
    if constexpr (Epi::PRELOAD) E.preload(acc, cur, wr, wc, fr, fq);
    bf16x8 At[4][2], B0[2][2], B1[2][2];
    const char* cA = (const char*)g.A + a_off(cur.pm); const char* cB = (const char*)g.Bt + (size_t)cur.pn * tstep;
    S.a_ready(cur);
    if constexpr (SP2) {
        PG8_STAGE(PG8_SB(0, 0), cB, voffB); PG8_STAGE(PG8_SB(0, 1), cB + hstep, voffB); PG8_STAGE(PG8_SA(0, 0), cA, voffA); PG8_STAGE(PG8_SA(0, 1), cA + hstep, voffA);
        if (wr == 1) PG8_BAR;
        PG8_WAIT_V(2); PG8_BAR;
        PG8_STAGE(PG8_SB(1, 0), cB + kstep, voffB); PG8_STAGE(PG8_SA(1, 0), cA + kstep, voffA); PG8_STAGE(PG8_SB(1, 1), cB + hstep + kstep, voffB);
        PG8_WAIT_V(6); PG8_BAR;
    } else {
        PG8_STAGE(PG8_SB(0, 0), cB, voffB); PG8_STAGE(PG8_SA(0, 0), cA, voffA); PG8_STAGE(PG8_SB(0, 1), cB + hstep, voffB); PG8_STAGE(PG8_SA(0, 1), cA + hstep, voffA);
        if (wr == 1) PG8_BAR;
        PG8_WAIT_V(4); PG8_BAR;
        PG8_STAGE(PG8_SB(1, 0), cB + kstep, voffB); PG8_STAGE(PG8_SA(1, 0), cA + kstep, voffA); PG8_STAGE(PG8_SB(1, 1), cB + hstep + kstep, voffB);
        PG8_WAIT_V(6); PG8_BAR;
    }
    for (;;) {
        const bool has_next = S.next(ui + 1, nxt);
        const char* nA = has_next ? (const char*)g.A + a_off(nxt.pm) : cA; const char* nB = has_next ? (const char*)g.Bt + (size_t)nxt.pn * tstep : cB;
        for (int t = 0; t < nt; t += 2) {
            const bool last = (t == nt - 2);
            const char* a1 = cA + (size_t)(t + 1) * kstep;
            const char* a2 = last ? nA : cA + (size_t)(t + 2) * kstep; const char* b2 = last ? nB : cB + (size_t)(t + 2) * kstep;
            const char* a3 = a2 + kstep; const char* b3 = b2 + kstep;
            if (last && has_next) S.a_ready(nxt);
            if constexpr (SP2) {
            PG8_LDB(B0, 0, 0); PG8_LDB(B1, 0, 1); PG8_SCHED; PG8_LDA(At, 0, 0); PG8_STAGE(PG8_SA(1, 1), a1 + hstep, voffA);
            PG8_WAIT_V(8); PG8_WAIT_L(0); PG8_BAR; PG8_MMA(0, 0, At, B0); PG8_MMA(0, 1, At, B1); PG8_BAR; PG8_SCHED;
            PG8_LDA(At, 0, 1); PG8_STAGE(PG8_SB(0, 0), b2, voffB); PG8_STAGE(PG8_SB(0, 1), b2 + hstep, voffB); PG8_STAGE(PG8_SA(0, 0), a2, voffA);
            PG8_WAIT_V(8); PG8_WAIT_L(0); PG8_BAR; PG8_MMA(1, 0, At, B0); PG8_MMA(1, 1, At, B1); PG8_BAR; PG8_SCHED;
            PG8_LDB(B0, 1, 0); PG8_LDB(B1, 1, 1); PG8_SCHED; PG8_LDA(At, 1, 0); PG8_STAGE(PG8_SA(0, 1), a2 + hstep, voffA);
            PG8_WAIT_V(8); PG8_WAIT_L(0); PG8_BAR; PG8_MMA(0, 0, At, B0); PG8_MMA(0, 1, At, B1); PG8_BAR; PG8_SCHED;
            PG8_LDA(At, 1, 1); PG8_STAGE(PG8_SB(1, 0), b3, voffB); PG8_STAGE(PG8_SB(1, 1), b3 + hstep, voffB); PG8_STAGE(PG8_SA(1, 0), a3, voffA);
            PG8_WAIT_V(8); PG8_WAIT_L(0); PG8_BAR; PG8_MMA(1, 0, At, B0); PG8_MMA(1, 1, At, B1); PG8_BAR; PG8_SCHED;
            } else {
            PG8_LDB(B0, 0, 0); PG8_SCHED; PG8_LDA(At, 0, 0); PG8_STAGE(PG8_SA(1, 1), a1 + hstep, voffA);
            PG8_WAIT_L(8); PG8_BAR; PG8_WAIT_L(0); PG8_MMA(0, 0, At, B0); PG8_BAR; PG8_SCHED;
            PG8_LDB(B1, 0, 1); PG8_STAGE(PG8_SB(0, 0), b2, voffB);
            PG8_BAR; PG8_WAIT_L(0); PG8_MMA(0, 1, At, B1); PG8_BAR;
            PG8_LDA(At, 0, 1); PG8_STAGE(PG8_SA(0, 0), a2, voffA);
            PG8_BAR; PG8_WAIT_L(0); PG8_MMA(1, 0, At, B0); PG8_BAR; PG8_SCHED;
            PG8_STAGE(PG8_SB(0, 1), b2 + hstep, voffB);
            PG8_WAIT_V(6); PG8_BAR; PG8_MMA(1, 1, At, B1); PG8_BAR;
            PG8_LDB(B0, 1, 0); PG8_SCHED; PG8_LDA(At, 1, 0); PG8_STAGE(PG8_SA(0, 1), a2 + hstep, voffA);
            PG8_WAIT_L(8); PG8_BAR; PG8_WAIT_L(0); PG8_MMA(0, 0, At, B0); PG8_BAR; PG8_SCHED;
            PG8_LDB(B1, 1, 1); PG8_STAGE(PG8_SB(1, 0), b3, voffB);
            PG8_BAR; PG8_WAIT_L(0); PG8_MMA(0, 1, At, B1); PG8_BAR;
            PG8_LDA(At, 1, 1); PG8_STAGE(PG8_SA(1, 0), a3, voffA);
            PG8_BAR; PG8_WAIT_L(0); PG8_MMA(1, 0, At, B0); PG8_BAR; PG8_SCHED;
            PG8_STAGE(PG8_SB(1, 1), b3 + hstep, voffB);
            PG8_WAIT_V(6); PG8_BAR; PG8_MMA(1, 1, At, B1); PG8_BAR;
            }
        }
        if constexpr (ALIGN_EPI) { if (wr == 0) PG8_BAR; }
        if constexpr (!Epi::AFTER_DRAIN) { E(acc, cur, wr, wc, fr, fq); S.done(cur); }
        if (!has_next) break;
#pragma unroll
        for (int a = 0; a < 2; ++a)
#pragma unroll
            for (int b = 0; b < 2; ++b)
#pragma unroll
                for (int m = 0; m < 4; ++m)
#pragma unroll
                    for (int n = 0; n < 2; ++n) acc[a][b][m][n] = (f32x4){0.f, 0.f, 0.f, 0.f};
        if constexpr (Epi::PRELOAD) { E.preload(acc, nxt, wr, wc, fr, fq); PG8_WAIT_V(0); }
        cur = nxt; cA = nA; cB = nB; ++ui;
        if constexpr (ALIGN_EPI) { if (wr == 1) PG8_BAR; }
    }
    PG8_WAIT_V(0);
    if constexpr (!ALIGN_EPI) { if (wr == 0) PG8_BAR; }
    PG8_BAR;
    if constexpr (Epi::AFTER_DRAIN) { E.fused(acc, cur, wr, wc, fr, fq, lds, wid, lane); S.done(cur); }
#undef PG8_SA
#undef PG8_SB
#undef PG8_STAGE
#undef PG8_LDA
#undef PG8_LDB
#undef PG8_MMA
#undef PG8_WAIT_V
#undef PG8_WAIT_L
#undef PG8_BAR
#undef PG8_SCHED
}
}

#define LAS __attribute__((address_space(3)))
typedef unsigned short bf16;
typedef unsigned u32x4 __attribute__((ext_vector_type(4)));
typedef unsigned u32x2 __attribute__((ext_vector_type(2)));
typedef float f32x4 __attribute__((ext_vector_type(4)));
typedef short bf16x8 __attribute__((ext_vector_type(8)));
constexpr int D = 1024, SEQ = 8192, NB = 2, NMETA = 16, TT = SEQ + NMETA, M = NB * SEQ, DEPTH = 4, DIN = 1536, FF = 4096, DH = 512;
constexpr float EPS = 1e-6f;
constexpr size_t MiB = 1u << 20;
constexpr size_t WS_CTL = 0;
constexpr size_t WS_POOLW = 1 * MiB, WS_GR = WS_POOLW + 512 * 1024, WS_GI = WS_GR + 256 * 1024;
constexpr size_t WS_SP = 2 * MiB, WS_HMETA = WS_SP + 64 * 1024, WS_MIDMETA = WS_HMETA + 64 * 1024;
constexpr size_t WS_SS = 3 * MiB, WS_CARA = 4 * MiB, WS_CARH = WS_CARA + 512 * 1024;
constexpr size_t WS_W = 8 * MiB, W_LAYER = 21 * MiB, W_IN = 0, W_OUT = 3 * MiB, W_UP = 5 * MiB, W_DOWN = 13 * MiB;
constexpr size_t WS_HB = 92 * MiB, WS_MID = 124 * MiB;
constexpr size_t WS_PROJ = WS_MID, WS_Y = WS_MID + 48 * MiB + 256 * 1024, WS_HL = WS_Y + 32 * MiB + 256 * 1024, WS_P = WS_HL + 32 * MiB + 256 * 1024, WS_END = 256 * MiB;
static_assert(WS_PROJ + (size_t)NB * TT * DIN * 2 <= WS_Y && WS_Y + (size_t)NB * TT * D * 2 <= WS_HL && WS_HL + (size_t)NB * TT * DH * 2 <= WS_P && WS_P + (size_t)NB * TT * DH * 2 <= WS_END, "ws map");
static_assert(WS_W + DEPTH * W_LAYER <= WS_HB && WS_HB + (size_t)M * D * 2 <= WS_MID && WS_MID + (size_t)M * FF * 2 <= WS_END, "ws map 2");
constexpr int LDS_HL = 0, LDS_P = 65536, LDS_CST = 131072, LDS_CARR = 147456, LDS_RED1 = 149504, LDS_RED2 = 152064, LDS_CARRY = 154624;
constexpr int LDS_XST = 163840 - 64;
constexpr int LDS_BYTES = 163840;
constexpr size_t WS_FLAG = 64 * 1024;

struct Params {
    const float* in[20];
    float* out;
    unsigned char* ws;
};

__device__ __forceinline__ Params launder(const Params& p) {
    Params q = p;
#pragma unroll
    for (int i = 0; i < 20; ++i) { const __attribute__((address_space(1))) float* g = (const __attribute__((address_space(1))) float*)q.in[i]; asm volatile("" : "+s"(g)); q.in[i] = (const float*)g; }
    { __attribute__((address_space(1))) float* g = (__attribute__((address_space(1))) float*)q.out; asm volatile("" : "+s"(g)); q.out = (float*)g; }
    { __attribute__((address_space(1))) unsigned char* g = (__attribute__((address_space(1))) unsigned char*)q.ws; asm volatile("" : "+s"(g)); q.ws = (unsigned char*)g; }
    return q;
}
__device__ __forceinline__ unsigned cvt_pk(float lo, float hi) { return pg8::cvt_pk_bf16(lo, hi); }
__device__ __forceinline__ float bf_lo(unsigned w) { return __builtin_bit_cast(float, w << 16); }
__device__ __forceinline__ float bf_hi(unsigned w) { return __builtin_bit_cast(float, w & 0xffff0000u); }
__device__ __forceinline__ void unpack8(const u32x4 w, float (&f)[8]) {
    f[0] = bf_lo(w.x); f[1] = bf_hi(w.x); f[2] = bf_lo(w.y); f[3] = bf_hi(w.y); f[4] = bf_lo(w.z); f[5] = bf_hi(w.z); f[6] = bf_lo(w.w); f[7] = bf_hi(w.w);
}
__device__ __forceinline__ u32x4 pack8(const float (&f)[8]) { u32x4 w; w.x = cvt_pk(f[0], f[1]); w.y = cvt_pk(f[2], f[3]); w.z = cvt_pk(f[4], f[5]); w.w = cvt_pk(f[6], f[7]); return w; }
__device__ __forceinline__ float wave_sum(float v) {
#pragma unroll
    for (int o = 1; o < 64; o <<= 1) v += __shfl_xor(v, o);
    return v;
}
template <int CTRL> __device__ __forceinline__ float dppf(float old, float src) {
    return __builtin_bit_cast(float, __builtin_amdgcn_update_dpp(__builtin_bit_cast(int, old), __builtin_bit_cast(int, src), CTRL, 0xf, 0xf, false));
}
template <int DD> __device__ __forceinline__ float shiftd(float cur, float prev) {
    const float t = dppf<0x100 + (16 - DD)>(0.f, prev);
    return dppf<0x110 + DD>(t, cur);
}
__device__ __forceinline__ float sigm(float v) { return __builtin_amdgcn_rcpf(1.0f + __expf(-v)); }
__device__ __forceinline__ int outchan(int n, int rho) { return 32 * (n >> 1) + 8 * (rho >> 2) + 4 * (n & 1) + (rho & 3); }

__device__ __forceinline__ float row_rstd(const float* ss, int r) {
    const f32x4* s4 = (const f32x4*)(ss + (size_t)r * 16);
    const f32x4 a = s4[0], b = s4[1], c = s4[2], d = s4[3];
    const float s = ((a.x + a.y) + (a.z + a.w)) + ((b.x + b.y) + (b.z + b.w)) + ((c.x + c.y) + (c.z + c.w)) + ((d.x + d.y) + (d.z + d.w));
    return 1.0f / sqrtf(s * (1.0f / D) + EPS);
}
__device__ __forceinline__ void rows_rstd(const float* ss, int rowbase  , int fr, float (&rs)[2][4]) {
    const int lane = threadIdx.x & 63;
    const float r0 = row_rstd(ss, rowbase + lane), r1 = row_rstd(ss, rowbase + 128 + lane);
#pragma unroll
    for (int m = 0; m < 4; ++m) { rs[0][m] = __shfl(r0, m * 16 + fr); rs[1][m] = __shfl(r1, m * 16 + fr); }
}
struct EpiIn {
    static constexpr bool PERM = true, AFTER_DRAIN = false, PRELOAD = false;
    bf16* P; const float* ss; const LAS float* rl; int pmc;
    __device__ __forceinline__ void operator()(const f32x4 (&acc)[2][2][4][2], const pg8::Unit& u, int wr, int wc, int fr, int fq) const {
        const int row0 = u.pm * 256 + wr * 64 + fr, col0 = u.pn * 256 + wc * 32 + 8 * fq;
        float rsv[2][4];
        if (u.pm == pmc) {
#pragma unroll
            for (int ai = 0; ai < 2; ++ai)
#pragma unroll
                for (int m = 0; m < 4; ++m) rsv[ai][m] = rl[ai * 128 + wr * 64 + m * 16 + fr];
        } else {
#pragma unroll
            for (int ai = 0; ai < 2; ++ai)
#pragma unroll
                for (int m = 0; m < 4; ++m) { rsv[ai][m] = row_rstd(ss, row0 + ai * 128 + m * 16); asm volatile("" ::: "memory"); }
        }
#pragma unroll
        for (int ai = 0; ai < 2; ++ai)
#pragma unroll
            for (int m = 0; m < 4; ++m) {
                const int r = row0 + ai * 128 + m * 16; const float rs = rsv[ai][m];
                bf16* rowp = P + (size_t)(r + NMETA * (1 + (r >> 13))) * DIN + col0;
#pragma unroll
                for (int bj = 0; bj < 2; ++bj) { const f32x4 v0 = acc[ai][bj][m][0] * rs, v1 = acc[ai][bj][m][1] * rs;
                    u32x4 w; w.x = cvt_pk(v0[0], v0[1]); w.y = cvt_pk(v0[2], v0[3]); w.z = cvt_pk(v1[0], v1[1]); w.w = cvt_pk(v1[2], v1[3]);
                    *(u32x4*)(rowp + bj * 128) = w; }
            }
    }
};
struct EpiUp {
    static constexpr bool PERM = true, AFTER_DRAIN = false, PRELOAD = false;
    bf16* O; const float* ss; const LAS float* rl; int pmc;
    __device__ __forceinline__ void operator()(const f32x4 (&acc)[2][2][4][2], const pg8::Unit& u, int wr, int wc, int fr, int fq) const {
        const int row0 = u.pm * 256 + wr * 64 + fr, col0 = u.pn * 256 + wc * 32 + 8 * fq;
        float rsv[2][4];
        if (u.pm == pmc) {
#pragma unroll
            for (int ai = 0; ai < 2; ++ai)
#pragma unroll
                for (int m = 0; m < 4; ++m) rsv[ai][m] = rl[ai * 128 + wr * 64 + m * 16 + fr];
        } else {
#pragma unroll
            for (int ai = 0; ai < 2; ++ai)
#pragma unroll
                for (int m = 0; m < 4; ++m) { rsv[ai][m] = row_rstd(ss, row0 + ai * 128 + m * 16); asm volatile("" ::: "memory"); }
        }
#pragma unroll
        for (int ai = 0; ai < 2; ++ai)
#pragma unroll
            for (int m = 0; m < 4; ++m) {
                const int r = row0 + ai * 128 + m * 16; const float rs = rsv[ai][m];
                bf16* rowp = O + (size_t)r * FF + col0;
#pragma unroll
                for (int bj = 0; bj < 2; ++bj) { f32x4 v0 = acc[ai][bj][m][0] * rs, v1 = acc[ai][bj][m][1] * rs;
#pragma unroll
                    for (int j = 0; j < 4; ++j) { v0[j] = fmaxf(v0[j], 0.f); v0[j] *= v0[j]; v1[j] = fmaxf(v1[j], 0.f); v1[j] *= v1[j]; }
                    u32x4 w; w.x = cvt_pk(v0[0], v0[1]); w.y = cvt_pk(v0[2], v0[3]); w.z = cvt_pk(v1[0], v1[1]); w.w = cvt_pk(v1[2], v1[3]);
                    *(u32x4*)(rowp + bj * 128) = w; }
            }
    }
};
struct EpiRes {
    static constexpr bool PERM = true, AFTER_DRAIN = false, PRELOAD = true;
    bf16* hb; float* ssn;
    __device__ __forceinline__ void preload(f32x4 (&acc)[2][2][4][2], const pg8::Unit& u, int wr, int wc, int fr, int fq) const {
        const int row0 = u.pm * 256 + wr * 64 + fr, col0 = u.pn * 256 + wc * 32 + 8 * fq;
#pragma unroll
        for (int ai = 0; ai < 2; ++ai)
#pragma unroll
            for (int m = 0; m < 4; ++m) { const size_t off = (size_t)(row0 + ai * 128 + m * 16) * D + col0;
#pragma unroll
                for (int bj = 0; bj < 2; ++bj) { const u32x4 w = *(const u32x4*)(hb + off + bj * 128);
                    acc[ai][bj][m][0] = (f32x4){bf_lo(w.x), bf_hi(w.x), bf_lo(w.y), bf_hi(w.y)}; acc[ai][bj][m][1] = (f32x4){bf_lo(w.z), bf_hi(w.z), bf_lo(w.w), bf_hi(w.w)}; } }
    }
    __device__ __forceinline__ void operator()(const f32x4 (&acc)[2][2][4][2], const pg8::Unit& u, int wr, int wc, int fr, int fq) const {
        const int row0 = u.pm * 256 + wr * 64 + fr, col0 = u.pn * 256 + wc * 32 + 8 * fq;
#pragma unroll
        for (int ai = 0; ai < 2; ++ai)
#pragma unroll
            for (int m = 0; m < 4; ++m) {
                const int r = row0 + ai * 128 + m * 16; const size_t off = (size_t)r * D + col0; float s = 0.f;
#pragma unroll
                for (int bj = 0; bj < 2; ++bj) {
                    const f32x4 o0 = acc[ai][bj][m][0], o1 = acc[ai][bj][m][1];
                    s += (o0[0] * o0[0] + o0[1] * o0[1]) + (o0[2] * o0[2] + o0[3] * o0[3]) + (o1[0] * o1[0] + o1[1] * o1[1]) + (o1[2] * o1[2] + o1[3] * o1[3]);
                    u32x4 w; w.x = cvt_pk(o0[0], o0[1]); w.y = cvt_pk(o0[2], o0[3]); w.z = cvt_pk(o1[0], o1[1]); w.w = cvt_pk(o1[2], o1[3]);
                    *(u32x4*)(hb + off + bj * 128) = w; }
                s += __shfl_xor(s, 16); s += __shfl_xor(s, 32);
                if (fq == 0) ssn[(size_t)r * 16 + u.pn * 4 + wc] = s;
            }
    }
};

struct TItem { const float* W; const float* gk; bf16* WT; int K, N, item; };
__device__ __forceinline__ void titem_load(const TItem& t, int lane, f32x4 (&v)[8], float (&gs)[8]) {
    const int nblk = t.N / 32, kb = t.item / nblk, nb = t.item % nblk, k0 = 64 * kb, n0 = 32 * nb, lr = lane >> 3, lc = (lane & 7) * 4;
#pragma unroll
    for (int i = 0; i < 8; ++i) { v[i] = __builtin_nontemporal_load((const f32x4*)(t.W + (size_t)(k0 + 8 * i + lr) * t.N + n0 + lc)); gs[i] = t.gk ? t.gk[k0 + 8 * i + lr] : 1.0f; }
}
__device__ __forceinline__ void titem_store(const TItem& t, int lane, const f32x4 (&v)[8], const float (&gs)[8], LAS float* scr, unsigned char* wsb) {
    const __amdgpu_buffer_rsrc_t rsrc = __builtin_amdgcn_make_buffer_rsrc(wsb, 0, (int)WS_END, 0x00020000);
    const int nblk = t.N / 32, kb = t.item / nblk, nb = t.item % nblk, k0 = 64 * kb, n0 = 32 * nb, lr = lane >> 3, lc = (lane & 7) * 4;
#pragma unroll
    for (int i = 0; i < 8; ++i) { LAS float* d = scr + (8 * i + lr) * 33 + lc; d[0] = v[i].x * gs[i]; d[1] = v[i].y * gs[i]; d[2] = v[i].z * gs[i]; d[3] = v[i].w * gs[i]; }
    asm volatile("s_waitcnt lgkmcnt(0)" ::: "memory");
    const int c = lane & 7;
#pragma unroll
    for (int j = 0; j < 4; ++j) { const int n = (lane >> 3) + 8 * j; const LAS float* s = scr + (8 * c) * 33 + n;
        u32x4 o; o.x = cvt_pk(s[0 * 33], s[1 * 33]); o.y = cvt_pk(s[2 * 33], s[3 * 33]); o.z = cvt_pk(s[4 * 33], s[5 * 33]); o.w = cvt_pk(s[6 * 33], s[7 * 33]);
        __builtin_amdgcn_raw_buffer_store_b128(o, rsrc, (unsigned)((unsigned char*)(t.WT + (size_t)(n0 + n) * t.K + k0 + 8 * c) - wsb), 0, 16); }
    asm volatile("s_waitcnt lgkmcnt(0)" ::: "memory");
}
__device__ __forceinline__ TItem titem_decode(const Params& p, int it) {
    constexpr int I_IN = 16 * 48, I_OUT = 16 * 32, I_UP = 16 * 128, I_DN = 64 * 32, I_PW = 4 * 8, I_G = 8 * 2, I_L = I_IN + I_OUT + I_UP + I_DN + I_PW + 2 * I_G;
    const int l = it / I_L; int r = it % I_L; unsigned char* ws = p.ws; unsigned char* wl = ws + WS_W + (size_t)l * W_LAYER; TItem t;
    if (r < I_IN) { t = TItem{p.in[3] + (size_t)l * D * DIN, p.in[2] + l * D, (bf16*)(wl + W_IN), D, DIN, r}; return t; } r -= I_IN;
    if (r < I_OUT) { t = TItem{p.in[15] + (size_t)l * D * D, p.in[14] + l * D, (bf16*)(wl + W_OUT), D, D, r}; return t; } r -= I_OUT;
    if (r < I_UP) { t = TItem{p.in[17] + (size_t)l * D * FF, p.in[16] + l * D, (bf16*)(wl + W_UP), D, FF, r}; return t; } r -= I_UP;
    if (r < I_DN) { t = TItem{p.in[18] + (size_t)l * FF * D, nullptr, (bf16*)(wl + W_DOWN), FF, D, r}; return t; } r -= I_DN;
    if (r < I_PW) { const int g = r / 8; t = TItem{p.in[4] + (size_t)(l * 4 + g) * 16384, nullptr, (bf16*)(ws + WS_POOLW) + (size_t)(l * 4 + g) * 16384, 128, 128, r % 8}; return t; } r -= I_PW;
    if (r < I_G) { const int h = r / 2; t = TItem{p.in[9] + (size_t)(l * 8 + h) * 4096, nullptr, (bf16*)(ws + WS_GR) + (size_t)(l * 8 + h) * 4096, 64, 64, r % 2}; return t; } r -= I_G;
    { const int h = r / 2; t = TItem{p.in[11] + (size_t)(l * 8 + h) * 4096, nullptr, (bf16*)(ws + WS_GI) + (size_t)(l * 8 + h) * 4096, 64, 64, r % 2}; }
    return t;
}
constexpr int TITEMS_PER_LAYER = 16 * 48 + 16 * 32 + 16 * 128 + 64 * 32 + 4 * 8 + 2 * 8 * 2, TITEMS_IN = 16 * 48;
__device__ __forceinline__ void convert_items(const Params& p_, LAS unsigned char* lds, int it_lo, int it_hi, int wblock, int nworkers) {
    const Params p = launder(p_);
    int tid_ = threadIdx.x; asm volatile("" : "+v"(tid_));
    const int lane = tid_ & 63, wid = __builtin_amdgcn_readfirstlane(tid_ >> 6);
    LAS float* scr = (LAS float*)(lds + wid * 16384);
    const int worker = wblock * 8 + wid;
    if (it_lo + worker < it_hi) {
        TItem cur = titem_decode(p, it_lo + worker); f32x4 v[8]; float gs[8]; titem_load(cur, lane, v, gs);
        for (int it = it_lo + worker; it < it_hi; it += nworkers) {
            const bool more = it + nworkers < it_hi; TItem nxt = cur; f32x4 nv[8]; float ngs[8];
            if (more) { nxt = titem_decode(p, it + nworkers); titem_load(nxt, lane, nv, ngs); }
            titem_store(cur, lane, v, gs, scr, p.ws);
            if (more) { cur = nxt;
#pragma unroll
                for (int i = 0; i < 8; ++i) { v[i] = nv[i]; gs[i] = ngs[i]; } }
        }
    }
}
__device__ __forceinline__ void prologue(const Params& p_, LAS unsigned char* lds, int G) {
    const Params p = launder(p_);
    int tid_ = threadIdx.x; asm volatile("" : "+v"(tid_));
    const int tid = tid_, lane = tid & 63, wid = __builtin_amdgcn_readfirstlane(tid >> 6);
    const int gw = blockIdx.x * 8 + wid, NGW = G * 8;
    unsigned char* ws = p.ws;
    convert_items(p_, lds, 0, G == 256 ? TITEMS_IN : DEPTH * TITEMS_PER_LAYER, (int)blockIdx.x, NGW);
    const float* x = p.in[0]; bf16* hb = (bf16*)(ws + WS_HB); float* ss = (float*)(ws + WS_SS);
    for (int m2 = gw; m2 < M / 2; m2 += NGW) {
        f32x4 v[2][4]; float s[2] = {0.f, 0.f};
#pragma unroll
        for (int r = 0; r < 2; ++r) { const f32x4* xr = (const f32x4*)(x + (size_t)(2 * m2 + r) * D) + lane;
#pragma unroll
            for (int j = 0; j < 4; ++j) v[r][j] = __builtin_nontemporal_load(xr + 64 * j); }
#pragma unroll
        for (int r = 0; r < 2; ++r) {
#pragma unroll
            for (int j = 0; j < 4; ++j) s[r] += (v[r][j].x * v[r][j].x + v[r][j].y * v[r][j].y) + (v[r][j].z * v[r][j].z + v[r][j].w * v[r][j].w);
            s[r] = wave_sum(s[r]);
            u32x2* o8 = (u32x2*)(hb + (size_t)(2 * m2 + r) * D) + lane;
#pragma unroll
            for (int j = 0; j < 4; ++j) { u32x2 w; w.x = cvt_pk(v[r][j].x, v[r][j].y); w.y = cvt_pk(v[r][j].z, v[r][j].w); o8[64 * j] = w; }
            if (lane < 16) ss[(size_t)(2 * m2 + r) * 16 + lane] = lane == 0 ? s[r] : 0.f;
        }
    }
    float* hm = (float*)(ws + WS_HMETA); float* sp = (float*)(ws + WS_SP);
    for (int i = blockIdx.x * 512 + tid; i < NMETA * D; i += G * 512) hm[i] = p.in[1][i];
    for (int i = blockIdx.x * 512 + tid; i < DEPTH * DH; i += G * 512) sp[i] = log1pf(expf(-p.in[13][i]));
}

template <int MODE, int NBATCH = 4> __device__ __forceinline__ void meta_tasks(const Params& p_, LAS unsigned char* lds, int G, const bf16* Ab, int lda, const bf16* Bt, int K, int ntasks) {
    const Params p = launder(p_);
    int tid_ = threadIdx.x; asm volatile("" : "+v"(tid_));
    const int tid = tid_, lane = tid & 63, wid = __builtin_amdgcn_readfirstlane(tid >> 6), fr = lane & 15, fq = lane >> 4;
    float* hm = (float*)(p.ws + WS_HMETA);
    LAS float* red = (LAS float*)lds;
    for (int task = G - 1 - (int)blockIdx.x; task < ntasks; task += G) {
        const int n0 = task * 16, kw = K / 8, k0 = wid * kw;
        f32x4 acc = {0.f, 0.f, 0.f, 0.f}; float ssq = 0.f;
        for (int kb = k0; kb < k0 + kw; kb += 32 * NBATCH) {
            bf16x8 af[NBATCH], bfr[NBATCH]; f32x4 a0[NBATCH], a1[NBATCH];
#pragma unroll
            for (int i = 0; i < NBATCH; ++i) { const int kk = kb + 32 * i;
                if (MODE == 1) af[i] = *(const bf16x8*)(Ab + (size_t)fr * lda + kk + 8 * fq);
                else { a0[i] = *(const f32x4*)(hm + fr * D + kk + 8 * fq); a1[i] = *(const f32x4*)(hm + fr * D + kk + 8 * fq + 4); }
                bfr[i] = *(const bf16x8*)(Bt + (size_t)(n0 + fr) * K + kk + 8 * fq); }
#pragma unroll
            for (int i = 0; i < NBATCH; ++i) {
                if (MODE != 1) { ssq += (a0[i].x * a0[i].x + a0[i].y * a0[i].y) + (a0[i].z * a0[i].z + a0[i].w * a0[i].w) + (a1[i].x * a1[i].x + a1[i].y * a1[i].y) + (a1[i].z * a1[i].z + a1[i].w * a1[i].w);
                    u32x4 w; w.x = cvt_pk(a0[i].x, a0[i].y); w.y = cvt_pk(a0[i].z, a0[i].w); w.z = cvt_pk(a1[i].x, a1[i].y); w.w = cvt_pk(a1[i].z, a1[i].w); af[i] = __builtin_bit_cast(bf16x8, w); }
                acc = __builtin_amdgcn_mfma_f32_16x16x32_bf16(bfr[i], af[i], acc, 0, 0, 0); }
        }
        ssq += __shfl_xor(ssq, 16); ssq += __shfl_xor(ssq, 32);
        LAS float* rp = red + (wid * 64 + lane) * 5;
        rp[0] = acc[0]; rp[1] = acc[1]; rp[2] = acc[2]; rp[3] = acc[3]; rp[4] = ssq;
        __syncthreads();
        if (wid == 0) {
            float a0 = 0.f, a1 = 0.f, a2 = 0.f, a3 = 0.f, sq = 0.f;
#pragma unroll
            for (int w = 0; w < 8; ++w) { const LAS float* q = red + (w * 64 + lane) * 5; a0 += q[0]; a1 += q[1]; a2 += q[2]; a3 += q[3]; sq += q[4]; }
            const int col = n0 + 4 * fq;
            if (MODE == 1) { f32x4* hp = (f32x4*)(hm + fr * D + col); f32x4 h = *hp; h.x += a0; h.y += a1; h.z += a2; h.w += a3; *hp = h; }
            else {
                const float rs = 1.0f / sqrtf(sq * (1.0f / D) + EPS); a0 *= rs; a1 *= rs; a2 *= rs; a3 *= rs;
                if (MODE == 0) { u32x2 w; w.x = cvt_pk(a0, a1); w.y = cvt_pk(a2, a3); bf16* pr = (bf16*)(p.ws + WS_PROJ);
                    *(u32x2*)(pr + (size_t)fr * DIN + col) = w; *(u32x2*)(pr + (size_t)(TT + fr) * DIN + col) = w; }
                else { a0 = fmaxf(a0, 0.f); a1 = fmaxf(a1, 0.f); a2 = fmaxf(a2, 0.f); a3 = fmaxf(a3, 0.f);
                    u32x2 w; w.x = cvt_pk(a0 * a0, a1 * a1); w.y = cvt_pk(a2 * a2, a3 * a3); *(u32x2*)((bf16*)(p.ws + WS_MIDMETA) + (size_t)fr * FF + col) = w; }
            }
        }
        __syncthreads();
    }
}

__device__ __forceinline__ void m1_phase(const Params& p_, LAS unsigned char* lds, int G, int l) {
    const Params p = launder(p_);
    int tid_ = threadIdx.x; asm volatile("" : "+v"(tid_));
    const int tid = tid_, lane = tid & 63, wid = __builtin_amdgcn_readfirstlane(tid >> 6), fr = lane & 15, fq = lane >> 4;
    LAS float* cst = (LAS float*)lds;
    for (int i = tid; i < 8 * DH; i += 512) { const int row = i >> 9, ch = i & 511; float v;
        if (row < 4) v = p.in[7][(l * 4 + row) * DH + ch]; else if (row == 4) v = p.in[8][l * DH + ch]; else if (row == 5) v = p.in[10][l * DH + ch];
        else if (row == 6) v = p.in[12][l * DH + ch]; else v = ((const float*)(p.ws + WS_SP))[l * DH + ch];
        cst[i] = v; }
    const bf16* proj = (const bf16*)(p.ws + WS_PROJ);
    const bf16* Wr = (const bf16*)(p.ws + WS_GR) + (size_t)(l * 8 + wid) * 4096; const bf16* Wi = (const bf16*)(p.ws + WS_GI) + (size_t)(l * 8 + wid) * 4096;
    LAS bf16x8* wl = (LAS bf16x8*)(lds + 16384 + wid * 16384) + lane;
#pragma unroll
    for (int n = 0; n < 4; ++n)
#pragma unroll
        for (int ks = 0; ks < 2; ++ks) {
            wl[((n * 2 + ks) * 2 + 0) * 64] = *(const bf16x8*)(Wr + outchan(n, fr) * 64 + 32 * ks + 8 * fq);
            wl[((n * 2 + ks) * 2 + 1) * 64] = *(const bf16x8*)(Wi + outchan(n, fr) * 64 + 32 * ks + 8 * fq); }
    __syncthreads();
    bf16* hl = (bf16*)(p.ws + WS_HL); bf16* Pp = (bf16*)(p.ws + WS_P);
    float* carA = (float*)(p.ws + WS_CARA); float* carH = (float*)(p.ws + WS_CARH);
    for (int unit = blockIdx.x; unit < 256; unit += G) {
        const int b = unit >> 7, c = unit & 127, t0 = c ? NMETA + 64 * c : 0, NM = c ? 4 : 5;
        float Hc[16], Pc[16];
#pragma unroll
        for (int k = 0; k < 16; ++k) { Hc[k] = 0.f; Pc[k] = 1.f; }
        u32x4 raw[2][4];
#pragma unroll
        for (int ks = 0; ks < 2; ++ks)
#pragma unroll
            for (int d = 0; d < 4; ++d) { const int tt = t0 + fr - 3 + d; raw[ks][d] = (u32x4){0u, 0u, 0u, 0u};
                if (tt >= 0) raw[ks][d] = *(const u32x4*)(proj + ((size_t)b * TT + tt) * DIN + DH + wid * 64 + 32 * ks + 8 * fq); }
#pragma unroll 1
        for (int m = 0; m < NM; ++m) {
            const int t = t0 + 16 * m + fr; const size_t rowg = (size_t)b * TT + t;
            u32x4 nraw[2][4];
#pragma unroll
            for (int ks = 0; ks < 2; ++ks)
#pragma unroll
                for (int d = 0; d < 4; ++d) { nraw[ks][d] = (u32x4){0u, 0u, 0u, 0u};
                    if (m + 1 < NM) nraw[ks][d] = *(const u32x4*)(proj + ((size_t)b * TT + t + 13 + d) * DIN + DH + wid * 64 + 32 * ks + 8 * fq); }
            float xc[2][8]; bf16x8 frag[2];
#pragma unroll
            for (int ks = 0; ks < 2; ++ks) {
                const int chb = wid * 64 + 32 * ks + 8 * fq;
                { const f32x4 c0 = *(const LAS f32x4*)(cst + 4 * DH + chb), c1 = *(const LAS f32x4*)(cst + 4 * DH + chb + 4);
                  xc[ks][0] = c0.x; xc[ks][1] = c0.y; xc[ks][2] = c0.z; xc[ks][3] = c0.w; xc[ks][4] = c1.x; xc[ks][5] = c1.y; xc[ks][6] = c1.z; xc[ks][7] = c1.w; }
#pragma unroll
                for (int d = 0; d < 4; ++d) {
                    float u[8]; unpack8(raw[ks][d], u);
                    const f32x4 w0 = *(const LAS f32x4*)(cst + d * DH + chb), w1 = *(const LAS f32x4*)(cst + d * DH + chb + 4);
                    xc[ks][0] += u[0] * w0.x; xc[ks][1] += u[1] * w0.y; xc[ks][2] += u[2] * w0.z; xc[ks][3] += u[3] * w0.w;
                    xc[ks][4] += u[4] * w1.x; xc[ks][5] += u[5] * w1.y; xc[ks][6] += u[6] * w1.z; xc[ks][7] += u[7] * w1.w;
                    raw[ks][d] = nraw[ks][d];
                }
                frag[ks] = __builtin_bit_cast(bf16x8, pack8(xc[ks]));
            }
            f32x4 ar[4], ai[4];
#pragma unroll
            for (int n = 0; n < 4; ++n) { ar[n] = (f32x4){0.f, 0.f, 0.f, 0.f}; ai[n] = (f32x4){0.f, 0.f, 0.f, 0.f};
#pragma unroll
                for (int ks = 0; ks < 2; ++ks) {
                    const bf16x8 wr_ = wl[((n * 2 + ks) * 2 + 0) * 64], wi_ = wl[((n * 2 + ks) * 2 + 1) * 64];
                    ar[n] = __builtin_amdgcn_mfma_f32_16x16x32_bf16(wr_, frag[ks], ar[n], 0, 0, 0);
                    ai[n] = __builtin_amdgcn_mfma_f32_16x16x32_bf16(wi_, frag[ks], ai[n], 0, 0, 0);
                } }
            float Aa[16], Bb[16];
#pragma unroll
            for (int n = 0; n < 4; ++n) {
                const int cho = wid * 64 + 32 * (n >> 1) + 8 * fq + 4 * (n & 1);
                const f32x4 rb = *(const LAS f32x4*)(cst + 5 * DH + cho), ib = *(const LAS f32x4*)(cst + 6 * DH + cho), spv = *(const LAS f32x4*)(cst + 7 * DH + cho);
#pragma unroll
                for (int jj = 0; jj < 4; ++jj) {
                    const float r = sigm(ar[n][jj] + rb[jj]), ig = sigm(ai[n][jj] + ib[jj]);
                    const float la = -8.0f * r * spv[jj], a = __expf(la), x2 = 2.0f * la;
                    const float m2s = -x2 * (1.0f + x2 * (0.5f + x2 * (0.16666667f + x2 * 0.041666668f))), m2 = (x2 > -0.0625f) ? m2s : 1.0f - a * a;
                    Aa[n * 4 + jj] = a; Bb[n * 4 + jj] = __builtin_amdgcn_sqrtf(m2) * ig * xc[n >> 1][4 * (n & 1) + jj];
                }
            }
#pragma unroll
            for (int k = 0; k < 16; ++k) {
                float A = Aa[k], B = Bb[k], Ap, Bq;
                Ap = dppf<0x111>(1.f, A); Bq = dppf<0x111>(0.f, B); B = fmaf(A, Bq, B); A *= Ap;
                Ap = dppf<0x112>(1.f, A); Bq = dppf<0x112>(0.f, B); B = fmaf(A, Bq, B); A *= Ap;
                Ap = dppf<0x114>(1.f, A); Bq = dppf<0x114>(0.f, B); B = fmaf(A, Bq, B); A *= Ap;
                Ap = dppf<0x118>(1.f, A); Bq = dppf<0x118>(0.f, B); B = fmaf(A, Bq, B); A *= Ap;
                Bb[k] = fmaf(A, Hc[k], B); Aa[k] = A * Pc[k];
            }
#pragma unroll
            for (int ks = 0; ks < 2; ++ks) {
                const size_t o = rowg * DH + wid * 64 + 32 * ks + 8 * fq;
                { u32x4 wh; wh.x = cvt_pk(Bb[8 * ks + 0], Bb[8 * ks + 1]); wh.y = cvt_pk(Bb[8 * ks + 2], Bb[8 * ks + 3]); wh.z = cvt_pk(Bb[8 * ks + 4], Bb[8 * ks + 5]); wh.w = cvt_pk(Bb[8 * ks + 6], Bb[8 * ks + 7]);
                  *(u32x4*)(hl + o) = wh; }
                u32x4 w; w.x = cvt_pk(Aa[8 * ks + 0], Aa[8 * ks + 1]); w.y = cvt_pk(Aa[8 * ks + 2], Aa[8 * ks + 3]); w.z = cvt_pk(Aa[8 * ks + 4], Aa[8 * ks + 5]); w.w = cvt_pk(Aa[8 * ks + 6], Aa[8 * ks + 7]);
                *(u32x4*)(Pp + o) = w;
            }
            const int src = (lane & 48) | 15;
#pragma unroll
            for (int k = 0; k < 16; ++k) { Hc[k] = __shfl(Bb[k], src); Pc[k] = __shfl(Aa[k], src); }
        }
        if (fr == 0) {
#pragma unroll
            for (int ks = 0; ks < 2; ++ks) {
                const size_t o = (size_t)(b * 128 + c) * DH + wid * 64 + 32 * ks + 8 * fq;
                *(f32x4*)(carA + o) = (f32x4){Pc[8 * ks + 0], Pc[8 * ks + 1], Pc[8 * ks + 2], Pc[8 * ks + 3]}; *(f32x4*)(carA + o + 4) = (f32x4){Pc[8 * ks + 4], Pc[8 * ks + 5], Pc[8 * ks + 6], Pc[8 * ks + 7]};
                *(f32x4*)(carH + o) = (f32x4){Hc[8 * ks + 0], Hc[8 * ks + 1], Hc[8 * ks + 2], Hc[8 * ks + 3]}; *(f32x4*)(carH + o + 4) = (f32x4){Hc[8 * ks + 4], Hc[8 * ks + 5], Hc[8 * ks + 6], Hc[8 * ks + 7]};
            }
        }
    }
    __syncthreads();
}


template <int NMR, bool FROM_LDS> __device__ __forceinline__ void m2_rnn_round(LAS unsigned char* lds, const bf16* hl, const bf16* Pp, const bf16* proj, bf16* Y, LAS float* red1, const float (&cr)[16], int b, int t0, int mbase, int wid, int fr, int fq) {
    u32x4 hw[NMR][2], pw[NMR][2], gw[NMR][2];
#pragma unroll
    for (int m = 0; m < NMR; ++m)
#pragma unroll
        for (int ks = 0; ks < 2; ++ks) { const size_t rowg = (size_t)b * TT + t0 + 16 * (mbase + m) + fr; const int ch = wid * 64 + 32 * ks + 8 * fq; const size_t o = rowg * DH + ch;
            if (FROM_LDS) { const int lane = fq * 16 + fr; hw[m][ks] = *(const LAS u32x4*)(lds + LDS_HL + wid * 8192 + (((mbase + m) * 2 + ks) * 64 + lane) * 16); pw[m][ks] = *(const LAS u32x4*)(lds + LDS_P + wid * 8192 + (((mbase + m) * 2 + ks) * 64 + lane) * 16); }
            else { hw[m][ks] = *(const u32x4*)(hl + o); pw[m][ks] = *(const u32x4*)(Pp + o); } gw[m][ks] = *(const u32x4*)(proj + rowg * DIN + 2 * DH + ch); }
    float y[NMR][16];
#pragma unroll
    for (int m = 0; m < NMR; ++m) { float s = 0.f;
#pragma unroll
        for (int ks = 0; ks < 2; ++ks) { float pf[8], gt[8]; unpack8(pw[m][ks], pf); unpack8(gw[m][ks], gt);
            float hh[8]; unpack8(hw[m][ks], hh);
#pragma unroll
            for (int e = 0; e < 8; ++e) { const float hv = fmaf(pf[e], cr[8 * ks + e], hh[e]), x = gt[e];
                const float ge = x * __builtin_amdgcn_rcpf(1.0f + __expf(-1.5957691216f * (x + 0.044715f * x * x * x)));
                const float yy = hv * ge; y[m][8 * ks + e] = yy; s = fmaf(yy, yy, s); } }
        s += __shfl_xor(s, 16); s += __shfl_xor(s, 32);
        if (fq == 0) red1[(16 * (mbase + m) + fr) * 8 + wid] = s; }
    __syncthreads();
#pragma unroll
    for (int m = 0; m < NMR; ++m) { const size_t rowg = (size_t)b * TT + t0 + 16 * (mbase + m) + fr;
        const f32x4 r0 = *(const LAS f32x4*)(red1 + (16 * (mbase + m) + fr) * 8), r1 = *(const LAS f32x4*)(red1 + (16 * (mbase + m) + fr) * 8 + 4);
        const float rs = __builtin_amdgcn_rsqf((((r0.x + r0.y) + (r0.z + r0.w)) + ((r1.x + r1.y) + (r1.z + r1.w))) * (1.0f / DH) + EPS);
#pragma unroll
        for (int ks = 0; ks < 2; ++ks) { float yy[8];
#pragma unroll
            for (int e = 0; e < 8; ++e) yy[e] = y[m][8 * ks + e] * rs;
            *(u32x4*)(Y + rowg * D + DH + wid * 64 + 32 * ks + 8 * fq) = pack8(yy); } }
}


template <int NMR> __device__ __forceinline__ void m2_pool_round(const bf16* proj, bf16* Y, const bf16* Wp, const float* pbias, const float* pscale, LAS float* red2,
                                                                  int b, int t0, int mbase, int g, int half, int kwin, int wid, int fr, int fq) {
    const int tb = t0 + 16 * mbase;
    bf16x8 pfr[NMR][4];
#pragma unroll
    for (int ks = 0; ks < 4; ++ks) {
        const int chb = g * 128 + 32 * ks + 8 * fq;
        float pu[8], p2[8], p4[8], p8[8];
        if (tb) { const u32x4 raw = *(const u32x4*)(proj + ((size_t)b * TT + tb - 16 + fr) * DIN + chb); unpack8(raw, pu);
#pragma unroll
            for (int e = 0; e < 8; ++e) { p2[e] = pu[e] + dppf<0x111>(0.f, pu[e]); p4[e] = p2[e] + dppf<0x112>(0.f, p2[e]); p8[e] = p4[e] + dppf<0x114>(0.f, p4[e]); } }
        else {
#pragma unroll
            for (int e = 0; e < 8; ++e) { pu[e] = 0.f; p2[e] = 0.f; p4[e] = 0.f; p8[e] = 0.f; } }
#pragma unroll
        for (int m = 0; m < NMR; ++m) {
            const int t = tb + 16 * m + fr; const size_t rowg = (size_t)b * TT + t;
            const u32x4 raw = *(const u32x4*)(proj + rowg * DIN + chb); float u[8], po[8]; unpack8(raw, u);
            const int cnt = (t + 1 < kwin) ? t + 1 : kwin; const float rc = __builtin_amdgcn_rcpf((float)cnt);
#pragma unroll
            for (int e = 0; e < 8; ++e) {
                const float s2 = u[e] + shiftd<1>(u[e], pu[e]), s4 = s2 + shiftd<2>(s2, p2[e]), s8 = s4 + shiftd<4>(s4, p4[e]), s16 = s8 + shiftd<8>(s8, p8[e]);
                const float win = g == 0 ? s2 : (g == 1 ? s4 : (g == 2 ? s8 : s16));
                po[e] = fmaf(win, rc, -u[e]); pu[e] = u[e]; p2[e] = s2; p4[e] = s4; p8[e] = s8;
            }
            pfr[m][ks] = __builtin_bit_cast(bf16x8, pack8(po));
        }
    }
    bf16x8 wfr[4][4];
#pragma unroll
    for (int n = 0; n < 4; ++n)
#pragma unroll
        for (int ks = 0; ks < 4; ++ks) wfr[n][ks] = *(const bf16x8*)(Wp + (size_t)(64 * half + outchan(n, fr)) * 128 + 32 * ks + 8 * fq);
#pragma unroll 1
    for (int pass = 0; pass < 2; ++pass) {
#pragma unroll
        for (int m = 0; m < NMR; ++m) {
            const int t = tb + 16 * m + fr; const size_t rowg = (size_t)b * TT + t; float s = 0.f, rs = 0.f;
            if (pass) { const f32x4 r0 = *(const LAS f32x4*)(red2 + (16 * (mbase + m) + fr) * 8), r1 = *(const LAS f32x4*)(red2 + (16 * (mbase + m) + fr) * 8 + 4);
                rs = __builtin_amdgcn_rsqf((((r0.x + r0.y) + (r0.z + r0.w)) + ((r1.x + r1.y) + (r1.z + r1.w))) * (1.0f / DH) + EPS); }
#pragma unroll
            for (int np = 0; np < 2; ++np) {
                f32x4 o2[2];
#pragma unroll
                for (int nn = 0; nn < 2; ++nn) { const int n = 2 * np + nn;
                    f32x4 acc = {0.f, 0.f, 0.f, 0.f};
#pragma unroll
                    for (int ks = 0; ks < 4; ++ks) acc = __builtin_amdgcn_mfma_f32_16x16x32_bf16(wfr[n][ks], pfr[m][ks], acc, 0, 0, 0);
                    const int col = g * 128 + 64 * half + 32 * np + 8 * fq + 4 * nn;
                    const f32x4 pb = *(const f32x4*)(pbias + col), ps = *(const f32x4*)(pscale + col);
                    acc = (acc + pb) * ps; s += (acc.x * acc.x + acc.y * acc.y) + (acc.z * acc.z + acc.w * acc.w); o2[nn] = acc * rs; }
                if (pass) { u32x4 w; w.x = cvt_pk(o2[0].x, o2[0].y); w.y = cvt_pk(o2[0].z, o2[0].w); w.z = cvt_pk(o2[1].x, o2[1].y); w.w = cvt_pk(o2[1].z, o2[1].w);
                    *(u32x4*)(Y + rowg * D + g * 128 + 64 * half + 32 * np + 8 * fq) = w; }
            }
            if (!pass) { s += __shfl_xor(s, 16); s += __shfl_xor(s, 32); if (fq == 0) red2[(16 * (mbase + m) + fr) * 8 + wid] = s; }
        }
        if (!pass) __syncthreads();
    }
}

__device__ __forceinline__ void m2_phase(const Params& p_, LAS unsigned char* lds, int G, int l) {
    const Params p = launder(p_);
    int tid_ = threadIdx.x; asm volatile("" : "+v"(tid_));
    const int tid = tid_, lane = tid & 63, wid = __builtin_amdgcn_readfirstlane(tid >> 6), fr = lane & 15, fq = lane >> 4;
    LAS float* segA = (LAS float*)lds; LAS float* segH = (LAS float*)(lds + 16384); LAS float* carr = (LAS float*)(lds + 32768);
    LAS float* red1 = (LAS float*)(lds + 34816); LAS float* red2 = (LAS float*)(lds + 37888);
    const bf16* proj = (const bf16*)(p.ws + WS_PROJ); bf16* Y = (bf16*)(p.ws + WS_Y);
    const bf16* hl = (const bf16*)(p.ws + WS_HL); const bf16* Pp = (const bf16*)(p.ws + WS_P);
    const float* carA = (const float*)(p.ws + WS_CARA); const float* carH = (const float*)(p.ws + WS_CARH);
    const int g = wid >> 1, half = wid & 1, kwin = 2 << g;
    const bf16* Wp = (const bf16*)(p.ws + WS_POOLW) + (size_t)(l * 4 + g) * 16384;
    const float* pbias = p.in[5] + l * DH; const float* pscale = p.in[6] + l * DH;
    for (int unit = blockIdx.x; unit < 256; unit += G) {
        const int b = unit >> 7, c = unit & 127, t0 = c ? NMETA + 64 * c : 0, NM = c ? 4 : 5;
        {
            const int q = (c + 7) >> 3, jlo = wid * q, jhi = (jlo + q < c) ? jlo + q : c;
            f32x4 A0 = {1.f, 1.f, 1.f, 1.f}, A1 = A0, H0 = {0.f, 0.f, 0.f, 0.f}, H1 = H0;
            for (int j = jlo; j < jhi; j += 8) {
                f32x4 a0[8], a1[8], h0[8], h1[8];
#pragma unroll
                for (int i = 0; i < 8; ++i) { const int jj = (j + i < jhi) ? j + i : jhi - 1; const size_t o = (size_t)(b * 128 + jj) * DH + 8 * lane;
                    a0[i] = *(const f32x4*)(carA + o); a1[i] = *(const f32x4*)(carA + o + 4); h0[i] = *(const f32x4*)(carH + o); h1[i] = *(const f32x4*)(carH + o + 4); }
#pragma unroll
                for (int i = 0; i < 8; ++i) if (j + i < jhi) { H0 = a0[i] * H0 + h0[i]; A0 = A0 * a0[i]; H1 = a1[i] * H1 + h1[i]; A1 = A1 * a1[i]; }
            }
            *(LAS f32x4*)(segA + wid * DH + 8 * lane) = A0; *(LAS f32x4*)(segA + wid * DH + 8 * lane + 4) = A1;
            *(LAS f32x4*)(segH + wid * DH + 8 * lane) = H0; *(LAS f32x4*)(segH + wid * DH + 8 * lane + 4) = H1;
        }
        __syncthreads();
        { float cy = 0.f;
#pragma unroll
          for (int s8 = 0; s8 < 8; ++s8) cy = segA[s8 * DH + tid] * cy + segH[s8 * DH + tid];
          carr[tid] = cy; }
        __syncthreads();
        {
            float cr[16];
#pragma unroll
            for (int ks = 0; ks < 2; ++ks) { const f32x4 c0 = *(const LAS f32x4*)(carr + wid * 64 + 32 * ks + 8 * fq), c1 = *(const LAS f32x4*)(carr + wid * 64 + 32 * ks + 8 * fq + 4);
                cr[8 * ks + 0] = c0.x; cr[8 * ks + 1] = c0.y; cr[8 * ks + 2] = c0.z; cr[8 * ks + 3] = c0.w; cr[8 * ks + 4] = c1.x; cr[8 * ks + 5] = c1.y; cr[8 * ks + 6] = c1.z; cr[8 * ks + 7] = c1.w; }
            m2_rnn_round<4, false>(lds, hl, Pp, proj, Y, red1, cr, b, t0, 0, wid, fr, fq);
            if (NM == 5) m2_rnn_round<1, false>(lds, hl, Pp, proj, Y, red1, cr, b, t0, 4, wid, fr, fq);
        }
        m2_pool_round<4>(proj, Y, Wp, pbias, pscale, red2, b, t0, 0, g, half, kwin, wid, fr, fq);
        if (NM == 5) m2_pool_round<1>(proj, Y, Wp, pbias, pscale, red2, b, t0, 4, g, half, kwin, wid, fr, fq);
    }
    __syncthreads();
}

__device__ __forceinline__ void final_norm(const Params& p_, int G) {
    const Params p = launder(p_);
    int tid_ = threadIdx.x; asm volatile("" : "+v"(tid_));
    const int tid = tid_, lane = tid & 63, wid = tid >> 6; const int gw = blockIdx.x * 8 + wid, NGW = G * 8;
    const bf16* hb = (const bf16*)(p.ws + WS_HB);
    const f32x4* gp = (const f32x4*)p.in[19] + 2 * lane; f32x4 gg[2][2];
#pragma unroll
    for (int j = 0; j < 2; ++j) { gg[j][0] = gp[128 * j]; gg[j][1] = gp[128 * j + 1]; }
    for (int m = gw; m < M; m += NGW) {
        const u32x4* xr = (const u32x4*)(hb + (size_t)m * D) + lane; float v[2][8]; float s = 0.f;
#pragma unroll
        for (int j = 0; j < 2; ++j) { unpack8(xr[64 * j], v[j]);
#pragma unroll
            for (int e = 0; e < 8; ++e) s = fmaf(v[j][e], v[j][e], s); }
        const float rs = 1.0f / sqrtf(wave_sum(s) * (1.0f / D) + EPS);
        f32x4* orow = (f32x4*)(p.out + (size_t)m * D) + 2 * lane;
#pragma unroll
        for (int j = 0; j < 2; ++j) {
            __builtin_nontemporal_store((f32x4){v[j][0] * rs * gg[j][0].x, v[j][1] * rs * gg[j][0].y, v[j][2] * rs * gg[j][0].z, v[j][3] * rs * gg[j][0].w}, orow + 128 * j);
            __builtin_nontemporal_store((f32x4){v[j][4] * rs * gg[j][1].x, v[j][5] * rs * gg[j][1].y, v[j][6] * rs * gg[j][1].z, v[j][7] * rs * gg[j][1].w}, orow + 128 * j + 1); }
    }
}


template <int KW> __device__ __forceinline__ float pool_win(float P, float Sp) {
    float w = P;
    if (KW < 16) w -= dppf<0x110 + (KW & 15)>(0.f, P);
    return w + dppf<0x100 + (17 - KW)>(0.f, Sp);
}
template <int KW, int MAXG> __device__ __forceinline__ void pool_frags(const bf16* proj, bf16x8 (&pfr)[MAXG][4], int b, int tb, int cnt, int g, int fr, int fq) {
#pragma unroll
    for (int ks = 0; ks < 4; ++ks) {
        const int chb = g * 128 + 32 * ks + 8 * fq;
        float Sp[8];
        if (tb) { const u32x4 raw = *(const u32x4*)(proj + ((size_t)b * TT + tb - 16 + fr) * DIN + chb); unpack8(raw, Sp);
#pragma unroll
            for (int e = 0; e < 8; ++e) { Sp[e] += dppf<0x101>(0.f, Sp[e]); Sp[e] += dppf<0x102>(0.f, Sp[e]); Sp[e] += dppf<0x104>(0.f, Sp[e]); Sp[e] += dppf<0x108>(0.f, Sp[e]); } }
        else {
#pragma unroll
            for (int e = 0; e < 8; ++e) Sp[e] = 0.f; }
#pragma unroll
        for (int mi = 0; mi < MAXG; ++mi) if (mi < cnt) {
            const int t = tb + 16 * mi + fr;
            const u32x4 raw = *(const u32x4*)(proj + ((size_t)b * TT + t) * DIN + chb); float u[8], po[8]; unpack8(raw, u);
            const int cn = (t + 1 < KW) ? t + 1 : KW; const float rc = __builtin_amdgcn_rcpf((float)cn);
#pragma unroll
            for (int e = 0; e < 8; ++e) {
                float P = u[e]; P += dppf<0x111>(0.f, P); P += dppf<0x112>(0.f, P); P += dppf<0x114>(0.f, P); P += dppf<0x118>(0.f, P);
                float S = u[e]; S += dppf<0x101>(0.f, S); S += dppf<0x102>(0.f, S); S += dppf<0x104>(0.f, S); S += dppf<0x108>(0.f, S);
                po[e] = fmaf(pool_win<KW>(P, Sp[e]), rc, -u[e]); Sp[e] = S;
            }
            pfr[mi][ks] = __builtin_bit_cast(bf16x8, pack8(po));
        }
    }
}
__device__ __forceinline__ void m2_pool2(const bf16* proj, bf16* Y, const bf16* Wp, const float* pbias, const float* pscale, LAS float* red2, int b, int t0, int NM, int g, int th, int fr, int fq) {
    const int m0 = th ? (NM == 5 ? 3 : 2) : 0, cnt = th ? 2 : (NM == 5 ? 3 : 2), tb = t0 + 16 * m0;
    bf16x8 pfr[3][4];
    switch (g) {
        case 0: pool_frags<2, 3>(proj, pfr, b, tb, cnt, g, fr, fq); break;
        case 1: pool_frags<4, 3>(proj, pfr, b, tb, cnt, g, fr, fq); break;
        case 2: pool_frags<8, 3>(proj, pfr, b, tb, cnt, g, fr, fq); break;
        default: pool_frags<16, 3>(proj, pfr, b, tb, cnt, g, fr, fq); break;
    }
    f32x4 ov[3][8]; float sq[3] = {0.f, 0.f, 0.f};
#pragma unroll
    for (int n = 0; n < 8; ++n) {
        bf16x8 wf[4];
#pragma unroll
        for (int ks = 0; ks < 4; ++ks) wf[ks] = *(const bf16x8*)(Wp + (size_t)outchan(n, fr) * 128 + 32 * ks + 8 * fq);
        const int col = g * 128 + 32 * (n >> 1) + 8 * fq + 4 * (n & 1);
        const f32x4 pb = *(const f32x4*)(pbias + col), ps = *(const f32x4*)(pscale + col);
#pragma unroll
        for (int mi = 0; mi < 3; ++mi) if (mi < cnt) {
            f32x4 acc = {0.f, 0.f, 0.f, 0.f};
#pragma unroll
            for (int ks = 0; ks < 4; ++ks) acc = __builtin_amdgcn_mfma_f32_16x16x32_bf16(wf[ks], pfr[mi][ks], acc, 0, 0, 0);
            acc = (acc + pb) * ps; ov[mi][n] = acc; sq[mi] += (acc.x * acc.x + acc.y * acc.y) + (acc.z * acc.z + acc.w * acc.w);
        }
    }
#pragma unroll
    for (int mi = 0; mi < 3; ++mi) if (mi < cnt) { float s = sq[mi]; s += __shfl_xor(s, 16); s += __shfl_xor(s, 32); if (fq == 0) red2[(16 * (m0 + mi) + fr) * 4 + g] = s; }
    __syncthreads();
#pragma unroll
    for (int mi = 0; mi < 3; ++mi) if (mi < cnt) {
        const size_t rowg = (size_t)b * TT + tb + 16 * mi + fr;
        const f32x4 r0 = *(const LAS f32x4*)(red2 + (16 * (m0 + mi) + fr) * 4);
        const float rs = __builtin_amdgcn_rsqf(((r0.x + r0.y) + (r0.z + r0.w)) * (1.0f / DH) + EPS);
#pragma unroll
        for (int np = 0; np < 4; ++np) {
            const f32x4 a = ov[mi][2 * np] * rs, bq = ov[mi][2 * np + 1] * rs;
            u32x4 w; w.x = cvt_pk(a.x, a.y); w.y = cvt_pk(a.z, a.w); w.z = cvt_pk(bq.x, bq.y); w.w = cvt_pk(bq.z, bq.w);
            *(u32x4*)(Y + rowg * D + g * 128 + 32 * np + 8 * fq) = w;
        }
    }
}

#ifndef PROBE_PHASE
#define PROBE_PHASE (-1)
#endif
#ifndef PROBE_BLOCK
#define PROBE_BLOCK 0
#endif
#define TIC() do { if (PROBE_PHASE >= 0) tic = __builtin_amdgcn_s_memrealtime(); } while (0)
#define TOC(k) do { if (PROBE_PHASE == (k)) tacc += __builtin_amdgcn_s_memrealtime() - tic; } while (0)

__device__ __forceinline__ void mixer_phase(const Params& p_, LAS unsigned char* lds, int G, int l, unsigned long long& tic, unsigned long long& tacc) {
    const Params p = launder(p_);
    int tid_ = threadIdx.x; asm volatile("" : "+v"(tid_));
    const int tid = tid_, lane = tid & 63, wid = __builtin_amdgcn_readfirstlane(tid >> 6), fr = lane & 15, fq = lane >> 4;
    LAS float* cst = (LAS float*)(lds + LDS_CST);
    const bf16* proj = (const bf16*)(p.ws + WS_PROJ);
    const bf16* Wr = (const bf16*)(p.ws + WS_GR) + (size_t)(l * 8 + wid) * 4096; const bf16* Wi = (const bf16*)(p.ws + WS_GI) + (size_t)(l * 8 + wid) * 4096;
    LAS float* segA = (LAS float*)(lds + LDS_CST); LAS float* segH = (LAS float*)(lds + LDS_CST + 8192); LAS float* carr = (LAS float*)(lds + LDS_CARR);
    LAS float* red1 = (LAS float*)(lds + LDS_RED1); LAS float* red2 = (LAS float*)(lds + LDS_RED2);
    bf16* Y = (bf16*)(p.ws + WS_Y);
    const int g = wid >> 1, half = wid & 1, kwin = 2 << g;
    const bf16* Wp = (const bf16*)(p.ws + WS_POOLW) + (size_t)(l * 4 + g) * 16384;
    const float* pbias = p.in[5] + l * DH; const float* pscale = p.in[6] + l * DH;
    unsigned* flags = (unsigned*)(p.ws + WS_FLAG); unsigned* car = (unsigned*)(p.ws + WS_CARA);
    bf16* hl = (bf16*)(p.ws + WS_HL); bf16* Pp = (bf16*)(p.ws + WS_P);
    float* carA = (float*)(p.ws + WS_CARA); float* carH = (float*)(p.ws + WS_CARH);
    const int unit = blockIdx.x;
    if (unit < 256) {
        const int b = unit >> 7, c = unit & 127, t0 = c ? NMETA + 64 * c : 0, NM = c ? 4 : 5;
        TIC();
        float cv[8];
#pragma unroll
        for (int k4 = 0; k4 < 4; ++k4) cv[k4] = p.in[7][(l * 4 + k4) * DH + tid];
        cv[4] = p.in[8][l * DH + tid]; cv[5] = p.in[10][l * DH + tid]; cv[6] = p.in[12][l * DH + tid]; cv[7] = ((const float*)(p.ws + WS_SP))[l * DH + tid];
        bf16x8 wfr[4][2][2];
#pragma unroll
        for (int n = 0; n < 4; ++n)
#pragma unroll
            for (int ks = 0; ks < 2; ++ks) { wfr[n][ks][0] = *(const bf16x8*)(Wr + outchan(n, fr) * 64 + 32 * ks + 8 * fq); wfr[n][ks][1] = *(const bf16x8*)(Wi + outchan(n, fr) * 64 + 32 * ks + 8 * fq); }
        LAS float* cslot = (LAS float*)(lds + LDS_CARRY) + (wid * 4 + fq) * 32;
        if (fr == 15) {
#pragma unroll
            for (int k4 = 0; k4 < 4; ++k4) { *(LAS f32x4*)(cslot + 4 * k4) = (f32x4){0.f, 0.f, 0.f, 0.f}; *(LAS f32x4*)(cslot + 16 + 4 * k4) = (f32x4){1.f, 1.f, 1.f, 1.f}; } }
        u32x4 raw[2][4];
#pragma unroll
        for (int ks = 0; ks < 2; ++ks)
#pragma unroll
            for (int d = 0; d < 4; ++d) { const int tt = t0 + fr - 3 + d; raw[ks][d] = (u32x4){0u, 0u, 0u, 0u};
                if (tt >= 0) raw[ks][d] = *(const u32x4*)(proj + ((size_t)b * TT + tt) * DIN + DH + wid * 64 + 32 * ks + 8 * fq); }
        __syncthreads();
#pragma unroll
        for (int k8 = 0; k8 < 8; ++k8) cst[k8 * DH + tid] = cv[k8];
        __syncthreads();
        TOC(10); TIC();
#pragma unroll 1
        for (int m = 0; m < NM; ++m) {
            const int t = t0 + 16 * m + fr; const size_t rowg = (size_t)b * TT + t;
            u32x4 nraw[2][4];
#pragma unroll
            for (int ks = 0; ks < 2; ++ks)
#pragma unroll
                for (int d = 0; d < 4; ++d) { nraw[ks][d] = (u32x4){0u, 0u, 0u, 0u};
                    if (m + 1 < NM) nraw[ks][d] = *(const u32x4*)(proj + ((size_t)b * TT + t + 13 + d) * DIN + DH + wid * 64 + 32 * ks + 8 * fq); }
            float xc[2][8]; bf16x8 frag[2];
#pragma unroll
            for (int ks = 0; ks < 2; ++ks) {
                const int chb = wid * 64 + 32 * ks + 8 * fq;
                { const f32x4 c0 = *(const LAS f32x4*)(cst + 4 * DH + chb), c1 = *(const LAS f32x4*)(cst + 4 * DH + chb + 4);
                  xc[ks][0] = c0.x; xc[ks][1] = c0.y; xc[ks][2] = c0.z; xc[ks][3] = c0.w; xc[ks][4] = c1.x; xc[ks][5] = c1.y; xc[ks][6] = c1.z; xc[ks][7] = c1.w; }
#pragma unroll
                for (int d = 0; d < 4; ++d) {
                    float u[8]; unpack8(raw[ks][d], u);
                    const f32x4 w0 = *(const LAS f32x4*)(cst + d * DH + chb), w1 = *(const LAS f32x4*)(cst + d * DH + chb + 4);
                    xc[ks][0] += u[0] * w0.x; xc[ks][1] += u[1] * w0.y; xc[ks][2] += u[2] * w0.z; xc[ks][3] += u[3] * w0.w;
                    xc[ks][4] += u[4] * w1.x; xc[ks][5] += u[5] * w1.y; xc[ks][6] += u[6] * w1.z; xc[ks][7] += u[7] * w1.w;
                    raw[ks][d] = nraw[ks][d];
                }
                frag[ks] = __builtin_bit_cast(bf16x8, pack8(xc[ks]));
            }
            f32x4 ar[4], ai[4];
#pragma unroll
            for (int n = 0; n < 4; ++n) { ar[n] = (f32x4){0.f, 0.f, 0.f, 0.f}; ai[n] = (f32x4){0.f, 0.f, 0.f, 0.f};
#pragma unroll
                for (int ks = 0; ks < 2; ++ks) {
                    const bf16x8 wr_ = wfr[n][ks][0], wi_ = wfr[n][ks][1];
                    ar[n] = __builtin_amdgcn_mfma_f32_16x16x32_bf16(wr_, frag[ks], ar[n], 0, 0, 0);
                    ai[n] = __builtin_amdgcn_mfma_f32_16x16x32_bf16(wi_, frag[ks], ai[n], 0, 0, 0);
                } }
            float Aa[16], Bb[16];
#pragma unroll
            for (int n = 0; n < 4; ++n) {
                const int cho = wid * 64 + 32 * (n >> 1) + 8 * fq + 4 * (n & 1);
                const f32x4 rb = *(const LAS f32x4*)(cst + 5 * DH + cho), ib = *(const LAS f32x4*)(cst + 6 * DH + cho), spv = *(const LAS f32x4*)(cst + 7 * DH + cho);
#pragma unroll
                for (int jj = 0; jj < 4; ++jj) {
                    const float r = sigm(ar[n][jj] + rb[jj]), ig = sigm(ai[n][jj] + ib[jj]);
                    const float la = -8.0f * r * spv[jj], a = __expf(la), x2 = 2.0f * la;
                    const float m2s = -x2 * (1.0f + x2 * (0.5f + x2 * (0.16666667f + x2 * 0.041666668f))), m2 = (x2 > -0.0625f) ? m2s : 1.0f - a * a;
                    Aa[n * 4 + jj] = a; Bb[n * 4 + jj] = __builtin_amdgcn_sqrtf(m2) * ig * xc[n >> 1][4 * (n & 1) + jj];
                }
            }
#pragma unroll
            for (int k = 0; k < 16; ++k) {
                float A = Aa[k], B = Bb[k], Ap, Bq;
                Ap = dppf<0x111>(1.f, A); Bq = dppf<0x111>(0.f, B); B = fmaf(A, Bq, B); A *= Ap;
                Ap = dppf<0x112>(1.f, A); Bq = dppf<0x112>(0.f, B); B = fmaf(A, Bq, B); A *= Ap;
                Ap = dppf<0x114>(1.f, A); Bq = dppf<0x114>(0.f, B); B = fmaf(A, Bq, B); A *= Ap;
                Ap = dppf<0x118>(1.f, A); Bq = dppf<0x118>(0.f, B); B = fmaf(A, Bq, B); A *= Ap;
                Bb[k] = B; Aa[k] = A;
            }
            {
                float Hc[16], Pc[16];
#pragma unroll
                for (int k4 = 0; k4 < 4; ++k4) { const f32x4 hq = *(const LAS f32x4*)(cslot + 4 * k4), pq = *(const LAS f32x4*)(cslot + 16 + 4 * k4);
                    Hc[4 * k4] = hq.x; Hc[4 * k4 + 1] = hq.y; Hc[4 * k4 + 2] = hq.z; Hc[4 * k4 + 3] = hq.w; Pc[4 * k4] = pq.x; Pc[4 * k4 + 1] = pq.y; Pc[4 * k4 + 2] = pq.z; Pc[4 * k4 + 3] = pq.w; }
#pragma unroll
                for (int k = 0; k < 16; ++k) { Bb[k] = fmaf(Aa[k], Hc[k], Bb[k]); Aa[k] *= Pc[k]; }
                if (fr == 15) {
#pragma unroll
                    for (int k4 = 0; k4 < 4; ++k4) { *(LAS f32x4*)(cslot + 4 * k4) = (f32x4){Bb[4 * k4], Bb[4 * k4 + 1], Bb[4 * k4 + 2], Bb[4 * k4 + 3]}; *(LAS f32x4*)(cslot + 16 + 4 * k4) = (f32x4){Aa[4 * k4], Aa[4 * k4 + 1], Aa[4 * k4 + 2], Aa[4 * k4 + 3]}; } }
            }
#pragma unroll
            for (int ks = 0; ks < 2; ++ks) {
                const size_t o = rowg * DH + wid * 64 + 32 * ks + 8 * fq;
                u32x4 wh; wh.x = cvt_pk(Bb[8 * ks + 0], Bb[8 * ks + 1]); wh.y = cvt_pk(Bb[8 * ks + 2], Bb[8 * ks + 3]); wh.z = cvt_pk(Bb[8 * ks + 4], Bb[8 * ks + 5]); wh.w = cvt_pk(Bb[8 * ks + 6], Bb[8 * ks + 7]);
                u32x4 w; w.x = cvt_pk(Aa[8 * ks + 0], Aa[8 * ks + 1]); w.y = cvt_pk(Aa[8 * ks + 2], Aa[8 * ks + 3]); w.z = cvt_pk(Aa[8 * ks + 4], Aa[8 * ks + 5]); w.w = cvt_pk(Aa[8 * ks + 6], Aa[8 * ks + 7]);
                if (m < 4) { *(LAS u32x4*)(lds + LDS_HL + wid * 8192 + ((m * 2 + ks) * 64 + lane) * 16) = wh; *(LAS u32x4*)(lds + LDS_P + wid * 8192 + ((m * 2 + ks) * 64 + lane) * 16) = w; }
                else { *(u32x4*)(hl + o) = wh; *(u32x4*)(Pp + o) = w; }
            }
        }
        TOC(11); TIC();
        if (fr == 0) {
            float Hc[16], Pc[16];
#pragma unroll
            for (int k4 = 0; k4 < 4; ++k4) { const f32x4 hq = *(const LAS f32x4*)(cslot + 4 * k4), pq = *(const LAS f32x4*)(cslot + 16 + 4 * k4);
                Hc[4 * k4] = hq.x; Hc[4 * k4 + 1] = hq.y; Hc[4 * k4 + 2] = hq.z; Hc[4 * k4 + 3] = hq.w; Pc[4 * k4] = pq.x; Pc[4 * k4 + 1] = pq.y; Pc[4 * k4 + 2] = pq.z; Pc[4 * k4 + 3] = pq.w; }
#pragma unroll
            for (int ks = 0; ks < 2; ++ks) {
                const size_t o = (size_t)(b * 128 + c) * DH + wid * 64 + 32 * ks + 8 * fq;
#pragma unroll
                for (int e2 = 0; e2 < 4; ++e2) {
                    const unsigned lo = cvt_pk(Pc[8 * ks + 2 * e2], Hc[8 * ks + 2 * e2]), hi = cvt_pk(Pc[8 * ks + 2 * e2 + 1], Hc[8 * ks + 2 * e2 + 1]);
                    __hip_atomic_store((unsigned long long*)(car + o) + e2, ((unsigned long long)hi << 32) | lo, __ATOMIC_RELAXED, __HIP_MEMORY_SCOPE_AGENT); }
            }
        }
        int fr2 = fr, fq2 = fq, tid2 = tid; asm volatile("" : "+v"(fr2), "+v"(fq2), "+v"(tid2));
        TOC(12); TIC();
#ifndef NO_MX_POOL
        m2_pool2(proj, Y, Wp, pbias, pscale, red2, b, t0, NM, g, half, fr2, fq2);
#endif
        asm volatile("s_waitcnt vmcnt(0)" ::: "memory");
        __syncthreads();
        if (tid2 == 0) __hip_atomic_store(flags + unit, (unsigned)(l + 1), __ATOMIC_RELAXED, __HIP_MEMORY_SCOPE_AGENT);
        TOC(13); TIC();
        if (tid2 < c) { unsigned sp = 0; while (__hip_atomic_load(flags + b * 128 + tid2, __ATOMIC_RELAXED, __HIP_MEMORY_SCOPE_AGENT) < (unsigned)(l + 1)) { __builtin_amdgcn_s_sleep(2); if (++sp > (1u << 22)) break; } }
#if defined(MIXER_ACQ_FENCE)
        if (tid2 < c) __builtin_amdgcn_fence(__ATOMIC_ACQUIRE, "agent");
#endif
        __syncthreads();
        TOC(14); TIC();
        {
            const int q = (c + 3) >> 2, seg = tid2 >> 7, cgi = tid2 & 127, jlo = seg * q, jhi = (jlo + q < c) ? jlo + q : c;
            f32x4 A0 = {1.f, 1.f, 1.f, 1.f}, H0 = {0.f, 0.f, 0.f, 0.f};
            for (int j = jlo; j < jhi; j += 16) {
                unsigned long long w0[16], w1[16];
#pragma unroll
                for (int i = 0; i < 16; ++i) { const int jj = (j + i < jhi) ? j + i : jhi - 1; const size_t o = (size_t)(b * 128 + jj) * DH + 4 * cgi;
                    w0[i] = __hip_atomic_load((const unsigned long long*)(car + o), __ATOMIC_RELAXED, __HIP_MEMORY_SCOPE_AGENT); w1[i] = __hip_atomic_load((const unsigned long long*)(car + o) + 1, __ATOMIC_RELAXED, __HIP_MEMORY_SCOPE_AGENT); }
#pragma unroll
                for (int i = 0; i < 16; ++i) if (j + i < jhi) {
                    const f32x4 a = {bf_lo((unsigned)w0[i]), bf_lo((unsigned)(w0[i] >> 32)), bf_lo((unsigned)w1[i]), bf_lo((unsigned)(w1[i] >> 32))};
                    const f32x4 h = {bf_hi((unsigned)w0[i]), bf_hi((unsigned)(w0[i] >> 32)), bf_hi((unsigned)w1[i]), bf_hi((unsigned)(w1[i] >> 32))};
                    H0 = a * H0 + h; A0 = A0 * a; }
            }
            *(LAS f32x4*)(segA + seg * DH + 4 * cgi) = A0; *(LAS f32x4*)(segH + seg * DH + 4 * cgi) = H0;
        }
        __syncthreads();
        { float cy = 0.f;
#pragma unroll
          for (int s4 = 0; s4 < 4; ++s4) cy = segA[s4 * DH + tid2] * cy + segH[s4 * DH + tid2];
          carr[tid2] = cy; }
        __syncthreads();
        TOC(15); TIC();
        {
            float cr[16];
#pragma unroll
            for (int ks = 0; ks < 2; ++ks) { const f32x4 c0 = *(const LAS f32x4*)(carr + wid * 64 + 32 * ks + 8 * fq2), c1 = *(const LAS f32x4*)(carr + wid * 64 + 32 * ks + 8 * fq2 + 4);
                cr[8 * ks + 0] = c0.x; cr[8 * ks + 1] = c0.y; cr[8 * ks + 2] = c0.z; cr[8 * ks + 3] = c0.w; cr[8 * ks + 4] = c1.x; cr[8 * ks + 5] = c1.y; cr[8 * ks + 6] = c1.z; cr[8 * ks + 7] = c1.w; }
#ifndef NO_MX_RNN
            m2_rnn_round<4, true>(lds, hl, Pp, proj, Y, red1, cr, b, t0, 0, wid, fr2, fq2);
            if (NM == 5) m2_rnn_round<1, false>(lds, hl, Pp, proj, Y, red1, cr, b, t0, 4, wid, fr2, fq2);
#endif
        }
        TOC(16);
    }
    __syncthreads();
}

#define XB_TMO      128
#define XB_XCNT(j)  (256  + 64 * (j))
#define XB_XSUB(j)  (1280 + 64 * (j))
#define XB_XGEN(j)  (2304 + 64 * (j))
#define XB_TOP      3328
#define XB_TOPGEN   3392
#define XCD_BAR_WORDS 3456
#define XB_SPIN_CAP (1u << 18)

__device__ __forceinline__ unsigned xb_ld(unsigned* p)              { return __hip_atomic_load(p, __ATOMIC_RELAXED, __HIP_MEMORY_SCOPE_AGENT); }
__device__ __forceinline__ unsigned xb_add(unsigned* p, unsigned v) { return __hip_atomic_fetch_add(p, v, __ATOMIC_RELAXED, __HIP_MEMORY_SCOPE_AGENT); }
__device__ __forceinline__ unsigned xb_xcc_id() { return (unsigned)__builtin_amdgcn_s_getreg((3 << 11) | 20) & 0xFu; }
#define XB_SPIN(cond, bar) do { unsigned _sp = 0; while (cond) { __builtin_amdgcn_s_sleep(1); \
    if ((++_sp & 255u) == 0u) { if (xb_ld(&(bar)[XB_TMO])) break; if (_sp > XB_SPIN_CAP) { atomicAdd(&(bar)[XB_TMO], 1u); break; } } } } while (0)

struct XcdBarrier {
    unsigned* bar; unsigned x;
    volatile LAS unsigned* st;
};

__device__ __forceinline__ XcdBarrier xcd_barrier_post(unsigned* bar, volatile LAS unsigned* st) {
    XcdBarrier b; b.bar = bar; b.x = xb_xcc_id(); b.st = st;
    if (threadIdx.x == 0) (void)xb_add(&bar[XB_XCNT(b.x)], 1u);
    return b;
}
__device__ __forceinline__ void xcd_barrier_complete(unsigned* bar, unsigned x, unsigned& nloc, unsigned& nx) {
    const unsigned G = gridDim.x * gridDim.y * gridDim.z;
    unsigned sum, cnt, mine, sp = 0u;
    for (;;) {
        sum = 0u; cnt = 0u; mine = 0u;
#pragma unroll
        for (unsigned j = 0; j < 16; ++j) { const unsigned c = xb_ld(&bar[XB_XCNT(j)]); sum += c; cnt += (c > 0u) ? 1u : 0u; mine = (j == x) ? c : mine; }
        if (sum == G) break;
        __builtin_amdgcn_s_sleep(1);
        if ((++sp & 255u) == 0u) { if (xb_ld(&bar[XB_TMO])) break; if (sp > XB_SPIN_CAP) { atomicAdd(&bar[XB_TMO], 1u); break; } }
    }
    nloc = mine > 0u ? mine : 1u; nx = cnt > 0u ? cnt : 1u;
}

__device__ __forceinline__ void xcd_barrier(const XcdBarrier& b) {
    asm volatile("s_waitcnt vmcnt(0)" ::: "memory");
    __syncthreads();
    if (threadIdx.x == 0) {
        unsigned* bar = b.bar;
        __builtin_amdgcn_s_waitcnt(0);
        unsigned nloc = b.st[0], nx = b.st[1];
        if (nloc == 0u) { xcd_barrier_complete(bar, b.x, nloc, nx); b.st[0] = nloc; b.st[1] = nx; }
        const unsigned old = xb_add(&bar[XB_XSUB(b.x)], 1u);
        const unsigned gen = old / nloc;
        if (old + 1u == (gen + 1u) * nloc) {
            __builtin_amdgcn_fence(__ATOMIC_RELEASE, "agent");
            asm volatile("s_waitcnt vmcnt(0)" ::: "memory");
            const unsigned og = xb_add(&bar[XB_TOP], 1u);
            const unsigned tg = og / nx;
            if (og + 1u == (tg + 1u) * nx) xb_add(&bar[XB_TOPGEN], 1u);
            else XB_SPIN(xb_ld(&bar[XB_TOPGEN]) == tg, bar);
            __builtin_amdgcn_fence(__ATOMIC_ACQUIRE, "agent");
            asm volatile("s_waitcnt vmcnt(0)" ::: "memory");
        } else {
            XB_SPIN(xb_ld(&bar[XB_TOPGEN]) == gen, bar);
            __builtin_amdgcn_fence(__ATOMIC_ACQUIRE, "agent");
            asm volatile("s_waitcnt vmcnt(0)" ::: "memory");
        }
    }
    __syncthreads();
}

#ifndef PROBE_SYNC2
#define PROBE_SYNC2 0
#endif
#ifndef PROBE_M1X2
#define PROBE_M1X2 0
#endif
#ifndef PROBE_M2X2
#define PROBE_M2X2 0
#endif
#define GSYNC() do { { __attribute__((address_space(1))) unsigned* gb_ = (__attribute__((address_space(1))) unsigned*)xbar.bar; asm volatile("" : "+s"(gb_)); xbar.bar = (unsigned*)gb_; asm volatile("" : "+s"(xbar.x)); } xcd_barrier(xbar); if (PROBE_SYNC2) xcd_barrier(xbar); } while (0)
__device__ __forceinline__ int rstd_cache(LAS unsigned char* lds, const float* ss, const pg8::StaticOrder& S) {
    pg8::Unit u0; int pmc = -1;
    int tid = threadIdx.x; asm volatile("" : "+v"(tid));
    if (S.next(0, u0)) { pmc = u0.pm; if (tid < 256) ((LAS float*)(lds + 131072))[tid] = row_rstd(ss, u0.pm * 256 + tid); }
    asm volatile("s_waitcnt vmcnt(0) lgkmcnt(0)" ::: "memory");
    return pmc;
}
__global__ void __launch_bounds__(512, 2) fwd_megakernel(Params p) {
    extern __shared__ __attribute__((aligned(16))) unsigned char lds_raw[];
    LAS unsigned char* lds = (LAS unsigned char*)lds_raw;
#if defined(KEEP_CG_SYNC)
    cg::grid_group grid = cg::this_grid();
#endif
    const int G = gridDim.x;
    unsigned long long tic = 0, tacc = 0;
    unsigned char* ws = p.ws;
    volatile LAS unsigned* xst = (volatile LAS unsigned*)(lds + LDS_XST);
    if (threadIdx.x < 2) xst[threadIdx.x] = 0u;
    __syncthreads();
    XcdBarrier xbar = xcd_barrier_post((unsigned*)(ws + WS_CTL), xst);
    bf16* hb = (bf16*)(ws + WS_HB); bf16* proj = (bf16*)(ws + WS_PROJ); bf16* Y = (bf16*)(ws + WS_Y); bf16* mid = (bf16*)(ws + WS_MID); float* ss = (float*)(ws + WS_SS);
#if defined(KEEP_CG_SYNC)
    grid.sync();
#endif
    TIC();
#ifndef NO_PRO
    prologue(p, lds, G);
#endif
    GSYNC();
    TOC(0);
#pragma unroll 1
    for (int l = 0; l < DEPTH; ++l) {
        { __attribute__((address_space(1))) unsigned char* gws = (__attribute__((address_space(1))) unsigned char*)ws; asm volatile("" : "+s"(gws)); ws = (unsigned char*)gws; }
        const unsigned char* wl = ws + WS_W + (size_t)l * W_LAYER;
        const bf16* in_t = (const bf16*)(wl + W_IN); const bf16* out_t = (const bf16*)(wl + W_OUT); const bf16* up_t = (const bf16*)(wl + W_UP); const bf16* down_t = (const bf16*)(wl + W_DOWN);
        TIC();
#ifndef NO_GIN
        { pg8::Gemm g{hb, in_t, M, DIN, D, 0}; pg8::StaticOrder S; S.init(M, DIN, G, (int)blockIdx.x); const int pmc = rstd_cache(lds, ss, S); EpiIn E{proj, ss, (const LAS float*)(lds + 131072), pmc};
          pg8::gemm_phase<EpiIn, pg8::StaticOrder, true, true>(lds, g, S, E); }
#endif
#ifndef NO_META
        meta_tasks<0>(p, lds, G, nullptr, 0, in_t, D, DIN / 16);
#endif
        if (G == 256 && blockIdx.x >= 128) {
            const int lo = l * TITEMS_PER_LAYER + TITEMS_IN, hi = (l + 1 < DEPTH) ? (l + 1) * TITEMS_PER_LAYER + TITEMS_IN : DEPTH * TITEMS_PER_LAYER;
            convert_items(p, lds, lo, hi, (int)blockIdx.x - 128, 128 * 8);
        }
        GSYNC();
        TOC(1); TIC();
#ifndef FUSED_MIXER
#define FUSED_MIXER 1
#endif
#if FUSED_MIXER
        mixer_phase(p, lds, G, l, tic, tacc);
        GSYNC();
        TOC(2);
#else
        m1_phase(p, lds, G, l);
        GSYNC();
        TOC(2); TIC();
        m2_phase(p, lds, G, l);
        GSYNC();
#endif
        TOC(3); TIC();
#ifndef NO_GOUT
        { pg8::Gemm g{Y, out_t, M, D, D, NMETA}; pg8::StaticOrder S; S.init(M, D, G, (int)blockIdx.x); EpiRes E{hb, ss};
          pg8::gemm_phase<EpiRes, pg8::StaticOrder, false, true>(lds, g, S, E); }
#endif
#ifndef NO_META
        if (l < DEPTH - 1) meta_tasks<1>(p, lds, G, Y, D, out_t, D, D / 16);
#endif
        GSYNC();
        TOC(4); TIC();
#ifndef NO_GUP
#ifndef STAGGER_UP
#define STAGGER_UP 0
#endif
        if (STAGGER_UP > 0) {
            const unsigned long long w0 = __builtin_amdgcn_s_memrealtime(), dl = (unsigned long long)(((blockIdx.x >> 3) & 3) * STAGGER_UP);
            while (__builtin_amdgcn_s_memrealtime() - w0 < dl) __builtin_amdgcn_s_sleep(4);
        }
        { pg8::Gemm g{hb, up_t, M, FF, D, 0}; pg8::StaticOrder S; S.init(M, FF, G, (int)blockIdx.x); const int pmc = rstd_cache(lds, ss, S); EpiUp E{mid, ss, (const LAS float*)(lds + 131072), pmc};
          pg8::gemm_phase<EpiUp, pg8::StaticOrder, true, true>(lds, g, S, E); }
#endif
#ifndef NO_META
        if (l < DEPTH - 1) meta_tasks<2>(p, lds, G, nullptr, 0, up_t, D, FF / 16);
#endif
        GSYNC();
        TOC(5); TIC();
#ifndef NO_GDN
        { pg8::Gemm g{mid, down_t, M, D, FF, 0}; pg8::StaticOrder S; S.init(M, D, G, (int)blockIdx.x); EpiRes E{hb, ss};
          pg8::gemm_phase<EpiRes, pg8::StaticOrder, false, true>(lds, g, S, E); }
#endif
#ifndef NO_META
        if (l < DEPTH - 1) meta_tasks<1, 16>(p, lds, G, (const bf16*)(ws + WS_MIDMETA), FF, down_t, FF, D / 16);
#endif
        GSYNC();
        TOC(6);
    }
    TIC();
    final_norm(p, G);
    TOC(7);
    if (PROBE_PHASE >= 0 && blockIdx.x == PROBE_BLOCK && threadIdx.x == 0) { const unsigned long long w0 = __builtin_amdgcn_s_memrealtime(); while (__builtin_amdgcn_s_memrealtime() - w0 < 4ull * tacc) __builtin_amdgcn_s_sleep(8); }
}

extern "C" void kernel_launch(void* const* d_in, const int* in_sizes, int n_in, void* d_out, int out_size, void* d_ws, size_t ws_size, hipStream_t stream) {
    static int grid = 0;
    if (grid == 0) {
        if (n_in != 20 || in_sizes[0] != M * D || out_size != M * D || ws_size < WS_END) { fprintf(stderr, "kernel_launch: unexpected shapes (n_in %d, in0 %d, out %d, ws %zu)\n", n_in, n_in > 0 ? in_sizes[0] : -1, out_size, ws_size); grid = -1; return; }
        int dev = 0, cus = 0, per_cu = 0;
        if (hipGetDevice(&dev) != hipSuccess || hipDeviceGetAttribute(&cus, hipDeviceAttributeMultiprocessorCount, dev) != hipSuccess) { grid = -1; return; }
        if (hipFuncSetAttribute((const void*)fwd_megakernel, hipFuncAttributeMaxDynamicSharedMemorySize, LDS_BYTES) != hipSuccess) { fprintf(stderr, "kernel_launch: hipFuncSetAttribute failed\n"); grid = -1; return; }
        if (hipOccupancyMaxActiveBlocksPerMultiprocessor(&per_cu, (const void*)fwd_megakernel, 512, LDS_BYTES) != hipSuccess || per_cu < 1) { fprintf(stderr, "kernel_launch: occupancy query gave %d\n", per_cu); (void)hipGetLastError(); grid = -1; return; }
        grid = cus * 1;
        if (grid < 256) { fprintf(stderr, "kernel_launch: %d CUs; the fused mixer phase needs 256 resident workgroups\n", cus); grid = -1; return; }
    }
    if (grid < 0) return;
    if (hipMemsetAsync((char*)d_ws + WS_CTL, 0, WS_FLAG + 256 * 4, stream) != hipSuccess) { fprintf(stderr, "kernel_launch: memset failed\n"); return; }
    Params p{};
    for (int i = 0; i < 20; ++i) p.in[i] = (const float*)d_in[i];
    p.out = (float*)d_out; p.ws = (unsigned char*)d_ws;
    void* args[] = {&p};
    hipError_t e = hipLaunchCooperativeKernel((const void*)fwd_megakernel, dim3(grid), dim3(512), args, LDS_BYTES, stream);
    if (e != hipSuccess) fprintf(stderr, "cooperative launch failed: %s (grid %d)\n", hipGetErrorString(e), grid);
}
```
